# Optimizing an MI355X kernel written in HIP

```python
import jax, jax.numpy as jnp
from jax import lax
import numpy as np

D_MODEL = 1024
BATCH = 2
SEQ = 8192
DEPTH = 4
DEC_BATCH = 32
DEC_SEQ = 2048
PAST_LEN = 128

N_MIXERS = 2
N_MLA = (DEPTH + 1) // 2
N_HGRN = DEPTH // 2
PLE_DIM = 256
MLA_HEADS = 8
MLA_NOPE = 128
MLA_ROPE = 64
MLA_V = 128
MLA_Q_LORA = 384
MLA_KV_LORA = 256
MLA_SCALE = (MLA_NOPE + MLA_ROPE) ** -0.5
ROPE_THETA = 10000.0
Q_BLOCK = 128
HGRN_HEADS = 8
HGRN_DK = 128
HGRN_DV = 128
HGRN_CHUNK = 32
GATE_FLOOR = 1e-30
PEER_HEADS = 8
PEER_DK = 256
N_KEYS = 128
N_EXPERTS = N_KEYS * N_KEYS
PEER_TOPK = 16
PEER_BLOCK = 128
DEEPNORM_ALPHA = (2 * DEPTH) ** 0.25
DEEPNORM_BETA = (8 * DEPTH) ** -0.25
LN_EPS = 1e-5
RMS_EPS = 1e-6

kernel_name = 'hybrid_mla_hgrn2_peer_encoder'


def layer_norm(x, g, b):
    xf = x.astype(jnp.float32)
    mu = jnp.mean(xf, axis=-1, keepdims=True)
    var = jnp.mean(jnp.square(xf - mu), axis=-1, keepdims=True)
    y = (xf - mu) * lax.rsqrt(var + LN_EPS) * g.astype(jnp.float32) + b.astype(jnp.float32)
    return y.astype(x.dtype)


def rms_norm(x, w):
    xf = x.astype(jnp.float32)
    return xf * lax.rsqrt(jnp.mean(jnp.square(xf), axis=-1, keepdims=True) + RMS_EPS) * w.astype(jnp.float32)


def rope_tables(seq_len):
    inv_freq = 1.0 / (ROPE_THETA ** (jnp.arange(0, MLA_ROPE, 2, dtype=jnp.float32) / MLA_ROPE))
    ang = jnp.arange(seq_len, dtype=jnp.float32)[:, None] * inv_freq[None, :]
    emb = jnp.concatenate([ang, ang], axis=-1)
    return jnp.cos(emb), jnp.sin(emb)


def rotate_half(t):
    t1, t2 = jnp.split(t, 2, axis=-1)
    return jnp.concatenate([-t2, t1], axis=-1)


def apply_rope(t, cos, sin):
    return t * cos.astype(t.dtype) + rotate_half(t) * sin.astype(t.dtype)


def bidir_attention(q, k, v):
    B, S, H, Dq = q.shape
    nb = S // Q_BLOCK
    qb = q.reshape(B, nb, Q_BLOCK, H, Dq).transpose(1, 0, 2, 3, 4)

    def one_block(qc):
        s = jnp.einsum('bqhd,bkhd->bhqk', qc, k, preferred_element_type=jnp.float32) * MLA_SCALE
        pr = jax.nn.softmax(s, axis=-1).astype(v.dtype)
        return jnp.einsum('bhqk,bkhd->bqhd', pr, v)

    o = lax.map(one_block, qb)
    return o.transpose(1, 0, 2, 3, 4).reshape(B, S, H, v.shape[-1])


def mla_mixer(x, w_a, q_norm, kv_norm, w_uq, w_ukv, w_o, cos, sin):
    B, S, _ = x.shape
    a = x @ w_a
    c_q = a[..., :MLA_Q_LORA]
    c_kv = a[..., MLA_Q_LORA:MLA_Q_LORA + MLA_KV_LORA]
    k_rope = a[..., MLA_Q_LORA + MLA_KV_LORA:]
    q = (rms_norm(c_q, q_norm).astype(x.dtype) @ w_uq).reshape(B, S, MLA_HEADS, MLA_NOPE + MLA_ROPE)
    kv = (rms_norm(c_kv, kv_norm).astype(x.dtype) @ w_ukv).reshape(B, S, MLA_HEADS, MLA_NOPE + MLA_V)
    q_nope, q_rope = q[..., :MLA_NOPE], q[..., MLA_NOPE:]
    k_nope, v = kv[..., :MLA_NOPE], kv[..., MLA_NOPE:]
    q_rope = apply_rope(q_rope, cos[None, :, None, :], sin[None, :, None, :])
    k_rope = apply_rope(k_rope, cos[None], sin[None])
    q = jnp.concatenate([q_nope, q_rope], axis=-1)
    k = jnp.concatenate([k_nope, jnp.broadcast_to(k_rope[:, :, None, :], (B, S, MLA_HEADS, MLA_ROPE))], axis=-1)
    o = bidir_attention(q, k, v)
    return o.reshape(B, S, MLA_HEADS * MLA_V) @ w_o


def gla_chunk_scan(q, k, v, log_f):
    B, S, H, dk = q.shape
    dv = v.shape[-1]
    nc = S // HGRN_CHUNK

    def to_chunks(t):
        return t.astype(jnp.float32).reshape(B, nc, HGRN_CHUNK, H, t.shape[-1]).transpose(1, 0, 3, 2, 4)

    lower = jnp.tril(jnp.ones((HGRN_CHUNK, HGRN_CHUNK), dtype=bool))[:, :, None]

    def step(state, inp):
        qc, kc, vc, gc = inp
        b = jnp.cumsum(gc, axis=-2)
        diff = b[..., :, None, :] - b[..., None, :, :]
        decay = jnp.where(lower, jnp.exp(jnp.minimum(diff, 0.0)), 0.0)
        attn = jnp.einsum('bhtk,bhtsk->bhts', qc, decay * kc[..., None, :, :])
        o = jnp.einsum('bhts,bhsv->bhtv', attn, vc) + jnp.einsum('bhtk,bhkv->bhtv', qc * jnp.exp(b), state)
        b_last = b[..., -1:, :]
        state = jnp.exp(b_last[..., 0, :])[..., None] * state + jnp.einsum('bhsk,bhsv->bhkv', kc * jnp.exp(b_last - b), vc)
        return state, o

    state0 = jnp.zeros((B, H, dk, dv), jnp.float32)
    _, o = lax.scan(step, state0, (to_chunks(q), to_chunks(k), to_chunks(v), to_chunks(log_f)))
    return o.transpose(1, 0, 3, 2, 4).reshape(B, S, H, dv)


def hgrn2_mixer(x, w_in, lb_f, lb_b, norm_w, w_o):
    B, S, _ = x.shape
    hk = HGRN_HEADS * HGRN_DK
    hv = HGRN_HEADS * HGRN_DV
    proj = x @ w_in
    q = jax.nn.silu(proj[..., :hk]).reshape(B, S, HGRN_HEADS, HGRN_DK)
    z_f = proj[..., hk:2 * hk]
    z_b = proj[..., 2 * hk:3 * hk]
    v = proj[..., 3 * hk:3 * hk + hv].reshape(B, S, HGRN_HEADS, HGRN_DV)
    g = proj[..., 3 * hk + hv:].reshape(B, S, HGRN_HEADS, HGRN_DV)

    def gates(z, lb):
        z = z.astype(jnp.float32)
        f = lb + (1.0 - lb) * jax.nn.sigmoid(z)
        log_f = jnp.log(jnp.maximum(f, GATE_FLOOR))
        k = (1.0 - lb) * jax.nn.sigmoid(-z)
        return log_f.reshape(B, S, HGRN_HEADS, HGRN_DK), k.reshape(B, S, HGRN_HEADS, HGRN_DK)

    g_f, k_f = gates(z_f, lb_f)
    g_b, k_b = gates(z_b, lb_b)
    flip = lambda t: jnp.flip(t, axis=1)
    o = gla_chunk_scan(q, k_f, v, g_f) + flip(gla_chunk_scan(flip(q), flip(k_b), flip(v), flip(g_b)))
    o = rms_norm(o, norm_w) * jax.nn.silu(g.astype(jnp.float32))
    return o.reshape(B, S, hv).astype(x.dtype) @ w_o


def peer_ffn(x, w_q, sub_keys, u, v):
    B, S, D = x.shape
    xb = x.reshape(B * S // PEER_BLOCK, PEER_BLOCK, D)
    kk = PEER_TOPK * PEER_TOPK

    def one_block(xc):
        q = (xc @ w_q).reshape(PEER_BLOCK, PEER_HEADS, 2, PEER_DK // 2)
        s = jnp.einsum('thcd,cnd->thcn', q, sub_keys, preferred_element_type=jnp.float32)
        sv, si = lax.top_k(s, PEER_TOPK)
        cand = (sv[:, :, 0, :, None] + sv[:, :, 1, None, :]).reshape(PEER_BLOCK, PEER_HEADS, kk)
        cidx = (si[:, :, 0, :, None] * N_KEYS + si[:, :, 1, None, :]).reshape(PEER_BLOCK, PEER_HEADS, kk)
        top_s, pos = lax.top_k(cand, PEER_TOPK)
        idx = jnp.take_along_axis(cidx, pos, axis=-1)
        gate = jax.nn.softmax(top_s, axis=-1)
        ue = jnp.take(u, idx, axis=0)
        ve = jnp.take(v, idx, axis=0)
        h = jax.nn.gelu(jnp.einsum('thkd,td->thk', ue, xc, preferred_element_type=jnp.float32), approximate=False)
        return jnp.einsum('thk,thkd->td', (gate * h).astype(x.dtype), ve)

    return lax.map(one_block, xb).reshape(B, S, D)


def trunk(x, p, lower_bounds, mla_w_a, mla_q_norm, mla_kv_norm, mla_w_uq, mla_w_ukv, mla_w_o,
          hgrn_w_in, hgrn_norm, hgrn_w_o, peer_w_q, peer_sub_keys, peer_u, peer_v,
          ln1_g, ln1_b, ln2_g, ln2_b, ple_gate_w, ple_gate_b, ple_proj):
    cos, sin = rope_tables(x.shape[1])
    for i in range(DEPTH):
        j = i // N_MIXERS
        if i % N_MIXERS == 0:
            h = mla_mixer(x, mla_w_a[j], mla_q_norm[j], mla_kv_norm[j], mla_w_uq[j], mla_w_ukv[j], mla_w_o[j], cos, sin)
        else:
            h = hgrn2_mixer(x, hgrn_w_in[j], lower_bounds[0, j], lower_bounds[1, j], hgrn_norm[j], hgrn_w_o[j])
        x = layer_norm(DEEPNORM_ALPHA * x + h, ln1_g[i], ln1_b[i])
        x = layer_norm(DEEPNORM_ALPHA * x + peer_ffn(x, peer_w_q[i], peer_sub_keys[i], peer_u[i], peer_v[i]), ln2_g[i], ln2_b[i])
        gate = jax.nn.sigmoid(x @ ple_gate_w[i] + ple_gate_b[i])
        x = x + gate * (p[i] @ ple_proj[i])
    return x


def setup_inputs(seed: int = 0) -> dict:
    key = jax.random.key(seed)
    ks = jax.random.split(key, 32)
    f32 = jnp.float32

    def nrm(k, shape, scale):
        return jax.random.normal(k, shape, f32) * scale

    hk = HGRN_HEADS * HGRN_DK
    hv = HGRN_HEADS * HGRN_DV
    ukv_scale = jnp.concatenate([jnp.ones((MLA_NOPE,), f32), jnp.full((MLA_V,), DEEPNORM_BETA, f32)])
    hin_scale = jnp.concatenate([jnp.ones((3 * hk,), f32), jnp.full((hv,), DEEPNORM_BETA, f32), jnp.ones((hv,), f32)])
    return {
        'x_prompt': nrm(ks[0], (BATCH, SEQ, D_MODEL), 1.0),
        'x_sample': nrm(ks[1], (DEC_BATCH, DEC_SEQ, D_MODEL), 1.0),
        'p_prompt': nrm(ks[2], (DEPTH, BATCH, SEQ, PLE_DIM), 1.0),
        'p_sample': nrm(ks[3], (DEPTH, DEC_BATCH, DEC_SEQ, PLE_DIM), 1.0),
        'mla_w_a': nrm(ks[4], (N_MLA, D_MODEL, MLA_Q_LORA + MLA_KV_LORA + MLA_ROPE), D_MODEL ** -0.5),
        'mla_q_norm': 1.0 + nrm(ks[5], (N_MLA, MLA_Q_LORA), 0.02),
        'mla_kv_norm': 1.0 + nrm(ks[6], (N_MLA, MLA_KV_LORA), 0.02),
        'mla_w_uq': nrm(ks[7], (N_MLA, MLA_Q_LORA, MLA_HEADS * (MLA_NOPE + MLA_ROPE)), MLA_Q_LORA ** -0.5),
        'mla_w_ukv': (nrm(ks[8], (N_MLA, MLA_KV_LORA, MLA_HEADS, MLA_NOPE + MLA_V), MLA_KV_LORA ** -0.5) * ukv_scale).reshape(N_MLA, MLA_KV_LORA, MLA_HEADS * (MLA_NOPE + MLA_V)),
        'mla_w_o': nrm(ks[9], (N_MLA, MLA_HEADS * MLA_V, D_MODEL), DEEPNORM_BETA * (MLA_HEADS * MLA_V) ** -0.5),
        'hgrn_w_in': nrm(ks[10], (N_HGRN, D_MODEL, 3 * hk + 2 * hv), D_MODEL ** -0.5) * hin_scale,
        'hgrn_lb': nrm(ks[11], (2, N_HGRN, hk), 0.5),
        'hgrn_norm': 1.0 + nrm(ks[12], (N_HGRN, HGRN_DV), 0.02),
        'hgrn_w_o': nrm(ks[13], (N_HGRN, hv, D_MODEL), DEEPNORM_BETA * hv ** -0.5),
        'peer_w_q': nrm(ks[14], (DEPTH, D_MODEL, PEER_HEADS * PEER_DK), D_MODEL ** -0.5),
        'peer_sub_keys': nrm(ks[15], (DEPTH, 2, N_KEYS, PEER_DK // 2), (PEER_DK // 2) ** -0.5),
        'peer_u': nrm(ks[16], (DEPTH, N_EXPERTS, D_MODEL), D_MODEL ** -0.5),
        'peer_v': nrm(ks[17], (DEPTH, N_EXPERTS, D_MODEL), DEEPNORM_BETA * PEER_HEADS ** -0.5),
        'ln1_g': 1.0 + nrm(ks[18], (DEPTH, D_MODEL), 0.02),
        'ln1_b': nrm(ks[19], (DEPTH, D_MODEL), 0.02),
        'ln2_g': 1.0 + nrm(ks[20], (DEPTH, D_MODEL), 0.02),
        'ln2_b': nrm(ks[21], (DEPTH, D_MODEL), 0.02),
        'ple_gate_w': nrm(ks[22], (DEPTH, D_MODEL, D_MODEL), D_MODEL ** -0.5),
        'ple_gate_b': nrm(ks[23], (DEPTH, D_MODEL), 0.02),
        'ple_proj': nrm(ks[24], (DEPTH, PLE_DIM, D_MODEL), PLE_DIM ** -0.5),
    }


def reference(x_prompt, x_sample, p_prompt, p_sample, mla_w_a, mla_q_norm, mla_kv_norm, mla_w_uq, mla_w_ukv, mla_w_o,
              hgrn_w_in, hgrn_lb, hgrn_norm, hgrn_w_o, peer_w_q, peer_sub_keys, peer_u, peer_v,
              ln1_g, ln1_b, ln2_g, ln2_b, ple_gate_w, ple_gate_b, ple_proj):
    sm = jax.nn.softmax(hgrn_lb.astype(jnp.float32), axis=1)
    lower_bounds = jnp.cumsum(sm, axis=1) - sm[:, :1]
    y_prompt = trunk(x_prompt, p_prompt, lower_bounds, mla_w_a, mla_q_norm, mla_kv_norm, mla_w_uq, mla_w_ukv, mla_w_o,
                     hgrn_w_in, hgrn_norm, hgrn_w_o, peer_w_q, peer_sub_keys, peer_u, peer_v,
                     ln1_g, ln1_b, ln2_g, ln2_b, ple_gate_w, ple_gate_b, ple_proj)
    y_sample = trunk(x_sample, p_sample, lower_bounds, mla_w_a, mla_q_norm, mla_kv_norm, mla_w_uq, mla_w_ukv, mla_w_o,
                     hgrn_w_in, hgrn_norm, hgrn_w_o, peer_w_q, peer_sub_keys, peer_u, peer_v,
                     ln1_g, ln1_b, ln2_g, ln2_b, ple_gate_w, ple_gate_b, ple_proj)
    return (y_prompt, y_sample)
```

```cpp
#include <hip/hip_runtime.h>
#include <cstdio>
#include <cstdint>

#ifndef MK_ONE_LAUNCH
#define MK_ONE_LAUNCH 1
#endif

#define GAS __attribute__((address_space(1)))
#define LAS __attribute__((address_space(3)))
typedef unsigned short bf16_t;
typedef short bf16x8 __attribute__((ext_vector_type(8)));
typedef short s16x4 __attribute__((ext_vector_type(4)));
typedef float f32x4 __attribute__((ext_vector_type(4)));
typedef float f32x2 __attribute__((ext_vector_type(2)));
typedef float f32x16 __attribute__((ext_vector_type(16)));
typedef unsigned u32x4 __attribute__((ext_vector_type(4)));
typedef unsigned u32x2 __attribute__((ext_vector_type(2)));

constexpr int D = 1024, TP = 16384, TS = 65536, T = TP + TS, SP = 8192, SS = 2048;
constexpr int NL = 4;
constexpr int NWAVES = 8, NTHR = 512;
constexpr float DN_ALPHA = 1.681792830507429f;
constexpr float LN_EPS = 1e-5f, RMS_EPS = 1e-6f;
constexpr float MLA_SCALE = 0.07216878364870323f;
constexpr int NEXP = 16384;

constexpr size_t MiB = 1u << 20;
constexpr size_t WS_CTL = 0, CTL_ZERO_BYTES = 64 * 1024;
constexpr size_t WS_ROPE = 1 * MiB;
constexpr size_t WS_MISC = 3 * MiB;
constexpr size_t WS_W = 4 * MiB;
constexpr size_t W_WA = WS_W;
constexpr size_t W_WUQ = W_WA + 2 * (size_t)768 * 1024 * 2;
constexpr size_t W_WUKV = W_WUQ + 2 * (size_t)1536 * 384 * 2;
constexpr size_t W_WO = W_WUKV + 2 * (size_t)2048 * 256 * 2;
constexpr size_t W_HIN = W_WO + 2 * (size_t)1024 * 1024 * 2;
constexpr size_t W_HO = W_HIN + 2 * (size_t)5120 * 1024 * 2;
constexpr size_t W_PQ = W_HO + 2 * (size_t)1024 * 1024 * 2;
constexpr size_t W_GW = W_PQ + 4 * (size_t)2048 * 1024 * 2;
constexpr size_t W_PP = W_GW + 4 * (size_t)1024 * 1024 * 2;
constexpr size_t W_KEYS = W_PP + 4 * (size_t)1024 * 256 * 2;
constexpr size_t W_END = W_KEYS + 4 * (size_t)2 * 128 * 128 * 2;
static_assert(W_END <= 68 * MiB, "weights region");
constexpr size_t WS_R2 = 68 * MiB;
constexpr size_t R2_UB = WS_R2, R2_VB = WS_R2 + 32 * MiB, R2_IDX = WS_R2 + 64 * MiB, R2_GATE = WS_R2 + 104 * MiB, R2_PB = WS_R2 + 144 * MiB;
constexpr size_t WS_XB = 252 * MiB;
constexpr size_t WS_BIG = 412 * MiB;
constexpr size_t WS_END = WS_BIG + 800 * MiB;
constexpr size_t B_Q = WS_BIG, B_KV = WS_BIG + 240 * MiB, B_O = WS_BIG + 560 * MiB, B_KROPE = WS_BIG + 720 * MiB;
constexpr size_t B_A32 = WS_BIG + 240 * MiB, B_CQN = WS_BIG + 560 * MiB, B_CKVN = WS_BIG + 620 * MiB, B_H32_MLA = WS_BIG;
constexpr size_t B_PLANE = WS_BIG, PLANE_BYTES = 160 * MiB, B_H32_HGRN = WS_BIG + 160 * MiB;
constexpr size_t B_PQ = WS_BIG, B_PP = WS_BIG + 320 * MiB;

constexpr int LDS_BYTES = 160 * 1024;
constexpr int LDS_MISC_OFF = LDS_BYTES - 256;

typedef __bf16 bf16x2_n __attribute__((ext_vector_type(2)));
__device__ __forceinline__ unsigned cvt_pk_bf16(float lo, float hi) { const f32x2 v = {lo, hi}; const bf16x2_n b = __builtin_convertvector(v, bf16x2_n); return __builtin_bit_cast(unsigned, b); }
__device__ __forceinline__ bf16_t f2bf(float f) { return (bf16_t)(cvt_pk_bf16(f, 0.f) & 0xffffu); }
__device__ __forceinline__ float bf2f(bf16_t b) { return __uint_as_float(((unsigned)b) << 16); }
__device__ __forceinline__ float bflo(unsigned w) { return __uint_as_float(w << 16); }
__device__ __forceinline__ float bfhi(unsigned w) { return __uint_as_float(w & 0xffff0000u); }
__device__ __forceinline__ float wave_sum(float v) {
#pragma unroll
    for (int o = 1; o < 64; o <<= 1) v += __shfl_xor(v, o);
    return v;
}
__device__ __forceinline__ float fast_exp(float x) { return __builtin_amdgcn_exp2f(x * 1.4426950408889634f); }
__device__ __forceinline__ float fast_log(float x) { return __builtin_amdgcn_logf(x) * 0.6931471805599453f; }
__device__ __forceinline__ float fast_rcp(float x) { return __builtin_amdgcn_rcpf(x); }
__device__ __forceinline__ float sigmoidf_(float x) { return fast_rcp(1.0f + fast_exp(-x)); }
__device__ __forceinline__ float siluf_(float x) { return x * sigmoidf_(x); }
#define LDS_WAIT() asm volatile("s_waitcnt lgkmcnt(0)" ::: "memory")
#define VM_WAIT() asm volatile("s_waitcnt vmcnt(0)" ::: "memory")
__device__ __forceinline__ int opaque_tid() { int t = (int)threadIdx.x; asm volatile("" : "+v"(t)); return t; }
__device__ __forceinline__ int opaque_bid() { int b = (int)blockIdx.x; asm volatile("" : "+s"(b)); return b; }
struct Args { const float* in[25]; float* out; unsigned char* ws; int ph_lo, ph_hi; };
#define XB_TMO      128
#define XB_XCNT(j)  (256  + 64 * (j))
#define XB_XSUB(j)  (1280 + 64 * (j))
#define XB_XGEN(j)  (2304 + 64 * (j))
#define XB_TOP      3328
#define XB_TOPGEN   3392
#define XCD_BAR_WORDS 3456
#define XB_SPIN_CAP (1u << 23)

__device__ __forceinline__ unsigned xb_ld(unsigned* p)              { return __hip_atomic_load(p, __ATOMIC_RELAXED, __HIP_MEMORY_SCOPE_AGENT); }
__device__ __forceinline__ unsigned xb_add(unsigned* p, unsigned v) { return __hip_atomic_fetch_add(p, v, __ATOMIC_RELAXED, __HIP_MEMORY_SCOPE_AGENT); }
__device__ __forceinline__ unsigned xb_xcc_id() { return (unsigned)__builtin_amdgcn_s_getreg((3 << 11) | 20) & 0xFu; }
#define XB_SPIN(cond, bar) do { unsigned _sp = 0; while (cond) { __builtin_amdgcn_s_sleep(1); \
    if ((++_sp & 255u) == 0u) { if (xb_ld(&(bar)[XB_TMO])) break; if (_sp > XB_SPIN_CAP) { atomicAdd(&(bar)[XB_TMO], 1u); break; } } } } while (0)

struct XcdBarrier {
    unsigned* bar; unsigned x;
    volatile LAS unsigned* st;
};

__device__ __forceinline__ XcdBarrier xcd_barrier_post(unsigned* bar, volatile LAS unsigned* st) {
    XcdBarrier b; b.bar = bar; b.x = xb_xcc_id(); b.st = st;
    if (threadIdx.x == 0) (void)xb_add(&bar[XB_XCNT(b.x)], 1u);
    return b;
}
__device__ __forceinline__ void xcd_barrier_complete(unsigned* bar, unsigned x, unsigned& nloc, unsigned& nx) {
    const unsigned G = gridDim.x * gridDim.y * gridDim.z;
    unsigned sum, cnt, mine, sp = 0u;
    for (;;) {
        sum = 0u; cnt = 0u; mine = 0u;
#pragma unroll
        for (unsigned j = 0; j < 16; ++j) { const unsigned c = xb_ld(&bar[XB_XCNT(j)]); sum += c; cnt += (c > 0u) ? 1u : 0u; mine = (j == x) ? c : mine; }
        if (sum == G) break;
        __builtin_amdgcn_s_sleep(1);
        if ((++sp & 255u) == 0u) { if (xb_ld(&bar[XB_TMO])) break; if (sp > XB_SPIN_CAP) { atomicAdd(&bar[XB_TMO], 1u); break; } }
    }
    nloc = mine > 0u ? mine : 1u; nx = cnt > 0u ? cnt : 1u;
}

__device__ __forceinline__ void xcd_barrier(const XcdBarrier& b) {
    asm volatile("s_waitcnt vmcnt(0)" ::: "memory");
    __syncthreads();
    if (threadIdx.x == 0) {
        unsigned* bar = b.bar;
        __builtin_amdgcn_s_waitcnt(0);
        unsigned nloc = b.st[0], nx = b.st[1];
        if (nloc == 0u) { xcd_barrier_complete(bar, b.x, nloc, nx); b.st[0] = nloc; b.st[1] = nx; }
        const unsigned old = xb_add(&bar[XB_XSUB(b.x)], 1u);
        const unsigned gen = old / nloc;
        if (old + 1u == (gen + 1u) * nloc) {
            __builtin_amdgcn_fence(__ATOMIC_RELEASE, "agent");
            asm volatile("s_waitcnt vmcnt(0)" ::: "memory");
            const unsigned og = xb_add(&bar[XB_TOP], 1u);
            const unsigned tg = og / nx;
            if (og + 1u == (tg + 1u) * nx) xb_add(&bar[XB_TOPGEN], 1u);
            else XB_SPIN(xb_ld(&bar[XB_TOPGEN]) == tg, bar);
            __builtin_amdgcn_fence(__ATOMIC_ACQUIRE, "agent");
            xb_add(&bar[XB_XGEN(b.x)], 1u);
            asm volatile("s_waitcnt vmcnt(0)" ::: "memory");
        } else {
            XB_SPIN(xb_ld(&bar[XB_XGEN(b.x)]) == gen, bar);
            __builtin_amdgcn_fence(__ATOMIC_ACQUIRE, "agent");
            asm volatile("s_waitcnt vmcnt(0)" ::: "memory");
        }
    }
    __syncthreads();
}
namespace pg8 {
#define PG8_LAS __attribute__((address_space(3)))
constexpr int BM = 256, BK = 64, HALF = 128, HTB = HALF * BK * 2  , STAGE_BYTES = 8 * HTB, NXCD = 8, WGM = 8;

__host__ __device__ __forceinline__ int lds_byte(int r, int c) { const int st = (r >> 4) * 2 + (c >> 5), rr = r & 15, cc = c & 31, ob = rr * 64 + cc * 2; return st * 1024 + (ob ^ (((ob >> 9) & 1) << 5)); }
__host__ __device__ __forceinline__ void stage_rc(int b, int& R, int& C) { const int st = b / 1024, sb = b % 1024, swz = sb ^ (((sb >> 9) & 1) << 5); R = (st >> 1) * 16 + swz / 64; C = (st & 1) * 32 + (swz % 64) / 2; }
__host__ __device__ __forceinline__ int perm32(int rho) { const int n = rho >> 4, i = rho & 15; return 8 * (i >> 2) + 4 * n + (i & 3); }

struct Unit { int pm, pn; };
struct Gemm { const bf16_t* A; const bf16_t* Bt; int M, N, K; };

struct StaticOrder {
    int nM, nN, nwg, G, c;
    __host__ __device__ void init(int M, int N, int G_, int c_) { nM = M / BM; nN = N / BM; nwg = nM * nN; G = G_; c = c_; }
    __host__ __device__ bool next(int i, Unit& u) const {
        const long L = (long)i * G + c; if (L >= nwg) return false;
        int wgid = (int)L; { const int q = nwg / NXCD, r = nwg % NXCD, xcd = wgid % NXCD, off = wgid / NXCD; wgid = (xcd < r ? xcd * (q + 1) : r * (q + 1) + (xcd - r) * q) + off; }
        const int nig = WGM * nN, gid = wgid / nig, fm = gid * WGM, gsz = (nM - fm) < WGM ? (nM - fm) : WGM;
        u.pm = fm + ((wgid % nig) % gsz); u.pn = (wgid % nig) / gsz; return true;
    }
    __device__ __forceinline__ void a_ready(const Unit&) const {}
    __device__ __forceinline__ void done(const Unit&) const {}
};
template <class Epi, class Sched>
__device__ __forceinline__ void gemm_phase(PG8_LAS unsigned char* lds, const Gemm g, const Sched& S, const Epi& E) {
    const int tid = opaque_tid(), wid = __builtin_amdgcn_readfirstlane(tid >> 6), lane = tid & 63, wr = wid >> 2, wc = wid & 3, fr = lane & 15, fq = lane >> 4;
    const int K = g.K, nt = K / BK;
    unsigned voffA[2], voffB[2];
#pragma unroll
    for (int i = 0; i < 2; ++i) { int R, C; stage_rc(tid * 16 + i * 8192, R, C); const int Rb = Epi::PERM ? ((R & ~31) + perm32(R & 31)) : R;
        voffA[i] = (unsigned)(R * K + C) * 2u; voffB[i] = (unsigned)(Rb * K + C) * 2u; }
    const size_t kstep = (size_t)(BK * 2);
    const size_t hstep = (size_t)HALF * K * 2;
    const size_t tstep = 2 * hstep;
    const unsigned ldsw = (unsigned)wid * 1024u;
    const int aoff = lds_byte(wr * 64 + fr, fq * 8), boff = lds_byte(wc * 32 + fr, fq * 8);
#define PG8_SA(b, h) (((b) * 2 + (h)) * HTB)
#define PG8_SB(b, h) ((4 + (b) * 2 + (h)) * HTB)
#define PG8_STAGE(bufoff, gbase, voff) do { _Pragma("unroll") for (int _i = 0; _i < 2; ++_i) \
        __builtin_amdgcn_global_load_lds((const unsigned*)((const char*)(gbase) + (voff)[_i]), (PG8_LAS unsigned*)(lds + (bufoff) + ldsw + _i * 8192), 16, 0, 0); } while (0)
#define PG8_LDA(dst, b, h) do { _Pragma("unroll") for (int m = 0; m < 4; ++m) _Pragma("unroll") for (int k = 0; k < 2; ++k) dst[m][k] = *(const PG8_LAS bf16x8*)(lds + PG8_SA(b, h) + aoff + m * 2048 + k * 1024); } while (0)
#define PG8_LDB(dst, b, h) do { _Pragma("unroll") for (int n = 0; n < 2; ++n) _Pragma("unroll") for (int k = 0; k < 2; ++k) dst[n][k] = *(const PG8_LAS bf16x8*)(lds + PG8_SB(b, h) + boff + n * 2048 + k * 1024); } while (0)
#define PG8_MMA(ai, bj, At, Bt) do { __builtin_amdgcn_s_setprio(1); _Pragma("unroll") for (int m = 0; m < 4; ++m) _Pragma("unroll") for (int n = 0; n < 2; ++n) _Pragma("unroll") for (int k = 0; k < 2; ++k) \
        acc[ai][bj][m][n] = __builtin_amdgcn_mfma_f32_16x16x32_bf16(Bt[n][k], At[m][k], acc[ai][bj][m][n], 0, 0, 0); __builtin_amdgcn_s_setprio(0); } while (0)
#define PG8_WAIT_V(n) asm volatile("s_waitcnt vmcnt(" #n ")" ::: "memory")
#define PG8_WAIT_L(n) asm volatile("s_waitcnt lgkmcnt(" #n ")" ::: "memory")
#define PG8_BAR __builtin_amdgcn_s_barrier()
#define PG8_SCHED __builtin_amdgcn_sched_barrier(0)
    Unit cur, nxt; int ui = 0;
    if (!S.next(0, cur)) return;
    f32x4 acc[2][2][4][2];
#pragma unroll
    for (int a = 0; a < 2; ++a)
#pragma unroll
        for (int b = 0; b < 2; ++b)
#pragma unroll
            for (int m = 0; m < 4; ++m)
#pragma unroll
                for (int n = 0; n < 2; ++n) acc[a][b][m][n] = (f32x4){0.f, 0.f, 0.f, 0.f};
    bf16x8 At[4][2], B0[2][2], B1[2][2];
    const char* cA = (const char*)g.A + (size_t)cur.pm * tstep; const char* cB = (const char*)g.Bt + (size_t)cur.pn * tstep;
    S.a_ready(cur);
    PG8_STAGE(PG8_SB(0, 0), cB, voffB); PG8_STAGE(PG8_SA(0, 0), cA, voffA); PG8_STAGE(PG8_SB(0, 1), cB + hstep, voffB); PG8_STAGE(PG8_SA(0, 1), cA + hstep, voffA);
    if (wr == 1) PG8_BAR;
    PG8_WAIT_V(4); PG8_BAR;
    PG8_STAGE(PG8_SB(1, 0), cB + kstep, voffB); PG8_STAGE(PG8_SA(1, 0), cA + kstep, voffA); PG8_STAGE(PG8_SB(1, 1), cB + hstep + kstep, voffB);
    PG8_WAIT_V(6); PG8_BAR;
    for (;;) {
        const bool has_next = S.next(ui + 1, nxt);
        const char* nA = has_next ? (const char*)g.A + (size_t)nxt.pm * tstep : cA; const char* nB = has_next ? (const char*)g.Bt + (size_t)nxt.pn * tstep : cB;
        for (int t = 0; t < nt; t += 2) {
            const bool last = (t == nt - 2);
            const char* a1 = cA + (size_t)(t + 1) * kstep;
            const char* a2 = last ? nA : cA + (size_t)(t + 2) * kstep; const char* b2 = last ? nB : cB + (size_t)(t + 2) * kstep;
            const char* a3 = a2 + kstep; const char* b3 = b2 + kstep;
            if (last && has_next) S.a_ready(nxt);
            PG8_LDB(B0, 0, 0); PG8_SCHED; PG8_LDA(At, 0, 0); PG8_STAGE(PG8_SA(1, 1), a1 + hstep, voffA);
            PG8_WAIT_L(8); PG8_BAR; PG8_WAIT_L(0); PG8_MMA(0, 0, At, B0); PG8_BAR; PG8_SCHED;
            PG8_LDB(B1, 0, 1); PG8_STAGE(PG8_SB(0, 0), b2, voffB);
            PG8_BAR; PG8_WAIT_L(0); PG8_MMA(0, 1, At, B1); PG8_BAR;
            PG8_LDA(At, 0, 1); PG8_STAGE(PG8_SA(0, 0), a2, voffA);
            PG8_BAR; PG8_WAIT_L(0); PG8_MMA(1, 0, At, B0); PG8_BAR; PG8_SCHED;
            PG8_STAGE(PG8_SB(0, 1), b2 + hstep, voffB);
            PG8_WAIT_V(6); PG8_BAR; PG8_MMA(1, 1, At, B1); PG8_BAR;
            PG8_LDB(B0, 1, 0); PG8_SCHED; PG8_LDA(At, 1, 0); PG8_STAGE(PG8_SA(0, 1), a2 + hstep, voffA);
            PG8_WAIT_L(8); PG8_BAR; PG8_WAIT_L(0); PG8_MMA(0, 0, At, B0); PG8_BAR; PG8_SCHED;
            PG8_LDB(B1, 1, 1); PG8_STAGE(PG8_SB(1, 0), b3, voffB);
            PG8_BAR; PG8_WAIT_L(0); PG8_MMA(0, 1, At, B1); PG8_BAR;
            PG8_LDA(At, 1, 1); PG8_STAGE(PG8_SA(1, 0), a3, voffA);
            PG8_BAR; PG8_WAIT_L(0); PG8_MMA(1, 0, At, B0); PG8_BAR; PG8_SCHED;
            PG8_STAGE(PG8_SB(1, 1), b3 + hstep, voffB);
            PG8_WAIT_V(6); PG8_BAR; PG8_MMA(1, 1, At, B1); PG8_BAR;
        }
        E(acc, cur, wr, wc, fr, fq); S.done(cur);
        if (!has_next) break;
#pragma unroll
        for (int a = 0; a < 2; ++a)
#pragma unroll
            for (int b = 0; b < 2; ++b)
#pragma unroll
                for (int m = 0; m < 4; ++m)
#pragma unroll
                    for (int n = 0; n < 2; ++n) acc[a][b][m][n] = (f32x4){0.f, 0.f, 0.f, 0.f};
        cur = nxt; cA = nA; cB = nB; ++ui;
    }
    PG8_WAIT_V(0);
    if (wr == 0) PG8_BAR;
    PG8_BAR;
#undef PG8_SA
#undef PG8_SB
#undef PG8_STAGE
#undef PG8_LDA
#undef PG8_LDB
#undef PG8_MMA
#undef PG8_WAIT_V
#undef PG8_WAIT_L
#undef PG8_BAR
#undef PG8_SCHED
}
struct EpiF32 {
    static constexpr bool PERM = false;
    float* C; int ldc;
    __device__ __forceinline__ void operator()(const f32x4 (&acc)[2][2][4][2], const Unit& u, int wr, int wc, int fr, int fq) const {
        const int row0 = u.pm * BM + wr * 64 + fr, col0 = u.pn * BM + wc * 32 + 4 * fq;
#pragma unroll
        for (int ai = 0; ai < 2; ++ai)
#pragma unroll
            for (int m = 0; m < 4; ++m) { float* rowp = C + (size_t)(row0 + ai * HALF + m * 16) * ldc + col0;
#pragma unroll
                for (int bj = 0; bj < 2; ++bj)
#pragma unroll
                    for (int n = 0; n < 2; ++n) *(f32x4*)(rowp + bj * HALF + n * 16) = acc[ai][bj][m][n]; }
    }
};
struct EpiBf16P {
    static constexpr bool PERM = true;
    bf16_t* O; int ldc;
    __device__ __forceinline__ void operator()(const f32x4 (&acc)[2][2][4][2], const Unit& u, int wr, int wc, int fr, int fq) const {
        const int row0 = u.pm * BM + wr * 64 + fr, col0 = u.pn * BM + wc * 32 + 8 * fq;
#pragma unroll
        for (int ai = 0; ai < 2; ++ai)
#pragma unroll
            for (int m = 0; m < 4; ++m) { bf16_t* rowp = O + (size_t)(row0 + ai * HALF + m * 16) * ldc + col0;
#pragma unroll
                for (int bj = 0; bj < 2; ++bj) { const f32x4 v0 = acc[ai][bj][m][0], v1 = acc[ai][bj][m][1];
                    u32x4 w; w.x = cvt_pk_bf16(v0[0], v0[1]); w.y = cvt_pk_bf16(v0[2], v0[3]); w.z = cvt_pk_bf16(v1[0], v1[1]); w.w = cvt_pk_bf16(v1[2], v1[3]);
                    *(u32x4*)(rowp + bj * HALF) = w; } }
    }
};
struct EpiHgrn {
    static constexpr bool PERM = true;
    bf16_t* planes; size_t plane_elems; const float* lb;
    __device__ __forceinline__ void operator()(const f32x4 (&acc)[2][2][4][2], const Unit& u, int wr, int wc, int fr, int fq) const {
        const int plane = u.pn >> 2;
        const int row0 = u.pm * BM + wr * 64 + fr, col0 = (u.pn & 3) * BM + wc * 32 + 8 * fq;
        bf16_t* base = planes + (size_t)plane * plane_elems;
        float lbv[2][8];
        if (plane == 1 || plane == 2) {
#pragma unroll
            for (int bj = 0; bj < 2; ++bj)
#pragma unroll
                for (int e = 0; e < 8; ++e) lbv[bj][e] = lb[(plane - 1) * 1024 + col0 + bj * HALF + e];
        } else {
#pragma unroll
            for (int bj = 0; bj < 2; ++bj)
#pragma unroll
                for (int e = 0; e < 8; ++e) lbv[bj][e] = 0.f;
        }
#pragma unroll
        for (int ai = 0; ai < 2; ++ai)
#pragma unroll
            for (int m = 0; m < 4; ++m) { bf16_t* rowp = base + (size_t)(row0 + ai * HALF + m * 16) * 1024 + col0;
#pragma unroll
                for (int bj = 0; bj < 2; ++bj) { float v[8];
#pragma unroll
                    for (int e = 0; e < 4; ++e) { v[e] = acc[ai][bj][m][0][e]; v[4 + e] = acc[ai][bj][m][1][e]; }
                    if (plane == 0 || plane == 4) {
#pragma unroll
                        for (int e = 0; e < 8; ++e) v[e] = siluf_(v[e]);
                    } else if (plane == 1 || plane == 2) {
#pragma unroll
                        for (int e = 0; e < 8; ++e) { const float l = lbv[bj][e]; const float f = l + (1.0f - l) * sigmoidf_(v[e]); v[e] = fast_log(fmaxf(f, 1e-30f)); }
                    }
                    u32x4 w; w.x = cvt_pk_bf16(v[0], v[1]); w.y = cvt_pk_bf16(v[2], v[3]); w.z = cvt_pk_bf16(v[4], v[5]); w.w = cvt_pk_bf16(v[6], v[7]);
                    *(u32x4*)(rowp + bj * HALF) = w; } }
    }
};
struct EpiPle {
    static constexpr bool PERM = false;
    float* X; const bf16_t* PP; const float* bias; bf16_t* XbOut;
    __device__ __forceinline__ void operator()(const f32x4 (&acc)[2][2][4][2], const Unit& u, int wr, int wc, int fr, int fq) const {
        const int row0 = u.pm * BM + wr * 64 + fr, col0 = u.pn * BM + wc * 32 + 4 * fq;
        f32x4 bv[2][2];
#pragma unroll
        for (int bj = 0; bj < 2; ++bj)
#pragma unroll
            for (int n = 0; n < 2; ++n) bv[bj][n] = *(const f32x4*)(bias + col0 + bj * HALF + n * 16);
#pragma unroll
        for (int ai = 0; ai < 2; ++ai)
#pragma unroll
            for (int m = 0; m < 4; ++m) { const size_t off = (size_t)(row0 + ai * HALF + m * 16) * 1024 + col0;
#pragma unroll
                for (int bj = 0; bj < 2; ++bj)
#pragma unroll
                    for (int n = 0; n < 2; ++n) { const size_t o2 = off + bj * HALF + n * 16;
                        const f32x4 x = *(const f32x4*)(X + o2); const u32x2 pw = *(const u32x2*)(PP + o2); const f32x4 z = acc[ai][bj][m][n] + bv[bj][n];
                        f32x4 o; o[0] = x[0] + sigmoidf_(z[0]) * bflo(pw.x); o[1] = x[1] + sigmoidf_(z[1]) * bfhi(pw.x); o[2] = x[2] + sigmoidf_(z[2]) * bflo(pw.y); o[3] = x[3] + sigmoidf_(z[3]) * bfhi(pw.y);
                        *(f32x4*)(X + o2) = o; u32x2 w; w.x = cvt_pk_bf16(o[0], o[1]); w.y = cvt_pk_bf16(o[2], o[3]); *(u32x2*)(XbOut + o2) = w; }
                asm volatile("" ::: "memory"); }
    }
};
}
namespace attn {
constexpr int DV = 128, DQK = 192, NW = 8, QBLK = 32, KVBLK = 64;
constexpr float SCALE = MLA_SCALE;
constexpr float THR = 8.f;
constexpr int LDQ = 8 * DQK, LDKV = 8 * 256, LDKR = 64, LDO = 1024;
constexpr int KROWB = 400;
constexpr int SHM_V = KVBLK * DV * 2, SHM_K = KVBLK * KROWB, SHM_ATTN = 2 * SHM_V + 2 * SHM_K + NW * 64 * 4;
#define SBAR() __builtin_amdgcn_sched_barrier(0)
__device__ __forceinline__ int crow(int r, int hi) { return (r & 3) + 8 * (r >> 2) + 4 * hi; }

__device__ __forceinline__ void partialSM(f32x16& p0, f32x16& p1, float& m_reg, float& mn, float& alpha) {
  constexpr float C = SCALE * 1.4426950408889634f;
  float pmax = p0[0];
#pragma unroll
  for (int r = 1; r < 16; ++r) pmax = fmaxf(pmax, p0[r]);
#pragma unroll
  for (int r = 0; r < 16; ++r) pmax = fmaxf(pmax, p1[r]);
  { auto rr = __builtin_amdgcn_permlane32_swap(__float_as_uint(pmax), __float_as_uint(pmax), false, false);
    pmax = fmaxf(__uint_as_float(rr[0]), __uint_as_float(rr[1])); }
  if (__builtin_expect(__all(pmax - m_reg <= THR / SCALE), 1)) { mn = m_reg; alpha = 1.f; }
  else { mn = fmaxf(m_reg, pmax); alpha = __builtin_amdgcn_exp2f((m_reg - mn) * C); m_reg = mn; }
  float mnC = -mn * C;
#pragma unroll
  for (int r = 0; r < 16; ++r) p0[r] = fmaf(p0[r], C, mnC);
#pragma unroll
  for (int r = 0; r < 16; ++r) p1[r] = fmaf(p1[r], C, mnC);
#pragma unroll
  for (int r = 0; r < 16; ++r) p0[r] = __builtin_amdgcn_exp2f(p0[r]);
}
__device__ __forceinline__ void finishSM(f32x16& p0, f32x16& p1, float alpha, float& l_reg, bf16x8& pa0, bf16x8& pa1, bf16x8& pa2, bf16x8& pa3) {
#pragma unroll
  for (int r = 0; r < 16; ++r) p1[r] = __builtin_amdgcn_exp2f(p1[r]);
  float ps = 0;
#pragma unroll
  for (int r = 0; r < 16; ++r) ps += p0[r];
#pragma unroll
  for (int r = 0; r < 16; ++r) ps += p1[r];
  { auto rr = __builtin_amdgcn_permlane32_swap(__float_as_uint(ps), __float_as_uint(ps), false, false);
    ps = __uint_as_float(rr[0]) + __uint_as_float(rr[1]); }
  l_reg = l_reg * alpha + ps;
#define PK4(P, BASE, OUT) do { unsigned a0 = cvt_pk_bf16(P[BASE + 0], P[BASE + 1]), a1 = cvt_pk_bf16(P[BASE + 2], P[BASE + 3]);   \
    unsigned b0 = cvt_pk_bf16(P[BASE + 4], P[BASE + 5]), b1 = cvt_pk_bf16(P[BASE + 6], P[BASE + 7]);                              \
    auto r0 = __builtin_amdgcn_permlane32_swap(a0, b0, false, false); auto r1 = __builtin_amdgcn_permlane32_swap(a1, b1, false, false); \
    u32x4 w = {r0[0], r1[0], r0[1], r1[1]}; OUT = *reinterpret_cast<bf16x8*>(&w); } while (0)
  PK4(p0, 0, pa0); PK4(p0, 8, pa1); PK4(p1, 0, pa2); PK4(p1, 8, pa3);
#undef PK4
}
__device__ __forceinline__ void qkt(f32x16& p0, f32x16& p1, const char* Ks, const bf16x8* qr, int r32, int hi) {
  p0 = f32x16{}; p1 = f32x16{};
#pragma unroll
  for (int d0 = 0; d0 < 12; ++d0) { const int cb = (d0 * 16 + hi * 8) * 2;
    bf16x8 b0 = *reinterpret_cast<const bf16x8*>(Ks + r32 * KROWB + cb);
    bf16x8 b1 = *reinterpret_cast<const bf16x8*>(Ks + (32 + r32) * KROWB + cb);
    p0 = __builtin_amdgcn_mfma_f32_32x32x16_bf16(b0, qr[d0], p0, 0, 0, 0);
    p1 = __builtin_amdgcn_mfma_f32_32x32x16_bf16(b1, qr[d0], p1, 0, 0, 0);
    if ((d0 & 3) == 3) SBAR(); }
}
__device__ __forceinline__ int v_st(int k, int c) { const int kk = (k & ~0xC) | ((k & 4) << 1) | ((k & 8) >> 1); return ((kk >> 3) * 4 + (c >> 5)) * 512 + ((kk & 7) * 32 + (c & 31)) * 2; }
__device__ __forceinline__ int v_rd_base(int lane) { return ((lane & 3) << 3) | (((lane >> 2) & 3) << 6) | (((lane >> 4) & 1) << 5) | (((lane >> 5) & 1) << 8); }
constexpr int v_rd_off(int d0, int ks, int half) { return d0 * 512 + ks * 4096 + half * 2048; }
template <int OFF> __device__ __forceinline__ s16x4 tr_read(int vb) {
  s16x4 r; asm volatile("ds_read_b64_tr_b16 %0, %1 offset:%2" : "=&v"(r) : "v"(vb), "i"(OFF) : "memory"); return r;
}
template <int D0> __device__ __forceinline__ void pv_one(f32x16& od, int vb, bf16x8 pa0, bf16x8 pa1, bf16x8 pa2, bf16x8 pa3) {
  const s16x4 l0 = tr_read<v_rd_off(D0, 0, 0)>(vb), h0 = tr_read<v_rd_off(D0, 0, 1)>(vb), l1 = tr_read<v_rd_off(D0, 1, 0)>(vb), h1 = tr_read<v_rd_off(D0, 1, 1)>(vb);
  const s16x4 l2 = tr_read<v_rd_off(D0, 2, 0)>(vb), h2 = tr_read<v_rd_off(D0, 2, 1)>(vb), l3 = tr_read<v_rd_off(D0, 3, 0)>(vb), h3 = tr_read<v_rd_off(D0, 3, 1)>(vb);
  asm volatile("s_waitcnt lgkmcnt(0)" ::: "memory"); SBAR();
#define PK(L, H) (bf16x8){L[0], L[1], L[2], L[3], H[0], H[1], H[2], H[3]}
  od = __builtin_amdgcn_mfma_f32_32x32x16_bf16(pa0, PK(l0, h0), od, 0, 0, 0);
  od = __builtin_amdgcn_mfma_f32_32x32x16_bf16(pa1, PK(l1, h1), od, 0, 0, 0);
  od = __builtin_amdgcn_mfma_f32_32x32x16_bf16(pa2, PK(l2, h2), od, 0, 0, 0);
  od = __builtin_amdgcn_mfma_f32_32x32x16_bf16(pa3, PK(l3, h3), od, 0, 0, 0);
#undef PK
}
__device__ __forceinline__ void pv_d0(f32x16* o, int vb, bf16x8 pa0, bf16x8 pa1, bf16x8 pa2, bf16x8 pa3) {
  pv_one<0>(o[0], vb, pa0, pa1, pa2, pa3); pv_one<1>(o[1], vb, pa0, pa1, pa2, pa3); pv_one<2>(o[2], vb, pa0, pa1, pa2, pa3); pv_one<3>(o[3], vb, pa0, pa1, pa2, pa3);
}

__device__ __forceinline__ void attn_body(const bf16_t* __restrict__ Qb, const bf16_t* __restrict__ Kn, const bf16_t* __restrict__ Kr,
                                          bf16_t* __restrict__ Ob, int seq, char* lds) {
  const int tid = opaque_tid(), wid = tid >> 6, lane = tid & 63, r32 = lane & 31, hi = lane >> 5;
  char* V_lds = lds; char* K_lds = lds + 2 * SHM_V;
  float* ws = (float*)(lds + 2 * SHM_V + 2 * SHM_K) + wid * 64; float* li_l = ws; float* al_l = ws + 32;
  float m_reg = -1e30f, l_reg = 0; f32x16 o[4] = {}; bf16x8 qr[12];
  const bf16_t* Qw = Qb + (long)(wid * QBLK + r32) * LDQ + hi * 8;
#pragma unroll
  for (int d0 = 0; d0 < 12; ++d0) qr[d0] = *reinterpret_cast<const bf16x8*>(Qw + d0 * 16);
  const bf16_t* Vh = Kn + 128;
  const int sr = tid >> 4, sc = (tid & 15) * 8, vst0 = v_st(sr, sc), vst1 = v_st(32 + sr, sc);
  int krow[3], kcc[3];
#pragma unroll
  for (int i = 0; i < 3; ++i) { const int id = tid + 512 * i; krow[i] = id / 24; kcc[i] = id % 24; }
  const int vb0 = (int)(uintptr_t)V_lds + v_rd_base(lane);
  bf16x8 vs0, vs1, ks0, ks1, ks2;
#define KSRC(i, k0) (kcc[i] < 16 ? (Kn + (long)((k0) + krow[i]) * LDKV + kcc[i] * 8) : (Kr + (long)((k0) + krow[i]) * LDKR + (kcc[i] - 16) * 8))
#define SLOAD(k0) do { vs0 = *reinterpret_cast<const bf16x8*>(&Vh[(long)((k0) + sr) * LDKV + sc]); vs1 = *reinterpret_cast<const bf16x8*>(&Vh[(long)((k0) + 32 + sr) * LDKV + sc]); \
    ks0 = *reinterpret_cast<const bf16x8*>(KSRC(0, k0)); ks1 = *reinterpret_cast<const bf16x8*>(KSRC(1, k0)); ks2 = *reinterpret_cast<const bf16x8*>(KSRC(2, k0)); } while (0)
#define SWRITE(b) do { *(bf16x8*)(V_lds + (b) * SHM_V + vst0) = vs0; *(bf16x8*)(V_lds + (b) * SHM_V + vst1) = vs1; \
    *(bf16x8*)(K_lds + (b) * SHM_K + krow[0] * KROWB + kcc[0] * 16) = ks0; *(bf16x8*)(K_lds + (b) * SHM_K + krow[1] * KROWB + kcc[1] * 16) = ks1; \
    *(bf16x8*)(K_lds + (b) * SHM_K + krow[2] * KROWB + kcc[2] * 16) = ks2; } while (0)
#define SWAIT() asm volatile("s_waitcnt vmcnt(0)" ::: "memory")
#define RESC(a) do { if (__any((a) < 1.f)) { if (hi == 0) al_l[r32] = (a); asm volatile("s_waitcnt lgkmcnt(0)" ::: "memory"); \
    _Pragma("unroll") for (int d = 0; d < 4; ++d) _Pragma("unroll") for (int r = 0; r < 16; ++r) o[d][r] *= al_l[crow(r, hi)]; } } while (0)
  f32x16 pA0, pA1; float mnA, alA; bf16x8 pa0, pa1, pa2, pa3; const int NT = seq / KVBLK;
  SLOAD(0); SWAIT(); SWRITE(0); __syncthreads();
  for (int j = 0; j < NT; ++j) {
    const int b = j & 1;
    if (j + 1 < NT) SLOAD((j + 1) * KVBLK);
    SBAR(); qkt(pA0, pA1, K_lds + b * SHM_K, qr, r32, hi);
    partialSM(pA0, pA1, m_reg, mnA, alA);
    RESC(alA);
    finishSM(pA0, pA1, alA, l_reg, pa0, pa1, pa2, pa3); SBAR();
    pv_d0(o, vb0 + b * (int)SHM_V, pa0, pa1, pa2, pa3);
    if (j + 1 < NT) { SWAIT(); SWRITE(b ^ 1); }
    __syncthreads();
  }
  if (hi == 0) li_l[r32] = l_reg; asm volatile("s_waitcnt lgkmcnt(0)" ::: "memory");
  float rli[16];
#pragma unroll
  for (int r = 0; r < 16; ++r) rli[r] = __builtin_amdgcn_rcpf(li_l[crow(r, hi)]);
  bf16_t* Ow = Ob + (long)(wid * QBLK) * LDO;
#pragma unroll
  for (int r = 0; r < 16; ++r) { const int orow = crow(r, hi);
#pragma unroll
    for (int d0 = 0; d0 < 4; ++d0) Ow[(long)orow * LDO + d0 * 32 + r32] = f2bf(o[d0][r] * rli[r]); }
#undef KSRC
#undef SLOAD
#undef SWRITE
#undef SWAIT
#undef RESC
}
#undef SBAR
}
typedef const __attribute__((address_space(4))) Args* KArgs;
struct Ctx {
    KArgs a; float* out; unsigned char* ws;
    LAS unsigned char* lds;
    int tid, lane, wave, vcu, G, gw, NGW, bid;
    __device__ __forceinline__ const float* in(int i) const { return a->in[i]; }
};
__device__ __forceinline__ Ctx mk_ctx(unsigned char* lds_raw) {
    Ctx c; KArgs a = (KArgs)__builtin_amdgcn_kernarg_segment_ptr(); asm volatile("" : "+s"(a));
    c.a = a; c.out = a->out; c.ws = a->ws; c.lds = (LAS unsigned char*)lds_raw;
    c.tid = opaque_tid(); c.lane = c.tid & 63; c.wave = __builtin_amdgcn_readfirstlane(c.tid >> 6);
    c.G = (int)gridDim.x; c.bid = opaque_bid(); c.vcu = (c.G % 8 == 0) ? (c.bid % 8) * (c.G / 8) + c.bid / 8 : c.bid;
    c.gw = c.vcu * NWAVES + c.wave; c.NGW = c.G * NWAVES;
    return c;
}
__device__ __forceinline__ int tok_pos(int t) { return t < TP ? (t & (SP - 1)) : ((t - TP) & (SS - 1)); }

__device__ __forceinline__ void transpose_item(const float* W, int K, int N, bf16_t* WT, LAS float* scr, int item, int lane) {
    const int nblk = N / 32, kb = item / nblk, nb = item % nblk, k0 = 64 * kb, n0 = 32 * nb;
#pragma unroll 8
    for (int i = 0; i < 32; ++i) { const int kk = 2 * i + (lane >> 5); scr[kk * 33 + (lane & 31)] = W[(size_t)(k0 + kk) * N + n0 + (lane & 31)]; }
    LDS_WAIT(); asm volatile("" ::: "memory");
    const int c = lane & 7;
#pragma unroll
    for (int j = 0; j < 4; ++j) { const int n = (lane >> 3) + 8 * j; const LAS float* s = scr + (8 * c) * 33 + n;
        u32x4 o; o.x = cvt_pk_bf16(s[0 * 33], s[1 * 33]); o.y = cvt_pk_bf16(s[2 * 33], s[3 * 33]); o.z = cvt_pk_bf16(s[4 * 33], s[5 * 33]); o.w = cvt_pk_bf16(s[6 * 33], s[7 * 33]);
        *(u32x4*)(WT + (size_t)(n0 + n) * K + k0 + 8 * c) = o; }
    LDS_WAIT(); asm volatile("" ::: "memory");
}
struct MatDesc { int in_idx, K, N, Npad, copies; size_t dst; };
__device__ __forceinline__ void p0_prologue(const Ctx& c) {
    LAS float* scr = (LAS float*)(c.lds + c.wave * 16384);
    const MatDesc MATS[9] = {
        {4, 1024, 704, 768, 2, W_WA}, {7, 384, 1536, 1536, 2, W_WUQ}, {8, 256, 2048, 2048, 2, W_WUKV}, {9, 1024, 1024, 1024, 2, W_WO},
        {10, 1024, 5120, 5120, 2, W_HIN}, {13, 1024, 1024, 1024, 2, W_HO}, {14, 1024, 2048, 2048, 4, W_PQ}, {22, 1024, 1024, 1024, 4, W_GW}, {24, 256, 1024, 1024, 4, W_PP}};
    int total = 0;
#pragma unroll
    for (int m = 0; m < 9; ++m) total += MATS[m].copies * (MATS[m].K / 64) * (MATS[m].N / 32);
    for (int it = c.gw; it < total; it += c.NGW) {
        int r = it;
#pragma unroll
        for (int m = 0; m < 9; ++m) {
            const int per = (MATS[m].K / 64) * (MATS[m].N / 32), cnt = MATS[m].copies * per;
            if (r >= 0 && r < cnt) { const int cp = r / per, item = r % per;
                transpose_item(c.in(MATS[m].in_idx) + (size_t)cp * MATS[m].K * MATS[m].N, MATS[m].K, MATS[m].N,
                               (bf16_t*)(c.ws + MATS[m].dst) + (size_t)cp * MATS[m].Npad * MATS[m].K, scr, item, c.lane);
                r = -1; }
            else if (r >= 0) r -= cnt;
        }
    }
    const int gt = c.gw * 64 + c.lane, NGT = c.NGW * 64;
    for (int i = gt; i < 2 * 64 * 1024 / 8; i += NGT) { const int cp = i / (64 * 1024 / 8), o = i % (64 * 1024 / 8);
        *(u32x4*)((bf16_t*)(c.ws + W_WA) + (size_t)cp * 768 * 1024 + (size_t)704 * 1024 + o * 8) = (u32x4){0u, 0u, 0u, 0u}; }
    for (int i = gt; i < 4 * 2 * 128 * 128 / 4; i += NGT) { const f32x4 v = *(const f32x4*)(c.in(15) + (size_t)i * 4);
        u32x2 w; w.x = cvt_pk_bf16(v[0], v[1]); w.y = cvt_pk_bf16(v[2], v[3]); *(u32x2*)((bf16_t*)(c.ws + W_KEYS) + (size_t)i * 4) = w; }
    for (int i = gt; i < 8192 * 32; i += NGT) { const int pos = i >> 5, f = i & 31;
        const float inv = 1.0f / powf(10000.0f, (float)(2 * f) / 64.0f); const float ang = (float)pos * inv;
        ((float*)(c.ws + WS_ROPE))[i] = cosf(ang); ((float*)(c.ws + WS_ROPE))[8192 * 32 + i] = sinf(ang); }
    for (int i = gt; i < 2 * 1024; i += NGT) { const int dir = i >> 10, k = i & 1023;
        const float l0 = c.in(11)[(dir * 2 + 0) * 1024 + k], l1 = c.in(11)[(dir * 2 + 1) * 1024 + k];
        float* lb = (float*)(c.ws + WS_MISC);
        lb[(0 * 2 + dir) * 1024 + k] = 0.f; lb[(1 * 2 + dir) * 1024 + k] = 1.0f / (1.0f + expf(l0 - l1)); }
    for (int t = c.gw; t < T; t += c.NGW) {
        const float* xr = t < TP ? c.in(0) + (size_t)t * D : c.in(1) + (size_t)(t - TP) * D;
        float* orow = c.out + (size_t)t * D; bf16_t* brow = (bf16_t*)(c.ws + WS_R2) + (size_t)t * D;
#pragma unroll
        for (int j = 0; j < 4; ++j) { const f32x4 v = *(const f32x4*)(xr + 256 * j + 4 * c.lane); *(f32x4*)(orow + 256 * j + 4 * c.lane) = v;
            u32x2 w; w.x = cvt_pk_bf16(v[0], v[1]); w.y = cvt_pk_bf16(v[2], v[3]); *(u32x2*)(brow + 256 * j + 4 * c.lane) = w; }
    }
}

__device__ __forceinline__ void cvt_range(const float* src, bf16_t* dst, size_t n8, int gt, int NGT) {
    for (size_t i = gt; i < n8; i += NGT) { const f32x4 a = *(const f32x4*)(src + i * 8), b = *(const f32x4*)(src + i * 8 + 4);
        u32x4 w; w.x = cvt_pk_bf16(a[0], a[1]); w.y = cvt_pk_bf16(a[2], a[3]); w.z = cvt_pk_bf16(b[0], b[1]); w.w = cvt_pk_bf16(b[2], b[3]); *(u32x4*)(dst + i * 8) = w; }
}
__device__ __forceinline__ void l0_convert(const Ctx& c, int layer) {
    const int gt = c.gw * 64 + c.lane, NGT = c.NGW * 64;
    cvt_range(c.in(16) + (size_t)layer * NEXP * D, (bf16_t*)(c.ws + R2_UB), (size_t)NEXP * D / 8, gt, NGT);
    cvt_range(c.in(17) + (size_t)layer * NEXP * D, (bf16_t*)(c.ws + R2_VB), (size_t)NEXP * D / 8, gt, NGT);
    cvt_range(c.in(2) + (size_t)layer * TP * 256, (bf16_t*)(c.ws + R2_PB), (size_t)TP * 256 / 8, gt, NGT);
    cvt_range(c.in(3) + (size_t)layer * TS * 256, (bf16_t*)(c.ws + R2_PB) + (size_t)TP * 256, (size_t)TS * 256 / 8, gt, NGT);
}

__device__ __forceinline__ void mla_e1(const Ctx& c, int j) {
    const float* a32 = (const float*)(c.ws + B_A32); bf16_t* cqn = (bf16_t*)(c.ws + B_CQN); bf16_t* ckvn = (bf16_t*)(c.ws + B_CKVN); bf16_t* krope = (bf16_t*)(c.ws + B_KROPE);
    const float* qnw = c.in(5) + j * 384; const float* kvnw = c.in(6) + j * 256;
    const float* cosT = (const float*)(c.ws + WS_ROPE); const float* sinT = cosT + 8192 * 32;
    LAS float* scr = (LAS float*)(c.lds + c.wave * 1024);
    const int lane = c.lane;
    for (int t = c.gw; t < T; t += c.NGW) {
        const float* ar = a32 + (size_t)t * 768;
        const f32x4 v0 = *(const f32x4*)(ar + 4 * lane), v1 = *(const f32x4*)(ar + 256 + 4 * lane), v2 = *(const f32x4*)(ar + 512 + 4 * lane);
        const float s0 = v0[0] * v0[0] + v0[1] * v0[1] + v0[2] * v0[2] + v0[3] * v0[3];
        const float s1 = v1[0] * v1[0] + v1[1] * v1[1] + v1[2] * v1[2] + v1[3] * v1[3];
        const float s2 = v2[0] * v2[0] + v2[1] * v2[1] + v2[2] * v2[2] + v2[3] * v2[3];
        const float ssq = wave_sum(s0 + (lane < 32 ? s1 : 0.f));
        const float sskv = wave_sum((lane >= 32 ? s1 : 0.f) + (lane < 32 ? s2 : 0.f));
        const float rq = 1.0f / sqrtf(ssq * (1.0f / 384.0f) + RMS_EPS), rkv = 1.0f / sqrtf(sskv * (1.0f / 256.0f) + RMS_EPS);
        { const f32x4 w = *(const f32x4*)(qnw + 4 * lane); u32x2 o; o.x = cvt_pk_bf16(v0[0] * rq * w[0], v0[1] * rq * w[1]); o.y = cvt_pk_bf16(v0[2] * rq * w[2], v0[3] * rq * w[3]);
          *(u32x2*)(cqn + (size_t)t * 384 + 4 * lane) = o; }
        if (lane < 32) { const f32x4 w = *(const f32x4*)(qnw + 256 + 4 * lane); u32x2 o; o.x = cvt_pk_bf16(v1[0] * rq * w[0], v1[1] * rq * w[1]); o.y = cvt_pk_bf16(v1[2] * rq * w[2], v1[3] * rq * w[3]);
          *(u32x2*)(cqn + (size_t)t * 384 + 256 + 4 * lane) = o; }
        else { const int ix = 4 * (lane - 32); const f32x4 w = *(const f32x4*)(kvnw + ix); u32x2 o; o.x = cvt_pk_bf16(v1[0] * rkv * w[0], v1[1] * rkv * w[1]); o.y = cvt_pk_bf16(v1[2] * rkv * w[2], v1[3] * rkv * w[3]);
          *(u32x2*)(ckvn + (size_t)t * 256 + ix) = o; }
        if (lane < 32) { const int ix = 128 + 4 * lane; const f32x4 w = *(const f32x4*)(kvnw + ix); u32x2 o; o.x = cvt_pk_bf16(v2[0] * rkv * w[0], v2[1] * rkv * w[1]); o.y = cvt_pk_bf16(v2[2] * rkv * w[2], v2[3] * rkv * w[3]);
          *(u32x2*)(ckvn + (size_t)t * 256 + ix) = o; }
        else if (lane < 48) { *(LAS f32x4*)(scr + 4 * (lane - 32)) = v2; }
        LDS_WAIT(); asm volatile("" ::: "memory");
        if (lane < 32) { const int pos = tok_pos(t); const float a = scr[lane], b = scr[lane + 32], cs = cosT[pos * 32 + lane], sn = sinT[pos * 32 + lane];
            krope[(size_t)t * 64 + lane] = f2bf(a * cs - b * sn); krope[(size_t)t * 64 + 32 + lane] = f2bf(b * cs + a * sn); }
        LDS_WAIT(); asm volatile("" ::: "memory");
    }
}
__device__ __forceinline__ void mla_qrope(const Ctx& c) {
    bf16_t* q = (bf16_t*)(c.ws + B_Q);
    const float* cosT = (const float*)(c.ws + WS_ROPE); const float* sinT = cosT + 8192 * 32;
    const int lane = c.lane, i = lane & 31;
    for (int t = c.gw; t < T; t += c.NGW) {
        const int pos = tok_pos(t); const float cs = cosT[pos * 32 + i], sn = sinT[pos * 32 + i];
#pragma unroll
        for (int k = 0; k < 4; ++k) { const int h = (lane >> 5) + 2 * k; bf16_t* p = q + (size_t)t * 1536 + h * 192 + 128 + i;
            const float a = bf2f(p[0]), b = bf2f(p[32]); p[0] = f2bf(a * cs - b * sn); p[32] = f2bf(b * cs + a * sn); }
    }
}
__device__ __forceinline__ void mla_attention(const Ctx& c) {
    const bf16_t* Q = (const bf16_t*)(c.ws + B_Q); const bf16_t* KV = (const bf16_t*)(c.ws + B_KV); const bf16_t* KR = (const bf16_t*)(c.ws + B_KROPE); bf16_t* O = (bf16_t*)(c.ws + B_O);
    const int NU = 512 + 2048;
    for (int u = c.bid; u < NU; u += c.G) {
        int tok0, qb, h, seq;
        if (u < 512) { const int round = u >> 8, cc = u & 255, bh = round * 8 + (cc & 7); tok0 = (bh >> 3) * SP; h = bh & 7; qb = cc >> 3; seq = SP; }
        else { const int us = u - 512, round = us >> 8, cc = us & 255, r = cc >> 3, bh = round * 32 + (cc & 7) * 4 + (r >> 3); tok0 = TP + (bh >> 3) * SS; h = bh & 7; qb = r & 7; seq = SS; }
        attn::attn_body(Q + (size_t)(tok0 + qb * 256) * 1536 + h * 192, KV + (size_t)tok0 * 2048 + h * 256, KR + (size_t)tok0 * 64,
                        O + (size_t)(tok0 + qb * 256) * 1024 + h * 128, seq, (char*)c.lds);
        __syncthreads();
    }
}
__device__ __forceinline__ void ln_residual(const Ctx& c, const float* h32, const float* g, const float* b) {
    bf16_t* xb = (bf16_t*)(c.ws + WS_XB); const int lane = c.lane;
    for (int t = c.gw; t < T; t += c.NGW) {
        float* xr = c.out + (size_t)t * D; const float* hr = h32 + (size_t)t * D;
        f32x4 v[4]; float s = 0.f;
#pragma unroll
        for (int j = 0; j < 4; ++j) { const f32x4 x = *(const f32x4*)(xr + 256 * j + 4 * lane), hh = *(const f32x4*)(hr + 256 * j + 4 * lane); v[j] = x * DN_ALPHA + hh; s += (v[j][0] + v[j][1]) + (v[j][2] + v[j][3]); }
        const float mean = wave_sum(s) * (1.0f / D); float s2 = 0.f;
#pragma unroll
        for (int j = 0; j < 4; ++j) { v[j] = v[j] - mean; s2 += (v[j][0] * v[j][0] + v[j][1] * v[j][1]) + (v[j][2] * v[j][2] + v[j][3] * v[j][3]); }
        const float rstd = 1.0f / sqrtf(wave_sum(s2) * (1.0f / D) + LN_EPS);
#pragma unroll
        for (int j = 0; j < 4; ++j) { const f32x4 gg = *(const f32x4*)(g + 256 * j + 4 * lane), bb = *(const f32x4*)(b + 256 * j + 4 * lane); const f32x4 o = v[j] * rstd * gg + bb;
            *(f32x4*)(xr + 256 * j + 4 * lane) = o; u32x2 w; w.x = cvt_pk_bf16(o[0], o[1]); w.y = cvt_pk_bf16(o[2], o[3]); *(u32x2*)(xb + (size_t)t * D + 256 * j + 4 * lane) = w; }
    }
}
__device__ __forceinline__ void hgrn_post(const Ctx& c, int j) {
    bf16_t* pl = (bf16_t*)(c.ws + B_PLANE); const size_t PE = (size_t)T * 1024;
    const bf16_t* of = pl + 1 * PE; const bf16_t* ob = pl + 2 * PE; const bf16_t* sg = pl + 4 * PE; bf16_t* on = pl;
    const float* nw = c.in(12) + j * 128; const int lane = c.lane;
    for (int t = c.gw; t < T; t += c.NGW) {
#pragma unroll
        for (int k = 0; k < 2; ++k) { const size_t off = (size_t)t * 1024 + 512 * k + 8 * lane;
            const u32x4 a = *(const u32x4*)(of + off), b = *(const u32x4*)(ob + off), g = *(const u32x4*)(sg + off);
            float o[8]; o[0] = bflo(a.x) + bflo(b.x); o[1] = bfhi(a.x) + bfhi(b.x); o[2] = bflo(a.y) + bflo(b.y); o[3] = bfhi(a.y) + bfhi(b.y);
            o[4] = bflo(a.z) + bflo(b.z); o[5] = bfhi(a.z) + bfhi(b.z); o[6] = bflo(a.w) + bflo(b.w); o[7] = bfhi(a.w) + bfhi(b.w);
            float ss = 0.f;
#pragma unroll
            for (int e = 0; e < 8; ++e) ss += o[e] * o[e];
            ss += __shfl_xor(ss, 1); ss += __shfl_xor(ss, 2); ss += __shfl_xor(ss, 4); ss += __shfl_xor(ss, 8);
            const float r = 1.0f / sqrtf(ss * (1.0f / 128.0f) + RMS_EPS);
            const int cw = (8 * lane) & 127; const f32x4 w0 = *(const f32x4*)(nw + cw), w1 = *(const f32x4*)(nw + cw + 4);
            float gg[8]; gg[0] = bflo(g.x); gg[1] = bfhi(g.x); gg[2] = bflo(g.y); gg[3] = bfhi(g.y); gg[4] = bflo(g.z); gg[5] = bfhi(g.z); gg[6] = bflo(g.w); gg[7] = bfhi(g.w);
            u32x4 w; w.x = cvt_pk_bf16(o[0] * r * w0[0] * gg[0], o[1] * r * w0[1] * gg[1]); w.y = cvt_pk_bf16(o[2] * r * w0[2] * gg[2], o[3] * r * w0[3] * gg[3]);
            w.z = cvt_pk_bf16(o[4] * r * w1[0] * gg[4], o[5] * r * w1[1] * gg[5]); w.w = cvt_pk_bf16(o[6] * r * w1[2] * gg[6], o[7] * r * w1[3] * gg[7]);
            *(u32x4*)(on + off) = w; }
    }
}
namespace scan {
constexpr int QT_OFF = 0, KT_OFF = 8704, KHT_OFF = 17408, VT_OFF = 27648, P_OFF = 37888, ST_OFF = 40448, DV_OFF = 75264, TOT_OFF = 75776, CHAIN_BYTES = 76800;
constexpr int RS = 272, RS2 = 80;
__device__ __forceinline__ int crow(int r, int hi) { return (r & 3) + 8 * (r >> 2) + 4 * hi; }

__device__ __forceinline__ void run_pair(const Ctx& c, int tok0, int L, int h) {
    bf16_t* pl = (bf16_t*)(c.ws + B_PLANE); const size_t PE = (size_t)T * 1024;
    const int tid = c.tid, lane = c.lane, wave = c.wave, ch = wave >> 2, w = wave & 3, r32 = lane & 31, hi = lane >> 5;
    const bf16_t* qs = pl; bf16_t* lf = pl + (size_t)(1 + ch) * PE; const bf16_t* vv = pl + 3 * PE;
    LAS unsigned char* base = c.lds + ch * CHAIN_BYTES;
    const int ctid = tid & 255, k = ctid & 127, th = ctid >> 7, tau0 = 16 * th;
    const int NC = L / 32;
    const int vcol = 32 * w + r32;
    { LAS u32x4* st = (LAS u32x4*)(base + ST_OFF + (32 * w) * RS); for (int i = lane; i < 32 * RS / 16; i += 64) st[i] = (u32x4){0u, 0u, 0u, 0u}; }
    f32x16 S[4];
#pragma unroll
    for (int kt = 0; kt < 4; ++kt) S[kt] = f32x16{};
    __syncthreads();
    for (int ci = 0; ci < NC; ++ci) {
        float lfv[16], qv[16], vvv[16];
#pragma unroll
        for (int i = 0; i < 16; ++i) { const int tau = tau0 + i; const int t = ch ? (tok0 + L - 1 - 32 * ci - tau) : (tok0 + 32 * ci + tau); const size_t off = (size_t)t * 1024 + h * 128 + k;
            lfv[i] = bf2f(lf[off]); qv[i] = bf2f(qs[off]); vvv[i] = bf2f(vv[off]); }
        float bl[16]; { float run = 0.f;
#pragma unroll
            for (int i = 0; i < 16; ++i) { run += lfv[i]; bl[i] = run; } }
        LAS float* tot = (LAS float*)(base + TOT_OFF);
        tot[th * 128 + k] = bl[15];
        __syncthreads();
        { const float t0 = tot[k], t1 = tot[128 + k]; const float off = th ? t0 : 0.f, blast = t0 + t1;
          unsigned khp[8], vtp[8];
          float khv[16];
#pragma unroll
          for (int i = 0; i < 16; ++i) { const float bt = bl[i] + off; const float E = fast_exp(bt), Ei = fast_exp(fminf(-bt, 80.f)); const float kk = 1.0f - fast_exp(lfv[i]);
              *(LAS bf16_t*)(base + QT_OFF + (tau0 + i) * RS + k * 2) = f2bf(qv[i] * E);
              *(LAS bf16_t*)(base + KT_OFF + (tau0 + i) * RS + k * 2) = f2bf(kk * Ei);
              khv[i] = kk * fast_exp(blast - bt); }
#pragma unroll
          for (int i = 0; i < 8; ++i) { khp[i] = cvt_pk_bf16(khv[2 * i], khv[2 * i + 1]); vtp[i] = cvt_pk_bf16(vvv[2 * i], vvv[2 * i + 1]); }
          *(LAS u32x4*)(base + KHT_OFF + k * RS2 + tau0 * 2) = (u32x4){khp[0], khp[1], khp[2], khp[3]};
          *(LAS u32x4*)(base + KHT_OFF + k * RS2 + tau0 * 2 + 16) = (u32x4){khp[4], khp[5], khp[6], khp[7]};
          *(LAS u32x4*)(base + VT_OFF + k * RS2 + tau0 * 2) = (u32x4){vtp[0], vtp[1], vtp[2], vtp[3]};
          *(LAS u32x4*)(base + VT_OFF + k * RS2 + tau0 * 2 + 16) = (u32x4){vtp[4], vtp[5], vtp[6], vtp[7]};
          if (th == 0) *(LAS float*)(base + DV_OFF + k * 4) = fast_exp(blast);
        }
        __syncthreads();
        bf16x8 qa[8];
        f32x16 X = f32x16{};
#pragma unroll
        for (int ks = 0; ks < 8; ++ks) { qa[ks] = *(const LAS bf16x8*)(base + QT_OFF + r32 * RS + (16 * ks + 8 * hi) * 2);
            const bf16x8 kb = *(const LAS bf16x8*)(base + KT_OFF + r32 * RS + (16 * ks + 8 * hi) * 2);
            X = __builtin_amdgcn_mfma_f32_32x32x16_bf16(qa[ks], kb, X, 0, 0, 0); }
        if (w == 0) {
#pragma unroll
        for (int r = 0; r < 16; ++r) { const int t = crow(r, hi); *(LAS bf16_t*)(base + P_OFF + t * RS2 + r32 * 2) = f2bf(t >= r32 ? X[r] : 0.f); }
        }
        __syncthreads();
        bf16x8 vb[2];
        f32x16 O = f32x16{};
#pragma unroll
        for (int ks = 0; ks < 2; ++ks) { const bf16x8 pa = *(const LAS bf16x8*)(base + P_OFF + r32 * RS2 + (16 * ks + 8 * hi) * 2);
            vb[ks] = *(const LAS bf16x8*)(base + VT_OFF + vcol * RS2 + (16 * ks + 8 * hi) * 2);
            O = __builtin_amdgcn_mfma_f32_32x32x16_bf16(pa, vb[ks], O, 0, 0, 0); }
#pragma unroll
        for (int ks = 0; ks < 8; ++ks) { const bf16x8 sb = *(const LAS bf16x8*)(base + ST_OFF + vcol * RS + (16 * ks + 8 * hi) * 2);
            O = __builtin_amdgcn_mfma_f32_32x32x16_bf16(qa[ks], sb, O, 0, 0, 0); }
#pragma unroll
        for (int r = 0; r < 16; ++r) { const int tau = crow(r, hi); const int t = ch ? (tok0 + L - 1 - 32 * ci - tau) : (tok0 + 32 * ci + tau);
            lf[(size_t)t * 1024 + h * 128 + vcol] = f2bf(O[r]); }
#pragma unroll
        for (int kt = 0; kt < 4; ++kt) {
#pragma unroll
            for (int g = 0; g < 4; ++g) { const f32x4 d4 = *(const LAS f32x4*)(base + DV_OFF + (32 * kt + 8 * g + 4 * hi) * 4);
#pragma unroll
                for (int e = 0; e < 4; ++e) S[kt][4 * g + e] *= d4[e]; }
#pragma unroll
            for (int ks = 0; ks < 2; ++ks) { const bf16x8 ka = *(const LAS bf16x8*)(base + KHT_OFF + (32 * kt + r32) * RS2 + (16 * ks + 8 * hi) * 2);
                S[kt] = __builtin_amdgcn_mfma_f32_32x32x16_bf16(ka, vb[ks], S[kt], 0, 0, 0); }
#pragma unroll
            for (int g = 0; g < 4; ++g) { u32x2 pk; pk.x = cvt_pk_bf16(S[kt][4 * g], S[kt][4 * g + 1]); pk.y = cvt_pk_bf16(S[kt][4 * g + 2], S[kt][4 * g + 3]);
                *(LAS u32x2*)(base + ST_OFF + vcol * RS + (32 * kt + 8 * g + 4 * hi) * 2) = pk; }
        }
        __syncthreads();
    }
}
__device__ __forceinline__ void hgrn_scan(const Ctx& c) {
    const int NP = 16 + 256;
    for (int rnd = 0;; ++rnd) {
        const int p = (rnd & 1) ? (rnd * c.G + (c.G - 1 - c.bid)) : (rnd * c.G + c.bid);
        if (rnd * c.G >= NP) break;
        if (p < NP) {
            if (p < 16) run_pair(c, (p >> 3) * SP, SP, p & 7);
            else run_pair(c, TP + ((p - 16) >> 3) * SS, SS, (p - 16) & 7);
        }
    }
}
}
namespace peer {
constexpr int KEY_RS = 272;
constexpr int KEYS_BYTES = 2 * 128 * KEY_RS;
constexpr int SI_OFF = KEYS_BYTES;
__device__ __forceinline__ int crow(int r, int hi) { return (r & 3) + 8 * (r >> 2) + 4 * hi; }
__device__ __forceinline__ unsigned sortable(float f) { const unsigned u = __float_as_uint(f); return u ^ ((u >> 31) ? 0xFFFFFFFFu : 0x80000000u); }
__device__ __forceinline__ float unsortable(unsigned s) { const unsigned u = (s >> 31) ? (s ^ 0x80000000u) : ~s; return __uint_as_float(u); }
__device__ __forceinline__ unsigned pair_max(unsigned m) { auto rr = __builtin_amdgcn_permlane32_swap(m, m, false, false); return rr[0] > rr[1] ? rr[0] : rr[1]; }

__device__ __forceinline__ void top16_half(const Ctx& c, const bf16_t* pq_rows, int half, LAS unsigned char* keys, unsigned (&sel)[16]) {
    const int lane = c.lane, r32 = lane & 31, hi = lane >> 5;
    f32x16 acc[4];
#pragma unroll
    for (int nt = 0; nt < 4; ++nt) acc[nt] = f32x16{};
    const bf16_t* qrow = pq_rows + (size_t)r32 * 256 + half * 128;
#pragma unroll 1
    for (int ks = 0; ks < 8; ++ks) { const bf16x8 qb = *reinterpret_cast<const bf16x8*>(qrow + 16 * ks + 8 * hi);
#pragma unroll
        for (int nt = 0; nt < 4; ++nt) { const bf16x8 ka = *(const LAS bf16x8*)(keys + (half * 128 + 32 * nt + r32) * KEY_RS + (16 * ks + 8 * hi) * 2);
            acc[nt] = __builtin_amdgcn_mfma_f32_32x32x16_bf16(ka, qb, acc[nt], 0, 0, 0); } }
    unsigned p[64];
#pragma unroll
    for (int nt = 0; nt < 4; ++nt)
#pragma unroll
        for (int r = 0; r < 16; ++r) { const int n = 32 * nt + crow(r, hi); p[nt * 16 + r] = (sortable(acc[nt][r]) & ~127u) | (unsigned)(127 - n); }
#pragma unroll
    for (int it = 0; it < 16; ++it) {
        unsigned m = p[0];
#pragma unroll
        for (int i = 1; i < 64; ++i) m = p[i] > m ? p[i] : m;
        m = pair_max(m); sel[it] = m;
#pragma unroll
        for (int i = 0; i < 64; ++i) p[i] = (p[i] == m) ? 0u : p[i];
    }
}
__device__ __forceinline__ void route(const Ctx& c, int layer) {
    const bf16_t* pq = (const bf16_t*)(c.ws + B_PQ); int* idx_out = (int*)(c.ws + R2_IDX); float* gate_out = (float*)(c.ws + R2_GATE);
    const bf16_t* keys_g = (const bf16_t*)(c.ws + W_KEYS) + (size_t)layer * 2 * 128 * 128;
    LAS unsigned char* keys = c.lds;
    const int lane = c.lane, r32 = lane & 31, hi = lane >> 5;
    for (int i = c.tid; i < 2 * 128 * 16; i += NTHR) { const int row = i >> 4, ch = i & 15; *(LAS u32x4*)(keys + row * KEY_RS + ch * 16) = *(const u32x4*)(keys_g + (size_t)row * 128 + ch * 8); }
    __syncthreads();
    LAS int* si = (LAS int*)(c.lds + SI_OFF + c.wave * 4096) + r32 * 32;
    for (int grp = c.gw; grp < T / 4; grp += c.NGW) {
        const bf16_t* rows = pq + (size_t)grp * 4 * 2048;
        unsigned s1[16], s2[16];
        top16_half(c, rows, 0, keys, s1);
        top16_half(c, rows, 1, keys, s2);
        float v1[16], v2[16];
#pragma unroll
        for (int i = 0; i < 16; ++i) { v1[i] = unsortable(s1[i] & ~127u); v2[i] = unsortable(s2[i] & ~127u); }
        if (hi == 0) {
#pragma unroll
            for (int i = 0; i < 16; ++i) { si[i] = 127 - (int)(s1[i] & 127u); si[16 + i] = 127 - (int)(s2[i] & 127u); }
        }
        float A[16], B[16];
#pragma unroll
        for (int i = 0; i < 16; ++i) { A[i] = hi ? v2[i] : v1[i]; B[i] = hi ? v1[i] : v2[i]; }
        unsigned cd[27]; int nc = 0;
#pragma unroll
        for (int i = 0; i < 16; ++i)
#pragma unroll
            for (int j = i; j < 16; ++j) if ((i + 1) * (j + 1) <= 16) {
                const unsigned flat = hi ? (unsigned)(j * 16 + i) : (unsigned)(i * 16 + j);
                unsigned pk = (sortable(A[i] + B[j]) & ~255u) | (255u - flat);
                if (i == j) pk = hi ? 0u : pk;
                cd[nc++] = pk; }
        unsigned sel[16];
#pragma unroll
        for (int it = 0; it < 16; ++it) {
            unsigned m = cd[0];
#pragma unroll
            for (int i = 1; i < 27; ++i) m = cd[i] > m ? cd[i] : m;
            m = pair_max(m); sel[it] = m;
#pragma unroll
            for (int i = 0; i < 27; ++i) cd[i] = (cd[i] == m) ? 0u : cd[i];
        }
        LDS_WAIT(); asm volatile("" ::: "memory");
        const float vmax = unsortable(sel[0] & ~255u);
        float e[16], es = 0.f;
#pragma unroll
        for (int i = 0; i < 16; ++i) { e[i] = fast_exp(unsortable(sel[i] & ~255u) - vmax); es += e[i]; }
        const float inv = 1.0f / es;
        const size_t obase = ((size_t)grp * 4 + (r32 >> 3)) * 128 + (r32 & 7) * 16 + 8 * hi;
        int oi[8]; float og[8];
#pragma unroll
        for (int q = 0; q < 8; ++q) { const unsigned sv = hi ? sel[8 + q] : sel[q]; const float ev = hi ? e[8 + q] : e[q];
            const int flat = 255 - (int)(sv & 255u); oi[q] = si[flat >> 4] * 128 + si[16 + (flat & 15)]; og[q] = ev * inv; }
        *(u32x4*)(idx_out + obase) = (u32x4){(unsigned)oi[0], (unsigned)oi[1], (unsigned)oi[2], (unsigned)oi[3]};
        *(u32x4*)(idx_out + obase + 4) = (u32x4){(unsigned)oi[4], (unsigned)oi[5], (unsigned)oi[6], (unsigned)oi[7]};
        *(f32x4*)(gate_out + obase) = (f32x4){og[0], og[1], og[2], og[3]};
        *(f32x4*)(gate_out + obase + 4) = (f32x4){og[4], og[5], og[6], og[7]};
        LDS_WAIT(); asm volatile("" ::: "memory");
    }
    __syncthreads();
}

__device__ __forceinline__ float gelu_exact(float x) { return 0.5f * x * (1.0f + erff(x * 0.70710678118654752f)); }
__device__ __forceinline__ void gather_ln(const Ctx& c, int layer) {
    const bf16_t* Ub = (const bf16_t*)(c.ws + R2_UB); const bf16_t* Vb = (const bf16_t*)(c.ws + R2_VB);
    const int* idx = (const int*)(c.ws + R2_IDX); const float* gate = (const float*)(c.ws + R2_GATE);
    bf16_t* xb = (bf16_t*)(c.ws + WS_XB);
    const float* lg = c.in(20) + layer * D; const float* lbv = c.in(21) + layer * D;
    const int lane = c.lane;
    for (int t = c.gw; t < T; t += c.NGW) {
        float* xr = c.out + (size_t)t * D;
        float x[16], acc[16];
        { const f32x4 a = *(const f32x4*)(xr + 8 * lane), b = *(const f32x4*)(xr + 8 * lane + 4), cc = *(const f32x4*)(xr + 512 + 8 * lane), d = *(const f32x4*)(xr + 512 + 8 * lane + 4);
#pragma unroll
          for (int e = 0; e < 4; ++e) { x[e] = a[e]; x[4 + e] = b[e]; x[8 + e] = cc[e]; x[12 + e] = d[e]; } }
#pragma unroll
        for (int e = 0; e < 16; ++e) acc[e] = 0.f;
        const int myidx0 = idx[(size_t)t * 128 + lane], myidx1 = idx[(size_t)t * 128 + 64 + lane];
        const float myg0 = gate[(size_t)t * 128 + lane], myg1 = gate[(size_t)t * 128 + 64 + lane];
        for (int eb = 0; eb < 128; eb += 8) {
            float part[8]; int ei[8];
#pragma unroll
            for (int q = 0; q < 8; ++q) { const int e = eb + q; ei[q] = __builtin_amdgcn_readlane(e < 64 ? myidx0 : myidx1, e & 63); }
#pragma unroll
            for (int q = 0; q < 8; ++q) { const bf16_t* ur = Ub + (size_t)ei[q] * D;
                const u32x4 a = *(const u32x4*)(ur + 8 * lane), b = *(const u32x4*)(ur + 512 + 8 * lane);
                float s = bflo(a.x) * x[0]; s = fmaf(bfhi(a.x), x[1], s); s = fmaf(bflo(a.y), x[2], s); s = fmaf(bfhi(a.y), x[3], s);
                s = fmaf(bflo(a.z), x[4], s); s = fmaf(bfhi(a.z), x[5], s); s = fmaf(bflo(a.w), x[6], s); s = fmaf(bfhi(a.w), x[7], s);
                s = fmaf(bflo(b.x), x[8], s); s = fmaf(bfhi(b.x), x[9], s); s = fmaf(bflo(b.y), x[10], s); s = fmaf(bfhi(b.y), x[11], s);
                s = fmaf(bflo(b.z), x[12], s); s = fmaf(bfhi(b.z), x[13], s); s = fmaf(bflo(b.w), x[14], s); s = fmaf(bfhi(b.w), x[15], s);
                part[q] = s; }
            float r4[4], r2[2], r1;
            { const bool up = (lane & 32) != 0;
#pragma unroll
              for (int i = 0; i < 4; ++i) { const float send = up ? part[i] : part[4 + i]; const float keep = up ? part[4 + i] : part[i]; r4[i] = keep + __shfl_xor(send, 32); } }
            { const bool up = (lane & 16) != 0;
#pragma unroll
              for (int i = 0; i < 2; ++i) { const float send = up ? r4[i] : r4[2 + i]; const float keep = up ? r4[2 + i] : r4[i]; r2[i] = keep + __shfl_xor(send, 16); } }
            { const bool up = (lane & 8) != 0; const float send = up ? r2[0] : r2[1]; const float keep = up ? r2[1] : r2[0]; r1 = keep + __shfl_xor(send, 8); }
            r1 += __shfl_xor(r1, 4); r1 += __shfl_xor(r1, 2); r1 += __shfl_xor(r1, 1);
            const int myq = ((lane >> 5) & 1) * 4 + ((lane >> 4) & 1) * 2 + ((lane >> 3) & 1);
            const int me = eb + myq;
            const float g = __shfl(me < 64 ? myg0 : myg1, me & 63);
            const float cf = g * gelu_exact(r1);
            float cq[8];
#pragma unroll
            for (int q = 0; q < 8; ++q) cq[q] = __int_as_float(__builtin_amdgcn_readlane(__float_as_int(cf), ((q >> 2) & 1) * 32 + ((q >> 1) & 1) * 16 + (q & 1) * 8));
#pragma unroll
            for (int q = 0; q < 8; ++q) { const bf16_t* vr = Vb + (size_t)ei[q] * D;
                const u32x4 a = *(const u32x4*)(vr + 8 * lane), b = *(const u32x4*)(vr + 512 + 8 * lane); const float s = cq[q];
                acc[0] = fmaf(s, bflo(a.x), acc[0]); acc[1] = fmaf(s, bfhi(a.x), acc[1]); acc[2] = fmaf(s, bflo(a.y), acc[2]); acc[3] = fmaf(s, bfhi(a.y), acc[3]);
                acc[4] = fmaf(s, bflo(a.z), acc[4]); acc[5] = fmaf(s, bfhi(a.z), acc[5]); acc[6] = fmaf(s, bflo(a.w), acc[6]); acc[7] = fmaf(s, bfhi(a.w), acc[7]);
                acc[8] = fmaf(s, bflo(b.x), acc[8]); acc[9] = fmaf(s, bfhi(b.x), acc[9]); acc[10] = fmaf(s, bflo(b.y), acc[10]); acc[11] = fmaf(s, bfhi(b.y), acc[11]);
                acc[12] = fmaf(s, bflo(b.z), acc[12]); acc[13] = fmaf(s, bfhi(b.z), acc[13]); acc[14] = fmaf(s, bflo(b.w), acc[14]); acc[15] = fmaf(s, bfhi(b.w), acc[15]); }
        }
        float s = 0.f;
#pragma unroll
        for (int e = 0; e < 16; ++e) { acc[e] = fmaf(DN_ALPHA, x[e], acc[e]); s += acc[e]; }
        const float mean = wave_sum(s) * (1.0f / D); float s2 = 0.f;
#pragma unroll
        for (int e = 0; e < 16; ++e) { acc[e] -= mean; s2 += acc[e] * acc[e]; }
        const float rstd = 1.0f / sqrtf(wave_sum(s2) * (1.0f / D) + LN_EPS);
        float o[16];
        { const f32x4 g0 = *(const f32x4*)(lg + 8 * lane), g1 = *(const f32x4*)(lg + 8 * lane + 4), g2 = *(const f32x4*)(lg + 512 + 8 * lane), g3 = *(const f32x4*)(lg + 512 + 8 * lane + 4);
          const f32x4 b0 = *(const f32x4*)(lbv + 8 * lane), b1 = *(const f32x4*)(lbv + 8 * lane + 4), b2 = *(const f32x4*)(lbv + 512 + 8 * lane), b3 = *(const f32x4*)(lbv + 512 + 8 * lane + 4);
#pragma unroll
          for (int e = 0; e < 4; ++e) { o[e] = acc[e] * rstd * g0[e] + b0[e]; o[4 + e] = acc[4 + e] * rstd * g1[e] + b1[e]; o[8 + e] = acc[8 + e] * rstd * g2[e] + b2[e]; o[12 + e] = acc[12 + e] * rstd * g3[e] + b3[e]; } }
        *(f32x4*)(xr + 8 * lane) = (f32x4){o[0], o[1], o[2], o[3]}; *(f32x4*)(xr + 8 * lane + 4) = (f32x4){o[4], o[5], o[6], o[7]};
        *(f32x4*)(xr + 512 + 8 * lane) = (f32x4){o[8], o[9], o[10], o[11]}; *(f32x4*)(xr + 512 + 8 * lane + 4) = (f32x4){o[12], o[13], o[14], o[15]};
        u32x4 w0, w1; w0.x = cvt_pk_bf16(o[0], o[1]); w0.y = cvt_pk_bf16(o[2], o[3]); w0.z = cvt_pk_bf16(o[4], o[5]); w0.w = cvt_pk_bf16(o[6], o[7]);
        w1.x = cvt_pk_bf16(o[8], o[9]); w1.y = cvt_pk_bf16(o[10], o[11]); w1.z = cvt_pk_bf16(o[12], o[13]); w1.w = cvt_pk_bf16(o[14], o[15]);
        *(u32x4*)(xb + (size_t)t * D + 8 * lane) = w0; *(u32x4*)(xb + (size_t)t * D + 512 + 8 * lane) = w1;
    }
}
}
__global__ void __launch_bounds__(256) k_checksum(const unsigned* p, size_t nwords, unsigned long long* dst) {
    unsigned long long acc = 0;
    for (size_t i = (size_t)blockIdx.x * 256 + threadIdx.x; i < nwords; i += (size_t)gridDim.x * 256) acc += (unsigned long long)p[i] * (unsigned long long)(2 * i + 1);
    for (int o = 32; o >= 1; o >>= 1) acc += __shfl_xor(acc, o);
    if ((threadIdx.x & 63) == 0) atomicAdd(dst, acc);
}
__global__ void __launch_bounds__(256) k_zero_out(float* out, size_t n) { for (size_t i = (size_t)blockIdx.x * 256 + threadIdx.x; i < n; i += (size_t)gridDim.x * 256) out[i] = 0.f; }
__global__ void k_report(const unsigned long long* tab, int nent, float* out) {
    if (threadIdx.x == 0 && blockIdx.x == 0) { int first = -1; for (int i = 0; i < nent; ++i) if (tab[i] != tab[nent + i]) { first = i; break; }
        out[0] = first < 0 ? 99000.f : 1000.f * (float)(first / 4 + 1); out[1] = first < 0 ? 0.f : (float)(first % 4); }
}
struct Reg { size_t off; size_t bytes; int in_out; };
static int phase_regions(int p, Reg* r) {
    int n = 0;
    auto add = [&](size_t off, size_t mib) { r[n].off = off; r[n].bytes = mib * MiB; r[n].in_out = 0; ++n; };
    auto addout = [&]() { r[n].off = 0; r[n].bytes = (size_t)T * D * 4; r[n].in_out = 1; ++n; };
    if (p == 0) { add(WS_W, 61); add(WS_R2, 160); addout(); return n; }
    int q = p - 1;
    for (int layer = 0; layer < NL; ++layer) {
        const int nm = (layer & 1) ? 5 : 7;
        if (q < nm) {
            if ((layer & 1) == 0) { switch (q) { case 0: add(B_A32, 240); break; case 1: add(R2_UB, 64); add(R2_PB, 40); add(B_CQN, 100); add(B_KROPE, 10); break; case 2: add(B_Q, 240); break; case 3: add(B_KV, 320); break;
                case 4: add(B_Q, 240); break; case 5: add(B_O, 160); break; case 6: add(B_H32_MLA, 320); break; } }
            else { switch (q) { case 0: add(B_PLANE, 800); break; case 1: add(R2_UB, 64); add(R2_PB, 40); break; case 2: add(B_PLANE + 160 * MiB, 320); break; case 3: add(B_PLANE, 160); break; case 4: add(B_H32_HGRN, 320); break; } }
            return n;
        }
        q -= nm;
        if (q < 6) { switch (q) { case 0: addout(); add(WS_XB, 160); break; case 1: add(B_PQ, 320); break; case 2: add(R2_IDX, 80); break; case 3: addout(); add(WS_XB, 160); break; case 4: add(B_PP, 160); break; case 5: addout(); add(WS_R2, 160); break; }
            return n; }
        q -= 6;
    }
    return n;
}
constexpr int N_PHASES = 1 + 2 * (7 + 6) + 2 * (5 + 6);

#define GEMM_PHASE(EPI, Aptr, Bptr, NN, KK, ...) { pg8::Gemm g{(const bf16_t*)(Aptr), (const bf16_t*)(Bptr), T, (NN), (KK)}; pg8::StaticOrder S; S.init(T, (NN), c.G, c.bid); \
        pg8::EPI E{__VA_ARGS__}; pg8::gemm_phase<pg8::EPI, pg8::StaticOrder>(c.lds, g, S, E); }

__global__ void __launch_bounds__(NTHR, 2) fwd_kernel(Args args) {
    extern __shared__ __attribute__((aligned(16))) unsigned char lds_raw[];
    volatile LAS unsigned* misc = (volatile LAS unsigned*)((LAS unsigned char*)lds_raw + LDS_MISC_OFF);
    if (threadIdx.x < 64) misc[threadIdx.x] = 0u;
    __syncthreads();
    const int lo = args.ph_lo, hi = args.ph_hi;
    XcdBarrier bar; bar.bar = (unsigned*)(args.ws + WS_CTL); bar.x = 0; bar.st = nullptr;
    if (hi - lo > 1) bar = xcd_barrier_post((unsigned*)(args.ws + WS_CTL), misc + 8);
    int ph = 0;
#define PH_BEGIN if (ph >= lo && ph < hi) { const Ctx c = mk_ctx(lds_raw); unsigned char* const ws = c.ws; (void)ws;
#define PH_END   if (ph + 1 < hi) xcd_barrier(bar); } ++ph;

    PH_BEGIN p0_prologue(c); PH_END

    for (int layer = 0; layer < NL; ++layer) {
        const int j = layer >> 1;
        if ((layer & 1) == 0) {
            PH_BEGIN GEMM_PHASE(EpiF32, ws + WS_R2, (const bf16_t*)(ws + W_WA) + (size_t)j * 768 * 1024, 768, 1024, (float*)(ws + B_A32), 768) PH_END
            PH_BEGIN l0_convert(c, layer); mla_e1(c, j); PH_END
            PH_BEGIN GEMM_PHASE(EpiBf16P, ws + B_CQN, (const bf16_t*)(ws + W_WUQ) + (size_t)j * 1536 * 384, 1536, 384, (bf16_t*)(ws + B_Q), 1536) PH_END
            PH_BEGIN GEMM_PHASE(EpiBf16P, ws + B_CKVN, (const bf16_t*)(ws + W_WUKV) + (size_t)j * 2048 * 256, 2048, 256, (bf16_t*)(ws + B_KV), 2048) PH_END
            PH_BEGIN mla_qrope(c); PH_END
            PH_BEGIN mla_attention(c); PH_END
            PH_BEGIN GEMM_PHASE(EpiF32, ws + B_O, (const bf16_t*)(ws + W_WO) + (size_t)j * 1024 * 1024, 1024, 1024, (float*)(ws + B_H32_MLA), 1024) PH_END
        } else {
            PH_BEGIN GEMM_PHASE(EpiHgrn, ws + WS_R2, (const bf16_t*)(ws + W_HIN) + (size_t)j * 5120 * 1024, 5120, 1024, (bf16_t*)(ws + B_PLANE), (size_t)T * 1024, (const float*)(ws + WS_MISC) + (size_t)j * 2048) PH_END
            PH_BEGIN l0_convert(c, layer); PH_END
            PH_BEGIN scan::hgrn_scan(c); PH_END
            PH_BEGIN hgrn_post(c, j); PH_END
            PH_BEGIN GEMM_PHASE(EpiF32, ws + B_PLANE, (const bf16_t*)(ws + W_HO) + (size_t)j * 1024 * 1024, 1024, 1024, (float*)(ws + B_H32_HGRN), 1024) PH_END
        }
        PH_BEGIN ln_residual(c, (const float*)(ws + ((layer & 1) ? B_H32_HGRN : B_H32_MLA)), c.in(18) + layer * D, c.in(19) + layer * D); PH_END
        PH_BEGIN GEMM_PHASE(EpiBf16P, ws + WS_XB, (const bf16_t*)(ws + W_PQ) + (size_t)layer * 2048 * 1024, 2048, 1024, (bf16_t*)(ws + B_PQ), 2048) PH_END
        PH_BEGIN peer::route(c, layer); PH_END
        PH_BEGIN peer::gather_ln(c, layer); PH_END
        PH_BEGIN GEMM_PHASE(EpiBf16P, ws + R2_PB, (const bf16_t*)(ws + W_PP) + (size_t)layer * 1024 * 256, 1024, 256, (bf16_t*)(ws + B_PP), 1024) PH_END
        PH_BEGIN GEMM_PHASE(EpiPle, ws + WS_XB, (const bf16_t*)(ws + W_GW) + (size_t)layer * 1024 * 1024, 1024, 1024, c.out, (const bf16_t*)(ws + B_PP), c.in(23) + layer * D, (bf16_t*)(ws + WS_R2)) PH_END
    }
#undef PH_BEGIN
#undef PH_END
}

extern "C" void kernel_launch(void* const* d_in, const int* in_sizes, int n_in, void* d_out, int out_size, void* d_ws, size_t ws_size, hipStream_t stream) {
    static int grid = 0;
    if (grid == 0) {
        if (n_in != 25 || out_size != T * D || ws_size < WS_END) { fprintf(stderr, "kernel_launch: unexpected shapes: n_in %d out %d ws %zu (need %zu)\n", n_in, out_size, ws_size, (size_t)WS_END); grid = -1; return; }
        int dev = 0, cus = 0, per_cu = 0;
        if (hipGetDevice(&dev) != hipSuccess || hipDeviceGetAttribute(&cus, hipDeviceAttributeMultiprocessorCount, dev) != hipSuccess) { grid = -1; return; }
        if (hipFuncSetAttribute((const void*)fwd_kernel, hipFuncAttributeMaxDynamicSharedMemorySize, LDS_BYTES) != hipSuccess) { fprintf(stderr, "kernel_launch: hipFuncSetAttribute failed\n"); grid = -1; return; }
        if (hipOccupancyMaxActiveBlocksPerMultiprocessor(&per_cu, (const void*)fwd_kernel, NTHR, LDS_BYTES) != hipSuccess || per_cu < 1) { fprintf(stderr, "kernel_launch: occupancy query says %d\n", per_cu); }
        (void)hipGetLastError();
        grid = cus;
    }
    if (grid < 0) return;
    (void)hipMemsetAsync((char*)d_ws + WS_CTL, 0, CTL_ZERO_BYTES, stream);
    Args a{};
    for (int i = 0; i < 25; ++i) a.in[i] = (const float*)d_in[i];
    a.out = (float*)d_out; a.ws = (unsigned char*)d_ws;
#if defined(MK_DEBUG_DET)
    unsigned long long* tab = (unsigned long long*)((char*)d_ws + WS_CTL + 32 * 1024);
    for (int pass = 0; pass < 2; ++pass)
        for (int p = 0; p < N_PHASES; ++p) { a.ph_lo = p; a.ph_hi = p + 1; hipLaunchKernelGGL(fwd_kernel, dim3(grid), dim3(NTHR), LDS_BYTES, stream, a);
            Reg r[4]; const int nr = phase_regions(p, r);
            for (int i = 0; i < nr; ++i) hipLaunchKernelGGL(k_checksum, dim3(2048), dim3(256), 0, stream, (const unsigned*)(r[i].in_out ? (char*)d_out : (char*)d_ws + r[i].off), r[i].bytes / 4, tab + (size_t)pass * N_PHASES * 4 + p * 4 + i); }
    hipLaunchKernelGGL(k_zero_out, dim3(2048), dim3(256), 0, stream, (float*)d_out, (size_t)T * D);
    hipLaunchKernelGGL(k_report, dim3(1), dim3(64), 0, stream, tab, N_PHASES * 4, (float*)d_out);
#elif MK_ONE_LAUNCH
    a.ph_lo = 0; a.ph_hi = N_PHASES;
    hipLaunchKernelGGL(fwd_kernel, dim3(grid), dim3(NTHR), LDS_BYTES, stream, a);
#else
    for (int p = 0; p < N_PHASES; ++p) { a.ph_lo = p; a.ph_hi = p + 1; hipLaunchKernelGGL(fwd_kernel, dim3(grid), dim3(NTHR), LDS_BYTES, stream, a); }
#endif
}
```

```cpp
#include <hip/hip_runtime.h>
#include <cstdio>
#include <cstdint>

#ifndef MK_ONE_LAUNCH
#define MK_ONE_LAUNCH 1
#endif

#define GAS __attribute__((address_space(1)))
#define LAS __attribute__((address_space(3)))
typedef unsigned short bf16_t;
typedef short bf16x8 __attribute__((ext_vector_type(8)));
typedef short s16x4 __attribute__((ext_vector_type(4)));
typedef float f32x4 __attribute__((ext_vector_type(4)));
typedef float f32x2 __attribute__((ext_vector_type(2)));
typedef float f32x16 __attribute__((ext_vector_type(16)));
typedef unsigned u32x4 __attribute__((ext_vector_type(4)));
typedef unsigned u32x2 __attribute__((ext_vector_type(2)));

constexpr int D = 1024, TP = 16384, TS = 65536, T = TP + TS, SP = 8192, SS = 2048;
constexpr int NL = 4;
constexpr int NWAVES = 8, NTHR = 512;
constexpr float DN_ALPHA = 1.681792830507429f;
constexpr float LN_EPS = 1e-5f, RMS_EPS = 1e-6f;
constexpr float MLA_SCALE = 0.07216878364870323f;
constexpr int NEXP = 16384;

constexpr size_t MiB = 1u << 20;
constexpr size_t WS_CTL = 0, CTL_ZERO_BYTES = 64 * 1024;
constexpr size_t WS_ROPE = 1 * MiB;
constexpr size_t WS_MISC = 3 * MiB;
constexpr size_t WS_W = 4 * MiB;
constexpr size_t W_WA = WS_W;
constexpr size_t W_WUQ = W_WA + 2 * (size_t)768 * 1024 * 2;
constexpr size_t W_WUKV = W_WUQ + 2 * (size_t)1536 * 384 * 2;
constexpr size_t W_WO = W_WUKV + 2 * (size_t)2048 * 256 * 2;
constexpr size_t W_HIN = W_WO + 2 * (size_t)1024 * 1024 * 2;
constexpr size_t W_HO = W_HIN + 2 * (size_t)5120 * 1024 * 2;
constexpr size_t W_PQ = W_HO + 2 * (size_t)1024 * 1024 * 2;
constexpr size_t W_GW = W_PQ + 4 * (size_t)2048 * 1024 * 2;
constexpr size_t W_PP = W_GW + 4 * (size_t)1024 * 1024 * 2;
constexpr size_t W_KEYS = W_PP + 4 * (size_t)1024 * 256 * 2;
constexpr size_t W_END = W_KEYS + 4 * (size_t)2 * 128 * 128 * 2;
static_assert(W_END <= 68 * MiB, "weights region");
constexpr size_t WS_R2 = 68 * MiB;
constexpr size_t R2_UB = WS_R2, R2_VB = WS_R2 + 16 * MiB, R2_SU = WS_R2 + 32 * MiB, R2_SV = WS_R2 + 33 * MiB, R2_IDX = WS_R2 + 64 * MiB, R2_GATE = WS_R2 + 104 * MiB, R2_PB = WS_R2 + 144 * MiB;
constexpr size_t WS_XB = 252 * MiB;
constexpr size_t WS_BIG = 412 * MiB;
constexpr size_t WS_END = WS_BIG + 800 * MiB;
constexpr size_t B_Q = WS_BIG, B_KV = WS_BIG + 240 * MiB, B_O = WS_BIG + 560 * MiB, B_KROPE = WS_BIG + 720 * MiB;
constexpr size_t B_A32 = WS_BIG + 240 * MiB, B_CQN = WS_BIG + 560 * MiB, B_CKVN = WS_BIG + 620 * MiB, B_H32_MLA = WS_BIG;
constexpr size_t B_PLANE = WS_BIG, PLANE_BYTES = 160 * MiB, B_H32_HGRN = WS_BIG + 160 * MiB;
constexpr size_t B_PQ = WS_BIG, B_PP = WS_BIG + 320 * MiB;

constexpr int LDS_BYTES = 160 * 1024;
constexpr int LDS_MISC_OFF = LDS_BYTES - 256;

typedef __bf16 bf16x2_n __attribute__((ext_vector_type(2)));
__device__ __forceinline__ unsigned cvt_pk_bf16(float lo, float hi) { const f32x2 v = {lo, hi}; const bf16x2_n b = __builtin_convertvector(v, bf16x2_n); return __builtin_bit_cast(unsigned, b); }
__device__ __forceinline__ bf16_t f2bf(float f) { return (bf16_t)(cvt_pk_bf16(f, 0.f) & 0xffffu); }
__device__ __forceinline__ float bf2f(bf16_t b) { return __uint_as_float(((unsigned)b) << 16); }
__device__ __forceinline__ float bflo(unsigned w) { return __uint_as_float(w << 16); }
__device__ __forceinline__ float bfhi(unsigned w) { return __uint_as_float(w & 0xffff0000u); }
__device__ __forceinline__ float wave_sum(float v) {
#pragma unroll
    for (int o = 1; o < 64; o <<= 1) v += __shfl_xor(v, o);
    return v;
}
__device__ __forceinline__ float fast_exp(float x) { return __builtin_amdgcn_exp2f(x * 1.4426950408889634f); }
__device__ __forceinline__ float fast_log(float x) { return __builtin_amdgcn_logf(x) * 0.6931471805599453f; }
__device__ __forceinline__ float fast_rcp(float x) { return __builtin_amdgcn_rcpf(x); }
__device__ __forceinline__ float sigmoidf_(float x) { return fast_rcp(1.0f + fast_exp(-x)); }
__device__ __forceinline__ float siluf_(float x) { return x * sigmoidf_(x); }
#define LDS_WAIT() asm volatile("s_waitcnt lgkmcnt(0)" ::: "memory")
#define VM_WAIT() asm volatile("s_waitcnt vmcnt(0)" ::: "memory")
__device__ __forceinline__ int opaque_tid() { int t = (int)threadIdx.x; asm volatile("" : "+v"(t)); return t; }
__device__ __forceinline__ int opaque_bid() { int b = (int)blockIdx.x; asm volatile("" : "+s"(b)); return b; }
struct Args { const float* in[25]; float* out; unsigned char* ws; int ph_lo, ph_hi; };
#define XB_TMO      128
#define XB_XCNT(j)  (256  + 64 * (j))
#define XB_XSUB(j)  (1280 + 64 * (j))
#define XB_XGEN(j)  (2304 + 64 * (j))
#define XB_TOP      3328
#define XB_TOPGEN   3392
#define XCD_BAR_WORDS 3456
#define XB_SPIN_CAP (1u << 23)

__device__ __forceinline__ unsigned xb_ld(unsigned* p)              { return __hip_atomic_load(p, __ATOMIC_RELAXED, __HIP_MEMORY_SCOPE_AGENT); }
__device__ __forceinline__ unsigned xb_add(unsigned* p, unsigned v) { return __hip_atomic_fetch_add(p, v, __ATOMIC_RELAXED, __HIP_MEMORY_SCOPE_AGENT); }
__device__ __forceinline__ unsigned xb_xcc_id() { return (unsigned)__builtin_amdgcn_s_getreg((3 << 11) | 20) & 0xFu; }
#define XB_SPIN(cond, bar) do { unsigned _sp = 0; while (cond) { __builtin_amdgcn_s_sleep(1); \
    if ((++_sp & 255u) == 0u) { if (xb_ld(&(bar)[XB_TMO])) break; if (_sp > XB_SPIN_CAP) { atomicAdd(&(bar)[XB_TMO], 1u); break; } } } } while (0)

struct XcdBarrier {
    unsigned* bar; unsigned x;
    volatile LAS unsigned* st;
};

__device__ __forceinline__ XcdBarrier xcd_barrier_post(unsigned* bar, volatile LAS unsigned* st) {
    XcdBarrier b; b.bar = bar; b.x = xb_xcc_id(); b.st = st;
    if (threadIdx.x == 0) (void)xb_add(&bar[XB_XCNT(b.x)], 1u);
    return b;
}
__device__ __forceinline__ void xcd_barrier_complete(unsigned* bar, unsigned x, unsigned& nloc, unsigned& nx) {
    const unsigned G = gridDim.x * gridDim.y * gridDim.z;
    unsigned sum, cnt, mine, sp = 0u;
    for (;;) {
        sum = 0u; cnt = 0u; mine = 0u;
#pragma unroll
        for (unsigned j = 0; j < 16; ++j) { const unsigned c = xb_ld(&bar[XB_XCNT(j)]); sum += c; cnt += (c > 0u) ? 1u : 0u; mine = (j == x) ? c : mine; }
        if (sum == G) break;
        __builtin_amdgcn_s_sleep(1);
        if ((++sp & 255u) == 0u) { if (xb_ld(&bar[XB_TMO])) break; if (sp > XB_SPIN_CAP) { atomicAdd(&bar[XB_TMO], 1u); break; } }
    }
    nloc = mine > 0u ? mine : 1u; nx = cnt > 0u ? cnt : 1u;
}

__device__ __forceinline__ void xcd_barrier(const XcdBarrier& b) {
    asm volatile("s_waitcnt vmcnt(0)" ::: "memory");
    __syncthreads();
    if (threadIdx.x == 0) {
        unsigned* bar = b.bar;
        __builtin_amdgcn_s_waitcnt(0);
        unsigned nloc = b.st[0], nx = b.st[1];
        if (nloc == 0u) { xcd_barrier_complete(bar, b.x, nloc, nx); b.st[0] = nloc; b.st[1] = nx; }
        const unsigned old = xb_add(&bar[XB_XSUB(b.x)], 1u);
        const unsigned gen = old / nloc;
        if (old + 1u == (gen + 1u) * nloc) {
            __builtin_amdgcn_fence(__ATOMIC_RELEASE, "agent");
            asm volatile("s_waitcnt vmcnt(0)" ::: "memory");
            const unsigned og = xb_add(&bar[XB_TOP], 1u);
            const unsigned tg = og / nx;
            if (og + 1u == (tg + 1u) * nx) xb_add(&bar[XB_TOPGEN], 1u);
            else XB_SPIN(xb_ld(&bar[XB_TOPGEN]) == tg, bar);
            __builtin_amdgcn_fence(__ATOMIC_ACQUIRE, "agent");
            xb_add(&bar[XB_XGEN(b.x)], 1u);
            asm volatile("s_waitcnt vmcnt(0)" ::: "memory");
        } else {
            XB_SPIN(xb_ld(&bar[XB_XGEN(b.x)]) == gen, bar);
            __builtin_amdgcn_fence(__ATOMIC_ACQUIRE, "agent");
            asm volatile("s_waitcnt vmcnt(0)" ::: "memory");
        }
    }
    __syncthreads();
}
namespace pg8 {
#define PG8_LAS __attribute__((address_space(3)))
constexpr int BM = 256, BK = 64, HALF = 128, HTB = HALF * BK * 2  , STAGE_BYTES = 8 * HTB, NXCD = 8, WGM = 8;

__host__ __device__ __forceinline__ int lds_byte(int r, int c) { const int st = (r >> 4) * 2 + (c >> 5), rr = r & 15, cc = c & 31, ob = rr * 64 + cc * 2; return st * 1024 + (ob ^ (((ob >> 9) & 1) << 5)); }
__host__ __device__ __forceinline__ void stage_rc(int b, int& R, int& C) { const int st = b / 1024, sb = b % 1024, swz = sb ^ (((sb >> 9) & 1) << 5); R = (st >> 1) * 16 + swz / 64; C = (st & 1) * 32 + (swz % 64) / 2; }
__host__ __device__ __forceinline__ int perm32(int rho) { const int n = rho >> 4, i = rho & 15; return 8 * (i >> 2) + 4 * n + (i & 3); }

struct Unit { int pm, pn; };
struct Gemm { const bf16_t* A; const bf16_t* Bt; int M, N, K; };

struct StaticOrder {
    int nM, nN, nwg, G, c;
    __host__ __device__ void init(int M, int N, int G_, int c_) { nM = M / BM; nN = N / BM; nwg = nM * nN; G = G_; c = c_; }
    __host__ __device__ bool next(int i, Unit& u) const {
        const long L = (long)i * G + c; if (L >= nwg) return false;
        int wgid = (int)L; { const int q = nwg / NXCD, r = nwg % NXCD, xcd = wgid % NXCD, off = wgid / NXCD; wgid = (xcd < r ? xcd * (q + 1) : r * (q + 1) + (xcd - r) * q) + off; }
        const int nig = WGM * nN, gid = wgid / nig, fm = gid * WGM, gsz = (nM - fm) < WGM ? (nM - fm) : WGM;
        u.pm = fm + ((wgid % nig) % gsz); u.pn = (wgid % nig) / gsz; return true;
    }
    __device__ __forceinline__ void a_ready(const Unit&) const {}
    __device__ __forceinline__ void done(const Unit&) const {}
};
template <class Epi, class Sched>
__device__ __forceinline__ void gemm_phase(PG8_LAS unsigned char* lds, const Gemm g, const Sched& S, const Epi& E) {
    const int tid = opaque_tid(), wid = __builtin_amdgcn_readfirstlane(tid >> 6), lane = tid & 63, wr = wid >> 2, wc = wid & 3, fr = lane & 15, fq = lane >> 4;
    const int K = g.K, nt = K / BK;
    unsigned voffA[2], voffB[2];
#pragma unroll
    for (int i = 0; i < 2; ++i) { int R, C; stage_rc(tid * 16 + i * 8192, R, C); const int Rb = Epi::PERM ? ((R & ~31) + perm32(R & 31)) : R;
        voffA[i] = (unsigned)(R * K + C) * 2u; voffB[i] = (unsigned)(Rb * K + C) * 2u; }
    const size_t kstep = (size_t)(BK * 2);
    const size_t hstep = (size_t)HALF * K * 2;
    const size_t tstep = 2 * hstep;
    const unsigned ldsw = (unsigned)wid * 1024u;
    const int aoff = lds_byte(wr * 64 + fr, fq * 8), boff = lds_byte(wc * 32 + fr, fq * 8);
#define PG8_SA(b, h) (((b) * 2 + (h)) * HTB)
#define PG8_SB(b, h) ((4 + (b) * 2 + (h)) * HTB)
#define PG8_STAGE(bufoff, gbase, voff) do { _Pragma("unroll") for (int _i = 0; _i < 2; ++_i) \
        __builtin_amdgcn_global_load_lds((const unsigned*)((const char*)(gbase) + (voff)[_i]), (PG8_LAS unsigned*)(lds + (bufoff) + ldsw + _i * 8192), 16, 0, 0); } while (0)
#define PG8_LDA(dst, b, h) do { _Pragma("unroll") for (int m = 0; m < 4; ++m) _Pragma("unroll") for (int k = 0; k < 2; ++k) dst[m][k] = *(const PG8_LAS bf16x8*)(lds + PG8_SA(b, h) + aoff + m * 2048 + k * 1024); } while (0)
#define PG8_LDB(dst, b, h) do { _Pragma("unroll") for (int n = 0; n < 2; ++n) _Pragma("unroll") for (int k = 0; k < 2; ++k) dst[n][k] = *(const PG8_LAS bf16x8*)(lds + PG8_SB(b, h) + boff + n * 2048 + k * 1024); } while (0)
#define PG8_MMA(ai, bj, At, Bt) do { __builtin_amdgcn_s_setprio(1); _Pragma("unroll") for (int m = 0; m < 4; ++m) _Pragma("unroll") for (int n = 0; n < 2; ++n) _Pragma("unroll") for (int k = 0; k < 2; ++k) \
        acc[ai][bj][m][n] = __builtin_amdgcn_mfma_f32_16x16x32_bf16(Bt[n][k], At[m][k], acc[ai][bj][m][n], 0, 0, 0); __builtin_amdgcn_s_setprio(0); } while (0)
#define PG8_WAIT_V(n) asm volatile("s_waitcnt vmcnt(" #n ")" ::: "memory")
#define PG8_WAIT_L(n) asm volatile("s_waitcnt lgkmcnt(" #n ")" ::: "memory")
#define PG8_BAR __builtin_amdgcn_s_barrier()
#define PG8_SCHED __builtin_amdgcn_sched_barrier(0)
    Unit cur, nxt; int ui = 0;
    if (!S.next(0, cur)) return;
    f32x4 acc[2][2][4][2];
#pragma unroll
    for (int a = 0; a < 2; ++a)
#pragma unroll
        for (int b = 0; b < 2; ++b)
#pragma unroll
            for (int m = 0; m < 4; ++m)
#pragma unroll
                for (int n = 0; n < 2; ++n) acc[a][b][m][n] = (f32x4){0.f, 0.f, 0.f, 0.f};
    bf16x8 At[4][2], B0[2][2], B1[2][2];
    const char* cA = (const char*)g.A + (size_t)cur.pm * tstep; const char* cB = (const char*)g.Bt + (size_t)cur.pn * tstep;
    S.a_ready(cur);
    PG8_STAGE(PG8_SB(0, 0), cB, voffB); PG8_STAGE(PG8_SA(0, 0), cA, voffA); PG8_STAGE(PG8_SB(0, 1), cB + hstep, voffB); PG8_STAGE(PG8_SA(0, 1), cA + hstep, voffA);
    if (wr == 1) PG8_BAR;
    PG8_WAIT_V(4); PG8_BAR;
    PG8_STAGE(PG8_SB(1, 0), cB + kstep, voffB); PG8_STAGE(PG8_SA(1, 0), cA + kstep, voffA); PG8_STAGE(PG8_SB(1, 1), cB + hstep + kstep, voffB);
    PG8_WAIT_V(6); PG8_BAR;
    for (;;) {
        const bool has_next = S.next(ui + 1, nxt);
        const char* nA = has_next ? (const char*)g.A + (size_t)nxt.pm * tstep : cA; const char* nB = has_next ? (const char*)g.Bt + (size_t)nxt.pn * tstep : cB;
        for (int t = 0; t < nt; t += 2) {
            const bool last = (t == nt - 2);
            const char* a1 = cA + (size_t)(t + 1) * kstep;
            const char* a2 = last ? nA : cA + (size_t)(t + 2) * kstep; const char* b2 = last ? nB : cB + (size_t)(t + 2) * kstep;
            const char* a3 = a2 + kstep; const char* b3 = b2 + kstep;
            if (last && has_next) S.a_ready(nxt);
            PG8_LDB(B0, 0, 0); PG8_SCHED; PG8_LDA(At, 0, 0); PG8_STAGE(PG8_SA(1, 1), a1 + hstep, voffA);
            PG8_WAIT_L(8); PG8_BAR; PG8_WAIT_L(0); PG8_MMA(0, 0, At, B0); PG8_BAR; PG8_SCHED;
            PG8_LDB(B1, 0, 1); PG8_STAGE(PG8_SB(0, 0), b2, voffB);
            PG8_BAR; PG8_WAIT_L(0); PG8_MMA(0, 1, At, B1); PG8_BAR;
            PG8_LDA(At, 0, 1); PG8_STAGE(PG8_SA(0, 0), a2, voffA);
            PG8_BAR; PG8_WAIT_L(0); PG8_MMA(1, 0, At, B0); PG8_BAR; PG8_SCHED;
            PG8_STAGE(PG8_SB(0, 1), b2 + hstep, voffB);
            PG8_WAIT_V(6); PG8_BAR; PG8_MMA(1, 1, At, B1); PG8_BAR;
            PG8_LDB(B0, 1, 0); PG8_SCHED; PG8_LDA(At, 1, 0); PG8_STAGE(PG8_SA(0, 1), a2 + hstep, voffA);
            PG8_WAIT_L(8); PG8_BAR; PG8_WAIT_L(0); PG8_MMA(0, 0, At, B0); PG8_BAR; PG8_SCHED;
            PG8_LDB(B1, 1, 1); PG8_STAGE(PG8_SB(1, 0), b3, voffB);
            PG8_BAR; PG8_WAIT_L(0); PG8_MMA(0, 1, At, B1); PG8_BAR;
            PG8_LDA(At, 1, 1); PG8_STAGE(PG8_SA(1, 0), a3, voffA);
            PG8_BAR; PG8_WAIT_L(0); PG8_MMA(1, 0, At, B0); PG8_BAR; PG8_SCHED;
            PG8_STAGE(PG8_SB(1, 1), b3 + hstep, voffB);
            PG8_WAIT_V(6); PG8_BAR; PG8_MMA(1, 1, At, B1); PG8_BAR;
        }
        E(acc, cur, wr, wc, fr, fq); S.done(cur);
        if (!has_next) break;
#pragma unroll
        for (int a = 0; a < 2; ++a)
#pragma unroll
            for (int b = 0; b < 2; ++b)
#pragma unroll
                for (int m = 0; m < 4; ++m)
#pragma unroll
                    for (int n = 0; n < 2; ++n) acc[a][b][m][n] = (f32x4){0.f, 0.f, 0.f, 0.f};
        cur = nxt; cA = nA; cB = nB; ++ui;
    }
    PG8_WAIT_V(0);
    if (wr == 0) PG8_BAR;
    PG8_BAR;
#undef PG8_SA
#undef PG8_SB
#undef PG8_STAGE
#undef PG8_LDA
#undef PG8_LDB
#undef PG8_MMA
#undef PG8_WAIT_V
#undef PG8_WAIT_L
#undef PG8_BAR
#undef PG8_SCHED
}
struct EpiF32 {
    static constexpr bool PERM = false;
    float* C; int ldc;
    __device__ __forceinline__ void operator()(const f32x4 (&acc)[2][2][4][2], const Unit& u, int wr, int wc, int fr, int fq) const {
        const int row0 = u.pm * BM + wr * 64 + fr, col0 = u.pn * BM + wc * 32 + 4 * fq;
#pragma unroll
        for (int ai = 0; ai < 2; ++ai)
#pragma unroll
            for (int m = 0; m < 4; ++m) { float* rowp = C + (size_t)(row0 + ai * HALF + m * 16) * ldc + col0;
#pragma unroll
                for (int bj = 0; bj < 2; ++bj)
#pragma unroll
                    for (int n = 0; n < 2; ++n) *(f32x4*)(rowp + bj * HALF + n * 16) = acc[ai][bj][m][n]; }
    }
};
struct EpiBf16P {
    static constexpr bool PERM = true;
    bf16_t* O; int ldc;
    __device__ __forceinline__ void operator()(const f32x4 (&acc)[2][2][4][2], const Unit& u, int wr, int wc, int fr, int fq) const {
        const int row0 = u.pm * BM + wr * 64 + fr, col0 = u.pn * BM + wc * 32 + 8 * fq;
#pragma unroll
        for (int ai = 0; ai < 2; ++ai)
#pragma unroll
            for (int m = 0; m < 4; ++m) { bf16_t* rowp = O + (size_t)(row0 + ai * HALF + m * 16) * ldc + col0;
#pragma unroll
                for (int bj = 0; bj < 2; ++bj) { const f32x4 v0 = acc[ai][bj][m][0], v1 = acc[ai][bj][m][1];
                    u32x4 w; w.x = cvt_pk_bf16(v0[0], v0[1]); w.y = cvt_pk_bf16(v0[2], v0[3]); w.z = cvt_pk_bf16(v1[0], v1[1]); w.w = cvt_pk_bf16(v1[2], v1[3]);
                    *(u32x4*)(rowp + bj * HALF) = w; } }
    }
};
struct EpiHgrn {
    static constexpr bool PERM = true;
    bf16_t* planes; size_t plane_elems; const float* lb;
    __device__ __forceinline__ void operator()(const f32x4 (&acc)[2][2][4][2], const Unit& u, int wr, int wc, int fr, int fq) const {
        const int plane = u.pn >> 2;
        const int row0 = u.pm * BM + wr * 64 + fr, col0 = (u.pn & 3) * BM + wc * 32 + 8 * fq;
        bf16_t* base = planes + (size_t)plane * plane_elems;
        float lbv[2][8];
        if (plane == 1 || plane == 2) {
#pragma unroll
            for (int bj = 0; bj < 2; ++bj)
#pragma unroll
                for (int e = 0; e < 8; ++e) lbv[bj][e] = lb[(plane - 1) * 1024 + col0 + bj * HALF + e];
        } else {
#pragma unroll
            for (int bj = 0; bj < 2; ++bj)
#pragma unroll
                for (int e = 0; e < 8; ++e) lbv[bj][e] = 0.f;
        }
#pragma unroll
        for (int ai = 0; ai < 2; ++ai)
#pragma unroll
            for (int m = 0; m < 4; ++m) { bf16_t* rowp = base + (size_t)(row0 + ai * HALF + m * 16) * 1024 + col0;
#pragma unroll
                for (int bj = 0; bj < 2; ++bj) { float v[8];
#pragma unroll
                    for (int e = 0; e < 4; ++e) { v[e] = acc[ai][bj][m][0][e]; v[4 + e] = acc[ai][bj][m][1][e]; }
                    if (plane == 0 || plane == 4) {
#pragma unroll
                        for (int e = 0; e < 8; ++e) v[e] = siluf_(v[e]);
                    } else if (plane == 1 || plane == 2) {
#pragma unroll
                        for (int e = 0; e < 8; ++e) { const float l = lbv[bj][e]; const float f = l + (1.0f - l) * sigmoidf_(v[e]); v[e] = fast_log(fmaxf(f, 1e-30f)); }
                    }
                    u32x4 w; w.x = cvt_pk_bf16(v[0], v[1]); w.y = cvt_pk_bf16(v[2], v[3]); w.z = cvt_pk_bf16(v[4], v[5]); w.w = cvt_pk_bf16(v[6], v[7]);
                    *(u32x4*)(rowp + bj * HALF) = w; } }
    }
};
struct EpiPle {
    static constexpr bool PERM = false;
    float* X; const bf16_t* PP; const float* bias; bf16_t* XbOut;
    __device__ __forceinline__ void operator()(const f32x4 (&acc)[2][2][4][2], const Unit& u, int wr, int wc, int fr, int fq) const {
        const int row0 = u.pm * BM + wr * 64 + fr, col0 = u.pn * BM + wc * 32 + 4 * fq;
        f32x4 bv[2][2];
#pragma unroll
        for (int bj = 0; bj < 2; ++bj)
#pragma unroll
            for (int n = 0; n < 2; ++n) bv[bj][n] = *(const f32x4*)(bias + col0 + bj * HALF + n * 16);
#pragma unroll
        for (int ai = 0; ai < 2; ++ai)
#pragma unroll
            for (int m = 0; m < 4; ++m) { const size_t off = (size_t)(row0 + ai * HALF + m * 16) * 1024 + col0;
#pragma unroll
                for (int bj = 0; bj < 2; ++bj)
#pragma unroll
                    for (int n = 0; n < 2; ++n) { const size_t o2 = off + bj * HALF + n * 16;
                        const f32x4 x = *(const f32x4*)(X + o2); const u32x2 pw = *(const u32x2*)(PP + o2); const f32x4 z = acc[ai][bj][m][n] + bv[bj][n];
                        f32x4 o; o[0] = x[0] + sigmoidf_(z[0]) * bflo(pw.x); o[1] = x[1] + sigmoidf_(z[1]) * bfhi(pw.x); o[2] = x[2] + sigmoidf_(z[2]) * bflo(pw.y); o[3] = x[3] + sigmoidf_(z[3]) * bfhi(pw.y);
                        *(f32x4*)(X + o2) = o; u32x2 w; w.x = cvt_pk_bf16(o[0], o[1]); w.y = cvt_pk_bf16(o[2], o[3]); *(u32x2*)(XbOut + o2) = w; }
                asm volatile("" ::: "memory"); }
    }
};
}
namespace attn {
constexpr int DV = 128, DQK = 192, NW = 8, QBLK = 32, KVBLK = 64;
constexpr float SCALE = MLA_SCALE;
constexpr float THR = 8.f;
constexpr int LDQ = 8 * DQK, LDKV = 8 * 256, LDKR = 64, LDO = 1024;
constexpr int KROWB = 400;
constexpr int SHM_V = KVBLK * DV * 2, SHM_K = KVBLK * KROWB, SHM_ATTN = 2 * SHM_V + 2 * SHM_K + NW * 64 * 4;
#define SBAR() __builtin_amdgcn_sched_barrier(0)
__device__ __forceinline__ int crow(int r, int hi) { return (r & 3) + 8 * (r >> 2) + 4 * hi; }

__device__ __forceinline__ void partialSM(f32x16& p0, f32x16& p1, float& m_reg, float& mn, float& alpha) {
  constexpr float C = SCALE * 1.4426950408889634f;
  float pmax = p0[0];
#pragma unroll
  for (int r = 1; r < 16; ++r) pmax = fmaxf(pmax, p0[r]);
#pragma unroll
  for (int r = 0; r < 16; ++r) pmax = fmaxf(pmax, p1[r]);
  { auto rr = __builtin_amdgcn_permlane32_swap(__float_as_uint(pmax), __float_as_uint(pmax), false, false);
    pmax = fmaxf(__uint_as_float(rr[0]), __uint_as_float(rr[1])); }
  if (__builtin_expect(__all(pmax - m_reg <= THR / SCALE), 1)) { mn = m_reg; alpha = 1.f; }
  else { mn = fmaxf(m_reg, pmax); alpha = __builtin_amdgcn_exp2f((m_reg - mn) * C); m_reg = mn; }
  float mnC = -mn * C;
#pragma unroll
  for (int r = 0; r < 16; ++r) p0[r] = fmaf(p0[r], C, mnC);
#pragma unroll
  for (int r = 0; r < 16; ++r) p1[r] = fmaf(p1[r], C, mnC);
#pragma unroll
  for (int r = 0; r < 16; ++r) p0[r] = __builtin_amdgcn_exp2f(p0[r]);
}
__device__ __forceinline__ void finishSM(f32x16& p0, f32x16& p1, float alpha, float& l_reg, bf16x8& pa0, bf16x8& pa1, bf16x8& pa2, bf16x8& pa3) {
#pragma unroll
  for (int r = 0; r < 16; ++r) p1[r] = __builtin_amdgcn_exp2f(p1[r]);
  float ps = 0;
#pragma unroll
  for (int r = 0; r < 16; ++r) ps += p0[r];
#pragma unroll
  for (int r = 0; r < 16; ++r) ps += p1[r];
  { auto rr = __builtin_amdgcn_permlane32_swap(__float_as_uint(ps), __float_as_uint(ps), false, false);
    ps = __uint_as_float(rr[0]) + __uint_as_float(rr[1]); }
  l_reg = l_reg * alpha + ps;
#define PK4(P, BASE, OUT) do { unsigned a0 = cvt_pk_bf16(P[BASE + 0], P[BASE + 1]), a1 = cvt_pk_bf16(P[BASE + 2], P[BASE + 3]);   \
    unsigned b0 = cvt_pk_bf16(P[BASE + 4], P[BASE + 5]), b1 = cvt_pk_bf16(P[BASE + 6], P[BASE + 7]);                              \
    auto r0 = __builtin_amdgcn_permlane32_swap(a0, b0, false, false); auto r1 = __builtin_amdgcn_permlane32_swap(a1, b1, false, false); \
    u32x4 w = {r0[0], r1[0], r0[1], r1[1]}; OUT = *reinterpret_cast<bf16x8*>(&w); } while (0)
  PK4(p0, 0, pa0); PK4(p0, 8, pa1); PK4(p1, 0, pa2); PK4(p1, 8, pa3);
#undef PK4
}
__device__ __forceinline__ void qkt(f32x16& p0, f32x16& p1, const char* Ks, const bf16x8* qr, int r32, int hi) {
  p0 = f32x16{}; p1 = f32x16{};
#pragma unroll
  for (int d0 = 0; d0 < 12; ++d0) { const int cb = (d0 * 16 + hi * 8) * 2;
    bf16x8 b0 = *reinterpret_cast<const bf16x8*>(Ks + r32 * KROWB + cb);
    bf16x8 b1 = *reinterpret_cast<const bf16x8*>(Ks + (32 + r32) * KROWB + cb);
    p0 = __builtin_amdgcn_mfma_f32_32x32x16_bf16(b0, qr[d0], p0, 0, 0, 0);
    p1 = __builtin_amdgcn_mfma_f32_32x32x16_bf16(b1, qr[d0], p1, 0, 0, 0);
    if ((d0 & 3) == 3) SBAR(); }
}
__device__ __forceinline__ int v_st(int k, int c) { const int kk = (k & ~0xC) | ((k & 4) << 1) | ((k & 8) >> 1); return ((kk >> 3) * 4 + (c >> 5)) * 512 + ((kk & 7) * 32 + (c & 31)) * 2; }
__device__ __forceinline__ int v_rd_base(int lane) { return ((lane & 3) << 3) | (((lane >> 2) & 3) << 6) | (((lane >> 4) & 1) << 5) | (((lane >> 5) & 1) << 8); }
constexpr int v_rd_off(int d0, int ks, int half) { return d0 * 512 + ks * 4096 + half * 2048; }
template <int OFF> __device__ __forceinline__ s16x4 tr_read(int vb) {
  s16x4 r; asm volatile("ds_read_b64_tr_b16 %0, %1 offset:%2" : "=&v"(r) : "v"(vb), "i"(OFF) : "memory"); return r;
}
template <int D0> __device__ __forceinline__ void pv_one(f32x16& od, int vb, bf16x8 pa0, bf16x8 pa1, bf16x8 pa2, bf16x8 pa3) {
  const s16x4 l0 = tr_read<v_rd_off(D0, 0, 0)>(vb), h0 = tr_read<v_rd_off(D0, 0, 1)>(vb), l1 = tr_read<v_rd_off(D0, 1, 0)>(vb), h1 = tr_read<v_rd_off(D0, 1, 1)>(vb);
  const s16x4 l2 = tr_read<v_rd_off(D0, 2, 0)>(vb), h2 = tr_read<v_rd_off(D0, 2, 1)>(vb), l3 = tr_read<v_rd_off(D0, 3, 0)>(vb), h3 = tr_read<v_rd_off(D0, 3, 1)>(vb);
  asm volatile("s_waitcnt lgkmcnt(0)" ::: "memory"); SBAR();
#define PK(L, H) (bf16x8){L[0], L[1], L[2], L[3], H[0], H[1], H[2], H[3]}
  od = __builtin_amdgcn_mfma_f32_32x32x16_bf16(pa0, PK(l0, h0), od, 0, 0, 0);
  od = __builtin_amdgcn_mfma_f32_32x32x16_bf16(pa1, PK(l1, h1), od, 0, 0, 0);
  od = __builtin_amdgcn_mfma_f32_32x32x16_bf16(pa2, PK(l2, h2), od, 0, 0, 0);
  od = __builtin_amdgcn_mfma_f32_32x32x16_bf16(pa3, PK(l3, h3), od, 0, 0, 0);
#undef PK
}
__device__ __forceinline__ void pv_d0(f32x16* o, int vb, bf16x8 pa0, bf16x8 pa1, bf16x8 pa2, bf16x8 pa3) {
  pv_one<0>(o[0], vb, pa0, pa1, pa2, pa3); pv_one<1>(o[1], vb, pa0, pa1, pa2, pa3); pv_one<2>(o[2], vb, pa0, pa1, pa2, pa3); pv_one<3>(o[3], vb, pa0, pa1, pa2, pa3);
}

__device__ __forceinline__ void attn_body(const bf16_t* __restrict__ Qb, const bf16_t* __restrict__ Kn, const bf16_t* __restrict__ Kr,
                                          bf16_t* __restrict__ Ob, int seq, char* lds) {
  const int tid = opaque_tid(), wid = tid >> 6, lane = tid & 63, r32 = lane & 31, hi = lane >> 5;
  char* V_lds = lds; char* K_lds = lds + 2 * SHM_V;
  float* ws = (float*)(lds + 2 * SHM_V + 2 * SHM_K) + wid * 64; float* li_l = ws; float* al_l = ws + 32;
  float m_reg = -1e30f, l_reg = 0; f32x16 o[4] = {}; bf16x8 qr[12];
  const bf16_t* Qw = Qb + (long)(wid * QBLK + r32) * LDQ + hi * 8;
#pragma unroll
  for (int d0 = 0; d0 < 12; ++d0) qr[d0] = *reinterpret_cast<const bf16x8*>(Qw + d0 * 16);
  const bf16_t* Vh = Kn + 128;
  const int sr = tid >> 4, sc = (tid & 15) * 8, vst0 = v_st(sr, sc), vst1 = v_st(32 + sr, sc);
  int krow[3], kcc[3];
#pragma unroll
  for (int i = 0; i < 3; ++i) { const int id = tid + 512 * i; krow[i] = id / 24; kcc[i] = id % 24; }
  const int vb0 = (int)(uintptr_t)V_lds + v_rd_base(lane);
  bf16x8 vs0, vs1, ks0, ks1, ks2;
#define KSRC(i, k0) (kcc[i] < 16 ? (Kn + (long)((k0) + krow[i]) * LDKV + kcc[i] * 8) : (Kr + (long)((k0) + krow[i]) * LDKR + (kcc[i] - 16) * 8))
#define SLOAD(k0) do { vs0 = *reinterpret_cast<const bf16x8*>(&Vh[(long)((k0) + sr) * LDKV + sc]); vs1 = *reinterpret_cast<const bf16x8*>(&Vh[(long)((k0) + 32 + sr) * LDKV + sc]); \
    ks0 = *reinterpret_cast<const bf16x8*>(KSRC(0, k0)); ks1 = *reinterpret_cast<const bf16x8*>(KSRC(1, k0)); ks2 = *reinterpret_cast<const bf16x8*>(KSRC(2, k0)); } while (0)
#define SWRITE(b) do { *(bf16x8*)(V_lds + (b) * SHM_V + vst0) = vs0; *(bf16x8*)(V_lds + (b) * SHM_V + vst1) = vs1; \
    *(bf16x8*)(K_lds + (b) * SHM_K + krow[0] * KROWB + kcc[0] * 16) = ks0; *(bf16x8*)(K_lds + (b) * SHM_K + krow[1] * KROWB + kcc[1] * 16) = ks1; \
    *(bf16x8*)(K_lds + (b) * SHM_K + krow[2] * KROWB + kcc[2] * 16) = ks2; } while (0)
#define SWAIT() asm volatile("s_waitcnt vmcnt(0)" ::: "memory")
#define RESC(a) do { if (__any((a) < 1.f)) { if (hi == 0) al_l[r32] = (a); asm volatile("s_waitcnt lgkmcnt(0)" ::: "memory"); \
    _Pragma("unroll") for (int d = 0; d < 4; ++d) _Pragma("unroll") for (int r = 0; r < 16; ++r) o[d][r] *= al_l[crow(r, hi)]; } } while (0)
  f32x16 pA0, pA1; float mnA, alA; bf16x8 pa0, pa1, pa2, pa3; const int NT = seq / KVBLK;
  SLOAD(0); SWAIT(); SWRITE(0); __syncthreads();
  for (int j = 0; j < NT; ++j) {
    const int b = j & 1;
    if (j + 1 < NT) SLOAD((j + 1) * KVBLK);
    SBAR(); qkt(pA0, pA1, K_lds + b * SHM_K, qr, r32, hi);
    partialSM(pA0, pA1, m_reg, mnA, alA);
    RESC(alA);
    finishSM(pA0, pA1, alA, l_reg, pa0, pa1, pa2, pa3); SBAR();
    pv_d0(o, vb0 + b * (int)SHM_V, pa0, pa1, pa2, pa3);
    if (j + 1 < NT) { SWAIT(); SWRITE(b ^ 1); }
    __syncthreads();
  }
  if (hi == 0) li_l[r32] = l_reg; asm volatile("s_waitcnt lgkmcnt(0)" ::: "memory");
  float rli[16];
#pragma unroll
  for (int r = 0; r < 16; ++r) rli[r] = __builtin_amdgcn_rcpf(li_l[crow(r, hi)]);
  bf16_t* Ow = Ob + (long)(wid * QBLK) * LDO;
#pragma unroll
  for (int r = 0; r < 16; ++r) { const int orow = crow(r, hi);
#pragma unroll
    for (int d0 = 0; d0 < 4; ++d0) Ow[(long)orow * LDO + d0 * 32 + r32] = f2bf(o[d0][r] * rli[r]); }
#undef KSRC
#undef SLOAD
#undef SWRITE
#undef SWAIT
#undef RESC
}
#undef SBAR
}
typedef const __attribute__((address_space(4))) Args* KArgs;
struct Ctx {
    KArgs a; float* out; unsigned char* ws;
    LAS unsigned char* lds;
    int tid, lane, wave, vcu, G, gw, NGW, bid;
    __device__ __forceinline__ const float* in(int i) const { return a->in[i]; }
};
__device__ __forceinline__ Ctx mk_ctx(unsigned char* lds_raw) {
    Ctx c; KArgs a = (KArgs)__builtin_amdgcn_kernarg_segment_ptr(); asm volatile("" : "+s"(a));
    c.a = a; c.out = a->out; c.ws = a->ws; c.lds = (LAS unsigned char*)lds_raw;
    c.tid = opaque_tid(); c.lane = c.tid & 63; c.wave = __builtin_amdgcn_readfirstlane(c.tid >> 6);
    c.G = (int)gridDim.x; c.bid = opaque_bid(); c.vcu = (c.G % 8 == 0) ? (c.bid % 8) * (c.G / 8) + c.bid / 8 : c.bid;
    c.gw = c.vcu * NWAVES + c.wave; c.NGW = c.G * NWAVES;
    return c;
}
__device__ __forceinline__ int tok_pos(int t) { return t < TP ? (t & (SP - 1)) : ((t - TP) & (SS - 1)); }

__device__ __forceinline__ void transpose_item(const float* W, int K, int N, bf16_t* WT, LAS float* scr, int item, int lane) {
    const int nblk = N / 32, kb = item / nblk, nb = item % nblk, k0 = 64 * kb, n0 = 32 * nb;
#pragma unroll 8
    for (int i = 0; i < 32; ++i) { const int kk = 2 * i + (lane >> 5); scr[kk * 33 + (lane & 31)] = W[(size_t)(k0 + kk) * N + n0 + (lane & 31)]; }
    LDS_WAIT(); asm volatile("" ::: "memory");
    const int c = lane & 7;
#pragma unroll
    for (int j = 0; j < 4; ++j) { const int n = (lane >> 3) + 8 * j; const LAS float* s = scr + (8 * c) * 33 + n;
        u32x4 o; o.x = cvt_pk_bf16(s[0 * 33], s[1 * 33]); o.y = cvt_pk_bf16(s[2 * 33], s[3 * 33]); o.z = cvt_pk_bf16(s[4 * 33], s[5 * 33]); o.w = cvt_pk_bf16(s[6 * 33], s[7 * 33]);
        *(u32x4*)(WT + (size_t)(n0 + n) * K + k0 + 8 * c) = o; }
    LDS_WAIT(); asm volatile("" ::: "memory");
}
struct MatDesc { int in_idx, K, N, Npad, copies; size_t dst; };
__device__ __forceinline__ void p0_prologue(const Ctx& c) {
    LAS float* scr = (LAS float*)(c.lds + c.wave * 16384);
    const MatDesc MATS[9] = {
        {4, 1024, 704, 768, 2, W_WA}, {7, 384, 1536, 1536, 2, W_WUQ}, {8, 256, 2048, 2048, 2, W_WUKV}, {9, 1024, 1024, 1024, 2, W_WO},
        {10, 1024, 5120, 5120, 2, W_HIN}, {13, 1024, 1024, 1024, 2, W_HO}, {14, 1024, 2048, 2048, 4, W_PQ}, {22, 1024, 1024, 1024, 4, W_GW}, {24, 256, 1024, 1024, 4, W_PP}};
    int total = 0;
#pragma unroll
    for (int m = 0; m < 9; ++m) total += MATS[m].copies * (MATS[m].K / 64) * (MATS[m].N / 32);
    for (int it = c.gw; it < total; it += c.NGW) {
        int r = it;
#pragma unroll
        for (int m = 0; m < 9; ++m) {
            const int per = (MATS[m].K / 64) * (MATS[m].N / 32), cnt = MATS[m].copies * per;
            if (r >= 0 && r < cnt) { const int cp = r / per, item = r % per;
                transpose_item(c.in(MATS[m].in_idx) + (size_t)cp * MATS[m].K * MATS[m].N, MATS[m].K, MATS[m].N,
                               (bf16_t*)(c.ws + MATS[m].dst) + (size_t)cp * MATS[m].Npad * MATS[m].K, scr, item, c.lane);
                r = -1; }
            else if (r >= 0) r -= cnt;
        }
    }
    const int gt = c.gw * 64 + c.lane, NGT = c.NGW * 64;
    for (int i = gt; i < 2 * 64 * 1024 / 8; i += NGT) { const int cp = i / (64 * 1024 / 8), o = i % (64 * 1024 / 8);
        *(u32x4*)((bf16_t*)(c.ws + W_WA) + (size_t)cp * 768 * 1024 + (size_t)704 * 1024 + o * 8) = (u32x4){0u, 0u, 0u, 0u}; }
    for (int i = gt; i < 4 * 2 * 128 * 128 / 4; i += NGT) { const f32x4 v = *(const f32x4*)(c.in(15) + (size_t)i * 4);
        u32x2 w; w.x = cvt_pk_bf16(v[0], v[1]); w.y = cvt_pk_bf16(v[2], v[3]); *(u32x2*)((bf16_t*)(c.ws + W_KEYS) + (size_t)i * 4) = w; }
    for (int i = gt; i < 8192 * 32; i += NGT) { const int pos = i >> 5, f = i & 31;
        const float inv = 1.0f / powf(10000.0f, (float)(2 * f) / 64.0f); const float ang = (float)pos * inv;
        ((float*)(c.ws + WS_ROPE))[i] = cosf(ang); ((float*)(c.ws + WS_ROPE))[8192 * 32 + i] = sinf(ang); }
    for (int i = gt; i < 2 * 1024; i += NGT) { const int dir = i >> 10, k = i & 1023;
        const float l0 = c.in(11)[(dir * 2 + 0) * 1024 + k], l1 = c.in(11)[(dir * 2 + 1) * 1024 + k];
        float* lb = (float*)(c.ws + WS_MISC);
        lb[(0 * 2 + dir) * 1024 + k] = 0.f; lb[(1 * 2 + dir) * 1024 + k] = 1.0f / (1.0f + expf(l0 - l1)); }
    for (int t = c.gw; t < T; t += c.NGW) {
        const float* xr = t < TP ? c.in(0) + (size_t)t * D : c.in(1) + (size_t)(t - TP) * D;
        float* orow = c.out + (size_t)t * D; bf16_t* brow = (bf16_t*)(c.ws + WS_R2) + (size_t)t * D;
#pragma unroll
        for (int j = 0; j < 4; ++j) { const f32x4 v = *(const f32x4*)(xr + 256 * j + 4 * c.lane); *(f32x4*)(orow + 256 * j + 4 * c.lane) = v;
            u32x2 w; w.x = cvt_pk_bf16(v[0], v[1]); w.y = cvt_pk_bf16(v[2], v[3]); *(u32x2*)(brow + 256 * j + 4 * c.lane) = w; }
    }
}

__device__ __forceinline__ void cvt_range(const float* src, bf16_t* dst, size_t n8, int gt, int NGT) {
    for (size_t i = gt; i < n8; i += NGT) { const f32x4 a = *(const f32x4*)(src + i * 8), b = *(const f32x4*)(src + i * 8 + 4);
        u32x4 w; w.x = cvt_pk_bf16(a[0], a[1]); w.y = cvt_pk_bf16(a[2], a[3]); w.z = cvt_pk_bf16(b[0], b[1]); w.w = cvt_pk_bf16(b[2], b[3]); *(u32x4*)(dst + i * 8) = w; }
}
__device__ __forceinline__ void l0_convert(const Ctx& c, int layer) {
    const int gt = c.gw * 64 + c.lane, NGT = c.NGW * 64;
    for (int r = c.gw; r < 2 * NEXP; r += c.NGW) {
        const int m = r >= NEXP, e = r - m * NEXP;
        const float* src = c.in(16 + m) + ((size_t)layer * NEXP + e) * D + 16 * c.lane;
        f32x4 v[4]; float am = 0.f;
#pragma unroll
        for (int j = 0; j < 4; ++j) { v[j] = *(const f32x4*)(src + 4 * j); am = fmaxf(am, fmaxf(fmaxf(fabsf(v[j][0]), fabsf(v[j][1])), fmaxf(fabsf(v[j][2]), fabsf(v[j][3])))); }
#pragma unroll
        for (int o = 1; o < 64; o <<= 1) am = fmaxf(am, __shfl_xor(am, o));
        const float sc = fmaxf(am, 1e-30f) * (1.0f / 440.0f), inv = 1.0f / sc;
        u32x4 w;
#pragma unroll
        for (int j = 0; j < 4; ++j) { int p = 0; p = __builtin_amdgcn_cvt_pk_fp8_f32(v[j][0] * inv, v[j][1] * inv, p, false); p = __builtin_amdgcn_cvt_pk_fp8_f32(v[j][2] * inv, v[j][3] * inv, p, true); w[j] = (unsigned)p; }
        *(u32x4*)(c.ws + (m ? R2_VB : R2_UB) + (size_t)e * D + 16 * c.lane) = w;
        if (c.lane == 0) ((float*)(c.ws + (m ? R2_SV : R2_SU)))[e] = sc;
    }
    cvt_range(c.in(2) + (size_t)layer * TP * 256, (bf16_t*)(c.ws + R2_PB), (size_t)TP * 256 / 8, gt, NGT);
    cvt_range(c.in(3) + (size_t)layer * TS * 256, (bf16_t*)(c.ws + R2_PB) + (size_t)TP * 256, (size_t)TS * 256 / 8, gt, NGT);
}

__device__ __forceinline__ void mla_e1(const Ctx& c, int j) {
    const float* a32 = (const float*)(c.ws + B_A32); bf16_t* cqn = (bf16_t*)(c.ws + B_CQN); bf16_t* ckvn = (bf16_t*)(c.ws + B_CKVN); bf16_t* krope = (bf16_t*)(c.ws + B_KROPE);
    const float* qnw = c.in(5) + j * 384; const float* kvnw = c.in(6) + j * 256;
    const float* cosT = (const float*)(c.ws + WS_ROPE); const float* sinT = cosT + 8192 * 32;
    LAS float* scr = (LAS float*)(c.lds + c.wave * 1024);
    const int lane = c.lane;
    for (int t = c.gw; t < T; t += c.NGW) {
        const float* ar = a32 + (size_t)t * 768;
        const f32x4 v0 = *(const f32x4*)(ar + 4 * lane), v1 = *(const f32x4*)(ar + 256 + 4 * lane), v2 = *(const f32x4*)(ar + 512 + 4 * lane);
        const float s0 = v0[0] * v0[0] + v0[1] * v0[1] + v0[2] * v0[2] + v0[3] * v0[3];
        const float s1 = v1[0] * v1[0] + v1[1] * v1[1] + v1[2] * v1[2] + v1[3] * v1[3];
        const float s2 = v2[0] * v2[0] + v2[1] * v2[1] + v2[2] * v2[2] + v2[3] * v2[3];
        const float ssq = wave_sum(s0 + (lane < 32 ? s1 : 0.f));
        const float sskv = wave_sum((lane >= 32 ? s1 : 0.f) + (lane < 32 ? s2 : 0.f));
        const float rq = 1.0f / sqrtf(ssq * (1.0f / 384.0f) + RMS_EPS), rkv = 1.0f / sqrtf(sskv * (1.0f / 256.0f) + RMS_EPS);
        { const f32x4 w = *(const f32x4*)(qnw + 4 * lane); u32x2 o; o.x = cvt_pk_bf16(v0[0] * rq * w[0], v0[1] * rq * w[1]); o.y = cvt_pk_bf16(v0[2] * rq * w[2], v0[3] * rq * w[3]);
          *(u32x2*)(cqn + (size_t)t * 384 + 4 * lane) = o; }
        if (lane < 32) { const f32x4 w = *(const f32x4*)(qnw + 256 + 4 * lane); u32x2 o; o.x = cvt_pk_bf16(v1[0] * rq * w[0], v1[1] * rq * w[1]); o.y = cvt_pk_bf16(v1[2] * rq * w[2], v1[3] * rq * w[3]);
          *(u32x2*)(cqn + (size_t)t * 384 + 256 + 4 * lane) = o; }
        else { const int ix = 4 * (lane - 32); const f32x4 w = *(const f32x4*)(kvnw + ix); u32x2 o; o.x = cvt_pk_bf16(v1[0] * rkv * w[0], v1[1] * rkv * w[1]); o.y = cvt_pk_bf16(v1[2] * rkv * w[2], v1[3] * rkv * w[3]);
          *(u32x2*)(ckvn + (size_t)t * 256 + ix) = o; }
        if (lane < 32) { const int ix = 128 + 4 * lane; const f32x4 w = *(const f32x4*)(kvnw + ix); u32x2 o; o.x = cvt_pk_bf16(v2[0] * rkv * w[0], v2[1] * rkv * w[1]); o.y = cvt_pk_bf16(v2[2] * rkv * w[2], v2[3] * rkv * w[3]);
          *(u32x2*)(ckvn + (size_t)t * 256 + ix) = o; }
        else if (lane < 48) { *(LAS f32x4*)(scr + 4 * (lane - 32)) = v2; }
        LDS_WAIT(); asm volatile("" ::: "memory");
        if (lane < 32) { const int pos = tok_pos(t); const float a = scr[lane], b = scr[lane + 32], cs = cosT[pos * 32 + lane], sn = sinT[pos * 32 + lane];
            krope[(size_t)t * 64 + lane] = f2bf(a * cs - b * sn); krope[(size_t)t * 64 + 32 + lane] = f2bf(b * cs + a * sn); }
        LDS_WAIT(); asm volatile("" ::: "memory");
    }
}
__device__ __forceinline__ void mla_qrope(const Ctx& c) {
    bf16_t* q = (bf16_t*)(c.ws + B_Q);
    const float* cosT = (const float*)(c.ws + WS_ROPE); const float* sinT = cosT + 8192 * 32;
    const int lane = c.lane, i = lane & 31;
    for (int t = c.gw; t < T; t += c.NGW) {
        const int pos = tok_pos(t); const float cs = cosT[pos * 32 + i], sn = sinT[pos * 32 + i];
#pragma unroll
        for (int k = 0; k < 4; ++k) { const int h = (lane >> 5) + 2 * k; bf16_t* p = q + (size_t)t * 1536 + h * 192 + 128 + i;
            const float a = bf2f(p[0]), b = bf2f(p[32]); p[0] = f2bf(a * cs - b * sn); p[32] = f2bf(b * cs + a * sn); }
    }
}
__device__ __forceinline__ void mla_attention(const Ctx& c) {
    const bf16_t* Q = (const bf16_t*)(c.ws + B_Q); const bf16_t* KV = (const bf16_t*)(c.ws + B_KV); const bf16_t* KR = (const bf16_t*)(c.ws + B_KROPE); bf16_t* O = (bf16_t*)(c.ws + B_O);
    const int NU = 512 + 2048;
    for (int u = c.bid; u < NU; u += c.G) {
        int tok0, qb, h, seq;
        if (u < 512) { const int round = u >> 8, cc = u & 255, bh = round * 8 + (cc & 7); tok0 = (bh >> 3) * SP; h = bh & 7; qb = cc >> 3; seq = SP; }
        else { const int us = u - 512, round = us >> 8, cc = us & 255, r = cc >> 3, bh = round * 32 + (cc & 7) * 4 + (r >> 3); tok0 = TP + (bh >> 3) * SS; h = bh & 7; qb = r & 7; seq = SS; }
        attn::attn_body(Q + (size_t)(tok0 + qb * 256) * 1536 + h * 192, KV + (size_t)tok0 * 2048 + h * 256, KR + (size_t)tok0 * 64,
                        O + (size_t)(tok0 + qb * 256) * 1024 + h * 128, seq, (char*)c.lds);
        __syncthreads();
    }
}
__device__ __forceinline__ void ln_residual(const Ctx& c, const float* h32, const float* g, const float* b) {
    bf16_t* xb = (bf16_t*)(c.ws + WS_XB); const int lane = c.lane;
    for (int t = c.gw; t < T; t += c.NGW) {
        float* xr = c.out + (size_t)t * D; const float* hr = h32 + (size_t)t * D;
        f32x4 v[4]; float s = 0.f;
#pragma unroll
        for (int j = 0; j < 4; ++j) { const f32x4 x = *(const f32x4*)(xr + 256 * j + 4 * lane), hh = *(const f32x4*)(hr + 256 * j + 4 * lane); v[j] = x * DN_ALPHA + hh; s += (v[j][0] + v[j][1]) + (v[j][2] + v[j][3]); }
        const float mean = wave_sum(s) * (1.0f / D); float s2 = 0.f;
#pragma unroll
        for (int j = 0; j < 4; ++j) { v[j] = v[j] - mean; s2 += (v[j][0] * v[j][0] + v[j][1] * v[j][1]) + (v[j][2] * v[j][2] + v[j][3] * v[j][3]); }
        const float rstd = 1.0f / sqrtf(wave_sum(s2) * (1.0f / D) + LN_EPS);
#pragma unroll
        for (int j = 0; j < 4; ++j) { const f32x4 gg = *(const f32x4*)(g + 256 * j + 4 * lane), bb = *(const f32x4*)(b + 256 * j + 4 * lane); const f32x4 o = v[j] * rstd * gg + bb;
            *(f32x4*)(xr + 256 * j + 4 * lane) = o; u32x2 w; w.x = cvt_pk_bf16(o[0], o[1]); w.y = cvt_pk_bf16(o[2], o[3]); *(u32x2*)(xb + (size_t)t * D + 256 * j + 4 * lane) = w; }
    }
}
__device__ __forceinline__ void hgrn_post(const Ctx& c, int j) {
    bf16_t* pl = (bf16_t*)(c.ws + B_PLANE); const size_t PE = (size_t)T * 1024;
    const bf16_t* of = pl + 1 * PE; const bf16_t* ob = pl + 2 * PE; const bf16_t* sg = pl + 4 * PE; bf16_t* on = pl;
    const float* nw = c.in(12) + j * 128; const int lane = c.lane;
    for (int t = c.gw; t < T; t += c.NGW) {
#pragma unroll
        for (int k = 0; k < 2; ++k) { const size_t off = (size_t)t * 1024 + 512 * k + 8 * lane;
            const u32x4 a = *(const u32x4*)(of + off), b = *(const u32x4*)(ob + off), g = *(const u32x4*)(sg + off);
            float o[8]; o[0] = bflo(a.x) + bflo(b.x); o[1] = bfhi(a.x) + bfhi(b.x); o[2] = bflo(a.y) + bflo(b.y); o[3] = bfhi(a.y) + bfhi(b.y);
            o[4] = bflo(a.z) + bflo(b.z); o[5] = bfhi(a.z) + bfhi(b.z); o[6] = bflo(a.w) + bflo(b.w); o[7] = bfhi(a.w) + bfhi(b.w);
            float ss = 0.f;
#pragma unroll
            for (int e = 0; e < 8; ++e) ss += o[e] * o[e];
            ss += __shfl_xor(ss, 1); ss += __shfl_xor(ss, 2); ss += __shfl_xor(ss, 4); ss += __shfl_xor(ss, 8);
            const float r = 1.0f / sqrtf(ss * (1.0f / 128.0f) + RMS_EPS);
            const int cw = (8 * lane) & 127; const f32x4 w0 = *(const f32x4*)(nw + cw), w1 = *(const f32x4*)(nw + cw + 4);
            float gg[8]; gg[0] = bflo(g.x); gg[1] = bfhi(g.x); gg[2] = bflo(g.y); gg[3] = bfhi(g.y); gg[4] = bflo(g.z); gg[5] = bfhi(g.z); gg[6] = bflo(g.w); gg[7] = bfhi(g.w);
            u32x4 w; w.x = cvt_pk_bf16(o[0] * r * w0[0] * gg[0], o[1] * r * w0[1] * gg[1]); w.y = cvt_pk_bf16(o[2] * r * w0[2] * gg[2], o[3] * r * w0[3] * gg[3]);
            w.z = cvt_pk_bf16(o[4] * r * w1[0] * gg[4], o[5] * r * w1[1] * gg[5]); w.w = cvt_pk_bf16(o[6] * r * w1[2] * gg[6], o[7] * r * w1[3] * gg[7]);
            *(u32x4*)(on + off) = w; }
    }
}
namespace scan {
constexpr int QT_OFF = 0, KT_OFF = 8704, KHT_OFF = 17408, VT_OFF = 27648, P_OFF = 37888, ST_OFF = 40448, DV_OFF = 75264, TOT_OFF = 75776, CHAIN_BYTES = 76800;
constexpr int RS = 272, RS2 = 80;
__device__ __forceinline__ int crow(int r, int hi) { return (r & 3) + 8 * (r >> 2) + 4 * hi; }

__device__ __forceinline__ void run_pair(const Ctx& c, int tok0, int L, int h, bool dummy) {
    bf16_t* pl = (bf16_t*)(c.ws + B_PLANE); const size_t PE = (size_t)T * 1024;
    const int tid = c.tid, lane = c.lane, wave = c.wave, ch = wave >> 2, w = wave & 3, r32 = lane & 31, hi = lane >> 5;
    const bf16_t* qs = pl; bf16_t* lf = pl + (size_t)(1 + ch) * PE; const bf16_t* vv = pl + 3 * PE;
    bf16_t* odst = dummy ? (bf16_t*)(c.ws + WS_XB) : lf;
    LAS unsigned char* base = c.lds + ch * CHAIN_BYTES;
    const int ctid = tid & 255, k = ctid & 127, th = ctid >> 7, tau0 = 16 * th;
    const int NC = L / 32;
    const int vcol = 32 * w + r32;
    { LAS u32x4* st = (LAS u32x4*)(base + ST_OFF + (32 * w) * RS); for (int i = lane; i < 32 * RS / 16; i += 64) st[i] = (u32x4){0u, 0u, 0u, 0u}; }
    f32x16 S[4];
#pragma unroll
    for (int kt = 0; kt < 4; ++kt) S[kt] = f32x16{};
    __syncthreads();
    for (int ci = 0; ci < NC; ++ci) {
        float lfv[16], qv[16], vvv[16];
#pragma unroll
        for (int i = 0; i < 16; ++i) { const int tau = tau0 + i; const int t = ch ? (tok0 + L - 1 - 32 * ci - tau) : (tok0 + 32 * ci + tau); const size_t off = (size_t)t * 1024 + h * 128 + k;
            lfv[i] = bf2f(lf[off]); qv[i] = bf2f(qs[off]); vvv[i] = bf2f(vv[off]); }
        float bl[16]; { float run = 0.f;
#pragma unroll
            for (int i = 0; i < 16; ++i) { run += lfv[i]; bl[i] = run; } }
        LAS float* tot = (LAS float*)(base + TOT_OFF);
        tot[th * 128 + k] = bl[15];
        __syncthreads();
        { const float t0 = tot[k], t1 = tot[128 + k]; const float off = th ? t0 : 0.f, blast = t0 + t1;
          unsigned khp[8], vtp[8];
          float khv[16];
#pragma unroll
          for (int i = 0; i < 16; ++i) { const float bt = bl[i] + off; const float E = fast_exp(bt), Ei = fast_exp(fminf(-bt, 80.f)); const float kk = 1.0f - fast_exp(lfv[i]);
              *(LAS bf16_t*)(base + QT_OFF + (tau0 + i) * RS + k * 2) = f2bf(qv[i] * E);
              *(LAS bf16_t*)(base + KT_OFF + (tau0 + i) * RS + k * 2) = f2bf(kk * Ei);
              khv[i] = kk * fast_exp(blast - bt); }
#pragma unroll
          for (int i = 0; i < 8; ++i) { khp[i] = cvt_pk_bf16(khv[2 * i], khv[2 * i + 1]); vtp[i] = cvt_pk_bf16(vvv[2 * i], vvv[2 * i + 1]); }
          *(LAS u32x4*)(base + KHT_OFF + k * RS2 + tau0 * 2) = (u32x4){khp[0], khp[1], khp[2], khp[3]};
          *(LAS u32x4*)(base + KHT_OFF + k * RS2 + tau0 * 2 + 16) = (u32x4){khp[4], khp[5], khp[6], khp[7]};
          *(LAS u32x4*)(base + VT_OFF + k * RS2 + tau0 * 2) = (u32x4){vtp[0], vtp[1], vtp[2], vtp[3]};
          *(LAS u32x4*)(base + VT_OFF + k * RS2 + tau0 * 2 + 16) = (u32x4){vtp[4], vtp[5], vtp[6], vtp[7]};
          if (th == 0) *(LAS float*)(base + DV_OFF + k * 4) = fast_exp(blast);
        }
        __syncthreads();
        bf16x8 qa[8];
        f32x16 X = f32x16{};
#pragma unroll
        for (int ks = 0; ks < 8; ++ks) { qa[ks] = *(const LAS bf16x8*)(base + QT_OFF + r32 * RS + (16 * ks + 8 * hi) * 2);
            const bf16x8 kb = *(const LAS bf16x8*)(base + KT_OFF + r32 * RS + (16 * ks + 8 * hi) * 2);
            X = __builtin_amdgcn_mfma_f32_32x32x16_bf16(qa[ks], kb, X, 0, 0, 0); }
        if (w == 0) {
#pragma unroll
        for (int r = 0; r < 16; ++r) { const int t = crow(r, hi); *(LAS bf16_t*)(base + P_OFF + t * RS2 + r32 * 2) = f2bf(t >= r32 ? X[r] : 0.f); }
        }
        __syncthreads();
        bf16x8 vb[2];
        f32x16 O = f32x16{};
#pragma unroll
        for (int ks = 0; ks < 2; ++ks) { const bf16x8 pa = *(const LAS bf16x8*)(base + P_OFF + r32 * RS2 + (16 * ks + 8 * hi) * 2);
            vb[ks] = *(const LAS bf16x8*)(base + VT_OFF + vcol * RS2 + (16 * ks + 8 * hi) * 2);
            O = __builtin_amdgcn_mfma_f32_32x32x16_bf16(pa, vb[ks], O, 0, 0, 0); }
#pragma unroll
        for (int ks = 0; ks < 8; ++ks) { const bf16x8 sb = *(const LAS bf16x8*)(base + ST_OFF + vcol * RS + (16 * ks + 8 * hi) * 2);
            O = __builtin_amdgcn_mfma_f32_32x32x16_bf16(qa[ks], sb, O, 0, 0, 0); }
#pragma unroll
        for (int r = 0; r < 16; ++r) { const int tau = crow(r, hi); const int t = ch ? (tok0 + L - 1 - 32 * ci - tau) : (tok0 + 32 * ci + tau);
            odst[(size_t)t * 1024 + h * 128 + vcol] = f2bf(O[r]); }
#pragma unroll
        for (int kt = 0; kt < 4; ++kt) {
#pragma unroll
            for (int g = 0; g < 4; ++g) { const f32x4 d4 = *(const LAS f32x4*)(base + DV_OFF + (32 * kt + 8 * g + 4 * hi) * 4);
#pragma unroll
                for (int e = 0; e < 4; ++e) S[kt][4 * g + e] *= d4[e]; }
#pragma unroll
            for (int ks = 0; ks < 2; ++ks) { const bf16x8 ka = *(const LAS bf16x8*)(base + KHT_OFF + (32 * kt + r32) * RS2 + (16 * ks + 8 * hi) * 2);
                S[kt] = __builtin_amdgcn_mfma_f32_32x32x16_bf16(ka, vb[ks], S[kt], 0, 0, 0); }
#pragma unroll
            for (int g = 0; g < 4; ++g) { u32x2 pk; pk.x = cvt_pk_bf16(S[kt][4 * g], S[kt][4 * g + 1]); pk.y = cvt_pk_bf16(S[kt][4 * g + 2], S[kt][4 * g + 3]);
                *(LAS u32x2*)(base + ST_OFF + vcol * RS + (32 * kt + 8 * g + 4 * hi) * 2) = pk; }
        }
        __syncthreads();
    }
}
__device__ __forceinline__ void hgrn_scan(const Ctx& c, bool dummy) {
    const int NP = 16 + 256;
    for (int rnd = 0;; ++rnd) {
        const int p = (rnd & 1) ? (rnd * c.G + (c.G - 1 - c.bid)) : (rnd * c.G + c.bid);
        if (rnd * c.G >= NP) break;
        if (p < NP) {
            const int tok0 = p < 16 ? (p >> 3) * SP : TP + ((p - 16) >> 3) * SS, L = p < 16 ? SP : SS, h = p < 16 ? (p & 7) : ((p - 16) & 7);
            run_pair(c, tok0, L, h, dummy);
        }
    }
}
}
namespace peer {
constexpr int KEY_RS = 272;
constexpr int KEYS_BYTES = 2 * 128 * KEY_RS;
constexpr int SI_OFF = KEYS_BYTES;
__device__ __forceinline__ int crow(int r, int hi) { return (r & 3) + 8 * (r >> 2) + 4 * hi; }
__device__ __forceinline__ unsigned sortable(float f) { const unsigned u = __float_as_uint(f); return u ^ ((u >> 31) ? 0xFFFFFFFFu : 0x80000000u); }
__device__ __forceinline__ float unsortable(unsigned s) { const unsigned u = (s >> 31) ? (s ^ 0x80000000u) : ~s; return __uint_as_float(u); }
__device__ __forceinline__ unsigned pair_max(unsigned m) { auto rr = __builtin_amdgcn_permlane32_swap(m, m, false, false); return rr[0] > rr[1] ? rr[0] : rr[1]; }

__device__ __forceinline__ void top16_half(const Ctx& c, const bf16_t* pq_rows, int half, LAS unsigned char* keys, unsigned (&sel)[16]) {
    const int lane = c.lane, r32 = lane & 31, hi = lane >> 5;
    f32x16 acc[4];
#pragma unroll
    for (int nt = 0; nt < 4; ++nt) acc[nt] = f32x16{};
    const bf16_t* qrow = pq_rows + (size_t)r32 * 256 + half * 128;
#pragma unroll 1
    for (int ks = 0; ks < 8; ++ks) { const bf16x8 qb = *reinterpret_cast<const bf16x8*>(qrow + 16 * ks + 8 * hi);
#pragma unroll
        for (int nt = 0; nt < 4; ++nt) { const bf16x8 ka = *(const LAS bf16x8*)(keys + (half * 128 + 32 * nt + r32) * KEY_RS + (16 * ks + 8 * hi) * 2);
            acc[nt] = __builtin_amdgcn_mfma_f32_32x32x16_bf16(ka, qb, acc[nt], 0, 0, 0); } }
    unsigned p[64];
#pragma unroll
    for (int nt = 0; nt < 4; ++nt)
#pragma unroll
        for (int r = 0; r < 16; ++r) { const int n = 32 * nt + crow(r, hi); p[nt * 16 + r] = (sortable(acc[nt][r]) & ~127u) | (unsigned)(127 - n); }
#pragma unroll
    for (int it = 0; it < 16; ++it) {
        unsigned m = p[0];
#pragma unroll
        for (int i = 1; i < 64; ++i) m = p[i] > m ? p[i] : m;
        m = pair_max(m); sel[it] = m;
#pragma unroll
        for (int i = 0; i < 64; ++i) p[i] = (p[i] == m) ? 0u : p[i];
    }
}
__device__ __forceinline__ void route(const Ctx& c, int layer) {
    const bf16_t* pq = (const bf16_t*)(c.ws + B_PQ); int* idx_out = (int*)(c.ws + R2_IDX); float* gate_out = (float*)(c.ws + R2_GATE);
    const bf16_t* keys_g = (const bf16_t*)(c.ws + W_KEYS) + (size_t)layer * 2 * 128 * 128;
    LAS unsigned char* keys = c.lds;
    const int lane = c.lane, r32 = lane & 31, hi = lane >> 5;
    for (int i = c.tid; i < 2 * 128 * 16; i += NTHR) { const int row = i >> 4, ch = i & 15; *(LAS u32x4*)(keys + row * KEY_RS + ch * 16) = *(const u32x4*)(keys_g + (size_t)row * 128 + ch * 8); }
    __syncthreads();
    LAS int* si = (LAS int*)(c.lds + SI_OFF + c.wave * 4096) + r32 * 32;
    for (int grp = c.gw; grp < T / 4; grp += c.NGW) {
        const bf16_t* rows = pq + (size_t)grp * 4 * 2048;
        unsigned s1[16], s2[16];
        top16_half(c, rows, 0, keys, s1);
        top16_half(c, rows, 1, keys, s2);
        float v1[16], v2[16];
#pragma unroll
        for (int i = 0; i < 16; ++i) { v1[i] = unsortable(s1[i] & ~127u); v2[i] = unsortable(s2[i] & ~127u); }
        if (hi == 0) {
#pragma unroll
            for (int i = 0; i < 16; ++i) { si[i] = 127 - (int)(s1[i] & 127u); si[16 + i] = 127 - (int)(s2[i] & 127u); }
        }
        float A[16], B[16];
#pragma unroll
        for (int i = 0; i < 16; ++i) { A[i] = hi ? v2[i] : v1[i]; B[i] = hi ? v1[i] : v2[i]; }
        unsigned cd[27]; int nc = 0;
#pragma unroll
        for (int i = 0; i < 16; ++i)
#pragma unroll
            for (int j = i; j < 16; ++j) if ((i + 1) * (j + 1) <= 16) {
                const unsigned flat = hi ? (unsigned)(j * 16 + i) : (unsigned)(i * 16 + j);
                unsigned pk = (sortable(A[i] + B[j]) & ~255u) | (255u - flat);
                if (i == j) pk = hi ? 0u : pk;
                cd[nc++] = pk; }
        unsigned sel[16];
#pragma unroll
        for (int it = 0; it < 16; ++it) {
            unsigned m = cd[0];
#pragma unroll
            for (int i = 1; i < 27; ++i) m = cd[i] > m ? cd[i] : m;
            m = pair_max(m); sel[it] = m;
#pragma unroll
            for (int i = 0; i < 27; ++i) cd[i] = (cd[i] == m) ? 0u : cd[i];
        }
        LDS_WAIT(); asm volatile("" ::: "memory");
        const float vmax = unsortable(sel[0] & ~255u);
        float e[16], es = 0.f;
#pragma unroll
        for (int i = 0; i < 16; ++i) { e[i] = fast_exp(unsortable(sel[i] & ~255u) - vmax); es += e[i]; }
        const float inv = 1.0f / es;
        const size_t obase = ((size_t)grp * 4 + (r32 >> 3)) * 128 + (r32 & 7) * 16 + 8 * hi;
        int oi[8]; float og[8];
#pragma unroll
        for (int q = 0; q < 8; ++q) { const unsigned sv = hi ? sel[8 + q] : sel[q]; const float ev = hi ? e[8 + q] : e[q];
            const int flat = 255 - (int)(sv & 255u); oi[q] = si[flat >> 4] * 128 + si[16 + (flat & 15)]; og[q] = ev * inv; }
        *(u32x4*)(idx_out + obase) = (u32x4){(unsigned)oi[0], (unsigned)oi[1], (unsigned)oi[2], (unsigned)oi[3]};
        *(u32x4*)(idx_out + obase + 4) = (u32x4){(unsigned)oi[4], (unsigned)oi[5], (unsigned)oi[6], (unsigned)oi[7]};
        *(f32x4*)(gate_out + obase) = (f32x4){og[0], og[1], og[2], og[3]};
        *(f32x4*)(gate_out + obase + 4) = (f32x4){og[4], og[5], og[6], og[7]};
        LDS_WAIT(); asm volatile("" ::: "memory");
    }
    __syncthreads();
}

__device__ __forceinline__ float gelu_exact(float x) { return 0.5f * x * (1.0f + erff(x * 0.70710678118654752f)); }
__device__ __forceinline__ void gather_ln(const Ctx& c, int layer, float* xout, bf16_t* xb) {
    const unsigned char* U8 = c.ws + R2_UB; const unsigned char* V8 = c.ws + R2_VB;
    const float* su = (const float*)(c.ws + R2_SU); const float* sv = (const float*)(c.ws + R2_SV);
    const int* idx = (const int*)(c.ws + R2_IDX); const float* gate = (const float*)(c.ws + R2_GATE);
    const float* lg = c.in(20) + layer * D; const float* lbv = c.in(21) + layer * D;
    const int lane = c.lane;
    for (int t = c.gw; t < T; t += c.NGW) {
        const float* xr = c.out + (size_t)t * D + 16 * lane; float* xw = xout + (size_t)t * D + 16 * lane;
        float x[16], acc[16];
#pragma unroll
        for (int j = 0; j < 4; ++j) { const f32x4 a = *(const f32x4*)(xr + 4 * j); x[4 * j] = a[0]; x[4 * j + 1] = a[1]; x[4 * j + 2] = a[2]; x[4 * j + 3] = a[3]; }
#pragma unroll
        for (int e = 0; e < 16; ++e) acc[e] = 0.f;
        const int myidx0 = idx[(size_t)t * 128 + lane], myidx1 = idx[(size_t)t * 128 + 64 + lane];
        const float myg0 = gate[(size_t)t * 128 + lane], myg1 = gate[(size_t)t * 128 + 64 + lane];
        for (int eb = 0; eb < 128; eb += 8) {
            float part[8]; int ei[8];
#pragma unroll
            for (int q = 0; q < 8; ++q) { const int e = eb + q; ei[q] = __builtin_amdgcn_readlane(e < 64 ? myidx0 : myidx1, e & 63); }
            u32x4 vr[8];
#pragma unroll
            for (int q = 0; q < 8; ++q) vr[q] = *(const u32x4*)(V8 + (size_t)ei[q] * D + 16 * lane);
#pragma unroll
            for (int q = 0; q < 8; ++q) { const u32x4 a = *(const u32x4*)(U8 + (size_t)ei[q] * D + 16 * lane);
                float s = 0.f;
#pragma unroll
                for (int j = 0; j < 4; ++j) { const f32x2 lo = __builtin_amdgcn_cvt_pk_f32_fp8((int)a[j], false), hi = __builtin_amdgcn_cvt_pk_f32_fp8((int)a[j], true);
                    s = fmaf(lo[0], x[4 * j], s); s = fmaf(lo[1], x[4 * j + 1], s); s = fmaf(hi[0], x[4 * j + 2], s); s = fmaf(hi[1], x[4 * j + 3], s); }
                part[q] = s; }
            float r4[4], r2[2], r1;
            { const bool up = (lane & 32) != 0;
#pragma unroll
              for (int i = 0; i < 4; ++i) { const float send = up ? part[i] : part[4 + i]; const float keep = up ? part[4 + i] : part[i]; r4[i] = keep + __shfl_xor(send, 32); } }
            { const bool up = (lane & 16) != 0;
#pragma unroll
              for (int i = 0; i < 2; ++i) { const float send = up ? r4[i] : r4[2 + i]; const float keep = up ? r4[2 + i] : r4[i]; r2[i] = keep + __shfl_xor(send, 16); } }
            { const bool up = (lane & 8) != 0; const float send = up ? r2[0] : r2[1]; const float keep = up ? r2[1] : r2[0]; r1 = keep + __shfl_xor(send, 8); }
            r1 += __shfl_xor(r1, 4); r1 += __shfl_xor(r1, 2); r1 += __shfl_xor(r1, 1);
            const int myq = ((lane >> 5) & 1) * 4 + ((lane >> 4) & 1) * 2 + ((lane >> 3) & 1);
            const int me = eb + myq;
            const float g = __shfl(me < 64 ? myg0 : myg1, me & 63);
            const int mye = __shfl(me < 64 ? myidx0 : myidx1, me & 63);
            const float cf = g * gelu_exact(r1 * su[mye]) * sv[mye];
            float cq[8];
#pragma unroll
            for (int q = 0; q < 8; ++q) cq[q] = __int_as_float(__builtin_amdgcn_readlane(__float_as_int(cf), ((q >> 2) & 1) * 32 + ((q >> 1) & 1) * 16 + (q & 1) * 8));
#pragma unroll
            for (int q = 0; q < 8; ++q) { const float s = cq[q];
#pragma unroll
                for (int j = 0; j < 4; ++j) { const f32x2 lo = __builtin_amdgcn_cvt_pk_f32_fp8((int)vr[q][j], false), hi = __builtin_amdgcn_cvt_pk_f32_fp8((int)vr[q][j], true);
                    acc[4 * j] = fmaf(s, lo[0], acc[4 * j]); acc[4 * j + 1] = fmaf(s, lo[1], acc[4 * j + 1]); acc[4 * j + 2] = fmaf(s, hi[0], acc[4 * j + 2]); acc[4 * j + 3] = fmaf(s, hi[1], acc[4 * j + 3]); } }
        }
        float s = 0.f;
#pragma unroll
        for (int e = 0; e < 16; ++e) { acc[e] = fmaf(DN_ALPHA, x[e], acc[e]); s += acc[e]; }
        const float mean = wave_sum(s) * (1.0f / D); float s2 = 0.f;
#pragma unroll
        for (int e = 0; e < 16; ++e) { acc[e] -= mean; s2 += acc[e] * acc[e]; }
        const float rstd = 1.0f / sqrtf(wave_sum(s2) * (1.0f / D) + LN_EPS);
        float o[16];
#pragma unroll
        for (int j = 0; j < 4; ++j) { const f32x4 g4 = *(const f32x4*)(lg + 16 * lane + 4 * j), b4 = *(const f32x4*)(lbv + 16 * lane + 4 * j);
#pragma unroll
            for (int e = 0; e < 4; ++e) o[4 * j + e] = acc[4 * j + e] * rstd * g4[e] + b4[e];
            *(f32x4*)(xw + 4 * j) = (f32x4){o[4 * j], o[4 * j + 1], o[4 * j + 2], o[4 * j + 3]}; }
        u32x4 w0, w1; w0.x = cvt_pk_bf16(o[0], o[1]); w0.y = cvt_pk_bf16(o[2], o[3]); w0.z = cvt_pk_bf16(o[4], o[5]); w0.w = cvt_pk_bf16(o[6], o[7]);
        w1.x = cvt_pk_bf16(o[8], o[9]); w1.y = cvt_pk_bf16(o[10], o[11]); w1.z = cvt_pk_bf16(o[12], o[13]); w1.w = cvt_pk_bf16(o[14], o[15]);
        *(u32x4*)(xb + (size_t)t * D + 16 * lane) = w0; *(u32x4*)(xb + (size_t)t * D + 16 * lane + 8) = w1;
    }
}
}
__global__ void __launch_bounds__(256) k_checksum(const unsigned* p, size_t nwords, unsigned long long* dst) {
    unsigned long long acc = 0;
    for (size_t i = (size_t)blockIdx.x * 256 + threadIdx.x; i < nwords; i += (size_t)gridDim.x * 256) acc += (unsigned long long)p[i] * (unsigned long long)(2 * i + 1);
    for (int o = 32; o >= 1; o >>= 1) acc += __shfl_xor(acc, o);
    if ((threadIdx.x & 63) == 0) atomicAdd(dst, acc);
}
__global__ void __launch_bounds__(256) k_zero_out(float* out, size_t n) { for (size_t i = (size_t)blockIdx.x * 256 + threadIdx.x; i < n; i += (size_t)gridDim.x * 256) out[i] = 0.f; }
__global__ void k_report(const unsigned long long* tab, int nent, float* out) {
    if (threadIdx.x == 0 && blockIdx.x == 0) { int first = -1; for (int i = 0; i < nent; ++i) if (tab[i] != tab[nent + i]) { first = i; break; }
        out[0] = first < 0 ? 99000.f : 1000.f * (float)(first / 4 + 1); out[1] = first < 0 ? 0.f : (float)(first % 4); }
}
struct Reg { size_t off; size_t bytes; int in_out; };
static int phase_regions(int p, Reg* r) {
    int n = 0;
    auto add = [&](size_t off, size_t mib) { r[n].off = off; r[n].bytes = mib * MiB; r[n].in_out = 0; ++n; };
    auto addout = [&]() { r[n].off = 0; r[n].bytes = (size_t)T * D * 4; r[n].in_out = 1; ++n; };
    if (p == 0) { add(WS_W, 61); add(WS_R2, 160); addout(); return n; }
    int q = p - 1;
    for (int layer = 0; layer < NL; ++layer) {
        const int nm = (layer & 1) ? 5 : 7;
        if (q < nm) {
            if ((layer & 1) == 0) { switch (q) { case 0: add(B_A32, 240); break; case 1: add(R2_UB, 34); add(R2_PB, 40); add(B_CQN, 100); add(B_KROPE, 10); break; case 2: add(B_Q, 240); break; case 3: add(B_KV, 320); break;
                case 4: add(B_Q, 240); break; case 5: add(B_O, 160); break; case 6: add(B_H32_MLA, 320); break; } }
            else { switch (q) { case 0: add(B_PLANE, 800); break; case 1: add(R2_UB, 34); add(R2_PB, 40); break; case 2: add(B_PLANE + 160 * MiB, 320); break; case 3: add(B_PLANE, 160); break; case 4: add(B_H32_HGRN, 320); break; } }
            return n;
        }
        q -= nm;
        if (q < 6) { switch (q) { case 0: addout(); add(WS_XB, 160); break; case 1: add(B_PQ, 320); break; case 2: add(R2_IDX, 80); break; case 3: addout(); add(WS_XB, 160); break; case 4: add(B_PP, 160); break; case 5: addout(); add(WS_R2, 160); break; }
            return n; }
        q -= 6;
    }
    return n;
}
constexpr int N_PHASES = 1 + 2 * (7 + 6) + 2 * (5 + 6);

#ifndef PROBE_DUP
#define PROBE_DUP 0
#endif
#define PROBE_REP(bit, ...) if constexpr ((PROBE_DUP & (bit)) != 0) { __VA_ARGS__ }
template <class E> struct RepOk { static constexpr bool v = true; };
template <> struct RepOk<pg8::EpiPle> { static constexpr bool v = false; };
#define GEMM_REP_OK(EPI) RepOk<pg8::EPI>::v
#define GEMM_PHASE(EPI, Aptr, Bptr, NN, KK, ...) { pg8::Gemm g{(const bf16_t*)(Aptr), (const bf16_t*)(Bptr), T, (NN), (KK)}; pg8::StaticOrder S; S.init(T, (NN), c.G, c.bid); \
        pg8::EPI E{__VA_ARGS__}; pg8::gemm_phase<pg8::EPI, pg8::StaticOrder>(c.lds, g, S, E); if (GEMM_REP_OK(EPI)) { PROBE_REP(8, __syncthreads(); pg8::gemm_phase<pg8::EPI, pg8::StaticOrder>(c.lds, g, S, E);) } }

__global__ void __launch_bounds__(NTHR, 2) fwd_kernel(Args args) {
    extern __shared__ __attribute__((aligned(16))) unsigned char lds_raw[];
    volatile LAS unsigned* misc = (volatile LAS unsigned*)((LAS unsigned char*)lds_raw + LDS_MISC_OFF);
    if (threadIdx.x < 64) misc[threadIdx.x] = 0u;
    __syncthreads();
    const int lo = args.ph_lo, hi = args.ph_hi;
    XcdBarrier bar; bar.bar = (unsigned*)(args.ws + WS_CTL); bar.x = 0; bar.st = nullptr;
    if (hi - lo > 1) bar = xcd_barrier_post((unsigned*)(args.ws + WS_CTL), misc + 8);
    int ph = 0;
#define PH_BEGIN if (ph >= lo && ph < hi) { const Ctx c = mk_ctx(lds_raw); unsigned char* const ws = c.ws; (void)ws;
#define PH_END   if (ph + 1 < hi) xcd_barrier(bar); } ++ph;

    PH_BEGIN p0_prologue(c); PH_END

    for (int layer = 0; layer < NL; ++layer) {
        const int j = layer >> 1;
        if ((layer & 1) == 0) {
            PH_BEGIN GEMM_PHASE(EpiF32, ws + WS_R2, (const bf16_t*)(ws + W_WA) + (size_t)j * 768 * 1024, 768, 1024, (float*)(ws + B_A32), 768) PH_END
            PH_BEGIN l0_convert(c, layer); mla_e1(c, j); PH_END
            PH_BEGIN GEMM_PHASE(EpiBf16P, ws + B_CQN, (const bf16_t*)(ws + W_WUQ) + (size_t)j * 1536 * 384, 1536, 384, (bf16_t*)(ws + B_Q), 1536) PH_END
            PH_BEGIN GEMM_PHASE(EpiBf16P, ws + B_CKVN, (const bf16_t*)(ws + W_WUKV) + (size_t)j * 2048 * 256, 2048, 256, (bf16_t*)(ws + B_KV), 2048) PH_END
            PH_BEGIN mla_qrope(c); PH_END
            PH_BEGIN mla_attention(c); PROBE_REP(1, mla_attention(c);) PH_END
            PH_BEGIN GEMM_PHASE(EpiF32, ws + B_O, (const bf16_t*)(ws + W_WO) + (size_t)j * 1024 * 1024, 1024, 1024, (float*)(ws + B_H32_MLA), 1024) PH_END
        } else {
            PH_BEGIN GEMM_PHASE(EpiHgrn, ws + WS_R2, (const bf16_t*)(ws + W_HIN) + (size_t)j * 5120 * 1024, 5120, 1024, (bf16_t*)(ws + B_PLANE), (size_t)T * 1024, (const float*)(ws + WS_MISC) + (size_t)j * 2048) PH_END
            PH_BEGIN l0_convert(c, layer); PH_END
            PH_BEGIN PROBE_REP(16, scan::hgrn_scan(c, true); __syncthreads();) scan::hgrn_scan(c, false); PH_END
            PH_BEGIN hgrn_post(c, j); PH_END
            PH_BEGIN GEMM_PHASE(EpiF32, ws + B_PLANE, (const bf16_t*)(ws + W_HO) + (size_t)j * 1024 * 1024, 1024, 1024, (float*)(ws + B_H32_HGRN), 1024) PH_END
        }
        PH_BEGIN ln_residual(c, (const float*)(ws + ((layer & 1) ? B_H32_HGRN : B_H32_MLA)), c.in(18) + layer * D, c.in(19) + layer * D); PH_END
        PH_BEGIN GEMM_PHASE(EpiBf16P, ws + WS_XB, (const bf16_t*)(ws + W_PQ) + (size_t)layer * 2048 * 1024, 2048, 1024, (bf16_t*)(ws + B_PQ), 2048) PH_END
        PH_BEGIN peer::route(c, layer); PROBE_REP(2, peer::route(c, layer);) PH_END
        PH_BEGIN PROBE_REP(4, peer::gather_ln(c, layer, (float*)(ws + WS_BIG + 480 * MiB), (bf16_t*)(ws + WS_BIG + 320 * MiB)); __syncthreads();) peer::gather_ln(c, layer, c.out, (bf16_t*)(ws + WS_XB)); PH_END
        PH_BEGIN GEMM_PHASE(EpiBf16P, ws + R2_PB, (const bf16_t*)(ws + W_PP) + (size_t)layer * 1024 * 256, 1024, 256, (bf16_t*)(ws + B_PP), 1024) PH_END
        PH_BEGIN GEMM_PHASE(EpiPle, ws + WS_XB, (const bf16_t*)(ws + W_GW) + (size_t)layer * 1024 * 1024, 1024, 1024, c.out, (const bf16_t*)(ws + B_PP), c.in(23) + layer * D, (bf16_t*)(ws + WS_R2)) PH_END
    }
#undef PH_BEGIN
#undef PH_END
}

extern "C" void kernel_launch(void* const* d_in, const int* in_sizes, int n_in, void* d_out, int out_size, void* d_ws, size_t ws_size, hipStream_t stream) {
    static int grid = 0;
    if (grid == 0) {
        if (n_in != 25 || out_size != T * D || ws_size < WS_END) { fprintf(stderr, "kernel_launch: unexpected shapes: n_in %d out %d ws %zu (need %zu)\n", n_in, out_size, ws_size, (size_t)WS_END); grid = -1; return; }
        int dev = 0, cus = 0, per_cu = 0;
        if (hipGetDevice(&dev) != hipSuccess || hipDeviceGetAttribute(&cus, hipDeviceAttributeMultiprocessorCount, dev) != hipSuccess) { grid = -1; return; }
        if (hipFuncSetAttribute((const void*)fwd_kernel, hipFuncAttributeMaxDynamicSharedMemorySize, LDS_BYTES) != hipSuccess) { fprintf(stderr, "kernel_launch: hipFuncSetAttribute failed\n"); grid = -1; return; }
        if (hipOccupancyMaxActiveBlocksPerMultiprocessor(&per_cu, (const void*)fwd_kernel, NTHR, LDS_BYTES) != hipSuccess || per_cu < 1) { fprintf(stderr, "kernel_launch: occupancy query says %d\n", per_cu); }
        (void)hipGetLastError();
        grid = cus;
    }
    if (grid < 0) return;
    (void)hipMemsetAsync((char*)d_ws + WS_CTL, 0, CTL_ZERO_BYTES, stream);
    Args a{};
    for (int i = 0; i < 25; ++i) a.in[i] = (const float*)d_in[i];
    a.out = (float*)d_out; a.ws = (unsigned char*)d_ws;
#if defined(MK_DEBUG_DET)
    unsigned long long* tab = (unsigned long long*)((char*)d_ws + WS_CTL + 32 * 1024);
    for (int pass = 0; pass < 2; ++pass)
        for (int p = 0; p < N_PHASES; ++p) { a.ph_lo = p; a.ph_hi = p + 1; hipLaunchKernelGGL(fwd_kernel, dim3(grid), dim3(NTHR), LDS_BYTES, stream, a);
            Reg r[4]; const int nr = phase_regions(p, r);
            for (int i = 0; i < nr; ++i) hipLaunchKernelGGL(k_checksum, dim3(2048), dim3(256), 0, stream, (const unsigned*)(r[i].in_out ? (char*)d_out : (char*)d_ws + r[i].off), r[i].bytes / 4, tab + (size_t)pass * N_PHASES * 4 + p * 4 + i); }
    hipLaunchKernelGGL(k_zero_out, dim3(2048), dim3(256), 0, stream, (float*)d_out, (size_t)T * D);
    hipLaunchKernelGGL(k_report, dim3(1), dim3(64), 0, stream, tab, N_PHASES * 4, (float*)d_out);
#elif MK_ONE_LAUNCH
    a.ph_lo = 0; a.ph_hi = N_PHASES;
    hipLaunchKernelGGL(fwd_kernel, dim3(grid), dim3(NTHR), LDS_BYTES, stream, a);
#else
    for (int p = 0; p < N_PHASES; ++p) { a.ph_lo = p; a.ph_hi = p + 1; hipLaunchKernelGGL(fwd_kernel, dim3(grid), dim3(NTHR), LDS_BYTES, stream, a); }
#endif
}
```

```cpp
#include <hip/hip_runtime.h>
#include <cstdio>
#include <cstdint>

#ifndef MK_ONE_LAUNCH
#define MK_ONE_LAUNCH 1
#endif

#define GAS __attribute__((address_space(1)))
#define LAS __attribute__((address_space(3)))
typedef unsigned short bf16_t;
typedef short bf16x8 __attribute__((ext_vector_type(8)));
typedef short s16x4 __attribute__((ext_vector_type(4)));
typedef float f32x4 __attribute__((ext_vector_type(4)));
typedef float f32x2 __attribute__((ext_vector_type(2)));
typedef float f32x16 __attribute__((ext_vector_type(16)));
typedef unsigned u32x4 __attribute__((ext_vector_type(4)));
typedef unsigned u32x2 __attribute__((ext_vector_type(2)));

constexpr int D = 1024, TP = 16384, TS = 65536, T = TP + TS, SP = 8192, SS = 2048;
constexpr int NL = 4;
constexpr int NWAVES = 8, NTHR = 512;
constexpr float DN_ALPHA = 1.681792830507429f;
constexpr float LN_EPS = 1e-5f, RMS_EPS = 1e-6f;
constexpr float MLA_SCALE = 0.07216878364870323f;
constexpr int NEXP = 16384;

constexpr size_t MiB = 1u << 20;
constexpr size_t WS_CTL = 0, CTL_ZERO_BYTES = 64 * 1024;
constexpr size_t WS_ROPE = 1 * MiB;
constexpr size_t WS_MISC = 3 * MiB;
constexpr size_t WS_W = 4 * MiB;
constexpr size_t W_WA = WS_W;
constexpr size_t W_WUQ = W_WA + 2 * (size_t)768 * 1024 * 2;
constexpr size_t W_WUKV = W_WUQ + 2 * (size_t)1536 * 384 * 2;
constexpr size_t W_WO = W_WUKV + 2 * (size_t)2048 * 256 * 2;
constexpr size_t W_HIN = W_WO + 2 * (size_t)1024 * 1024 * 2;
constexpr size_t W_HO = W_HIN + 2 * (size_t)5120 * 1024 * 2;
constexpr size_t W_PQ = W_HO + 2 * (size_t)1024 * 1024 * 2;
constexpr size_t W_GW = W_PQ + 4 * (size_t)2048 * 1024 * 2;
constexpr size_t W_PP = W_GW + 4 * (size_t)1024 * 1024 * 2;
constexpr size_t W_KEYS = W_PP + 4 * (size_t)1024 * 256 * 2;
constexpr size_t W_END = W_KEYS + 4 * (size_t)2 * 128 * 128 * 2;
static_assert(W_END <= 68 * MiB, "weights region");
constexpr size_t WS_R2 = 68 * MiB;
constexpr size_t R2_UB = WS_R2, R2_VB = WS_R2 + 16 * MiB, R2_SU = WS_R2 + 32 * MiB, R2_SV = WS_R2 + 33 * MiB, R2_IDX = WS_R2 + 64 * MiB, R2_GATE = WS_R2 + 104 * MiB, R2_PB = WS_R2 + 144 * MiB;
constexpr size_t WS_XB = 252 * MiB;
constexpr size_t WS_BIG = 412 * MiB;
constexpr size_t WS_END = WS_BIG + 800 * MiB;
constexpr size_t B_Q = WS_BIG, B_KV = WS_BIG + 240 * MiB, B_O = WS_BIG + 560 * MiB, B_KROPE = WS_BIG + 720 * MiB;
constexpr size_t B_A32 = WS_BIG + 240 * MiB, B_CQN = WS_BIG + 560 * MiB, B_CKVN = WS_BIG + 620 * MiB, B_H32_MLA = WS_BIG;
constexpr size_t B_PLANE = WS_BIG, PLANE_BYTES = 160 * MiB, B_H32_HGRN = WS_BIG + 160 * MiB;
constexpr size_t B_PQ = WS_BIG, B_PP = WS_BIG + 320 * MiB;

constexpr int LDS_BYTES = 160 * 1024;
constexpr int LDS_MISC_OFF = LDS_BYTES - 256;

typedef __bf16 bf16x2_n __attribute__((ext_vector_type(2)));
__device__ __forceinline__ unsigned cvt_pk_bf16(float lo, float hi) { const f32x2 v = {lo, hi}; const bf16x2_n b = __builtin_convertvector(v, bf16x2_n); return __builtin_bit_cast(unsigned, b); }
__device__ __forceinline__ bf16_t f2bf(float f) { return (bf16_t)(cvt_pk_bf16(f, 0.f) & 0xffffu); }
__device__ __forceinline__ float bf2f(bf16_t b) { return __uint_as_float(((unsigned)b) << 16); }
__device__ __forceinline__ float bflo(unsigned w) { return __uint_as_float(w << 16); }
__device__ __forceinline__ float bfhi(unsigned w) { return __uint_as_float(w & 0xffff0000u); }
__device__ __forceinline__ float wave_sum(float v) {
#pragma unroll
    for (int o = 1; o < 64; o <<= 1) v += __shfl_xor(v, o);
    return v;
}
__device__ __forceinline__ float fast_exp(float x) { return __builtin_amdgcn_exp2f(x * 1.4426950408889634f); }
__device__ __forceinline__ float fast_log(float x) { return __builtin_amdgcn_logf(x) * 0.6931471805599453f; }
__device__ __forceinline__ float fast_rcp(float x) { return __builtin_amdgcn_rcpf(x); }
__device__ __forceinline__ float sigmoidf_(float x) { return fast_rcp(1.0f + fast_exp(-x)); }
__device__ __forceinline__ float siluf_(float x) { return x * sigmoidf_(x); }
#define LDS_WAIT() asm volatile("s_waitcnt lgkmcnt(0)" ::: "memory")
#define VM_WAIT() asm volatile("s_waitcnt vmcnt(0)" ::: "memory")
__device__ __forceinline__ int opaque_tid() { int t = (int)threadIdx.x; asm volatile("" : "+v"(t)); return t; }
__device__ __forceinline__ int opaque_bid() { int b = (int)blockIdx.x; asm volatile("" : "+s"(b)); return b; }
struct Args { const float* in[25]; float* out; unsigned char* ws; int ph_lo, ph_hi; };
#define XB_TMO      128
#define XB_XCNT(j)  (256  + 64 * (j))
#define XB_XSUB(j)  (1280 + 64 * (j))
#define XB_XGEN(j)  (2304 + 64 * (j))
#define XB_TOP      3328
#define XB_TOPGEN   3392
#define XCD_BAR_WORDS 3456
#define XB_SPIN_CAP (1u << 23)

__device__ __forceinline__ unsigned xb_ld(unsigned* p)              { return __hip_atomic_load(p, __ATOMIC_RELAXED, __HIP_MEMORY_SCOPE_AGENT); }
__device__ __forceinline__ unsigned xb_add(unsigned* p, unsigned v) { return __hip_atomic_fetch_add(p, v, __ATOMIC_RELAXED, __HIP_MEMORY_SCOPE_AGENT); }
__device__ __forceinline__ unsigned xb_xcc_id() { return (unsigned)__builtin_amdgcn_s_getreg((3 << 11) | 20) & 0xFu; }
#define XB_SPIN(cond, bar) do { unsigned _sp = 0; while (cond) { __builtin_amdgcn_s_sleep(1); \
    if ((++_sp & 255u) == 0u) { if (xb_ld(&(bar)[XB_TMO])) break; if (_sp > XB_SPIN_CAP) { atomicAdd(&(bar)[XB_TMO], 1u); break; } } } } while (0)

struct XcdBarrier {
    unsigned* bar; unsigned x;
    volatile LAS unsigned* st;
};

__device__ __forceinline__ XcdBarrier xcd_barrier_post(unsigned* bar, volatile LAS unsigned* st) {
    XcdBarrier b; b.bar = bar; b.x = xb_xcc_id(); b.st = st;
    if (threadIdx.x == 0) (void)xb_add(&bar[XB_XCNT(b.x)], 1u);
    return b;
}
__device__ __forceinline__ void xcd_barrier_complete(unsigned* bar, unsigned x, unsigned& nloc, unsigned& nx) {
    const unsigned G = gridDim.x * gridDim.y * gridDim.z;
    unsigned sum, cnt, mine, sp = 0u;
    for (;;) {
        sum = 0u; cnt = 0u; mine = 0u;
#pragma unroll
        for (unsigned j = 0; j < 16; ++j) { const unsigned c = xb_ld(&bar[XB_XCNT(j)]); sum += c; cnt += (c > 0u) ? 1u : 0u; mine = (j == x) ? c : mine; }
        if (sum == G) break;
        __builtin_amdgcn_s_sleep(1);
        if ((++sp & 255u) == 0u) { if (xb_ld(&bar[XB_TMO])) break; if (sp > XB_SPIN_CAP) { atomicAdd(&bar[XB_TMO], 1u); break; } }
    }
    nloc = mine > 0u ? mine : 1u; nx = cnt > 0u ? cnt : 1u;
}

__device__ __forceinline__ void xcd_barrier(const XcdBarrier& b) {
    asm volatile("s_waitcnt vmcnt(0)" ::: "memory");
    __syncthreads();
    if (threadIdx.x == 0) {
        unsigned* bar = b.bar;
        __builtin_amdgcn_s_waitcnt(0);
        unsigned nloc = b.st[0], nx = b.st[1];
        if (nloc == 0u) { xcd_barrier_complete(bar, b.x, nloc, nx); b.st[0] = nloc; b.st[1] = nx; }
        const unsigned old = xb_add(&bar[XB_XSUB(b.x)], 1u);
        const unsigned gen = old / nloc;
        if (old + 1u == (gen + 1u) * nloc) {
            __builtin_amdgcn_fence(__ATOMIC_RELEASE, "agent");
            asm volatile("s_waitcnt vmcnt(0)" ::: "memory");
            const unsigned og = xb_add(&bar[XB_TOP], 1u);
            const unsigned tg = og / nx;
            if (og + 1u == (tg + 1u) * nx) xb_add(&bar[XB_TOPGEN], 1u);
            else XB_SPIN(xb_ld(&bar[XB_TOPGEN]) == tg, bar);
            __builtin_amdgcn_fence(__ATOMIC_ACQUIRE, "agent");
            xb_add(&bar[XB_XGEN(b.x)], 1u);
            asm volatile("s_waitcnt vmcnt(0)" ::: "memory");
        } else {
            XB_SPIN(xb_ld(&bar[XB_XGEN(b.x)]) == gen, bar);
            __builtin_amdgcn_fence(__ATOMIC_ACQUIRE, "agent");
            asm volatile("s_waitcnt vmcnt(0)" ::: "memory");
        }
    }
    __syncthreads();
}
namespace pg8 {
#define PG8_LAS __attribute__((address_space(3)))
constexpr int BM = 256, BK = 64, HALF = 128, HTB = HALF * BK * 2  , STAGE_BYTES = 8 * HTB, NXCD = 8, WGM = 8;

__host__ __device__ __forceinline__ int lds_byte(int r, int c) { const int st = (r >> 4) * 2 + (c >> 5), rr = r & 15, cc = c & 31, ob = rr * 64 + cc * 2; return st * 1024 + (ob ^ (((ob >> 9) & 1) << 5)); }
__host__ __device__ __forceinline__ void stage_rc(int b, int& R, int& C) { const int st = b / 1024, sb = b % 1024, swz = sb ^ (((sb >> 9) & 1) << 5); R = (st >> 1) * 16 + swz / 64; C = (st & 1) * 32 + (swz % 64) / 2; }
__host__ __device__ __forceinline__ int perm32(int rho) { const int n = rho >> 4, i = rho & 15; return 8 * (i >> 2) + 4 * n + (i & 3); }

struct Unit { int pm, pn; };
struct Gemm { const bf16_t* A; const bf16_t* Bt; int M, N, K; };

struct StaticOrder {
    int nM, nN, nwg, G, c;
    __host__ __device__ void init(int M, int N, int G_, int c_) { nM = M / BM; nN = N / BM; nwg = nM * nN; G = G_; c = c_; }
    __host__ __device__ bool next(int i, Unit& u) const {
        const long L = (long)i * G + c; if (L >= nwg) return false;
        int wgid = (int)L; { const int q = nwg / NXCD, r = nwg % NXCD, xcd = wgid % NXCD, off = wgid / NXCD; wgid = (xcd < r ? xcd * (q + 1) : r * (q + 1) + (xcd - r) * q) + off; }
        const int nig = WGM * nN, gid = wgid / nig, fm = gid * WGM, gsz = (nM - fm) < WGM ? (nM - fm) : WGM;
        u.pm = fm + ((wgid % nig) % gsz); u.pn = (wgid % nig) / gsz; return true;
    }
    __device__ __forceinline__ void a_ready(const Unit&) const {}
    __device__ __forceinline__ void done(const Unit&) const {}
};
template <class Epi, class Sched>
__device__ __forceinline__ void gemm_phase(PG8_LAS unsigned char* lds, const Gemm g, const Sched& S, const Epi& E) {
    const int tid = opaque_tid(), wid = __builtin_amdgcn_readfirstlane(tid >> 6), lane = tid & 63, wr = wid >> 2, wc = wid & 3, fr = lane & 15, fq = lane >> 4;
    const int K = g.K, nt = K / BK;
    unsigned voffA[2], voffB[2];
#pragma unroll
    for (int i = 0; i < 2; ++i) { int R, C; stage_rc(tid * 16 + i * 8192, R, C); const int Rb = Epi::PERM ? ((R & ~31) + perm32(R & 31)) : R;
        voffA[i] = (unsigned)(R * K + C) * 2u; voffB[i] = (unsigned)(Rb * K + C) * 2u; }
    const size_t kstep = (size_t)(BK * 2);
    const size_t hstep = (size_t)HALF * K * 2;
    const size_t tstep = 2 * hstep;
    const unsigned ldsw = (unsigned)wid * 1024u;
    const int aoff = lds_byte(wr * 64 + fr, fq * 8), boff = lds_byte(wc * 32 + fr, fq * 8);
#define PG8_SA(b, h) (((b) * 2 + (h)) * HTB)
#define PG8_SB(b, h) ((4 + (b) * 2 + (h)) * HTB)
#define PG8_STAGE(bufoff, gbase, voff) do { _Pragma("unroll") for (int _i = 0; _i < 2; ++_i) \
        __builtin_amdgcn_global_load_lds((const unsigned*)((const char*)(gbase) + (voff)[_i]), (PG8_LAS unsigned*)(lds + (bufoff) + ldsw + _i * 8192), 16, 0, 0); } while (0)
#define PG8_LDA(dst, b, h) do { _Pragma("unroll") for (int m = 0; m < 4; ++m) _Pragma("unroll") for (int k = 0; k < 2; ++k) dst[m][k] = *(const PG8_LAS bf16x8*)(lds + PG8_SA(b, h) + aoff + m * 2048 + k * 1024); } while (0)
#define PG8_LDB(dst, b, h) do { _Pragma("unroll") for (int n = 0; n < 2; ++n) _Pragma("unroll") for (int k = 0; k < 2; ++k) dst[n][k] = *(const PG8_LAS bf16x8*)(lds + PG8_SB(b, h) + boff + n * 2048 + k * 1024); } while (0)
#define PG8_MMA(ai, bj, At, Bt) do { __builtin_amdgcn_s_setprio(1); _Pragma("unroll") for (int m = 0; m < 4; ++m) _Pragma("unroll") for (int n = 0; n < 2; ++n) _Pragma("unroll") for (int k = 0; k < 2; ++k) \
        acc[ai][bj][m][n] = __builtin_amdgcn_mfma_f32_16x16x32_bf16(Bt[n][k], At[m][k], acc[ai][bj][m][n], 0, 0, 0); __builtin_amdgcn_s_setprio(0); } while (0)
#define PG8_WAIT_V(n) asm volatile("s_waitcnt vmcnt(" #n ")" ::: "memory")
#define PG8_WAIT_L(n) asm volatile("s_waitcnt lgkmcnt(" #n ")" ::: "memory")
#define PG8_BAR __builtin_amdgcn_s_barrier()
#define PG8_SCHED __builtin_amdgcn_sched_barrier(0)
    Unit cur, nxt; int ui = 0;
    if (!S.next(0, cur)) return;
    f32x4 acc[2][2][4][2];
#pragma unroll
    for (int a = 0; a < 2; ++a)
#pragma unroll
        for (int b = 0; b < 2; ++b)
#pragma unroll
            for (int m = 0; m < 4; ++m)
#pragma unroll
                for (int n = 0; n < 2; ++n) acc[a][b][m][n] = (f32x4){0.f, 0.f, 0.f, 0.f};
    bf16x8 At[4][2], B0[2][2], B1[2][2];
    const char* cA = (const char*)g.A + (size_t)cur.pm * tstep; const char* cB = (const char*)g.Bt + (size_t)cur.pn * tstep;
    S.a_ready(cur);
    PG8_STAGE(PG8_SB(0, 0), cB, voffB); PG8_STAGE(PG8_SA(0, 0), cA, voffA); PG8_STAGE(PG8_SB(0, 1), cB + hstep, voffB); PG8_STAGE(PG8_SA(0, 1), cA + hstep, voffA);
    if (wr == 1) PG8_BAR;
    PG8_WAIT_V(4); PG8_BAR;
    PG8_STAGE(PG8_SB(1, 0), cB + kstep, voffB); PG8_STAGE(PG8_SA(1, 0), cA + kstep, voffA); PG8_STAGE(PG8_SB(1, 1), cB + hstep + kstep, voffB);
    PG8_WAIT_V(6); PG8_BAR;
    for (;;) {
        const bool has_next = S.next(ui + 1, nxt);
        const char* nA = has_next ? (const char*)g.A + (size_t)nxt.pm * tstep : cA; const char* nB = has_next ? (const char*)g.Bt + (size_t)nxt.pn * tstep : cB;
        for (int t = 0; t < nt; t += 2) {
            const bool last = (t == nt - 2);
            const char* a1 = cA + (size_t)(t + 1) * kstep;
            const char* a2 = last ? nA : cA + (size_t)(t + 2) * kstep; const char* b2 = last ? nB : cB + (size_t)(t + 2) * kstep;
            const char* a3 = a2 + kstep; const char* b3 = b2 + kstep;
            if (last && has_next) S.a_ready(nxt);
            PG8_LDB(B0, 0, 0); PG8_SCHED; PG8_LDA(At, 0, 0); PG8_STAGE(PG8_SA(1, 1), a1 + hstep, voffA);
            PG8_WAIT_L(8); PG8_BAR; PG8_WAIT_L(0); PG8_MMA(0, 0, At, B0); PG8_BAR; PG8_SCHED;
            PG8_LDB(B1, 0, 1); PG8_STAGE(PG8_SB(0, 0), b2, voffB);
            PG8_BAR; PG8_WAIT_L(0); PG8_MMA(0, 1, At, B1); PG8_BAR;
            PG8_LDA(At, 0, 1); PG8_STAGE(PG8_SA(0, 0), a2, voffA);
            PG8_BAR; PG8_WAIT_L(0); PG8_MMA(1, 0, At, B0); PG8_BAR; PG8_SCHED;
            PG8_STAGE(PG8_SB(0, 1), b2 + hstep, voffB);
            PG8_WAIT_V(6); PG8_BAR; PG8_MMA(1, 1, At, B1); PG8_BAR;
            PG8_LDB(B0, 1, 0); PG8_SCHED; PG8_LDA(At, 1, 0); PG8_STAGE(PG8_SA(0, 1), a2 + hstep, voffA);
            PG8_WAIT_L(8); PG8_BAR; PG8_WAIT_L(0); PG8_MMA(0, 0, At, B0); PG8_BAR; PG8_SCHED;
            PG8_LDB(B1, 1, 1); PG8_STAGE(PG8_SB(1, 0), b3, voffB);
            PG8_BAR; PG8_WAIT_L(0); PG8_MMA(0, 1, At, B1); PG8_BAR;
            PG8_LDA(At, 1, 1); PG8_STAGE(PG8_SA(1, 0), a3, voffA);
            PG8_BAR; PG8_WAIT_L(0); PG8_MMA(1, 0, At, B0); PG8_BAR; PG8_SCHED;
            PG8_STAGE(PG8_SB(1, 1), b3 + hstep, voffB);
            PG8_WAIT_V(6); PG8_BAR; PG8_MMA(1, 1, At, B1); PG8_BAR;
        }
        E(acc, cur, wr, wc, fr, fq); S.done(cur);
        if (!has_next) break;
#pragma unroll
        for (int a = 0; a < 2; ++a)
#pragma unroll
            for (int b = 0; b < 2; ++b)
#pragma unroll
                for (int m = 0; m < 4; ++m)
#pragma unroll
                    for (int n = 0; n < 2; ++n) acc[a][b][m][n] = (f32x4){0.f, 0.f, 0.f, 0.f};
        cur = nxt; cA = nA; cB = nB; ++ui;
    }
    PG8_WAIT_V(0);
    if (wr == 0) PG8_BAR;
    PG8_BAR;
#undef PG8_SA
#undef PG8_SB
#undef PG8_STAGE
#undef PG8_LDA
#undef PG8_LDB
#undef PG8_MMA
#undef PG8_WAIT_V
#undef PG8_WAIT_L
#undef PG8_BAR
#undef PG8_SCHED
}
struct EpiF32 {
    static constexpr bool PERM = false;
    float* C; int ldc;
    __device__ __forceinline__ void operator()(const f32x4 (&acc)[2][2][4][2], const Unit& u, int wr, int wc, int fr, int fq) const {
        const int row0 = u.pm * BM + wr * 64 + fr, col0 = u.pn * BM + wc * 32 + 4 * fq;
#pragma unroll
        for (int ai = 0; ai < 2; ++ai)
#pragma unroll
            for (int m = 0; m < 4; ++m) { float* rowp = C + (size_t)(row0 + ai * HALF + m * 16) * ldc + col0;
#pragma unroll
                for (int bj = 0; bj < 2; ++bj)
#pragma unroll
                    for (int n = 0; n < 2; ++n) *(f32x4*)(rowp + bj * HALF + n * 16) = acc[ai][bj][m][n]; }
    }
};
struct EpiBf16P {
    static constexpr bool PERM = true;
    bf16_t* O; int ldc;
    __device__ __forceinline__ void operator()(const f32x4 (&acc)[2][2][4][2], const Unit& u, int wr, int wc, int fr, int fq) const {
        const int row0 = u.pm * BM + wr * 64 + fr, col0 = u.pn * BM + wc * 32 + 8 * fq;
#pragma unroll
        for (int ai = 0; ai < 2; ++ai)
#pragma unroll
            for (int m = 0; m < 4; ++m) { bf16_t* rowp = O + (size_t)(row0 + ai * HALF + m * 16) * ldc + col0;
#pragma unroll
                for (int bj = 0; bj < 2; ++bj) { const f32x4 v0 = acc[ai][bj][m][0], v1 = acc[ai][bj][m][1];
                    u32x4 w; w.x = cvt_pk_bf16(v0[0], v0[1]); w.y = cvt_pk_bf16(v0[2], v0[3]); w.z = cvt_pk_bf16(v1[0], v1[1]); w.w = cvt_pk_bf16(v1[2], v1[3]);
                    *(u32x4*)(rowp + bj * HALF) = w; } }
    }
};
struct EpiHgrn {
    static constexpr bool PERM = true;
    bf16_t* planes; size_t plane_elems; const float* lb;
    __device__ __forceinline__ void operator()(const f32x4 (&acc)[2][2][4][2], const Unit& u, int wr, int wc, int fr, int fq) const {
        const int plane = u.pn >> 2;
        const int row0 = u.pm * BM + wr * 64 + fr, col0 = (u.pn & 3) * BM + wc * 32 + 8 * fq;
        bf16_t* base = planes + (size_t)plane * plane_elems;
        float lbv[2][8];
        if (plane == 1 || plane == 2) {
#pragma unroll
            for (int bj = 0; bj < 2; ++bj)
#pragma unroll
                for (int e = 0; e < 8; ++e) lbv[bj][e] = lb[(plane - 1) * 1024 + col0 + bj * HALF + e];
        } else {
#pragma unroll
            for (int bj = 0; bj < 2; ++bj)
#pragma unroll
                for (int e = 0; e < 8; ++e) lbv[bj][e] = 0.f;
        }
#pragma unroll
        for (int ai = 0; ai < 2; ++ai)
#pragma unroll
            for (int m = 0; m < 4; ++m) { bf16_t* rowp = base + (size_t)(row0 + ai * HALF + m * 16) * 1024 + col0;
#pragma unroll
                for (int bj = 0; bj < 2; ++bj) { float v[8];
#pragma unroll
                    for (int e = 0; e < 4; ++e) { v[e] = acc[ai][bj][m][0][e]; v[4 + e] = acc[ai][bj][m][1][e]; }
                    if (plane == 0 || plane == 4) {
#pragma unroll
                        for (int e = 0; e < 8; ++e) v[e] = siluf_(v[e]);
                    } else if (plane == 1 || plane == 2) {
#pragma unroll
                        for (int e = 0; e < 8; ++e) { const float l = lbv[bj][e]; const float f = l + (1.0f - l) * sigmoidf_(v[e]); v[e] = fast_log(fmaxf(f, 1e-30f)); }
                    }
                    u32x4 w; w.x = cvt_pk_bf16(v[0], v[1]); w.y = cvt_pk_bf16(v[2], v[3]); w.z = cvt_pk_bf16(v[4], v[5]); w.w = cvt_pk_bf16(v[6], v[7]);
                    *(u32x4*)(rowp + bj * HALF) = w; } }
    }
};
struct EpiPle {
    static constexpr bool PERM = false;
    float* X; const bf16_t* PP; const float* bias; bf16_t* XbOut;
    __device__ __forceinline__ void operator()(const f32x4 (&acc)[2][2][4][2], const Unit& u, int wr, int wc, int fr, int fq) const {
        const int row0 = u.pm * BM + wr * 64 + fr, col0 = u.pn * BM + wc * 32 + 4 * fq;
        f32x4 bv[2][2];
#pragma unroll
        for (int bj = 0; bj < 2; ++bj)
#pragma unroll
            for (int n = 0; n < 2; ++n) bv[bj][n] = *(const f32x4*)(bias + col0 + bj * HALF + n * 16);
#pragma unroll
        for (int ai = 0; ai < 2; ++ai)
#pragma unroll
            for (int m = 0; m < 4; ++m) { const size_t off = (size_t)(row0 + ai * HALF + m * 16) * 1024 + col0;
#pragma unroll
                for (int bj = 0; bj < 2; ++bj)
#pragma unroll
                    for (int n = 0; n < 2; ++n) { const size_t o2 = off + bj * HALF + n * 16;
                        const f32x4 x = *(const f32x4*)(X + o2); const u32x2 pw = *(const u32x2*)(PP + o2); const f32x4 z = acc[ai][bj][m][n] + bv[bj][n];
                        f32x4 o; o[0] = x[0] + sigmoidf_(z[0]) * bflo(pw.x); o[1] = x[1] + sigmoidf_(z[1]) * bfhi(pw.x); o[2] = x[2] + sigmoidf_(z[2]) * bflo(pw.y); o[3] = x[3] + sigmoidf_(z[3]) * bfhi(pw.y);
                        *(f32x4*)(X + o2) = o; u32x2 w; w.x = cvt_pk_bf16(o[0], o[1]); w.y = cvt_pk_bf16(o[2], o[3]); *(u32x2*)(XbOut + o2) = w; }
                asm volatile("" ::: "memory"); }
    }
};
}
namespace attn {
constexpr int DV = 128, DQK = 192, NW = 8, QBLK = 32, KVBLK = 64;
constexpr float SCALE = MLA_SCALE;
constexpr float THR = 8.f;
constexpr int LDQ = 8 * DQK, LDKV = 8 * 256, LDKR = 64, LDO = 1024;
constexpr int KROWB = 400;
constexpr int SHM_V = KVBLK * DV * 2, SHM_K = KVBLK * KROWB, SHM_ATTN = 2 * SHM_V + 2 * SHM_K + NW * 64 * 4;
#define SBAR() __builtin_amdgcn_sched_barrier(0)
__device__ __forceinline__ int crow(int r, int hi) { return (r & 3) + 8 * (r >> 2) + 4 * hi; }

__device__ __forceinline__ void partialSM(f32x16& p0, f32x16& p1, float& m_reg, float& mn, float& alpha) {
  constexpr float C = SCALE * 1.4426950408889634f;
  float pmax = p0[0];
#pragma unroll
  for (int r = 1; r < 16; ++r) pmax = fmaxf(pmax, p0[r]);
#pragma unroll
  for (int r = 0; r < 16; ++r) pmax = fmaxf(pmax, p1[r]);
  { auto rr = __builtin_amdgcn_permlane32_swap(__float_as_uint(pmax), __float_as_uint(pmax), false, false);
    pmax = fmaxf(__uint_as_float(rr[0]), __uint_as_float(rr[1])); }
  if (__builtin_expect(__all(pmax - m_reg <= THR / SCALE), 1)) { mn = m_reg; alpha = 1.f; }
  else { mn = fmaxf(m_reg, pmax); alpha = __builtin_amdgcn_exp2f((m_reg - mn) * C); m_reg = mn; }
  float mnC = -mn * C;
#pragma unroll
  for (int r = 0; r < 16; ++r) p0[r] = fmaf(p0[r], C, mnC);
#pragma unroll
  for (int r = 0; r < 16; ++r) p1[r] = fmaf(p1[r], C, mnC);
#pragma unroll
  for (int r = 0; r < 16; ++r) p0[r] = __builtin_amdgcn_exp2f(p0[r]);
}
__device__ __forceinline__ void finishSM(f32x16& p0, f32x16& p1, float alpha, float& l_reg, bf16x8& pa0, bf16x8& pa1, bf16x8& pa2, bf16x8& pa3) {
#pragma unroll
  for (int r = 0; r < 16; ++r) p1[r] = __builtin_amdgcn_exp2f(p1[r]);
  float ps = 0;
#pragma unroll
  for (int r = 0; r < 16; ++r) ps += p0[r];
#pragma unroll
  for (int r = 0; r < 16; ++r) ps += p1[r];
  { auto rr = __builtin_amdgcn_permlane32_swap(__float_as_uint(ps), __float_as_uint(ps), false, false);
    ps = __uint_as_float(rr[0]) + __uint_as_float(rr[1]); }
  l_reg = l_reg * alpha + ps;
#define PK4(P, BASE, OUT) do { unsigned a0 = cvt_pk_bf16(P[BASE + 0], P[BASE + 1]), a1 = cvt_pk_bf16(P[BASE + 2], P[BASE + 3]);   \
    unsigned b0 = cvt_pk_bf16(P[BASE + 4], P[BASE + 5]), b1 = cvt_pk_bf16(P[BASE + 6], P[BASE + 7]);                              \
    auto r0 = __builtin_amdgcn_permlane32_swap(a0, b0, false, false); auto r1 = __builtin_amdgcn_permlane32_swap(a1, b1, false, false); \
    u32x4 w = {r0[0], r1[0], r0[1], r1[1]}; OUT = *reinterpret_cast<bf16x8*>(&w); } while (0)
  PK4(p0, 0, pa0); PK4(p0, 8, pa1); PK4(p1, 0, pa2); PK4(p1, 8, pa3);
#undef PK4
}
__device__ __forceinline__ void qkt(f32x16& p0, f32x16& p1, const char* Ks, const bf16x8* qr, int r32, int hi) {
  p0 = f32x16{}; p1 = f32x16{};
#pragma unroll
  for (int d0 = 0; d0 < 12; ++d0) { const int cb = (d0 * 16 + hi * 8) * 2;
    bf16x8 b0 = *reinterpret_cast<const bf16x8*>(Ks + r32 * KROWB + cb);
    bf16x8 b1 = *reinterpret_cast<const bf16x8*>(Ks + (32 + r32) * KROWB + cb);
    p0 = __builtin_amdgcn_mfma_f32_32x32x16_bf16(b0, qr[d0], p0, 0, 0, 0);
    p1 = __builtin_amdgcn_mfma_f32_32x32x16_bf16(b1, qr[d0], p1, 0, 0, 0);
    if ((d0 & 3) == 3) SBAR(); }
}
__device__ __forceinline__ int v_st(int k, int c) { const int kk = (k & ~0xC) | ((k & 4) << 1) | ((k & 8) >> 1); return ((kk >> 3) * 4 + (c >> 5)) * 512 + ((kk & 7) * 32 + (c & 31)) * 2; }
__device__ __forceinline__ int v_rd_base(int lane) { return ((lane & 3) << 3) | (((lane >> 2) & 3) << 6) | (((lane >> 4) & 1) << 5) | (((lane >> 5) & 1) << 8); }
constexpr int v_rd_off(int d0, int ks, int half) { return d0 * 512 + ks * 4096 + half * 2048; }
template <int OFF> __device__ __forceinline__ s16x4 tr_read(int vb) {
  s16x4 r; asm volatile("ds_read_b64_tr_b16 %0, %1 offset:%2" : "=&v"(r) : "v"(vb), "i"(OFF) : "memory"); return r;
}
template <int D0> __device__ __forceinline__ void pv_one(f32x16& od, int vb, bf16x8 pa0, bf16x8 pa1, bf16x8 pa2, bf16x8 pa3) {
  const s16x4 l0 = tr_read<v_rd_off(D0, 0, 0)>(vb), h0 = tr_read<v_rd_off(D0, 0, 1)>(vb), l1 = tr_read<v_rd_off(D0, 1, 0)>(vb), h1 = tr_read<v_rd_off(D0, 1, 1)>(vb);
  const s16x4 l2 = tr_read<v_rd_off(D0, 2, 0)>(vb), h2 = tr_read<v_rd_off(D0, 2, 1)>(vb), l3 = tr_read<v_rd_off(D0, 3, 0)>(vb), h3 = tr_read<v_rd_off(D0, 3, 1)>(vb);
  asm volatile("s_waitcnt lgkmcnt(0)" ::: "memory"); SBAR();
#define PK(L, H) (bf16x8){L[0], L[1], L[2], L[3], H[0], H[1], H[2], H[3]}
  od = __builtin_amdgcn_mfma_f32_32x32x16_bf16(pa0, PK(l0, h0), od, 0, 0, 0);
  od = __builtin_amdgcn_mfma_f32_32x32x16_bf16(pa1, PK(l1, h1), od, 0, 0, 0);
  od = __builtin_amdgcn_mfma_f32_32x32x16_bf16(pa2, PK(l2, h2), od, 0, 0, 0);
  od = __builtin_amdgcn_mfma_f32_32x32x16_bf16(pa3, PK(l3, h3), od, 0, 0, 0);
#undef PK
}
__device__ __forceinline__ void pv_d0(f32x16* o, int vb, bf16x8 pa0, bf16x8 pa1, bf16x8 pa2, bf16x8 pa3) {
  pv_one<0>(o[0], vb, pa0, pa1, pa2, pa3); pv_one<1>(o[1], vb, pa0, pa1, pa2, pa3); pv_one<2>(o[2], vb, pa0, pa1, pa2, pa3); pv_one<3>(o[3], vb, pa0, pa1, pa2, pa3);
}

__device__ __forceinline__ void attn_body(const bf16_t* __restrict__ Qb, const bf16_t* __restrict__ Kn, const bf16_t* __restrict__ Kr,
                                          bf16_t* __restrict__ Ob, int seq, char* lds) {
  const int tid = opaque_tid(), wid = tid >> 6, lane = tid & 63, r32 = lane & 31, hi = lane >> 5;
  char* V_lds = lds; char* K_lds = lds + 2 * SHM_V;
  float* ws = (float*)(lds + 2 * SHM_V + 2 * SHM_K) + wid * 64; float* li_l = ws; float* al_l = ws + 32;
  float m_reg = -1e30f, l_reg = 0; f32x16 o[4] = {}; bf16x8 qr[12];
  const bf16_t* Qw = Qb + (long)(wid * QBLK + r32) * LDQ + hi * 8;
#pragma unroll
  for (int d0 = 0; d0 < 12; ++d0) qr[d0] = *reinterpret_cast<const bf16x8*>(Qw + d0 * 16);
  const bf16_t* Vh = Kn + 128;
  const int sr = tid >> 4, sc = (tid & 15) * 8, vst0 = v_st(sr, sc), vst1 = v_st(32 + sr, sc);
  int krow[3], kcc[3];
#pragma unroll
  for (int i = 0; i < 3; ++i) { const int id = tid + 512 * i; krow[i] = id / 24; kcc[i] = id % 24; }
  const int vb0 = (int)(uintptr_t)V_lds + v_rd_base(lane);
  bf16x8 vs0, vs1, ks0, ks1, ks2;
#define KSRC(i, k0) (kcc[i] < 16 ? (Kn + (long)((k0) + krow[i]) * LDKV + kcc[i] * 8) : (Kr + (long)((k0) + krow[i]) * LDKR + (kcc[i] - 16) * 8))
#define SLOAD(k0) do { vs0 = *reinterpret_cast<const bf16x8*>(&Vh[(long)((k0) + sr) * LDKV + sc]); vs1 = *reinterpret_cast<const bf16x8*>(&Vh[(long)((k0) + 32 + sr) * LDKV + sc]); \
    ks0 = *reinterpret_cast<const bf16x8*>(KSRC(0, k0)); ks1 = *reinterpret_cast<const bf16x8*>(KSRC(1, k0)); ks2 = *reinterpret_cast<const bf16x8*>(KSRC(2, k0)); } while (0)
#define SWRITE(b) do { *(bf16x8*)(V_lds + (b) * SHM_V + vst0) = vs0; *(bf16x8*)(V_lds + (b) * SHM_V + vst1) = vs1; \
    *(bf16x8*)(K_lds + (b) * SHM_K + krow[0] * KROWB + kcc[0] * 16) = ks0; *(bf16x8*)(K_lds + (b) * SHM_K + krow[1] * KROWB + kcc[1] * 16) = ks1; \
    *(bf16x8*)(K_lds + (b) * SHM_K + krow[2] * KROWB + kcc[2] * 16) = ks2; } while (0)
#define SWAIT() asm volatile("s_waitcnt vmcnt(0)" ::: "memory")
#define RESC(a) do { if (__any((a) < 1.f)) { if (hi == 0) al_l[r32] = (a); asm volatile("s_waitcnt lgkmcnt(0)" ::: "memory"); \
    _Pragma("unroll") for (int d = 0; d < 4; ++d) _Pragma("unroll") for (int r = 0; r < 16; ++r) o[d][r] *= al_l[crow(r, hi)]; } } while (0)
  f32x16 pA0, pA1; float mnA, alA; bf16x8 pa0, pa1, pa2, pa3; const int NT = seq / KVBLK;
  SLOAD(0); SWAIT(); SWRITE(0); __syncthreads();
  for (int j = 0; j < NT; ++j) {
    const int b = j & 1;
    if (j + 1 < NT) SLOAD((j + 1) * KVBLK);
    SBAR(); qkt(pA0, pA1, K_lds + b * SHM_K, qr, r32, hi);
    partialSM(pA0, pA1, m_reg, mnA, alA);
    RESC(alA);
    finishSM(pA0, pA1, alA, l_reg, pa0, pa1, pa2, pa3); SBAR();
    pv_d0(o, vb0 + b * (int)SHM_V, pa0, pa1, pa2, pa3);
    if (j + 1 < NT) { SWAIT(); SWRITE(b ^ 1); }
    __syncthreads();
  }
  if (hi == 0) li_l[r32] = l_reg; asm volatile("s_waitcnt lgkmcnt(0)" ::: "memory");
  float rli[16];
#pragma unroll
  for (int r = 0; r < 16; ++r) rli[r] = __builtin_amdgcn_rcpf(li_l[crow(r, hi)]);
  bf16_t* Ow = Ob + (long)(wid * QBLK) * LDO;
#pragma unroll
  for (int r = 0; r < 16; ++r) { const int orow = crow(r, hi);
#pragma unroll
    for (int d0 = 0; d0 < 4; ++d0) Ow[(long)orow * LDO + d0 * 32 + r32] = f2bf(o[d0][r] * rli[r]); }
#undef KSRC
#undef SLOAD
#undef SWRITE
#undef SWAIT
#undef RESC
}
#undef SBAR
}
typedef const __attribute__((address_space(4))) Args* KArgs;
struct Ctx {
    KArgs a; float* out; unsigned char* ws;
    LAS unsigned char* lds;
    int tid, lane, wave, vcu, G, gw, NGW, bid;
    __device__ __forceinline__ const float* in(int i) const { return a->in[i]; }
};
__device__ __forceinline__ Ctx mk_ctx(unsigned char* lds_raw) {
    Ctx c; KArgs a = (KArgs)__builtin_amdgcn_kernarg_segment_ptr(); asm volatile("" : "+s"(a));
    c.a = a; c.out = a->out; c.ws = a->ws; c.lds = (LAS unsigned char*)lds_raw;
    c.tid = opaque_tid(); c.lane = c.tid & 63; c.wave = __builtin_amdgcn_readfirstlane(c.tid >> 6);
    c.G = (int)gridDim.x; c.bid = opaque_bid(); c.vcu = (c.G % 8 == 0) ? (c.bid % 8) * (c.G / 8) + c.bid / 8 : c.bid;
    c.gw = c.vcu * NWAVES + c.wave; c.NGW = c.G * NWAVES;
    return c;
}
__device__ __forceinline__ int tok_pos(int t) { return t < TP ? (t & (SP - 1)) : ((t - TP) & (SS - 1)); }

__device__ __forceinline__ void transpose_item(const float* W, int K, int N, bf16_t* WT, LAS float* scr, int item, int lane) {
    const int nblk = N / 32, kb = item / nblk, nb = item % nblk, k0 = 64 * kb, n0 = 32 * nb;
#pragma unroll 8
    for (int i = 0; i < 32; ++i) { const int kk = 2 * i + (lane >> 5); scr[kk * 33 + (lane & 31)] = W[(size_t)(k0 + kk) * N + n0 + (lane & 31)]; }
    LDS_WAIT(); asm volatile("" ::: "memory");
    const int c = lane & 7;
#pragma unroll
    for (int j = 0; j < 4; ++j) { const int n = (lane >> 3) + 8 * j; const LAS float* s = scr + (8 * c) * 33 + n;
        u32x4 o; o.x = cvt_pk_bf16(s[0 * 33], s[1 * 33]); o.y = cvt_pk_bf16(s[2 * 33], s[3 * 33]); o.z = cvt_pk_bf16(s[4 * 33], s[5 * 33]); o.w = cvt_pk_bf16(s[6 * 33], s[7 * 33]);
        *(u32x4*)(WT + (size_t)(n0 + n) * K + k0 + 8 * c) = o; }
    LDS_WAIT(); asm volatile("" ::: "memory");
}
struct MatDesc { int in_idx, K, N, Npad, copies; size_t dst; };
__device__ __forceinline__ void p0_prologue(const Ctx& c) {
    LAS float* scr = (LAS float*)(c.lds + c.wave * 16384);
    const MatDesc MATS[9] = {
        {4, 1024, 704, 768, 2, W_WA}, {7, 384, 1536, 1536, 2, W_WUQ}, {8, 256, 2048, 2048, 2, W_WUKV}, {9, 1024, 1024, 1024, 2, W_WO},
        {10, 1024, 5120, 5120, 2, W_HIN}, {13, 1024, 1024, 1024, 2, W_HO}, {14, 1024, 2048, 2048, 4, W_PQ}, {22, 1024, 1024, 1024, 4, W_GW}, {24, 256, 1024, 1024, 4, W_PP}};
    int total = 0;
#pragma unroll
    for (int m = 0; m < 9; ++m) total += MATS[m].copies * (MATS[m].K / 64) * (MATS[m].N / 32);
    for (int it = c.gw; it < total; it += c.NGW) {
        int r = it;
#pragma unroll
        for (int m = 0; m < 9; ++m) {
            const int per = (MATS[m].K / 64) * (MATS[m].N / 32), cnt = MATS[m].copies * per;
            if (r >= 0 && r < cnt) { const int cp = r / per, item = r % per;
                transpose_item(c.in(MATS[m].in_idx) + (size_t)cp * MATS[m].K * MATS[m].N, MATS[m].K, MATS[m].N,
                               (bf16_t*)(c.ws + MATS[m].dst) + (size_t)cp * MATS[m].Npad * MATS[m].K, scr, item, c.lane);
                r = -1; }
            else if (r >= 0) r -= cnt;
        }
    }
    const int gt = c.gw * 64 + c.lane, NGT = c.NGW * 64;
    for (int i = gt; i < 2 * 64 * 1024 / 8; i += NGT) { const int cp = i / (64 * 1024 / 8), o = i % (64 * 1024 / 8);
        *(u32x4*)((bf16_t*)(c.ws + W_WA) + (size_t)cp * 768 * 1024 + (size_t)704 * 1024 + o * 8) = (u32x4){0u, 0u, 0u, 0u}; }
    for (int i = gt; i < 4 * 2 * 128 * 128 / 4; i += NGT) { const f32x4 v = *(const f32x4*)(c.in(15) + (size_t)i * 4);
        u32x2 w; w.x = cvt_pk_bf16(v[0], v[1]); w.y = cvt_pk_bf16(v[2], v[3]); *(u32x2*)((bf16_t*)(c.ws + W_KEYS) + (size_t)i * 4) = w; }
    for (int i = gt; i < 8192 * 32; i += NGT) { const int pos = i >> 5, f = i & 31;
        const float inv = 1.0f / powf(10000.0f, (float)(2 * f) / 64.0f); const float ang = (float)pos * inv;
        ((float*)(c.ws + WS_ROPE))[i] = cosf(ang); ((float*)(c.ws + WS_ROPE))[8192 * 32 + i] = sinf(ang); }
    for (int i = gt; i < 2 * 1024; i += NGT) { const int dir = i >> 10, k = i & 1023;
        const float l0 = c.in(11)[(dir * 2 + 0) * 1024 + k], l1 = c.in(11)[(dir * 2 + 1) * 1024 + k];
        float* lb = (float*)(c.ws + WS_MISC);
        lb[(0 * 2 + dir) * 1024 + k] = 0.f; lb[(1 * 2 + dir) * 1024 + k] = 1.0f / (1.0f + expf(l0 - l1)); }
    for (int t = c.gw; t < T; t += c.NGW) {
        const float* xr = t < TP ? c.in(0) + (size_t)t * D : c.in(1) + (size_t)(t - TP) * D;
        float* orow = c.out + (size_t)t * D; bf16_t* brow = (bf16_t*)(c.ws + WS_R2) + (size_t)t * D;
#pragma unroll
        for (int j = 0; j < 4; ++j) { const f32x4 v = *(const f32x4*)(xr + 256 * j + 4 * c.lane); *(f32x4*)(orow + 256 * j + 4 * c.lane) = v;
            u32x2 w; w.x = cvt_pk_bf16(v[0], v[1]); w.y = cvt_pk_bf16(v[2], v[3]); *(u32x2*)(brow + 256 * j + 4 * c.lane) = w; }
    }
}

__device__ __forceinline__ void cvt_range(const float* src, bf16_t* dst, size_t n8, int gt, int NGT) {
    for (size_t i = gt; i < n8; i += NGT) { const f32x4 a = *(const f32x4*)(src + i * 8), b = *(const f32x4*)(src + i * 8 + 4);
        u32x4 w; w.x = cvt_pk_bf16(a[0], a[1]); w.y = cvt_pk_bf16(a[2], a[3]); w.z = cvt_pk_bf16(b[0], b[1]); w.w = cvt_pk_bf16(b[2], b[3]); *(u32x4*)(dst + i * 8) = w; }
}
__device__ __forceinline__ void l0_convert(const Ctx& c, int layer) {
    const int gt = c.gw * 64 + c.lane, NGT = c.NGW * 64;
    for (int r = c.gw; r < 2 * NEXP; r += c.NGW) {
        const int m = r >= NEXP, e = r - m * NEXP;
        const float* src = c.in(16 + m) + ((size_t)layer * NEXP + e) * D + 16 * c.lane;
        f32x4 v[4]; float am = 0.f;
#pragma unroll
        for (int j = 0; j < 4; ++j) { v[j] = *(const f32x4*)(src + 4 * j); am = fmaxf(am, fmaxf(fmaxf(fabsf(v[j][0]), fabsf(v[j][1])), fmaxf(fabsf(v[j][2]), fabsf(v[j][3])))); }
#pragma unroll
        for (int o = 1; o < 64; o <<= 1) am = fmaxf(am, __shfl_xor(am, o));
        const float sc = fmaxf(am, 1e-30f) * (1.0f / 440.0f), inv = 1.0f / sc;
        u32x4 w;
#pragma unroll
        for (int j = 0; j < 4; ++j) { int p = 0; p = __builtin_amdgcn_cvt_pk_fp8_f32(v[j][0] * inv, v[j][1] * inv, p, false); p = __builtin_amdgcn_cvt_pk_fp8_f32(v[j][2] * inv, v[j][3] * inv, p, true); w[j] = (unsigned)p; }
        *(u32x4*)(c.ws + (m ? R2_VB : R2_UB) + (size_t)e * D + 16 * c.lane) = w;
        if (c.lane == 0) ((float*)(c.ws + (m ? R2_SV : R2_SU)))[e] = sc;
    }
    cvt_range(c.in(2) + (size_t)layer * TP * 256, (bf16_t*)(c.ws + R2_PB), (size_t)TP * 256 / 8, gt, NGT);
    cvt_range(c.in(3) + (size_t)layer * TS * 256, (bf16_t*)(c.ws + R2_PB) + (size_t)TP * 256, (size_t)TS * 256 / 8, gt, NGT);
}

__device__ __forceinline__ void mla_e1(const Ctx& c, int j) {
    const float* a32 = (const float*)(c.ws + B_A32); bf16_t* cqn = (bf16_t*)(c.ws + B_CQN); bf16_t* ckvn = (bf16_t*)(c.ws + B_CKVN); bf16_t* krope = (bf16_t*)(c.ws + B_KROPE);
    const float* qnw = c.in(5) + j * 384; const float* kvnw = c.in(6) + j * 256;
    const float* cosT = (const float*)(c.ws + WS_ROPE); const float* sinT = cosT + 8192 * 32;
    LAS float* scr = (LAS float*)(c.lds + c.wave * 1024);
    const int lane = c.lane;
    for (int t = c.gw; t < T; t += c.NGW) {
        const float* ar = a32 + (size_t)t * 768;
        const f32x4 v0 = *(const f32x4*)(ar + 4 * lane), v1 = *(const f32x4*)(ar + 256 + 4 * lane), v2 = *(const f32x4*)(ar + 512 + 4 * lane);
        const float s0 = v0[0] * v0[0] + v0[1] * v0[1] + v0[2] * v0[2] + v0[3] * v0[3];
        const float s1 = v1[0] * v1[0] + v1[1] * v1[1] + v1[2] * v1[2] + v1[3] * v1[3];
        const float s2 = v2[0] * v2[0] + v2[1] * v2[1] + v2[2] * v2[2] + v2[3] * v2[3];
        const float ssq = wave_sum(s0 + (lane < 32 ? s1 : 0.f));
        const float sskv = wave_sum((lane >= 32 ? s1 : 0.f) + (lane < 32 ? s2 : 0.f));
        const float rq = 1.0f / sqrtf(ssq * (1.0f / 384.0f) + RMS_EPS), rkv = 1.0f / sqrtf(sskv * (1.0f / 256.0f) + RMS_EPS);
        { const f32x4 w = *(const f32x4*)(qnw + 4 * lane); u32x2 o; o.x = cvt_pk_bf16(v0[0] * rq * w[0], v0[1] * rq * w[1]); o.y = cvt_pk_bf16(v0[2] * rq * w[2], v0[3] * rq * w[3]);
          *(u32x2*)(cqn + (size_t)t * 384 + 4 * lane) = o; }
        if (lane < 32) { const f32x4 w = *(const f32x4*)(qnw + 256 + 4 * lane); u32x2 o; o.x = cvt_pk_bf16(v1[0] * rq * w[0], v1[1] * rq * w[1]); o.y = cvt_pk_bf16(v1[2] * rq * w[2], v1[3] * rq * w[3]);
          *(u32x2*)(cqn + (size_t)t * 384 + 256 + 4 * lane) = o; }
        else { const int ix = 4 * (lane - 32); const f32x4 w = *(const f32x4*)(kvnw + ix); u32x2 o; o.x = cvt_pk_bf16(v1[0] * rkv * w[0], v1[1] * rkv * w[1]); o.y = cvt_pk_bf16(v1[2] * rkv * w[2], v1[3] * rkv * w[3]);
          *(u32x2*)(ckvn + (size_t)t * 256 + ix) = o; }
        if (lane < 32) { const int ix = 128 + 4 * lane; const f32x4 w = *(const f32x4*)(kvnw + ix); u32x2 o; o.x = cvt_pk_bf16(v2[0] * rkv * w[0], v2[1] * rkv * w[1]); o.y = cvt_pk_bf16(v2[2] * rkv * w[2], v2[3] * rkv * w[3]);
          *(u32x2*)(ckvn + (size_t)t * 256 + ix) = o; }
        else if (lane < 48) { *(LAS f32x4*)(scr + 4 * (lane - 32)) = v2; }
        LDS_WAIT(); asm volatile("" ::: "memory");
        if (lane < 32) { const int pos = tok_pos(t); const float a = scr[lane], b = scr[lane + 32], cs = cosT[pos * 32 + lane], sn = sinT[pos * 32 + lane];
            krope[(size_t)t * 64 + lane] = f2bf(a * cs - b * sn); krope[(size_t)t * 64 + 32 + lane] = f2bf(b * cs + a * sn); }
        LDS_WAIT(); asm volatile("" ::: "memory");
    }
}
__device__ __forceinline__ void mla_qrope(const Ctx& c) {
    bf16_t* q = (bf16_t*)(c.ws + B_Q);
    const float* cosT = (const float*)(c.ws + WS_ROPE); const float* sinT = cosT + 8192 * 32;
    const int lane = c.lane, i = lane & 31;
    for (int t = c.gw; t < T; t += c.NGW) {
        const int pos = tok_pos(t); const float cs = cosT[pos * 32 + i], sn = sinT[pos * 32 + i];
#pragma unroll
        for (int k = 0; k < 4; ++k) { const int h = (lane >> 5) + 2 * k; bf16_t* p = q + (size_t)t * 1536 + h * 192 + 128 + i;
            const float a = bf2f(p[0]), b = bf2f(p[32]); p[0] = f2bf(a * cs - b * sn); p[32] = f2bf(b * cs + a * sn); }
    }
}
__device__ __forceinline__ void mla_attention(const Ctx& c) {
    const bf16_t* Q = (const bf16_t*)(c.ws + B_Q); const bf16_t* KV = (const bf16_t*)(c.ws + B_KV); const bf16_t* KR = (const bf16_t*)(c.ws + B_KROPE); bf16_t* O = (bf16_t*)(c.ws + B_O);
    const int NU = 512 + 2048;
    for (int u = c.bid; u < NU; u += c.G) {
        int tok0, qb, h, seq;
        if (u < 512) { const int round = u >> 8, cc = u & 255, bh = round * 8 + (cc & 7); tok0 = (bh >> 3) * SP; h = bh & 7; qb = cc >> 3; seq = SP; }
        else { const int us = u - 512, round = us >> 8, cc = us & 255, r = cc >> 3, bh = round * 32 + (cc & 7) * 4 + (r >> 3); tok0 = TP + (bh >> 3) * SS; h = bh & 7; qb = r & 7; seq = SS; }
        attn::attn_body(Q + (size_t)(tok0 + qb * 256) * 1536 + h * 192, KV + (size_t)tok0 * 2048 + h * 256, KR + (size_t)tok0 * 64,
                        O + (size_t)(tok0 + qb * 256) * 1024 + h * 128, seq, (char*)c.lds);
        __syncthreads();
    }
}
__device__ __forceinline__ void ln_residual(const Ctx& c, const float* h32, const float* g, const float* b) {
    bf16_t* xb = (bf16_t*)(c.ws + WS_XB); const int lane = c.lane;
    for (int t = c.gw; t < T; t += c.NGW) {
        float* xr = c.out + (size_t)t * D; const float* hr = h32 + (size_t)t * D;
        f32x4 v[4]; float s = 0.f;
#pragma unroll
        for (int j = 0; j < 4; ++j) { const f32x4 x = *(const f32x4*)(xr + 256 * j + 4 * lane), hh = *(const f32x4*)(hr + 256 * j + 4 * lane); v[j] = x * DN_ALPHA + hh; s += (v[j][0] + v[j][1]) + (v[j][2] + v[j][3]); }
        const float mean = wave_sum(s) * (1.0f / D); float s2 = 0.f;
#pragma unroll
        for (int j = 0; j < 4; ++j) { v[j] = v[j] - mean; s2 += (v[j][0] * v[j][0] + v[j][1] * v[j][1]) + (v[j][2] * v[j][2] + v[j][3] * v[j][3]); }
        const float rstd = 1.0f / sqrtf(wave_sum(s2) * (1.0f / D) + LN_EPS);
#pragma unroll
        for (int j = 0; j < 4; ++j) { const f32x4 gg = *(const f32x4*)(g + 256 * j + 4 * lane), bb = *(const f32x4*)(b + 256 * j + 4 * lane); const f32x4 o = v[j] * rstd * gg + bb;
            *(f32x4*)(xr + 256 * j + 4 * lane) = o; u32x2 w; w.x = cvt_pk_bf16(o[0], o[1]); w.y = cvt_pk_bf16(o[2], o[3]); *(u32x2*)(xb + (size_t)t * D + 256 * j + 4 * lane) = w; }
    }
}
__device__ __forceinline__ void hgrn_post(const Ctx& c, int j) {
    bf16_t* pl = (bf16_t*)(c.ws + B_PLANE); const size_t PE = (size_t)T * 1024;
    const bf16_t* of = pl + 1 * PE; const bf16_t* ob = pl + 2 * PE; const bf16_t* sg = pl + 4 * PE; bf16_t* on = pl;
    const float* nw = c.in(12) + j * 128; const int lane = c.lane;
    for (int t = c.gw; t < T; t += c.NGW) {
#pragma unroll
        for (int k = 0; k < 2; ++k) { const size_t off = (size_t)t * 1024 + 512 * k + 8 * lane;
            const u32x4 a = *(const u32x4*)(of + off), b = *(const u32x4*)(ob + off), g = *(const u32x4*)(sg + off);
            float o[8]; o[0] = bflo(a.x) + bflo(b.x); o[1] = bfhi(a.x) + bfhi(b.x); o[2] = bflo(a.y) + bflo(b.y); o[3] = bfhi(a.y) + bfhi(b.y);
            o[4] = bflo(a.z) + bflo(b.z); o[5] = bfhi(a.z) + bfhi(b.z); o[6] = bflo(a.w) + bflo(b.w); o[7] = bfhi(a.w) + bfhi(b.w);
            float ss = 0.f;
#pragma unroll
            for (int e = 0; e < 8; ++e) ss += o[e] * o[e];
            ss += __shfl_xor(ss, 1); ss += __shfl_xor(ss, 2); ss += __shfl_xor(ss, 4); ss += __shfl_xor(ss, 8);
            const float r = 1.0f / sqrtf(ss * (1.0f / 128.0f) + RMS_EPS);
            const int cw = (8 * lane) & 127; const f32x4 w0 = *(const f32x4*)(nw + cw), w1 = *(const f32x4*)(nw + cw + 4);
            float gg[8]; gg[0] = bflo(g.x); gg[1] = bfhi(g.x); gg[2] = bflo(g.y); gg[3] = bfhi(g.y); gg[4] = bflo(g.z); gg[5] = bfhi(g.z); gg[6] = bflo(g.w); gg[7] = bfhi(g.w);
            u32x4 w; w.x = cvt_pk_bf16(o[0] * r * w0[0] * gg[0], o[1] * r * w0[1] * gg[1]); w.y = cvt_pk_bf16(o[2] * r * w0[2] * gg[2], o[3] * r * w0[3] * gg[3]);
            w.z = cvt_pk_bf16(o[4] * r * w1[0] * gg[4], o[5] * r * w1[1] * gg[5]); w.w = cvt_pk_bf16(o[6] * r * w1[2] * gg[6], o[7] * r * w1[3] * gg[7]);
            *(u32x4*)(on + off) = w; }
    }
}
namespace scan {
constexpr size_t D_F = R2_IDX, D_B = R2_IDX + 12 * MiB;
constexpr int NCH = T / 32;
__device__ __forceinline__ void hgrn_prep(const Ctx& c) {
    bf16_t* pl = (bf16_t*)(c.ws + B_PLANE); const size_t PE = (size_t)T * 1024;
    bf16_t* qs = pl; bf16_t* lff = pl + PE; bf16_t* lfb = pl + 2 * PE; bf16_t* qtb = (bf16_t*)(c.ws + WS_XB);
    float* dF = (float*)(c.ws + D_F); float* dB = (float*)(c.ws + D_B);
    const int lane = c.lane;
    for (int it = c.gw; it < NCH * 8; it += c.NGW) {
        const int chunk = it >> 3, h = it & 7; const size_t base = (size_t)chunk * 32 * 1024 + h * 128 + 2 * lane;
        { float r0 = 0.f, r1 = 0.f;
#pragma unroll 8
          for (int tau = 31; tau >= 0; --tau) { const size_t o = base + (size_t)tau * 1024; const unsigned lw = *(const unsigned*)(lfb + o), qw = *(const unsigned*)(qs + o);
              const float l0 = bflo(lw), l1 = bfhi(lw); r0 += l0; r1 += l1;
              const float k0 = 1.0f - fast_exp(l0), k1 = 1.0f - fast_exp(l1);
              *(unsigned*)(qtb + o) = cvt_pk_bf16(bflo(qw) * fast_exp(r0), bfhi(qw) * fast_exp(r1));
              *(unsigned*)(lfb + o) = cvt_pk_bf16(k0 * fast_exp(fminf(-r0, 80.f)), k1 * fast_exp(fminf(-r1, 80.f))); }
          *(f32x2*)(dB + (size_t)chunk * 1024 + h * 128 + 2 * lane) = (f32x2){fast_exp(r0), fast_exp(r1)}; }
        { float r0 = 0.f, r1 = 0.f;
#pragma unroll 8
          for (int tau = 0; tau < 32; ++tau) { const size_t o = base + (size_t)tau * 1024; const unsigned lw = *(const unsigned*)(lff + o), qw = *(const unsigned*)(qs + o);
              const float l0 = bflo(lw), l1 = bfhi(lw); r0 += l0; r1 += l1;
              const float k0 = 1.0f - fast_exp(l0), k1 = 1.0f - fast_exp(l1);
              *(unsigned*)(qs + o) = cvt_pk_bf16(bflo(qw) * fast_exp(r0), bfhi(qw) * fast_exp(r1));
              *(unsigned*)(lff + o) = cvt_pk_bf16(k0 * fast_exp(fminf(-r0, 80.f)), k1 * fast_exp(fminf(-r1, 80.f))); }
          *(f32x2*)(dF + (size_t)chunk * 1024 + h * 128 + 2 * lane) = (f32x2){fast_exp(r0), fast_exp(r1)}; }
    }
}

constexpr int QT_OFF = 0, KT_OFF = 8192, V_OFF = 16384, P_OFF = 24576, ST_OFF = 34816, DV_OFF = 69632, CHAIN_BYTES = 70144;
constexpr int RS = 272, RS2 = 80;
__device__ __forceinline__ int crow(int r, int hi) { return (r & 3) + 8 * (r >> 2) + 4 * hi; }
__device__ __forceinline__ unsigned off_b(unsigned row, unsigned ch) { return 256u * row + 16u * (ch ^ (((row & 3) << 2) | ((row >> 2) & 3))); }
__device__ __forceinline__ unsigned row_read_addr(unsigned lane, unsigned s) { return off_b(lane & 31, 2 * s + (lane >> 5)); }
__device__ __forceinline__ unsigned tr_read_addr(unsigned lane, unsigned cc, unsigned ks, unsigned t) {
    const unsigned h = lane >> 5, blk = (lane >> 4) & 1, q = (lane & 15) >> 2, p = lane & 3;
    return off_b(16 * ks + 8 * h + 4 * t + q, 4 * cc + 2 * blk + (p >> 1)) + 8 * (p & 1);
}
__device__ __forceinline__ s16x4 tr_rd(unsigned addr) { s16x4 r; asm volatile("ds_read_b64_tr_b16 %0, %1" : "=&v"(r) : "v"(addr) : "memory"); return r; }
#define TRPK(L, H) (bf16x8){L[0], L[1], L[2], L[3], H[0], H[1], H[2], H[3]}

__device__ __forceinline__ void run_pair(const Ctx& c, int tok0, int L, int h, bool dummy) {
    bf16_t* pl = (bf16_t*)(c.ws + B_PLANE); const size_t PE = (size_t)T * 1024;
    const int tid = c.tid, lane = c.lane, wave = c.wave, ch = wave >> 2, w = wave & 3, r32 = lane & 31, hi = lane >> 5;
    const bf16_t* qt = ch ? (const bf16_t*)(c.ws + WS_XB) : pl; bf16_t* kt = pl + (size_t)(1 + ch) * PE; const bf16_t* vv = pl + 3 * PE;
    const float* dd = (const float*)(c.ws + (ch ? D_B : D_F));
    bf16_t* odst = dummy ? (bf16_t*)(c.ws + R2_PB) - (size_t)20 * MiB : kt;
    LAS unsigned char* base = c.lds + ch * CHAIN_BYTES;
    const unsigned lbase = (unsigned)(uintptr_t)base;
    const int ctid = tid & 255;
    const int NC = L / 32;
    const int vcol = 32 * w + r32;
    LAS unsigned char* Pw = base + P_OFF + w * 2560;
    const int s_r0 = ctid >> 4, s_chn = ctid & 15;
    u32x4 sreg[6]; f32x4 dreg = (f32x4){0.f, 0.f, 0.f, 0.f};
#define SCAN_LOAD(cidx) do { const size_t rowb = (size_t)(tok0 + 32 * (cidx)) * 1024 + h * 128; \
        _Pragma("unroll") for (int i = 0; i < 6; ++i) { const bf16_t* src = ((i >> 1) == 0 ? qt : ((i >> 1) == 1 ? (const bf16_t*)kt : vv)) + rowb + (size_t)(s_r0 + 16 * (i & 1)) * 1024 + s_chn * 8; sreg[i] = *(const u32x4*)src; } \
        if (ctid < 32) dreg = *(const f32x4*)(dd + (size_t)((tok0 >> 5) + (cidx)) * 1024 + h * 128 + 4 * ctid); } while (0)
#define SCAN_WRITE() do { _Pragma("unroll") for (int i = 0; i < 6; ++i) *(LAS u32x4*)(base + (i >> 1) * 8192 + off_b(s_r0 + 16 * (i & 1), s_chn)) = sreg[i]; \
        if (ctid < 32) *(LAS f32x4*)(base + DV_OFF + 16 * ctid) = dreg; } while (0)
    { LAS u32x4* st = (LAS u32x4*)(base + ST_OFF + (32 * w) * RS); for (int i = lane; i < 32 * RS / 16; i += 64) st[i] = (u32x4){0u, 0u, 0u, 0u}; }
    f32x16 S[4];
#pragma unroll
    for (int kt2 = 0; kt2 < 4; ++kt2) S[kt2] = f32x16{};
    SCAN_LOAD(ch ? NC - 1 : 0); SCAN_WRITE();
    __syncthreads();
    for (int ci = 0; ci < NC; ++ci) {
        const int cidx = ch ? NC - 1 - ci : ci;
        if (ci + 1 < NC) SCAN_LOAD(ch ? cidx - 1 : cidx + 1);
        f32x16 X = f32x16{};
#pragma unroll
        for (int ks = 0; ks < 8; ++ks) { const bf16x8 qa = *(const LAS bf16x8*)(base + QT_OFF + row_read_addr(lane, ks));
            const bf16x8 kb = *(const LAS bf16x8*)(base + KT_OFF + row_read_addr(lane, ks));
            X = __builtin_amdgcn_mfma_f32_32x32x16_bf16(qa, kb, X, 0, 0, 0); }
#pragma unroll
        for (int r = 0; r < 16; ++r) { const int t = crow(r, hi); const bool keep = ch ? (t <= r32) : (t >= r32); *(LAS bf16_t*)(Pw + t * RS2 + r32 * 2) = f2bf(keep ? X[r] : 0.f); }
        s16x4 vl[2], vh[2];
#pragma unroll
        for (int ks = 0; ks < 2; ++ks) { vl[ks] = tr_rd(lbase + V_OFF + tr_read_addr(lane, w, ks, 0)); vh[ks] = tr_rd(lbase + V_OFF + tr_read_addr(lane, w, ks, 1)); }
        asm volatile("s_waitcnt lgkmcnt(0)" ::: "memory"); __builtin_amdgcn_sched_barrier(0);
        bf16x8 vb[2];
#pragma unroll
        for (int ks = 0; ks < 2; ++ks) vb[ks] = TRPK(vl[ks], vh[ks]);
        f32x16 O = f32x16{};
#pragma unroll
        for (int ks = 0; ks < 2; ++ks) { const bf16x8 pa = *(const LAS bf16x8*)(Pw + r32 * RS2 + (16 * ks + 8 * hi) * 2);
            O = __builtin_amdgcn_mfma_f32_32x32x16_bf16(pa, vb[ks], O, 0, 0, 0); }
#pragma unroll
        for (int ks = 0; ks < 8; ++ks) { const bf16x8 sb = *(const LAS bf16x8*)(base + ST_OFF + vcol * RS + (16 * ks + 8 * hi) * 2);
            const bf16x8 qa = *(const LAS bf16x8*)(base + QT_OFF + row_read_addr(lane, ks));
            O = __builtin_amdgcn_mfma_f32_32x32x16_bf16(qa, sb, O, 0, 0, 0); }
#pragma unroll
        for (int r = 0; r < 16; ++r) { const int t = tok0 + 32 * cidx + crow(r, hi); odst[(size_t)t * 1024 + h * 128 + vcol] = f2bf(O[r]); }
#pragma unroll
        for (int kt2 = 0; kt2 < 4; ++kt2) {
            s16x4 al[2], ah[2];
#pragma unroll
            for (int ks = 0; ks < 2; ++ks) { al[ks] = tr_rd(lbase + KT_OFF + tr_read_addr(lane, kt2, ks, 0)); ah[ks] = tr_rd(lbase + KT_OFF + tr_read_addr(lane, kt2, ks, 1)); }
            asm volatile("s_waitcnt lgkmcnt(0)" ::: "memory"); __builtin_amdgcn_sched_barrier(0);
#pragma unroll
            for (int ks = 0; ks < 2; ++ks) S[kt2] = __builtin_amdgcn_mfma_f32_32x32x16_bf16(TRPK(al[ks], ah[ks]), vb[ks], S[kt2], 0, 0, 0);
#pragma unroll
            for (int g = 0; g < 4; ++g) { const f32x4 d4 = *(const LAS f32x4*)(base + DV_OFF + (32 * kt2 + 8 * g + 4 * hi) * 4);
#pragma unroll
                for (int e = 0; e < 4; ++e) S[kt2][4 * g + e] *= d4[e];
                u32x2 pk; pk.x = cvt_pk_bf16(S[kt2][4 * g], S[kt2][4 * g + 1]); pk.y = cvt_pk_bf16(S[kt2][4 * g + 2], S[kt2][4 * g + 3]);
                *(LAS u32x2*)(base + ST_OFF + vcol * RS + (32 * kt2 + 8 * g + 4 * hi) * 2) = pk; }
        }
        __syncthreads();
        if (ci + 1 < NC) SCAN_WRITE();
        __syncthreads();
    }
#undef SCAN_LOAD
#undef SCAN_WRITE
}
#undef TRPK
__device__ __forceinline__ void hgrn_scan(const Ctx& c, bool dummy) {
    const int NP = 16 + 256;
    for (int rnd = 0;; ++rnd) {
        const int p = (rnd & 1) ? (rnd * c.G + (c.G - 1 - c.bid)) : (rnd * c.G + c.bid);
        if (rnd * c.G >= NP) break;
        if (p < NP) {
            const int tok0 = p < 16 ? (p >> 3) * SP : TP + ((p - 16) >> 3) * SS, L = p < 16 ? SP : SS, h = p < 16 ? (p & 7) : ((p - 16) & 7);
            run_pair(c, tok0, L, h, dummy);
        }
    }
}
}
namespace peer {
constexpr int KEY_RS = 272;
constexpr int KEYS_BYTES = 2 * 128 * KEY_RS;
constexpr int SI_OFF = KEYS_BYTES;
__device__ __forceinline__ int crow(int r, int hi) { return (r & 3) + 8 * (r >> 2) + 4 * hi; }
__device__ __forceinline__ unsigned sortable(float f) { const unsigned u = __float_as_uint(f); return u ^ ((u >> 31) ? 0xFFFFFFFFu : 0x80000000u); }
__device__ __forceinline__ float unsortable(unsigned s) { const unsigned u = (s >> 31) ? (s ^ 0x80000000u) : ~s; return __uint_as_float(u); }
__device__ __forceinline__ unsigned pair_max(unsigned m) { auto rr = __builtin_amdgcn_permlane32_swap(m, m, false, false); return rr[0] > rr[1] ? rr[0] : rr[1]; }

__device__ __forceinline__ void top16_half(const Ctx& c, const bf16_t* pq_rows, int half, LAS unsigned char* keys, unsigned (&sel)[16]) {
    const int lane = c.lane, r32 = lane & 31, hi = lane >> 5;
    f32x16 acc[4];
#pragma unroll
    for (int nt = 0; nt < 4; ++nt) acc[nt] = f32x16{};
    const bf16_t* qrow = pq_rows + (size_t)r32 * 256 + half * 128;
#pragma unroll 1
    for (int ks = 0; ks < 8; ++ks) { const bf16x8 qb = *reinterpret_cast<const bf16x8*>(qrow + 16 * ks + 8 * hi);
#pragma unroll
        for (int nt = 0; nt < 4; ++nt) { const bf16x8 ka = *(const LAS bf16x8*)(keys + (half * 128 + 32 * nt + r32) * KEY_RS + (16 * ks + 8 * hi) * 2);
            acc[nt] = __builtin_amdgcn_mfma_f32_32x32x16_bf16(ka, qb, acc[nt], 0, 0, 0); } }
    unsigned p[64];
#pragma unroll
    for (int nt = 0; nt < 4; ++nt)
#pragma unroll
        for (int r = 0; r < 16; ++r) { const int n = 32 * nt + crow(r, hi); p[nt * 16 + r] = (sortable(acc[nt][r]) & ~127u) | (unsigned)(127 - n); }
#pragma unroll
    for (int it = 0; it < 16; ++it) {
        unsigned m = p[0];
#pragma unroll
        for (int i = 1; i < 64; ++i) m = p[i] > m ? p[i] : m;
        m = pair_max(m); sel[it] = m;
#pragma unroll
        for (int i = 0; i < 64; ++i) p[i] = (p[i] == m) ? 0u : p[i];
    }
}
__device__ __forceinline__ void route(const Ctx& c, int layer) {
    const bf16_t* pq = (const bf16_t*)(c.ws + B_PQ); int* idx_out = (int*)(c.ws + R2_IDX); float* gate_out = (float*)(c.ws + R2_GATE);
    const bf16_t* keys_g = (const bf16_t*)(c.ws + W_KEYS) + (size_t)layer * 2 * 128 * 128;
    LAS unsigned char* keys = c.lds;
    const int lane = c.lane, r32 = lane & 31, hi = lane >> 5;
    for (int i = c.tid; i < 2 * 128 * 16; i += NTHR) { const int row = i >> 4, ch = i & 15; *(LAS u32x4*)(keys + row * KEY_RS + ch * 16) = *(const u32x4*)(keys_g + (size_t)row * 128 + ch * 8); }
    __syncthreads();
    LAS int* si = (LAS int*)(c.lds + SI_OFF + c.wave * 4096) + r32 * 32;
    for (int grp = c.gw; grp < T / 4; grp += c.NGW) {
        const bf16_t* rows = pq + (size_t)grp * 4 * 2048;
        unsigned s1[16], s2[16];
        top16_half(c, rows, 0, keys, s1);
        top16_half(c, rows, 1, keys, s2);
        float v1[16], v2[16];
#pragma unroll
        for (int i = 0; i < 16; ++i) { v1[i] = unsortable(s1[i] & ~127u); v2[i] = unsortable(s2[i] & ~127u); }
        if (hi == 0) {
#pragma unroll
            for (int i = 0; i < 16; ++i) { si[i] = 127 - (int)(s1[i] & 127u); si[16 + i] = 127 - (int)(s2[i] & 127u); }
        }
        float A[16], B[16];
#pragma unroll
        for (int i = 0; i < 16; ++i) { A[i] = hi ? v2[i] : v1[i]; B[i] = hi ? v1[i] : v2[i]; }
        unsigned cd[27]; int nc = 0;
#pragma unroll
        for (int i = 0; i < 16; ++i)
#pragma unroll
            for (int j = i; j < 16; ++j) if ((i + 1) * (j + 1) <= 16) {
                const unsigned flat = hi ? (unsigned)(j * 16 + i) : (unsigned)(i * 16 + j);
                unsigned pk = (sortable(A[i] + B[j]) & ~255u) | (255u - flat);
                if (i == j) pk = hi ? 0u : pk;
                cd[nc++] = pk; }
        unsigned sel[16];
#pragma unroll
        for (int it = 0; it < 16; ++it) {
            unsigned m = cd[0];
#pragma unroll
            for (int i = 1; i < 27; ++i) m = cd[i] > m ? cd[i] : m;
            m = pair_max(m); sel[it] = m;
#pragma unroll
            for (int i = 0; i < 27; ++i) cd[i] = (cd[i] == m) ? 0u : cd[i];
        }
        LDS_WAIT(); asm volatile("" ::: "memory");
        const float vmax = unsortable(sel[0] & ~255u);
        float e[16], es = 0.f;
#pragma unroll
        for (int i = 0; i < 16; ++i) { e[i] = fast_exp(unsortable(sel[i] & ~255u) - vmax); es += e[i]; }
        const float inv = 1.0f / es;
        const size_t obase = ((size_t)grp * 4 + (r32 >> 3)) * 128 + (r32 & 7) * 16 + 8 * hi;
        int oi[8]; float og[8];
#pragma unroll
        for (int q = 0; q < 8; ++q) { const unsigned sv = hi ? sel[8 + q] : sel[q]; const float ev = hi ? e[8 + q] : e[q];
            const int flat = 255 - (int)(sv & 255u); oi[q] = si[flat >> 4] * 128 + si[16 + (flat & 15)]; og[q] = ev * inv; }
        *(u32x4*)(idx_out + obase) = (u32x4){(unsigned)oi[0], (unsigned)oi[1], (unsigned)oi[2], (unsigned)oi[3]};
        *(u32x4*)(idx_out + obase + 4) = (u32x4){(unsigned)oi[4], (unsigned)oi[5], (unsigned)oi[6], (unsigned)oi[7]};
        *(f32x4*)(gate_out + obase) = (f32x4){og[0], og[1], og[2], og[3]};
        *(f32x4*)(gate_out + obase + 4) = (f32x4){og[4], og[5], og[6], og[7]};
        LDS_WAIT(); asm volatile("" ::: "memory");
    }
    __syncthreads();
}

__device__ __forceinline__ float gelu_exact(float x) { return 0.5f * x * (1.0f + erff(x * 0.70710678118654752f)); }
template <int IDXMASK> __device__ __forceinline__ void gather_ln(const Ctx& c, int layer, float* xout, bf16_t* xb) {
    const unsigned char* U8 = c.ws + R2_UB; const unsigned char* V8 = c.ws + R2_VB;
    const float* su = (const float*)(c.ws + R2_SU); const float* sv = (const float*)(c.ws + R2_SV);
    const int* idx = (const int*)(c.ws + R2_IDX); const float* gate = (const float*)(c.ws + R2_GATE);
    const float* lg = c.in(20) + layer * D; const float* lbv = c.in(21) + layer * D;
    const int lane = c.lane;
    for (int t = c.gw; t < T; t += c.NGW) {
        const float* xr = c.out + (size_t)t * D + 16 * lane; float* xw = xout + (size_t)t * D + 16 * lane;
        float x[16], acc[16];
#pragma unroll
        for (int j = 0; j < 4; ++j) { const f32x4 a = *(const f32x4*)(xr + 4 * j); x[4 * j] = a[0]; x[4 * j + 1] = a[1]; x[4 * j + 2] = a[2]; x[4 * j + 3] = a[3]; }
#pragma unroll
        for (int e = 0; e < 16; ++e) acc[e] = 0.f;
        const int myidx0 = idx[(size_t)t * 128 + lane] & IDXMASK, myidx1 = idx[(size_t)t * 128 + 64 + lane] & IDXMASK;
        const float myg0 = gate[(size_t)t * 128 + lane], myg1 = gate[(size_t)t * 128 + 64 + lane];
        for (int eb = 0; eb < 128; eb += 8) {
            float part[8]; int ei[8];
#pragma unroll
            for (int q = 0; q < 8; ++q) { const int e = eb + q; ei[q] = __builtin_amdgcn_readlane(e < 64 ? myidx0 : myidx1, e & 63); }
            u32x4 vr[8];
#pragma unroll
            for (int q = 0; q < 8; ++q) vr[q] = *(const u32x4*)(V8 + (size_t)ei[q] * D + 16 * lane);
#pragma unroll
            for (int q = 0; q < 8; ++q) { const u32x4 a = *(const u32x4*)(U8 + (size_t)ei[q] * D + 16 * lane);
                float s = 0.f;
#pragma unroll
                for (int j = 0; j < 4; ++j) { const f32x2 lo = __builtin_amdgcn_cvt_pk_f32_fp8((int)a[j], false), hi = __builtin_amdgcn_cvt_pk_f32_fp8((int)a[j], true);
                    s = fmaf(lo[0], x[4 * j], s); s = fmaf(lo[1], x[4 * j + 1], s); s = fmaf(hi[0], x[4 * j + 2], s); s = fmaf(hi[1], x[4 * j + 3], s); }
                part[q] = s; }
            float r4[4], r2[2], r1;
            { const bool up = (lane & 32) != 0;
#pragma unroll
              for (int i = 0; i < 4; ++i) { const float send = up ? part[i] : part[4 + i]; const float keep = up ? part[4 + i] : part[i]; r4[i] = keep + __shfl_xor(send, 32); } }
            { const bool up = (lane & 16) != 0;
#pragma unroll
              for (int i = 0; i < 2; ++i) { const float send = up ? r4[i] : r4[2 + i]; const float keep = up ? r4[2 + i] : r4[i]; r2[i] = keep + __shfl_xor(send, 16); } }
            { const bool up = (lane & 8) != 0; const float send = up ? r2[0] : r2[1]; const float keep = up ? r2[1] : r2[0]; r1 = keep + __shfl_xor(send, 8); }
            r1 += __shfl_xor(r1, 4); r1 += __shfl_xor(r1, 2); r1 += __shfl_xor(r1, 1);
            const int myq = ((lane >> 5) & 1) * 4 + ((lane >> 4) & 1) * 2 + ((lane >> 3) & 1);
            const int me = eb + myq;
            const float g = __shfl(me < 64 ? myg0 : myg1, me & 63);
            const int mye = __shfl(me < 64 ? myidx0 : myidx1, me & 63);
            const float cf = g * gelu_exact(r1 * su[mye]) * sv[mye];
            float cq[8];
#pragma unroll
            for (int q = 0; q < 8; ++q) cq[q] = __int_as_float(__builtin_amdgcn_readlane(__float_as_int(cf), ((q >> 2) & 1) * 32 + ((q >> 1) & 1) * 16 + (q & 1) * 8));
#pragma unroll
            for (int q = 0; q < 8; ++q) { const float s = cq[q];
#pragma unroll
                for (int j = 0; j < 4; ++j) { const f32x2 lo = __builtin_amdgcn_cvt_pk_f32_fp8((int)vr[q][j], false), hi = __builtin_amdgcn_cvt_pk_f32_fp8((int)vr[q][j], true);
                    acc[4 * j] = fmaf(s, lo[0], acc[4 * j]); acc[4 * j + 1] = fmaf(s, lo[1], acc[4 * j + 1]); acc[4 * j + 2] = fmaf(s, hi[0], acc[4 * j + 2]); acc[4 * j + 3] = fmaf(s, hi[1], acc[4 * j + 3]); } }
        }
        float s = 0.f;
#pragma unroll
        for (int e = 0; e < 16; ++e) { acc[e] = fmaf(DN_ALPHA, x[e], acc[e]); s += acc[e]; }
        const float mean = wave_sum(s) * (1.0f / D); float s2 = 0.f;
#pragma unroll
        for (int e = 0; e < 16; ++e) { acc[e] -= mean; s2 += acc[e] * acc[e]; }
        const float rstd = 1.0f / sqrtf(wave_sum(s2) * (1.0f / D) + LN_EPS);
        float o[16];
#pragma unroll
        for (int j = 0; j < 4; ++j) { const f32x4 g4 = *(const f32x4*)(lg + 16 * lane + 4 * j), b4 = *(const f32x4*)(lbv + 16 * lane + 4 * j);
#pragma unroll
            for (int e = 0; e < 4; ++e) o[4 * j + e] = acc[4 * j + e] * rstd * g4[e] + b4[e];
            *(f32x4*)(xw + 4 * j) = (f32x4){o[4 * j], o[4 * j + 1], o[4 * j + 2], o[4 * j + 3]}; }
        u32x4 w0, w1; w0.x = cvt_pk_bf16(o[0], o[1]); w0.y = cvt_pk_bf16(o[2], o[3]); w0.z = cvt_pk_bf16(o[4], o[5]); w0.w = cvt_pk_bf16(o[6], o[7]);
        w1.x = cvt_pk_bf16(o[8], o[9]); w1.y = cvt_pk_bf16(o[10], o[11]); w1.z = cvt_pk_bf16(o[12], o[13]); w1.w = cvt_pk_bf16(o[14], o[15]);
        *(u32x4*)(xb + (size_t)t * D + 16 * lane) = w0; *(u32x4*)(xb + (size_t)t * D + 16 * lane + 8) = w1;
    }
}
}
namespace peer {
constexpr size_t HP_OFF = WS_BIG;
constexpr int QW_BASE = 4096;
constexpr int ITEM_TOK = 64, NBLK = T / ITEM_TOK;
#define DPP_F(v, ctrl) __int_as_float(__builtin_amdgcn_update_dpp(0, __float_as_int(v), (ctrl), 0xf, 0xf, true))

template <class F> __device__ __forceinline__ void for_items(const Ctx& c, int layer, int phase, F body) {
    unsigned* qw = (unsigned*)(c.ws + WS_CTL) + QW_BASE + (size_t)((layer * 2 + phase) * 8) * 16;
    volatile LAS int* slot = (volatile LAS int*)(c.lds + LDS_MISC_OFF + 128);
    const int home = (int)(xb_xcc_id() & 7u);
    for (int k = 0; k < 8; ++k) {
        const int s = (home + k) & 7;
        if (c.tid == 0) slot[0] = (int)__hip_atomic_fetch_add(qw + s * 16, 1u, __ATOMIC_RELAXED, __HIP_MEMORY_SCOPE_AGENT);
        __syncthreads();
        int cur = slot[0];
        __syncthreads();
        while (cur < NBLK) {
            if (c.tid == 0) slot[0] = (int)__hip_atomic_fetch_add(qw + s * 16, 1u, __ATOMIC_RELAXED, __HIP_MEMORY_SCOPE_AGENT);
            body(s, cur);
            __syncthreads();
            cur = slot[0];
            __syncthreads();
        }
    }
}

__device__ __forceinline__ void g1_udot(const Ctx& c, int layer) {
    const unsigned char* U8 = c.ws + R2_UB; const int* idx = (const int*)(c.ws + R2_IDX); float* hp = (float*)(c.ws + HP_OFF);
    const int lane = c.lane, g = lane >> 3, c8 = lane & 7;
    for_items(c, layer, 0, [&](int s, int blk) {
        const int co = 128 * s + 16 * c8;
#pragma unroll 1
        for (int i = 0; i < ITEM_TOK / NWAVES; ++i) {
            const int t = blk * ITEM_TOK + c.wave * (ITEM_TOK / NWAVES) + i;
            float x[16]; int id[16];
#pragma unroll
            for (int j = 0; j < 4; ++j) { const f32x4 a = *(const f32x4*)(c.out + (size_t)t * D + co + 4 * j); x[4 * j] = a[0]; x[4 * j + 1] = a[1]; x[4 * j + 2] = a[2]; x[4 * j + 3] = a[3];
                const u32x4 q = *(const u32x4*)(idx + (size_t)t * 128 + 16 * g + 4 * j); id[4 * j] = (int)q[0]; id[4 * j + 1] = (int)q[1]; id[4 * j + 2] = (int)q[2]; id[4 * j + 3] = (int)q[3]; }
            u32x4 row[16];
#pragma unroll
            for (int j = 0; j < 16; ++j) row[j] = *(const u32x4*)(U8 + (size_t)id[j] * D + co);
            float V[16];
#pragma unroll
            for (int j = 0; j < 16; ++j) { float acc = 0.f;
#pragma unroll
                for (int q = 0; q < 4; ++q) { const f32x2 lo = __builtin_amdgcn_cvt_pk_f32_fp8((int)row[j][q], false), hi = __builtin_amdgcn_cvt_pk_f32_fp8((int)row[j][q], true);
                    acc = fmaf(lo[0], x[4 * q], acc); acc = fmaf(lo[1], x[4 * q + 1], acc); acc = fmaf(hi[0], x[4 * q + 2], acc); acc = fmaf(hi[1], x[4 * q + 3], acc); }
                V[j] = acc; }
            float W[8], Y[4], Z[2];
            { const bool hiA = (lane & 4) != 0;
#pragma unroll
              for (int m = 0; m < 8; ++m) { const float send = hiA ? V[m] : V[8 + m], keep = hiA ? V[8 + m] : V[m]; W[m] = keep + DPP_F(send, 0x141); } }
            { const bool hiB = (lane & 2) != 0;
#pragma unroll
              for (int m = 0; m < 4; ++m) { const float send = hiB ? W[m] : W[4 + m], keep = hiB ? W[4 + m] : W[m]; Y[m] = keep + DPP_F(send, 0x1B); } }
            { const bool hiC = (lane & 1) != 0;
#pragma unroll
              for (int m = 0; m < 2; ++m) { const float send = hiC ? Y[m] : Y[2 + m], keep = hiC ? Y[2 + m] : Y[m]; Z[m] = keep + DPP_F(send, 0xB1); } }
            *(f32x2*)(hp + ((size_t)s * T + t) * 128 + 16 * g + 2 * c8) = (f32x2){Z[0], Z[1]};
        }
    });
}
__device__ __forceinline__ void g2_coef(const Ctx& c) {
    const int* idx = (const int*)(c.ws + R2_IDX); float* gate = (float*)(c.ws + R2_GATE); const float* hp = (const float*)(c.ws + HP_OFF);
    const float* su = (const float*)(c.ws + R2_SU); const float* sv = (const float*)(c.ws + R2_SV);
    const int lane = c.lane;
    for (int t = c.gw; t < T; t += c.NGW) {
#pragma unroll
        for (int k = 0; k < 2; ++k) { const int p = lane + 64 * k; float h = 0.f;
#pragma unroll
            for (int s = 0; s < 8; ++s) h += hp[((size_t)s * T + t) * 128 + p];
            const int e = idx[(size_t)t * 128 + p]; const float gt = gate[(size_t)t * 128 + p];
            gate[(size_t)t * 128 + p] = gt * gelu_exact(h * su[e]) * sv[e]; }
    }
}
__device__ __forceinline__ void g3_vaxpy(const Ctx& c, int layer) {
    const unsigned char* V8 = c.ws + R2_VB; const int* idx = (const int*)(c.ws + R2_IDX); const float* coef = (const float*)(c.ws + R2_GATE);
    const int lane = c.lane, g = lane >> 3, c8 = lane & 7;
    for_items(c, layer, 1, [&](int s, int blk) {
        const int co = 128 * s + 16 * c8;
#pragma unroll 1
        for (int i = 0; i < ITEM_TOK / NWAVES; ++i) {
            const int t = blk * ITEM_TOK + c.wave * (ITEM_TOK / NWAVES) + i;
            float cf[16]; int id[16];
#pragma unroll
            for (int j = 0; j < 4; ++j) { const f32x4 a = *(const f32x4*)(coef + (size_t)t * 128 + 16 * g + 4 * j); cf[4 * j] = a[0]; cf[4 * j + 1] = a[1]; cf[4 * j + 2] = a[2]; cf[4 * j + 3] = a[3];
                const u32x4 q = *(const u32x4*)(idx + (size_t)t * 128 + 16 * g + 4 * j); id[4 * j] = (int)q[0]; id[4 * j + 1] = (int)q[1]; id[4 * j + 2] = (int)q[2]; id[4 * j + 3] = (int)q[3]; }
            u32x4 row[16];
#pragma unroll
            for (int j = 0; j < 16; ++j) row[j] = *(const u32x4*)(V8 + (size_t)id[j] * D + co);
            float A[16];
#pragma unroll
            for (int e = 0; e < 16; ++e) A[e] = 0.f;
#pragma unroll
            for (int j = 0; j < 16; ++j) { const float sc = cf[j];
#pragma unroll
                for (int q = 0; q < 4; ++q) { const f32x2 lo = __builtin_amdgcn_cvt_pk_f32_fp8((int)row[j][q], false), hi = __builtin_amdgcn_cvt_pk_f32_fp8((int)row[j][q], true);
                    A[4 * q] = fmaf(sc, lo[0], A[4 * q]); A[4 * q + 1] = fmaf(sc, lo[1], A[4 * q + 1]); A[4 * q + 2] = fmaf(sc, hi[0], A[4 * q + 2]); A[4 * q + 3] = fmaf(sc, hi[1], A[4 * q + 3]); } }
            float R[8], S2[4], Y[2];
#pragma unroll
            for (int m = 0; m < 8; ++m) { auto rr = __builtin_amdgcn_permlane32_swap(__float_as_uint(A[m]), __float_as_uint(A[8 + m]), false, false); R[m] = __uint_as_float(rr[0]) + __uint_as_float(rr[1]); }
#pragma unroll
            for (int m = 0; m < 4; ++m) { auto rr = __builtin_amdgcn_permlane16_swap(__float_as_uint(R[m]), __float_as_uint(R[4 + m]), false, false); S2[m] = __uint_as_float(rr[0]) + __uint_as_float(rr[1]); }
            { const bool hi8 = (lane & 8) != 0;
#pragma unroll
              for (int m = 0; m < 2; ++m) { const float send = hi8 ? S2[m] : S2[2 + m], keep = hi8 ? S2[2 + m] : S2[m]; Y[m] = keep + DPP_F(send, 0x128); } }
            float* yp = c.out + (size_t)t * D + co + 8 * ((lane >> 5) & 1) + 4 * ((lane >> 4) & 1) + 2 * ((lane >> 3) & 1);
            const f32x2 xo = *(const f32x2*)yp;
            *(f32x2*)yp = (f32x2){fmaf(DN_ALPHA, xo[0], Y[0]), fmaf(DN_ALPHA, xo[1], Y[1])};
        }
    });
}
__device__ __forceinline__ void ln_pass(const Ctx& c, const float* g, const float* b) {
    bf16_t* xb = (bf16_t*)(c.ws + WS_XB); const int lane = c.lane;
    for (int t = c.gw; t < T; t += c.NGW) {
        float* xr = c.out + (size_t)t * D;
        f32x4 v[4]; float s = 0.f;
#pragma unroll
        for (int j = 0; j < 4; ++j) { v[j] = *(const f32x4*)(xr + 256 * j + 4 * lane); s += (v[j][0] + v[j][1]) + (v[j][2] + v[j][3]); }
        const float mean = wave_sum(s) * (1.0f / D); float s2 = 0.f;
#pragma unroll
        for (int j = 0; j < 4; ++j) { v[j] = v[j] - mean; s2 += (v[j][0] * v[j][0] + v[j][1] * v[j][1]) + (v[j][2] * v[j][2] + v[j][3] * v[j][3]); }
        const float rstd = 1.0f / sqrtf(wave_sum(s2) * (1.0f / D) + LN_EPS);
#pragma unroll
        for (int j = 0; j < 4; ++j) { const f32x4 gg = *(const f32x4*)(g + 256 * j + 4 * lane), bb = *(const f32x4*)(b + 256 * j + 4 * lane); const f32x4 o = v[j] * rstd * gg + bb;
            *(f32x4*)(xr + 256 * j + 4 * lane) = o; u32x2 w; w.x = cvt_pk_bf16(o[0], o[1]); w.y = cvt_pk_bf16(o[2], o[3]); *(u32x2*)(xb + (size_t)t * D + 256 * j + 4 * lane) = w; }
    }
}
#undef DPP_F
}
__global__ void __launch_bounds__(256) k_checksum(const unsigned* p, size_t nwords, unsigned long long* dst) {
    unsigned long long acc = 0;
    for (size_t i = (size_t)blockIdx.x * 256 + threadIdx.x; i < nwords; i += (size_t)gridDim.x * 256) acc += (unsigned long long)p[i] * (unsigned long long)(2 * i + 1);
    for (int o = 32; o >= 1; o >>= 1) acc += __shfl_xor(acc, o);
    if ((threadIdx.x & 63) == 0) atomicAdd(dst, acc);
}
__global__ void __launch_bounds__(256) k_zero_out(float* out, size_t n) { for (size_t i = (size_t)blockIdx.x * 256 + threadIdx.x; i < n; i += (size_t)gridDim.x * 256) out[i] = 0.f; }
__global__ void k_report(const unsigned long long* tab, int nent, float* out) {
    if (threadIdx.x == 0 && blockIdx.x == 0) { int first = -1; for (int i = 0; i < nent; ++i) if (tab[i] != tab[nent + i]) { first = i; break; }
        out[0] = first < 0 ? 99000.f : 1000.f * (float)(first / 4 + 1); out[1] = first < 0 ? 0.f : (float)(first % 4); }
}
struct Reg { size_t off; size_t bytes; int in_out; };
static int phase_regions(int p, Reg* r) {
    int n = 0;
    auto add = [&](size_t off, size_t mib) { r[n].off = off; r[n].bytes = mib * MiB; r[n].in_out = 0; ++n; };
    auto addout = [&]() { r[n].off = 0; r[n].bytes = (size_t)T * D * 4; r[n].in_out = 1; ++n; };
    if (p == 0) { add(WS_W, 61); add(WS_R2, 160); addout(); return n; }
    int q = p - 1;
    for (int layer = 0; layer < NL; ++layer) {
        const int nm = (layer & 1) ? 5 : 7;
        if (q < nm) {
            if ((layer & 1) == 0) { switch (q) { case 0: add(B_A32, 240); break; case 1: add(R2_UB, 34); add(R2_PB, 40); add(B_CQN, 100); add(B_KROPE, 10); break; case 2: add(B_Q, 240); break; case 3: add(B_KV, 320); break;
                case 4: add(B_Q, 240); break; case 5: add(B_O, 160); break; case 6: add(B_H32_MLA, 320); break; } }
            else { switch (q) { case 0: add(B_PLANE, 800); break; case 1: add(R2_UB, 34); add(R2_PB, 40); break; case 2: add(B_PLANE + 160 * MiB, 320); break; case 3: add(B_PLANE, 160); break; case 4: add(B_H32_HGRN, 320); break; } }
            return n;
        }
        q -= nm;
        if (q < 6) { switch (q) { case 0: addout(); add(WS_XB, 160); break; case 1: add(B_PQ, 320); break; case 2: add(R2_IDX, 80); break; case 3: addout(); add(WS_XB, 160); break; case 4: add(B_PP, 160); break; case 5: addout(); add(WS_R2, 160); break; }
            return n; }
        q -= 6;
    }
    return n;
}
constexpr int N_PHASES = 1 + 2 * (7 + 8) + 2 * (5 + 8);

#ifndef PROBE_DUP
#define PROBE_DUP 0
#endif
#define PROBE_REP(bit, ...) if constexpr ((PROBE_DUP & (bit)) != 0) { __VA_ARGS__ }
template <class E> struct RepOk { static constexpr bool v = true; };
template <> struct RepOk<pg8::EpiPle> { static constexpr bool v = false; };
#define GEMM_REP_OK(EPI) RepOk<pg8::EPI>::v
#define GEMM_PHASE(EPI, Aptr, Bptr, NN, KK, ...) { pg8::Gemm g{(const bf16_t*)(Aptr), (const bf16_t*)(Bptr), T, (NN), (KK)}; pg8::StaticOrder S; S.init(T, (NN), c.G, c.bid); \
        pg8::EPI E{__VA_ARGS__}; pg8::gemm_phase<pg8::EPI, pg8::StaticOrder>(c.lds, g, S, E); if (GEMM_REP_OK(EPI)) { PROBE_REP(8, __syncthreads(); pg8::gemm_phase<pg8::EPI, pg8::StaticOrder>(c.lds, g, S, E);) } }

__global__ void __launch_bounds__(NTHR, 2) fwd_kernel(Args args) {
    extern __shared__ __attribute__((aligned(16))) unsigned char lds_raw[];
    volatile LAS unsigned* misc = (volatile LAS unsigned*)((LAS unsigned char*)lds_raw + LDS_MISC_OFF);
    if (threadIdx.x < 64) misc[threadIdx.x] = 0u;
    __syncthreads();
    const int lo = args.ph_lo, hi = args.ph_hi;
    XcdBarrier bar; bar.bar = (unsigned*)(args.ws + WS_CTL); bar.x = 0; bar.st = nullptr;
    if (hi - lo > 1) bar = xcd_barrier_post((unsigned*)(args.ws + WS_CTL), misc + 8);
    int ph = 0;
#define PH_BEGIN if (ph >= lo && ph < hi) { const Ctx c = mk_ctx(lds_raw); unsigned char* const ws = c.ws; (void)ws;
#define PH_END   if (ph + 1 < hi) xcd_barrier(bar); } ++ph;

    PH_BEGIN p0_prologue(c); PH_END

    for (int layer = 0; layer < NL; ++layer) {
        const int j = layer >> 1;
        if ((layer & 1) == 0) {
            PH_BEGIN GEMM_PHASE(EpiF32, ws + WS_R2, (const bf16_t*)(ws + W_WA) + (size_t)j * 768 * 1024, 768, 1024, (float*)(ws + B_A32), 768) PH_END
            PH_BEGIN l0_convert(c, layer); mla_e1(c, j); PH_END
            PH_BEGIN GEMM_PHASE(EpiBf16P, ws + B_CQN, (const bf16_t*)(ws + W_WUQ) + (size_t)j * 1536 * 384, 1536, 384, (bf16_t*)(ws + B_Q), 1536) PH_END
            PH_BEGIN GEMM_PHASE(EpiBf16P, ws + B_CKVN, (const bf16_t*)(ws + W_WUKV) + (size_t)j * 2048 * 256, 2048, 256, (bf16_t*)(ws + B_KV), 2048) PH_END
            PH_BEGIN mla_qrope(c); PH_END
            PH_BEGIN mla_attention(c); PROBE_REP(1, mla_attention(c);) PH_END
            PH_BEGIN GEMM_PHASE(EpiF32, ws + B_O, (const bf16_t*)(ws + W_WO) + (size_t)j * 1024 * 1024, 1024, 1024, (float*)(ws + B_H32_MLA), 1024) PH_END
        } else {
            PH_BEGIN GEMM_PHASE(EpiHgrn, ws + WS_R2, (const bf16_t*)(ws + W_HIN) + (size_t)j * 5120 * 1024, 5120, 1024, (bf16_t*)(ws + B_PLANE), (size_t)T * 1024, (const float*)(ws + WS_MISC) + (size_t)j * 2048) PH_END
            PH_BEGIN l0_convert(c, layer); scan::hgrn_prep(c); PH_END
            PH_BEGIN scan::hgrn_scan(c, false); PH_END
            PH_BEGIN hgrn_post(c, j); PH_END
            PH_BEGIN GEMM_PHASE(EpiF32, ws + B_PLANE, (const bf16_t*)(ws + W_HO) + (size_t)j * 1024 * 1024, 1024, 1024, (float*)(ws + B_H32_HGRN), 1024) PH_END
        }
        PH_BEGIN ln_residual(c, (const float*)(ws + ((layer & 1) ? B_H32_HGRN : B_H32_MLA)), c.in(18) + layer * D, c.in(19) + layer * D); PH_END
        PH_BEGIN GEMM_PHASE(EpiBf16P, ws + WS_XB, (const bf16_t*)(ws + W_PQ) + (size_t)layer * 2048 * 1024, 2048, 1024, (bf16_t*)(ws + B_PQ), 2048) PH_END
        PH_BEGIN peer::route(c, layer); PROBE_REP(2, peer::route(c, layer);) PH_END
        PH_BEGIN peer::g1_udot(c, layer); PH_END
        PH_BEGIN peer::g2_coef(c); PH_END
        PH_BEGIN peer::g3_vaxpy(c, layer); PH_END
        PH_BEGIN GEMM_PHASE(EpiBf16P, ws + R2_PB, (const bf16_t*)(ws + W_PP) + (size_t)layer * 1024 * 256, 1024, 256, (bf16_t*)(ws + B_PP), 1024) peer::ln_pass(c, c.in(20) + layer * D, c.in(21) + layer * D); PH_END
        PH_BEGIN GEMM_PHASE(EpiPle, ws + WS_XB, (const bf16_t*)(ws + W_GW) + (size_t)layer * 1024 * 1024, 1024, 1024, c.out, (const bf16_t*)(ws + B_PP), c.in(23) + layer * D, (bf16_t*)(ws + WS_R2)) PH_END
    }
#undef PH_BEGIN
#undef PH_END
}

extern "C" void kernel_launch(void* const* d_in, const int* in_sizes, int n_in, void* d_out, int out_size, void* d_ws, size_t ws_size, hipStream_t stream) {
    static int grid = 0;
    if (grid == 0) {
        if (n_in != 25 || out_size != T * D || ws_size < WS_END) { fprintf(stderr, "kernel_launch: unexpected shapes: n_in %d out %d ws %zu (need %zu)\n", n_in, out_size, ws_size, (size_t)WS_END); grid = -1; return; }
        int dev = 0, cus = 0, per_cu = 0;
        if (hipGetDevice(&dev) != hipSuccess || hipDeviceGetAttribute(&cus, hipDeviceAttributeMultiprocessorCount, dev) != hipSuccess) { grid = -1; return; }
        if (hipFuncSetAttribute((const void*)fwd_kernel, hipFuncAttributeMaxDynamicSharedMemorySize, LDS_BYTES) != hipSuccess) { fprintf(stderr, "kernel_launch: hipFuncSetAttribute failed\n"); grid = -1; return; }
        if (hipOccupancyMaxActiveBlocksPerMultiprocessor(&per_cu, (const void*)fwd_kernel, NTHR, LDS_BYTES) != hipSuccess || per_cu < 1) { fprintf(stderr, "kernel_launch: occupancy query says %d\n", per_cu); }
        (void)hipGetLastError();
        grid = cus;
    }
    if (grid < 0) return;
    (void)hipMemsetAsync((char*)d_ws + WS_CTL, 0, CTL_ZERO_BYTES, stream);
    Args a{};
    for (int i = 0; i < 25; ++i) a.in[i] = (const float*)d_in[i];
    a.out = (float*)d_out; a.ws = (unsigned char*)d_ws;
#if defined(MK_DEBUG_DET)
    unsigned long long* tab = (unsigned long long*)((char*)d_ws + WS_CTL + 32 * 1024);
    for (int pass = 0; pass < 2; ++pass)
        for (int p = 0; p < N_PHASES; ++p) { a.ph_lo = p; a.ph_hi = p + 1; hipLaunchKernelGGL(fwd_kernel, dim3(grid), dim3(NTHR), LDS_BYTES, stream, a);
            Reg r[4]; const int nr = phase_regions(p, r);
            for (int i = 0; i < nr; ++i) hipLaunchKernelGGL(k_checksum, dim3(2048), dim3(256), 0, stream, (const unsigned*)(r[i].in_out ? (char*)d_out : (char*)d_ws + r[i].off), r[i].bytes / 4, tab + (size_t)pass * N_PHASES * 4 + p * 4 + i); }
    hipLaunchKernelGGL(k_zero_out, dim3(2048), dim3(256), 0, stream, (float*)d_out, (size_t)T * D);
    hipLaunchKernelGGL(k_report, dim3(1), dim3(64), 0, stream, tab, N_PHASES * 4, (float*)d_out);
#elif MK_ONE_LAUNCH
    a.ph_lo = 0; a.ph_hi = N_PHASES;
    hipLaunchKernelGGL(fwd_kernel, dim3(grid), dim3(NTHR), LDS_BYTES, stream, a);
#else
    for (int p = 0; p < N_PHASES; ++p) { a.ph_lo = p; a.ph_hi = p + 1; hipLaunchKernelGGL(fwd_kernel, dim3(grid), dim3(NTHR), LDS_BYTES, stream, a); }
#endif
}
```

```cpp
#include <hip/hip_runtime.h>
#include <cstdio>
#include <cstdint>

#ifndef MK_ONE_LAUNCH
#define MK_ONE_LAUNCH 1
#endif

#define GAS __attribute__((address_space(1)))
#define LAS __attribute__((address_space(3)))
typedef unsigned short bf16_t;
typedef short bf16x8 __attribute__((ext_vector_type(8)));
typedef short s16x4 __attribute__((ext_vector_type(4)));
typedef float f32x4 __attribute__((ext_vector_type(4)));
typedef float f32x2 __attribute__((ext_vector_type(2)));
typedef float f32x16 __attribute__((ext_vector_type(16)));
typedef unsigned u32x4 __attribute__((ext_vector_type(4)));
typedef unsigned u32x2 __attribute__((ext_vector_type(2)));

constexpr int D = 1024, TP = 16384, TS = 65536, T = TP + TS, SP = 8192, SS = 2048;
constexpr int NL = 4;
constexpr int NWAVES = 8, NTHR = 512;
constexpr float DN_ALPHA = 1.681792830507429f;
constexpr float LN_EPS = 1e-5f, RMS_EPS = 1e-6f;
constexpr float MLA_SCALE = 0.07216878364870323f;
constexpr int NEXP = 16384;

constexpr size_t MiB = 1u << 20;
constexpr size_t WS_CTL = 0, CTL_ZERO_BYTES = 64 * 1024;
constexpr size_t WS_ROPE = 1 * MiB;
constexpr size_t WS_MISC = 3 * MiB;
constexpr size_t WS_W = 4 * MiB;
constexpr size_t W_WA = WS_W;
constexpr size_t W_WUQ = W_WA + 2 * (size_t)768 * 1024 * 2;
constexpr size_t W_WUKV = W_WUQ + 2 * (size_t)1536 * 384 * 2;
constexpr size_t W_WO = W_WUKV + 2 * (size_t)2048 * 256 * 2;
constexpr size_t W_HIN = W_WO + 2 * (size_t)1024 * 1024 * 2;
constexpr size_t W_HO = W_HIN + 2 * (size_t)5120 * 1024 * 2;
constexpr size_t W_PQ = W_HO + 2 * (size_t)1024 * 1024 * 2;
constexpr size_t W_GW = W_PQ + 4 * (size_t)2048 * 1024 * 2;
constexpr size_t W_PP = W_GW + 4 * (size_t)1024 * 1024 * 2;
constexpr size_t W_KEYS = W_PP + 4 * (size_t)1024 * 256 * 2;
constexpr size_t W_END = W_KEYS + 4 * (size_t)2 * 128 * 128 * 2;
static_assert(W_END <= 68 * MiB, "weights region");
constexpr size_t WS_R2 = 68 * MiB;
constexpr size_t R2_UB = WS_R2, R2_VB = WS_R2 + 16 * MiB, R2_SU = WS_R2 + 32 * MiB, R2_SV = WS_R2 + 33 * MiB, R2_IDX = WS_R2 + 64 * MiB, R2_GATE = WS_R2 + 104 * MiB, R2_PB = WS_R2 + 144 * MiB;
constexpr size_t WS_XB = 252 * MiB;
constexpr size_t WS_BIG = 412 * MiB;
constexpr size_t WS_END = WS_BIG + 800 * MiB;
constexpr size_t B_Q = WS_BIG, B_KV = WS_BIG + 240 * MiB, B_O = WS_BIG + 560 * MiB, B_KROPE = WS_BIG + 720 * MiB;
constexpr size_t B_A32 = WS_BIG + 240 * MiB, B_CQN = WS_BIG + 560 * MiB, B_CKVN = WS_BIG + 620 * MiB, B_H32_MLA = WS_BIG;
constexpr size_t B_PLANE = WS_BIG, PLANE_BYTES = 160 * MiB, B_H32_HGRN = WS_BIG + 160 * MiB;
constexpr size_t B_PQ = WS_BIG, B_PP = WS_BIG + 320 * MiB;

constexpr int LDS_BYTES = 160 * 1024;
constexpr int LDS_MISC_OFF = LDS_BYTES - 256;

typedef __bf16 bf16x2_n __attribute__((ext_vector_type(2)));
__device__ __forceinline__ unsigned cvt_pk_bf16(float lo, float hi) { const f32x2 v = {lo, hi}; const bf16x2_n b = __builtin_convertvector(v, bf16x2_n); return __builtin_bit_cast(unsigned, b); }
__device__ __forceinline__ bf16_t f2bf(float f) { return (bf16_t)(cvt_pk_bf16(f, 0.f) & 0xffffu); }
__device__ __forceinline__ float bf2f(bf16_t b) { return __uint_as_float(((unsigned)b) << 16); }
__device__ __forceinline__ float bflo(unsigned w) { return __uint_as_float(w << 16); }
__device__ __forceinline__ float bfhi(unsigned w) { return __uint_as_float(w & 0xffff0000u); }
#define DPPF(v, ctrl) __int_as_float(__builtin_amdgcn_update_dpp(0, __float_as_int(v), (ctrl), 0xf, 0xf, true))
__device__ __forceinline__ float row16_sum(float v) { v += DPPF(v, 0xB1); v += DPPF(v, 0x4E); v += DPPF(v, 0x141); v += DPPF(v, 0x140); return v; }
__device__ __forceinline__ float wave_sum(float v) { v = row16_sum(v);
    { auto r = __builtin_amdgcn_permlane16_swap(__float_as_uint(v), __float_as_uint(v), false, false); v = __uint_as_float(r[0]) + __uint_as_float(r[1]); }
    { auto r = __builtin_amdgcn_permlane32_swap(__float_as_uint(v), __float_as_uint(v), false, false); v = __uint_as_float(r[0]) + __uint_as_float(r[1]); }
    return v; }
__device__ __forceinline__ float wave_max(float v) { v = fmaxf(v, DPPF(v, 0xB1)); v = fmaxf(v, DPPF(v, 0x4E)); v = fmaxf(v, DPPF(v, 0x141)); v = fmaxf(v, DPPF(v, 0x140));
    { auto r = __builtin_amdgcn_permlane16_swap(__float_as_uint(v), __float_as_uint(v), false, false); v = fmaxf(__uint_as_float(r[0]), __uint_as_float(r[1])); }
    { auto r = __builtin_amdgcn_permlane32_swap(__float_as_uint(v), __float_as_uint(v), false, false); v = fmaxf(__uint_as_float(r[0]), __uint_as_float(r[1])); }
    return v; }
__device__ __forceinline__ float fast_exp(float x) { return __builtin_amdgcn_exp2f(x * 1.4426950408889634f); }
__device__ __forceinline__ float fast_log(float x) { return __builtin_amdgcn_logf(x) * 0.6931471805599453f; }
__device__ __forceinline__ float fast_rcp(float x) { return __builtin_amdgcn_rcpf(x); }
__device__ __forceinline__ float sigmoidf_(float x) { return fast_rcp(1.0f + fast_exp(-x)); }
__device__ __forceinline__ float siluf_(float x) { return x * sigmoidf_(x); }
#define LDS_WAIT() asm volatile("s_waitcnt lgkmcnt(0)" ::: "memory")
#define VM_WAIT() asm volatile("s_waitcnt vmcnt(0)" ::: "memory")
__device__ __forceinline__ int opaque_lane() { int l; asm volatile("v_mbcnt_lo_u32_b32 %0, -1, 0\n\tv_mbcnt_hi_u32_b32 %0, -1, %0" : "=v"(l)); return l; }
__device__ __forceinline__ int opaque_tid(int wave_s) { asm volatile("" : "+s"(wave_s)); return (wave_s << 6) + opaque_lane(); }
__device__ __forceinline__ int opaque_bid() { int b = (int)blockIdx.x; asm volatile("" : "+s"(b)); return b; }
struct Args { const float* in[25]; float* out; unsigned char* ws; int ph_lo, ph_hi; };
#define XB_TMO      128
#define XB_XCNT(j)  (256  + 64 * (j))
#define XB_XSUB(j)  (1280 + 64 * (j))
#define XB_XGEN(j)  (2304 + 64 * (j))
#define XB_TOP      3328
#define XB_TOPGEN   3392
#define XCD_BAR_WORDS 3456
#define XB_SPIN_CAP (1u << 23)

__device__ __forceinline__ unsigned xb_ld(unsigned* p)              { return __hip_atomic_load(p, __ATOMIC_RELAXED, __HIP_MEMORY_SCOPE_AGENT); }
__device__ __forceinline__ unsigned xb_add(unsigned* p, unsigned v) { return __hip_atomic_fetch_add(p, v, __ATOMIC_RELAXED, __HIP_MEMORY_SCOPE_AGENT); }
__device__ __forceinline__ unsigned xb_xcc_id() { return (unsigned)__builtin_amdgcn_s_getreg((3 << 11) | 20) & 0xFu; }
#define XB_SPIN(cond, bar) do { unsigned _sp = 0; while (cond) { __builtin_amdgcn_s_sleep(1); \
    if ((++_sp & 255u) == 0u) { if (xb_ld(&(bar)[XB_TMO])) break; if (_sp > XB_SPIN_CAP) { atomicAdd(&(bar)[XB_TMO], 1u); break; } } } } while (0)

struct XcdBarrier {
    unsigned* bar; unsigned x;
    volatile LAS unsigned* st;
};

__device__ __forceinline__ XcdBarrier xcd_barrier_post(unsigned* bar, volatile LAS unsigned* st) {
    XcdBarrier b; b.bar = bar; b.x = xb_xcc_id(); b.st = st;
    if (threadIdx.x == 0) (void)xb_add(&bar[XB_XCNT(b.x)], 1u);
    return b;
}
__device__ __forceinline__ void xcd_barrier_complete(unsigned* bar, unsigned x, unsigned& nloc, unsigned& nx) {
    const unsigned G = gridDim.x * gridDim.y * gridDim.z;
    unsigned sum, cnt, mine, sp = 0u;
    for (;;) {
        sum = 0u; cnt = 0u; mine = 0u;
#pragma unroll
        for (unsigned j = 0; j < 16; ++j) { const unsigned c = xb_ld(&bar[XB_XCNT(j)]); sum += c; cnt += (c > 0u) ? 1u : 0u; mine = (j == x) ? c : mine; }
        if (sum == G) break;
        __builtin_amdgcn_s_sleep(1);
        if ((++sp & 255u) == 0u) { if (xb_ld(&bar[XB_TMO])) break; if (sp > XB_SPIN_CAP) { atomicAdd(&bar[XB_TMO], 1u); break; } }
    }
    nloc = mine > 0u ? mine : 1u; nx = cnt > 0u ? cnt : 1u;
}

__device__ __forceinline__ void xcd_barrier(const XcdBarrier& b) {
    asm volatile("s_waitcnt vmcnt(0)" ::: "memory");
    __syncthreads();
    if (threadIdx.x == 0) {
        unsigned* bar = b.bar;
        __builtin_amdgcn_s_waitcnt(0);
        unsigned nloc = b.st[0], nx = b.st[1];
        if (nloc == 0u) { xcd_barrier_complete(bar, b.x, nloc, nx); b.st[0] = nloc; b.st[1] = nx; }
        const unsigned old = xb_add(&bar[XB_XSUB(b.x)], 1u);
        const unsigned gen = old / nloc;
        if (old + 1u == (gen + 1u) * nloc) {
            __builtin_amdgcn_fence(__ATOMIC_RELEASE, "agent");
            asm volatile("s_waitcnt vmcnt(0)" ::: "memory");
            const unsigned og = xb_add(&bar[XB_TOP], 1u);
            const unsigned tg = og / nx;
            if (og + 1u == (tg + 1u) * nx) xb_add(&bar[XB_TOPGEN], 1u);
            else XB_SPIN(xb_ld(&bar[XB_TOPGEN]) == tg, bar);
            __builtin_amdgcn_fence(__ATOMIC_ACQUIRE, "agent");
            xb_add(&bar[XB_XGEN(b.x)], 1u);
            asm volatile("s_waitcnt vmcnt(0)" ::: "memory");
        } else {
            XB_SPIN(xb_ld(&bar[XB_XGEN(b.x)]) == gen, bar);
            __builtin_amdgcn_fence(__ATOMIC_ACQUIRE, "agent");
            asm volatile("s_waitcnt vmcnt(0)" ::: "memory");
        }
    }
    __syncthreads();
}
namespace pg8 {
#define PG8_LAS __attribute__((address_space(3)))
constexpr int BM = 256, BK = 64, HALF = 128, HTB = HALF * BK * 2  , STAGE_BYTES = 8 * HTB, NXCD = 8, WGM = 8;

__host__ __device__ __forceinline__ int lds_byte(int r, int c) { const int st = (r >> 4) * 2 + (c >> 5), rr = r & 15, cc = c & 31, ob = rr * 64 + cc * 2; return st * 1024 + (ob ^ (((ob >> 9) & 1) << 5)); }
__host__ __device__ __forceinline__ void stage_rc(int b, int& R, int& C) { const int st = b / 1024, sb = b % 1024, swz = sb ^ (((sb >> 9) & 1) << 5); R = (st >> 1) * 16 + swz / 64; C = (st & 1) * 32 + (swz % 64) / 2; }
__host__ __device__ __forceinline__ int perm32(int rho) { const int n = rho >> 4, i = rho & 15; return 8 * (i >> 2) + 4 * n + (i & 3); }

struct Unit { int pm, pn; };
struct Gemm { const bf16_t* A; const bf16_t* Bt; int M, N, K; };

struct StaticOrder {
    int nM, nN, nwg, G, c;
    __host__ __device__ void init(int M, int N, int G_, int c_) { nM = M / BM; nN = N / BM; nwg = nM * nN; G = G_; c = c_; }
    __host__ __device__ bool next(int i, Unit& u) const {
        const long L = (long)i * G + c; if (L >= nwg) return false;
        int wgid = (int)L; { const int q = nwg / NXCD, r = nwg % NXCD, xcd = wgid % NXCD, off = wgid / NXCD; wgid = (xcd < r ? xcd * (q + 1) : r * (q + 1) + (xcd - r) * q) + off; }
        const int nig = WGM * nN, gid = wgid / nig, fm = gid * WGM, gsz = (nM - fm) < WGM ? (nM - fm) : WGM;
        u.pm = fm + ((wgid % nig) % gsz); u.pn = (wgid % nig) / gsz; return true;
    }
    __device__ __forceinline__ void a_ready(const Unit&) const {}
    __device__ __forceinline__ void done(const Unit&) const {}
};
template <class Epi, class Sched>
__device__ __forceinline__ void gemm_phase(PG8_LAS unsigned char* lds, const Gemm g, const Sched& S, const Epi& E, const int tid) {
    const int wid = __builtin_amdgcn_readfirstlane(tid >> 6), lane = tid & 63, wr = wid >> 2, wc = wid & 3, fr = lane & 15, fq = lane >> 4;
    const int K = g.K, nt = K / BK;
    unsigned voffA[2], voffB[2];
#pragma unroll
    for (int i = 0; i < 2; ++i) { int R, C; stage_rc(tid * 16 + i * 8192, R, C); const int Rb = Epi::PERM ? ((R & ~31) + perm32(R & 31)) : R;
        voffA[i] = (unsigned)(R * K + C) * 2u; voffB[i] = (unsigned)(Rb * K + C) * 2u; }
    const size_t kstep = (size_t)(BK * 2);
    const size_t hstep = (size_t)HALF * K * 2;
    const size_t tstep = 2 * hstep;
    const unsigned ldsw = (unsigned)wid * 1024u;
    const int aoff = lds_byte(wr * 64 + fr, fq * 8), boff = lds_byte(wc * 32 + fr, fq * 8);
#define PG8_SA(b, h) (((b) * 2 + (h)) * HTB)
#define PG8_SB(b, h) ((4 + (b) * 2 + (h)) * HTB)
#define PG8_STAGE(bufoff, gbase, voff) do { _Pragma("unroll") for (int _i = 0; _i < 2; ++_i) \
        __builtin_amdgcn_global_load_lds((const unsigned*)((const char*)(gbase) + (voff)[_i]), (PG8_LAS unsigned*)(lds + (bufoff) + ldsw + _i * 8192), 16, 0, 0); } while (0)
#define PG8_LDA(dst, b, h) do { _Pragma("unroll") for (int m = 0; m < 4; ++m) _Pragma("unroll") for (int k = 0; k < 2; ++k) dst[m][k] = *(const PG8_LAS bf16x8*)(lds + PG8_SA(b, h) + aoff + m * 2048 + k * 1024); } while (0)
#define PG8_LDB(dst, b, h) do { _Pragma("unroll") for (int n = 0; n < 2; ++n) _Pragma("unroll") for (int k = 0; k < 2; ++k) dst[n][k] = *(const PG8_LAS bf16x8*)(lds + PG8_SB(b, h) + boff + n * 2048 + k * 1024); } while (0)
#define PG8_MMA(ai, bj, At, Bt) do { __builtin_amdgcn_s_setprio(1); _Pragma("unroll") for (int m = 0; m < 4; ++m) _Pragma("unroll") for (int n = 0; n < 2; ++n) _Pragma("unroll") for (int k = 0; k < 2; ++k) \
        acc[ai][bj][m][n] = __builtin_amdgcn_mfma_f32_16x16x32_bf16(Bt[n][k], At[m][k], acc[ai][bj][m][n], 0, 0, 0); __builtin_amdgcn_s_setprio(0); } while (0)
#define PG8_WAIT_V(n) asm volatile("s_waitcnt vmcnt(" #n ")" ::: "memory")
#define PG8_WAIT_L(n) asm volatile("s_waitcnt lgkmcnt(" #n ")" ::: "memory")
#define PG8_BAR __builtin_amdgcn_s_barrier()
#define PG8_SCHED __builtin_amdgcn_sched_barrier(0)
    Unit cur, nxt; int ui = 0;
    if (!S.next(0, cur)) return;
    f32x4 acc[2][2][4][2];
#pragma unroll
    for (int a = 0; a < 2; ++a)
#pragma unroll
        for (int b = 0; b < 2; ++b)
#pragma unroll
            for (int m = 0; m < 4; ++m)
#pragma unroll
                for (int n = 0; n < 2; ++n) acc[a][b][m][n] = (f32x4){0.f, 0.f, 0.f, 0.f};
    bf16x8 At[4][2], B0[2][2], B1[2][2];
    const char* cA = (const char*)g.A + (size_t)cur.pm * tstep; const char* cB = (const char*)g.Bt + (size_t)cur.pn * tstep;
    S.a_ready(cur);
    PG8_STAGE(PG8_SB(0, 0), cB, voffB); PG8_STAGE(PG8_SA(0, 0), cA, voffA); PG8_STAGE(PG8_SB(0, 1), cB + hstep, voffB); PG8_STAGE(PG8_SA(0, 1), cA + hstep, voffA);
    if (wr == 1) PG8_BAR;
    PG8_WAIT_V(4); PG8_BAR;
    PG8_STAGE(PG8_SB(1, 0), cB + kstep, voffB); PG8_STAGE(PG8_SA(1, 0), cA + kstep, voffA); PG8_STAGE(PG8_SB(1, 1), cB + hstep + kstep, voffB);
    PG8_WAIT_V(6); PG8_BAR;
    for (;;) {
        const bool has_next = S.next(ui + 1, nxt);
        const char* nA = has_next ? (const char*)g.A + (size_t)nxt.pm * tstep : cA; const char* nB = has_next ? (const char*)g.Bt + (size_t)nxt.pn * tstep : cB;
        for (int t = 0; t < nt; t += 2) {
            const bool last = (t == nt - 2);
            const char* a1 = cA + (size_t)(t + 1) * kstep;
            const char* a2 = last ? nA : cA + (size_t)(t + 2) * kstep; const char* b2 = last ? nB : cB + (size_t)(t + 2) * kstep;
            const char* a3 = a2 + kstep; const char* b3 = b2 + kstep;
            if (last && has_next) S.a_ready(nxt);
            PG8_LDB(B0, 0, 0); PG8_SCHED; PG8_LDA(At, 0, 0); PG8_STAGE(PG8_SA(1, 1), a1 + hstep, voffA);
            PG8_WAIT_L(8); PG8_BAR; PG8_WAIT_L(0); PG8_MMA(0, 0, At, B0); PG8_BAR; PG8_SCHED;
            PG8_LDB(B1, 0, 1); PG8_STAGE(PG8_SB(0, 0), b2, voffB);
            PG8_BAR; PG8_WAIT_L(0); PG8_MMA(0, 1, At, B1); PG8_BAR;
            PG8_LDA(At, 0, 1); PG8_STAGE(PG8_SA(0, 0), a2, voffA);
            PG8_BAR; PG8_WAIT_L(0); PG8_MMA(1, 0, At, B0); PG8_BAR; PG8_SCHED;
            PG8_STAGE(PG8_SB(0, 1), b2 + hstep, voffB);
            PG8_WAIT_V(6); PG8_BAR; PG8_MMA(1, 1, At, B1); PG8_BAR;
            PG8_LDB(B0, 1, 0); PG8_SCHED; PG8_LDA(At, 1, 0); PG8_STAGE(PG8_SA(0, 1), a2 + hstep, voffA);
            PG8_WAIT_L(8); PG8_BAR; PG8_WAIT_L(0); PG8_MMA(0, 0, At, B0); PG8_BAR; PG8_SCHED;
            PG8_LDB(B1, 1, 1); PG8_STAGE(PG8_SB(1, 0), b3, voffB);
            PG8_BAR; PG8_WAIT_L(0); PG8_MMA(0, 1, At, B1); PG8_BAR;
            PG8_LDA(At, 1, 1); PG8_STAGE(PG8_SA(1, 0), a3, voffA);
            PG8_BAR; PG8_WAIT_L(0); PG8_MMA(1, 0, At, B0); PG8_BAR; PG8_SCHED;
            PG8_STAGE(PG8_SB(1, 1), b3 + hstep, voffB);
            PG8_WAIT_V(6); PG8_BAR; PG8_MMA(1, 1, At, B1); PG8_BAR;
        }
        E(acc, cur, wr, wc, fr, fq); S.done(cur);
        if (!has_next) break;
#pragma unroll
        for (int a = 0; a < 2; ++a)
#pragma unroll
            for (int b = 0; b < 2; ++b)
#pragma unroll
                for (int m = 0; m < 4; ++m)
#pragma unroll
                    for (int n = 0; n < 2; ++n) acc[a][b][m][n] = (f32x4){0.f, 0.f, 0.f, 0.f};
        cur = nxt; cA = nA; cB = nB; ++ui;
    }
    PG8_WAIT_V(0);
    if (wr == 0) PG8_BAR;
    PG8_BAR;
#undef PG8_SA
#undef PG8_SB
#undef PG8_STAGE
#undef PG8_LDA
#undef PG8_LDB
#undef PG8_MMA
#undef PG8_WAIT_V
#undef PG8_WAIT_L
#undef PG8_BAR
#undef PG8_SCHED
}
struct EpiF32 {
    static constexpr bool PERM = false;
    float* C; int ldc;
    __device__ __forceinline__ void operator()(const f32x4 (&acc)[2][2][4][2], const Unit& u, int wr, int wc, int fr, int fq) const {
        const int row0 = u.pm * BM + wr * 64 + fr, col0 = u.pn * BM + wc * 32 + 4 * fq;
#pragma unroll
        for (int ai = 0; ai < 2; ++ai)
#pragma unroll
            for (int m = 0; m < 4; ++m) { float* rowp = C + (size_t)(row0 + ai * HALF + m * 16) * ldc + col0;
#pragma unroll
                for (int bj = 0; bj < 2; ++bj)
#pragma unroll
                    for (int n = 0; n < 2; ++n) *(f32x4*)(rowp + bj * HALF + n * 16) = acc[ai][bj][m][n]; }
    }
};
struct EpiBf16P {
    static constexpr bool PERM = true;
    bf16_t* O; int ldc;
    __device__ __forceinline__ void operator()(const f32x4 (&acc)[2][2][4][2], const Unit& u, int wr, int wc, int fr, int fq) const {
        const int row0 = u.pm * BM + wr * 64 + fr, col0 = u.pn * BM + wc * 32 + 8 * fq;
#pragma unroll
        for (int ai = 0; ai < 2; ++ai)
#pragma unroll
            for (int m = 0; m < 4; ++m) { bf16_t* rowp = O + (size_t)(row0 + ai * HALF + m * 16) * ldc + col0;
#pragma unroll
                for (int bj = 0; bj < 2; ++bj) { const f32x4 v0 = acc[ai][bj][m][0], v1 = acc[ai][bj][m][1];
                    u32x4 w; w.x = cvt_pk_bf16(v0[0], v0[1]); w.y = cvt_pk_bf16(v0[2], v0[3]); w.z = cvt_pk_bf16(v1[0], v1[1]); w.w = cvt_pk_bf16(v1[2], v1[3]);
                    *(u32x4*)(rowp + bj * HALF) = w; } }
    }
};
struct EpiHgrn {
    static constexpr bool PERM = true;
    bf16_t* planes; size_t plane_elems; const float* lb;
    __device__ __forceinline__ void operator()(const f32x4 (&acc)[2][2][4][2], const Unit& u, int wr, int wc, int fr, int fq) const {
        const int plane = u.pn >> 2;
        const int row0 = u.pm * BM + wr * 64 + fr, col0 = (u.pn & 3) * BM + wc * 32 + 8 * fq;
        bf16_t* base = planes + (size_t)plane * plane_elems;
        float lbv[2][8];
        if (plane == 1 || plane == 2) {
#pragma unroll
            for (int bj = 0; bj < 2; ++bj)
#pragma unroll
                for (int e = 0; e < 8; ++e) lbv[bj][e] = lb[(plane - 1) * 1024 + col0 + bj * HALF + e];
        } else {
#pragma unroll
            for (int bj = 0; bj < 2; ++bj)
#pragma unroll
                for (int e = 0; e < 8; ++e) lbv[bj][e] = 0.f;
        }
#pragma unroll
        for (int ai = 0; ai < 2; ++ai)
#pragma unroll
            for (int m = 0; m < 4; ++m) { bf16_t* rowp = base + (size_t)(row0 + ai * HALF + m * 16) * 1024 + col0;
#pragma unroll
                for (int bj = 0; bj < 2; ++bj) { float v[8];
#pragma unroll
                    for (int e = 0; e < 4; ++e) { v[e] = acc[ai][bj][m][0][e]; v[4 + e] = acc[ai][bj][m][1][e]; }
                    if (plane == 0 || plane == 4) {
#pragma unroll
                        for (int e = 0; e < 8; ++e) v[e] = siluf_(v[e]);
                    } else if (plane == 1 || plane == 2) {
#pragma unroll
                        for (int e = 0; e < 8; ++e) { const float l = lbv[bj][e]; const float f = l + (1.0f - l) * sigmoidf_(v[e]); v[e] = fast_log(fmaxf(f, 1e-30f)); }
                    }
                    u32x4 w; w.x = cvt_pk_bf16(v[0], v[1]); w.y = cvt_pk_bf16(v[2], v[3]); w.z = cvt_pk_bf16(v[4], v[5]); w.w = cvt_pk_bf16(v[6], v[7]);
                    *(u32x4*)(rowp + bj * HALF) = w; } }
    }
};
struct EpiPle {
    static constexpr bool PERM = false;
    float* X; const bf16_t* PP; const float* bias; bf16_t* XbOut;
    __device__ __forceinline__ void operator()(const f32x4 (&acc)[2][2][4][2], const Unit& u, int wr, int wc, int fr, int fq) const {
        const int row0 = u.pm * BM + wr * 64 + fr, col0 = u.pn * BM + wc * 32 + 4 * fq;
        f32x4 bv[2][2];
#pragma unroll
        for (int bj = 0; bj < 2; ++bj)
#pragma unroll
            for (int n = 0; n < 2; ++n) bv[bj][n] = *(const f32x4*)(bias + col0 + bj * HALF + n * 16);
#pragma unroll
        for (int ai = 0; ai < 2; ++ai)
#pragma unroll
            for (int m = 0; m < 4; ++m) { const size_t off = (size_t)(row0 + ai * HALF + m * 16) * 1024 + col0;
#pragma unroll
                for (int bj = 0; bj < 2; ++bj)
#pragma unroll
                    for (int n = 0; n < 2; ++n) { const size_t o2 = off + bj * HALF + n * 16;
                        const f32x4 x = *(const f32x4*)(X + o2); const u32x2 pw = *(const u32x2*)(PP + o2); const f32x4 z = acc[ai][bj][m][n] + bv[bj][n];
                        f32x4 o; o[0] = x[0] + sigmoidf_(z[0]) * bflo(pw.x); o[1] = x[1] + sigmoidf_(z[1]) * bfhi(pw.x); o[2] = x[2] + sigmoidf_(z[2]) * bflo(pw.y); o[3] = x[3] + sigmoidf_(z[3]) * bfhi(pw.y);
                        *(f32x4*)(X + o2) = o; u32x2 w; w.x = cvt_pk_bf16(o[0], o[1]); w.y = cvt_pk_bf16(o[2], o[3]); *(u32x2*)(XbOut + o2) = w; }
                asm volatile("" ::: "memory"); }
    }
};
}
namespace attn {
constexpr int DV = 128, DQK = 192, NW = 8, QBLK = 32, KVBLK = 64;
constexpr float SCALE = MLA_SCALE;
constexpr float THR = 8.f;
constexpr int LDQ = 8 * DQK, LDKV = 8 * 256, LDKR = 64, LDO = 1024;
constexpr int KROWB = 400;
constexpr int SHM_V = KVBLK * DV * 2, SHM_K = KVBLK * KROWB, SHM_ATTN = 2 * SHM_V + 2 * SHM_K + NW * 64 * 4;
#define SBAR() __builtin_amdgcn_sched_barrier(0)
__device__ __forceinline__ int crow(int r, int hi) { return (r & 3) + 8 * (r >> 2) + 4 * hi; }

__device__ __forceinline__ void partialSM(f32x16& p0, f32x16& p1, float& m_reg, float& mn, float& alpha) {
  constexpr float C = SCALE * 1.4426950408889634f;
  float pmax = p0[0];
#pragma unroll
  for (int r = 1; r < 16; ++r) pmax = fmaxf(pmax, p0[r]);
#pragma unroll
  for (int r = 0; r < 16; ++r) pmax = fmaxf(pmax, p1[r]);
  { auto rr = __builtin_amdgcn_permlane32_swap(__float_as_uint(pmax), __float_as_uint(pmax), false, false);
    pmax = fmaxf(__uint_as_float(rr[0]), __uint_as_float(rr[1])); }
  if (__builtin_expect(__all(pmax - m_reg <= THR / SCALE), 1)) { mn = m_reg; alpha = 1.f; }
  else { mn = fmaxf(m_reg, pmax); alpha = __builtin_amdgcn_exp2f((m_reg - mn) * C); m_reg = mn; }
  float mnC = -mn * C;
#pragma unroll
  for (int r = 0; r < 16; ++r) p0[r] = fmaf(p0[r], C, mnC);
#pragma unroll
  for (int r = 0; r < 16; ++r) p1[r] = fmaf(p1[r], C, mnC);
#pragma unroll
  for (int r = 0; r < 16; ++r) p0[r] = __builtin_amdgcn_exp2f(p0[r]);
}
__device__ __forceinline__ void finishSM(f32x16& p0, f32x16& p1, float alpha, float& l_reg, bf16x8& pa0, bf16x8& pa1, bf16x8& pa2, bf16x8& pa3) {
#pragma unroll
  for (int r = 0; r < 16; ++r) p1[r] = __builtin_amdgcn_exp2f(p1[r]);
  float ps = 0;
#pragma unroll
  for (int r = 0; r < 16; ++r) ps += p0[r];
#pragma unroll
  for (int r = 0; r < 16; ++r) ps += p1[r];
  { auto rr = __builtin_amdgcn_permlane32_swap(__float_as_uint(ps), __float_as_uint(ps), false, false);
    ps = __uint_as_float(rr[0]) + __uint_as_float(rr[1]); }
  l_reg = l_reg * alpha + ps;
#define PK4(P, BASE, OUT) do { unsigned a0 = cvt_pk_bf16(P[BASE + 0], P[BASE + 1]), a1 = cvt_pk_bf16(P[BASE + 2], P[BASE + 3]);   \
    unsigned b0 = cvt_pk_bf16(P[BASE + 4], P[BASE + 5]), b1 = cvt_pk_bf16(P[BASE + 6], P[BASE + 7]);                              \
    auto r0 = __builtin_amdgcn_permlane32_swap(a0, b0, false, false); auto r1 = __builtin_amdgcn_permlane32_swap(a1, b1, false, false); \
    u32x4 w = {r0[0], r1[0], r0[1], r1[1]}; OUT = *reinterpret_cast<bf16x8*>(&w); } while (0)
  PK4(p0, 0, pa0); PK4(p0, 8, pa1); PK4(p1, 0, pa2); PK4(p1, 8, pa3);
#undef PK4
}
__device__ __forceinline__ void qkt(f32x16& p0, f32x16& p1, const char* Ks, const bf16x8* qr, int r32, int hi) {
  p0 = f32x16{}; p1 = f32x16{};
#pragma unroll
  for (int d0 = 0; d0 < 12; ++d0) { const int cb = (d0 * 16 + hi * 8) * 2;
    bf16x8 b0 = *reinterpret_cast<const bf16x8*>(Ks + r32 * KROWB + cb);
    bf16x8 b1 = *reinterpret_cast<const bf16x8*>(Ks + (32 + r32) * KROWB + cb);
    p0 = __builtin_amdgcn_mfma_f32_32x32x16_bf16(b0, qr[d0], p0, 0, 0, 0);
    p1 = __builtin_amdgcn_mfma_f32_32x32x16_bf16(b1, qr[d0], p1, 0, 0, 0);
    if ((d0 & 3) == 3) SBAR(); }
}
__device__ __forceinline__ int v_st(int k, int c) { const int kk = (k & ~0xC) | ((k & 4) << 1) | ((k & 8) >> 1); return ((kk >> 3) * 4 + (c >> 5)) * 512 + ((kk & 7) * 32 + (c & 31)) * 2; }
__device__ __forceinline__ int v_rd_base(int lane) { return ((lane & 3) << 3) | (((lane >> 2) & 3) << 6) | (((lane >> 4) & 1) << 5) | (((lane >> 5) & 1) << 8); }
constexpr int v_rd_off(int d0, int ks, int half) { return d0 * 512 + ks * 4096 + half * 2048; }
template <int OFF> __device__ __forceinline__ s16x4 tr_read(int vb) {
  s16x4 r; asm volatile("ds_read_b64_tr_b16 %0, %1 offset:%2" : "=&v"(r) : "v"(vb), "i"(OFF) : "memory"); return r;
}
template <int D0> __device__ __forceinline__ void pv_one(f32x16& od, int vb, bf16x8 pa0, bf16x8 pa1, bf16x8 pa2, bf16x8 pa3) {
  const s16x4 l0 = tr_read<v_rd_off(D0, 0, 0)>(vb), h0 = tr_read<v_rd_off(D0, 0, 1)>(vb), l1 = tr_read<v_rd_off(D0, 1, 0)>(vb), h1 = tr_read<v_rd_off(D0, 1, 1)>(vb);
  const s16x4 l2 = tr_read<v_rd_off(D0, 2, 0)>(vb), h2 = tr_read<v_rd_off(D0, 2, 1)>(vb), l3 = tr_read<v_rd_off(D0, 3, 0)>(vb), h3 = tr_read<v_rd_off(D0, 3, 1)>(vb);
  asm volatile("s_waitcnt lgkmcnt(0)" ::: "memory"); SBAR();
#define PK(L, H) (bf16x8){L[0], L[1], L[2], L[3], H[0], H[1], H[2], H[3]}
  od = __builtin_amdgcn_mfma_f32_32x32x16_bf16(pa0, PK(l0, h0), od, 0, 0, 0);
  od = __builtin_amdgcn_mfma_f32_32x32x16_bf16(pa1, PK(l1, h1), od, 0, 0, 0);
  od = __builtin_amdgcn_mfma_f32_32x32x16_bf16(pa2, PK(l2, h2), od, 0, 0, 0);
  od = __builtin_amdgcn_mfma_f32_32x32x16_bf16(pa3, PK(l3, h3), od, 0, 0, 0);
#undef PK
}
__device__ __forceinline__ void pv_d0(f32x16* o, int vb, bf16x8 pa0, bf16x8 pa1, bf16x8 pa2, bf16x8 pa3) {
  pv_one<0>(o[0], vb, pa0, pa1, pa2, pa3); pv_one<1>(o[1], vb, pa0, pa1, pa2, pa3); pv_one<2>(o[2], vb, pa0, pa1, pa2, pa3); pv_one<3>(o[3], vb, pa0, pa1, pa2, pa3);
}

__device__ __forceinline__ void attn_body(const bf16_t* __restrict__ Qb, const bf16_t* __restrict__ Kn, const bf16_t* __restrict__ Kr,
                                          bf16_t* __restrict__ Ob, int seq, char* lds, int tid, int pos0, const float* __restrict__ ropeT) {
  asm volatile("" : "+v"(tid));
  const int wid = tid >> 6, lane = tid & 63, r32 = lane & 31, hi = lane >> 5;
  char* V_lds = lds; char* K_lds = lds + 2 * SHM_V;
  float* ws = (float*)(lds + 2 * SHM_V + 2 * SHM_K) + wid * 64; float* li_l = ws; float* al_l = ws + 32;
  float m_reg = -1e30f, l_reg = 0; f32x16 o[4] = {}; bf16x8 qr[12];
  const bf16_t* Qw = Qb + (long)(wid * QBLK + r32) * LDQ + hi * 8;
#pragma unroll
  for (int d0 = 0; d0 < 12; ++d0) qr[d0] = *reinterpret_cast<const bf16x8*>(Qw + d0 * 16);
  { const float* cp = ropeT + (size_t)(pos0 + wid * QBLK + r32) * 32 + hi * 8; const float* sp = cp + 8192 * 32;
#pragma unroll
    for (int dd = 0; dd < 2; ++dd) { const f32x4 c0 = *(const f32x4*)(cp + 16 * dd), c1 = *(const f32x4*)(cp + 16 * dd + 4), s0 = *(const f32x4*)(sp + 16 * dd), s1 = *(const f32x4*)(sp + 16 * dd + 4);
      const u32x4 A = *reinterpret_cast<const u32x4*>(&qr[8 + dd]), B = *reinterpret_cast<const u32x4*>(&qr[10 + dd]); u32x4 An, Bn;
#pragma unroll
      for (int w2 = 0; w2 < 4; ++w2) { const float cs0 = w2 < 2 ? c0[2 * w2] : c1[2 * w2 - 4], cs1 = w2 < 2 ? c0[2 * w2 + 1] : c1[2 * w2 - 3], sn0 = w2 < 2 ? s0[2 * w2] : s1[2 * w2 - 4], sn1 = w2 < 2 ? s0[2 * w2 + 1] : s1[2 * w2 - 3];
        const float a0 = bflo(A[w2]), a1 = bfhi(A[w2]), b0 = bflo(B[w2]), b1 = bfhi(B[w2]);
        An[w2] = cvt_pk_bf16(a0 * cs0 - b0 * sn0, a1 * cs1 - b1 * sn1); Bn[w2] = cvt_pk_bf16(b0 * cs0 + a0 * sn0, b1 * cs1 + a1 * sn1); }
      qr[8 + dd] = *reinterpret_cast<const bf16x8*>(&An); qr[10 + dd] = *reinterpret_cast<const bf16x8*>(&Bn); } }
  const bf16_t* Vh = Kn + 128;
  const int sr = tid >> 4, sc = (tid & 15) * 8, vst0 = v_st(sr, sc), vst1 = v_st(32 + sr, sc);
  int krow[3], kcc[3];
#pragma unroll
  for (int i = 0; i < 3; ++i) { const int id = tid + 512 * i; krow[i] = id / 24; kcc[i] = id % 24; }
  const int vb0 = (int)(uintptr_t)V_lds + v_rd_base(lane);
  bf16x8 vs0, vs1, ks0, ks1, ks2;
#define KSRC(i, k0) (kcc[i] < 16 ? (Kn + (long)((k0) + krow[i]) * LDKV + kcc[i] * 8) : (Kr + (long)((k0) + krow[i]) * LDKR + (kcc[i] - 16) * 8))
#define SLOAD(k0) do { vs0 = *reinterpret_cast<const bf16x8*>(&Vh[(long)((k0) + sr) * LDKV + sc]); vs1 = *reinterpret_cast<const bf16x8*>(&Vh[(long)((k0) + 32 + sr) * LDKV + sc]); \
    ks0 = *reinterpret_cast<const bf16x8*>(KSRC(0, k0)); ks1 = *reinterpret_cast<const bf16x8*>(KSRC(1, k0)); ks2 = *reinterpret_cast<const bf16x8*>(KSRC(2, k0)); } while (0)
#define SWRITE(b) do { *(bf16x8*)(V_lds + (b) * SHM_V + vst0) = vs0; *(bf16x8*)(V_lds + (b) * SHM_V + vst1) = vs1; \
    *(bf16x8*)(K_lds + (b) * SHM_K + krow[0] * KROWB + kcc[0] * 16) = ks0; *(bf16x8*)(K_lds + (b) * SHM_K + krow[1] * KROWB + kcc[1] * 16) = ks1; \
    *(bf16x8*)(K_lds + (b) * SHM_K + krow[2] * KROWB + kcc[2] * 16) = ks2; } while (0)
#define SWAIT() asm volatile("s_waitcnt vmcnt(0)" ::: "memory")
#define RESC(a) do { if (__any((a) < 1.f)) { if (hi == 0) al_l[r32] = (a); asm volatile("s_waitcnt lgkmcnt(0)" ::: "memory"); \
    _Pragma("unroll") for (int d = 0; d < 4; ++d) _Pragma("unroll") for (int r = 0; r < 16; ++r) o[d][r] *= al_l[crow(r, hi)]; } } while (0)
  f32x16 pA0, pA1; float mnA, alA; bf16x8 pa0, pa1, pa2, pa3; const int NT = seq / KVBLK;
  SLOAD(0); SWAIT(); SWRITE(0); __syncthreads();
  for (int j = 0; j < NT; ++j) {
    const int b = j & 1;
    if (j + 1 < NT) SLOAD((j + 1) * KVBLK);
    SBAR(); qkt(pA0, pA1, K_lds + b * SHM_K, qr, r32, hi);
    partialSM(pA0, pA1, m_reg, mnA, alA);
    RESC(alA);
    finishSM(pA0, pA1, alA, l_reg, pa0, pa1, pa2, pa3); SBAR();
    pv_d0(o, vb0 + b * (int)SHM_V, pa0, pa1, pa2, pa3);
    if (j + 1 < NT) { SWAIT(); SWRITE(b ^ 1); }
    __syncthreads();
  }
  if (hi == 0) li_l[r32] = l_reg; asm volatile("s_waitcnt lgkmcnt(0)" ::: "memory");
  float rli[16];
#pragma unroll
  for (int r = 0; r < 16; ++r) rli[r] = __builtin_amdgcn_rcpf(li_l[crow(r, hi)]);
  bf16_t* Ow = Ob + (long)(wid * QBLK) * LDO;
#pragma unroll
  for (int r = 0; r < 16; ++r) { const int orow = crow(r, hi);
#pragma unroll
    for (int d0 = 0; d0 < 4; ++d0) Ow[(long)orow * LDO + d0 * 32 + r32] = f2bf(o[d0][r] * rli[r]); }
#undef KSRC
#undef SLOAD
#undef SWRITE
#undef SWAIT
#undef RESC
}
#undef SBAR
}
typedef const __attribute__((address_space(4))) Args* KArgs;
struct Ctx {
    KArgs a; float* out; unsigned char* ws;
    LAS unsigned char* lds;
    int tid, lane, wave, vcu, G, gw, NGW, bid;
    __device__ __forceinline__ const float* in(int i) const { return a->in[i]; }
};
__device__ __forceinline__ Ctx mk_ctx(unsigned char* lds_raw, int wave_s) {
    Ctx c; KArgs a = (KArgs)__builtin_amdgcn_kernarg_segment_ptr(); asm volatile("" : "+s"(a));
    c.a = a; c.out = a->out; c.ws = a->ws; c.lds = (LAS unsigned char*)lds_raw;
    c.tid = opaque_tid(wave_s); c.lane = c.tid & 63; c.wave = __builtin_amdgcn_readfirstlane(c.tid >> 6);
    c.G = (int)gridDim.x; c.bid = opaque_bid(); c.vcu = (c.G % 8 == 0) ? (c.bid % 8) * (c.G / 8) + c.bid / 8 : c.bid;
    c.gw = c.vcu * NWAVES + c.wave; c.NGW = c.G * NWAVES;
    return c;
}
__device__ __forceinline__ int tok_pos(int t) { return t < TP ? (t & (SP - 1)) : ((t - TP) & (SS - 1)); }

__device__ __forceinline__ void transpose_item(const float* W, int K, int N, bf16_t* WT, LAS float* scr, int item, int lane) {
    const int nblk = N / 32, kb = item / nblk, nb = item % nblk, k0 = 64 * kb, n0 = 32 * nb;
#pragma unroll 8
    for (int i = 0; i < 32; ++i) { const int kk = 2 * i + (lane >> 5); scr[kk * 33 + (lane & 31)] = W[(size_t)(k0 + kk) * N + n0 + (lane & 31)]; }
    LDS_WAIT(); asm volatile("" ::: "memory");
    const int c = lane & 7;
#pragma unroll
    for (int j = 0; j < 4; ++j) { const int n = (lane >> 3) + 8 * j; const LAS float* s = scr + (8 * c) * 33 + n;
        u32x4 o; o.x = cvt_pk_bf16(s[0 * 33], s[1 * 33]); o.y = cvt_pk_bf16(s[2 * 33], s[3 * 33]); o.z = cvt_pk_bf16(s[4 * 33], s[5 * 33]); o.w = cvt_pk_bf16(s[6 * 33], s[7 * 33]);
        *(u32x4*)(WT + (size_t)(n0 + n) * K + k0 + 8 * c) = o; }
    LDS_WAIT(); asm volatile("" ::: "memory");
}
struct MatDesc { int in_idx, K, N, Npad, copies; size_t dst; };
__device__ __forceinline__ void p0_prologue(const Ctx& c) {
    LAS float* scr = (LAS float*)(c.lds + c.wave * 16384);
    const MatDesc MATS[9] = {
        {4, 1024, 704, 768, 2, W_WA}, {7, 384, 1536, 1536, 2, W_WUQ}, {8, 256, 2048, 2048, 2, W_WUKV}, {9, 1024, 1024, 1024, 2, W_WO},
        {10, 1024, 5120, 5120, 2, W_HIN}, {13, 1024, 1024, 1024, 2, W_HO}, {14, 1024, 2048, 2048, 4, W_PQ}, {22, 1024, 1024, 1024, 4, W_GW}, {24, 256, 1024, 1024, 4, W_PP}};
    int total = 0;
#pragma unroll
    for (int m = 0; m < 9; ++m) total += MATS[m].copies * (MATS[m].K / 64) * (MATS[m].N / 32);
    for (int it = c.gw; it < total; it += c.NGW) {
        int r = it;
#pragma unroll
        for (int m = 0; m < 9; ++m) {
            const int per = (MATS[m].K / 64) * (MATS[m].N / 32), cnt = MATS[m].copies * per;
            if (r >= 0 && r < cnt) { const int cp = r / per, item = r % per;
                transpose_item(c.in(MATS[m].in_idx) + (size_t)cp * MATS[m].K * MATS[m].N, MATS[m].K, MATS[m].N,
                               (bf16_t*)(c.ws + MATS[m].dst) + (size_t)cp * MATS[m].Npad * MATS[m].K, scr, item, c.lane);
                r = -1; }
            else if (r >= 0) r -= cnt;
        }
    }
    const int gt = c.gw * 64 + c.lane, NGT = c.NGW * 64;
    for (int i = gt; i < 2 * 64 * 1024 / 8; i += NGT) { const int cp = i / (64 * 1024 / 8), o = i % (64 * 1024 / 8);
        *(u32x4*)((bf16_t*)(c.ws + W_WA) + (size_t)cp * 768 * 1024 + (size_t)704 * 1024 + o * 8) = (u32x4){0u, 0u, 0u, 0u}; }
    for (int i = gt; i < 4 * 2 * 128 * 128 / 4; i += NGT) { const f32x4 v = *(const f32x4*)(c.in(15) + (size_t)i * 4);
        u32x2 w; w.x = cvt_pk_bf16(v[0], v[1]); w.y = cvt_pk_bf16(v[2], v[3]); *(u32x2*)((bf16_t*)(c.ws + W_KEYS) + (size_t)i * 4) = w; }
    for (int i = gt; i < 8192 * 32; i += NGT) { const int pos = i >> 5, f = i & 31;
        const float inv = 1.0f / powf(10000.0f, (float)(2 * f) / 64.0f); const float ang = (float)pos * inv;
        ((float*)(c.ws + WS_ROPE))[i] = cosf(ang); ((float*)(c.ws + WS_ROPE))[8192 * 32 + i] = sinf(ang); }
    for (int i = gt; i < 2 * 1024; i += NGT) { const int dir = i >> 10, k = i & 1023;
        const float l0 = c.in(11)[(dir * 2 + 0) * 1024 + k], l1 = c.in(11)[(dir * 2 + 1) * 1024 + k];
        float* lb = (float*)(c.ws + WS_MISC);
        lb[(0 * 2 + dir) * 1024 + k] = 0.f; lb[(1 * 2 + dir) * 1024 + k] = 1.0f / (1.0f + expf(l0 - l1)); }
    for (int t = c.gw; t < T; t += c.NGW) {
        const float* xr = t < TP ? c.in(0) + (size_t)t * D : c.in(1) + (size_t)(t - TP) * D;
        bf16_t* brow = (bf16_t*)(c.ws + WS_R2) + (size_t)t * D;
#pragma unroll
        for (int j = 0; j < 4; ++j) { const f32x4 v = *(const f32x4*)(xr + 256 * j + 4 * c.lane);
            u32x2 w; w.x = cvt_pk_bf16(v[0], v[1]); w.y = cvt_pk_bf16(v[2], v[3]); *(u32x2*)(brow + 256 * j + 4 * c.lane) = w; }
    }
}

__device__ __forceinline__ void cvt_range(const float* src, bf16_t* dst, size_t n8, int gt, int NGT) {
    for (size_t i = gt; i < n8; i += NGT) { const f32x4 a = *(const f32x4*)(src + i * 8), b = *(const f32x4*)(src + i * 8 + 4);
        u32x4 w; w.x = cvt_pk_bf16(a[0], a[1]); w.y = cvt_pk_bf16(a[2], a[3]); w.z = cvt_pk_bf16(b[0], b[1]); w.w = cvt_pk_bf16(b[2], b[3]); *(u32x4*)(dst + i * 8) = w; }
}
__device__ __forceinline__ void l0_convert(const Ctx& c, int layer) {
    const int gt = c.gw * 64 + c.lane, NGT = c.NGW * 64;
    for (int r = c.gw; r < 2 * NEXP; r += c.NGW) {
        const int m = r >= NEXP, e = r - m * NEXP;
        const float* src = c.in(16 + m) + ((size_t)layer * NEXP + e) * D + 16 * c.lane;
        f32x4 v[4]; float am = 0.f;
#pragma unroll
        for (int j = 0; j < 4; ++j) { v[j] = *(const f32x4*)(src + 4 * j); am = fmaxf(am, fmaxf(fmaxf(fabsf(v[j][0]), fabsf(v[j][1])), fmaxf(fabsf(v[j][2]), fabsf(v[j][3])))); }
        am = wave_max(am);
        const float sc = fmaxf(am, 1e-30f) * (1.0f / 440.0f), inv = 1.0f / sc;
        u32x4 w;
#pragma unroll
        for (int j = 0; j < 4; ++j) { int p = 0; p = __builtin_amdgcn_cvt_pk_fp8_f32(v[j][0] * inv, v[j][1] * inv, p, false); p = __builtin_amdgcn_cvt_pk_fp8_f32(v[j][2] * inv, v[j][3] * inv, p, true); w[j] = (unsigned)p; }
        *(u32x4*)(c.ws + (m ? R2_VB : R2_UB) + (size_t)e * D + 16 * c.lane) = w;
        if (c.lane == 0) ((float*)(c.ws + (m ? R2_SV : R2_SU)))[e] = sc;
    }
    cvt_range(c.in(2) + (size_t)layer * TP * 256, (bf16_t*)(c.ws + R2_PB), (size_t)TP * 256 / 8, gt, NGT);
    cvt_range(c.in(3) + (size_t)layer * TS * 256, (bf16_t*)(c.ws + R2_PB) + (size_t)TP * 256, (size_t)TS * 256 / 8, gt, NGT);
}

__device__ __forceinline__ void mla_e1(const Ctx& c, int j) {
    const float* a32 = (const float*)(c.ws + B_A32); bf16_t* cqn = (bf16_t*)(c.ws + B_CQN); bf16_t* ckvn = (bf16_t*)(c.ws + B_CKVN); bf16_t* krope = (bf16_t*)(c.ws + B_KROPE);
    const float* qnw = c.in(5) + j * 384; const float* kvnw = c.in(6) + j * 256;
    const float* cosT = (const float*)(c.ws + WS_ROPE); const float* sinT = cosT + 8192 * 32;
    LAS float* scr = (LAS float*)(c.lds + c.wave * 1024);
    const int lane = c.lane;
    for (int t = c.gw; t < T; t += c.NGW) {
        const float* ar = a32 + (size_t)t * 768;
        const f32x4 v0 = *(const f32x4*)(ar + 4 * lane), v1 = *(const f32x4*)(ar + 256 + 4 * lane), v2 = *(const f32x4*)(ar + 512 + 4 * lane);
        const float s0 = v0[0] * v0[0] + v0[1] * v0[1] + v0[2] * v0[2] + v0[3] * v0[3];
        const float s1 = v1[0] * v1[0] + v1[1] * v1[1] + v1[2] * v1[2] + v1[3] * v1[3];
        const float s2 = v2[0] * v2[0] + v2[1] * v2[1] + v2[2] * v2[2] + v2[3] * v2[3];
        const float ssq = wave_sum(s0 + (lane < 32 ? s1 : 0.f));
        const float sskv = wave_sum((lane >= 32 ? s1 : 0.f) + (lane < 32 ? s2 : 0.f));
        const float rq = 1.0f / sqrtf(ssq * (1.0f / 384.0f) + RMS_EPS), rkv = 1.0f / sqrtf(sskv * (1.0f / 256.0f) + RMS_EPS);
        { const f32x4 w = *(const f32x4*)(qnw + 4 * lane); u32x2 o; o.x = cvt_pk_bf16(v0[0] * rq * w[0], v0[1] * rq * w[1]); o.y = cvt_pk_bf16(v0[2] * rq * w[2], v0[3] * rq * w[3]);
          *(u32x2*)(cqn + (size_t)t * 384 + 4 * lane) = o; }
        if (lane < 32) { const f32x4 w = *(const f32x4*)(qnw + 256 + 4 * lane); u32x2 o; o.x = cvt_pk_bf16(v1[0] * rq * w[0], v1[1] * rq * w[1]); o.y = cvt_pk_bf16(v1[2] * rq * w[2], v1[3] * rq * w[3]);
          *(u32x2*)(cqn + (size_t)t * 384 + 256 + 4 * lane) = o; }
        else { const int ix = 4 * (lane - 32); const f32x4 w = *(const f32x4*)(kvnw + ix); u32x2 o; o.x = cvt_pk_bf16(v1[0] * rkv * w[0], v1[1] * rkv * w[1]); o.y = cvt_pk_bf16(v1[2] * rkv * w[2], v1[3] * rkv * w[3]);
          *(u32x2*)(ckvn + (size_t)t * 256 + ix) = o; }
        if (lane < 32) { const int ix = 128 + 4 * lane; const f32x4 w = *(const f32x4*)(kvnw + ix); u32x2 o; o.x = cvt_pk_bf16(v2[0] * rkv * w[0], v2[1] * rkv * w[1]); o.y = cvt_pk_bf16(v2[2] * rkv * w[2], v2[3] * rkv * w[3]);
          *(u32x2*)(ckvn + (size_t)t * 256 + ix) = o; }
        else if (lane < 48) { *(LAS f32x4*)(scr + 4 * (lane - 32)) = v2; }
        LDS_WAIT(); asm volatile("" ::: "memory");
        if (lane < 32) { const int pos = tok_pos(t); const float a = scr[lane], b = scr[lane + 32], cs = cosT[pos * 32 + lane], sn = sinT[pos * 32 + lane];
            krope[(size_t)t * 64 + lane] = f2bf(a * cs - b * sn); krope[(size_t)t * 64 + 32 + lane] = f2bf(b * cs + a * sn); }
        LDS_WAIT(); asm volatile("" ::: "memory");
    }
}
__device__ __forceinline__ void mla_qrope(const Ctx& c) {
    bf16_t* q = (bf16_t*)(c.ws + B_Q);
    const float* cosT = (const float*)(c.ws + WS_ROPE); const float* sinT = cosT + 8192 * 32;
    const int lane = c.lane, i = lane & 31;
    for (int t = c.gw; t < T; t += c.NGW) {
        const int pos = tok_pos(t); const float cs = cosT[pos * 32 + i], sn = sinT[pos * 32 + i];
#pragma unroll
        for (int k = 0; k < 4; ++k) { const int h = (lane >> 5) + 2 * k; bf16_t* p = q + (size_t)t * 1536 + h * 192 + 128 + i;
            const float a = bf2f(p[0]), b = bf2f(p[32]); p[0] = f2bf(a * cs - b * sn); p[32] = f2bf(b * cs + a * sn); }
    }
}
__device__ __forceinline__ void mla_attention(const Ctx& c) {
    const bf16_t* Q = (const bf16_t*)(c.ws + B_Q); const bf16_t* KV = (const bf16_t*)(c.ws + B_KV); const bf16_t* KR = (const bf16_t*)(c.ws + B_KROPE); bf16_t* O = (bf16_t*)(c.ws + B_O);
    const int NU = 512 + 2048;
    for (int u = c.bid; u < NU; u += c.G) {
        int tok0, qb, h, seq;
        if (u < 512) { const int round = u >> 8, cc = u & 255, bh = round * 8 + (cc & 7); tok0 = (bh >> 3) * SP; h = bh & 7; qb = cc >> 3; seq = SP; }
        else { const int us = u - 512, round = us >> 8, cc = us & 255, r = cc >> 3, bh = round * 32 + (cc & 7) * 4 + (r >> 3); tok0 = TP + (bh >> 3) * SS; h = bh & 7; qb = r & 7; seq = SS; }
        attn::attn_body(Q + (size_t)(tok0 + qb * 256) * 1536 + h * 192, KV + (size_t)tok0 * 2048 + h * 256, KR + (size_t)tok0 * 64,
                        O + (size_t)(tok0 + qb * 256) * 1024 + h * 128, seq, (char*)c.lds, c.tid, qb * 256, (const float*)(c.ws + WS_ROPE));
        __syncthreads();
    }
}
__device__ __forceinline__ void ln_residual(const Ctx& c, const bf16_t* hb, const float* g, const float* b, bool first) {
    bf16_t* xb = (bf16_t*)(c.ws + WS_XB); const int lane = c.lane;
    for (int t = c.gw; t < T; t += c.NGW) {
        float* xr = c.out + (size_t)t * D; const bf16_t* hr = hb + (size_t)t * D;
        const float* xs = first ? (t < TP ? c.in(0) + (size_t)t * D : c.in(1) + (size_t)(t - TP) * D) : xr;
        f32x4 v[4]; float s = 0.f;
#pragma unroll
        for (int j = 0; j < 4; ++j) { const f32x4 x = *(const f32x4*)(xs + 256 * j + 4 * lane); const u32x2 hw = *(const u32x2*)(hr + 256 * j + 4 * lane);
            const f32x4 hh = (f32x4){bflo(hw.x), bfhi(hw.x), bflo(hw.y), bfhi(hw.y)}; v[j] = x * DN_ALPHA + hh; s += (v[j][0] + v[j][1]) + (v[j][2] + v[j][3]); }
        const float mean = wave_sum(s) * (1.0f / D); float s2 = 0.f;
#pragma unroll
        for (int j = 0; j < 4; ++j) { v[j] = v[j] - mean; s2 += (v[j][0] * v[j][0] + v[j][1] * v[j][1]) + (v[j][2] * v[j][2] + v[j][3] * v[j][3]); }
        const float rstd = 1.0f / sqrtf(wave_sum(s2) * (1.0f / D) + LN_EPS);
#pragma unroll
        for (int j = 0; j < 4; ++j) { const f32x4 gg = *(const f32x4*)(g + 256 * j + 4 * lane), bb = *(const f32x4*)(b + 256 * j + 4 * lane); const f32x4 o = v[j] * rstd * gg + bb;
            *(f32x4*)(xr + 256 * j + 4 * lane) = o; u32x2 w; w.x = cvt_pk_bf16(o[0], o[1]); w.y = cvt_pk_bf16(o[2], o[3]); *(u32x2*)(xb + (size_t)t * D + 256 * j + 4 * lane) = w; }
    }
}
__device__ __forceinline__ void hgrn_post(const Ctx& c, int j) {
    bf16_t* pl = (bf16_t*)(c.ws + B_PLANE); const size_t PE = (size_t)T * 1024;
    const bf16_t* of = pl + 1 * PE; const bf16_t* ob = pl + 2 * PE; const bf16_t* sg = pl + 4 * PE; bf16_t* on = pl;
    const float* nw = c.in(12) + j * 128; const int lane = c.lane;
    for (int t = c.gw; t < T; t += c.NGW) {
#pragma unroll
        for (int k = 0; k < 2; ++k) { const size_t off = (size_t)t * 1024 + 512 * k + 8 * lane;
            const u32x4 a = *(const u32x4*)(of + off), b = *(const u32x4*)(ob + off), g = *(const u32x4*)(sg + off);
            float o[8]; o[0] = bflo(a.x) + bflo(b.x); o[1] = bfhi(a.x) + bfhi(b.x); o[2] = bflo(a.y) + bflo(b.y); o[3] = bfhi(a.y) + bfhi(b.y);
            o[4] = bflo(a.z) + bflo(b.z); o[5] = bfhi(a.z) + bfhi(b.z); o[6] = bflo(a.w) + bflo(b.w); o[7] = bfhi(a.w) + bfhi(b.w);
            float ss = 0.f;
#pragma unroll
            for (int e = 0; e < 8; ++e) ss += o[e] * o[e];
            ss = row16_sum(ss);
            const float r = 1.0f / sqrtf(ss * (1.0f / 128.0f) + RMS_EPS);
            const int cw = (8 * lane) & 127; const f32x4 w0 = *(const f32x4*)(nw + cw), w1 = *(const f32x4*)(nw + cw + 4);
            float gg[8]; gg[0] = bflo(g.x); gg[1] = bfhi(g.x); gg[2] = bflo(g.y); gg[3] = bfhi(g.y); gg[4] = bflo(g.z); gg[5] = bfhi(g.z); gg[6] = bflo(g.w); gg[7] = bfhi(g.w);
            u32x4 w; w.x = cvt_pk_bf16(o[0] * r * w0[0] * gg[0], o[1] * r * w0[1] * gg[1]); w.y = cvt_pk_bf16(o[2] * r * w0[2] * gg[2], o[3] * r * w0[3] * gg[3]);
            w.z = cvt_pk_bf16(o[4] * r * w1[0] * gg[4], o[5] * r * w1[1] * gg[5]); w.w = cvt_pk_bf16(o[6] * r * w1[2] * gg[6], o[7] * r * w1[3] * gg[7]);
            *(u32x4*)(on + off) = w; }
    }
}
namespace scan {
constexpr size_t D_F = R2_IDX, D_B = R2_IDX + 12 * MiB;
constexpr int NCH = T / 32;
__device__ __forceinline__ void hgrn_prep(const Ctx& c) {
    bf16_t* pl = (bf16_t*)(c.ws + B_PLANE); const size_t PE = (size_t)T * 1024;
    bf16_t* qs = pl; bf16_t* lff = pl + PE; bf16_t* lfb = pl + 2 * PE; bf16_t* qtb = (bf16_t*)(c.ws + WS_XB);
    float* dF = (float*)(c.ws + D_F); float* dB = (float*)(c.ws + D_B);
    const int lane = c.lane;
    for (int it = c.gw; it < NCH * 8; it += c.NGW) {
        const int chunk = it >> 3, h = it & 7; const size_t base = (size_t)chunk * 32 * 1024 + h * 128 + 2 * lane;
        { float r0 = 0.f, r1 = 0.f;
#pragma unroll 8
          for (int tau = 31; tau >= 0; --tau) { const size_t o = base + (size_t)tau * 1024; const unsigned lw = *(const unsigned*)(lfb + o), qw = *(const unsigned*)(qs + o);
              const float l0 = bflo(lw), l1 = bfhi(lw); r0 += l0; r1 += l1;
              const float k0 = 1.0f - fast_exp(l0), k1 = 1.0f - fast_exp(l1);
              *(unsigned*)(qtb + o) = cvt_pk_bf16(bflo(qw) * fast_exp(r0), bfhi(qw) * fast_exp(r1));
              *(unsigned*)(lfb + o) = cvt_pk_bf16(k0 * fast_exp(fminf(-r0, 80.f)), k1 * fast_exp(fminf(-r1, 80.f))); }
          *(f32x2*)(dB + (size_t)chunk * 1024 + h * 128 + 2 * lane) = (f32x2){fast_exp(r0), fast_exp(r1)}; }
        { float r0 = 0.f, r1 = 0.f;
#pragma unroll 8
          for (int tau = 0; tau < 32; ++tau) { const size_t o = base + (size_t)tau * 1024; const unsigned lw = *(const unsigned*)(lff + o), qw = *(const unsigned*)(qs + o);
              const float l0 = bflo(lw), l1 = bfhi(lw); r0 += l0; r1 += l1;
              const float k0 = 1.0f - fast_exp(l0), k1 = 1.0f - fast_exp(l1);
              *(unsigned*)(qs + o) = cvt_pk_bf16(bflo(qw) * fast_exp(r0), bfhi(qw) * fast_exp(r1));
              *(unsigned*)(lff + o) = cvt_pk_bf16(k0 * fast_exp(fminf(-r0, 80.f)), k1 * fast_exp(fminf(-r1, 80.f))); }
          *(f32x2*)(dF + (size_t)chunk * 1024 + h * 128 + 2 * lane) = (f32x2){fast_exp(r0), fast_exp(r1)}; }
    }
}

constexpr int QT_OFF = 0, KT_OFF = 8192, V_OFF = 16384, P_OFF = 24576, ST_OFF = 34816, DV_OFF = 69632, CHAIN_BYTES = 70144;
constexpr int RS = 272, RS2 = 80;
__device__ __forceinline__ int crow(int r, int hi) { return (r & 3) + 8 * (r >> 2) + 4 * hi; }
__device__ __forceinline__ unsigned off_b(unsigned row, unsigned ch) { return 256u * row + 16u * (ch ^ (((row & 3) << 2) | ((row >> 2) & 3))); }
__device__ __forceinline__ unsigned row_read_addr(unsigned lane, unsigned s) { return off_b(lane & 31, 2 * s + (lane >> 5)); }
__device__ __forceinline__ unsigned tr_read_addr(unsigned lane, unsigned cc, unsigned ks, unsigned t) {
    const unsigned h = lane >> 5, blk = (lane >> 4) & 1, q = (lane & 15) >> 2, p = lane & 3;
    return off_b(16 * ks + 8 * h + 4 * t + q, 4 * cc + 2 * blk + (p >> 1)) + 8 * (p & 1);
}
__device__ __forceinline__ s16x4 tr_rd(unsigned addr) { s16x4 r; asm volatile("ds_read_b64_tr_b16 %0, %1" : "=&v"(r) : "v"(addr) : "memory"); return r; }
#define TRPK(L, H) (bf16x8){L[0], L[1], L[2], L[3], H[0], H[1], H[2], H[3]}

__device__ __forceinline__ void run_pair(const Ctx& c, int tok0, int L, int h, bool dummy) {
    bf16_t* pl = (bf16_t*)(c.ws + B_PLANE); const size_t PE = (size_t)T * 1024;
    const int tid = c.tid, lane = c.lane, wave = c.wave, ch = wave >> 2, w = wave & 3, r32 = lane & 31, hi = lane >> 5;
    const bf16_t* qt = ch ? (const bf16_t*)(c.ws + WS_XB) : pl; bf16_t* kt = pl + (size_t)(1 + ch) * PE; const bf16_t* vv = pl + 3 * PE;
    const float* dd = (const float*)(c.ws + (ch ? D_B : D_F));
    bf16_t* odst = dummy ? (bf16_t*)(c.ws + R2_PB) - (size_t)20 * MiB : kt;
    LAS unsigned char* base = c.lds + ch * CHAIN_BYTES;
    const unsigned lbase = (unsigned)(uintptr_t)base;
    const int ctid = tid & 255;
    const int NC = L / 32;
    const int vcol = 32 * w + r32;
    LAS unsigned char* Pw = base + P_OFF + w * 2560;
    const int s_r0 = ctid >> 4, s_chn = ctid & 15;
    u32x4 sreg[6]; f32x4 dreg = (f32x4){0.f, 0.f, 0.f, 0.f};
#define SCAN_LOAD(cidx) do { const size_t rowb = (size_t)(tok0 + 32 * (cidx)) * 1024 + h * 128; \
        _Pragma("unroll") for (int i = 0; i < 6; ++i) { const bf16_t* src = ((i >> 1) == 0 ? qt : ((i >> 1) == 1 ? (const bf16_t*)kt : vv)) + rowb + (size_t)(s_r0 + 16 * (i & 1)) * 1024 + s_chn * 8; sreg[i] = *(const u32x4*)src; } \
        if (ctid < 32) dreg = *(const f32x4*)(dd + (size_t)((tok0 >> 5) + (cidx)) * 1024 + h * 128 + 4 * ctid); } while (0)
#define SCAN_WRITE() do { _Pragma("unroll") for (int i = 0; i < 6; ++i) *(LAS u32x4*)(base + (i >> 1) * 8192 + off_b(s_r0 + 16 * (i & 1), s_chn)) = sreg[i]; \
        if (ctid < 32) *(LAS f32x4*)(base + DV_OFF + 16 * ctid) = dreg; } while (0)
    { LAS u32x4* st = (LAS u32x4*)(base + ST_OFF + (32 * w) * RS); for (int i = lane; i < 32 * RS / 16; i += 64) st[i] = (u32x4){0u, 0u, 0u, 0u}; }
    f32x16 S[4];
#pragma unroll
    for (int kt2 = 0; kt2 < 4; ++kt2) S[kt2] = f32x16{};
    SCAN_LOAD(ch ? NC - 1 : 0); SCAN_WRITE();
    __syncthreads();
    for (int ci = 0; ci < NC; ++ci) {
        const int cidx = ch ? NC - 1 - ci : ci;
        if (ci + 1 < NC) SCAN_LOAD(ch ? cidx - 1 : cidx + 1);
        f32x16 X = f32x16{};
#pragma unroll
        for (int ks = 0; ks < 8; ++ks) { const bf16x8 qa = *(const LAS bf16x8*)(base + QT_OFF + row_read_addr(lane, ks));
            const bf16x8 kb = *(const LAS bf16x8*)(base + KT_OFF + row_read_addr(lane, ks));
            X = __builtin_amdgcn_mfma_f32_32x32x16_bf16(qa, kb, X, 0, 0, 0); }
#pragma unroll
        for (int r = 0; r < 16; ++r) { const int t = crow(r, hi); const bool keep = ch ? (t <= r32) : (t >= r32); *(LAS bf16_t*)(Pw + t * RS2 + r32 * 2) = f2bf(keep ? X[r] : 0.f); }
        s16x4 vl[2], vh[2];
#pragma unroll
        for (int ks = 0; ks < 2; ++ks) { vl[ks] = tr_rd(lbase + V_OFF + tr_read_addr(lane, w, ks, 0)); vh[ks] = tr_rd(lbase + V_OFF + tr_read_addr(lane, w, ks, 1)); }
        asm volatile("s_waitcnt lgkmcnt(0)" ::: "memory"); __builtin_amdgcn_sched_barrier(0);
        bf16x8 vb[2];
#pragma unroll
        for (int ks = 0; ks < 2; ++ks) vb[ks] = TRPK(vl[ks], vh[ks]);
        f32x16 O = f32x16{};
#pragma unroll
        for (int ks = 0; ks < 2; ++ks) { const bf16x8 pa = *(const LAS bf16x8*)(Pw + r32 * RS2 + (16 * ks + 8 * hi) * 2);
            O = __builtin_amdgcn_mfma_f32_32x32x16_bf16(pa, vb[ks], O, 0, 0, 0); }
#pragma unroll
        for (int ks = 0; ks < 8; ++ks) { const bf16x8 sb = *(const LAS bf16x8*)(base + ST_OFF + vcol * RS + (16 * ks + 8 * hi) * 2);
            const bf16x8 qa = *(const LAS bf16x8*)(base + QT_OFF + row_read_addr(lane, ks));
            O = __builtin_amdgcn_mfma_f32_32x32x16_bf16(qa, sb, O, 0, 0, 0); }
#pragma unroll
        for (int r = 0; r < 16; ++r) { const int t = tok0 + 32 * cidx + crow(r, hi); odst[(size_t)t * 1024 + h * 128 + vcol] = f2bf(O[r]); }
#pragma unroll
        for (int kt2 = 0; kt2 < 4; ++kt2) {
            s16x4 al[2], ah[2];
#pragma unroll
            for (int ks = 0; ks < 2; ++ks) { al[ks] = tr_rd(lbase + KT_OFF + tr_read_addr(lane, kt2, ks, 0)); ah[ks] = tr_rd(lbase + KT_OFF + tr_read_addr(lane, kt2, ks, 1)); }
            asm volatile("s_waitcnt lgkmcnt(0)" ::: "memory"); __builtin_amdgcn_sched_barrier(0);
#pragma unroll
            for (int ks = 0; ks < 2; ++ks) S[kt2] = __builtin_amdgcn_mfma_f32_32x32x16_bf16(TRPK(al[ks], ah[ks]), vb[ks], S[kt2], 0, 0, 0);
#pragma unroll
            for (int g = 0; g < 4; ++g) { const f32x4 d4 = *(const LAS f32x4*)(base + DV_OFF + (32 * kt2 + 8 * g + 4 * hi) * 4);
#pragma unroll
                for (int e = 0; e < 4; ++e) S[kt2][4 * g + e] *= d4[e];
                u32x2 pk; pk.x = cvt_pk_bf16(S[kt2][4 * g], S[kt2][4 * g + 1]); pk.y = cvt_pk_bf16(S[kt2][4 * g + 2], S[kt2][4 * g + 3]);
                *(LAS u32x2*)(base + ST_OFF + vcol * RS + (32 * kt2 + 8 * g + 4 * hi) * 2) = pk; }
        }
        __syncthreads();
        if (ci + 1 < NC) SCAN_WRITE();
        __syncthreads();
    }
#undef SCAN_LOAD
#undef SCAN_WRITE
}
#undef TRPK
__device__ __forceinline__ void hgrn_scan(const Ctx& c, bool dummy) {
    const int NP = 16 + 256;
    for (int rnd = 0;; ++rnd) {
        const int p = (rnd & 1) ? (rnd * c.G + (c.G - 1 - c.bid)) : (rnd * c.G + c.bid);
        if (rnd * c.G >= NP) break;
        if (p < NP) {
            const int tok0 = p < 16 ? (p >> 3) * SP : TP + ((p - 16) >> 3) * SS, L = p < 16 ? SP : SS, h = p < 16 ? (p & 7) : ((p - 16) & 7);
            run_pair(c, tok0, L, h, dummy);
        }
    }
}
}
#define CE_(a, i, j) { const unsigned _x = a[i] > a[j] ? a[i] : a[j], _y = a[i] > a[j] ? a[j] : a[i]; a[i] = _x; a[j] = _y; }
__device__ __forceinline__ void sort16_desc(unsigned (&a)[16]) {
    CE_(a, 0, 1) CE_(a, 2, 3) CE_(a, 0, 2) CE_(a, 1, 3) CE_(a, 1, 2) CE_(a, 4, 5) CE_(a, 6, 7) CE_(a, 4, 6) CE_(a, 5, 7) CE_(a, 5, 6) CE_(a, 0, 4) CE_(a, 2, 6) CE_(a, 2, 4) CE_(a, 1, 5) CE_(a, 3, 7) CE_(a, 3, 5) CE_(a, 1, 2) CE_(a, 3, 4) CE_(a, 5, 6) CE_(a, 8, 9) CE_(a, 10, 11) CE_(a, 8, 10) CE_(a, 9, 11) CE_(a, 9, 10) CE_(a, 12, 13) CE_(a, 14, 15) CE_(a, 12, 14) CE_(a, 13, 15) CE_(a, 13, 14) CE_(a, 8, 12) CE_(a, 10, 14) CE_(a, 10, 12) CE_(a, 9, 13) CE_(a, 11, 15) CE_(a, 11, 13) CE_(a, 9, 10) CE_(a, 11, 12) CE_(a, 13, 14) CE_(a, 0, 8) CE_(a, 4, 12) CE_(a, 4, 8) CE_(a, 2, 10) CE_(a, 6, 14) CE_(a, 6, 10) CE_(a, 2, 4) CE_(a, 6, 8) CE_(a, 10, 12) CE_(a, 1, 9) CE_(a, 5, 13) CE_(a, 5, 9) CE_(a, 3, 11) CE_(a, 7, 15) CE_(a, 7, 11) CE_(a, 3, 5) CE_(a, 7, 9) CE_(a, 11, 13) CE_(a, 1, 2) CE_(a, 3, 4) CE_(a, 5, 6) CE_(a, 7, 8) CE_(a, 9, 10) CE_(a, 11, 12) CE_(a, 13, 14)
}
__device__ __forceinline__ void merge16_top(unsigned (&a)[16], const unsigned (&b)[16]) {
    a[0] = a[0] > b[15] ? a[0] : b[15]; a[1] = a[1] > b[14] ? a[1] : b[14]; a[2] = a[2] > b[13] ? a[2] : b[13]; a[3] = a[3] > b[12] ? a[3] : b[12]; a[4] = a[4] > b[11] ? a[4] : b[11]; a[5] = a[5] > b[10] ? a[5] : b[10]; a[6] = a[6] > b[9] ? a[6] : b[9]; a[7] = a[7] > b[8] ? a[7] : b[8]; a[8] = a[8] > b[7] ? a[8] : b[7]; a[9] = a[9] > b[6] ? a[9] : b[6]; a[10] = a[10] > b[5] ? a[10] : b[5]; a[11] = a[11] > b[4] ? a[11] : b[4]; a[12] = a[12] > b[3] ? a[12] : b[3]; a[13] = a[13] > b[2] ? a[13] : b[2]; a[14] = a[14] > b[1] ? a[14] : b[1]; a[15] = a[15] > b[0] ? a[15] : b[0];
    CE_(a, 0, 8) CE_(a, 1, 9) CE_(a, 2, 10) CE_(a, 3, 11) CE_(a, 4, 12) CE_(a, 5, 13) CE_(a, 6, 14) CE_(a, 7, 15) CE_(a, 0, 4) CE_(a, 1, 5) CE_(a, 2, 6) CE_(a, 3, 7) CE_(a, 8, 12) CE_(a, 9, 13) CE_(a, 10, 14) CE_(a, 11, 15) CE_(a, 0, 2) CE_(a, 1, 3) CE_(a, 4, 6) CE_(a, 5, 7) CE_(a, 8, 10) CE_(a, 9, 11) CE_(a, 12, 14) CE_(a, 13, 15) CE_(a, 0, 1) CE_(a, 2, 3) CE_(a, 4, 5) CE_(a, 6, 7) CE_(a, 8, 9) CE_(a, 10, 11) CE_(a, 12, 13) CE_(a, 14, 15)
}
namespace peer {
constexpr int KEY_RS = 272;
constexpr int KEYS_BYTES = 2 * 128 * KEY_RS;
constexpr int SI_OFF = KEYS_BYTES;
__device__ __forceinline__ int crow(int r, int hi) { return (r & 3) + 8 * (r >> 2) + 4 * hi; }
__device__ __forceinline__ unsigned sortable(float f) { const unsigned u = __float_as_uint(f); return u ^ ((u >> 31) ? 0xFFFFFFFFu : 0x80000000u); }
__device__ __forceinline__ float unsortable(unsigned s) { const unsigned u = (s >> 31) ? (s ^ 0x80000000u) : ~s; return __uint_as_float(u); }
__device__ __forceinline__ unsigned pair_max(unsigned m) { auto rr = __builtin_amdgcn_permlane32_swap(m, m, false, false); return rr[0] > rr[1] ? rr[0] : rr[1]; }

__device__ __forceinline__ void top16_half(const Ctx& c, const bf16_t* pq_rows, int half, LAS unsigned char* keys, unsigned (&sel)[16]) {
    const int lane = c.lane, r32 = lane & 31, hi = lane >> 5;
    f32x16 acc[4];
#pragma unroll
    for (int nt = 0; nt < 4; ++nt) acc[nt] = f32x16{};
    const bf16_t* qrow = pq_rows + (size_t)r32 * 256 + half * 128;
#pragma unroll 1
    for (int ks = 0; ks < 8; ++ks) { const bf16x8 qb = *reinterpret_cast<const bf16x8*>(qrow + 16 * ks + 8 * hi);
#pragma unroll
        for (int nt = 0; nt < 4; ++nt) { const bf16x8 ka = *(const LAS bf16x8*)(keys + (half * 128 + 32 * nt + r32) * KEY_RS + (16 * ks + 8 * hi) * 2);
            acc[nt] = __builtin_amdgcn_mfma_f32_32x32x16_bf16(ka, qb, acc[nt], 0, 0, 0); } }
    unsigned p[64];
#pragma unroll
    for (int nt = 0; nt < 4; ++nt)
#pragma unroll
        for (int r = 0; r < 16; ++r) { const int n = 32 * nt + crow(r, hi); p[nt * 16 + r] = (sortable(acc[nt][r]) & ~127u) | (unsigned)(127 - n); }
    unsigned g0[16], g1[16], g2[16], g3[16];
#pragma unroll
    for (int i = 0; i < 16; ++i) { g0[i] = p[i]; g1[i] = p[16 + i]; g2[i] = p[32 + i]; g3[i] = p[48 + i]; }
    sort16_desc(g0); sort16_desc(g1); sort16_desc(g2); sort16_desc(g3);
    merge16_top(g0, g1); merge16_top(g2, g3); merge16_top(g0, g2);
    unsigned pb[16];
#pragma unroll
    for (int i = 0; i < 16; ++i) { auto rr = __builtin_amdgcn_permlane32_swap(g0[i], g0[i], false, false); sel[i] = rr[0]; pb[i] = rr[1]; }
    merge16_top(sel, pb);
}
__device__ __forceinline__ void route(const Ctx& c, int layer) {
    const bf16_t* pq = (const bf16_t*)(c.ws + B_PQ); int* idx_out = (int*)(c.ws + R2_IDX); float* gate_out = (float*)(c.ws + R2_GATE);
    const bf16_t* keys_g = (const bf16_t*)(c.ws + W_KEYS) + (size_t)layer * 2 * 128 * 128;
    LAS unsigned char* keys = c.lds;
    const int lane = c.lane, r32 = lane & 31, hi = lane >> 5;
    for (int i = c.tid; i < 2 * 128 * 16; i += NTHR) { const int row = i >> 4, ch = i & 15; *(LAS u32x4*)(keys + row * KEY_RS + ch * 16) = *(const u32x4*)(keys_g + (size_t)row * 128 + ch * 8); }
    __syncthreads();
    LAS int* si = (LAS int*)(c.lds + SI_OFF + c.wave * 4096) + r32 * 32;
    for (int grp = c.gw; grp < T / 4; grp += c.NGW) {
        const bf16_t* rows = pq + (size_t)grp * 4 * 2048;
        unsigned s1[16], s2[16];
        top16_half(c, rows, 0, keys, s1);
        top16_half(c, rows, 1, keys, s2);
        float v1[16], v2[16];
#pragma unroll
        for (int i = 0; i < 16; ++i) { v1[i] = unsortable(s1[i] & ~127u); v2[i] = unsortable(s2[i] & ~127u); }
        if (hi == 0) {
#pragma unroll
            for (int i = 0; i < 16; ++i) { si[i] = 127 - (int)(s1[i] & 127u); si[16 + i] = 127 - (int)(s2[i] & 127u); }
        }
        float A[16], B[16];
#pragma unroll
        for (int i = 0; i < 16; ++i) { A[i] = hi ? v2[i] : v1[i]; B[i] = hi ? v1[i] : v2[i]; }
        unsigned cd[27]; int nc = 0;
#pragma unroll
        for (int i = 0; i < 16; ++i)
#pragma unroll
            for (int j = i; j < 16; ++j) if ((i + 1) * (j + 1) <= 16) {
                const unsigned flat = hi ? (unsigned)(j * 16 + i) : (unsigned)(i * 16 + j);
                unsigned pk = (sortable(A[i] + B[j]) & ~255u) | (255u - flat);
                if (i == j) pk = hi ? 0u : pk;
                cd[nc++] = pk; }
        unsigned sel[16], c1[16], pb[16];
#pragma unroll
        for (int i = 0; i < 16; ++i) { sel[i] = cd[i]; c1[i] = (16 + i < 27) ? cd[(16 + i < 27) ? 16 + i : 0] : 0u; }
        sort16_desc(sel); sort16_desc(c1); merge16_top(sel, c1);
#pragma unroll
        for (int i = 0; i < 16; ++i) { auto rr = __builtin_amdgcn_permlane32_swap(sel[i], sel[i], false, false); sel[i] = rr[0]; pb[i] = rr[1]; }
        merge16_top(sel, pb);
        LDS_WAIT(); asm volatile("" ::: "memory");
        const float vmax = unsortable(sel[0] & ~255u);
        float e[16], es = 0.f;
#pragma unroll
        for (int i = 0; i < 16; ++i) { e[i] = fast_exp(unsortable(sel[i] & ~255u) - vmax); es += e[i]; }
        const float inv = 1.0f / es;
        const size_t obase = ((size_t)grp * 4 + (r32 >> 3)) * 128 + (r32 & 7) * 16 + 8 * hi;
        int oi[8]; float og[8];
#pragma unroll
        for (int q = 0; q < 8; ++q) { const unsigned sv = hi ? sel[8 + q] : sel[q]; const float ev = hi ? e[8 + q] : e[q];
            const int flat = 255 - (int)(sv & 255u); oi[q] = si[flat >> 4] * 128 + si[16 + (flat & 15)]; og[q] = ev * inv; }
        *(u32x4*)(idx_out + obase) = (u32x4){(unsigned)oi[0], (unsigned)oi[1], (unsigned)oi[2], (unsigned)oi[3]};
        *(u32x4*)(idx_out + obase + 4) = (u32x4){(unsigned)oi[4], (unsigned)oi[5], (unsigned)oi[6], (unsigned)oi[7]};
        *(f32x4*)(gate_out + obase) = (f32x4){og[0], og[1], og[2], og[3]};
        *(f32x4*)(gate_out + obase + 4) = (f32x4){og[4], og[5], og[6], og[7]};
        LDS_WAIT(); asm volatile("" ::: "memory");
    }
    __syncthreads();
}

__device__ __forceinline__ float gelu_exact(float x) { return 0.5f * x * (1.0f + erff(x * 0.70710678118654752f)); }
template <int IDXMASK> __device__ __forceinline__ void gather_ln(const Ctx& c, int layer, float* xout, bf16_t* xb) {
    const unsigned char* U8 = c.ws + R2_UB; const unsigned char* V8 = c.ws + R2_VB;
    const float* su = (const float*)(c.ws + R2_SU); const float* sv = (const float*)(c.ws + R2_SV);
    const int* idx = (const int*)(c.ws + R2_IDX); const float* gate = (const float*)(c.ws + R2_GATE);
    const float* lg = c.in(20) + layer * D; const float* lbv = c.in(21) + layer * D;
    const int lane = c.lane;
    for (int t = c.gw; t < T; t += c.NGW) {
        const float* xr = c.out + (size_t)t * D + 16 * lane; float* xw = xout + (size_t)t * D + 16 * lane;
        float x[16], acc[16];
#pragma unroll
        for (int j = 0; j < 4; ++j) { const f32x4 a = *(const f32x4*)(xr + 4 * j); x[4 * j] = a[0]; x[4 * j + 1] = a[1]; x[4 * j + 2] = a[2]; x[4 * j + 3] = a[3]; }
#pragma unroll
        for (int e = 0; e < 16; ++e) acc[e] = 0.f;
        const int myidx0 = idx[(size_t)t * 128 + lane] & IDXMASK, myidx1 = idx[(size_t)t * 128 + 64 + lane] & IDXMASK;
        const float myg0 = gate[(size_t)t * 128 + lane], myg1 = gate[(size_t)t * 128 + 64 + lane];
        for (int eb = 0; eb < 128; eb += 8) {
            float part[8]; int ei[8];
#pragma unroll
            for (int q = 0; q < 8; ++q) { const int e = eb + q; ei[q] = __builtin_amdgcn_readlane(e < 64 ? myidx0 : myidx1, e & 63); }
            u32x4 vr[8];
#pragma unroll
            for (int q = 0; q < 8; ++q) vr[q] = *(const u32x4*)(V8 + (size_t)ei[q] * D + 16 * lane);
#pragma unroll
            for (int q = 0; q < 8; ++q) { const u32x4 a = *(const u32x4*)(U8 + (size_t)ei[q] * D + 16 * lane);
                float s = 0.f;
#pragma unroll
                for (int j = 0; j < 4; ++j) { const f32x2 lo = __builtin_amdgcn_cvt_pk_f32_fp8((int)a[j], false), hi = __builtin_amdgcn_cvt_pk_f32_fp8((int)a[j], true);
                    s = fmaf(lo[0], x[4 * j], s); s = fmaf(lo[1], x[4 * j + 1], s); s = fmaf(hi[0], x[4 * j + 2], s); s = fmaf(hi[1], x[4 * j + 3], s); }
                part[q] = s; }
            float r4[4], r2[2], r1;
            { const bool up = (lane & 32) != 0;
#pragma unroll
              for (int i = 0; i < 4; ++i) { const float send = up ? part[i] : part[4 + i]; const float keep = up ? part[4 + i] : part[i]; r4[i] = keep + __shfl_xor(send, 32); } }
            { const bool up = (lane & 16) != 0;
#pragma unroll
              for (int i = 0; i < 2; ++i) { const float send = up ? r4[i] : r4[2 + i]; const float keep = up ? r4[2 + i] : r4[i]; r2[i] = keep + __shfl_xor(send, 16); } }
            { const bool up = (lane & 8) != 0; const float send = up ? r2[0] : r2[1]; const float keep = up ? r2[1] : r2[0]; r1 = keep + __shfl_xor(send, 8); }
            r1 += __shfl_xor(r1, 4); r1 += __shfl_xor(r1, 2); r1 += __shfl_xor(r1, 1);
            const int myq = ((lane >> 5) & 1) * 4 + ((lane >> 4) & 1) * 2 + ((lane >> 3) & 1);
            const int me = eb + myq;
            const float g = __shfl(me < 64 ? myg0 : myg1, me & 63);
            const int mye = __shfl(me < 64 ? myidx0 : myidx1, me & 63);
            const float cf = g * gelu_exact(r1 * su[mye]) * sv[mye];
            float cq[8];
#pragma unroll
            for (int q = 0; q < 8; ++q) cq[q] = __int_as_float(__builtin_amdgcn_readlane(__float_as_int(cf), ((q >> 2) & 1) * 32 + ((q >> 1) & 1) * 16 + (q & 1) * 8));
#pragma unroll
            for (int q = 0; q < 8; ++q) { const float s = cq[q];
#pragma unroll
                for (int j = 0; j < 4; ++j) { const f32x2 lo = __builtin_amdgcn_cvt_pk_f32_fp8((int)vr[q][j], false), hi = __builtin_amdgcn_cvt_pk_f32_fp8((int)vr[q][j], true);
                    acc[4 * j] = fmaf(s, lo[0], acc[4 * j]); acc[4 * j + 1] = fmaf(s, lo[1], acc[4 * j + 1]); acc[4 * j + 2] = fmaf(s, hi[0], acc[4 * j + 2]); acc[4 * j + 3] = fmaf(s, hi[1], acc[4 * j + 3]); } }
        }
        float s = 0.f;
#pragma unroll
        for (int e = 0; e < 16; ++e) { acc[e] = fmaf(DN_ALPHA, x[e], acc[e]); s += acc[e]; }
        const float mean = wave_sum(s) * (1.0f / D); float s2 = 0.f;
#pragma unroll
        for (int e = 0; e < 16; ++e) { acc[e] -= mean; s2 += acc[e] * acc[e]; }
        const float rstd = 1.0f / sqrtf(wave_sum(s2) * (1.0f / D) + LN_EPS);
        float o[16];
#pragma unroll
        for (int j = 0; j < 4; ++j) { const f32x4 g4 = *(const f32x4*)(lg + 16 * lane + 4 * j), b4 = *(const f32x4*)(lbv + 16 * lane + 4 * j);
#pragma unroll
            for (int e = 0; e < 4; ++e) o[4 * j + e] = acc[4 * j + e] * rstd * g4[e] + b4[e];
            *(f32x4*)(xw + 4 * j) = (f32x4){o[4 * j], o[4 * j + 1], o[4 * j + 2], o[4 * j + 3]}; }
        u32x4 w0, w1; w0.x = cvt_pk_bf16(o[0], o[1]); w0.y = cvt_pk_bf16(o[2], o[3]); w0.z = cvt_pk_bf16(o[4], o[5]); w0.w = cvt_pk_bf16(o[6], o[7]);
        w1.x = cvt_pk_bf16(o[8], o[9]); w1.y = cvt_pk_bf16(o[10], o[11]); w1.z = cvt_pk_bf16(o[12], o[13]); w1.w = cvt_pk_bf16(o[14], o[15]);
        *(u32x4*)(xb + (size_t)t * D + 16 * lane) = w0; *(u32x4*)(xb + (size_t)t * D + 16 * lane + 8) = w1;
    }
}
}
namespace peer {
constexpr size_t HP_OFF = WS_BIG;
constexpr int QW_BASE = 4096;
constexpr int ITEM_TOK = 128, NBLK = T / ITEM_TOK;
#define DPP_F(v, ctrl) __int_as_float(__builtin_amdgcn_update_dpp(0, __float_as_int(v), (ctrl), 0xf, 0xf, true))

template <class F> __device__ __forceinline__ void for_items(const Ctx& c, int layer, int phase, F body) {
    unsigned* qw = (unsigned*)(c.ws + WS_CTL) + QW_BASE + (size_t)((layer * 2 + phase) * 8) * 16;
    volatile LAS int* slot = (volatile LAS int*)(c.lds + LDS_MISC_OFF + 128);
    const int home = (int)(xb_xcc_id() & 7u);
    for (int k = 0; k < 8; ++k) {
        const int s = (home + k) & 7;
        if (c.tid == 0) slot[0] = (int)__hip_atomic_fetch_add(qw + s * 16, 1u, __ATOMIC_RELAXED, __HIP_MEMORY_SCOPE_AGENT);
        __syncthreads();
        int cur = slot[0];
        __syncthreads();
        while (cur < NBLK) {
            if (c.tid == 0) slot[0] = (int)__hip_atomic_fetch_add(qw + s * 16, 1u, __ATOMIC_RELAXED, __HIP_MEMORY_SCOPE_AGENT);
            body(s, cur);
            __syncthreads();
            cur = slot[0];
            __syncthreads();
        }
    }
}

__device__ __forceinline__ void g1_udot(const Ctx& c, int layer) {
    const unsigned char* U8 = c.ws + R2_UB; const int* idx = (const int*)(c.ws + R2_IDX); float* hp = (float*)(c.ws + HP_OFF);
    for_items(c, layer, 0, [&](int s, int blk) {
        int lane = c.lane; asm volatile("" : "+v"(lane));
        const int g = lane >> 3, c8 = lane & 7;
        const int co = 128 * s + 16 * c8;
#pragma unroll 1
        for (int i = 0; i < ITEM_TOK / NWAVES; i += 2) {
            const int t0 = blk * ITEM_TOK + c.wave * (ITEM_TOK / NWAVES) + i;
            float x[2][16]; int id[2][16];
#pragma unroll
            for (int u = 0; u < 2; ++u)
#pragma unroll
            for (int j = 0; j < 4; ++j) { const f32x4 a = *(const f32x4*)(c.out + (size_t)(t0 + u) * D + co + 4 * j); x[u][4 * j] = a[0]; x[u][4 * j + 1] = a[1]; x[u][4 * j + 2] = a[2]; x[u][4 * j + 3] = a[3];
                const u32x4 q = *(const u32x4*)(idx + (size_t)(t0 + u) * 128 + 16 * g + 4 * j); id[u][4 * j] = (int)q[0]; id[u][4 * j + 1] = (int)q[1]; id[u][4 * j + 2] = (int)q[2]; id[u][4 * j + 3] = (int)q[3]; }
            u32x4 row[2][16];
#pragma unroll
            for (int u = 0; u < 2; ++u)
#pragma unroll
            for (int j = 0; j < 16; ++j) row[u][j] = *(const u32x4*)(U8 + (size_t)id[u][j] * D + co);
#pragma unroll
            for (int u = 0; u < 2; ++u) {
            float V[16];
#pragma unroll
            for (int j = 0; j < 16; ++j) { float acc = 0.f;
#pragma unroll
                for (int q = 0; q < 4; ++q) { const f32x2 lo = __builtin_amdgcn_cvt_pk_f32_fp8((int)row[u][j][q], false), hi = __builtin_amdgcn_cvt_pk_f32_fp8((int)row[u][j][q], true);
                    acc = fmaf(lo[0], x[u][4 * q], acc); acc = fmaf(lo[1], x[u][4 * q + 1], acc); acc = fmaf(hi[0], x[u][4 * q + 2], acc); acc = fmaf(hi[1], x[u][4 * q + 3], acc); }
                V[j] = acc; }
            float W[8], Y[4], Z[2];
            { const bool hiA = (lane & 4) != 0;
#pragma unroll
              for (int m = 0; m < 8; ++m) { const float send = hiA ? V[m] : V[8 + m], keep = hiA ? V[8 + m] : V[m]; W[m] = keep + DPP_F(send, 0x141); } }
            { const bool hiB = (lane & 2) != 0;
#pragma unroll
              for (int m = 0; m < 4; ++m) { const float send = hiB ? W[m] : W[4 + m], keep = hiB ? W[4 + m] : W[m]; Y[m] = keep + DPP_F(send, 0x1B); } }
            { const bool hiC = (lane & 1) != 0;
#pragma unroll
              for (int m = 0; m < 2; ++m) { const float send = hiC ? Y[m] : Y[2 + m], keep = hiC ? Y[2 + m] : Y[m]; Z[m] = keep + DPP_F(send, 0xB1); } }
            *(f32x2*)(hp + ((size_t)s * T + t0 + u) * 128 + 16 * g + 2 * c8) = (f32x2){Z[0], Z[1]};
            }
        }
    });
}
__device__ __forceinline__ void g2_coef(const Ctx& c) {
    const int* idx = (const int*)(c.ws + R2_IDX); float* gate = (float*)(c.ws + R2_GATE); const float* hp = (const float*)(c.ws + HP_OFF);
    const float* su = (const float*)(c.ws + R2_SU); const float* sv = (const float*)(c.ws + R2_SV);
    const int lane = c.lane;
    for (int t = c.gw; t < T; t += c.NGW) {
#pragma unroll
        for (int k = 0; k < 2; ++k) { const int p = lane + 64 * k; float h = 0.f;
#pragma unroll
            for (int s = 0; s < 8; ++s) h += hp[((size_t)s * T + t) * 128 + p];
            const int e = idx[(size_t)t * 128 + p]; const float gt = gate[(size_t)t * 128 + p];
            gate[(size_t)t * 128 + p] = gt * gelu_exact(h * su[e]) * sv[e]; }
    }
}
__device__ __forceinline__ void g3_vaxpy(const Ctx& c, int layer) {
    const unsigned char* V8 = c.ws + R2_VB; const int* idx = (const int*)(c.ws + R2_IDX); const float* coef = (const float*)(c.ws + R2_GATE);
    for_items(c, layer, 1, [&](int s, int blk) {
        int lane = c.lane; asm volatile("" : "+v"(lane));
        const int g = lane >> 3, c8 = lane & 7;
        const int co = 128 * s + 16 * c8;
#pragma unroll 1
        for (int i = 0; i < ITEM_TOK / NWAVES; i += 2) {
            const int t0 = blk * ITEM_TOK + c.wave * (ITEM_TOK / NWAVES) + i;
            float cf[2][16]; int id[2][16];
#pragma unroll
            for (int u = 0; u < 2; ++u)
#pragma unroll
            for (int j = 0; j < 4; ++j) { const f32x4 a = *(const f32x4*)(coef + (size_t)(t0 + u) * 128 + 16 * g + 4 * j); cf[u][4 * j] = a[0]; cf[u][4 * j + 1] = a[1]; cf[u][4 * j + 2] = a[2]; cf[u][4 * j + 3] = a[3];
                const u32x4 q = *(const u32x4*)(idx + (size_t)(t0 + u) * 128 + 16 * g + 4 * j); id[u][4 * j] = (int)q[0]; id[u][4 * j + 1] = (int)q[1]; id[u][4 * j + 2] = (int)q[2]; id[u][4 * j + 3] = (int)q[3]; }
            u32x4 row[2][16];
#pragma unroll
            for (int u = 0; u < 2; ++u)
#pragma unroll
            for (int j = 0; j < 16; ++j) row[u][j] = *(const u32x4*)(V8 + (size_t)id[u][j] * D + co);
#pragma unroll
            for (int u = 0; u < 2; ++u) {
            float A[16];
#pragma unroll
            for (int e = 0; e < 16; ++e) A[e] = 0.f;
#pragma unroll
            for (int j = 0; j < 16; ++j) { const float sc = cf[u][j];
#pragma unroll
                for (int q = 0; q < 4; ++q) { const f32x2 lo = __builtin_amdgcn_cvt_pk_f32_fp8((int)row[u][j][q], false), hi = __builtin_amdgcn_cvt_pk_f32_fp8((int)row[u][j][q], true);
                    A[4 * q] = fmaf(sc, lo[0], A[4 * q]); A[4 * q + 1] = fmaf(sc, lo[1], A[4 * q + 1]); A[4 * q + 2] = fmaf(sc, hi[0], A[4 * q + 2]); A[4 * q + 3] = fmaf(sc, hi[1], A[4 * q + 3]); } }
            float R[8], S2[4], Y[2];
#pragma unroll
            for (int m = 0; m < 8; ++m) { auto rr = __builtin_amdgcn_permlane32_swap(__float_as_uint(A[m]), __float_as_uint(A[8 + m]), false, false); R[m] = __uint_as_float(rr[0]) + __uint_as_float(rr[1]); }
#pragma unroll
            for (int m = 0; m < 4; ++m) { auto rr = __builtin_amdgcn_permlane16_swap(__float_as_uint(R[m]), __float_as_uint(R[4 + m]), false, false); S2[m] = __uint_as_float(rr[0]) + __uint_as_float(rr[1]); }
            { const bool hi8 = (lane & 8) != 0;
#pragma unroll
              for (int m = 0; m < 2; ++m) { const float send = hi8 ? S2[m] : S2[2 + m], keep = hi8 ? S2[2 + m] : S2[m]; Y[m] = keep + DPP_F(send, 0x128); } }
            float* yp = c.out + (size_t)(t0 + u) * D + co + 8 * ((lane >> 5) & 1) + 4 * ((lane >> 4) & 1) + 2 * ((lane >> 3) & 1);
            const f32x2 xo = *(const f32x2*)yp;
            *(f32x2*)yp = (f32x2){fmaf(DN_ALPHA, xo[0], Y[0]), fmaf(DN_ALPHA, xo[1], Y[1])};
            }
        }
    });
}
__device__ __forceinline__ void ln_pass(const Ctx& c, const float* g, const float* b) {
    bf16_t* xb = (bf16_t*)(c.ws + WS_XB); const int lane = c.lane;
    for (int t = c.gw; t < T; t += c.NGW) {
        float* xr = c.out + (size_t)t * D;
        f32x4 v[4]; float s = 0.f;
#pragma unroll
        for (int j = 0; j < 4; ++j) { v[j] = *(const f32x4*)(xr + 256 * j + 4 * lane); s += (v[j][0] + v[j][1]) + (v[j][2] + v[j][3]); }
        const float mean = wave_sum(s) * (1.0f / D); float s2 = 0.f;
#pragma unroll
        for (int j = 0; j < 4; ++j) { v[j] = v[j] - mean; s2 += (v[j][0] * v[j][0] + v[j][1] * v[j][1]) + (v[j][2] * v[j][2] + v[j][3] * v[j][3]); }
        const float rstd = 1.0f / sqrtf(wave_sum(s2) * (1.0f / D) + LN_EPS);
#pragma unroll
        for (int j = 0; j < 4; ++j) { const f32x4 gg = *(const f32x4*)(g + 256 * j + 4 * lane), bb = *(const f32x4*)(b + 256 * j + 4 * lane); const f32x4 o = v[j] * rstd * gg + bb;
            *(f32x4*)(xr + 256 * j + 4 * lane) = o; u32x2 w; w.x = cvt_pk_bf16(o[0], o[1]); w.y = cvt_pk_bf16(o[2], o[3]); *(u32x2*)(xb + (size_t)t * D + 256 * j + 4 * lane) = w; }
    }
}
#undef DPP_F
}
__global__ void __launch_bounds__(256) k_checksum(const unsigned* p, size_t nwords, unsigned long long* dst) {
    unsigned long long acc = 0;
    for (size_t i = (size_t)blockIdx.x * 256 + threadIdx.x; i < nwords; i += (size_t)gridDim.x * 256) acc += (unsigned long long)p[i] * (unsigned long long)(2 * i + 1);
    for (int o = 32; o >= 1; o >>= 1) acc += __shfl_xor(acc, o);
    if ((threadIdx.x & 63) == 0) atomicAdd(dst, acc);
}
__global__ void __launch_bounds__(256) k_zero_out(float* out, size_t n) { for (size_t i = (size_t)blockIdx.x * 256 + threadIdx.x; i < n; i += (size_t)gridDim.x * 256) out[i] = 0.f; }
__global__ void k_report(const unsigned long long* tab, int nent, float* out) {
    if (threadIdx.x == 0 && blockIdx.x == 0) { int first = -1; for (int i = 0; i < nent; ++i) if (tab[i] != tab[nent + i]) { first = i; break; }
        out[0] = first < 0 ? 99000.f : 1000.f * (float)(first / 4 + 1); out[1] = first < 0 ? 0.f : (float)(first % 4); }
}
struct Reg { size_t off; size_t bytes; int in_out; };
static int phase_regions(int p, Reg* r) {
    int n = 0;
    auto add = [&](size_t off, size_t mib) { r[n].off = off; r[n].bytes = mib * MiB; r[n].in_out = 0; ++n; };
    auto addout = [&]() { r[n].off = 0; r[n].bytes = (size_t)T * D * 4; r[n].in_out = 1; ++n; };
    if (p == 0) { add(WS_W, 61); add(WS_R2, 160); addout(); return n; }
    int q = p - 1;
    for (int layer = 0; layer < NL; ++layer) {
        const int nm = (layer & 1) ? 5 : 7;
        if (q < nm) {
            if ((layer & 1) == 0) { switch (q) { case 0: add(B_A32, 240); break; case 1: add(R2_UB, 34); add(R2_PB, 40); add(B_CQN, 100); add(B_KROPE, 10); break; case 2: add(B_Q, 240); break; case 3: add(B_KV, 320); break;
                case 4: add(B_Q, 240); break; case 5: add(B_O, 160); break; case 6: add(B_H32_MLA, 320); break; } }
            else { switch (q) { case 0: add(B_PLANE, 800); break; case 1: add(R2_UB, 34); add(R2_PB, 40); break; case 2: add(B_PLANE + 160 * MiB, 320); break; case 3: add(B_PLANE, 160); break; case 4: add(B_H32_HGRN, 320); break; } }
            return n;
        }
        q -= nm;
        if (q < 6) { switch (q) { case 0: addout(); add(WS_XB, 160); break; case 1: add(B_PQ, 320); break; case 2: add(R2_IDX, 80); break; case 3: addout(); add(WS_XB, 160); break; case 4: add(B_PP, 160); break; case 5: addout(); add(WS_R2, 160); break; }
            return n; }
        q -= 6;
    }
    return n;
}
constexpr int N_PHASES = 1 + 2 * (6 + 8) + 2 * (5 + 8);

#ifndef PROBE_DUP
#define PROBE_DUP 0
#endif
#define PROBE_REP(bit, ...) if constexpr ((PROBE_DUP & (bit)) != 0) { __VA_ARGS__ }
template <class E> struct RepOk { static constexpr bool v = true; };
template <> struct RepOk<pg8::EpiPle> { static constexpr bool v = false; };
#define GEMM_REP_OK(EPI) RepOk<pg8::EPI>::v
#define GEMM_PHASE(EPI, Aptr, Bptr, NN, KK, ...) { pg8::Gemm g{(const bf16_t*)(Aptr), (const bf16_t*)(Bptr), T, (NN), (KK)}; pg8::StaticOrder S; S.init(T, (NN), c.G, c.bid); \
        pg8::EPI E{__VA_ARGS__}; pg8::gemm_phase<pg8::EPI, pg8::StaticOrder>(c.lds, g, S, E, c.tid); if (GEMM_REP_OK(EPI)) { PROBE_REP(8, __syncthreads(); pg8::gemm_phase<pg8::EPI, pg8::StaticOrder>(c.lds, g, S, E, c.tid);) } }

__global__ void __launch_bounds__(NTHR, 2) fwd_kernel(Args args) {
    extern __shared__ __attribute__((aligned(16))) unsigned char lds_raw[];
    volatile LAS unsigned* misc = (volatile LAS unsigned*)((LAS unsigned char*)lds_raw + LDS_MISC_OFF);
    if (threadIdx.x < 64) misc[threadIdx.x] = 0u;
    __syncthreads();
    const int wave_s = __builtin_amdgcn_readfirstlane((int)threadIdx.x >> 6);
    const int lo = args.ph_lo, hi = args.ph_hi;
    XcdBarrier bar; bar.bar = (unsigned*)(args.ws + WS_CTL); bar.x = 0; bar.st = nullptr;
    if (hi - lo > 1) bar = xcd_barrier_post((unsigned*)(args.ws + WS_CTL), misc + 8);
    int ph = 0;
#define PH_BEGIN if (ph >= lo && ph < hi) { const Ctx c = mk_ctx(lds_raw, wave_s); unsigned char* const ws = c.ws; (void)ws;
#define PH_END   if (ph + 1 < hi) xcd_barrier(bar); } ++ph;

    PH_BEGIN p0_prologue(c); PH_END

    for (int layer = 0; layer < NL; ++layer) {
        const int j = layer >> 1;
        if ((layer & 1) == 0) {
            PH_BEGIN GEMM_PHASE(EpiF32, ws + WS_R2, (const bf16_t*)(ws + W_WA) + (size_t)j * 768 * 1024, 768, 1024, (float*)(ws + B_A32), 768) PH_END
            PH_BEGIN l0_convert(c, layer); mla_e1(c, j); PH_END
            PH_BEGIN GEMM_PHASE(EpiBf16P, ws + B_CQN, (const bf16_t*)(ws + W_WUQ) + (size_t)j * 1536 * 384, 1536, 384, (bf16_t*)(ws + B_Q), 1536) PH_END
            PH_BEGIN GEMM_PHASE(EpiBf16P, ws + B_CKVN, (const bf16_t*)(ws + W_WUKV) + (size_t)j * 2048 * 256, 2048, 256, (bf16_t*)(ws + B_KV), 2048) PH_END
            PH_BEGIN mla_attention(c); PROBE_REP(1, mla_attention(c);) PH_END
            PH_BEGIN GEMM_PHASE(EpiBf16P, ws + B_O, (const bf16_t*)(ws + W_WO) + (size_t)j * 1024 * 1024, 1024, 1024, (bf16_t*)(ws + B_H32_MLA), 1024) PH_END
        } else {
            PH_BEGIN GEMM_PHASE(EpiHgrn, ws + WS_R2, (const bf16_t*)(ws + W_HIN) + (size_t)j * 5120 * 1024, 5120, 1024, (bf16_t*)(ws + B_PLANE), (size_t)T * 1024, (const float*)(ws + WS_MISC) + (size_t)j * 2048) PH_END
            PH_BEGIN l0_convert(c, layer); scan::hgrn_prep(c); PH_END
            PH_BEGIN scan::hgrn_scan(c, false); PH_END
            PH_BEGIN hgrn_post(c, j); PH_END
            PH_BEGIN GEMM_PHASE(EpiBf16P, ws + B_PLANE, (const bf16_t*)(ws + W_HO) + (size_t)j * 1024 * 1024, 1024, 1024, (bf16_t*)(ws + B_H32_HGRN), 1024) PH_END
        }
        PH_BEGIN ln_residual(c, (const bf16_t*)(ws + ((layer & 1) ? B_H32_HGRN : B_H32_MLA)), c.in(18) + layer * D, c.in(19) + layer * D, layer == 0); PH_END
        PH_BEGIN GEMM_PHASE(EpiBf16P, ws + WS_XB, (const bf16_t*)(ws + W_PQ) + (size_t)layer * 2048 * 1024, 2048, 1024, (bf16_t*)(ws + B_PQ), 2048) PH_END
        PH_BEGIN peer::route(c, layer); PROBE_REP(2, peer::route(c, layer);) PH_END
        PH_BEGIN peer::g1_udot(c, layer); PH_END
        PH_BEGIN peer::g2_coef(c); PH_END
        PH_BEGIN peer::g3_vaxpy(c, layer); PH_END
        PH_BEGIN GEMM_PHASE(EpiBf16P, ws + R2_PB, (const bf16_t*)(ws + W_PP) + (size_t)layer * 1024 * 256, 1024, 256, (bf16_t*)(ws + B_PP), 1024) peer::ln_pass(c, c.in(20) + layer * D, c.in(21) + layer * D); PH_END
        PH_BEGIN GEMM_PHASE(EpiPle, ws + WS_XB, (const bf16_t*)(ws + W_GW) + (size_t)layer * 1024 * 1024, 1024, 1024, c.out, (const bf16_t*)(ws + B_PP), c.in(23) + layer * D, (bf16_t*)(ws + WS_R2)) PH_END
    }
#undef PH_BEGIN
#undef PH_END
}

extern "C" void kernel_launch(void* const* d_in, const int* in_sizes, int n_in, void* d_out, int out_size, void* d_ws, size_t ws_size, hipStream_t stream) {
    static int grid = 0;
    if (grid == 0) {
        if (n_in != 25 || out_size != T * D || ws_size < WS_END) { fprintf(stderr, "kernel_launch: unexpected shapes: n_in %d out %d ws %zu (need %zu)\n", n_in, out_size, ws_size, (size_t)WS_END); grid = -1; return; }
        int dev = 0, cus = 0, per_cu = 0;
        if (hipGetDevice(&dev) != hipSuccess || hipDeviceGetAttribute(&cus, hipDeviceAttributeMultiprocessorCount, dev) != hipSuccess) { grid = -1; return; }
        if (hipFuncSetAttribute((const void*)fwd_kernel, hipFuncAttributeMaxDynamicSharedMemorySize, LDS_BYTES) != hipSuccess) { fprintf(stderr, "kernel_launch: hipFuncSetAttribute failed\n"); grid = -1; return; }
        if (hipOccupancyMaxActiveBlocksPerMultiprocessor(&per_cu, (const void*)fwd_kernel, NTHR, LDS_BYTES) != hipSuccess || per_cu < 1) { fprintf(stderr, "kernel_launch: occupancy query says %d\n", per_cu); }
        (void)hipGetLastError();
        grid = cus;
    }
    if (grid < 0) return;
    (void)hipMemsetAsync((char*)d_ws + WS_CTL, 0, CTL_ZERO_BYTES, stream);
    Args a{};
    for (int i = 0; i < 25; ++i) a.in[i] = (const float*)d_in[i];
    a.out = (float*)d_out; a.ws = (unsigned char*)d_ws;
#if defined(MK_DEBUG_DET)
    unsigned long long* tab = (unsigned long long*)((char*)d_ws + WS_CTL + 32 * 1024);
    for (int pass = 0; pass < 2; ++pass)
        for (int p = 0; p < N_PHASES; ++p) { a.ph_lo = p; a.ph_hi = p + 1; hipLaunchKernelGGL(fwd_kernel, dim3(grid), dim3(NTHR), LDS_BYTES, stream, a);
            Reg r[4]; const int nr = phase_regions(p, r);
            for (int i = 0; i < nr; ++i) hipLaunchKernelGGL(k_checksum, dim3(2048), dim3(256), 0, stream, (const unsigned*)(r[i].in_out ? (char*)d_out : (char*)d_ws + r[i].off), r[i].bytes / 4, tab + (size_t)pass * N_PHASES * 4 + p * 4 + i); }
    hipLaunchKernelGGL(k_zero_out, dim3(2048), dim3(256), 0, stream, (float*)d_out, (size_t)T * D);
    hipLaunchKernelGGL(k_report, dim3(1), dim3(64), 0, stream, tab, N_PHASES * 4, (float*)d_out);
#elif MK_ONE_LAUNCH
    a.ph_lo = 0; a.ph_hi = N_PHASES;
    hipLaunchKernelGGL(fwd_kernel, dim3(grid), dim3(NTHR), LDS_BYTES, stream, a);
#else
    for (int p = 0; p < N_PHASES; ++p) { a.ph_lo = p; a.ph_hi = p + 1; hipLaunchKernelGGL(fwd_kernel, dim3(grid), dim3(NTHR), LDS_BYTES, stream, a); }
#endif
}
```

```cpp
#include <hip/hip_runtime.h>
#include <cstdio>
#include <cstdint>

#ifndef MK_ONE_LAUNCH
#define MK_ONE_LAUNCH 1
#endif

#define GAS __attribute__((address_space(1)))
#define LAS __attribute__((address_space(3)))
typedef unsigned short bf16_t;
typedef short bf16x8 __attribute__((ext_vector_type(8)));
typedef short s16x4 __attribute__((ext_vector_type(4)));
typedef float f32x4 __attribute__((ext_vector_type(4)));
typedef float f32x2 __attribute__((ext_vector_type(2)));
typedef float f32x16 __attribute__((ext_vector_type(16)));
typedef unsigned u32x4 __attribute__((ext_vector_type(4)));
typedef unsigned u32x2 __attribute__((ext_vector_type(2)));

constexpr int D = 1024, TP = 16384, TS = 65536, T = TP + TS, SP = 8192, SS = 2048;
constexpr int NL = 4;
constexpr int NWAVES = 8, NTHR = 512;
constexpr float DN_ALPHA = 1.681792830507429f;
constexpr float LN_EPS = 1e-5f, RMS_EPS = 1e-6f;
constexpr float MLA_SCALE = 0.07216878364870323f;
constexpr int NEXP = 16384;

constexpr size_t MiB = 1u << 20;
constexpr size_t WS_CTL = 0, CTL_ZERO_BYTES = 64 * 1024;
constexpr size_t WS_ROPE = 1 * MiB;
constexpr size_t WS_MISC = 3 * MiB;
constexpr size_t WS_W = 4 * MiB;
constexpr size_t W_WA = WS_W;
constexpr size_t W_WUQ = W_WA + 2 * (size_t)768 * 1024 * 2;
constexpr size_t W_WUKV = W_WUQ + 2 * (size_t)1536 * 384 * 2;
constexpr size_t W_WO = W_WUKV + 2 * (size_t)2048 * 256 * 2;
constexpr size_t W_HIN = W_WO + 2 * (size_t)1024 * 1024 * 2;
constexpr size_t W_HO = W_HIN + 2 * (size_t)5120 * 1024 * 2;
constexpr size_t W_PQ = W_HO + 2 * (size_t)1024 * 1024 * 2;
constexpr size_t W_GW = W_PQ + 4 * (size_t)2048 * 1024 * 2;
constexpr size_t W_PP = W_GW + 4 * (size_t)1024 * 1024 * 2;
constexpr size_t W_KEYS = W_PP + 4 * (size_t)1024 * 256 * 2;
constexpr size_t W_END = W_KEYS + 4 * (size_t)2 * 128 * 128 * 2;
static_assert(W_END <= 68 * MiB, "weights region");
constexpr size_t WS_R2 = 68 * MiB;
constexpr size_t R2_UB = WS_R2, R2_VB = WS_R2 + 16 * MiB, R2_SU = WS_R2 + 32 * MiB, R2_SV = WS_R2 + 33 * MiB, R2_IDX = WS_R2 + 64 * MiB, R2_GATE = WS_R2 + 104 * MiB, R2_PB = WS_R2 + 144 * MiB;
constexpr size_t WS_XB = 252 * MiB;
constexpr size_t WS_BIG = 412 * MiB;
constexpr size_t WS_END = WS_BIG + 800 * MiB;
constexpr size_t B_Q = WS_BIG, B_KV = WS_BIG + 240 * MiB, B_O = WS_BIG + 560 * MiB, B_KROPE = WS_BIG + 720 * MiB;
constexpr size_t B_A32 = WS_BIG + 240 * MiB, B_CQN = WS_BIG + 560 * MiB, B_CKVN = WS_BIG + 620 * MiB, B_H32_MLA = WS_BIG;
constexpr size_t B_PLANE = WS_BIG, PLANE_BYTES = 160 * MiB, B_H32_HGRN = WS_BIG + 160 * MiB;
constexpr size_t B_PQ = WS_BIG, B_PP = WS_BIG + 320 * MiB;

constexpr int LDS_BYTES = 160 * 1024;
constexpr int LDS_MISC_OFF = LDS_BYTES - 256;

typedef __bf16 bf16x2_n __attribute__((ext_vector_type(2)));
__device__ __forceinline__ unsigned cvt_pk_bf16(float lo, float hi) { const f32x2 v = {lo, hi}; const bf16x2_n b = __builtin_convertvector(v, bf16x2_n); return __builtin_bit_cast(unsigned, b); }
__device__ __forceinline__ bf16_t f2bf(float f) { return (bf16_t)(cvt_pk_bf16(f, 0.f) & 0xffffu); }
__device__ __forceinline__ float bf2f(bf16_t b) { return __uint_as_float(((unsigned)b) << 16); }
__device__ __forceinline__ float bflo(unsigned w) { return __uint_as_float(w << 16); }
__device__ __forceinline__ float bfhi(unsigned w) { return __uint_as_float(w & 0xffff0000u); }
#define DPPF(v, ctrl) __int_as_float(__builtin_amdgcn_update_dpp(0, __float_as_int(v), (ctrl), 0xf, 0xf, true))
__device__ __forceinline__ float row16_sum(float v) { v += DPPF(v, 0xB1); v += DPPF(v, 0x4E); v += DPPF(v, 0x141); v += DPPF(v, 0x140); return v; }
__device__ __forceinline__ float wave_sum(float v) { v = row16_sum(v);
    { auto r = __builtin_amdgcn_permlane16_swap(__float_as_uint(v), __float_as_uint(v), false, false); v = __uint_as_float(r[0]) + __uint_as_float(r[1]); }
    { auto r = __builtin_amdgcn_permlane32_swap(__float_as_uint(v), __float_as_uint(v), false, false); v = __uint_as_float(r[0]) + __uint_as_float(r[1]); }
    return v; }
__device__ __forceinline__ float wave_max(float v) { v = fmaxf(v, DPPF(v, 0xB1)); v = fmaxf(v, DPPF(v, 0x4E)); v = fmaxf(v, DPPF(v, 0x141)); v = fmaxf(v, DPPF(v, 0x140));
    { auto r = __builtin_amdgcn_permlane16_swap(__float_as_uint(v), __float_as_uint(v), false, false); v = fmaxf(__uint_as_float(r[0]), __uint_as_float(r[1])); }
    { auto r = __builtin_amdgcn_permlane32_swap(__float_as_uint(v), __float_as_uint(v), false, false); v = fmaxf(__uint_as_float(r[0]), __uint_as_float(r[1])); }
    return v; }
__device__ __forceinline__ float fast_exp(float x) { return __builtin_amdgcn_exp2f(x * 1.4426950408889634f); }
__device__ __forceinline__ float fast_log(float x) { return __builtin_amdgcn_logf(x) * 0.6931471805599453f; }
__device__ __forceinline__ float fast_rcp(float x) { return __builtin_amdgcn_rcpf(x); }
__device__ __forceinline__ float sigmoidf_(float x) { return fast_rcp(1.0f + fast_exp(-x)); }
__device__ __forceinline__ float siluf_(float x) { return x * sigmoidf_(x); }
#define LDS_WAIT() asm volatile("s_waitcnt lgkmcnt(0)" ::: "memory")
#define VM_WAIT() asm volatile("s_waitcnt vmcnt(0)" ::: "memory")
__device__ __forceinline__ int opaque_lane() { int l; asm volatile("v_mbcnt_lo_u32_b32 %0, -1, 0\n\tv_mbcnt_hi_u32_b32 %0, -1, %0" : "=v"(l)); return l; }
__device__ __forceinline__ int opaque_tid(int wave_s) { asm volatile("" : "+s"(wave_s)); return (wave_s << 6) + opaque_lane(); }
__device__ __forceinline__ int opaque_bid() { int b = (int)blockIdx.x; asm volatile("" : "+s"(b)); return b; }
struct Args { const float* in[25]; float* out; unsigned char* ws; int ph_lo, ph_hi; };
#define XB_TMO      128
#define XB_XCNT(j)  (256  + 64 * (j))
#define XB_XSUB(j)  (1280 + 64 * (j))
#define XB_XGEN(j)  (2304 + 64 * (j))
#define XB_TOP      3328
#define XB_TOPGEN   3392
#define XCD_BAR_WORDS 3456
#define XB_SPIN_CAP (1u << 23)

__device__ __forceinline__ unsigned xb_ld(unsigned* p)              { return __hip_atomic_load(p, __ATOMIC_RELAXED, __HIP_MEMORY_SCOPE_AGENT); }
__device__ __forceinline__ unsigned xb_add(unsigned* p, unsigned v) { return __hip_atomic_fetch_add(p, v, __ATOMIC_RELAXED, __HIP_MEMORY_SCOPE_AGENT); }
__device__ __forceinline__ unsigned xb_xcc_id() { return (unsigned)__builtin_amdgcn_s_getreg((3 << 11) | 20) & 0xFu; }
#define XB_SPIN(cond, bar) do { unsigned _sp = 0; while (cond) { __builtin_amdgcn_s_sleep(1); \
    if ((++_sp & 255u) == 0u) { if (xb_ld(&(bar)[XB_TMO])) break; if (_sp > XB_SPIN_CAP) { atomicAdd(&(bar)[XB_TMO], 1u); break; } } } } while (0)

struct XcdBarrier {
    unsigned* bar; unsigned x;
    volatile LAS unsigned* st;
};

__device__ __forceinline__ XcdBarrier xcd_barrier_post(unsigned* bar, volatile LAS unsigned* st) {
    XcdBarrier b; b.bar = bar; b.x = xb_xcc_id(); b.st = st;
    if (threadIdx.x == 0) (void)xb_add(&bar[XB_XCNT(b.x)], 1u);
    return b;
}
__device__ __forceinline__ void xcd_barrier_complete(unsigned* bar, unsigned x, unsigned& nloc, unsigned& nx) {
    const unsigned G = gridDim.x * gridDim.y * gridDim.z;
    unsigned sum, cnt, mine, sp = 0u;
    for (;;) {
        sum = 0u; cnt = 0u; mine = 0u;
#pragma unroll
        for (unsigned j = 0; j < 16; ++j) { const unsigned c = xb_ld(&bar[XB_XCNT(j)]); sum += c; cnt += (c > 0u) ? 1u : 0u; mine = (j == x) ? c : mine; }
        if (sum == G) break;
        __builtin_amdgcn_s_sleep(1);
        if ((++sp & 255u) == 0u) { if (xb_ld(&bar[XB_TMO])) break; if (sp > XB_SPIN_CAP) { atomicAdd(&bar[XB_TMO], 1u); break; } }
    }
    nloc = mine > 0u ? mine : 1u; nx = cnt > 0u ? cnt : 1u;
}

__device__ __forceinline__ void xcd_barrier(const XcdBarrier& b) {
    asm volatile("s_waitcnt vmcnt(0)" ::: "memory");
    __syncthreads();
    if (threadIdx.x == 0) {
        unsigned* bar = b.bar;
        __builtin_amdgcn_s_waitcnt(0);
        unsigned nloc = b.st[0], nx = b.st[1];
        if (nloc == 0u) { xcd_barrier_complete(bar, b.x, nloc, nx); b.st[0] = nloc; b.st[1] = nx; }
        const unsigned old = xb_add(&bar[XB_XSUB(b.x)], 1u);
        const unsigned gen = old / nloc;
        if (old + 1u == (gen + 1u) * nloc) {
            __builtin_amdgcn_fence(__ATOMIC_RELEASE, "agent");
            asm volatile("s_waitcnt vmcnt(0)" ::: "memory");
            const unsigned og = xb_add(&bar[XB_TOP], 1u);
            const unsigned tg = og / nx;
            if (og + 1u == (tg + 1u) * nx) xb_add(&bar[XB_TOPGEN], 1u);
            else XB_SPIN(xb_ld(&bar[XB_TOPGEN]) == tg, bar);
            __builtin_amdgcn_fence(__ATOMIC_ACQUIRE, "agent");
            xb_add(&bar[XB_XGEN(b.x)], 1u);
            asm volatile("s_waitcnt vmcnt(0)" ::: "memory");
        } else {
            XB_SPIN(xb_ld(&bar[XB_XGEN(b.x)]) == gen, bar);
            __builtin_amdgcn_fence(__ATOMIC_ACQUIRE, "agent");
            asm volatile("s_waitcnt vmcnt(0)" ::: "memory");
        }
    }
    __syncthreads();
}
namespace pg8 {
#define PG8_LAS __attribute__((address_space(3)))
constexpr int BM = 256, BK = 64, HALF = 128, HTB = HALF * BK * 2  , STAGE_BYTES = 8 * HTB, NXCD = 8, WGM = 8;

__host__ __device__ __forceinline__ int lds_byte(int r, int c) { const int st = (r >> 4) * 2 + (c >> 5), rr = r & 15, cc = c & 31, ob = rr * 64 + cc * 2; return st * 1024 + (ob ^ (((ob >> 9) & 1) << 5)); }
__host__ __device__ __forceinline__ void stage_rc(int b, int& R, int& C) { const int st = b / 1024, sb = b % 1024, swz = sb ^ (((sb >> 9) & 1) << 5); R = (st >> 1) * 16 + swz / 64; C = (st & 1) * 32 + (swz % 64) / 2; }
__host__ __device__ __forceinline__ int perm32(int rho) { const int n = rho >> 4, i = rho & 15; return 8 * (i >> 2) + 4 * n + (i & 3); }

struct Unit { int pm, pn; };
struct Gemm { const bf16_t* A; const bf16_t* Bt; int M, N, K; };

struct StaticOrder {
    int nM, nN, nwg, G, c;
    __host__ __device__ void init(int M, int N, int G_, int c_) { nM = M / BM; nN = N / BM; nwg = nM * nN; G = G_; c = c_; }
    __host__ __device__ bool next(int i, Unit& u) const {
        const long L = (long)i * G + c; if (L >= nwg) return false;
        int wgid = (int)L; { const int q = nwg / NXCD, r = nwg % NXCD, xcd = wgid % NXCD, off = wgid / NXCD; wgid = (xcd < r ? xcd * (q + 1) : r * (q + 1) + (xcd - r) * q) + off; }
        const int nig = WGM * nN, gid = wgid / nig, fm = gid * WGM, gsz = (nM - fm) < WGM ? (nM - fm) : WGM;
        u.pm = fm + ((wgid % nig) % gsz); u.pn = (wgid % nig) / gsz; return true;
    }
    __device__ __forceinline__ void a_ready(const Unit&) const {}
    __device__ __forceinline__ void done(const Unit&) const {}
};
template <class Epi, class Sched>
__device__ __forceinline__ void gemm_phase(PG8_LAS unsigned char* lds, const Gemm g, const Sched& S, const Epi& E, const int tid) {
    const int wid = __builtin_amdgcn_readfirstlane(tid >> 6), lane = tid & 63, wr = wid >> 2, wc = wid & 3, fr = lane & 15, fq = lane >> 4;
    const int K = g.K, nt = K / BK;
    unsigned voffA[2], voffB[2];
#pragma unroll
    for (int i = 0; i < 2; ++i) { int R, C; stage_rc(tid * 16 + i * 8192, R, C); const int Rb = Epi::PERM ? ((R & ~31) + perm32(R & 31)) : R;
        voffA[i] = (unsigned)(R * K + C) * 2u; voffB[i] = (unsigned)(Rb * K + C) * 2u; }
    const size_t kstep = (size_t)(BK * 2);
    const size_t hstep = (size_t)HALF * K * 2;
    const size_t tstep = 2 * hstep;
    const unsigned ldsw = (unsigned)wid * 1024u;
    const int aoff = lds_byte(wr * 64 + fr, fq * 8), boff = lds_byte(wc * 32 + fr, fq * 8);
#define PG8_SA(b, h) (((b) * 2 + (h)) * HTB)
#define PG8_SB(b, h) ((4 + (b) * 2 + (h)) * HTB)
#define PG8_STAGE(bufoff, gbase, voff) do { _Pragma("unroll") for (int _i = 0; _i < 2; ++_i) \
        __builtin_amdgcn_global_load_lds((const unsigned*)((const char*)(gbase) + (voff)[_i]), (PG8_LAS unsigned*)(lds + (bufoff) + ldsw + _i * 8192), 16, 0, 0); } while (0)
#define PG8_LDA(dst, b, h) do { _Pragma("unroll") for (int m = 0; m < 4; ++m) _Pragma("unroll") for (int k = 0; k < 2; ++k) dst[m][k] = *(const PG8_LAS bf16x8*)(lds + PG8_SA(b, h) + aoff + m * 2048 + k * 1024); } while (0)
#define PG8_LDB(dst, b, h) do { _Pragma("unroll") for (int n = 0; n < 2; ++n) _Pragma("unroll") for (int k = 0; k < 2; ++k) dst[n][k] = *(const PG8_LAS bf16x8*)(lds + PG8_SB(b, h) + boff + n * 2048 + k * 1024); } while (0)
#define PG8_MMA(ai, bj, At, Bt) do { __builtin_amdgcn_s_setprio(1); _Pragma("unroll") for (int m = 0; m < 4; ++m) _Pragma("unroll") for (int n = 0; n < 2; ++n) _Pragma("unroll") for (int k = 0; k < 2; ++k) \
        acc[ai][bj][m][n] = __builtin_amdgcn_mfma_f32_16x16x32_bf16(Bt[n][k], At[m][k], acc[ai][bj][m][n], 0, 0, 0); __builtin_amdgcn_s_setprio(0); } while (0)
#define PG8_WAIT_V(n) asm volatile("s_waitcnt vmcnt(" #n ")" ::: "memory")
#define PG8_WAIT_L(n) asm volatile("s_waitcnt lgkmcnt(" #n ")" ::: "memory")
#define PG8_BAR __builtin_amdgcn_s_barrier()
#define PG8_SCHED __builtin_amdgcn_sched_barrier(0)
    Unit cur, nxt; int ui = 0;
    if (!S.next(0, cur)) return;
    f32x4 acc[2][2][4][2];
#pragma unroll
    for (int a = 0; a < 2; ++a)
#pragma unroll
        for (int b = 0; b < 2; ++b)
#pragma unroll
            for (int m = 0; m < 4; ++m)
#pragma unroll
                for (int n = 0; n < 2; ++n) acc[a][b][m][n] = (f32x4){0.f, 0.f, 0.f, 0.f};
    bf16x8 At[4][2], B0[2][2], B1[2][2];
    const char* cA = (const char*)g.A + (size_t)cur.pm * tstep; const char* cB = (const char*)g.Bt + (size_t)cur.pn * tstep;
    S.a_ready(cur);
    PG8_STAGE(PG8_SB(0, 0), cB, voffB); PG8_STAGE(PG8_SA(0, 0), cA, voffA); PG8_STAGE(PG8_SB(0, 1), cB + hstep, voffB); PG8_STAGE(PG8_SA(0, 1), cA + hstep, voffA);
    if (wr == 1) PG8_BAR;
    PG8_WAIT_V(4); PG8_BAR;
    PG8_STAGE(PG8_SB(1, 0), cB + kstep, voffB); PG8_STAGE(PG8_SA(1, 0), cA + kstep, voffA); PG8_STAGE(PG8_SB(1, 1), cB + hstep + kstep, voffB);
    PG8_WAIT_V(6); PG8_BAR;
    for (;;) {
        const bool has_next = S.next(ui + 1, nxt);
        const char* nA = has_next ? (const char*)g.A + (size_t)nxt.pm * tstep : cA; const char* nB = has_next ? (const char*)g.Bt + (size_t)nxt.pn * tstep : cB;
        for (int t = 0; t < nt; t += 2) {
            const bool last = (t == nt - 2);
            const char* a1 = cA + (size_t)(t + 1) * kstep;
            const char* a2 = last ? nA : cA + (size_t)(t + 2) * kstep; const char* b2 = last ? nB : cB + (size_t)(t + 2) * kstep;
            const char* a3 = a2 + kstep; const char* b3 = b2 + kstep;
            if (last && has_next) S.a_ready(nxt);
            PG8_LDB(B0, 0, 0); PG8_SCHED; PG8_LDA(At, 0, 0); PG8_STAGE(PG8_SA(1, 1), a1 + hstep, voffA);
            PG8_WAIT_L(8); PG8_BAR; PG8_WAIT_L(0); PG8_MMA(0, 0, At, B0); PG8_BAR; PG8_SCHED;
            PG8_LDB(B1, 0, 1); PG8_STAGE(PG8_SB(0, 0), b2, voffB);
            PG8_BAR; PG8_WAIT_L(0); PG8_MMA(0, 1, At, B1); PG8_BAR;
            PG8_LDA(At, 0, 1); PG8_STAGE(PG8_SA(0, 0), a2, voffA);
            PG8_BAR; PG8_WAIT_L(0); PG8_MMA(1, 0, At, B0); PG8_BAR; PG8_SCHED;
            PG8_STAGE(PG8_SB(0, 1), b2 + hstep, voffB);
            PG8_WAIT_V(6); PG8_BAR; PG8_MMA(1, 1, At, B1); PG8_BAR;
            PG8_LDB(B0, 1, 0); PG8_SCHED; PG8_LDA(At, 1, 0); PG8_STAGE(PG8_SA(0, 1), a2 + hstep, voffA);
            PG8_WAIT_L(8); PG8_BAR; PG8_WAIT_L(0); PG8_MMA(0, 0, At, B0); PG8_BAR; PG8_SCHED;
            PG8_LDB(B1, 1, 1); PG8_STAGE(PG8_SB(1, 0), b3, voffB);
            PG8_BAR; PG8_WAIT_L(0); PG8_MMA(0, 1, At, B1); PG8_BAR;
            PG8_LDA(At, 1, 1); PG8_STAGE(PG8_SA(1, 0), a3, voffA);
            PG8_BAR; PG8_WAIT_L(0); PG8_MMA(1, 0, At, B0); PG8_BAR; PG8_SCHED;
            PG8_STAGE(PG8_SB(1, 1), b3 + hstep, voffB);
            PG8_WAIT_V(6); PG8_BAR; PG8_MMA(1, 1, At, B1); PG8_BAR;
        }
        E(acc, cur, wr, wc, fr, fq); S.done(cur);
        if (!has_next) break;
#pragma unroll
        for (int a = 0; a < 2; ++a)
#pragma unroll
            for (int b = 0; b < 2; ++b)
#pragma unroll
                for (int m = 0; m < 4; ++m)
#pragma unroll
                    for (int n = 0; n < 2; ++n) acc[a][b][m][n] = (f32x4){0.f, 0.f, 0.f, 0.f};
        cur = nxt; cA = nA; cB = nB; ++ui;
    }
    PG8_WAIT_V(0);
    if (wr == 0) PG8_BAR;
    PG8_BAR;
#undef PG8_SA
#undef PG8_SB
#undef PG8_STAGE
#undef PG8_LDA
#undef PG8_LDB
#undef PG8_MMA
#undef PG8_WAIT_V
#undef PG8_WAIT_L
#undef PG8_BAR
#undef PG8_SCHED
}
struct EpiF32 {
    static constexpr bool PERM = false;
    float* C; int ldc;
    __device__ __forceinline__ void operator()(const f32x4 (&acc)[2][2][4][2], const Unit& u, int wr, int wc, int fr, int fq) const {
        const int row0 = u.pm * BM + wr * 64 + fr, col0 = u.pn * BM + wc * 32 + 4 * fq;
#pragma unroll
        for (int ai = 0; ai < 2; ++ai)
#pragma unroll
            for (int m = 0; m < 4; ++m) { float* rowp = C + (size_t)(row0 + ai * HALF + m * 16) * ldc + col0;
#pragma unroll
                for (int bj = 0; bj < 2; ++bj)
#pragma unroll
                    for (int n = 0; n < 2; ++n) *(f32x4*)(rowp + bj * HALF + n * 16) = acc[ai][bj][m][n]; }
    }
};
struct EpiBf16P {
    static constexpr bool PERM = true;
    bf16_t* O; int ldc;
    __device__ __forceinline__ void operator()(const f32x4 (&acc)[2][2][4][2], const Unit& u, int wr, int wc, int fr, int fq) const {
        const int row0 = u.pm * BM + wr * 64 + fr, col0 = u.pn * BM + wc * 32 + 8 * fq;
#pragma unroll
        for (int ai = 0; ai < 2; ++ai)
#pragma unroll
            for (int m = 0; m < 4; ++m) { bf16_t* rowp = O + (size_t)(row0 + ai * HALF + m * 16) * ldc + col0;
#pragma unroll
                for (int bj = 0; bj < 2; ++bj) { const f32x4 v0 = acc[ai][bj][m][0], v1 = acc[ai][bj][m][1];
                    u32x4 w; w.x = cvt_pk_bf16(v0[0], v0[1]); w.y = cvt_pk_bf16(v0[2], v0[3]); w.z = cvt_pk_bf16(v1[0], v1[1]); w.w = cvt_pk_bf16(v1[2], v1[3]);
                    *(u32x4*)(rowp + bj * HALF) = w; } }
    }
};
struct EpiHgrn {
    static constexpr bool PERM = true;
    bf16_t* planes; size_t plane_elems; const float* lb;
    __device__ __forceinline__ void operator()(const f32x4 (&acc)[2][2][4][2], const Unit& u, int wr, int wc, int fr, int fq) const {
        const int plane = u.pn >> 2;
        const int row0 = u.pm * BM + wr * 64 + fr, col0 = (u.pn & 3) * BM + wc * 32 + 8 * fq;
        bf16_t* base = planes + (size_t)plane * plane_elems;
        float lbv[2][8];
        if (plane == 1 || plane == 2) {
#pragma unroll
            for (int bj = 0; bj < 2; ++bj)
#pragma unroll
                for (int e = 0; e < 8; ++e) lbv[bj][e] = lb[(plane - 1) * 1024 + col0 + bj * HALF + e];
        } else {
#pragma unroll
            for (int bj = 0; bj < 2; ++bj)
#pragma unroll
                for (int e = 0; e < 8; ++e) lbv[bj][e] = 0.f;
        }
#pragma unroll
        for (int ai = 0; ai < 2; ++ai)
#pragma unroll
            for (int m = 0; m < 4; ++m) { bf16_t* rowp = base + (size_t)(row0 + ai * HALF + m * 16) * 1024 + col0;
#pragma unroll
                for (int bj = 0; bj < 2; ++bj) { float v[8];
#pragma unroll
                    for (int e = 0; e < 4; ++e) { v[e] = acc[ai][bj][m][0][e]; v[4 + e] = acc[ai][bj][m][1][e]; }
                    if (plane == 0 || plane == 4) {
#pragma unroll
                        for (int e = 0; e < 8; ++e) v[e] = siluf_(v[e]);
                    } else if (plane == 1 || plane == 2) {
#pragma unroll
                        for (int e = 0; e < 8; ++e) { const float l = lbv[bj][e]; const float f = l + (1.0f - l) * sigmoidf_(v[e]); v[e] = fast_log(fmaxf(f, 1e-30f)); }
                    }
                    u32x4 w; w.x = cvt_pk_bf16(v[0], v[1]); w.y = cvt_pk_bf16(v[2], v[3]); w.z = cvt_pk_bf16(v[4], v[5]); w.w = cvt_pk_bf16(v[6], v[7]);
                    *(u32x4*)(rowp + bj * HALF) = w; } }
    }
};
struct EpiPle {
    static constexpr bool PERM = false;
    const bf16_t* Xin; const bf16_t* PP; const float* bias; bf16_t* XbOut; float* Fout;
    __device__ __forceinline__ void operator()(const f32x4 (&acc)[2][2][4][2], const Unit& u, int wr, int wc, int fr, int fq) const {
        const int row0 = u.pm * BM + wr * 64 + fr, col0 = u.pn * BM + wc * 32 + 4 * fq;
        f32x4 bv[2][2];
#pragma unroll
        for (int bj = 0; bj < 2; ++bj)
#pragma unroll
            for (int n = 0; n < 2; ++n) bv[bj][n] = *(const f32x4*)(bias + col0 + bj * HALF + n * 16);
#pragma unroll
        for (int ai = 0; ai < 2; ++ai)
#pragma unroll
            for (int m = 0; m < 4; ++m) { const size_t off = (size_t)(row0 + ai * HALF + m * 16) * 1024 + col0;
#pragma unroll
                for (int bj = 0; bj < 2; ++bj)
#pragma unroll
                    for (int n = 0; n < 2; ++n) { const size_t o2 = off + bj * HALF + n * 16;
                        const u32x2 xw = *(const u32x2*)(Xin + o2); const u32x2 pw = *(const u32x2*)(PP + o2); const f32x4 z = acc[ai][bj][m][n] + bv[bj][n];
                        f32x4 o; o[0] = bflo(xw.x) + sigmoidf_(z[0]) * bflo(pw.x); o[1] = bfhi(xw.x) + sigmoidf_(z[1]) * bfhi(pw.x); o[2] = bflo(xw.y) + sigmoidf_(z[2]) * bflo(pw.y); o[3] = bfhi(xw.y) + sigmoidf_(z[3]) * bfhi(pw.y);
                        if (Fout) *(f32x4*)(Fout + o2) = o; else { u32x2 w; w.x = cvt_pk_bf16(o[0], o[1]); w.y = cvt_pk_bf16(o[2], o[3]); *(u32x2*)(XbOut + o2) = w; } }
                asm volatile("" ::: "memory"); }
    }
};
}
namespace attn {
constexpr int DV = 128, DQK = 192, NW = 8, QBLK = 32, KVBLK = 64;
constexpr float SCALE = MLA_SCALE;
constexpr float THR = 8.f;
constexpr int LDQ = 8 * DQK, LDKV = 8 * 256, LDKR = 64, LDO = 1024;
constexpr int KROWB = 400;
constexpr int SHM_V = KVBLK * DV * 2, SHM_K = KVBLK * KROWB, SHM_ATTN = 2 * SHM_V + 2 * SHM_K + NW * 64 * 4;
#define SBAR() __builtin_amdgcn_sched_barrier(0)
__device__ __forceinline__ int crow(int r, int hi) { return (r & 3) + 8 * (r >> 2) + 4 * hi; }

__device__ __forceinline__ void partialSM(f32x16& p0, f32x16& p1, float& m_reg, float& mn, float& alpha) {
  constexpr float C = SCALE * 1.4426950408889634f;
  float pmax = p0[0];
#pragma unroll
  for (int r = 1; r < 16; ++r) pmax = fmaxf(pmax, p0[r]);
#pragma unroll
  for (int r = 0; r < 16; ++r) pmax = fmaxf(pmax, p1[r]);
  { auto rr = __builtin_amdgcn_permlane32_swap(__float_as_uint(pmax), __float_as_uint(pmax), false, false);
    pmax = fmaxf(__uint_as_float(rr[0]), __uint_as_float(rr[1])); }
  if (__builtin_expect(__all(pmax - m_reg <= THR / SCALE), 1)) { mn = m_reg; alpha = 1.f; }
  else { mn = fmaxf(m_reg, pmax); alpha = __builtin_amdgcn_exp2f((m_reg - mn) * C); m_reg = mn; }
  float mnC = -mn * C;
#pragma unroll
  for (int r = 0; r < 16; ++r) p0[r] = fmaf(p0[r], C, mnC);
#pragma unroll
  for (int r = 0; r < 16; ++r) p1[r] = fmaf(p1[r], C, mnC);
#pragma unroll
  for (int r = 0; r < 16; ++r) p0[r] = __builtin_amdgcn_exp2f(p0[r]);
}
__device__ __forceinline__ void finishSM(f32x16& p0, f32x16& p1, float alpha, float& l_reg, bf16x8& pa0, bf16x8& pa1, bf16x8& pa2, bf16x8& pa3) {
#pragma unroll
  for (int r = 0; r < 16; ++r) p1[r] = __builtin_amdgcn_exp2f(p1[r]);
  float ps = 0;
#pragma unroll
  for (int r = 0; r < 16; ++r) ps += p0[r];
#pragma unroll
  for (int r = 0; r < 16; ++r) ps += p1[r];
  { auto rr = __builtin_amdgcn_permlane32_swap(__float_as_uint(ps), __float_as_uint(ps), false, false);
    ps = __uint_as_float(rr[0]) + __uint_as_float(rr[1]); }
  l_reg = l_reg * alpha + ps;
#define PK4(P, BASE, OUT) do { unsigned a0 = cvt_pk_bf16(P[BASE + 0], P[BASE + 1]), a1 = cvt_pk_bf16(P[BASE + 2], P[BASE + 3]);   \
    unsigned b0 = cvt_pk_bf16(P[BASE + 4], P[BASE + 5]), b1 = cvt_pk_bf16(P[BASE + 6], P[BASE + 7]);                              \
    auto r0 = __builtin_amdgcn_permlane32_swap(a0, b0, false, false); auto r1 = __builtin_amdgcn_permlane32_swap(a1, b1, false, false); \
    u32x4 w = {r0[0], r1[0], r0[1], r1[1]}; OUT = *reinterpret_cast<bf16x8*>(&w); } while (0)
  PK4(p0, 0, pa0); PK4(p0, 8, pa1); PK4(p1, 0, pa2); PK4(p1, 8, pa3);
#undef PK4
}
__device__ __forceinline__ void qkt(f32x16& p0, f32x16& p1, const char* Ks, const bf16x8* qr, int r32, int hi) {
  p0 = f32x16{}; p1 = f32x16{};
#pragma unroll
  for (int d0 = 0; d0 < 12; ++d0) { const int cb = (d0 * 16 + hi * 8) * 2;
    bf16x8 b0 = *reinterpret_cast<const bf16x8*>(Ks + r32 * KROWB + cb);
    bf16x8 b1 = *reinterpret_cast<const bf16x8*>(Ks + (32 + r32) * KROWB + cb);
    p0 = __builtin_amdgcn_mfma_f32_32x32x16_bf16(b0, qr[d0], p0, 0, 0, 0);
    p1 = __builtin_amdgcn_mfma_f32_32x32x16_bf16(b1, qr[d0], p1, 0, 0, 0);
    if ((d0 & 3) == 3) SBAR(); }
}
__device__ __forceinline__ int v_st(int k, int c) { const int kk = (k & ~0xC) | ((k & 4) << 1) | ((k & 8) >> 1); return ((kk >> 3) * 4 + (c >> 5)) * 512 + ((kk & 7) * 32 + (c & 31)) * 2; }
__device__ __forceinline__ int v_rd_base(int lane) { return ((lane & 3) << 3) | (((lane >> 2) & 3) << 6) | (((lane >> 4) & 1) << 5) | (((lane >> 5) & 1) << 8); }
constexpr int v_rd_off(int d0, int ks, int half) { return d0 * 512 + ks * 4096 + half * 2048; }
template <int OFF> __device__ __forceinline__ s16x4 tr_read(int vb) {
  s16x4 r; asm volatile("ds_read_b64_tr_b16 %0, %1 offset:%2" : "=&v"(r) : "v"(vb), "i"(OFF) : "memory"); return r;
}
template <int D0> __device__ __forceinline__ void pv_one(f32x16& od, int vb, bf16x8 pa0, bf16x8 pa1, bf16x8 pa2, bf16x8 pa3) {
  const s16x4 l0 = tr_read<v_rd_off(D0, 0, 0)>(vb), h0 = tr_read<v_rd_off(D0, 0, 1)>(vb), l1 = tr_read<v_rd_off(D0, 1, 0)>(vb), h1 = tr_read<v_rd_off(D0, 1, 1)>(vb);
  const s16x4 l2 = tr_read<v_rd_off(D0, 2, 0)>(vb), h2 = tr_read<v_rd_off(D0, 2, 1)>(vb), l3 = tr_read<v_rd_off(D0, 3, 0)>(vb), h3 = tr_read<v_rd_off(D0, 3, 1)>(vb);
  asm volatile("s_waitcnt lgkmcnt(0)" ::: "memory"); SBAR();
#define PK(L, H) (bf16x8){L[0], L[1], L[2], L[3], H[0], H[1], H[2], H[3]}
  od = __builtin_amdgcn_mfma_f32_32x32x16_bf16(pa0, PK(l0, h0), od, 0, 0, 0);
  od = __builtin_amdgcn_mfma_f32_32x32x16_bf16(pa1, PK(l1, h1), od, 0, 0, 0);
  od = __builtin_amdgcn_mfma_f32_32x32x16_bf16(pa2, PK(l2, h2), od, 0, 0, 0);
  od = __builtin_amdgcn_mfma_f32_32x32x16_bf16(pa3, PK(l3, h3), od, 0, 0, 0);
#undef PK
}
__device__ __forceinline__ void pv_d0(f32x16* o, int vb, bf16x8 pa0, bf16x8 pa1, bf16x8 pa2, bf16x8 pa3) {
  pv_one<0>(o[0], vb, pa0, pa1, pa2, pa3); pv_one<1>(o[1], vb, pa0, pa1, pa2, pa3); pv_one<2>(o[2], vb, pa0, pa1, pa2, pa3); pv_one<3>(o[3], vb, pa0, pa1, pa2, pa3);
}

__device__ __forceinline__ void attn_body(const bf16_t* __restrict__ Qb, const bf16_t* __restrict__ Kn, const bf16_t* __restrict__ Kr,
                                          bf16_t* __restrict__ Ob, int seq, char* lds, int tid, int pos0, const float* __restrict__ ropeT) {
  asm volatile("" : "+v"(tid));
  const int wid = tid >> 6, lane = tid & 63, r32 = lane & 31, hi = lane >> 5;
  char* V_lds = lds; char* K_lds = lds + 2 * SHM_V;
  float* ws = (float*)(lds + 2 * SHM_V + 2 * SHM_K) + wid * 64; float* li_l = ws; float* al_l = ws + 32;
  float m_reg = -1e30f, l_reg = 0; f32x16 o[4] = {}; bf16x8 qr[12];
  const bf16_t* Qw = Qb + (long)(wid * QBLK + r32) * LDQ + hi * 8;
#pragma unroll
  for (int d0 = 0; d0 < 12; ++d0) qr[d0] = *reinterpret_cast<const bf16x8*>(Qw + d0 * 16);
  { const float* cp = ropeT + (size_t)(pos0 + wid * QBLK + r32) * 32 + hi * 8; const float* sp = cp + 8192 * 32;
#pragma unroll
    for (int dd = 0; dd < 2; ++dd) { const f32x4 c0 = *(const f32x4*)(cp + 16 * dd), c1 = *(const f32x4*)(cp + 16 * dd + 4), s0 = *(const f32x4*)(sp + 16 * dd), s1 = *(const f32x4*)(sp + 16 * dd + 4);
      const u32x4 A = *reinterpret_cast<const u32x4*>(&qr[8 + dd]), B = *reinterpret_cast<const u32x4*>(&qr[10 + dd]); u32x4 An, Bn;
#pragma unroll
      for (int w2 = 0; w2 < 4; ++w2) { const float cs0 = w2 < 2 ? c0[2 * w2] : c1[2 * w2 - 4], cs1 = w2 < 2 ? c0[2 * w2 + 1] : c1[2 * w2 - 3], sn0 = w2 < 2 ? s0[2 * w2] : s1[2 * w2 - 4], sn1 = w2 < 2 ? s0[2 * w2 + 1] : s1[2 * w2 - 3];
        const float a0 = bflo(A[w2]), a1 = bfhi(A[w2]), b0 = bflo(B[w2]), b1 = bfhi(B[w2]);
        An[w2] = cvt_pk_bf16(a0 * cs0 - b0 * sn0, a1 * cs1 - b1 * sn1); Bn[w2] = cvt_pk_bf16(b0 * cs0 + a0 * sn0, b1 * cs1 + a1 * sn1); }
      qr[8 + dd] = *reinterpret_cast<const bf16x8*>(&An); qr[10 + dd] = *reinterpret_cast<const bf16x8*>(&Bn); } }
  const bf16_t* Vh = Kn + 128;
  const int sr = tid >> 4, sc = (tid & 15) * 8, vst0 = v_st(sr, sc), vst1 = v_st(32 + sr, sc);
  int krow[3], kcc[3];
#pragma unroll
  for (int i = 0; i < 3; ++i) { const int id = tid + 512 * i; krow[i] = id / 24; kcc[i] = id % 24; }
  const int vb0 = (int)(uintptr_t)V_lds + v_rd_base(lane);
  bf16x8 vs0, vs1, ks0, ks1, ks2;
#define KSRC(i, k0) (kcc[i] < 16 ? (Kn + (long)((k0) + krow[i]) * LDKV + kcc[i] * 8) : (Kr + (long)((k0) + krow[i]) * LDKR + (kcc[i] - 16) * 8))
#define SLOAD(k0) do { vs0 = *reinterpret_cast<const bf16x8*>(&Vh[(long)((k0) + sr) * LDKV + sc]); vs1 = *reinterpret_cast<const bf16x8*>(&Vh[(long)((k0) + 32 + sr) * LDKV + sc]); \
    ks0 = *reinterpret_cast<const bf16x8*>(KSRC(0, k0)); ks1 = *reinterpret_cast<const bf16x8*>(KSRC(1, k0)); ks2 = *reinterpret_cast<const bf16x8*>(KSRC(2, k0)); } while (0)
#define SWRITE(b) do { *(bf16x8*)(V_lds + (b) * SHM_V + vst0) = vs0; *(bf16x8*)(V_lds + (b) * SHM_V + vst1) = vs1; \
    *(bf16x8*)(K_lds + (b) * SHM_K + krow[0] * KROWB + kcc[0] * 16) = ks0; *(bf16x8*)(K_lds + (b) * SHM_K + krow[1] * KROWB + kcc[1] * 16) = ks1; \
    *(bf16x8*)(K_lds + (b) * SHM_K + krow[2] * KROWB + kcc[2] * 16) = ks2; } while (0)
#define SWAIT() asm volatile("s_waitcnt vmcnt(0)" ::: "memory")
#define RESC(a) do { if (__any((a) < 1.f)) { if (hi == 0) al_l[r32] = (a); asm volatile("s_waitcnt lgkmcnt(0)" ::: "memory"); \
    _Pragma("unroll") for (int d = 0; d < 4; ++d) _Pragma("unroll") for (int r = 0; r < 16; ++r) o[d][r] *= al_l[crow(r, hi)]; } } while (0)
  f32x16 pA0, pA1; float mnA, alA; bf16x8 pa0, pa1, pa2, pa3; const int NT = seq / KVBLK;
  SLOAD(0); SWAIT(); SWRITE(0); __syncthreads();
  for (int j = 0; j < NT; ++j) {
    const int b = j & 1;
    if (j + 1 < NT) SLOAD((j + 1) * KVBLK);
    SBAR(); qkt(pA0, pA1, K_lds + b * SHM_K, qr, r32, hi);
    partialSM(pA0, pA1, m_reg, mnA, alA);
    RESC(alA);
    finishSM(pA0, pA1, alA, l_reg, pa0, pa1, pa2, pa3); SBAR();
    pv_d0(o, vb0 + b * (int)SHM_V, pa0, pa1, pa2, pa3);
    if (j + 1 < NT) { SWAIT(); SWRITE(b ^ 1); }
    __syncthreads();
  }
  if (hi == 0) li_l[r32] = l_reg; asm volatile("s_waitcnt lgkmcnt(0)" ::: "memory");
  float rli[16];
#pragma unroll
  for (int r = 0; r < 16; ++r) rli[r] = __builtin_amdgcn_rcpf(li_l[crow(r, hi)]);
  bf16_t* Ow = Ob + (long)(wid * QBLK) * LDO;
#pragma unroll
  for (int r = 0; r < 16; ++r) { const int orow = crow(r, hi);
#pragma unroll
    for (int d0 = 0; d0 < 4; ++d0) Ow[(long)orow * LDO + d0 * 32 + r32] = f2bf(o[d0][r] * rli[r]); }
#undef KSRC
#undef SLOAD
#undef SWRITE
#undef SWAIT
#undef RESC
}
#undef SBAR
}
typedef const __attribute__((address_space(4))) Args* KArgs;
struct Ctx {
    KArgs a; float* out; unsigned char* ws;
    LAS unsigned char* lds;
    int tid, lane, wave, vcu, G, gw, NGW, bid;
    __device__ __forceinline__ const float* in(int i) const { return a->in[i]; }
};
__device__ __forceinline__ Ctx mk_ctx(unsigned char* lds_raw, int wave_s) {
    Ctx c; KArgs a = (KArgs)__builtin_amdgcn_kernarg_segment_ptr(); asm volatile("" : "+s"(a));
    c.a = a; c.out = a->out; c.ws = a->ws; c.lds = (LAS unsigned char*)lds_raw;
    c.tid = opaque_tid(wave_s); c.lane = c.tid & 63; c.wave = __builtin_amdgcn_readfirstlane(c.tid >> 6);
    c.G = (int)gridDim.x; c.bid = opaque_bid(); c.vcu = (c.G % 8 == 0) ? (c.bid % 8) * (c.G / 8) + c.bid / 8 : c.bid;
    c.gw = c.vcu * NWAVES + c.wave; c.NGW = c.G * NWAVES;
    return c;
}
__device__ __forceinline__ int tok_pos(int t) { return t < TP ? (t & (SP - 1)) : ((t - TP) & (SS - 1)); }

__device__ __forceinline__ void transpose_item(const float* W, int K, int N, bf16_t* WT, LAS float* scr, int item, int lane) {
    const int nblk = N / 32, kb = item / nblk, nb = item % nblk, k0 = 64 * kb, n0 = 32 * nb;
#pragma unroll 8
    for (int i = 0; i < 32; ++i) { const int kk = 2 * i + (lane >> 5); scr[kk * 33 + (lane & 31)] = W[(size_t)(k0 + kk) * N + n0 + (lane & 31)]; }
    LDS_WAIT(); asm volatile("" ::: "memory");
    const int c = lane & 7;
#pragma unroll
    for (int j = 0; j < 4; ++j) { const int n = (lane >> 3) + 8 * j; const LAS float* s = scr + (8 * c) * 33 + n;
        u32x4 o; o.x = cvt_pk_bf16(s[0 * 33], s[1 * 33]); o.y = cvt_pk_bf16(s[2 * 33], s[3 * 33]); o.z = cvt_pk_bf16(s[4 * 33], s[5 * 33]); o.w = cvt_pk_bf16(s[6 * 33], s[7 * 33]);
        *(u32x4*)(WT + (size_t)(n0 + n) * K + k0 + 8 * c) = o; }
    LDS_WAIT(); asm volatile("" ::: "memory");
}
struct MatDesc { int in_idx, K, N, Npad, copies; size_t dst; };
__device__ __forceinline__ void p0_prologue(const Ctx& c) {
    LAS float* scr = (LAS float*)(c.lds + c.wave * 16384);
    const MatDesc MATS[9] = {
        {4, 1024, 704, 768, 2, W_WA}, {7, 384, 1536, 1536, 2, W_WUQ}, {8, 256, 2048, 2048, 2, W_WUKV}, {9, 1024, 1024, 1024, 2, W_WO},
        {10, 1024, 5120, 5120, 2, W_HIN}, {13, 1024, 1024, 1024, 2, W_HO}, {14, 1024, 2048, 2048, 4, W_PQ}, {22, 1024, 1024, 1024, 4, W_GW}, {24, 256, 1024, 1024, 4, W_PP}};
    int total = 0;
#pragma unroll
    for (int m = 0; m < 9; ++m) total += MATS[m].copies * (MATS[m].K / 64) * (MATS[m].N / 32);
    for (int it = c.gw; it < total; it += c.NGW) {
        int r = it;
#pragma unroll
        for (int m = 0; m < 9; ++m) {
            const int per = (MATS[m].K / 64) * (MATS[m].N / 32), cnt = MATS[m].copies * per;
            if (r >= 0 && r < cnt) { const int cp = r / per, item = r % per;
                transpose_item(c.in(MATS[m].in_idx) + (size_t)cp * MATS[m].K * MATS[m].N, MATS[m].K, MATS[m].N,
                               (bf16_t*)(c.ws + MATS[m].dst) + (size_t)cp * MATS[m].Npad * MATS[m].K, scr, item, c.lane);
                r = -1; }
            else if (r >= 0) r -= cnt;
        }
    }
    const int gt = c.gw * 64 + c.lane, NGT = c.NGW * 64;
    for (int i = gt; i < 2 * 64 * 1024 / 8; i += NGT) { const int cp = i / (64 * 1024 / 8), o = i % (64 * 1024 / 8);
        *(u32x4*)((bf16_t*)(c.ws + W_WA) + (size_t)cp * 768 * 1024 + (size_t)704 * 1024 + o * 8) = (u32x4){0u, 0u, 0u, 0u}; }
    for (int i = gt; i < 4 * 2 * 128 * 128 / 4; i += NGT) { const f32x4 v = *(const f32x4*)(c.in(15) + (size_t)i * 4);
        u32x2 w; w.x = cvt_pk_bf16(v[0], v[1]); w.y = cvt_pk_bf16(v[2], v[3]); *(u32x2*)((bf16_t*)(c.ws + W_KEYS) + (size_t)i * 4) = w; }
    for (int i = gt; i < 8192 * 32; i += NGT) { const int pos = i >> 5, f = i & 31;
        const float inv = 1.0f / powf(10000.0f, (float)(2 * f) / 64.0f); const float ang = (float)pos * inv;
        ((float*)(c.ws + WS_ROPE))[i] = cosf(ang); ((float*)(c.ws + WS_ROPE))[8192 * 32 + i] = sinf(ang); }
    for (int i = gt; i < 2 * 1024; i += NGT) { const int dir = i >> 10, k = i & 1023;
        const float l0 = c.in(11)[(dir * 2 + 0) * 1024 + k], l1 = c.in(11)[(dir * 2 + 1) * 1024 + k];
        float* lb = (float*)(c.ws + WS_MISC);
        lb[(0 * 2 + dir) * 1024 + k] = 0.f; lb[(1 * 2 + dir) * 1024 + k] = 1.0f / (1.0f + expf(l0 - l1)); }
    for (int t = c.gw; t < T; t += c.NGW) {
        const float* xr = t < TP ? c.in(0) + (size_t)t * D : c.in(1) + (size_t)(t - TP) * D;
        bf16_t* brow = (bf16_t*)c.out + (size_t)t * D;
#pragma unroll
        for (int j = 0; j < 4; ++j) { const f32x4 v = *(const f32x4*)(xr + 256 * j + 4 * c.lane);
            u32x2 w; w.x = cvt_pk_bf16(v[0], v[1]); w.y = cvt_pk_bf16(v[2], v[3]); *(u32x2*)(brow + 256 * j + 4 * c.lane) = w; }
    }
}

__device__ __forceinline__ void cvt_range(const float* src, bf16_t* dst, size_t n8, int gt, int NGT) {
    for (size_t i = gt; i < n8; i += NGT) { const f32x4 a = *(const f32x4*)(src + i * 8), b = *(const f32x4*)(src + i * 8 + 4);
        u32x4 w; w.x = cvt_pk_bf16(a[0], a[1]); w.y = cvt_pk_bf16(a[2], a[3]); w.z = cvt_pk_bf16(b[0], b[1]); w.w = cvt_pk_bf16(b[2], b[3]); *(u32x4*)(dst + i * 8) = w; }
}
__device__ __forceinline__ void l0_convert(const Ctx& c, int layer) {
    const int gt = c.gw * 64 + c.lane, NGT = c.NGW * 64;
    for (int r = c.gw; r < 2 * NEXP; r += c.NGW) {
        const int m = r >= NEXP, e = r - m * NEXP;
        const float* src = c.in(16 + m) + ((size_t)layer * NEXP + e) * D + 16 * c.lane;
        f32x4 v[4]; float am = 0.f;
#pragma unroll
        for (int j = 0; j < 4; ++j) { v[j] = *(const f32x4*)(src + 4 * j); am = fmaxf(am, fmaxf(fmaxf(fabsf(v[j][0]), fabsf(v[j][1])), fmaxf(fabsf(v[j][2]), fabsf(v[j][3])))); }
        am = wave_max(am);
        const float sc = fmaxf(am, 1e-30f) * (1.0f / 440.0f), inv = 1.0f / sc;
        u32x4 w;
#pragma unroll
        for (int j = 0; j < 4; ++j) { int p = 0; p = __builtin_amdgcn_cvt_pk_fp8_f32(v[j][0] * inv, v[j][1] * inv, p, false); p = __builtin_amdgcn_cvt_pk_fp8_f32(v[j][2] * inv, v[j][3] * inv, p, true); w[j] = (unsigned)p; }
        *(u32x4*)(c.ws + (m ? R2_VB : R2_UB) + (size_t)e * D + 16 * c.lane) = w;
        if (c.lane == 0) ((float*)(c.ws + (m ? R2_SV : R2_SU)))[e] = sc;
    }
    cvt_range(c.in(2) + (size_t)layer * TP * 256, (bf16_t*)(c.ws + R2_PB), (size_t)TP * 256 / 8, gt, NGT);
    cvt_range(c.in(3) + (size_t)layer * TS * 256, (bf16_t*)(c.ws + R2_PB) + (size_t)TP * 256, (size_t)TS * 256 / 8, gt, NGT);
}

__device__ __forceinline__ void mla_e1(const Ctx& c, int j) {
    const float* a32 = (const float*)(c.ws + B_A32); bf16_t* cqn = (bf16_t*)(c.ws + B_CQN); bf16_t* ckvn = (bf16_t*)(c.ws + B_CKVN); bf16_t* krope = (bf16_t*)(c.ws + B_KROPE);
    const float* qnw = c.in(5) + j * 384; const float* kvnw = c.in(6) + j * 256;
    const float* cosT = (const float*)(c.ws + WS_ROPE); const float* sinT = cosT + 8192 * 32;
    LAS float* scr = (LAS float*)(c.lds + c.wave * 1024);
    const int lane = c.lane;
    for (int t = c.gw; t < T; t += c.NGW) {
        const float* ar = a32 + (size_t)t * 768;
        const f32x4 v0 = *(const f32x4*)(ar + 4 * lane), v1 = *(const f32x4*)(ar + 256 + 4 * lane), v2 = *(const f32x4*)(ar + 512 + 4 * lane);
        const float s0 = v0[0] * v0[0] + v0[1] * v0[1] + v0[2] * v0[2] + v0[3] * v0[3];
        const float s1 = v1[0] * v1[0] + v1[1] * v1[1] + v1[2] * v1[2] + v1[3] * v1[3];
        const float s2 = v2[0] * v2[0] + v2[1] * v2[1] + v2[2] * v2[2] + v2[3] * v2[3];
        const float ssq = wave_sum(s0 + (lane < 32 ? s1 : 0.f));
        const float sskv = wave_sum((lane >= 32 ? s1 : 0.f) + (lane < 32 ? s2 : 0.f));
        const float rq = 1.0f / sqrtf(ssq * (1.0f / 384.0f) + RMS_EPS), rkv = 1.0f / sqrtf(sskv * (1.0f / 256.0f) + RMS_EPS);
        { const f32x4 w = *(const f32x4*)(qnw + 4 * lane); u32x2 o; o.x = cvt_pk_bf16(v0[0] * rq * w[0], v0[1] * rq * w[1]); o.y = cvt_pk_bf16(v0[2] * rq * w[2], v0[3] * rq * w[3]);
          *(u32x2*)(cqn + (size_t)t * 384 + 4 * lane) = o; }
        if (lane < 32) { const f32x4 w = *(const f32x4*)(qnw + 256 + 4 * lane); u32x2 o; o.x = cvt_pk_bf16(v1[0] * rq * w[0], v1[1] * rq * w[1]); o.y = cvt_pk_bf16(v1[2] * rq * w[2], v1[3] * rq * w[3]);
          *(u32x2*)(cqn + (size_t)t * 384 + 256 + 4 * lane) = o; }
        else { const int ix = 4 * (lane - 32); const f32x4 w = *(const f32x4*)(kvnw + ix); u32x2 o; o.x = cvt_pk_bf16(v1[0] * rkv * w[0], v1[1] * rkv * w[1]); o.y = cvt_pk_bf16(v1[2] * rkv * w[2], v1[3] * rkv * w[3]);
          *(u32x2*)(ckvn + (size_t)t * 256 + ix) = o; }
        if (lane < 32) { const int ix = 128 + 4 * lane; const f32x4 w = *(const f32x4*)(kvnw + ix); u32x2 o; o.x = cvt_pk_bf16(v2[0] * rkv * w[0], v2[1] * rkv * w[1]); o.y = cvt_pk_bf16(v2[2] * rkv * w[2], v2[3] * rkv * w[3]);
          *(u32x2*)(ckvn + (size_t)t * 256 + ix) = o; }
        else if (lane < 48) { *(LAS f32x4*)(scr + 4 * (lane - 32)) = v2; }
        LDS_WAIT(); asm volatile("" ::: "memory");
        if (lane < 32) { const int pos = tok_pos(t); const float a = scr[lane], b = scr[lane + 32], cs = cosT[pos * 32 + lane], sn = sinT[pos * 32 + lane];
            krope[(size_t)t * 64 + lane] = f2bf(a * cs - b * sn); krope[(size_t)t * 64 + 32 + lane] = f2bf(b * cs + a * sn); }
        LDS_WAIT(); asm volatile("" ::: "memory");
    }
}
__device__ __forceinline__ void mla_qrope(const Ctx& c) {
    bf16_t* q = (bf16_t*)(c.ws + B_Q);
    const float* cosT = (const float*)(c.ws + WS_ROPE); const float* sinT = cosT + 8192 * 32;
    const int lane = c.lane, i = lane & 31;
    for (int t = c.gw; t < T; t += c.NGW) {
        const int pos = tok_pos(t); const float cs = cosT[pos * 32 + i], sn = sinT[pos * 32 + i];
#pragma unroll
        for (int k = 0; k < 4; ++k) { const int h = (lane >> 5) + 2 * k; bf16_t* p = q + (size_t)t * 1536 + h * 192 + 128 + i;
            const float a = bf2f(p[0]), b = bf2f(p[32]); p[0] = f2bf(a * cs - b * sn); p[32] = f2bf(b * cs + a * sn); }
    }
}
__device__ __forceinline__ void mla_attention(const Ctx& c) {
    const bf16_t* Q = (const bf16_t*)(c.ws + B_Q); const bf16_t* KV = (const bf16_t*)(c.ws + B_KV); const bf16_t* KR = (const bf16_t*)(c.ws + B_KROPE); bf16_t* O = (bf16_t*)(c.ws + B_O);
    const int NU = 512 + 2048;
    for (int u = c.bid; u < NU; u += c.G) {
        int tok0, qb, h, seq;
        if (u < 512) { const int round = u >> 8, cc = u & 255, bh = round * 8 + (cc & 7); tok0 = (bh >> 3) * SP; h = bh & 7; qb = cc >> 3; seq = SP; }
        else { const int us = u - 512, round = us >> 8, cc = us & 255, r = cc >> 3, bh = round * 32 + (cc & 7) * 4 + (r >> 3); tok0 = TP + (bh >> 3) * SS; h = bh & 7; qb = r & 7; seq = SS; }
        attn::attn_body(Q + (size_t)(tok0 + qb * 256) * 1536 + h * 192, KV + (size_t)tok0 * 2048 + h * 256, KR + (size_t)tok0 * 64,
                        O + (size_t)(tok0 + qb * 256) * 1024 + h * 128, seq, (char*)c.lds, c.tid, qb * 256, (const float*)(c.ws + WS_ROPE));
        __syncthreads();
    }
}
__device__ __forceinline__ void ln_residual(const Ctx& c, const bf16_t* hb, const float* g, const float* b) {
    const bf16_t* xm = (const bf16_t*)c.out; bf16_t* xa = (bf16_t*)(c.ws + WS_XB); const int lane = c.lane;
    for (int t = c.gw; t < T; t += c.NGW) {
        const bf16_t* xr = xm + (size_t)t * D; const bf16_t* hr = hb + (size_t)t * D;
        f32x4 v[4]; float s = 0.f;
#pragma unroll
        for (int j = 0; j < 4; ++j) { const u32x2 xw = *(const u32x2*)(xr + 256 * j + 4 * lane), hw = *(const u32x2*)(hr + 256 * j + 4 * lane);
            v[j] = (f32x4){bflo(xw.x), bfhi(xw.x), bflo(xw.y), bfhi(xw.y)} * DN_ALPHA + (f32x4){bflo(hw.x), bfhi(hw.x), bflo(hw.y), bfhi(hw.y)}; s += (v[j][0] + v[j][1]) + (v[j][2] + v[j][3]); }
        const float mean = wave_sum(s) * (1.0f / D); float s2 = 0.f;
#pragma unroll
        for (int j = 0; j < 4; ++j) { v[j] = v[j] - mean; s2 += (v[j][0] * v[j][0] + v[j][1] * v[j][1]) + (v[j][2] * v[j][2] + v[j][3] * v[j][3]); }
        const float rstd = 1.0f / sqrtf(wave_sum(s2) * (1.0f / D) + LN_EPS);
#pragma unroll
        for (int j = 0; j < 4; ++j) { const f32x4 gg = *(const f32x4*)(g + 256 * j + 4 * lane), bb = *(const f32x4*)(b + 256 * j + 4 * lane); const f32x4 o = v[j] * rstd * gg + bb;
            u32x2 w; w.x = cvt_pk_bf16(o[0], o[1]); w.y = cvt_pk_bf16(o[2], o[3]); *(u32x2*)(xa + (size_t)t * D + 256 * j + 4 * lane) = w; }
    }
}
__device__ __forceinline__ void hgrn_post(const Ctx& c, int j) {
    bf16_t* pl = (bf16_t*)(c.ws + B_PLANE); const size_t PE = (size_t)T * 1024;
    const bf16_t* of = pl + 1 * PE; const bf16_t* ob = pl + 2 * PE; const bf16_t* sg = pl + 4 * PE; bf16_t* on = pl;
    const float* nw = c.in(12) + j * 128; const int lane = c.lane;
    for (int t = c.gw; t < T; t += c.NGW) {
#pragma unroll
        for (int k = 0; k < 2; ++k) { const size_t off = (size_t)t * 1024 + 512 * k + 8 * lane;
            const u32x4 a = *(const u32x4*)(of + off), b = *(const u32x4*)(ob + off), g = *(const u32x4*)(sg + off);
            float o[8]; o[0] = bflo(a.x) + bflo(b.x); o[1] = bfhi(a.x) + bfhi(b.x); o[2] = bflo(a.y) + bflo(b.y); o[3] = bfhi(a.y) + bfhi(b.y);
            o[4] = bflo(a.z) + bflo(b.z); o[5] = bfhi(a.z) + bfhi(b.z); o[6] = bflo(a.w) + bflo(b.w); o[7] = bfhi(a.w) + bfhi(b.w);
            float ss = 0.f;
#pragma unroll
            for (int e = 0; e < 8; ++e) ss += o[e] * o[e];
            ss = row16_sum(ss);
            const float r = 1.0f / sqrtf(ss * (1.0f / 128.0f) + RMS_EPS);
            const int cw = (8 * lane) & 127; const f32x4 w0 = *(const f32x4*)(nw + cw), w1 = *(const f32x4*)(nw + cw + 4);
            float gg[8]; gg[0] = bflo(g.x); gg[1] = bfhi(g.x); gg[2] = bflo(g.y); gg[3] = bfhi(g.y); gg[4] = bflo(g.z); gg[5] = bfhi(g.z); gg[6] = bflo(g.w); gg[7] = bfhi(g.w);
            u32x4 w; w.x = cvt_pk_bf16(o[0] * r * w0[0] * gg[0], o[1] * r * w0[1] * gg[1]); w.y = cvt_pk_bf16(o[2] * r * w0[2] * gg[2], o[3] * r * w0[3] * gg[3]);
            w.z = cvt_pk_bf16(o[4] * r * w1[0] * gg[4], o[5] * r * w1[1] * gg[5]); w.w = cvt_pk_bf16(o[6] * r * w1[2] * gg[6], o[7] * r * w1[3] * gg[7]);
            *(u32x4*)(on + off) = w; }
    }
}
namespace scan {
constexpr size_t D_F = R2_IDX, D_B = R2_IDX + 12 * MiB;
constexpr int NCH = T / 32;
__device__ __forceinline__ void hgrn_prep(const Ctx& c) {
    bf16_t* pl = (bf16_t*)(c.ws + B_PLANE); const size_t PE = (size_t)T * 1024;
    bf16_t* qs = pl; bf16_t* lff = pl + PE; bf16_t* lfb = pl + 2 * PE; bf16_t* qtb = (bf16_t*)(c.ws + WS_XB);
    float* dF = (float*)(c.ws + D_F); float* dB = (float*)(c.ws + D_B);
    const int lane = c.lane;
    for (int it = c.gw; it < NCH * 8; it += c.NGW) {
        const int chunk = it >> 3, h = it & 7; const size_t base = (size_t)chunk * 32 * 1024 + h * 128 + 2 * lane;
        { float r0 = 0.f, r1 = 0.f;
#pragma unroll 8
          for (int tau = 31; tau >= 0; --tau) { const size_t o = base + (size_t)tau * 1024; const unsigned lw = *(const unsigned*)(lfb + o), qw = *(const unsigned*)(qs + o);
              const float l0 = bflo(lw), l1 = bfhi(lw); r0 += l0; r1 += l1;
              const float k0 = 1.0f - fast_exp(l0), k1 = 1.0f - fast_exp(l1);
              *(unsigned*)(qtb + o) = cvt_pk_bf16(bflo(qw) * fast_exp(r0), bfhi(qw) * fast_exp(r1));
              *(unsigned*)(lfb + o) = cvt_pk_bf16(k0 * fast_exp(fminf(-r0, 80.f)), k1 * fast_exp(fminf(-r1, 80.f))); }
          *(f32x2*)(dB + (size_t)chunk * 1024 + h * 128 + 2 * lane) = (f32x2){fast_exp(r0), fast_exp(r1)}; }
        { float r0 = 0.f, r1 = 0.f;
#pragma unroll 8
          for (int tau = 0; tau < 32; ++tau) { const size_t o = base + (size_t)tau * 1024; const unsigned lw = *(const unsigned*)(lff + o), qw = *(const unsigned*)(qs + o);
              const float l0 = bflo(lw), l1 = bfhi(lw); r0 += l0; r1 += l1;
              const float k0 = 1.0f - fast_exp(l0), k1 = 1.0f - fast_exp(l1);
              *(unsigned*)(qs + o) = cvt_pk_bf16(bflo(qw) * fast_exp(r0), bfhi(qw) * fast_exp(r1));
              *(unsigned*)(lff + o) = cvt_pk_bf16(k0 * fast_exp(fminf(-r0, 80.f)), k1 * fast_exp(fminf(-r1, 80.f))); }
          *(f32x2*)(dF + (size_t)chunk * 1024 + h * 128 + 2 * lane) = (f32x2){fast_exp(r0), fast_exp(r1)}; }
    }
}

constexpr int QT_OFF = 0, KT_OFF = 8192, V_OFF = 16384, P_OFF = 24576, ST_OFF = 34816, DV_OFF = 69632, CHAIN_BYTES = 70144;
constexpr int RS = 272, RS2 = 80;
__device__ __forceinline__ int crow(int r, int hi) { return (r & 3) + 8 * (r >> 2) + 4 * hi; }
__device__ __forceinline__ unsigned off_b(unsigned row, unsigned ch) { return 256u * row + 16u * (ch ^ (((row & 3) << 2) | ((row >> 2) & 3))); }
__device__ __forceinline__ unsigned row_read_addr(unsigned lane, unsigned s) { return off_b(lane & 31, 2 * s + (lane >> 5)); }
__device__ __forceinline__ unsigned tr_read_addr(unsigned lane, unsigned cc, unsigned ks, unsigned t) {
    const unsigned h = lane >> 5, blk = (lane >> 4) & 1, q = (lane & 15) >> 2, p = lane & 3;
    return off_b(16 * ks + 8 * h + 4 * t + q, 4 * cc + 2 * blk + (p >> 1)) + 8 * (p & 1);
}
__device__ __forceinline__ s16x4 tr_rd(unsigned addr) { s16x4 r; asm volatile("ds_read_b64_tr_b16 %0, %1" : "=&v"(r) : "v"(addr) : "memory"); return r; }
#define TRPK(L, H) (bf16x8){L[0], L[1], L[2], L[3], H[0], H[1], H[2], H[3]}

__device__ __forceinline__ void run_pair(const Ctx& c, int tok0, int L, int h, bool dummy) {
    bf16_t* pl = (bf16_t*)(c.ws + B_PLANE); const size_t PE = (size_t)T * 1024;
    const int tid = c.tid, lane = c.lane, wave = c.wave, ch = wave >> 2, w = wave & 3, r32 = lane & 31, hi = lane >> 5;
    const bf16_t* qt = ch ? (const bf16_t*)(c.ws + WS_XB) : pl; bf16_t* kt = pl + (size_t)(1 + ch) * PE; const bf16_t* vv = pl + 3 * PE;
    const float* dd = (const float*)(c.ws + (ch ? D_B : D_F));
    bf16_t* odst = dummy ? (bf16_t*)(c.ws + R2_PB) - (size_t)20 * MiB : kt;
    LAS unsigned char* base = c.lds + ch * CHAIN_BYTES;
    const unsigned lbase = (unsigned)(uintptr_t)base;
    const int ctid = tid & 255;
    const int NC = L / 32;
    const int vcol = 32 * w + r32;
    LAS unsigned char* Pw = base + P_OFF + w * 2560;
    const int s_r0 = ctid >> 4, s_chn = ctid & 15;
    u32x4 sreg[6]; f32x4 dreg = (f32x4){0.f, 0.f, 0.f, 0.f};
#define SCAN_LOAD(cidx) do { const size_t rowb = (size_t)(tok0 + 32 * (cidx)) * 1024 + h * 128; \
        _Pragma("unroll") for (int i = 0; i < 6; ++i) { const bf16_t* src = ((i >> 1) == 0 ? qt : ((i >> 1) == 1 ? (const bf16_t*)kt : vv)) + rowb + (size_t)(s_r0 + 16 * (i & 1)) * 1024 + s_chn * 8; sreg[i] = *(const u32x4*)src; } \
        if (ctid < 32) dreg = *(const f32x4*)(dd + (size_t)((tok0 >> 5) + (cidx)) * 1024 + h * 128 + 4 * ctid); } while (0)
#define SCAN_WRITE() do { _Pragma("unroll") for (int i = 0; i < 6; ++i) *(LAS u32x4*)(base + (i >> 1) * 8192 + off_b(s_r0 + 16 * (i & 1), s_chn)) = sreg[i]; \
        if (ctid < 32) *(LAS f32x4*)(base + DV_OFF + 16 * ctid) = dreg; } while (0)
    { LAS u32x4* st = (LAS u32x4*)(base + ST_OFF + (32 * w) * RS); for (int i = lane; i < 32 * RS / 16; i += 64) st[i] = (u32x4){0u, 0u, 0u, 0u}; }
    f32x16 S[4];
#pragma unroll
    for (int kt2 = 0; kt2 < 4; ++kt2) S[kt2] = f32x16{};
    SCAN_LOAD(ch ? NC - 1 : 0); SCAN_WRITE();
    __syncthreads();
    for (int ci = 0; ci < NC; ++ci) {
        const int cidx = ch ? NC - 1 - ci : ci;
        if (ci + 1 < NC) SCAN_LOAD(ch ? cidx - 1 : cidx + 1);
        f32x16 X = f32x16{};
#pragma unroll
        for (int ks = 0; ks < 8; ++ks) { const bf16x8 qa = *(const LAS bf16x8*)(base + QT_OFF + row_read_addr(lane, ks));
            const bf16x8 kb = *(const LAS bf16x8*)(base + KT_OFF + row_read_addr(lane, ks));
            X = __builtin_amdgcn_mfma_f32_32x32x16_bf16(qa, kb, X, 0, 0, 0); }
#pragma unroll
        for (int r = 0; r < 16; ++r) { const int t = crow(r, hi); const bool keep = ch ? (t <= r32) : (t >= r32); *(LAS bf16_t*)(Pw + t * RS2 + r32 * 2) = f2bf(keep ? X[r] : 0.f); }
        s16x4 vl[2], vh[2];
#pragma unroll
        for (int ks = 0; ks < 2; ++ks) { vl[ks] = tr_rd(lbase + V_OFF + tr_read_addr(lane, w, ks, 0)); vh[ks] = tr_rd(lbase + V_OFF + tr_read_addr(lane, w, ks, 1)); }
        asm volatile("s_waitcnt lgkmcnt(0)" ::: "memory"); __builtin_amdgcn_sched_barrier(0);
        bf16x8 vb[2];
#pragma unroll
        for (int ks = 0; ks < 2; ++ks) vb[ks] = TRPK(vl[ks], vh[ks]);
        f32x16 O = f32x16{};
#pragma unroll
        for (int ks = 0; ks < 2; ++ks) { const bf16x8 pa = *(const LAS bf16x8*)(Pw + r32 * RS2 + (16 * ks + 8 * hi) * 2);
            O = __builtin_amdgcn_mfma_f32_32x32x16_bf16(pa, vb[ks], O, 0, 0, 0); }
#pragma unroll
        for (int ks = 0; ks < 8; ++ks) { const bf16x8 sb = *(const LAS bf16x8*)(base + ST_OFF + vcol * RS + (16 * ks + 8 * hi) * 2);
            const bf16x8 qa = *(const LAS bf16x8*)(base + QT_OFF + row_read_addr(lane, ks));
            O = __builtin_amdgcn_mfma_f32_32x32x16_bf16(qa, sb, O, 0, 0, 0); }
#pragma unroll
        for (int r = 0; r < 16; ++r) { const int t = tok0 + 32 * cidx + crow(r, hi); odst[(size_t)t * 1024 + h * 128 + vcol] = f2bf(O[r]); }
#pragma unroll
        for (int kt2 = 0; kt2 < 4; ++kt2) {
            s16x4 al[2], ah[2];
#pragma unroll
            for (int ks = 0; ks < 2; ++ks) { al[ks] = tr_rd(lbase + KT_OFF + tr_read_addr(lane, kt2, ks, 0)); ah[ks] = tr_rd(lbase + KT_OFF + tr_read_addr(lane, kt2, ks, 1)); }
            asm volatile("s_waitcnt lgkmcnt(0)" ::: "memory"); __builtin_amdgcn_sched_barrier(0);
#pragma unroll
            for (int ks = 0; ks < 2; ++ks) S[kt2] = __builtin_amdgcn_mfma_f32_32x32x16_bf16(TRPK(al[ks], ah[ks]), vb[ks], S[kt2], 0, 0, 0);
#pragma unroll
            for (int g = 0; g < 4; ++g) { const f32x4 d4 = *(const LAS f32x4*)(base + DV_OFF + (32 * kt2 + 8 * g + 4 * hi) * 4);
#pragma unroll
                for (int e = 0; e < 4; ++e) S[kt2][4 * g + e] *= d4[e];
                u32x2 pk; pk.x = cvt_pk_bf16(S[kt2][4 * g], S[kt2][4 * g + 1]); pk.y = cvt_pk_bf16(S[kt2][4 * g + 2], S[kt2][4 * g + 3]);
                *(LAS u32x2*)(base + ST_OFF + vcol * RS + (32 * kt2 + 8 * g + 4 * hi) * 2) = pk; }
        }
        __syncthreads();
        if (ci + 1 < NC) SCAN_WRITE();
        __syncthreads();
    }
#undef SCAN_LOAD
#undef SCAN_WRITE
}
#undef TRPK
__device__ __forceinline__ void hgrn_scan(const Ctx& c, bool dummy) {
    const int NP = 16 + 256;
    for (int rnd = 0;; ++rnd) {
        const int p = (rnd & 1) ? (rnd * c.G + (c.G - 1 - c.bid)) : (rnd * c.G + c.bid);
        if (rnd * c.G >= NP) break;
        if (p < NP) {
            const int tok0 = p < 16 ? (p >> 3) * SP : TP + ((p - 16) >> 3) * SS, L = p < 16 ? SP : SS, h = p < 16 ? (p & 7) : ((p - 16) & 7);
            run_pair(c, tok0, L, h, dummy);
        }
    }
}
}
#define CE_(a, i, j) { const unsigned _x = a[i] > a[j] ? a[i] : a[j], _y = a[i] > a[j] ? a[j] : a[i]; a[i] = _x; a[j] = _y; }
__device__ __forceinline__ void sort16_desc(unsigned (&a)[16]) {
    CE_(a, 0, 1) CE_(a, 2, 3) CE_(a, 0, 2) CE_(a, 1, 3) CE_(a, 1, 2) CE_(a, 4, 5) CE_(a, 6, 7) CE_(a, 4, 6) CE_(a, 5, 7) CE_(a, 5, 6) CE_(a, 0, 4) CE_(a, 2, 6) CE_(a, 2, 4) CE_(a, 1, 5) CE_(a, 3, 7) CE_(a, 3, 5) CE_(a, 1, 2) CE_(a, 3, 4) CE_(a, 5, 6) CE_(a, 8, 9) CE_(a, 10, 11) CE_(a, 8, 10) CE_(a, 9, 11) CE_(a, 9, 10) CE_(a, 12, 13) CE_(a, 14, 15) CE_(a, 12, 14) CE_(a, 13, 15) CE_(a, 13, 14) CE_(a, 8, 12) CE_(a, 10, 14) CE_(a, 10, 12) CE_(a, 9, 13) CE_(a, 11, 15) CE_(a, 11, 13) CE_(a, 9, 10) CE_(a, 11, 12) CE_(a, 13, 14) CE_(a, 0, 8) CE_(a, 4, 12) CE_(a, 4, 8) CE_(a, 2, 10) CE_(a, 6, 14) CE_(a, 6, 10) CE_(a, 2, 4) CE_(a, 6, 8) CE_(a, 10, 12) CE_(a, 1, 9) CE_(a, 5, 13) CE_(a, 5, 9) CE_(a, 3, 11) CE_(a, 7, 15) CE_(a, 7, 11) CE_(a, 3, 5) CE_(a, 7, 9) CE_(a, 11, 13) CE_(a, 1, 2) CE_(a, 3, 4) CE_(a, 5, 6) CE_(a, 7, 8) CE_(a, 9, 10) CE_(a, 11, 12) CE_(a, 13, 14)
}
__device__ __forceinline__ void merge16_top(unsigned (&a)[16], const unsigned (&b)[16]) {
    a[0] = a[0] > b[15] ? a[0] : b[15]; a[1] = a[1] > b[14] ? a[1] : b[14]; a[2] = a[2] > b[13] ? a[2] : b[13]; a[3] = a[3] > b[12] ? a[3] : b[12]; a[4] = a[4] > b[11] ? a[4] : b[11]; a[5] = a[5] > b[10] ? a[5] : b[10]; a[6] = a[6] > b[9] ? a[6] : b[9]; a[7] = a[7] > b[8] ? a[7] : b[8]; a[8] = a[8] > b[7] ? a[8] : b[7]; a[9] = a[9] > b[6] ? a[9] : b[6]; a[10] = a[10] > b[5] ? a[10] : b[5]; a[11] = a[11] > b[4] ? a[11] : b[4]; a[12] = a[12] > b[3] ? a[12] : b[3]; a[13] = a[13] > b[2] ? a[13] : b[2]; a[14] = a[14] > b[1] ? a[14] : b[1]; a[15] = a[15] > b[0] ? a[15] : b[0];
    CE_(a, 0, 8) CE_(a, 1, 9) CE_(a, 2, 10) CE_(a, 3, 11) CE_(a, 4, 12) CE_(a, 5, 13) CE_(a, 6, 14) CE_(a, 7, 15) CE_(a, 0, 4) CE_(a, 1, 5) CE_(a, 2, 6) CE_(a, 3, 7) CE_(a, 8, 12) CE_(a, 9, 13) CE_(a, 10, 14) CE_(a, 11, 15) CE_(a, 0, 2) CE_(a, 1, 3) CE_(a, 4, 6) CE_(a, 5, 7) CE_(a, 8, 10) CE_(a, 9, 11) CE_(a, 12, 14) CE_(a, 13, 15) CE_(a, 0, 1) CE_(a, 2, 3) CE_(a, 4, 5) CE_(a, 6, 7) CE_(a, 8, 9) CE_(a, 10, 11) CE_(a, 12, 13) CE_(a, 14, 15)
}
namespace peer {
constexpr int KEY_RS = 272;
constexpr int KEYS_BYTES = 2 * 128 * KEY_RS;
constexpr int SI_OFF = KEYS_BYTES;
__device__ __forceinline__ int crow(int r, int hi) { return (r & 3) + 8 * (r >> 2) + 4 * hi; }
__device__ __forceinline__ unsigned sortable(float f) { const unsigned u = __float_as_uint(f); return u ^ ((u >> 31) ? 0xFFFFFFFFu : 0x80000000u); }
__device__ __forceinline__ float unsortable(unsigned s) { const unsigned u = (s >> 31) ? (s ^ 0x80000000u) : ~s; return __uint_as_float(u); }
__device__ __forceinline__ unsigned pair_max(unsigned m) { auto rr = __builtin_amdgcn_permlane32_swap(m, m, false, false); return rr[0] > rr[1] ? rr[0] : rr[1]; }

__device__ __forceinline__ void top16_half(const Ctx& c, const bf16_t* pq_rows, int half, LAS unsigned char* keys, unsigned (&sel)[16]) {
    const int lane = c.lane, r32 = lane & 31, hi = lane >> 5;
    f32x16 acc[4];
#pragma unroll
    for (int nt = 0; nt < 4; ++nt) acc[nt] = f32x16{};
    const bf16_t* qrow = pq_rows + (size_t)r32 * 256 + half * 128;
#pragma unroll 1
    for (int ks = 0; ks < 8; ++ks) { const bf16x8 qb = *reinterpret_cast<const bf16x8*>(qrow + 16 * ks + 8 * hi);
#pragma unroll
        for (int nt = 0; nt < 4; ++nt) { const bf16x8 ka = *(const LAS bf16x8*)(keys + (half * 128 + 32 * nt + r32) * KEY_RS + (16 * ks + 8 * hi) * 2);
            acc[nt] = __builtin_amdgcn_mfma_f32_32x32x16_bf16(ka, qb, acc[nt], 0, 0, 0); } }
    unsigned p[64];
#pragma unroll
    for (int nt = 0; nt < 4; ++nt)
#pragma unroll
        for (int r = 0; r < 16; ++r) { const int n = 32 * nt + crow(r, hi); p[nt * 16 + r] = (sortable(acc[nt][r]) & ~127u) | (unsigned)(127 - n); }
    unsigned g0[16], g1[16], g2[16], g3[16];
#pragma unroll
    for (int i = 0; i < 16; ++i) { g0[i] = p[i]; g1[i] = p[16 + i]; g2[i] = p[32 + i]; g3[i] = p[48 + i]; }
    sort16_desc(g0); sort16_desc(g1); sort16_desc(g2); sort16_desc(g3);
    merge16_top(g0, g1); merge16_top(g2, g3); merge16_top(g0, g2);
    unsigned pb[16];
#pragma unroll
    for (int i = 0; i < 16; ++i) { auto rr = __builtin_amdgcn_permlane32_swap(g0[i], g0[i], false, false); sel[i] = rr[0]; pb[i] = rr[1]; }
    merge16_top(sel, pb);
}
__device__ __forceinline__ void route(const Ctx& c, int layer) {
    const bf16_t* pq = (const bf16_t*)(c.ws + B_PQ); int* idx_out = (int*)(c.ws + R2_IDX); float* gate_out = (float*)(c.ws + R2_GATE);
    const bf16_t* keys_g = (const bf16_t*)(c.ws + W_KEYS) + (size_t)layer * 2 * 128 * 128;
    LAS unsigned char* keys = c.lds;
    const int lane = c.lane, r32 = lane & 31, hi = lane >> 5;
    for (int i = c.tid; i < 2 * 128 * 16; i += NTHR) { const int row = i >> 4, ch = i & 15; *(LAS u32x4*)(keys + row * KEY_RS + ch * 16) = *(const u32x4*)(keys_g + (size_t)row * 128 + ch * 8); }
    __syncthreads();
    LAS int* si = (LAS int*)(c.lds + SI_OFF + c.wave * 4096) + r32 * 32;
    for (int grp = c.gw; grp < T / 4; grp += c.NGW) {
        const bf16_t* rows = pq + (size_t)grp * 4 * 2048;
        unsigned s1[16], s2[16];
        top16_half(c, rows, 0, keys, s1);
        top16_half(c, rows, 1, keys, s2);
        float v1[16], v2[16];
#pragma unroll
        for (int i = 0; i < 16; ++i) { v1[i] = unsortable(s1[i] & ~127u); v2[i] = unsortable(s2[i] & ~127u); }
        if (hi == 0) {
#pragma unroll
            for (int i = 0; i < 16; ++i) { si[i] = 127 - (int)(s1[i] & 127u); si[16 + i] = 127 - (int)(s2[i] & 127u); }
        }
        float A[16], B[16];
#pragma unroll
        for (int i = 0; i < 16; ++i) { A[i] = hi ? v2[i] : v1[i]; B[i] = hi ? v1[i] : v2[i]; }
        unsigned cd[27]; int nc = 0;
#pragma unroll
        for (int i = 0; i < 16; ++i)
#pragma unroll
            for (int j = i; j < 16; ++j) if ((i + 1) * (j + 1) <= 16) {
                const unsigned flat = hi ? (unsigned)(j * 16 + i) : (unsigned)(i * 16 + j);
                unsigned pk = (sortable(A[i] + B[j]) & ~255u) | (255u - flat);
                if (i == j) pk = hi ? 0u : pk;
                cd[nc++] = pk; }
        unsigned sel[16], c1[16], pb[16];
#pragma unroll
        for (int i = 0; i < 16; ++i) { sel[i] = cd[i]; c1[i] = (16 + i < 27) ? cd[(16 + i < 27) ? 16 + i : 0] : 0u; }
        sort16_desc(sel); sort16_desc(c1); merge16_top(sel, c1);
#pragma unroll
        for (int i = 0; i < 16; ++i) { auto rr = __builtin_amdgcn_permlane32_swap(sel[i], sel[i], false, false); sel[i] = rr[0]; pb[i] = rr[1]; }
        merge16_top(sel, pb);
        LDS_WAIT(); asm volatile("" ::: "memory");
        const float vmax = unsortable(sel[0] & ~255u);
        float e[16], es = 0.f;
#pragma unroll
        for (int i = 0; i < 16; ++i) { e[i] = fast_exp(unsortable(sel[i] & ~255u) - vmax); es += e[i]; }
        const float inv = 1.0f / es;
        const size_t obase = ((size_t)grp * 4 + (r32 >> 3)) * 128 + (r32 & 7) * 16 + 8 * hi;
        int oi[8]; float og[8];
#pragma unroll
        for (int q = 0; q < 8; ++q) { const unsigned sv = hi ? sel[8 + q] : sel[q]; const float ev = hi ? e[8 + q] : e[q];
            const int flat = 255 - (int)(sv & 255u); oi[q] = si[flat >> 4] * 128 + si[16 + (flat & 15)]; og[q] = ev * inv; }
        *(u32x4*)(idx_out + obase) = (u32x4){(unsigned)oi[0], (unsigned)oi[1], (unsigned)oi[2], (unsigned)oi[3]};
        *(u32x4*)(idx_out + obase + 4) = (u32x4){(unsigned)oi[4], (unsigned)oi[5], (unsigned)oi[6], (unsigned)oi[7]};
        *(f32x4*)(gate_out + obase) = (f32x4){og[0], og[1], og[2], og[3]};
        *(f32x4*)(gate_out + obase + 4) = (f32x4){og[4], og[5], og[6], og[7]};
        LDS_WAIT(); asm volatile("" ::: "memory");
    }
    __syncthreads();
}

__device__ __forceinline__ float gelu_exact(float x) { return 0.5f * x * (1.0f + erff(x * 0.70710678118654752f)); }
template <int IDXMASK> __device__ __forceinline__ void gather_ln(const Ctx& c, int layer, float* xout, bf16_t* xb) {
    const unsigned char* U8 = c.ws + R2_UB; const unsigned char* V8 = c.ws + R2_VB;
    const float* su = (const float*)(c.ws + R2_SU); const float* sv = (const float*)(c.ws + R2_SV);
    const int* idx = (const int*)(c.ws + R2_IDX); const float* gate = (const float*)(c.ws + R2_GATE);
    const float* lg = c.in(20) + layer * D; const float* lbv = c.in(21) + layer * D;
    const int lane = c.lane;
    for (int t = c.gw; t < T; t += c.NGW) {
        const float* xr = c.out + (size_t)t * D + 16 * lane; float* xw = xout + (size_t)t * D + 16 * lane;
        float x[16], acc[16];
#pragma unroll
        for (int j = 0; j < 4; ++j) { const f32x4 a = *(const f32x4*)(xr + 4 * j); x[4 * j] = a[0]; x[4 * j + 1] = a[1]; x[4 * j + 2] = a[2]; x[4 * j + 3] = a[3]; }
#pragma unroll
        for (int e = 0; e < 16; ++e) acc[e] = 0.f;
        const int myidx0 = idx[(size_t)t * 128 + lane] & IDXMASK, myidx1 = idx[(size_t)t * 128 + 64 + lane] & IDXMASK;
        const float myg0 = gate[(size_t)t * 128 + lane], myg1 = gate[(size_t)t * 128 + 64 + lane];
        for (int eb = 0; eb < 128; eb += 8) {
            float part[8]; int ei[8];
#pragma unroll
            for (int q = 0; q < 8; ++q) { const int e = eb + q; ei[q] = __builtin_amdgcn_readlane(e < 64 ? myidx0 : myidx1, e & 63); }
            u32x4 vr[8];
#pragma unroll
            for (int q = 0; q < 8; ++q) vr[q] = *(const u32x4*)(V8 + (size_t)ei[q] * D + 16 * lane);
#pragma unroll
            for (int q = 0; q < 8; ++q) { const u32x4 a = *(const u32x4*)(U8 + (size_t)ei[q] * D + 16 * lane);
                float s = 0.f;
#pragma unroll
                for (int j = 0; j < 4; ++j) { const f32x2 lo = __builtin_amdgcn_cvt_pk_f32_fp8((int)a[j], false), hi = __builtin_amdgcn_cvt_pk_f32_fp8((int)a[j], true);
                    s = fmaf(lo[0], x[4 * j], s); s = fmaf(lo[1], x[4 * j + 1], s); s = fmaf(hi[0], x[4 * j + 2], s); s = fmaf(hi[1], x[4 * j + 3], s); }
                part[q] = s; }
            float r4[4], r2[2], r1;
            { const bool up = (lane & 32) != 0;
#pragma unroll
              for (int i = 0; i < 4; ++i) { const float send = up ? part[i] : part[4 + i]; const float keep = up ? part[4 + i] : part[i]; r4[i] = keep + __shfl_xor(send, 32); } }
            { const bool up = (lane & 16) != 0;
#pragma unroll
              for (int i = 0; i < 2; ++i) { const float send = up ? r4[i] : r4[2 + i]; const float keep = up ? r4[2 + i] : r4[i]; r2[i] = keep + __shfl_xor(send, 16); } }
            { const bool up = (lane & 8) != 0; const float send = up ? r2[0] : r2[1]; const float keep = up ? r2[1] : r2[0]; r1 = keep + __shfl_xor(send, 8); }
            r1 += __shfl_xor(r1, 4); r1 += __shfl_xor(r1, 2); r1 += __shfl_xor(r1, 1);
            const int myq = ((lane >> 5) & 1) * 4 + ((lane >> 4) & 1) * 2 + ((lane >> 3) & 1);
            const int me = eb + myq;
            const float g = __shfl(me < 64 ? myg0 : myg1, me & 63);
            const int mye = __shfl(me < 64 ? myidx0 : myidx1, me & 63);
            const float cf = g * gelu_exact(r1 * su[mye]) * sv[mye];
            float cq[8];
#pragma unroll
            for (int q = 0; q < 8; ++q) cq[q] = __int_as_float(__builtin_amdgcn_readlane(__float_as_int(cf), ((q >> 2) & 1) * 32 + ((q >> 1) & 1) * 16 + (q & 1) * 8));
#pragma unroll
            for (int q = 0; q < 8; ++q) { const float s = cq[q];
#pragma unroll
                for (int j = 0; j < 4; ++j) { const f32x2 lo = __builtin_amdgcn_cvt_pk_f32_fp8((int)vr[q][j], false), hi = __builtin_amdgcn_cvt_pk_f32_fp8((int)vr[q][j], true);
                    acc[4 * j] = fmaf(s, lo[0], acc[4 * j]); acc[4 * j + 1] = fmaf(s, lo[1], acc[4 * j + 1]); acc[4 * j + 2] = fmaf(s, hi[0], acc[4 * j + 2]); acc[4 * j + 3] = fmaf(s, hi[1], acc[4 * j + 3]); } }
        }
        float s = 0.f;
#pragma unroll
        for (int e = 0; e < 16; ++e) { acc[e] = fmaf(DN_ALPHA, x[e], acc[e]); s += acc[e]; }
        const float mean = wave_sum(s) * (1.0f / D); float s2 = 0.f;
#pragma unroll
        for (int e = 0; e < 16; ++e) { acc[e] -= mean; s2 += acc[e] * acc[e]; }
        const float rstd = 1.0f / sqrtf(wave_sum(s2) * (1.0f / D) + LN_EPS);
        float o[16];
#pragma unroll
        for (int j = 0; j < 4; ++j) { const f32x4 g4 = *(const f32x4*)(lg + 16 * lane + 4 * j), b4 = *(const f32x4*)(lbv + 16 * lane + 4 * j);
#pragma unroll
            for (int e = 0; e < 4; ++e) o[4 * j + e] = acc[4 * j + e] * rstd * g4[e] + b4[e];
            *(f32x4*)(xw + 4 * j) = (f32x4){o[4 * j], o[4 * j + 1], o[4 * j + 2], o[4 * j + 3]}; }
        u32x4 w0, w1; w0.x = cvt_pk_bf16(o[0], o[1]); w0.y = cvt_pk_bf16(o[2], o[3]); w0.z = cvt_pk_bf16(o[4], o[5]); w0.w = cvt_pk_bf16(o[6], o[7]);
        w1.x = cvt_pk_bf16(o[8], o[9]); w1.y = cvt_pk_bf16(o[10], o[11]); w1.z = cvt_pk_bf16(o[12], o[13]); w1.w = cvt_pk_bf16(o[14], o[15]);
        *(u32x4*)(xb + (size_t)t * D + 16 * lane) = w0; *(u32x4*)(xb + (size_t)t * D + 16 * lane + 8) = w1;
    }
}
}
namespace peer {
constexpr size_t HP_OFF = WS_BIG;
constexpr int QW_BASE = 4096;
constexpr int ITEM_TOK = 128, NBLK = T / ITEM_TOK;
constexpr int GT = 1;
#define DPP_F(v, ctrl) __int_as_float(__builtin_amdgcn_update_dpp(0, __float_as_int(v), (ctrl), 0xf, 0xf, true))

template <class F> __device__ __forceinline__ void for_items(const Ctx& c, int layer, int phase, F body) {
    unsigned* qw = (unsigned*)(c.ws + WS_CTL) + QW_BASE + (size_t)((layer * 2 + phase) * 8) * 16;
    volatile LAS int* slot = (volatile LAS int*)(c.lds + LDS_MISC_OFF + 128);
    const int home = (int)(xb_xcc_id() & 7u);
    for (int k = 0; k < 8; ++k) {
        const int s = (home + k) & 7;
        if (c.tid == 0) slot[0] = (int)__hip_atomic_fetch_add(qw + s * 16, 1u, __ATOMIC_RELAXED, __HIP_MEMORY_SCOPE_AGENT);
        __syncthreads();
        int cur = slot[0];
        __syncthreads();
        while (cur < NBLK) {
            if (c.tid == 0) slot[0] = (int)__hip_atomic_fetch_add(qw + s * 16, 1u, __ATOMIC_RELAXED, __HIP_MEMORY_SCOPE_AGENT);
            body(s, cur);
            __syncthreads();
            cur = slot[0];
            __syncthreads();
        }
    }
}

__device__ __forceinline__ void g1_udot(const Ctx& c, int layer) {
    const unsigned char* U8 = c.ws + R2_UB; const int* idx = (const int*)(c.ws + R2_IDX); float* hp = (float*)(c.ws + HP_OFF);
    for_items(c, layer, 0, [&](int s, int blk) {
        int lane = c.lane; asm volatile("" : "+v"(lane));
        const int g = lane >> 3, c8 = lane & 7;
        const int co = 128 * s + 16 * c8;
#pragma unroll 1
        for (int i = 0; i < ITEM_TOK / NWAVES; i += GT) {
            const int t0 = blk * ITEM_TOK + c.wave * (ITEM_TOK / NWAVES) + i;
            float x[GT][16]; int id[GT][16];
#pragma unroll
            for (int u = 0; u < GT; ++u)
#pragma unroll
            for (int j = 0; j < 4; ++j) { const u32x2 a = *(const u32x2*)((const bf16_t*)(c.ws + WS_XB) + (size_t)(t0 + u) * D + co + 4 * j); x[u][4 * j] = bflo(a.x); x[u][4 * j + 1] = bfhi(a.x); x[u][4 * j + 2] = bflo(a.y); x[u][4 * j + 3] = bfhi(a.y);
                const u32x4 q = *(const u32x4*)(idx + (size_t)(t0 + u) * 128 + 16 * g + 4 * j); id[u][4 * j] = (int)q[0]; id[u][4 * j + 1] = (int)q[1]; id[u][4 * j + 2] = (int)q[2]; id[u][4 * j + 3] = (int)q[3]; }
            u32x4 row[GT][16];
#pragma unroll
            for (int u = 0; u < GT; ++u)
#pragma unroll
            for (int j = 0; j < 16; ++j) row[u][j] = *(const u32x4*)(U8 + (size_t)id[u][j] * D + co);
#pragma unroll
            for (int u = 0; u < GT; ++u) {
            float V[16];
#pragma unroll
            for (int j = 0; j < 16; ++j) { float acc = 0.f;
#pragma unroll
                for (int q = 0; q < 4; ++q) { const f32x2 lo = __builtin_amdgcn_cvt_pk_f32_fp8((int)row[u][j][q], false), hi = __builtin_amdgcn_cvt_pk_f32_fp8((int)row[u][j][q], true);
                    acc = fmaf(lo[0], x[u][4 * q], acc); acc = fmaf(lo[1], x[u][4 * q + 1], acc); acc = fmaf(hi[0], x[u][4 * q + 2], acc); acc = fmaf(hi[1], x[u][4 * q + 3], acc); }
                V[j] = acc; }
            float W[8], Y[4], Z[2];
            { const bool hiA = (lane & 4) != 0;
#pragma unroll
              for (int m = 0; m < 8; ++m) { const float send = hiA ? V[m] : V[8 + m], keep = hiA ? V[8 + m] : V[m]; W[m] = keep + DPP_F(send, 0x141); } }
            { const bool hiB = (lane & 2) != 0;
#pragma unroll
              for (int m = 0; m < 4; ++m) { const float send = hiB ? W[m] : W[4 + m], keep = hiB ? W[4 + m] : W[m]; Y[m] = keep + DPP_F(send, 0x1B); } }
            { const bool hiC = (lane & 1) != 0;
#pragma unroll
              for (int m = 0; m < 2; ++m) { const float send = hiC ? Y[m] : Y[2 + m], keep = hiC ? Y[2 + m] : Y[m]; Z[m] = keep + DPP_F(send, 0xB1); } }
            *(f32x2*)(hp + ((size_t)s * T + t0 + u) * 128 + 16 * g + 2 * c8) = (f32x2){Z[0], Z[1]};
            }
        }
    });
}
__device__ __forceinline__ void g2_coef(const Ctx& c) {
    const int* idx = (const int*)(c.ws + R2_IDX); float* gate = (float*)(c.ws + R2_GATE); const float* hp = (const float*)(c.ws + HP_OFF);
    const float* su = (const float*)(c.ws + R2_SU); const float* sv = (const float*)(c.ws + R2_SV);
    const int lane = c.lane;
    for (int t = c.gw; t < T; t += c.NGW) {
#pragma unroll
        for (int k = 0; k < 2; ++k) { const int p = lane + 64 * k; float h = 0.f;
#pragma unroll
            for (int s = 0; s < 8; ++s) h += hp[((size_t)s * T + t) * 128 + p];
            const int e = idx[(size_t)t * 128 + p]; const float gt = gate[(size_t)t * 128 + p];
            gate[(size_t)t * 128 + p] = gt * gelu_exact(h * su[e]) * sv[e]; }
    }
}
__device__ __forceinline__ void g3_vaxpy(const Ctx& c, int layer) {
    const unsigned char* V8 = c.ws + R2_VB; const int* idx = (const int*)(c.ws + R2_IDX); const float* coef = (const float*)(c.ws + R2_GATE);
    for_items(c, layer, 1, [&](int s, int blk) {
        int lane = c.lane; asm volatile("" : "+v"(lane));
        const int g = lane >> 3, c8 = lane & 7;
        const int co = 128 * s + 16 * c8;
#pragma unroll 1
        for (int i = 0; i < ITEM_TOK / NWAVES; i += GT) {
            const int t0 = blk * ITEM_TOK + c.wave * (ITEM_TOK / NWAVES) + i;
            float cf[GT][16]; int id[GT][16];
#pragma unroll
            for (int u = 0; u < GT; ++u)
#pragma unroll
            for (int j = 0; j < 4; ++j) { const f32x4 a = *(const f32x4*)(coef + (size_t)(t0 + u) * 128 + 16 * g + 4 * j); cf[u][4 * j] = a[0]; cf[u][4 * j + 1] = a[1]; cf[u][4 * j + 2] = a[2]; cf[u][4 * j + 3] = a[3];
                const u32x4 q = *(const u32x4*)(idx + (size_t)(t0 + u) * 128 + 16 * g + 4 * j); id[u][4 * j] = (int)q[0]; id[u][4 * j + 1] = (int)q[1]; id[u][4 * j + 2] = (int)q[2]; id[u][4 * j + 3] = (int)q[3]; }
            u32x4 row[GT][16];
#pragma unroll
            for (int u = 0; u < GT; ++u)
#pragma unroll
            for (int j = 0; j < 16; ++j) row[u][j] = *(const u32x4*)(V8 + (size_t)id[u][j] * D + co);
#pragma unroll
            for (int u = 0; u < GT; ++u) {
            float A[16];
#pragma unroll
            for (int e = 0; e < 16; ++e) A[e] = 0.f;
#pragma unroll
            for (int j = 0; j < 16; ++j) { const float sc = cf[u][j];
#pragma unroll
                for (int q = 0; q < 4; ++q) { const f32x2 lo = __builtin_amdgcn_cvt_pk_f32_fp8((int)row[u][j][q], false), hi = __builtin_amdgcn_cvt_pk_f32_fp8((int)row[u][j][q], true);
                    A[4 * q] = fmaf(sc, lo[0], A[4 * q]); A[4 * q + 1] = fmaf(sc, lo[1], A[4 * q + 1]); A[4 * q + 2] = fmaf(sc, hi[0], A[4 * q + 2]); A[4 * q + 3] = fmaf(sc, hi[1], A[4 * q + 3]); } }
            float R[8], S2[4], Y[2];
#pragma unroll
            for (int m = 0; m < 8; ++m) { auto rr = __builtin_amdgcn_permlane32_swap(__float_as_uint(A[m]), __float_as_uint(A[8 + m]), false, false); R[m] = __uint_as_float(rr[0]) + __uint_as_float(rr[1]); }
#pragma unroll
            for (int m = 0; m < 4; ++m) { auto rr = __builtin_amdgcn_permlane16_swap(__float_as_uint(R[m]), __float_as_uint(R[4 + m]), false, false); S2[m] = __uint_as_float(rr[0]) + __uint_as_float(rr[1]); }
            { const bool hi8 = (lane & 8) != 0;
#pragma unroll
              for (int m = 0; m < 2; ++m) { const float send = hi8 ? S2[m] : S2[2 + m], keep = hi8 ? S2[2 + m] : S2[m]; Y[m] = keep + DPP_F(send, 0x128); } }
            const size_t yo = (size_t)(t0 + u) * D + co + 8 * ((lane >> 5) & 1) + 4 * ((lane >> 4) & 1) + 2 * ((lane >> 3) & 1);
            const unsigned xo = *(const unsigned*)((const bf16_t*)(c.ws + WS_XB) + yo);
            *(unsigned*)((bf16_t*)c.out + yo) = cvt_pk_bf16(fmaf(DN_ALPHA, bflo(xo), Y[0]), fmaf(DN_ALPHA, bfhi(xo), Y[1]));
            }
        }
    });
}
__device__ __forceinline__ void ln_pass(const Ctx& c, const float* g, const float* b) {
    const bf16_t* ym = (const bf16_t*)c.out; bf16_t* xa = (bf16_t*)(c.ws + WS_XB); const int lane = c.lane;
    for (int t = c.gw; t < T; t += c.NGW) {
        const bf16_t* yr = ym + (size_t)t * D;
        f32x4 v[4]; float s = 0.f;
#pragma unroll
        for (int j = 0; j < 4; ++j) { const u32x2 w = *(const u32x2*)(yr + 256 * j + 4 * lane); v[j] = (f32x4){bflo(w.x), bfhi(w.x), bflo(w.y), bfhi(w.y)}; s += (v[j][0] + v[j][1]) + (v[j][2] + v[j][3]); }
        const float mean = wave_sum(s) * (1.0f / D); float s2 = 0.f;
#pragma unroll
        for (int j = 0; j < 4; ++j) { v[j] = v[j] - mean; s2 += (v[j][0] * v[j][0] + v[j][1] * v[j][1]) + (v[j][2] * v[j][2] + v[j][3] * v[j][3]); }
        const float rstd = 1.0f / sqrtf(wave_sum(s2) * (1.0f / D) + LN_EPS);
#pragma unroll
        for (int j = 0; j < 4; ++j) { const f32x4 gg = *(const f32x4*)(g + 256 * j + 4 * lane), bb = *(const f32x4*)(b + 256 * j + 4 * lane); const f32x4 o = v[j] * rstd * gg + bb;
            u32x2 w; w.x = cvt_pk_bf16(o[0], o[1]); w.y = cvt_pk_bf16(o[2], o[3]); *(u32x2*)(xa + (size_t)t * D + 256 * j + 4 * lane) = w; }
    }
}
#undef DPP_F
}
__global__ void __launch_bounds__(256) k_checksum(const unsigned* p, size_t nwords, unsigned long long* dst) {
    unsigned long long acc = 0;
    for (size_t i = (size_t)blockIdx.x * 256 + threadIdx.x; i < nwords; i += (size_t)gridDim.x * 256) acc += (unsigned long long)p[i] * (unsigned long long)(2 * i + 1);
    for (int o = 32; o >= 1; o >>= 1) acc += __shfl_xor(acc, o);
    if ((threadIdx.x & 63) == 0) atomicAdd(dst, acc);
}
__global__ void __launch_bounds__(256) k_zero_out(float* out, size_t n) { for (size_t i = (size_t)blockIdx.x * 256 + threadIdx.x; i < n; i += (size_t)gridDim.x * 256) out[i] = 0.f; }
__global__ void k_report(const unsigned long long* tab, int nent, float* out) {
    if (threadIdx.x == 0 && blockIdx.x == 0) { int first = -1; for (int i = 0; i < nent; ++i) if (tab[i] != tab[nent + i]) { first = i; break; }
        out[0] = first < 0 ? 99000.f : 1000.f * (float)(first / 4 + 1); out[1] = first < 0 ? 0.f : (float)(first % 4); }
}
struct Reg { size_t off; size_t bytes; int in_out; };
static int phase_regions(int p, Reg* r) {
    int n = 0;
    auto add = [&](size_t off, size_t mib) { r[n].off = off; r[n].bytes = mib * MiB; r[n].in_out = 0; ++n; };
    auto addout = [&]() { r[n].off = 0; r[n].bytes = (size_t)T * D * 4; r[n].in_out = 1; ++n; };
    if (p == 0) { add(WS_W, 61); add(WS_R2, 160); addout(); return n; }
    int q = p - 1;
    for (int layer = 0; layer < NL; ++layer) {
        const int nm = (layer & 1) ? 5 : 7;
        if (q < nm) {
            if ((layer & 1) == 0) { switch (q) { case 0: add(B_A32, 240); break; case 1: add(R2_UB, 34); add(R2_PB, 40); add(B_CQN, 100); add(B_KROPE, 10); break; case 2: add(B_Q, 240); break; case 3: add(B_KV, 320); break;
                case 4: add(B_Q, 240); break; case 5: add(B_O, 160); break; case 6: add(B_H32_MLA, 320); break; } }
            else { switch (q) { case 0: add(B_PLANE, 800); break; case 1: add(R2_UB, 34); add(R2_PB, 40); break; case 2: add(B_PLANE + 160 * MiB, 320); break; case 3: add(B_PLANE, 160); break; case 4: add(B_H32_HGRN, 320); break; } }
            return n;
        }
        q -= nm;
        if (q < 6) { switch (q) { case 0: addout(); add(WS_XB, 160); break; case 1: add(B_PQ, 320); break; case 2: add(R2_IDX, 80); break; case 3: addout(); add(WS_XB, 160); break; case 4: add(B_PP, 160); break; case 5: addout(); add(WS_R2, 160); break; }
            return n; }
        q -= 6;
    }
    return n;
}
constexpr int N_PHASES = 1 + 2 * (6 + 8) + 2 * (5 + 8);

#ifndef PROBE_DUP
#define PROBE_DUP 0
#endif
#define PROBE_REP(bit, ...) if constexpr ((PROBE_DUP & (bit)) != 0) { __VA_ARGS__ }
template <class E> struct RepOk { static constexpr bool v = true; };
template <> struct RepOk<pg8::EpiPle> { static constexpr bool v = false; };
#define GEMM_REP_OK(EPI) RepOk<pg8::EPI>::v
#define GEMM_PHASE(EPI, Aptr, Bptr, NN, KK, ...) { pg8::Gemm g{(const bf16_t*)(Aptr), (const bf16_t*)(Bptr), T, (NN), (KK)}; pg8::StaticOrder S; S.init(T, (NN), c.G, c.bid); \
        pg8::EPI E{__VA_ARGS__}; pg8::gemm_phase<pg8::EPI, pg8::StaticOrder>(c.lds, g, S, E, c.tid); if (GEMM_REP_OK(EPI)) { PROBE_REP(8, __syncthreads(); pg8::gemm_phase<pg8::EPI, pg8::StaticOrder>(c.lds, g, S, E, c.tid);) } }

__global__ void __launch_bounds__(NTHR, 2) fwd_kernel(Args args) {
    extern __shared__ __attribute__((aligned(16))) unsigned char lds_raw[];
    volatile LAS unsigned* misc = (volatile LAS unsigned*)((LAS unsigned char*)lds_raw + LDS_MISC_OFF);
    if (threadIdx.x < 64) misc[threadIdx.x] = 0u;
    __syncthreads();
    const int wave_s = __builtin_amdgcn_readfirstlane((int)threadIdx.x >> 6);
    const int lo = args.ph_lo, hi = args.ph_hi;
    XcdBarrier bar; bar.bar = (unsigned*)(args.ws + WS_CTL); bar.x = 0; bar.st = nullptr;
    if (hi - lo > 1) bar = xcd_barrier_post((unsigned*)(args.ws + WS_CTL), misc + 8);
    int ph = 0;
#define PH_BEGIN if (ph >= lo && ph < hi) { const Ctx c = mk_ctx(lds_raw, wave_s); unsigned char* const ws = c.ws; (void)ws;
#define PH_END   if (ph + 1 < hi) xcd_barrier(bar); } ++ph;

    PH_BEGIN p0_prologue(c); PH_END

    for (int layer = 0; layer < NL; ++layer) {
        const int j = layer >> 1;
        if ((layer & 1) == 0) {
            PH_BEGIN GEMM_PHASE(EpiF32, c.out, (const bf16_t*)(ws + W_WA) + (size_t)j * 768 * 1024, 768, 1024, (float*)(ws + B_A32), 768) PH_END
            PH_BEGIN l0_convert(c, layer); mla_e1(c, j); PH_END
            PH_BEGIN GEMM_PHASE(EpiBf16P, ws + B_CQN, (const bf16_t*)(ws + W_WUQ) + (size_t)j * 1536 * 384, 1536, 384, (bf16_t*)(ws + B_Q), 1536) PH_END
            PH_BEGIN GEMM_PHASE(EpiBf16P, ws + B_CKVN, (const bf16_t*)(ws + W_WUKV) + (size_t)j * 2048 * 256, 2048, 256, (bf16_t*)(ws + B_KV), 2048) PH_END
            PH_BEGIN mla_attention(c); PROBE_REP(1, mla_attention(c);) PH_END
            PH_BEGIN GEMM_PHASE(EpiBf16P, ws + B_O, (const bf16_t*)(ws + W_WO) + (size_t)j * 1024 * 1024, 1024, 1024, (bf16_t*)(ws + B_H32_MLA), 1024) PH_END
        } else {
            PH_BEGIN GEMM_PHASE(EpiHgrn, c.out, (const bf16_t*)(ws + W_HIN) + (size_t)j * 5120 * 1024, 5120, 1024, (bf16_t*)(ws + B_PLANE), (size_t)T * 1024, (const float*)(ws + WS_MISC) + (size_t)j * 2048) PH_END
            PH_BEGIN l0_convert(c, layer); scan::hgrn_prep(c); PH_END
            PH_BEGIN scan::hgrn_scan(c, false); PH_END
            PH_BEGIN hgrn_post(c, j); PH_END
            PH_BEGIN GEMM_PHASE(EpiBf16P, ws + B_PLANE, (const bf16_t*)(ws + W_HO) + (size_t)j * 1024 * 1024, 1024, 1024, (bf16_t*)(ws + B_H32_HGRN), 1024) PH_END
        }
        PH_BEGIN ln_residual(c, (const bf16_t*)(ws + ((layer & 1) ? B_H32_HGRN : B_H32_MLA)), c.in(18) + layer * D, c.in(19) + layer * D); PH_END
        PH_BEGIN GEMM_PHASE(EpiBf16P, ws + WS_XB, (const bf16_t*)(ws + W_PQ) + (size_t)layer * 2048 * 1024, 2048, 1024, (bf16_t*)(ws + B_PQ), 2048) PH_END
        PH_BEGIN peer::route(c, layer); PROBE_REP(2, peer::route(c, layer);) PH_END
        PH_BEGIN peer::g1_udot(c, layer); PH_END
        PH_BEGIN peer::g2_coef(c); PH_END
        PH_BEGIN peer::g3_vaxpy(c, layer); PH_END
        PH_BEGIN GEMM_PHASE(EpiBf16P, ws + R2_PB, (const bf16_t*)(ws + W_PP) + (size_t)layer * 1024 * 256, 1024, 256, (bf16_t*)(ws + B_PP), 1024) peer::ln_pass(c, c.in(20) + layer * D, c.in(21) + layer * D); PH_END
        PH_BEGIN GEMM_PHASE(EpiPle, ws + WS_XB, (const bf16_t*)(ws + W_GW) + (size_t)layer * 1024 * 1024, 1024, 1024, (const bf16_t*)(ws + WS_XB), (const bf16_t*)(ws + B_PP), c.in(23) + layer * D, (bf16_t*)c.out, (layer == NL - 1) ? c.out : (float*)nullptr) PH_END
    }
#undef PH_BEGIN
#undef PH_END
}

extern "C" void kernel_launch(void* const* d_in, const int* in_sizes, int n_in, void* d_out, int out_size, void* d_ws, size_t ws_size, hipStream_t stream) {
    static int grid = 0;
    if (grid == 0) {
        if (n_in != 25 || out_size != T * D || ws_size < WS_END) { fprintf(stderr, "kernel_launch: unexpected shapes: n_in %d out %d ws %zu (need %zu)\n", n_in, out_size, ws_size, (size_t)WS_END); grid = -1; return; }
        int dev = 0, cus = 0, per_cu = 0;
        if (hipGetDevice(&dev) != hipSuccess || hipDeviceGetAttribute(&cus, hipDeviceAttributeMultiprocessorCount, dev) != hipSuccess) { grid = -1; return; }
        if (hipFuncSetAttribute((const void*)fwd_kernel, hipFuncAttributeMaxDynamicSharedMemorySize, LDS_BYTES) != hipSuccess) { fprintf(stderr, "kernel_launch: hipFuncSetAttribute failed\n"); grid = -1; return; }
        if (hipOccupancyMaxActiveBlocksPerMultiprocessor(&per_cu, (const void*)fwd_kernel, NTHR, LDS_BYTES) != hipSuccess || per_cu < 1) { fprintf(stderr, "kernel_launch: occupancy query says %d\n", per_cu); }
        (void)hipGetLastError();
        grid = cus;
    }
    if (grid < 0) return;
    (void)hipMemsetAsync((char*)d_ws + WS_CTL, 0, CTL_ZERO_BYTES, stream);
    Args a{};
    for (int i = 0; i < 25; ++i) a.in[i] = (const float*)d_in[i];
    a.out = (float*)d_out; a.ws = (unsigned char*)d_ws;
#if defined(MK_DEBUG_DET)
    unsigned long long* tab = (unsigned long long*)((char*)d_ws + WS_CTL + 32 * 1024);
    for (int pass = 0; pass < 2; ++pass)
        for (int p = 0; p < N_PHASES; ++p) { a.ph_lo = p; a.ph_hi = p + 1; hipLaunchKernelGGL(fwd_kernel, dim3(grid), dim3(NTHR), LDS_BYTES, stream, a);
            Reg r[4]; const int nr = phase_regions(p, r);
            for (int i = 0; i < nr; ++i) hipLaunchKernelGGL(k_checksum, dim3(2048), dim3(256), 0, stream, (const unsigned*)(r[i].in_out ? (char*)d_out : (char*)d_ws + r[i].off), r[i].bytes / 4, tab + (size_t)pass * N_PHASES * 4 + p * 4 + i); }
    hipLaunchKernelGGL(k_zero_out, dim3(2048), dim3(256), 0, stream, (float*)d_out, (size_t)T * D);
    hipLaunchKernelGGL(k_report, dim3(1), dim3(64), 0, stream, tab, N_PHASES * 4, (float*)d_out);
#elif MK_ONE_LAUNCH
    a.ph_lo = 0; a.ph_hi = N_PHASES;
    hipLaunchKernelGGL(fwd_kernel, dim3(grid), dim3(NTHR), LDS_BYTES, stream, a);
#else
    for (int p = 0; p < N_PHASES; ++p) { a.ph_lo = p; a.ph_hi = p + 1; hipLaunchKernelGGL(fwd_kernel, dim3(grid), dim3(NTHR), LDS_BYTES, stream, a); }
#endif
}
```

```cpp
#include <hip/hip_runtime.h>
#include <cstdio>
#include <cstdint>

#ifndef MK_ONE_LAUNCH
#define MK_ONE_LAUNCH 1
#endif

#define GAS __attribute__((address_space(1)))
#define LAS __attribute__((address_space(3)))
typedef unsigned short bf16_t;
typedef short bf16x8 __attribute__((ext_vector_type(8)));
typedef short s16x4 __attribute__((ext_vector_type(4)));
typedef float f32x4 __attribute__((ext_vector_type(4)));
typedef float f32x2 __attribute__((ext_vector_type(2)));
typedef float f32x16 __attribute__((ext_vector_type(16)));
typedef unsigned u32x4 __attribute__((ext_vector_type(4)));
typedef unsigned u32x2 __attribute__((ext_vector_type(2)));

constexpr int D = 1024, TP = 16384, TS = 65536, T = TP + TS, SP = 8192, SS = 2048;
constexpr int NL = 4;
constexpr int NWAVES = 8, NTHR = 512;
constexpr float DN_ALPHA = 1.681792830507429f;
constexpr float LN_EPS = 1e-5f, RMS_EPS = 1e-6f;
constexpr float MLA_SCALE = 0.07216878364870323f;
constexpr int NEXP = 16384;

constexpr size_t MiB = 1u << 20;
constexpr size_t WS_CTL = 0, CTL_ZERO_BYTES = 64 * 1024;
constexpr size_t WS_ROPE = 1 * MiB;
constexpr size_t WS_MISC = 3 * MiB;
constexpr size_t WS_W = 4 * MiB;
constexpr size_t W_WA = WS_W;
constexpr size_t W_WUQ = W_WA + 2 * (size_t)768 * 1024 * 2;
constexpr size_t W_WUKV = W_WUQ + 2 * (size_t)1536 * 384 * 2;
constexpr size_t W_WO = W_WUKV + 2 * (size_t)2048 * 256 * 2;
constexpr size_t W_HIN = W_WO + 2 * (size_t)1024 * 1024 * 2;
constexpr size_t W_HO = W_HIN + 2 * (size_t)5120 * 1024 * 2;
constexpr size_t W_PQ = W_HO + 2 * (size_t)1024 * 1024 * 2;
constexpr size_t W_GW = W_PQ + 4 * (size_t)2048 * 1024 * 2;
constexpr size_t W_PP = W_GW + 4 * (size_t)1024 * 1024 * 2;
constexpr size_t W_KEYS = W_PP + 4 * (size_t)1024 * 256 * 2;
constexpr size_t W_END = W_KEYS + 4 * (size_t)2 * 128 * 128 * 2;
static_assert(W_END <= 68 * MiB, "weights region");
constexpr size_t WS_R2 = 68 * MiB;
constexpr size_t R2_UB = WS_R2, R2_VB = WS_R2 + 16 * MiB, R2_SU = WS_R2 + 32 * MiB, R2_SV = WS_R2 + 33 * MiB, R2_IDX = WS_R2 + 64 * MiB, R2_GATE = WS_R2 + 104 * MiB, R2_PB = WS_R2 + 144 * MiB;
constexpr size_t WS_XB = 252 * MiB;
constexpr size_t WS_BIG = 412 * MiB;
constexpr size_t WS_END = WS_BIG + 800 * MiB;
constexpr size_t B_Q = WS_BIG, B_KV = WS_BIG + 240 * MiB, B_O = WS_BIG + 560 * MiB, B_KROPE = WS_BIG + 720 * MiB;
constexpr size_t B_A32 = WS_BIG + 240 * MiB, B_CQN = WS_BIG + 560 * MiB, B_CKVN = WS_BIG + 620 * MiB, B_H32_MLA = WS_BIG;
constexpr size_t B_PLANE = WS_BIG, PLANE_BYTES = 160 * MiB, B_H32_HGRN = WS_BIG + 160 * MiB;
constexpr size_t B_PQ = WS_BIG, B_PP = WS_BIG + 320 * MiB, B_X8 = WS_BIG + 480 * MiB, B_XS = WS_BIG + 560 * MiB;

constexpr int LDS_BYTES = 160 * 1024;
constexpr int LDS_MISC_OFF = LDS_BYTES - 256;

typedef __bf16 bf16x2_n __attribute__((ext_vector_type(2)));
__device__ __forceinline__ unsigned cvt_pk_bf16(float lo, float hi) { const f32x2 v = {lo, hi}; const bf16x2_n b = __builtin_convertvector(v, bf16x2_n); return __builtin_bit_cast(unsigned, b); }
__device__ __forceinline__ bf16_t f2bf(float f) { return (bf16_t)(cvt_pk_bf16(f, 0.f) & 0xffffu); }
__device__ __forceinline__ float bf2f(bf16_t b) { return __uint_as_float(((unsigned)b) << 16); }
__device__ __forceinline__ float bflo(unsigned w) { return __uint_as_float(w << 16); }
__device__ __forceinline__ float bfhi(unsigned w) { return __uint_as_float(w & 0xffff0000u); }
#define DPPF(v, ctrl) __int_as_float(__builtin_amdgcn_update_dpp(0, __float_as_int(v), (ctrl), 0xf, 0xf, true))
__device__ __forceinline__ float row16_sum(float v) { v += DPPF(v, 0xB1); v += DPPF(v, 0x4E); v += DPPF(v, 0x141); v += DPPF(v, 0x140); return v; }
__device__ __forceinline__ float wave_sum(float v) { v = row16_sum(v);
    { auto r = __builtin_amdgcn_permlane16_swap(__float_as_uint(v), __float_as_uint(v), false, false); v = __uint_as_float(r[0]) + __uint_as_float(r[1]); }
    { auto r = __builtin_amdgcn_permlane32_swap(__float_as_uint(v), __float_as_uint(v), false, false); v = __uint_as_float(r[0]) + __uint_as_float(r[1]); }
    return v; }
__device__ __forceinline__ float wave_max(float v) { v = fmaxf(v, DPPF(v, 0xB1)); v = fmaxf(v, DPPF(v, 0x4E)); v = fmaxf(v, DPPF(v, 0x141)); v = fmaxf(v, DPPF(v, 0x140));
    { auto r = __builtin_amdgcn_permlane16_swap(__float_as_uint(v), __float_as_uint(v), false, false); v = fmaxf(__uint_as_float(r[0]), __uint_as_float(r[1])); }
    { auto r = __builtin_amdgcn_permlane32_swap(__float_as_uint(v), __float_as_uint(v), false, false); v = fmaxf(__uint_as_float(r[0]), __uint_as_float(r[1])); }
    return v; }
__device__ __forceinline__ float fast_exp(float x) { return __builtin_amdgcn_exp2f(x * 1.4426950408889634f); }
__device__ __forceinline__ float fast_log(float x) { return __builtin_amdgcn_logf(x) * 0.6931471805599453f; }
__device__ __forceinline__ float fast_rcp(float x) { return __builtin_amdgcn_rcpf(x); }
__device__ __forceinline__ float sigmoidf_(float x) { return fast_rcp(1.0f + fast_exp(-x)); }
__device__ __forceinline__ float siluf_(float x) { return x * sigmoidf_(x); }
#define LDS_WAIT() asm volatile("s_waitcnt lgkmcnt(0)" ::: "memory")
#define VM_WAIT() asm volatile("s_waitcnt vmcnt(0)" ::: "memory")
__device__ __forceinline__ int opaque_lane() { int l; asm volatile("v_mbcnt_lo_u32_b32 %0, -1, 0\n\tv_mbcnt_hi_u32_b32 %0, -1, %0" : "=v"(l)); return l; }
__device__ __forceinline__ int opaque_tid(int wave_s) { asm volatile("" : "+s"(wave_s)); return (wave_s << 6) + opaque_lane(); }
__device__ __forceinline__ int opaque_bid() { int b = (int)blockIdx.x; asm volatile("" : "+s"(b)); return b; }
struct Args { const float* in[25]; float* out; unsigned char* ws; int ph_lo, ph_hi; };
#define XB_TMO      128
#define XB_XCNT(j)  (256  + 64 * (j))
#define XB_XSUB(j)  (1280 + 64 * (j))
#define XB_XGEN(j)  (2304 + 64 * (j))
#define XB_TOP      3328
#define XB_TOPGEN   3392
#define XCD_BAR_WORDS 3456
#define XB_SPIN_CAP (1u << 23)

__device__ __forceinline__ unsigned xb_ld(unsigned* p)              { return __hip_atomic_load(p, __ATOMIC_RELAXED, __HIP_MEMORY_SCOPE_AGENT); }
__device__ __forceinline__ unsigned xb_add(unsigned* p, unsigned v) { return __hip_atomic_fetch_add(p, v, __ATOMIC_RELAXED, __HIP_MEMORY_SCOPE_AGENT); }
__device__ __forceinline__ unsigned xb_xcc_id() { return (unsigned)__builtin_amdgcn_s_getreg((3 << 11) | 20) & 0xFu; }
#define XB_SPIN(cond, bar) do { unsigned _sp = 0; while (cond) { __builtin_amdgcn_s_sleep(1); \
    if ((++_sp & 255u) == 0u) { if (xb_ld(&(bar)[XB_TMO])) break; if (_sp > XB_SPIN_CAP) { atomicAdd(&(bar)[XB_TMO], 1u); break; } } } } while (0)

struct XcdBarrier {
    unsigned* bar; unsigned x;
    volatile LAS unsigned* st;
};

__device__ __forceinline__ XcdBarrier xcd_barrier_post(unsigned* bar, volatile LAS unsigned* st) {
    XcdBarrier b; b.bar = bar; b.x = xb_xcc_id(); b.st = st;
    if (threadIdx.x == 0) (void)xb_add(&bar[XB_XCNT(b.x)], 1u);
    return b;
}
__device__ __forceinline__ void xcd_barrier_complete(unsigned* bar, unsigned x, unsigned& nloc, unsigned& nx) {
    const unsigned G = gridDim.x * gridDim.y * gridDim.z;
    unsigned sum, cnt, mine, sp = 0u;
    for (;;) {
        sum = 0u; cnt = 0u; mine = 0u;
#pragma unroll
        for (unsigned j = 0; j < 16; ++j) { const unsigned c = xb_ld(&bar[XB_XCNT(j)]); sum += c; cnt += (c > 0u) ? 1u : 0u; mine = (j == x) ? c : mine; }
        if (sum == G) break;
        __builtin_amdgcn_s_sleep(1);
        if ((++sp & 255u) == 0u) { if (xb_ld(&bar[XB_TMO])) break; if (sp > XB_SPIN_CAP) { atomicAdd(&bar[XB_TMO], 1u); break; } }
    }
    nloc = mine > 0u ? mine : 1u; nx = cnt > 0u ? cnt : 1u;
}

__device__ __forceinline__ void xcd_barrier(const XcdBarrier& b) {
    asm volatile("s_waitcnt vmcnt(0)" ::: "memory");
    __syncthreads();
    if (threadIdx.x == 0) {
        unsigned* bar = b.bar;
        __builtin_amdgcn_s_waitcnt(0);
        unsigned nloc = b.st[0], nx = b.st[1];
        if (nloc == 0u) { xcd_barrier_complete(bar, b.x, nloc, nx); b.st[0] = nloc; b.st[1] = nx; }
        const unsigned old = xb_add(&bar[XB_XSUB(b.x)], 1u);
        const unsigned gen = old / nloc;
        if (old + 1u == (gen + 1u) * nloc) {
            __builtin_amdgcn_fence(__ATOMIC_RELEASE, "agent");
            asm volatile("s_waitcnt vmcnt(0)" ::: "memory");
            const unsigned og = xb_add(&bar[XB_TOP], 1u);
            const unsigned tg = og / nx;
            if (og + 1u == (tg + 1u) * nx) xb_add(&bar[XB_TOPGEN], 1u);
            else XB_SPIN(xb_ld(&bar[XB_TOPGEN]) == tg, bar);
            __builtin_amdgcn_fence(__ATOMIC_ACQUIRE, "agent");
            xb_add(&bar[XB_XGEN(b.x)], 1u);
            asm volatile("s_waitcnt vmcnt(0)" ::: "memory");
        } else {
            XB_SPIN(xb_ld(&bar[XB_XGEN(b.x)]) == gen, bar);
            __builtin_amdgcn_fence(__ATOMIC_ACQUIRE, "agent");
            asm volatile("s_waitcnt vmcnt(0)" ::: "memory");
        }
    }
    __syncthreads();
}
namespace pg8 {
#define PG8_LAS __attribute__((address_space(3)))
constexpr int BM = 256, BK = 64, HALF = 128, HTB = HALF * BK * 2  , STAGE_BYTES = 8 * HTB, NXCD = 8, WGM = 8;

__host__ __device__ __forceinline__ int lds_byte(int r, int c) { const int st = (r >> 4) * 2 + (c >> 5), rr = r & 15, cc = c & 31, ob = rr * 64 + cc * 2; return st * 1024 + (ob ^ (((ob >> 9) & 1) << 5)); }
__host__ __device__ __forceinline__ void stage_rc(int b, int& R, int& C) { const int st = b / 1024, sb = b % 1024, swz = sb ^ (((sb >> 9) & 1) << 5); R = (st >> 1) * 16 + swz / 64; C = (st & 1) * 32 + (swz % 64) / 2; }
__host__ __device__ __forceinline__ int perm32(int rho) { const int n = rho >> 4, i = rho & 15; return 8 * (i >> 2) + 4 * n + (i & 3); }

struct Unit { int pm, pn; };
struct Gemm { const bf16_t* A; const bf16_t* Bt; int M, N, K; };

struct StaticOrder {
    int nM, nN, nwg, G, c;
    __host__ __device__ void init(int M, int N, int G_, int c_) { nM = M / BM; nN = N / BM; nwg = nM * nN; G = G_; c = c_; }
    __host__ __device__ bool next(int i, Unit& u) const {
        const long L = (long)i * G + c; if (L >= nwg) return false;
        int wgid = (int)L; { const int q = nwg / NXCD, r = nwg % NXCD, xcd = wgid % NXCD, off = wgid / NXCD; wgid = (xcd < r ? xcd * (q + 1) : r * (q + 1) + (xcd - r) * q) + off; }
        const int nig = WGM * nN, gid = wgid / nig, fm = gid * WGM, gsz = (nM - fm) < WGM ? (nM - fm) : WGM;
        u.pm = fm + ((wgid % nig) % gsz); u.pn = (wgid % nig) / gsz; return true;
    }
    __device__ __forceinline__ void a_ready(const Unit&) const {}
    __device__ __forceinline__ void done(const Unit&) const {}
};
template <class Epi, class Sched>
__device__ __forceinline__ void gemm_phase(PG8_LAS unsigned char* lds, const Gemm g, const Sched& S, const Epi& E, const int tid) {
    const int wid = __builtin_amdgcn_readfirstlane(tid >> 6), lane = tid & 63, wr = wid >> 2, wc = wid & 3, fr = lane & 15, fq = lane >> 4;
    const int K = g.K, nt = K / BK;
    unsigned voffA[2], voffB[2];
#pragma unroll
    for (int i = 0; i < 2; ++i) { int R, C; stage_rc(tid * 16 + i * 8192, R, C); const int Rb = Epi::PERM ? ((R & ~31) + perm32(R & 31)) : R;
        voffA[i] = (unsigned)(R * K + C) * 2u; voffB[i] = (unsigned)(Rb * K + C) * 2u; }
    const size_t kstep = (size_t)(BK * 2);
    const size_t hstep = (size_t)HALF * K * 2;
    const size_t tstep = 2 * hstep;
    const unsigned ldsw = (unsigned)wid * 1024u;
    const int aoff = lds_byte(wr * 64 + fr, fq * 8), boff = lds_byte(wc * 32 + fr, fq * 8);
#define PG8_SA(b, h) (((b) * 2 + (h)) * HTB)
#define PG8_SB(b, h) ((4 + (b) * 2 + (h)) * HTB)
#define PG8_STAGE(bufoff, gbase, voff) do { _Pragma("unroll") for (int _i = 0; _i < 2; ++_i) \
        __builtin_amdgcn_global_load_lds((const unsigned*)((const char*)(gbase) + (voff)[_i]), (PG8_LAS unsigned*)(lds + (bufoff) + ldsw + _i * 8192), 16, 0, 0); } while (0)
#define PG8_LDA(dst, b, h) do { _Pragma("unroll") for (int m = 0; m < 4; ++m) _Pragma("unroll") for (int k = 0; k < 2; ++k) dst[m][k] = *(const PG8_LAS bf16x8*)(lds + PG8_SA(b, h) + aoff + m * 2048 + k * 1024); } while (0)
#define PG8_LDB(dst, b, h) do { _Pragma("unroll") for (int n = 0; n < 2; ++n) _Pragma("unroll") for (int k = 0; k < 2; ++k) dst[n][k] = *(const PG8_LAS bf16x8*)(lds + PG8_SB(b, h) + boff + n * 2048 + k * 1024); } while (0)
#define PG8_MMA(ai, bj, At, Bt) do { __builtin_amdgcn_s_setprio(1); _Pragma("unroll") for (int m = 0; m < 4; ++m) _Pragma("unroll") for (int n = 0; n < 2; ++n) _Pragma("unroll") for (int k = 0; k < 2; ++k) \
        acc[ai][bj][m][n] = __builtin_amdgcn_mfma_f32_16x16x32_bf16(Bt[n][k], At[m][k], acc[ai][bj][m][n], 0, 0, 0); __builtin_amdgcn_s_setprio(0); } while (0)
#define PG8_WAIT_V(n) asm volatile("s_waitcnt vmcnt(" #n ")" ::: "memory")
#define PG8_WAIT_L(n) asm volatile("s_waitcnt lgkmcnt(" #n ")" ::: "memory")
#define PG8_BAR __builtin_amdgcn_s_barrier()
#define PG8_SCHED __builtin_amdgcn_sched_barrier(0)
    Unit cur, nxt; int ui = 0;
    if (!S.next(0, cur)) return;
    f32x4 acc[2][2][4][2];
#pragma unroll
    for (int a = 0; a < 2; ++a)
#pragma unroll
        for (int b = 0; b < 2; ++b)
#pragma unroll
            for (int m = 0; m < 4; ++m)
#pragma unroll
                for (int n = 0; n < 2; ++n) acc[a][b][m][n] = (f32x4){0.f, 0.f, 0.f, 0.f};
    bf16x8 At[4][2], B0[2][2], B1[2][2];
    const char* cA = (const char*)g.A + (size_t)cur.pm * tstep; const char* cB = (const char*)g.Bt + (size_t)cur.pn * tstep;
    S.a_ready(cur);
    PG8_STAGE(PG8_SB(0, 0), cB, voffB); PG8_STAGE(PG8_SA(0, 0), cA, voffA); PG8_STAGE(PG8_SB(0, 1), cB + hstep, voffB); PG8_STAGE(PG8_SA(0, 1), cA + hstep, voffA);
    if (wr == 1) PG8_BAR;
    PG8_WAIT_V(4); PG8_BAR;
    PG8_STAGE(PG8_SB(1, 0), cB + kstep, voffB); PG8_STAGE(PG8_SA(1, 0), cA + kstep, voffA); PG8_STAGE(PG8_SB(1, 1), cB + hstep + kstep, voffB);
    PG8_WAIT_V(6); PG8_BAR;
    for (;;) {
        const bool has_next = S.next(ui + 1, nxt);
        const char* nA = has_next ? (const char*)g.A + (size_t)nxt.pm * tstep : cA; const char* nB = has_next ? (const char*)g.Bt + (size_t)nxt.pn * tstep : cB;
        for (int t = 0; t < nt; t += 2) {
            const bool last = (t == nt - 2);
            const char* a1 = cA + (size_t)(t + 1) * kstep;
            const char* a2 = last ? nA : cA + (size_t)(t + 2) * kstep; const char* b2 = last ? nB : cB + (size_t)(t + 2) * kstep;
            const char* a3 = a2 + kstep; const char* b3 = b2 + kstep;
            if (last && has_next) S.a_ready(nxt);
            PG8_LDB(B0, 0, 0); PG8_SCHED; PG8_LDA(At, 0, 0); PG8_STAGE(PG8_SA(1, 1), a1 + hstep, voffA);
            PG8_WAIT_L(8); PG8_BAR; PG8_WAIT_L(0); PG8_MMA(0, 0, At, B0); PG8_BAR; PG8_SCHED;
            PG8_LDB(B1, 0, 1); PG8_STAGE(PG8_SB(0, 0), b2, voffB);
            PG8_BAR; PG8_WAIT_L(0); PG8_MMA(0, 1, At, B1); PG8_BAR;
            PG8_LDA(At, 0, 1); PG8_STAGE(PG8_SA(0, 0), a2, voffA);
            PG8_BAR; PG8_WAIT_L(0); PG8_MMA(1, 0, At, B0); PG8_BAR; PG8_SCHED;
            PG8_STAGE(PG8_SB(0, 1), b2 + hstep, voffB);
            PG8_WAIT_V(6); PG8_BAR; PG8_MMA(1, 1, At, B1); PG8_BAR;
            PG8_LDB(B0, 1, 0); PG8_SCHED; PG8_LDA(At, 1, 0); PG8_STAGE(PG8_SA(0, 1), a2 + hstep, voffA);
            PG8_WAIT_L(8); PG8_BAR; PG8_WAIT_L(0); PG8_MMA(0, 0, At, B0); PG8_BAR; PG8_SCHED;
            PG8_LDB(B1, 1, 1); PG8_STAGE(PG8_SB(1, 0), b3, voffB);
            PG8_BAR; PG8_WAIT_L(0); PG8_MMA(0, 1, At, B1); PG8_BAR;
            PG8_LDA(At, 1, 1); PG8_STAGE(PG8_SA(1, 0), a3, voffA);
            PG8_BAR; PG8_WAIT_L(0); PG8_MMA(1, 0, At, B0); PG8_BAR; PG8_SCHED;
            PG8_STAGE(PG8_SB(1, 1), b3 + hstep, voffB);
            PG8_WAIT_V(6); PG8_BAR; PG8_MMA(1, 1, At, B1); PG8_BAR;
        }
        E(acc, cur, wr, wc, fr, fq); S.done(cur);
        if (!has_next) break;
#pragma unroll
        for (int a = 0; a < 2; ++a)
#pragma unroll
            for (int b = 0; b < 2; ++b)
#pragma unroll
                for (int m = 0; m < 4; ++m)
#pragma unroll
                    for (int n = 0; n < 2; ++n) acc[a][b][m][n] = (f32x4){0.f, 0.f, 0.f, 0.f};
        cur = nxt; cA = nA; cB = nB; ++ui;
    }
    PG8_WAIT_V(0);
    if (wr == 0) PG8_BAR;
    PG8_BAR;
#undef PG8_SA
#undef PG8_SB
#undef PG8_STAGE
#undef PG8_LDA
#undef PG8_LDB
#undef PG8_MMA
#undef PG8_WAIT_V
#undef PG8_WAIT_L
#undef PG8_BAR
#undef PG8_SCHED
}
struct EpiF32 {
    static constexpr bool PERM = false;
    float* C; int ldc;
    __device__ __forceinline__ void operator()(const f32x4 (&acc)[2][2][4][2], const Unit& u, int wr, int wc, int fr, int fq) const {
        const int row0 = u.pm * BM + wr * 64 + fr, col0 = u.pn * BM + wc * 32 + 4 * fq;
#pragma unroll
        for (int ai = 0; ai < 2; ++ai)
#pragma unroll
            for (int m = 0; m < 4; ++m) { float* rowp = C + (size_t)(row0 + ai * HALF + m * 16) * ldc + col0;
#pragma unroll
                for (int bj = 0; bj < 2; ++bj)
#pragma unroll
                    for (int n = 0; n < 2; ++n) *(f32x4*)(rowp + bj * HALF + n * 16) = acc[ai][bj][m][n]; }
    }
};
struct EpiBf16P {
    static constexpr bool PERM = true;
    bf16_t* O; int ldc;
    __device__ __forceinline__ void operator()(const f32x4 (&acc)[2][2][4][2], const Unit& u, int wr, int wc, int fr, int fq) const {
        const int row0 = u.pm * BM + wr * 64 + fr, col0 = u.pn * BM + wc * 32 + 8 * fq;
#pragma unroll
        for (int ai = 0; ai < 2; ++ai)
#pragma unroll
            for (int m = 0; m < 4; ++m) { bf16_t* rowp = O + (size_t)(row0 + ai * HALF + m * 16) * ldc + col0;
#pragma unroll
                for (int bj = 0; bj < 2; ++bj) { const f32x4 v0 = acc[ai][bj][m][0], v1 = acc[ai][bj][m][1];
                    u32x4 w; w.x = cvt_pk_bf16(v0[0], v0[1]); w.y = cvt_pk_bf16(v0[2], v0[3]); w.z = cvt_pk_bf16(v1[0], v1[1]); w.w = cvt_pk_bf16(v1[2], v1[3]);
                    *(u32x4*)(rowp + bj * HALF) = w; } }
    }
};
struct EpiHgrn {
    static constexpr bool PERM = true;
    bf16_t* planes; size_t plane_elems; const float* lb;
    __device__ __forceinline__ void operator()(const f32x4 (&acc)[2][2][4][2], const Unit& u, int wr, int wc, int fr, int fq) const {
        const int plane = u.pn >> 2;
        const int row0 = u.pm * BM + wr * 64 + fr, col0 = (u.pn & 3) * BM + wc * 32 + 8 * fq;
        bf16_t* base = planes + (size_t)plane * plane_elems;
        float lbv[2][8];
        if (plane == 1 || plane == 2) {
#pragma unroll
            for (int bj = 0; bj < 2; ++bj)
#pragma unroll
                for (int e = 0; e < 8; ++e) lbv[bj][e] = lb[(plane - 1) * 1024 + col0 + bj * HALF + e];
        } else {
#pragma unroll
            for (int bj = 0; bj < 2; ++bj)
#pragma unroll
                for (int e = 0; e < 8; ++e) lbv[bj][e] = 0.f;
        }
#pragma unroll
        for (int ai = 0; ai < 2; ++ai)
#pragma unroll
            for (int m = 0; m < 4; ++m) { bf16_t* rowp = base + (size_t)(row0 + ai * HALF + m * 16) * 1024 + col0;
#pragma unroll
                for (int bj = 0; bj < 2; ++bj) { float v[8];
#pragma unroll
                    for (int e = 0; e < 4; ++e) { v[e] = acc[ai][bj][m][0][e]; v[4 + e] = acc[ai][bj][m][1][e]; }
                    if (plane == 0 || plane == 4) {
#pragma unroll
                        for (int e = 0; e < 8; ++e) v[e] = siluf_(v[e]);
                    } else if (plane == 1 || plane == 2) {
#pragma unroll
                        for (int e = 0; e < 8; ++e) { const float l = lbv[bj][e]; const float f = l + (1.0f - l) * sigmoidf_(v[e]); v[e] = fast_log(fmaxf(f, 1e-30f)); }
                    }
                    u32x4 w; w.x = cvt_pk_bf16(v[0], v[1]); w.y = cvt_pk_bf16(v[2], v[3]); w.z = cvt_pk_bf16(v[4], v[5]); w.w = cvt_pk_bf16(v[6], v[7]);
                    *(u32x4*)(rowp + bj * HALF) = w; } }
    }
};
struct EpiPle {
    static constexpr bool PERM = false;
    const bf16_t* Xin; const bf16_t* PP; const float* bias; bf16_t* XbOut; float* Fout;
    __device__ __forceinline__ void operator()(const f32x4 (&acc)[2][2][4][2], const Unit& u, int wr, int wc, int fr, int fq) const {
        const int row0 = u.pm * BM + wr * 64 + fr, col0 = u.pn * BM + wc * 32 + 4 * fq;
        f32x4 bv[2][2];
#pragma unroll
        for (int bj = 0; bj < 2; ++bj)
#pragma unroll
            for (int n = 0; n < 2; ++n) bv[bj][n] = *(const f32x4*)(bias + col0 + bj * HALF + n * 16);
#pragma unroll
        for (int ai = 0; ai < 2; ++ai)
#pragma unroll
            for (int m = 0; m < 4; ++m) { const size_t off = (size_t)(row0 + ai * HALF + m * 16) * 1024 + col0;
#pragma unroll
                for (int bj = 0; bj < 2; ++bj)
#pragma unroll
                    for (int n = 0; n < 2; ++n) { const size_t o2 = off + bj * HALF + n * 16;
                        const u32x2 xw = *(const u32x2*)(Xin + o2); const u32x2 pw = *(const u32x2*)(PP + o2); const f32x4 z = acc[ai][bj][m][n] + bv[bj][n];
                        f32x4 o; o[0] = bflo(xw.x) + sigmoidf_(z[0]) * bflo(pw.x); o[1] = bfhi(xw.x) + sigmoidf_(z[1]) * bfhi(pw.x); o[2] = bflo(xw.y) + sigmoidf_(z[2]) * bflo(pw.y); o[3] = bfhi(xw.y) + sigmoidf_(z[3]) * bfhi(pw.y);
                        if (Fout) *(f32x4*)(Fout + o2) = o; else { u32x2 w; w.x = cvt_pk_bf16(o[0], o[1]); w.y = cvt_pk_bf16(o[2], o[3]); *(u32x2*)(XbOut + o2) = w; } }
                asm volatile("" ::: "memory"); }
    }
};
}
namespace attn {
constexpr int DV = 128, DQK = 192, NW = 8, QBLK = 32, KVBLK = 64;
constexpr float SCALE = MLA_SCALE;
constexpr float THR = 8.f;
constexpr int LDQ = 8 * DQK, LDKV = 8 * 256, LDKR = 64, LDO = 1024;
constexpr int KROWB = 400;
constexpr int SHM_V = KVBLK * DV * 2, SHM_K = KVBLK * KROWB, SHM_ATTN = 2 * SHM_V + 2 * SHM_K + NW * 64 * 4;
#define SBAR() __builtin_amdgcn_sched_barrier(0)
__device__ __forceinline__ int crow(int r, int hi) { return (r & 3) + 8 * (r >> 2) + 4 * hi; }

__device__ __forceinline__ void partialSM(f32x16& p0, f32x16& p1, float& m_reg, float& mn, float& alpha) {
  constexpr float C = SCALE * 1.4426950408889634f;
  float pmax = p0[0];
#pragma unroll
  for (int r = 1; r < 16; ++r) pmax = fmaxf(pmax, p0[r]);
#pragma unroll
  for (int r = 0; r < 16; ++r) pmax = fmaxf(pmax, p1[r]);
  { auto rr = __builtin_amdgcn_permlane32_swap(__float_as_uint(pmax), __float_as_uint(pmax), false, false);
    pmax = fmaxf(__uint_as_float(rr[0]), __uint_as_float(rr[1])); }
  if (__builtin_expect(__all(pmax - m_reg <= THR / SCALE), 1)) { mn = m_reg; alpha = 1.f; }
  else { mn = fmaxf(m_reg, pmax); alpha = __builtin_amdgcn_exp2f((m_reg - mn) * C); m_reg = mn; }
  float mnC = -mn * C;
#pragma unroll
  for (int r = 0; r < 16; ++r) p0[r] = fmaf(p0[r], C, mnC);
#pragma unroll
  for (int r = 0; r < 16; ++r) p1[r] = fmaf(p1[r], C, mnC);
#pragma unroll
  for (int r = 0; r < 16; ++r) p0[r] = __builtin_amdgcn_exp2f(p0[r]);
}
__device__ __forceinline__ void finishSM(f32x16& p0, f32x16& p1, float alpha, float& l_reg, bf16x8& pa0, bf16x8& pa1, bf16x8& pa2, bf16x8& pa3) {
#pragma unroll
  for (int r = 0; r < 16; ++r) p1[r] = __builtin_amdgcn_exp2f(p1[r]);
  float ps = 0;
#pragma unroll
  for (int r = 0; r < 16; ++r) ps += p0[r];
#pragma unroll
  for (int r = 0; r < 16; ++r) ps += p1[r];
  { auto rr = __builtin_amdgcn_permlane32_swap(__float_as_uint(ps), __float_as_uint(ps), false, false);
    ps = __uint_as_float(rr[0]) + __uint_as_float(rr[1]); }
  l_reg = l_reg * alpha + ps;
#define PK4(P, BASE, OUT) do { unsigned a0 = cvt_pk_bf16(P[BASE + 0], P[BASE + 1]), a1 = cvt_pk_bf16(P[BASE + 2], P[BASE + 3]);   \
    unsigned b0 = cvt_pk_bf16(P[BASE + 4], P[BASE + 5]), b1 = cvt_pk_bf16(P[BASE + 6], P[BASE + 7]);                              \
    auto r0 = __builtin_amdgcn_permlane32_swap(a0, b0, false, false); auto r1 = __builtin_amdgcn_permlane32_swap(a1, b1, false, false); \
    u32x4 w = {r0[0], r1[0], r0[1], r1[1]}; OUT = *reinterpret_cast<bf16x8*>(&w); } while (0)
  PK4(p0, 0, pa0); PK4(p0, 8, pa1); PK4(p1, 0, pa2); PK4(p1, 8, pa3);
#undef PK4
}
__device__ __forceinline__ void qkt(f32x16& p0, f32x16& p1, const char* Ks, const bf16x8* qr, int r32, int hi) {
  p0 = f32x16{}; p1 = f32x16{};
#pragma unroll
  for (int d0 = 0; d0 < 12; ++d0) { const int cb = (d0 * 16 + hi * 8) * 2;
    bf16x8 b0 = *reinterpret_cast<const bf16x8*>(Ks + r32 * KROWB + cb);
    bf16x8 b1 = *reinterpret_cast<const bf16x8*>(Ks + (32 + r32) * KROWB + cb);
    p0 = __builtin_amdgcn_mfma_f32_32x32x16_bf16(b0, qr[d0], p0, 0, 0, 0);
    p1 = __builtin_amdgcn_mfma_f32_32x32x16_bf16(b1, qr[d0], p1, 0, 0, 0);
    if ((d0 & 3) == 3) SBAR(); }
}
__device__ __forceinline__ int v_st(int k, int c) { const int kk = (k & ~0xC) | ((k & 4) << 1) | ((k & 8) >> 1); return ((kk >> 3) * 4 + (c >> 5)) * 512 + ((kk & 7) * 32 + (c & 31)) * 2; }
__device__ __forceinline__ int v_rd_base(int lane) { return ((lane & 3) << 3) | (((lane >> 2) & 3) << 6) | (((lane >> 4) & 1) << 5) | (((lane >> 5) & 1) << 8); }
constexpr int v_rd_off(int d0, int ks, int half) { return d0 * 512 + ks * 4096 + half * 2048; }
template <int OFF> __device__ __forceinline__ s16x4 tr_read(int vb) {
  s16x4 r; asm volatile("ds_read_b64_tr_b16 %0, %1 offset:%2" : "=&v"(r) : "v"(vb), "i"(OFF) : "memory"); return r;
}
template <int D0> __device__ __forceinline__ void pv_one(f32x16& od, int vb, bf16x8 pa0, bf16x8 pa1, bf16x8 pa2, bf16x8 pa3) {
  const s16x4 l0 = tr_read<v_rd_off(D0, 0, 0)>(vb), h0 = tr_read<v_rd_off(D0, 0, 1)>(vb), l1 = tr_read<v_rd_off(D0, 1, 0)>(vb), h1 = tr_read<v_rd_off(D0, 1, 1)>(vb);
  const s16x4 l2 = tr_read<v_rd_off(D0, 2, 0)>(vb), h2 = tr_read<v_rd_off(D0, 2, 1)>(vb), l3 = tr_read<v_rd_off(D0, 3, 0)>(vb), h3 = tr_read<v_rd_off(D0, 3, 1)>(vb);
  asm volatile("s_waitcnt lgkmcnt(0)" ::: "memory"); SBAR();
#define PK(L, H) (bf16x8){L[0], L[1], L[2], L[3], H[0], H[1], H[2], H[3]}
  od = __builtin_amdgcn_mfma_f32_32x32x16_bf16(pa0, PK(l0, h0), od, 0, 0, 0);
  od = __builtin_amdgcn_mfma_f32_32x32x16_bf16(pa1, PK(l1, h1), od, 0, 0, 0);
  od = __builtin_amdgcn_mfma_f32_32x32x16_bf16(pa2, PK(l2, h2), od, 0, 0, 0);
  od = __builtin_amdgcn_mfma_f32_32x32x16_bf16(pa3, PK(l3, h3), od, 0, 0, 0);
#undef PK
}
__device__ __forceinline__ void pv_d0(f32x16* o, int vb, bf16x8 pa0, bf16x8 pa1, bf16x8 pa2, bf16x8 pa3) {
  pv_one<0>(o[0], vb, pa0, pa1, pa2, pa3); pv_one<1>(o[1], vb, pa0, pa1, pa2, pa3); pv_one<2>(o[2], vb, pa0, pa1, pa2, pa3); pv_one<3>(o[3], vb, pa0, pa1, pa2, pa3);
}

__device__ __forceinline__ void attn_body(const bf16_t* __restrict__ Qb, const bf16_t* __restrict__ Kn, const bf16_t* __restrict__ Kr,
                                          bf16_t* __restrict__ Ob, int seq, char* lds, int tid, int pos0, const float* __restrict__ ropeT) {
  asm volatile("" : "+v"(tid));
  const int wid = tid >> 6, lane = tid & 63, r32 = lane & 31, hi = lane >> 5;
  char* V_lds = lds; char* K_lds = lds + 2 * SHM_V;
  float* ws = (float*)(lds + 2 * SHM_V + 2 * SHM_K) + wid * 64; float* li_l = ws; float* al_l = ws + 32;
  float m_reg = -1e30f, l_reg = 0; f32x16 o[4] = {}; bf16x8 qr[12];
  const bf16_t* Qw = Qb + (long)(wid * QBLK + r32) * LDQ + hi * 8;
#pragma unroll
  for (int d0 = 0; d0 < 12; ++d0) qr[d0] = *reinterpret_cast<const bf16x8*>(Qw + d0 * 16);
  { const float* cp = ropeT + (size_t)(pos0 + wid * QBLK + r32) * 32 + hi * 8; const float* sp = cp + 8192 * 32;
#pragma unroll
    for (int dd = 0; dd < 2; ++dd) { const f32x4 c0 = *(const f32x4*)(cp + 16 * dd), c1 = *(const f32x4*)(cp + 16 * dd + 4), s0 = *(const f32x4*)(sp + 16 * dd), s1 = *(const f32x4*)(sp + 16 * dd + 4);
      const u32x4 A = *reinterpret_cast<const u32x4*>(&qr[8 + dd]), B = *reinterpret_cast<const u32x4*>(&qr[10 + dd]); u32x4 An, Bn;
#pragma unroll
      for (int w2 = 0; w2 < 4; ++w2) { const float cs0 = w2 < 2 ? c0[2 * w2] : c1[2 * w2 - 4], cs1 = w2 < 2 ? c0[2 * w2 + 1] : c1[2 * w2 - 3], sn0 = w2 < 2 ? s0[2 * w2] : s1[2 * w2 - 4], sn1 = w2 < 2 ? s0[2 * w2 + 1] : s1[2 * w2 - 3];
        const float a0 = bflo(A[w2]), a1 = bfhi(A[w2]), b0 = bflo(B[w2]), b1 = bfhi(B[w2]);
        An[w2] = cvt_pk_bf16(a0 * cs0 - b0 * sn0, a1 * cs1 - b1 * sn1); Bn[w2] = cvt_pk_bf16(b0 * cs0 + a0 * sn0, b1 * cs1 + a1 * sn1); }
      qr[8 + dd] = *reinterpret_cast<const bf16x8*>(&An); qr[10 + dd] = *reinterpret_cast<const bf16x8*>(&Bn); } }
  const bf16_t* Vh = Kn + 128;
  const int sr = tid >> 4, sc = (tid & 15) * 8, vst0 = v_st(sr, sc), vst1 = v_st(32 + sr, sc);
  int krow[3], kcc[3];
#pragma unroll
  for (int i = 0; i < 3; ++i) { const int id = tid + 512 * i; krow[i] = id / 24; kcc[i] = id % 24; }
  const int vb0 = (int)(uintptr_t)V_lds + v_rd_base(lane);
  bf16x8 vs0, vs1, ks0, ks1, ks2;
#define KSRC(i, k0) (kcc[i] < 16 ? (Kn + (long)((k0) + krow[i]) * LDKV + kcc[i] * 8) : (Kr + (long)((k0) + krow[i]) * LDKR + (kcc[i] - 16) * 8))
#define SLOAD(k0) do { vs0 = *reinterpret_cast<const bf16x8*>(&Vh[(long)((k0) + sr) * LDKV + sc]); vs1 = *reinterpret_cast<const bf16x8*>(&Vh[(long)((k0) + 32 + sr) * LDKV + sc]); \
    ks0 = *reinterpret_cast<const bf16x8*>(KSRC(0, k0)); ks1 = *reinterpret_cast<const bf16x8*>(KSRC(1, k0)); ks2 = *reinterpret_cast<const bf16x8*>(KSRC(2, k0)); } while (0)
#define SWRITE(b) do { *(bf16x8*)(V_lds + (b) * SHM_V + vst0) = vs0; *(bf16x8*)(V_lds + (b) * SHM_V + vst1) = vs1; \
    *(bf16x8*)(K_lds + (b) * SHM_K + krow[0] * KROWB + kcc[0] * 16) = ks0; *(bf16x8*)(K_lds + (b) * SHM_K + krow[1] * KROWB + kcc[1] * 16) = ks1; \
    *(bf16x8*)(K_lds + (b) * SHM_K + krow[2] * KROWB + kcc[2] * 16) = ks2; } while (0)
#define SWAIT() asm volatile("s_waitcnt vmcnt(0)" ::: "memory")
#define RESC(a) do { if (__any((a) < 1.f)) { if (hi == 0) al_l[r32] = (a); asm volatile("s_waitcnt lgkmcnt(0)" ::: "memory"); \
    _Pragma("unroll") for (int d = 0; d < 4; ++d) _Pragma("unroll") for (int r = 0; r < 16; ++r) o[d][r] *= al_l[crow(r, hi)]; } } while (0)
  f32x16 pA0, pA1; float mnA, alA; bf16x8 pa0, pa1, pa2, pa3; const int NT = seq / KVBLK;
  SLOAD(0); SWAIT(); SWRITE(0); __syncthreads();
  for (int j = 0; j < NT; ++j) {
    const int b = j & 1;
    if (j + 1 < NT) SLOAD((j + 1) * KVBLK);
    SBAR(); qkt(pA0, pA1, K_lds + b * SHM_K, qr, r32, hi);
    partialSM(pA0, pA1, m_reg, mnA, alA);
    RESC(alA);
    finishSM(pA0, pA1, alA, l_reg, pa0, pa1, pa2, pa3); SBAR();
    pv_d0(o, vb0 + b * (int)SHM_V, pa0, pa1, pa2, pa3);
    if (j + 1 < NT) { SWAIT(); SWRITE(b ^ 1); }
    __syncthreads();
  }
  if (hi == 0) li_l[r32] = l_reg; asm volatile("s_waitcnt lgkmcnt(0)" ::: "memory");
  float rli[16];
#pragma unroll
  for (int r = 0; r < 16; ++r) rli[r] = __builtin_amdgcn_rcpf(li_l[crow(r, hi)]);
  bf16_t* Ow = Ob + (long)(wid * QBLK) * LDO;
#pragma unroll
  for (int r = 0; r < 16; ++r) { const int orow = crow(r, hi);
#pragma unroll
    for (int d0 = 0; d0 < 4; ++d0) Ow[(long)orow * LDO + d0 * 32 + r32] = f2bf(o[d0][r] * rli[r]); }
#undef KSRC
#undef SLOAD
#undef SWRITE
#undef SWAIT
#undef RESC
}
#undef SBAR
}
typedef const __attribute__((address_space(4))) Args* KArgs;
struct Ctx {
    KArgs a; float* out; unsigned char* ws;
    LAS unsigned char* lds;
    int tid, lane, wave, vcu, G, gw, NGW, bid;
    __device__ __forceinline__ const float* in(int i) const { return a->in[i]; }
};
__device__ __forceinline__ Ctx mk_ctx(unsigned char* lds_raw, int wave_s) {
    Ctx c; KArgs a = (KArgs)__builtin_amdgcn_kernarg_segment_ptr(); asm volatile("" : "+s"(a));
    c.a = a; c.out = a->out; c.ws = a->ws; c.lds = (LAS unsigned char*)lds_raw;
    c.tid = opaque_tid(wave_s); c.lane = c.tid & 63; c.wave = __builtin_amdgcn_readfirstlane(c.tid >> 6);
    c.G = (int)gridDim.x; c.bid = opaque_bid(); c.vcu = (c.G % 8 == 0) ? (c.bid % 8) * (c.G / 8) + c.bid / 8 : c.bid;
    c.gw = c.vcu * NWAVES + c.wave; c.NGW = c.G * NWAVES;
    return c;
}
__device__ __forceinline__ int tok_pos(int t) { return t < TP ? (t & (SP - 1)) : ((t - TP) & (SS - 1)); }

__device__ __forceinline__ void transpose_item(const float* W, int K, int N, bf16_t* WT, LAS float* scr, int item, int lane) {
    const int nblk = N / 32, kb = item / nblk, nb = item % nblk, k0 = 64 * kb, n0 = 32 * nb;
#pragma unroll 8
    for (int i = 0; i < 32; ++i) { const int kk = 2 * i + (lane >> 5); scr[kk * 33 + (lane & 31)] = W[(size_t)(k0 + kk) * N + n0 + (lane & 31)]; }
    LDS_WAIT(); asm volatile("" ::: "memory");
    const int c = lane & 7;
#pragma unroll
    for (int j = 0; j < 4; ++j) { const int n = (lane >> 3) + 8 * j; const LAS float* s = scr + (8 * c) * 33 + n;
        u32x4 o; o.x = cvt_pk_bf16(s[0 * 33], s[1 * 33]); o.y = cvt_pk_bf16(s[2 * 33], s[3 * 33]); o.z = cvt_pk_bf16(s[4 * 33], s[5 * 33]); o.w = cvt_pk_bf16(s[6 * 33], s[7 * 33]);
        *(u32x4*)(WT + (size_t)(n0 + n) * K + k0 + 8 * c) = o; }
    LDS_WAIT(); asm volatile("" ::: "memory");
}
struct MatDesc { int in_idx, K, N, Npad, copies; size_t dst; };
__device__ __forceinline__ void p0_prologue(const Ctx& c) {
    LAS float* scr = (LAS float*)(c.lds + c.wave * 16384);
    const MatDesc MATS[9] = {
        {4, 1024, 704, 768, 2, W_WA}, {7, 384, 1536, 1536, 2, W_WUQ}, {8, 256, 2048, 2048, 2, W_WUKV}, {9, 1024, 1024, 1024, 2, W_WO},
        {10, 1024, 5120, 5120, 2, W_HIN}, {13, 1024, 1024, 1024, 2, W_HO}, {14, 1024, 2048, 2048, 4, W_PQ}, {22, 1024, 1024, 1024, 4, W_GW}, {24, 256, 1024, 1024, 4, W_PP}};
    int total = 0;
#pragma unroll
    for (int m = 0; m < 9; ++m) total += MATS[m].copies * (MATS[m].K / 64) * (MATS[m].N / 32);
    for (int it = c.gw; it < total; it += c.NGW) {
        int r = it;
#pragma unroll
        for (int m = 0; m < 9; ++m) {
            const int per = (MATS[m].K / 64) * (MATS[m].N / 32), cnt = MATS[m].copies * per;
            if (r >= 0 && r < cnt) { const int cp = r / per, item = r % per;
                transpose_item(c.in(MATS[m].in_idx) + (size_t)cp * MATS[m].K * MATS[m].N, MATS[m].K, MATS[m].N,
                               (bf16_t*)(c.ws + MATS[m].dst) + (size_t)cp * MATS[m].Npad * MATS[m].K, scr, item, c.lane);
                r = -1; }
            else if (r >= 0) r -= cnt;
        }
    }
    const int gt = c.gw * 64 + c.lane, NGT = c.NGW * 64;
    for (int i = gt; i < 2 * 64 * 1024 / 8; i += NGT) { const int cp = i / (64 * 1024 / 8), o = i % (64 * 1024 / 8);
        *(u32x4*)((bf16_t*)(c.ws + W_WA) + (size_t)cp * 768 * 1024 + (size_t)704 * 1024 + o * 8) = (u32x4){0u, 0u, 0u, 0u}; }
    for (int i = gt; i < 4 * 2 * 128 * 128 / 4; i += NGT) { const f32x4 v = *(const f32x4*)(c.in(15) + (size_t)i * 4);
        u32x2 w; w.x = cvt_pk_bf16(v[0], v[1]); w.y = cvt_pk_bf16(v[2], v[3]); *(u32x2*)((bf16_t*)(c.ws + W_KEYS) + (size_t)i * 4) = w; }
    for (int i = gt; i < 8192 * 32; i += NGT) { const int pos = i >> 5, f = i & 31;
        const float inv = 1.0f / powf(10000.0f, (float)(2 * f) / 64.0f); const float ang = (float)pos * inv;
        ((float*)(c.ws + WS_ROPE))[i] = cosf(ang); ((float*)(c.ws + WS_ROPE))[8192 * 32 + i] = sinf(ang); }
    for (int i = gt; i < 2 * 1024; i += NGT) { const int dir = i >> 10, k = i & 1023;
        const float l0 = c.in(11)[(dir * 2 + 0) * 1024 + k], l1 = c.in(11)[(dir * 2 + 1) * 1024 + k];
        float* lb = (float*)(c.ws + WS_MISC);
        lb[(0 * 2 + dir) * 1024 + k] = 0.f; lb[(1 * 2 + dir) * 1024 + k] = 1.0f / (1.0f + expf(l0 - l1)); }
    for (int t = c.gw; t < T; t += c.NGW) {
        const float* xr = t < TP ? c.in(0) + (size_t)t * D : c.in(1) + (size_t)(t - TP) * D;
        bf16_t* brow = (bf16_t*)c.out + (size_t)t * D;
#pragma unroll
        for (int j = 0; j < 4; ++j) { const f32x4 v = *(const f32x4*)(xr + 256 * j + 4 * c.lane);
            u32x2 w; w.x = cvt_pk_bf16(v[0], v[1]); w.y = cvt_pk_bf16(v[2], v[3]); *(u32x2*)(brow + 256 * j + 4 * c.lane) = w; }
    }
}

__device__ __forceinline__ void cvt_range(const float* src, bf16_t* dst, size_t n8, int gt, int NGT) {
    for (size_t i = gt; i < n8; i += NGT) { const f32x4 a = *(const f32x4*)(src + i * 8), b = *(const f32x4*)(src + i * 8 + 4);
        u32x4 w; w.x = cvt_pk_bf16(a[0], a[1]); w.y = cvt_pk_bf16(a[2], a[3]); w.z = cvt_pk_bf16(b[0], b[1]); w.w = cvt_pk_bf16(b[2], b[3]); *(u32x4*)(dst + i * 8) = w; }
}
__device__ __forceinline__ void l0_convert(const Ctx& c, int layer) {
    const int gt = c.gw * 64 + c.lane, NGT = c.NGW * 64;
    for (int r = c.gw; r < 2 * NEXP; r += c.NGW) {
        const int m = r >= NEXP, e = r - m * NEXP;
        const float* src = c.in(16 + m) + ((size_t)layer * NEXP + e) * D + 16 * c.lane;
        f32x4 v[4]; float am = 0.f;
#pragma unroll
        for (int j = 0; j < 4; ++j) { v[j] = *(const f32x4*)(src + 4 * j); am = fmaxf(am, fmaxf(fmaxf(fabsf(v[j][0]), fabsf(v[j][1])), fmaxf(fabsf(v[j][2]), fabsf(v[j][3])))); }
        am = wave_max(am);
        const float sc = fmaxf(am, 1e-30f) * (1.0f / 440.0f), inv = 1.0f / sc;
        u32x4 w;
#pragma unroll
        for (int j = 0; j < 4; ++j) { int p = 0; p = __builtin_amdgcn_cvt_pk_fp8_f32(v[j][0] * inv, v[j][1] * inv, p, false); p = __builtin_amdgcn_cvt_pk_fp8_f32(v[j][2] * inv, v[j][3] * inv, p, true); w[j] = (unsigned)p; }
        *(u32x4*)(c.ws + (m ? R2_VB : R2_UB) + (size_t)e * D + 16 * c.lane) = w;
        if (c.lane == 0) ((float*)(c.ws + (m ? R2_SV : R2_SU)))[e] = sc;
    }
    cvt_range(c.in(2) + (size_t)layer * TP * 256, (bf16_t*)(c.ws + R2_PB), (size_t)TP * 256 / 8, gt, NGT);
    cvt_range(c.in(3) + (size_t)layer * TS * 256, (bf16_t*)(c.ws + R2_PB) + (size_t)TP * 256, (size_t)TS * 256 / 8, gt, NGT);
}

__device__ __forceinline__ void mla_e1(const Ctx& c, int j) {
    const float* a32 = (const float*)(c.ws + B_A32); bf16_t* cqn = (bf16_t*)(c.ws + B_CQN); bf16_t* ckvn = (bf16_t*)(c.ws + B_CKVN); bf16_t* krope = (bf16_t*)(c.ws + B_KROPE);
    const float* qnw = c.in(5) + j * 384; const float* kvnw = c.in(6) + j * 256;
    const float* cosT = (const float*)(c.ws + WS_ROPE); const float* sinT = cosT + 8192 * 32;
    LAS float* scr = (LAS float*)(c.lds + c.wave * 1024);
    const int lane = c.lane;
    for (int t = c.gw; t < T; t += c.NGW) {
        const float* ar = a32 + (size_t)t * 768;
        const f32x4 v0 = *(const f32x4*)(ar + 4 * lane), v1 = *(const f32x4*)(ar + 256 + 4 * lane), v2 = *(const f32x4*)(ar + 512 + 4 * lane);
        const float s0 = v0[0] * v0[0] + v0[1] * v0[1] + v0[2] * v0[2] + v0[3] * v0[3];
        const float s1 = v1[0] * v1[0] + v1[1] * v1[1] + v1[2] * v1[2] + v1[3] * v1[3];
        const float s2 = v2[0] * v2[0] + v2[1] * v2[1] + v2[2] * v2[2] + v2[3] * v2[3];
        const float ssq = wave_sum(s0 + (lane < 32 ? s1 : 0.f));
        const float sskv = wave_sum((lane >= 32 ? s1 : 0.f) + (lane < 32 ? s2 : 0.f));
        const float rq = 1.0f / sqrtf(ssq * (1.0f / 384.0f) + RMS_EPS), rkv = 1.0f / sqrtf(sskv * (1.0f / 256.0f) + RMS_EPS);
        { const f32x4 w = *(const f32x4*)(qnw + 4 * lane); u32x2 o; o.x = cvt_pk_bf16(v0[0] * rq * w[0], v0[1] * rq * w[1]); o.y = cvt_pk_bf16(v0[2] * rq * w[2], v0[3] * rq * w[3]);
          *(u32x2*)(cqn + (size_t)t * 384 + 4 * lane) = o; }
        if (lane < 32) { const f32x4 w = *(const f32x4*)(qnw + 256 + 4 * lane); u32x2 o; o.x = cvt_pk_bf16(v1[0] * rq * w[0], v1[1] * rq * w[1]); o.y = cvt_pk_bf16(v1[2] * rq * w[2], v1[3] * rq * w[3]);
          *(u32x2*)(cqn + (size_t)t * 384 + 256 + 4 * lane) = o; }
        else { const int ix = 4 * (lane - 32); const f32x4 w = *(const f32x4*)(kvnw + ix); u32x2 o; o.x = cvt_pk_bf16(v1[0] * rkv * w[0], v1[1] * rkv * w[1]); o.y = cvt_pk_bf16(v1[2] * rkv * w[2], v1[3] * rkv * w[3]);
          *(u32x2*)(ckvn + (size_t)t * 256 + ix) = o; }
        if (lane < 32) { const int ix = 128 + 4 * lane; const f32x4 w = *(const f32x4*)(kvnw + ix); u32x2 o; o.x = cvt_pk_bf16(v2[0] * rkv * w[0], v2[1] * rkv * w[1]); o.y = cvt_pk_bf16(v2[2] * rkv * w[2], v2[3] * rkv * w[3]);
          *(u32x2*)(ckvn + (size_t)t * 256 + ix) = o; }
        else if (lane < 48) { *(LAS f32x4*)(scr + 4 * (lane - 32)) = v2; }
        LDS_WAIT(); asm volatile("" ::: "memory");
        if (lane < 32) { const int pos = tok_pos(t); const float a = scr[lane], b = scr[lane + 32], cs = cosT[pos * 32 + lane], sn = sinT[pos * 32 + lane];
            krope[(size_t)t * 64 + lane] = f2bf(a * cs - b * sn); krope[(size_t)t * 64 + 32 + lane] = f2bf(b * cs + a * sn); }
        LDS_WAIT(); asm volatile("" ::: "memory");
    }
}
__device__ __forceinline__ void mla_qrope(const Ctx& c) {
    bf16_t* q = (bf16_t*)(c.ws + B_Q);
    const float* cosT = (const float*)(c.ws + WS_ROPE); const float* sinT = cosT + 8192 * 32;
    const int lane = c.lane, i = lane & 31;
    for (int t = c.gw; t < T; t += c.NGW) {
        const int pos = tok_pos(t); const float cs = cosT[pos * 32 + i], sn = sinT[pos * 32 + i];
#pragma unroll
        for (int k = 0; k < 4; ++k) { const int h = (lane >> 5) + 2 * k; bf16_t* p = q + (size_t)t * 1536 + h * 192 + 128 + i;
            const float a = bf2f(p[0]), b = bf2f(p[32]); p[0] = f2bf(a * cs - b * sn); p[32] = f2bf(b * cs + a * sn); }
    }
}
__device__ __forceinline__ void mla_attention(const Ctx& c) {
    const bf16_t* Q = (const bf16_t*)(c.ws + B_Q); const bf16_t* KV = (const bf16_t*)(c.ws + B_KV); const bf16_t* KR = (const bf16_t*)(c.ws + B_KROPE); bf16_t* O = (bf16_t*)(c.ws + B_O);
    const int NU = 512 + 2048;
    for (int u = c.bid; u < NU; u += c.G) {
        int tok0, qb, h, seq;
        if (u < 512) { const int round = u >> 8, cc = u & 255, bh = round * 8 + (cc & 7); tok0 = (bh >> 3) * SP; h = bh & 7; qb = cc >> 3; seq = SP; }
        else { const int us = u - 512, round = us >> 8, cc = us & 255, r = cc >> 3, bh = round * 32 + (cc & 7) * 4 + (r >> 3); tok0 = TP + (bh >> 3) * SS; h = bh & 7; qb = r & 7; seq = SS; }
        attn::attn_body(Q + (size_t)(tok0 + qb * 256) * 1536 + h * 192, KV + (size_t)tok0 * 2048 + h * 256, KR + (size_t)tok0 * 64,
                        O + (size_t)(tok0 + qb * 256) * 1024 + h * 128, seq, (char*)c.lds, c.tid, qb * 256, (const float*)(c.ws + WS_ROPE));
        __syncthreads();
    }
}
template <int NU, bool W8> __device__ __forceinline__ void ln_rows(f32x4 (&v)[NU][4], const float* g, const float* b, int lane, bf16_t* const (&dst)[NU], unsigned char* const (&dst8)[NU], float* const (&dsc)[NU]) {
    float s[NU], s2[NU];
#pragma unroll
    for (int u = 0; u < NU; ++u) { s[u] = 0.f;
#pragma unroll
        for (int j = 0; j < 4; ++j) s[u] += (v[u][j][0] + v[u][j][1]) + (v[u][j][2] + v[u][j][3]); }
#pragma unroll
    for (int u = 0; u < NU; ++u) s[u] = wave_sum(s[u]) * (1.0f / D);
#pragma unroll
    for (int u = 0; u < NU; ++u) { s2[u] = 0.f;
#pragma unroll
        for (int j = 0; j < 4; ++j) { v[u][j] = v[u][j] - s[u]; s2[u] += (v[u][j][0] * v[u][j][0] + v[u][j][1] * v[u][j][1]) + (v[u][j][2] * v[u][j][2] + v[u][j][3] * v[u][j][3]); } }
#pragma unroll
    for (int u = 0; u < NU; ++u) s2[u] = 1.0f / sqrtf(wave_sum(s2[u]) * (1.0f / D) + LN_EPS);
    float am[NU];
#pragma unroll
    for (int u = 0; u < NU; ++u) am[u] = 0.f;
#pragma unroll
    for (int j = 0; j < 4; ++j) { const f32x4 gg = *(const f32x4*)(g + 256 * j + 4 * lane), bb = *(const f32x4*)(b + 256 * j + 4 * lane);
#pragma unroll
        for (int u = 0; u < NU; ++u) { const f32x4 o = v[u][j] * s2[u] * gg + bb; u32x2 w; w.x = cvt_pk_bf16(o[0], o[1]); w.y = cvt_pk_bf16(o[2], o[3]); *(u32x2*)(dst[u] + 256 * j + 4 * lane) = w;
            if (W8) { v[u][j] = o; am[u] = fmaxf(am[u], fmaxf(fmaxf(fabsf(o[0]), fabsf(o[1])), fmaxf(fabsf(o[2]), fabsf(o[3])))); } } }
    if (W8) {
#pragma unroll
        for (int u = 0; u < NU; ++u) { const float mx = fmaxf(wave_max(am[u]), 1e-20f), inv = 240.0f / mx;
#pragma unroll
            for (int j = 0; j < 4; ++j) { int q = 0; q = __builtin_amdgcn_cvt_pk_fp8_f32(v[u][j][0] * inv, v[u][j][1] * inv, q, false); q = __builtin_amdgcn_cvt_pk_fp8_f32(v[u][j][2] * inv, v[u][j][3] * inv, q, true);
                *(unsigned*)(dst8[u] + 256 * j + 4 * lane) = (unsigned)q; }
            if (lane == 0) *dsc[u] = mx * (1.0f / 240.0f); }
    }
}
__device__ __forceinline__ void ln_residual(const Ctx& c, const bf16_t* hb, const float* g, const float* b) {
    const bf16_t* xm = (const bf16_t*)c.out; bf16_t* xa = (bf16_t*)(c.ws + WS_XB); const int lane = c.lane;
    constexpr int NU = 4;
    for (int t0 = c.gw * NU; t0 < T; t0 += c.NGW * NU) {
        f32x4 v[NU][4]; bf16_t* dst[NU]; unsigned char* dst8[NU]; float* dsc[NU];
#pragma unroll
        for (int u = 0; u < NU; ++u) { const bf16_t* xr = xm + (size_t)(t0 + u) * D; const bf16_t* hr = hb + (size_t)(t0 + u) * D; dst[u] = xa + (size_t)(t0 + u) * D;
            dst8[u] = c.ws + B_X8 + (size_t)(t0 + u) * D; dsc[u] = (float*)(c.ws + B_XS) + (t0 + u);
#pragma unroll
            for (int j = 0; j < 4; ++j) { const u32x2 xw = *(const u32x2*)(xr + 256 * j + 4 * lane), hw = *(const u32x2*)(hr + 256 * j + 4 * lane);
                v[u][j] = (f32x4){bflo(xw.x), bfhi(xw.x), bflo(xw.y), bfhi(xw.y)} * DN_ALPHA + (f32x4){bflo(hw.x), bfhi(hw.x), bflo(hw.y), bfhi(hw.y)}; } }
        ln_rows<NU, false>(v, g, b, lane, dst, dst8, dsc);
    }
}
__device__ __forceinline__ void hgrn_post(const Ctx& c, int j) {
    bf16_t* pl = (bf16_t*)(c.ws + B_PLANE); const size_t PE = (size_t)T * 1024;
    const bf16_t* of = pl + 1 * PE; const bf16_t* ob = pl + 2 * PE; const bf16_t* sg = pl + 4 * PE; bf16_t* on = pl;
    const float* nw = c.in(12) + j * 128; const int lane = c.lane;
    const int cw = (8 * lane) & 127; const f32x4 w0 = *(const f32x4*)(nw + cw), w1 = *(const f32x4*)(nw + cw + 4);
    constexpr int NU = 4;
    for (int t0 = c.gw * NU; t0 < T; t0 += c.NGW * NU) {
        u32x4 a[NU][2], b[NU][2], g[NU][2];
#pragma unroll
        for (int u = 0; u < NU; ++u)
#pragma unroll
            for (int k = 0; k < 2; ++k) { const size_t off = (size_t)(t0 + u) * 1024 + 512 * k + 8 * lane;
                a[u][k] = *(const u32x4*)(of + off); b[u][k] = *(const u32x4*)(ob + off); g[u][k] = *(const u32x4*)(sg + off); }
#pragma unroll
        for (int u = 0; u < NU; ++u)
#pragma unroll
            for (int k = 0; k < 2; ++k) { const size_t off = (size_t)(t0 + u) * 1024 + 512 * k + 8 * lane;
                float o[8], gg[8]; float ss = 0.f;
#pragma unroll
                for (int q = 0; q < 4; ++q) { o[2 * q] = bflo(a[u][k][q]) + bflo(b[u][k][q]); o[2 * q + 1] = bfhi(a[u][k][q]) + bfhi(b[u][k][q]); gg[2 * q] = bflo(g[u][k][q]); gg[2 * q + 1] = bfhi(g[u][k][q]); }
#pragma unroll
                for (int e = 0; e < 8; ++e) ss += o[e] * o[e];
                ss = row16_sum(ss);
                const float r = 1.0f / sqrtf(ss * (1.0f / 128.0f) + RMS_EPS);
                u32x4 w; w.x = cvt_pk_bf16(o[0] * r * w0[0] * gg[0], o[1] * r * w0[1] * gg[1]); w.y = cvt_pk_bf16(o[2] * r * w0[2] * gg[2], o[3] * r * w0[3] * gg[3]);
                w.z = cvt_pk_bf16(o[4] * r * w1[0] * gg[4], o[5] * r * w1[1] * gg[5]); w.w = cvt_pk_bf16(o[6] * r * w1[2] * gg[6], o[7] * r * w1[3] * gg[7]);
                *(u32x4*)(on + off) = w; }
    }
}
namespace scan {
constexpr size_t D_F = R2_IDX, D_B = R2_IDX + 12 * MiB;
constexpr int NCH = T / 32;
__device__ __forceinline__ void hgrn_prep(const Ctx& c) {
    bf16_t* pl = (bf16_t*)(c.ws + B_PLANE); const size_t PE = (size_t)T * 1024;
    bf16_t* qs = pl; bf16_t* lff = pl + PE; bf16_t* lfb = pl + 2 * PE; bf16_t* qtb = (bf16_t*)(c.ws + WS_XB);
    float* dF = (float*)(c.ws + D_F); float* dB = (float*)(c.ws + D_B);
    const int lane = c.lane;
#define PREP_STEP(LW, QW, QDST, KDST, R0, R1) { const unsigned lw = (LW), qw = (QW); const float l0 = bflo(lw), l1 = bfhi(lw); R0 += l0; R1 += l1; \
        const float k0 = 1.0f - fast_exp(l0), k1 = 1.0f - fast_exp(l1); \
        *(unsigned*)(QDST) = cvt_pk_bf16(bflo(qw) * fast_exp(R0), bfhi(qw) * fast_exp(R1)); \
        *(unsigned*)(KDST) = cvt_pk_bf16(k0 * fast_exp(fminf(-R0, 80.f)), k1 * fast_exp(fminf(-R1, 80.f))); }
    const char* qsB = (const char*)qs; const char* lffB = (const char*)lff; const char* lfbB = (const char*)lfb; const char* qtbB = (const char*)qtb;
    for (int it = c.gw; it < NCH * 8; it += c.NGW) {
        const int chunk = it >> 3, h = it & 7; const unsigned base = ((unsigned)chunk * 32u * 1024u + (unsigned)h * 128u + 2u * (unsigned)lane) * 2u;
        float b0 = 0.f, b1 = 0.f, f0 = 0.f, f1 = 0.f;
#define LDW(P, O) (*(const unsigned*)((P) + (O)))
#define STP(P, O) ((unsigned*)((char*)(P) + (O)))
        { unsigned wb[16], wq[16];
#pragma unroll
          for (int i = 0; i < 16; ++i) { const unsigned o = base + (unsigned)(16 + i) * 2048u; wb[i] = LDW(lfbB, o); wq[i] = LDW(qsB, o); }
#pragma unroll
          for (int i = 15; i >= 0; --i) { const unsigned o = base + (unsigned)(16 + i) * 2048u; PREP_STEP(wb[i], wq[i], STP(qtbB, o), STP(lfbB, o), b0, b1) } }
        { unsigned wb[16], wq[16], wf[16];
#pragma unroll
          for (int i = 0; i < 16; ++i) { const unsigned o = base + (unsigned)i * 2048u; wb[i] = LDW(lfbB, o); wq[i] = LDW(qsB, o); wf[i] = LDW(lffB, o); }
#pragma unroll
          for (int i = 15; i >= 0; --i) { const unsigned o = base + (unsigned)i * 2048u; PREP_STEP(wb[i], wq[i], STP(qtbB, o), STP(lfbB, o), b0, b1) }
          *(f32x2*)(dB + (size_t)chunk * 1024 + h * 128 + 2 * lane) = (f32x2){fast_exp(b0), fast_exp(b1)};
#pragma unroll
          for (int i = 0; i < 16; ++i) { const unsigned o = base + (unsigned)i * 2048u; PREP_STEP(wf[i], wq[i], STP(qsB, o), STP(lffB, o), f0, f1) } }
        { unsigned wf[16], wq[16];
#pragma unroll
          for (int i = 0; i < 16; ++i) { const unsigned o = base + (unsigned)(16 + i) * 2048u; wf[i] = LDW(lffB, o); wq[i] = LDW(qsB, o); }
#pragma unroll
          for (int i = 0; i < 16; ++i) { const unsigned o = base + (unsigned)(16 + i) * 2048u; PREP_STEP(wf[i], wq[i], STP(qsB, o), STP(lffB, o), f0, f1) }
          *(f32x2*)(dF + (size_t)chunk * 1024 + h * 128 + 2 * lane) = (f32x2){fast_exp(f0), fast_exp(f1)}; }
    }
#undef LDW
#undef STP
#undef PREP_STEP
}

constexpr int QT_OFF = 0, KT_OFF = 8192, V_OFF = 16384, P_OFF = 24576, ST_OFF = 34816, DV_OFF = 69632, CHAIN_BYTES = 70144;
constexpr int RS = 272, RS2 = 80;
__device__ __forceinline__ int crow(int r, int hi) { return (r & 3) + 8 * (r >> 2) + 4 * hi; }
__device__ __forceinline__ unsigned off_b(unsigned row, unsigned ch) { return 256u * row + 16u * (ch ^ (((row & 3) << 2) | ((row >> 2) & 3))); }
__device__ __forceinline__ unsigned row_read_addr(unsigned lane, unsigned s) { return off_b(lane & 31, 2 * s + (lane >> 5)); }
__device__ __forceinline__ unsigned tr_read_addr(unsigned lane, unsigned cc, unsigned ks, unsigned t) {
    const unsigned h = lane >> 5, blk = (lane >> 4) & 1, q = (lane & 15) >> 2, p = lane & 3;
    return off_b(16 * ks + 8 * h + 4 * t + q, 4 * cc + 2 * blk + (p >> 1)) + 8 * (p & 1);
}
__device__ __forceinline__ s16x4 tr_rd(unsigned addr) { s16x4 r; asm volatile("ds_read_b64_tr_b16 %0, %1" : "=&v"(r) : "v"(addr) : "memory"); return r; }
#define TRPK(L, H) (bf16x8){L[0], L[1], L[2], L[3], H[0], H[1], H[2], H[3]}

__device__ __forceinline__ void run_pair(const Ctx& c, int tok0, int L, int h, bool dummy) {
    bf16_t* pl = (bf16_t*)(c.ws + B_PLANE); const size_t PE = (size_t)T * 1024;
    const int tid = c.tid, lane = c.lane, wave = c.wave, ch = wave >> 2, w = wave & 3, r32 = lane & 31, hi = lane >> 5;
    const bf16_t* qt = ch ? (const bf16_t*)(c.ws + WS_XB) : pl; bf16_t* kt = pl + (size_t)(1 + ch) * PE; const bf16_t* vv = pl + 3 * PE;
    const float* dd = (const float*)(c.ws + (ch ? D_B : D_F));
    bf16_t* odst = dummy ? (bf16_t*)(c.ws + R2_PB) - (size_t)20 * MiB : kt;
    LAS unsigned char* base = c.lds + ch * CHAIN_BYTES;
    const unsigned lbase = (unsigned)(uintptr_t)base;
    const int ctid = tid & 255;
    const int NC = L / 32;
    const int vcol = 32 * w + r32;
    LAS unsigned char* Pw = base + P_OFF + w * 2560;
    const int s_r0 = ctid >> 4, s_chn = ctid & 15;
    u32x4 sreg[6]; f32x4 dreg = (f32x4){0.f, 0.f, 0.f, 0.f};
#define SCAN_LOAD(cidx) do { const size_t rowb = (size_t)(tok0 + 32 * (cidx)) * 1024 + h * 128; \
        _Pragma("unroll") for (int i = 0; i < 6; ++i) { const bf16_t* src = ((i >> 1) == 0 ? qt : ((i >> 1) == 1 ? (const bf16_t*)kt : vv)) + rowb + (size_t)(s_r0 + 16 * (i & 1)) * 1024 + s_chn * 8; sreg[i] = *(const u32x4*)src; } \
        if (ctid < 32) dreg = *(const f32x4*)(dd + (size_t)((tok0 >> 5) + (cidx)) * 1024 + h * 128 + 4 * ctid); } while (0)
#define SCAN_WRITE() do { _Pragma("unroll") for (int i = 0; i < 6; ++i) *(LAS u32x4*)(base + (i >> 1) * 8192 + off_b(s_r0 + 16 * (i & 1), s_chn)) = sreg[i]; \
        if (ctid < 32) *(LAS f32x4*)(base + DV_OFF + 16 * ctid) = dreg; } while (0)
    { LAS u32x4* st = (LAS u32x4*)(base + ST_OFF + (32 * w) * RS); for (int i = lane; i < 32 * RS / 16; i += 64) st[i] = (u32x4){0u, 0u, 0u, 0u}; }
    f32x16 S[4];
#pragma unroll
    for (int kt2 = 0; kt2 < 4; ++kt2) S[kt2] = f32x16{};
    SCAN_LOAD(ch ? NC - 1 : 0); SCAN_WRITE();
    __syncthreads();
    for (int ci = 0; ci < NC; ++ci) {
        const int cidx = ch ? NC - 1 - ci : ci;
        if (ci + 1 < NC) SCAN_LOAD(ch ? cidx - 1 : cidx + 1);
        f32x16 X = f32x16{};
#pragma unroll
        for (int ks = 0; ks < 8; ++ks) { const bf16x8 qa = *(const LAS bf16x8*)(base + QT_OFF + row_read_addr(lane, ks));
            const bf16x8 kb = *(const LAS bf16x8*)(base + KT_OFF + row_read_addr(lane, ks));
            X = __builtin_amdgcn_mfma_f32_32x32x16_bf16(qa, kb, X, 0, 0, 0); }
#pragma unroll
        for (int r = 0; r < 16; ++r) { const int t = crow(r, hi); const bool keep = ch ? (t <= r32) : (t >= r32); *(LAS bf16_t*)(Pw + t * RS2 + r32 * 2) = f2bf(keep ? X[r] : 0.f); }
        s16x4 vl[2], vh[2];
#pragma unroll
        for (int ks = 0; ks < 2; ++ks) { vl[ks] = tr_rd(lbase + V_OFF + tr_read_addr(lane, w, ks, 0)); vh[ks] = tr_rd(lbase + V_OFF + tr_read_addr(lane, w, ks, 1)); }
        asm volatile("s_waitcnt lgkmcnt(0)" ::: "memory"); __builtin_amdgcn_sched_barrier(0);
        bf16x8 vb[2];
#pragma unroll
        for (int ks = 0; ks < 2; ++ks) vb[ks] = TRPK(vl[ks], vh[ks]);
        f32x16 O = f32x16{};
#pragma unroll
        for (int ks = 0; ks < 2; ++ks) { const bf16x8 pa = *(const LAS bf16x8*)(Pw + r32 * RS2 + (16 * ks + 8 * hi) * 2);
            O = __builtin_amdgcn_mfma_f32_32x32x16_bf16(pa, vb[ks], O, 0, 0, 0); }
#pragma unroll
        for (int ks = 0; ks < 8; ++ks) { const bf16x8 sb = *(const LAS bf16x8*)(base + ST_OFF + vcol * RS + (16 * ks + 8 * hi) * 2);
            const bf16x8 qa = *(const LAS bf16x8*)(base + QT_OFF + row_read_addr(lane, ks));
            O = __builtin_amdgcn_mfma_f32_32x32x16_bf16(qa, sb, O, 0, 0, 0); }
#pragma unroll
        for (int r = 0; r < 16; ++r) { const int t = tok0 + 32 * cidx + crow(r, hi); odst[(size_t)t * 1024 + h * 128 + vcol] = f2bf(O[r]); }
#pragma unroll
        for (int kt2 = 0; kt2 < 4; ++kt2) {
            s16x4 al[2], ah[2];
#pragma unroll
            for (int ks = 0; ks < 2; ++ks) { al[ks] = tr_rd(lbase + KT_OFF + tr_read_addr(lane, kt2, ks, 0)); ah[ks] = tr_rd(lbase + KT_OFF + tr_read_addr(lane, kt2, ks, 1)); }
            asm volatile("s_waitcnt lgkmcnt(0)" ::: "memory"); __builtin_amdgcn_sched_barrier(0);
#pragma unroll
            for (int ks = 0; ks < 2; ++ks) S[kt2] = __builtin_amdgcn_mfma_f32_32x32x16_bf16(TRPK(al[ks], ah[ks]), vb[ks], S[kt2], 0, 0, 0);
#pragma unroll
            for (int g = 0; g < 4; ++g) { const f32x4 d4 = *(const LAS f32x4*)(base + DV_OFF + (32 * kt2 + 8 * g + 4 * hi) * 4);
#pragma unroll
                for (int e = 0; e < 4; ++e) S[kt2][4 * g + e] *= d4[e];
                u32x2 pk; pk.x = cvt_pk_bf16(S[kt2][4 * g], S[kt2][4 * g + 1]); pk.y = cvt_pk_bf16(S[kt2][4 * g + 2], S[kt2][4 * g + 3]);
                *(LAS u32x2*)(base + ST_OFF + vcol * RS + (32 * kt2 + 8 * g + 4 * hi) * 2) = pk; }
        }
        __syncthreads();
        if (ci + 1 < NC) SCAN_WRITE();
        __syncthreads();
    }
#undef SCAN_LOAD
#undef SCAN_WRITE
}
#undef TRPK
__device__ __forceinline__ void hgrn_scan(const Ctx& c, bool dummy) {
    const int NP = 16 + 256;
    for (int rnd = 0;; ++rnd) {
        const int p = (rnd & 1) ? (rnd * c.G + (c.G - 1 - c.bid)) : (rnd * c.G + c.bid);
        if (rnd * c.G >= NP) break;
        if (p < NP) {
            const int tok0 = p < 16 ? (p >> 3) * SP : TP + ((p - 16) >> 3) * SS, L = p < 16 ? SP : SS, h = p < 16 ? (p & 7) : ((p - 16) & 7);
            run_pair(c, tok0, L, h, dummy);
        }
    }
}
}
#define CE_(a, i, j) { const unsigned _x = a[i] > a[j] ? a[i] : a[j], _y = a[i] > a[j] ? a[j] : a[i]; a[i] = _x; a[j] = _y; }
__device__ __forceinline__ void sort16_desc(unsigned (&a)[16]) {
    CE_(a, 0, 1) CE_(a, 2, 3) CE_(a, 0, 2) CE_(a, 1, 3) CE_(a, 1, 2) CE_(a, 4, 5) CE_(a, 6, 7) CE_(a, 4, 6) CE_(a, 5, 7) CE_(a, 5, 6) CE_(a, 0, 4) CE_(a, 2, 6) CE_(a, 2, 4) CE_(a, 1, 5) CE_(a, 3, 7) CE_(a, 3, 5) CE_(a, 1, 2) CE_(a, 3, 4) CE_(a, 5, 6) CE_(a, 8, 9) CE_(a, 10, 11) CE_(a, 8, 10) CE_(a, 9, 11) CE_(a, 9, 10) CE_(a, 12, 13) CE_(a, 14, 15) CE_(a, 12, 14) CE_(a, 13, 15) CE_(a, 13, 14) CE_(a, 8, 12) CE_(a, 10, 14) CE_(a, 10, 12) CE_(a, 9, 13) CE_(a, 11, 15) CE_(a, 11, 13) CE_(a, 9, 10) CE_(a, 11, 12) CE_(a, 13, 14) CE_(a, 0, 8) CE_(a, 4, 12) CE_(a, 4, 8) CE_(a, 2, 10) CE_(a, 6, 14) CE_(a, 6, 10) CE_(a, 2, 4) CE_(a, 6, 8) CE_(a, 10, 12) CE_(a, 1, 9) CE_(a, 5, 13) CE_(a, 5, 9) CE_(a, 3, 11) CE_(a, 7, 15) CE_(a, 7, 11) CE_(a, 3, 5) CE_(a, 7, 9) CE_(a, 11, 13) CE_(a, 1, 2) CE_(a, 3, 4) CE_(a, 5, 6) CE_(a, 7, 8) CE_(a, 9, 10) CE_(a, 11, 12) CE_(a, 13, 14)
}
__device__ __forceinline__ void merge16_top(unsigned (&a)[16], const unsigned (&b)[16]) {
    a[0] = a[0] > b[15] ? a[0] : b[15]; a[1] = a[1] > b[14] ? a[1] : b[14]; a[2] = a[2] > b[13] ? a[2] : b[13]; a[3] = a[3] > b[12] ? a[3] : b[12]; a[4] = a[4] > b[11] ? a[4] : b[11]; a[5] = a[5] > b[10] ? a[5] : b[10]; a[6] = a[6] > b[9] ? a[6] : b[9]; a[7] = a[7] > b[8] ? a[7] : b[8]; a[8] = a[8] > b[7] ? a[8] : b[7]; a[9] = a[9] > b[6] ? a[9] : b[6]; a[10] = a[10] > b[5] ? a[10] : b[5]; a[11] = a[11] > b[4] ? a[11] : b[4]; a[12] = a[12] > b[3] ? a[12] : b[3]; a[13] = a[13] > b[2] ? a[13] : b[2]; a[14] = a[14] > b[1] ? a[14] : b[1]; a[15] = a[15] > b[0] ? a[15] : b[0];
    CE_(a, 0, 8) CE_(a, 1, 9) CE_(a, 2, 10) CE_(a, 3, 11) CE_(a, 4, 12) CE_(a, 5, 13) CE_(a, 6, 14) CE_(a, 7, 15) CE_(a, 0, 4) CE_(a, 1, 5) CE_(a, 2, 6) CE_(a, 3, 7) CE_(a, 8, 12) CE_(a, 9, 13) CE_(a, 10, 14) CE_(a, 11, 15) CE_(a, 0, 2) CE_(a, 1, 3) CE_(a, 4, 6) CE_(a, 5, 7) CE_(a, 8, 10) CE_(a, 9, 11) CE_(a, 12, 14) CE_(a, 13, 15) CE_(a, 0, 1) CE_(a, 2, 3) CE_(a, 4, 5) CE_(a, 6, 7) CE_(a, 8, 9) CE_(a, 10, 11) CE_(a, 12, 13) CE_(a, 14, 15)
}
namespace peer {
constexpr int KEY_RS = 272;
constexpr int KEYS_BYTES = 2 * 128 * KEY_RS;
constexpr int SI_OFF = KEYS_BYTES;
__device__ __forceinline__ int crow(int r, int hi) { return (r & 3) + 8 * (r >> 2) + 4 * hi; }
__device__ __forceinline__ unsigned sortable(float f) { const unsigned u = __float_as_uint(f); return u ^ ((u >> 31) ? 0xFFFFFFFFu : 0x80000000u); }
__device__ __forceinline__ float unsortable(unsigned s) { const unsigned u = (s >> 31) ? (s ^ 0x80000000u) : ~s; return __uint_as_float(u); }
__device__ __forceinline__ unsigned pair_max(unsigned m) { auto rr = __builtin_amdgcn_permlane32_swap(m, m, false, false); return rr[0] > rr[1] ? rr[0] : rr[1]; }

__device__ __forceinline__ void top16_half(const Ctx& c, const bf16_t* pq_rows, int half, LAS unsigned char* keys, unsigned (&sel)[16]) {
    const int lane = c.lane, r32 = lane & 31, hi = lane >> 5;
    f32x16 acc[4];
#pragma unroll
    for (int nt = 0; nt < 4; ++nt) acc[nt] = f32x16{};
    const bf16_t* qrow = pq_rows + (size_t)r32 * 256 + half * 128;
#pragma unroll 1
    for (int ks = 0; ks < 8; ++ks) { const bf16x8 qb = *reinterpret_cast<const bf16x8*>(qrow + 16 * ks + 8 * hi);
#pragma unroll
        for (int nt = 0; nt < 4; ++nt) { const bf16x8 ka = *(const LAS bf16x8*)(keys + (half * 128 + 32 * nt + r32) * KEY_RS + (16 * ks + 8 * hi) * 2);
            acc[nt] = __builtin_amdgcn_mfma_f32_32x32x16_bf16(ka, qb, acc[nt], 0, 0, 0); } }
    unsigned p[64];
#pragma unroll
    for (int nt = 0; nt < 4; ++nt)
#pragma unroll
        for (int r = 0; r < 16; ++r) { const int n = 32 * nt + crow(r, hi); p[nt * 16 + r] = (sortable(acc[nt][r]) & ~127u) | (unsigned)(127 - n); }
    unsigned g0[16], g1[16], g2[16], g3[16];
#pragma unroll
    for (int i = 0; i < 16; ++i) { g0[i] = p[i]; g1[i] = p[16 + i]; g2[i] = p[32 + i]; g3[i] = p[48 + i]; }
    sort16_desc(g0); sort16_desc(g1); sort16_desc(g2); sort16_desc(g3);
    merge16_top(g0, g1); merge16_top(g2, g3); merge16_top(g0, g2);
    unsigned pb[16];
#pragma unroll
    for (int i = 0; i < 16; ++i) { auto rr = __builtin_amdgcn_permlane32_swap(g0[i], g0[i], false, false); sel[i] = rr[0]; pb[i] = rr[1]; }
    merge16_top(sel, pb);
}
__device__ __forceinline__ void route(const Ctx& c, int layer) {
    const bf16_t* pq = (const bf16_t*)(c.ws + B_PQ); int* idx_out = (int*)(c.ws + R2_IDX); float* gate_out = (float*)(c.ws + R2_GATE);
    const bf16_t* keys_g = (const bf16_t*)(c.ws + W_KEYS) + (size_t)layer * 2 * 128 * 128;
    LAS unsigned char* keys = c.lds;
    const int lane = c.lane, r32 = lane & 31, hi = lane >> 5;
    for (int i = c.tid; i < 2 * 128 * 16; i += NTHR) { const int row = i >> 4, ch = i & 15; *(LAS u32x4*)(keys + row * KEY_RS + ch * 16) = *(const u32x4*)(keys_g + (size_t)row * 128 + ch * 8); }
    __syncthreads();
    LAS int* si = (LAS int*)(c.lds + SI_OFF + c.wave * 4096) + r32 * 32;
    for (int grp = c.gw; grp < T / 4; grp += c.NGW) {
        const bf16_t* rows = pq + (size_t)grp * 4 * 2048;
        unsigned s1[16], s2[16];
        top16_half(c, rows, 0, keys, s1);
        top16_half(c, rows, 1, keys, s2);
        float v1[16], v2[16];
#pragma unroll
        for (int i = 0; i < 16; ++i) { v1[i] = unsortable(s1[i] & ~127u); v2[i] = unsortable(s2[i] & ~127u); }
        if (hi == 0) {
#pragma unroll
            for (int i = 0; i < 16; ++i) { si[i] = 127 - (int)(s1[i] & 127u); si[16 + i] = 127 - (int)(s2[i] & 127u); }
        }
        float A[16], B[16];
#pragma unroll
        for (int i = 0; i < 16; ++i) { A[i] = hi ? v2[i] : v1[i]; B[i] = hi ? v1[i] : v2[i]; }
        unsigned cd[27]; int nc = 0;
#pragma unroll
        for (int i = 0; i < 16; ++i)
#pragma unroll
            for (int j = i; j < 16; ++j) if ((i + 1) * (j + 1) <= 16) {
                const unsigned flat = hi ? (unsigned)(j * 16 + i) : (unsigned)(i * 16 + j);
                unsigned pk = (sortable(A[i] + B[j]) & ~255u) | (255u - flat);
                if (i == j) pk = hi ? 0u : pk;
                cd[nc++] = pk; }
        unsigned sel[16], c1[16], pb[16];
#pragma unroll
        for (int i = 0; i < 16; ++i) { sel[i] = cd[i]; c1[i] = (16 + i < 27) ? cd[(16 + i < 27) ? 16 + i : 0] : 0u; }
        sort16_desc(sel); sort16_desc(c1); merge16_top(sel, c1);
#pragma unroll
        for (int i = 0; i < 16; ++i) { auto rr = __builtin_amdgcn_permlane32_swap(sel[i], sel[i], false, false); sel[i] = rr[0]; pb[i] = rr[1]; }
        merge16_top(sel, pb);
        LDS_WAIT(); asm volatile("" ::: "memory");
        const float vmax = unsortable(sel[0] & ~255u);
        float e[16], es = 0.f;
#pragma unroll
        for (int i = 0; i < 16; ++i) { e[i] = fast_exp(unsortable(sel[i] & ~255u) - vmax); es += e[i]; }
        const float inv = 1.0f / es;
        const size_t obase = ((size_t)grp * 4 + (r32 >> 3)) * 128 + (r32 & 7) * 16 + 8 * hi;
        int oi[8]; float og[8];
#pragma unroll
        for (int q = 0; q < 8; ++q) { const unsigned sv = hi ? sel[8 + q] : sel[q]; const float ev = hi ? e[8 + q] : e[q];
            const int flat = 255 - (int)(sv & 255u); oi[q] = si[flat >> 4] * 128 + si[16 + (flat & 15)]; og[q] = ev * inv; }
        *(u32x4*)(idx_out + obase) = (u32x4){(unsigned)oi[0], (unsigned)oi[1], (unsigned)oi[2], (unsigned)oi[3]};
        *(u32x4*)(idx_out + obase + 4) = (u32x4){(unsigned)oi[4], (unsigned)oi[5], (unsigned)oi[6], (unsigned)oi[7]};
        *(f32x4*)(gate_out + obase) = (f32x4){og[0], og[1], og[2], og[3]};
        *(f32x4*)(gate_out + obase + 4) = (f32x4){og[4], og[5], og[6], og[7]};
        LDS_WAIT(); asm volatile("" ::: "memory");
    }
    __syncthreads();
}

__device__ __forceinline__ float gelu_exact(float x) { return 0.5f * x * (1.0f + erff(x * 0.70710678118654752f)); }
template <int IDXMASK> __device__ __forceinline__ void gather_ln(const Ctx& c, int layer, float* xout, bf16_t* xb) {
    const unsigned char* U8 = c.ws + R2_UB; const unsigned char* V8 = c.ws + R2_VB;
    const float* su = (const float*)(c.ws + R2_SU); const float* sv = (const float*)(c.ws + R2_SV);
    const int* idx = (const int*)(c.ws + R2_IDX); const float* gate = (const float*)(c.ws + R2_GATE);
    const float* lg = c.in(20) + layer * D; const float* lbv = c.in(21) + layer * D;
    const int lane = c.lane;
    for (int t = c.gw; t < T; t += c.NGW) {
        const float* xr = c.out + (size_t)t * D + 16 * lane; float* xw = xout + (size_t)t * D + 16 * lane;
        float x[16], acc[16];
#pragma unroll
        for (int j = 0; j < 4; ++j) { const f32x4 a = *(const f32x4*)(xr + 4 * j); x[4 * j] = a[0]; x[4 * j + 1] = a[1]; x[4 * j + 2] = a[2]; x[4 * j + 3] = a[3]; }
#pragma unroll
        for (int e = 0; e < 16; ++e) acc[e] = 0.f;
        const int myidx0 = idx[(size_t)t * 128 + lane] & IDXMASK, myidx1 = idx[(size_t)t * 128 + 64 + lane] & IDXMASK;
        const float myg0 = gate[(size_t)t * 128 + lane], myg1 = gate[(size_t)t * 128 + 64 + lane];
        for (int eb = 0; eb < 128; eb += 8) {
            float part[8]; int ei[8];
#pragma unroll
            for (int q = 0; q < 8; ++q) { const int e = eb + q; ei[q] = __builtin_amdgcn_readlane(e < 64 ? myidx0 : myidx1, e & 63); }
            u32x4 vr[8];
#pragma unroll
            for (int q = 0; q < 8; ++q) vr[q] = *(const u32x4*)(V8 + (size_t)ei[q] * D + 16 * lane);
#pragma unroll
            for (int q = 0; q < 8; ++q) { const u32x4 a = *(const u32x4*)(U8 + (size_t)ei[q] * D + 16 * lane);
                float s = 0.f;
#pragma unroll
                for (int j = 0; j < 4; ++j) { const f32x2 lo = __builtin_amdgcn_cvt_pk_f32_fp8((int)a[j], false), hi = __builtin_amdgcn_cvt_pk_f32_fp8((int)a[j], true);
                    s = fmaf(lo[0], x[4 * j], s); s = fmaf(lo[1], x[4 * j + 1], s); s = fmaf(hi[0], x[4 * j + 2], s); s = fmaf(hi[1], x[4 * j + 3], s); }
                part[q] = s; }
            float r4[4], r2[2], r1;
            { const bool up = (lane & 32) != 0;
#pragma unroll
              for (int i = 0; i < 4; ++i) { const float send = up ? part[i] : part[4 + i]; const float keep = up ? part[4 + i] : part[i]; r4[i] = keep + __shfl_xor(send, 32); } }
            { const bool up = (lane & 16) != 0;
#pragma unroll
              for (int i = 0; i < 2; ++i) { const float send = up ? r4[i] : r4[2 + i]; const float keep = up ? r4[2 + i] : r4[i]; r2[i] = keep + __shfl_xor(send, 16); } }
            { const bool up = (lane & 8) != 0; const float send = up ? r2[0] : r2[1]; const float keep = up ? r2[1] : r2[0]; r1 = keep + __shfl_xor(send, 8); }
            r1 += __shfl_xor(r1, 4); r1 += __shfl_xor(r1, 2); r1 += __shfl_xor(r1, 1);
            const int myq = ((lane >> 5) & 1) * 4 + ((lane >> 4) & 1) * 2 + ((lane >> 3) & 1);
            const int me = eb + myq;
            const float g = __shfl(me < 64 ? myg0 : myg1, me & 63);
            const int mye = __shfl(me < 64 ? myidx0 : myidx1, me & 63);
            const float cf = g * gelu_exact(r1 * su[mye]) * sv[mye];
            float cq[8];
#pragma unroll
            for (int q = 0; q < 8; ++q) cq[q] = __int_as_float(__builtin_amdgcn_readlane(__float_as_int(cf), ((q >> 2) & 1) * 32 + ((q >> 1) & 1) * 16 + (q & 1) * 8));
#pragma unroll
            for (int q = 0; q < 8; ++q) { const float s = cq[q];
#pragma unroll
                for (int j = 0; j < 4; ++j) { const f32x2 lo = __builtin_amdgcn_cvt_pk_f32_fp8((int)vr[q][j], false), hi = __builtin_amdgcn_cvt_pk_f32_fp8((int)vr[q][j], true);
                    acc[4 * j] = fmaf(s, lo[0], acc[4 * j]); acc[4 * j + 1] = fmaf(s, lo[1], acc[4 * j + 1]); acc[4 * j + 2] = fmaf(s, hi[0], acc[4 * j + 2]); acc[4 * j + 3] = fmaf(s, hi[1], acc[4 * j + 3]); } }
        }
        float s = 0.f;
#pragma unroll
        for (int e = 0; e < 16; ++e) { acc[e] = fmaf(DN_ALPHA, x[e], acc[e]); s += acc[e]; }
        const float mean = wave_sum(s) * (1.0f / D); float s2 = 0.f;
#pragma unroll
        for (int e = 0; e < 16; ++e) { acc[e] -= mean; s2 += acc[e] * acc[e]; }
        const float rstd = 1.0f / sqrtf(wave_sum(s2) * (1.0f / D) + LN_EPS);
        float o[16];
#pragma unroll
        for (int j = 0; j < 4; ++j) { const f32x4 g4 = *(const f32x4*)(lg + 16 * lane + 4 * j), b4 = *(const f32x4*)(lbv + 16 * lane + 4 * j);
#pragma unroll
            for (int e = 0; e < 4; ++e) o[4 * j + e] = acc[4 * j + e] * rstd * g4[e] + b4[e];
            *(f32x4*)(xw + 4 * j) = (f32x4){o[4 * j], o[4 * j + 1], o[4 * j + 2], o[4 * j + 3]}; }
        u32x4 w0, w1; w0.x = cvt_pk_bf16(o[0], o[1]); w0.y = cvt_pk_bf16(o[2], o[3]); w0.z = cvt_pk_bf16(o[4], o[5]); w0.w = cvt_pk_bf16(o[6], o[7]);
        w1.x = cvt_pk_bf16(o[8], o[9]); w1.y = cvt_pk_bf16(o[10], o[11]); w1.z = cvt_pk_bf16(o[12], o[13]); w1.w = cvt_pk_bf16(o[14], o[15]);
        *(u32x4*)(xb + (size_t)t * D + 16 * lane) = w0; *(u32x4*)(xb + (size_t)t * D + 16 * lane + 8) = w1;
    }
}
}
namespace peer {
constexpr size_t HP_OFF = WS_BIG;
constexpr int QW_BASE = 4096;
constexpr int ITEM_TOK = 128, NBLK = T / ITEM_TOK;
constexpr int GT = 1;
#define DPP_F(v, ctrl) __int_as_float(__builtin_amdgcn_update_dpp(0, __float_as_int(v), (ctrl), 0xf, 0xf, true))

template <class F> __device__ __forceinline__ void for_items(const Ctx& c, int layer, int phase, F body) {
    unsigned* qw = (unsigned*)(c.ws + WS_CTL) + QW_BASE + (size_t)((layer * 4 + phase) * 8) * 16;
    volatile LAS int* slot = (volatile LAS int*)(c.lds + LDS_MISC_OFF + 128);
    const int home = (int)(xb_xcc_id() & 7u);
    for (int k = 0; k < 8; ++k) {
        const int s = (home + k) & 7;
        if (c.tid == 0) slot[0] = (int)__hip_atomic_fetch_add(qw + s * 16, 1u, __ATOMIC_RELAXED, __HIP_MEMORY_SCOPE_AGENT);
        __syncthreads();
        int cur = slot[0];
        __syncthreads();
        while (cur < NBLK) {
            if (c.tid == 0) slot[0] = (int)__hip_atomic_fetch_add(qw + s * 16, 1u, __ATOMIC_RELAXED, __HIP_MEMORY_SCOPE_AGENT);
            body(s, cur);
            __syncthreads();
            cur = slot[0];
            __syncthreads();
        }
    }
}

__device__ __forceinline__ void g1_udot(const Ctx& c, int layer, int dup) {
    const unsigned char* U8 = c.ws + R2_UB; const int* idx = (const int*)(c.ws + R2_IDX); float* hp = (float*)(c.ws + HP_OFF);
    for_items(c, layer, 0 + 2 * dup, [&](int s, int blk) {
        int lane = c.lane; asm volatile("" : "+v"(lane));
        const int g = lane >> 3, c8 = lane & 7;
        const int co = 128 * s + 16 * c8;
#pragma unroll 1
        for (int i = 0; i < ITEM_TOK / NWAVES; i += GT) {
            const int t0 = blk * ITEM_TOK + c.wave * (ITEM_TOK / NWAVES) + i;
            float x[GT][16]; int id[GT][16];
#pragma unroll
            for (int u = 0; u < GT; ++u)
#pragma unroll
            for (int j = 0; j < 4; ++j) { const u32x2 a = *(const u32x2*)((const bf16_t*)(c.ws + WS_XB) + (size_t)(t0 + u) * D + co + 4 * j); x[u][4 * j] = bflo(a.x); x[u][4 * j + 1] = bfhi(a.x); x[u][4 * j + 2] = bflo(a.y); x[u][4 * j + 3] = bfhi(a.y);
                const u32x4 q = *(const u32x4*)(idx + (size_t)(t0 + u) * 128 + 16 * g + 4 * j); id[u][4 * j] = (int)q[0]; id[u][4 * j + 1] = (int)q[1]; id[u][4 * j + 2] = (int)q[2]; id[u][4 * j + 3] = (int)q[3]; }
            u32x4 row[GT][16];
#pragma unroll
            for (int u = 0; u < GT; ++u)
#pragma unroll
            for (int j = 0; j < 16; ++j) row[u][j] = *(const u32x4*)(U8 + (size_t)id[u][j] * D + co);
#pragma unroll
            for (int u = 0; u < GT; ++u) {
            float V[16];
#pragma unroll
            for (int j = 0; j < 16; ++j) { f32x2 acc2 = (f32x2){0.f, 0.f};
                if (dup) { V[j] = __uint_as_float((row[u][j][0] ^ row[u][j][1] ^ row[u][j][2] ^ row[u][j][3]) & 0x3fffffffu); continue; }
#pragma unroll
                for (int q = 0; q < 4; ++q) { const f32x2 lo = __builtin_amdgcn_cvt_pk_f32_fp8((int)row[u][j][q], false), hi = __builtin_amdgcn_cvt_pk_f32_fp8((int)row[u][j][q], true);
                    acc2 = __builtin_elementwise_fma(lo, (f32x2){x[u][4 * q], x[u][4 * q + 1]}, acc2); acc2 = __builtin_elementwise_fma(hi, (f32x2){x[u][4 * q + 2], x[u][4 * q + 3]}, acc2); }
                V[j] = acc2[0] + acc2[1]; }
            float W[8], Y[4], Z[2];
            { const bool hiA = (lane & 4) != 0;
#pragma unroll
              for (int m = 0; m < 8; ++m) { const float send = hiA ? V[m] : V[8 + m], keep = hiA ? V[8 + m] : V[m]; W[m] = keep + DPP_F(send, 0x141); } }
            { const bool hiB = (lane & 2) != 0;
#pragma unroll
              for (int m = 0; m < 4; ++m) { const float send = hiB ? W[m] : W[4 + m], keep = hiB ? W[4 + m] : W[m]; Y[m] = keep + DPP_F(send, 0x1B); } }
            { const bool hiC = (lane & 1) != 0;
#pragma unroll
              for (int m = 0; m < 2; ++m) { const float send = hiC ? Y[m] : Y[2 + m], keep = hiC ? Y[2 + m] : Y[m]; Z[m] = keep + DPP_F(send, 0xB1); } }
            *(f32x2*)((dup ? hp + (size_t)160 * MiB : hp) + ((size_t)(dup ? 0 : s) * T + t0 + u) * 128 + 16 * g + 2 * c8) = (f32x2){Z[0], Z[1]};
            }
        }
    });
}
__device__ __forceinline__ void g2_coef(const Ctx& c, int dup) {
    const int* idx = (const int*)(c.ws + R2_IDX); float* gate = (float*)(c.ws + R2_GATE); const float* hp = (const float*)(c.ws + HP_OFF);
    const float* su = (const float*)(c.ws + R2_SU); const float* sv = (const float*)(c.ws + R2_SV);
    float* dstb = dup ? (float*)(c.ws + HP_OFF) + (size_t)170 * MiB : gate;
    const float* xs = (const float*)(c.ws + B_XS);
    const int lane = c.lane;
    constexpr int NU = 4;
    for (int t0 = c.gw * NU; t0 < T; t0 += c.NGW * NU) {
        float h[NU][2]; int e[NU][2]; float gt[NU][2];
#pragma unroll
        for (int u = 0; u < NU; ++u)
#pragma unroll
            for (int k = 0; k < 2; ++k) { const size_t o = (size_t)(t0 + u) * 128 + lane + 64 * k; e[u][k] = idx[o]; gt[u][k] = gate[o]; float a = 0.f;
#pragma unroll
                for (int s = 0; s < 8; ++s) a += hp[(size_t)s * T * 128 + o];
                h[u][k] = a; }
        float s1[NU][2], s2[NU][2];
#pragma unroll
        for (int u = 0; u < NU; ++u)
#pragma unroll
            for (int k = 0; k < 2; ++k) { s1[u][k] = su[e[u][k]]; s2[u][k] = sv[e[u][k]]; }
#pragma unroll
        for (int u = 0; u < NU; ++u)
#pragma unroll
            for (int k = 0; k < 2; ++k) dstb[(size_t)(t0 + u) * 128 + lane + 64 * k] = gt[u][k] * gelu_exact(h[u][k] * s1[u][k]) * s2[u][k];
    }
}
__device__ __forceinline__ void g3_vaxpy(const Ctx& c, int layer, int dup) {
    const unsigned char* V8 = c.ws + R2_VB; const int* idx = (const int*)(c.ws + R2_IDX); const float* coef = (const float*)(c.ws + R2_GATE);
    for_items(c, layer, 1 + 2 * dup, [&](int s, int blk) {
        int lane = c.lane; asm volatile("" : "+v"(lane));
        const int g = lane >> 3, c8 = lane & 7;
        const int co = 128 * s + 16 * c8;
        constexpr int N = ITEM_TOK / NWAVES;
        const int t0 = blk * ITEM_TOK + c.wave * N;
        auto load_idx = [&](int t, int (&id)[16]) {
#pragma unroll
            for (int j = 0; j < 4; ++j) { const u32x4 q = *(const u32x4*)(idx + (size_t)t * 128 + 16 * g + 4 * j); id[4 * j] = (int)q[0]; id[4 * j + 1] = (int)q[1]; id[4 * j + 2] = (int)q[2]; id[4 * j + 3] = (int)q[3]; } };
        auto load_rows = [&](int t, const int (&id)[16], u32x4 (&row)[16], f32x4 (&cf)[4]) {
#pragma unroll
            for (int j = 0; j < 4; ++j) cf[j] = *(const f32x4*)(coef + (size_t)t * 128 + 16 * g + 4 * j);
#pragma unroll
            for (int j = 0; j < 16; ++j) row[j] = *(const u32x4*)(V8 + ((unsigned)id[j] * 1024u + (unsigned)co)); };
        auto compute = [&](int t, const u32x4 (&row)[16], const f32x4 (&cf)[4]) {
            f32x2 A2[8];
#pragma unroll
            for (int e = 0; e < 8; ++e) A2[e] = (f32x2){0.f, 0.f};
#pragma unroll
            for (int j = 0; j < 16; ++j) { const float cj = cf[j >> 2][j & 3]; const f32x2 sc = (f32x2){cj, cj};
#pragma unroll
                for (int q = 0; q < 4; ++q) { const f32x2 lo = __builtin_amdgcn_cvt_pk_f32_fp8((int)row[j][q], false), hi = __builtin_amdgcn_cvt_pk_f32_fp8((int)row[j][q], true);
                    A2[2 * q] = __builtin_elementwise_fma(sc, lo, A2[2 * q]); A2[2 * q + 1] = __builtin_elementwise_fma(sc, hi, A2[2 * q + 1]); } }
            float A[16];
#pragma unroll
            for (int e = 0; e < 8; ++e) { A[2 * e] = A2[e][0]; A[2 * e + 1] = A2[e][1]; }
            float R[8], S2[4], Y[2];
#pragma unroll
            for (int m = 0; m < 8; ++m) { auto rr = __builtin_amdgcn_permlane32_swap(__float_as_uint(A[m]), __float_as_uint(A[8 + m]), false, false); R[m] = __uint_as_float(rr[0]) + __uint_as_float(rr[1]); }
#pragma unroll
            for (int m = 0; m < 4; ++m) { auto rr = __builtin_amdgcn_permlane16_swap(__float_as_uint(R[m]), __float_as_uint(R[4 + m]), false, false); S2[m] = __uint_as_float(rr[0]) + __uint_as_float(rr[1]); }
            { const bool hi8 = (lane & 8) != 0;
#pragma unroll
              for (int m = 0; m < 2; ++m) { const float send = hi8 ? S2[m] : S2[2 + m], keep = hi8 ? S2[2 + m] : S2[m]; Y[m] = keep + DPP_F(send, 0x128); } }
            const size_t yo = (size_t)t * D + co + 8 * ((lane >> 5) & 1) + 4 * ((lane >> 4) & 1) + 2 * ((lane >> 3) & 1);
            const unsigned xo = *(const unsigned*)((const bf16_t*)(c.ws + WS_XB) + yo);
            *(unsigned*)((bf16_t*)c.out + yo) = cvt_pk_bf16(fmaf(DN_ALPHA, bflo(xo), Y[0]), fmaf(DN_ALPHA, bfhi(xo), Y[1])); };
        int idA[16], idB[16]; u32x4 rowA[16], rowB[16]; f32x4 cfA[4], cfB[4];
        load_idx(t0, idA); load_rows(t0, idA, rowA, cfA); load_idx(t0 + 1, idB);
#pragma unroll 1
        for (int i = 0; i < N; i += 2) {
            load_rows(t0 + i + 1, idB, rowB, cfB);
            if (i + 2 < N) load_idx(t0 + i + 2, idA);
            __builtin_amdgcn_sched_barrier(0);
            compute(t0 + i, rowA, cfA);
            __builtin_amdgcn_sched_barrier(0);
            if (i + 2 < N) load_rows(t0 + i + 2, idA, rowA, cfA);
            if (i + 3 < N) load_idx(t0 + i + 3, idB);
            __builtin_amdgcn_sched_barrier(0);
            compute(t0 + i + 1, rowB, cfB);
            __builtin_amdgcn_sched_barrier(0);
        }
    });
}
__device__ __forceinline__ void ln_pass(const Ctx& c, const float* g, const float* b) {
    const bf16_t* ym = (const bf16_t*)c.out; bf16_t* xa = (bf16_t*)(c.ws + WS_XB); const int lane = c.lane;
    constexpr int NU = 4;
    for (int t0 = c.gw * NU; t0 < T; t0 += c.NGW * NU) {
        f32x4 v[NU][4]; bf16_t* dst[NU]; unsigned char* dst8[NU]; float* dsc[NU];
#pragma unroll
        for (int u = 0; u < NU; ++u) { dst8[u] = nullptr; dsc[u] = nullptr; const bf16_t* yr = ym + (size_t)(t0 + u) * D; dst[u] = xa + (size_t)(t0 + u) * D;
#pragma unroll
            for (int j = 0; j < 4; ++j) { const u32x2 w = *(const u32x2*)(yr + 256 * j + 4 * lane); v[u][j] = (f32x4){bflo(w.x), bfhi(w.x), bflo(w.y), bfhi(w.y)}; } }
        ln_rows<NU, false>(v, g, b, lane, dst, dst8, dsc);
    }
}
#undef DPP_F
}
__global__ void __launch_bounds__(256) k_checksum(const unsigned* p, size_t nwords, unsigned long long* dst) {
    unsigned long long acc = 0;
    for (size_t i = (size_t)blockIdx.x * 256 + threadIdx.x; i < nwords; i += (size_t)gridDim.x * 256) acc += (unsigned long long)p[i] * (unsigned long long)(2 * i + 1);
    for (int o = 32; o >= 1; o >>= 1) acc += __shfl_xor(acc, o);
    if ((threadIdx.x & 63) == 0) atomicAdd(dst, acc);
}
__global__ void __launch_bounds__(256) k_zero_out(float* out, size_t n) { for (size_t i = (size_t)blockIdx.x * 256 + threadIdx.x; i < n; i += (size_t)gridDim.x * 256) out[i] = 0.f; }
__global__ void k_report(const unsigned long long* tab, int nent, float* out) {
    if (threadIdx.x == 0 && blockIdx.x == 0) { int first = -1; for (int i = 0; i < nent; ++i) if (tab[i] != tab[nent + i]) { first = i; break; }
        out[0] = first < 0 ? 99000.f : 1000.f * (float)(first / 4 + 1); out[1] = first < 0 ? 0.f : (float)(first % 4); }
}
struct Reg { size_t off; size_t bytes; int in_out; };
static int phase_regions(int p, Reg* r) {
    int n = 0;
    auto add = [&](size_t off, size_t mib) { r[n].off = off; r[n].bytes = mib * MiB; r[n].in_out = 0; ++n; };
    auto addout = [&]() { r[n].off = 0; r[n].bytes = (size_t)T * D * 4; r[n].in_out = 1; ++n; };
    if (p == 0) { add(WS_W, 61); add(WS_R2, 160); addout(); return n; }
    int q = p - 1;
    for (int layer = 0; layer < NL; ++layer) {
        const int nm = (layer & 1) ? 5 : 7;
        if (q < nm) {
            if ((layer & 1) == 0) { switch (q) { case 0: add(B_A32, 240); break; case 1: add(R2_UB, 34); add(R2_PB, 40); add(B_CQN, 100); add(B_KROPE, 10); break; case 2: add(B_Q, 240); break; case 3: add(B_KV, 320); break;
                case 4: add(B_Q, 240); break; case 5: add(B_O, 160); break; case 6: add(B_H32_MLA, 320); break; } }
            else { switch (q) { case 0: add(B_PLANE, 800); break; case 1: add(R2_UB, 34); add(R2_PB, 40); break; case 2: add(B_PLANE + 160 * MiB, 320); break; case 3: add(B_PLANE, 160); break; case 4: add(B_H32_HGRN, 320); break; } }
            return n;
        }
        q -= nm;
        if (q < 6) { switch (q) { case 0: addout(); add(WS_XB, 160); break; case 1: add(B_PQ, 320); break; case 2: add(R2_IDX, 80); break; case 3: addout(); add(WS_XB, 160); break; case 4: add(B_PP, 160); break; case 5: addout(); add(WS_R2, 160); break; }
            return n; }
        q -= 6;
    }
    return n;
}
constexpr int N_PHASES = 1 + 2 * (6 + 8) + 2 * (5 + 8);

#ifndef PROBE_SITE
#define PROBE_SITE -1
#endif
#ifndef PROBE_LN
#define PROBE_LN 0
#endif
#define GEMM_PHASE(EPI, Aptr, Bptr, NN, KK, ...) { pg8::Gemm g{(const bf16_t*)(Aptr), (const bf16_t*)(Bptr), T, (NN), (KK)}; pg8::StaticOrder S; S.init(T, (NN), c.G, c.bid); \
        pg8::EPI E{__VA_ARGS__}; pg8::gemm_phase<pg8::EPI, pg8::StaticOrder>(c.lds, g, S, E, c.tid); }

__global__ void __launch_bounds__(NTHR, 2) fwd_kernel(Args args) {
    extern __shared__ __attribute__((aligned(16))) unsigned char lds_raw[];
    volatile LAS unsigned* misc = (volatile LAS unsigned*)((LAS unsigned char*)lds_raw + LDS_MISC_OFF);
    if (threadIdx.x < 64) misc[threadIdx.x] = 0u;
    __syncthreads();
    const int wave_s = __builtin_amdgcn_readfirstlane((int)threadIdx.x >> 6);
    const int lo = args.ph_lo, hi = args.ph_hi;
    XcdBarrier bar; bar.bar = (unsigned*)(args.ws + WS_CTL); bar.x = 0; bar.st = nullptr;
    if (hi - lo > 1) bar = xcd_barrier_post((unsigned*)(args.ws + WS_CTL), misc + 8);
    int ph = 0;
#define PHASE(site, ...) if (ph >= lo && ph < hi) { const Ctx c = mk_ctx(lds_raw, wave_s); unsigned char* const ws = c.ws; (void)ws; { constexpr int dup = 0; (void)dup; __VA_ARGS__ } \
        if constexpr (PROBE_SITE == (site)) { __syncthreads(); constexpr int dup = 1; (void)dup; __VA_ARGS__ } if (ph + 1 < hi) xcd_barrier(bar); } ++ph;

    PHASE(0, p0_prologue(c);)

    for (int layer = 0; layer < NL; ++layer) {
        const int j = layer >> 1;
        if ((layer & 1) == 0) {
            PHASE(1, GEMM_PHASE(EpiF32, c.out, (const bf16_t*)(ws + W_WA) + (size_t)j * 768 * 1024, 768, 1024, (float*)(ws + B_A32), 768))
            PHASE(2, l0_convert(c, layer); mla_e1(c, j);)
            PHASE(3, GEMM_PHASE(EpiBf16P, ws + B_CQN, (const bf16_t*)(ws + W_WUQ) + (size_t)j * 1536 * 384, 1536, 384, (bf16_t*)(ws + B_Q), 1536))
            PHASE(4, GEMM_PHASE(EpiBf16P, ws + B_CKVN, (const bf16_t*)(ws + W_WUKV) + (size_t)j * 2048 * 256, 2048, 256, (bf16_t*)(ws + B_KV), 2048))
            PHASE(5, mla_attention(c);)
            PHASE(6, GEMM_PHASE(EpiBf16P, ws + B_O, (const bf16_t*)(ws + W_WO) + (size_t)j * 1024 * 1024, 1024, 1024, (bf16_t*)(ws + B_H32_MLA), 1024))
        } else {
            PHASE(7, GEMM_PHASE(EpiHgrn, c.out, (const bf16_t*)(ws + W_HIN) + (size_t)j * 5120 * 1024, 5120, 1024, (bf16_t*)(ws + B_PLANE), (size_t)T * 1024, (const float*)(ws + WS_MISC) + (size_t)j * 2048))
            PHASE(8, if (dup == 0) { l0_convert(c, layer); scan::hgrn_prep(c); } else { l0_convert(c, layer); })
            PHASE(9, scan::hgrn_scan(c, false);)
            PHASE(10, hgrn_post(c, j);)
            PHASE(11, GEMM_PHASE(EpiBf16P, ws + B_PLANE, (const bf16_t*)(ws + W_HO) + (size_t)j * 1024 * 1024, 1024, 1024, (bf16_t*)(ws + B_H32_HGRN), 1024))
        }
        PHASE(12, ln_residual(c, (const bf16_t*)(ws + ((layer & 1) ? B_H32_HGRN : B_H32_MLA)), c.in(18) + layer * D, c.in(19) + layer * D);)
        PHASE(13, GEMM_PHASE(EpiBf16P, ws + WS_XB, (const bf16_t*)(ws + W_PQ) + (size_t)layer * 2048 * 1024, 2048, 1024, (bf16_t*)(ws + B_PQ), 2048))
        PHASE(14, peer::route(c, layer);)
        PHASE(15, peer::g1_udot(c, layer, dup);)
        PHASE(16, peer::g2_coef(c, dup);)
        PHASE(17, peer::g3_vaxpy(c, layer, dup);)
        PHASE(18, if (dup == 0 || PROBE_LN == 0) GEMM_PHASE(EpiBf16P, ws + R2_PB, (const bf16_t*)(ws + W_PP) + (size_t)layer * 1024 * 256, 1024, 256, (bf16_t*)(ws + B_PP), 1024) if (dup == 0 || PROBE_LN == 1) peer::ln_pass(c, c.in(20) + layer * D, c.in(21) + layer * D);)
        PHASE(19, GEMM_PHASE(EpiPle, ws + WS_XB, (const bf16_t*)(ws + W_GW) + (size_t)layer * 1024 * 1024, 1024, 1024, (const bf16_t*)(ws + WS_XB), (const bf16_t*)(ws + B_PP), c.in(23) + layer * D, (bf16_t*)c.out, (layer == NL - 1) ? c.out : (float*)nullptr))
    }
#undef PHASE
}

extern "C" void kernel_launch(void* const* d_in, const int* in_sizes, int n_in, void* d_out, int out_size, void* d_ws, size_t ws_size, hipStream_t stream) {
    static int grid = 0;
    if (grid == 0) {
        if (n_in != 25 || out_size != T * D || ws_size < WS_END) { fprintf(stderr, "kernel_launch: unexpected shapes: n_in %d out %d ws %zu (need %zu)\n", n_in, out_size, ws_size, (size_t)WS_END); grid = -1; return; }
        int dev = 0, cus = 0, per_cu = 0;
        if (hipGetDevice(&dev) != hipSuccess || hipDeviceGetAttribute(&cus, hipDeviceAttributeMultiprocessorCount, dev) != hipSuccess) { grid = -1; return; }
        if (hipFuncSetAttribute((const void*)fwd_kernel, hipFuncAttributeMaxDynamicSharedMemorySize, LDS_BYTES) != hipSuccess) { fprintf(stderr, "kernel_launch: hipFuncSetAttribute failed\n"); grid = -1; return; }
        if (hipOccupancyMaxActiveBlocksPerMultiprocessor(&per_cu, (const void*)fwd_kernel, NTHR, LDS_BYTES) != hipSuccess || per_cu < 1) { fprintf(stderr, "kernel_launch: occupancy query says %d\n", per_cu); }
        (void)hipGetLastError();
        grid = cus;
    }
    if (grid < 0) return;
    (void)hipMemsetAsync((char*)d_ws + WS_CTL, 0, CTL_ZERO_BYTES, stream);
    Args a{};
    for (int i = 0; i < 25; ++i) a.in[i] = (const float*)d_in[i];
    a.out = (float*)d_out; a.ws = (unsigned char*)d_ws;
#if defined(MK_DEBUG_DET)
    unsigned long long* tab = (unsigned long long*)((char*)d_ws + WS_CTL + 32 * 1024);
    for (int pass = 0; pass < 2; ++pass)
        for (int p = 0; p < N_PHASES; ++p) { a.ph_lo = p; a.ph_hi = p + 1; hipLaunchKernelGGL(fwd_kernel, dim3(grid), dim3(NTHR), LDS_BYTES, stream, a);
            Reg r[4]; const int nr = phase_regions(p, r);
            for (int i = 0; i < nr; ++i) hipLaunchKernelGGL(k_checksum, dim3(2048), dim3(256), 0, stream, (const unsigned*)(r[i].in_out ? (char*)d_out : (char*)d_ws + r[i].off), r[i].bytes / 4, tab + (size_t)pass * N_PHASES * 4 + p * 4 + i); }
    hipLaunchKernelGGL(k_zero_out, dim3(2048), dim3(256), 0, stream, (float*)d_out, (size_t)T * D);
    hipLaunchKernelGGL(k_report, dim3(1), dim3(64), 0, stream, tab, N_PHASES * 4, (float*)d_out);
#elif MK_ONE_LAUNCH
    a.ph_lo = 0; a.ph_hi = N_PHASES;
    hipLaunchKernelGGL(fwd_kernel, dim3(grid), dim3(NTHR), LDS_BYTES, stream, a);
#else
    for (int p = 0; p < N_PHASES; ++p) { a.ph_lo = p; a.ph_hi = p + 1; hipLaunchKernelGGL(fwd_kernel, dim3(grid), dim3(NTHR), LDS_BYTES, stream, a); }
#endif
}
```

```cpp
#include <hip/hip_runtime.h>
#include <cstdio>
#include <cstdint>

#ifndef MK_ONE_LAUNCH
#define MK_ONE_LAUNCH 1
#endif

#define GAS __attribute__((address_space(1)))
#define LAS __attribute__((address_space(3)))
typedef unsigned short bf16_t;
typedef short bf16x8 __attribute__((ext_vector_type(8)));
typedef short s16x4 __attribute__((ext_vector_type(4)));
typedef float f32x4 __attribute__((ext_vector_type(4)));
typedef float f32x2 __attribute__((ext_vector_type(2)));
typedef float f32x16 __attribute__((ext_vector_type(16)));
typedef unsigned u32x4 __attribute__((ext_vector_type(4)));
typedef unsigned u32x2 __attribute__((ext_vector_type(2)));

constexpr int D = 1024, TP = 16384, TS = 65536, T = TP + TS, SP = 8192, SS = 2048;
constexpr int NL = 4;
constexpr int NWAVES = 8, NTHR = 512;
constexpr float DN_ALPHA = 1.681792830507429f;
constexpr float LN_EPS = 1e-5f, RMS_EPS = 1e-6f;
constexpr float MLA_SCALE = 0.07216878364870323f;
constexpr int NEXP = 16384;

constexpr size_t MiB = 1u << 20;
constexpr size_t WS_CTL = 0, CTL_ZERO_BYTES = 64 * 1024;
constexpr size_t WS_ROPE = 1 * MiB;
constexpr size_t WS_MISC = 3 * MiB;
constexpr size_t WS_W = 4 * MiB;
constexpr size_t W_WA = WS_W;
constexpr size_t W_WUQ = W_WA + 2 * (size_t)768 * 1024 * 2;
constexpr size_t W_WUKV = W_WUQ + 2 * (size_t)1536 * 384 * 2;
constexpr size_t W_WO = W_WUKV + 2 * (size_t)2048 * 256 * 2;
constexpr size_t W_HIN = W_WO + 2 * (size_t)1024 * 1024 * 2;
constexpr size_t W_HO = W_HIN + 2 * (size_t)5120 * 1024 * 2;
constexpr size_t W_PQ = W_HO + 2 * (size_t)1024 * 1024 * 2;
constexpr size_t W_GW = W_PQ + 4 * (size_t)2048 * 1024 * 2;
constexpr size_t W_PP = W_GW + 4 * (size_t)1024 * 1024 * 2;
constexpr size_t W_KEYS = W_PP + 4 * (size_t)1024 * 256 * 2;
constexpr size_t W_END = W_KEYS + 4 * (size_t)2 * 128 * 128 * 2;
static_assert(W_END <= 68 * MiB, "weights region");
constexpr size_t WS_R2 = 68 * MiB;
constexpr size_t R2_UB = WS_R2, R2_VB = WS_R2 + 16 * MiB, R2_SU = WS_R2 + 32 * MiB, R2_SV = WS_R2 + 33 * MiB, R2_IDX = WS_R2 + 64 * MiB, R2_GATE = WS_R2 + 104 * MiB, R2_PB = WS_R2 + 144 * MiB;
constexpr size_t WS_XB = 252 * MiB;
constexpr size_t WS_BIG = 412 * MiB;
constexpr size_t WS_END = WS_BIG + 800 * MiB;
constexpr size_t B_Q = WS_BIG, B_KV = WS_BIG + 240 * MiB, B_O = WS_BIG + 560 * MiB, B_KROPE = WS_BIG + 720 * MiB;
constexpr size_t B_A32 = WS_BIG + 240 * MiB, B_CQN = WS_BIG + 560 * MiB, B_CKVN = WS_BIG + 620 * MiB, B_H32_MLA = WS_BIG;
constexpr size_t B_PLANE = WS_BIG, PLANE_BYTES = 160 * MiB, B_H32_HGRN = WS_BIG + 160 * MiB;
constexpr size_t B_PQ = WS_BIG, B_PP = WS_BIG + 320 * MiB, B_X8 = WS_BIG + 480 * MiB, B_XS = WS_BIG + 560 * MiB;

constexpr int LDS_BYTES = 160 * 1024;
constexpr int LDS_MISC_OFF = LDS_BYTES - 256;

typedef __bf16 bf16x2_n __attribute__((ext_vector_type(2)));
__device__ __forceinline__ unsigned cvt_pk_bf16(float lo, float hi) { const f32x2 v = {lo, hi}; const bf16x2_n b = __builtin_convertvector(v, bf16x2_n); return __builtin_bit_cast(unsigned, b); }
__device__ __forceinline__ bf16_t f2bf(float f) { return (bf16_t)(cvt_pk_bf16(f, 0.f) & 0xffffu); }
__device__ __forceinline__ float bf2f(bf16_t b) { return __uint_as_float(((unsigned)b) << 16); }
__device__ __forceinline__ float bflo(unsigned w) { return __uint_as_float(w << 16); }
__device__ __forceinline__ float bfhi(unsigned w) { return __uint_as_float(w & 0xffff0000u); }
#define DPPF(v, ctrl) __int_as_float(__builtin_amdgcn_update_dpp(0, __float_as_int(v), (ctrl), 0xf, 0xf, true))
__device__ __forceinline__ float row16_sum(float v) { v += DPPF(v, 0xB1); v += DPPF(v, 0x4E); v += DPPF(v, 0x141); v += DPPF(v, 0x140); return v; }
__device__ __forceinline__ float wave_sum(float v) { v = row16_sum(v);
    { auto r = __builtin_amdgcn_permlane16_swap(__float_as_uint(v), __float_as_uint(v), false, false); v = __uint_as_float(r[0]) + __uint_as_float(r[1]); }
    { auto r = __builtin_amdgcn_permlane32_swap(__float_as_uint(v), __float_as_uint(v), false, false); v = __uint_as_float(r[0]) + __uint_as_float(r[1]); }
    return v; }
__device__ __forceinline__ float wave_max(float v) { v = fmaxf(v, DPPF(v, 0xB1)); v = fmaxf(v, DPPF(v, 0x4E)); v = fmaxf(v, DPPF(v, 0x141)); v = fmaxf(v, DPPF(v, 0x140));
    { auto r = __builtin_amdgcn_permlane16_swap(__float_as_uint(v), __float_as_uint(v), false, false); v = fmaxf(__uint_as_float(r[0]), __uint_as_float(r[1])); }
    { auto r = __builtin_amdgcn_permlane32_swap(__float_as_uint(v), __float_as_uint(v), false, false); v = fmaxf(__uint_as_float(r[0]), __uint_as_float(r[1])); }
    return v; }
__device__ __forceinline__ float fast_exp(float x) { return __builtin_amdgcn_exp2f(x * 1.4426950408889634f); }
__device__ __forceinline__ float fast_log(float x) { return __builtin_amdgcn_logf(x) * 0.6931471805599453f; }
__device__ __forceinline__ float fast_rcp(float x) { return __builtin_amdgcn_rcpf(x); }
__device__ __forceinline__ float sigmoidf_(float x) { return fast_rcp(1.0f + fast_exp(-x)); }
__device__ __forceinline__ float siluf_(float x) { return x * sigmoidf_(x); }
#define LDS_WAIT() asm volatile("s_waitcnt lgkmcnt(0)" ::: "memory")
#define VM_WAIT() asm volatile("s_waitcnt vmcnt(0)" ::: "memory")
__device__ __forceinline__ int opaque_lane() { int l; asm volatile("v_mbcnt_lo_u32_b32 %0, -1, 0\n\tv_mbcnt_hi_u32_b32 %0, -1, %0" : "=v"(l)); return l; }
__device__ __forceinline__ int opaque_tid(int wave_s) { asm volatile("" : "+s"(wave_s)); return (wave_s << 6) + opaque_lane(); }
__device__ __forceinline__ int opaque_bid() { int b = (int)blockIdx.x; asm volatile("" : "+s"(b)); return b; }
struct Args { const float* in[25]; float* out; unsigned char* ws; int ph_lo, ph_hi; };
#define XB_TMO      128
#define XB_XCNT(j)  (256  + 64 * (j))
#define XB_XSUB(j)  (1280 + 64 * (j))
#define XB_XGEN(j)  (2304 + 64 * (j))
#define XB_TOP      3328
#define XB_TOPGEN   3392
#define XCD_BAR_WORDS 3456
#define XB_SPIN_CAP (1u << 23)

__device__ __forceinline__ unsigned xb_ld(unsigned* p)              { return __hip_atomic_load(p, __ATOMIC_RELAXED, __HIP_MEMORY_SCOPE_AGENT); }
__device__ __forceinline__ unsigned xb_add(unsigned* p, unsigned v) { return __hip_atomic_fetch_add(p, v, __ATOMIC_RELAXED, __HIP_MEMORY_SCOPE_AGENT); }
__device__ __forceinline__ unsigned xb_xcc_id() { return (unsigned)__builtin_amdgcn_s_getreg((3 << 11) | 20) & 0xFu; }
#define XB_SPIN(cond, bar) do { unsigned _sp = 0; while (cond) { __builtin_amdgcn_s_sleep(1); \
    if ((++_sp & 255u) == 0u) { if (xb_ld(&(bar)[XB_TMO])) break; if (_sp > XB_SPIN_CAP) { atomicAdd(&(bar)[XB_TMO], 1u); break; } } } } while (0)

struct XcdBarrier {
    unsigned* bar; unsigned x;
    volatile LAS unsigned* st;
};

__device__ __forceinline__ XcdBarrier xcd_barrier_post(unsigned* bar, volatile LAS unsigned* st) {
    XcdBarrier b; b.bar = bar; b.x = xb_xcc_id(); b.st = st;
    if (threadIdx.x == 0) (void)xb_add(&bar[XB_XCNT(b.x)], 1u);
    return b;
}
__device__ __forceinline__ void xcd_barrier_complete(unsigned* bar, unsigned x, unsigned& nloc, unsigned& nx) {
    const unsigned G = gridDim.x * gridDim.y * gridDim.z;
    unsigned sum, cnt, mine, sp = 0u;
    for (;;) {
        sum = 0u; cnt = 0u; mine = 0u;
#pragma unroll
        for (unsigned j = 0; j < 16; ++j) { const unsigned c = xb_ld(&bar[XB_XCNT(j)]); sum += c; cnt += (c > 0u) ? 1u : 0u; mine = (j == x) ? c : mine; }
        if (sum == G) break;
        __builtin_amdgcn_s_sleep(1);
        if ((++sp & 255u) == 0u) { if (xb_ld(&bar[XB_TMO])) break; if (sp > XB_SPIN_CAP) { atomicAdd(&bar[XB_TMO], 1u); break; } }
    }
    nloc = mine > 0u ? mine : 1u; nx = cnt > 0u ? cnt : 1u;
}

__device__ __forceinline__ void xcd_barrier(const XcdBarrier& b) {
    asm volatile("s_waitcnt vmcnt(0)" ::: "memory");
    __syncthreads();
    if (threadIdx.x == 0) {
        unsigned* bar = b.bar;
        __builtin_amdgcn_s_waitcnt(0);
        unsigned nloc = b.st[0], nx = b.st[1];
        if (nloc == 0u) { xcd_barrier_complete(bar, b.x, nloc, nx); b.st[0] = nloc; b.st[1] = nx; }
        const unsigned old = xb_add(&bar[XB_XSUB(b.x)], 1u);
        const unsigned gen = old / nloc;
        if (old + 1u == (gen + 1u) * nloc) {
            __builtin_amdgcn_fence(__ATOMIC_RELEASE, "agent");
            asm volatile("s_waitcnt vmcnt(0)" ::: "memory");
            const unsigned og = xb_add(&bar[XB_TOP], 1u);
            const unsigned tg = og / nx;
            if (og + 1u == (tg + 1u) * nx) xb_add(&bar[XB_TOPGEN], 1u);
            else XB_SPIN(xb_ld(&bar[XB_TOPGEN]) == tg, bar);
            __builtin_amdgcn_fence(__ATOMIC_ACQUIRE, "agent");
            xb_add(&bar[XB_XGEN(b.x)], 1u);
            asm volatile("s_waitcnt vmcnt(0)" ::: "memory");
        } else {
            XB_SPIN(xb_ld(&bar[XB_XGEN(b.x)]) == gen, bar);
            __builtin_amdgcn_fence(__ATOMIC_ACQUIRE, "agent");
            asm volatile("s_waitcnt vmcnt(0)" ::: "memory");
        }
    }
    __syncthreads();
}
namespace pg8 {
#define PG8_LAS __attribute__((address_space(3)))
constexpr int BM = 256, BK = 64, HALF = 128, HTB = HALF * BK * 2  , STAGE_BYTES = 8 * HTB, NXCD = 8, WGM = 8;

__host__ __device__ __forceinline__ int lds_byte(int r, int c) { const int st = (r >> 4) * 2 + (c >> 5), rr = r & 15, cc = c & 31, ob = rr * 64 + cc * 2; return st * 1024 + (ob ^ (((ob >> 9) & 1) << 5)); }
__host__ __device__ __forceinline__ void stage_rc(int b, int& R, int& C) { const int st = b / 1024, sb = b % 1024, swz = sb ^ (((sb >> 9) & 1) << 5); R = (st >> 1) * 16 + swz / 64; C = (st & 1) * 32 + (swz % 64) / 2; }
__host__ __device__ __forceinline__ int perm32(int rho) { const int n = rho >> 4, i = rho & 15; return 8 * (i >> 2) + 4 * n + (i & 3); }

struct Unit { int pm, pn; };
struct Gemm { const bf16_t* A; const bf16_t* Bt; int M, N, K; };

struct StaticOrder {
    int nM, nN, nwg, G, c;
    __host__ __device__ void init(int M, int N, int G_, int c_) { nM = M / BM; nN = N / BM; nwg = nM * nN; G = G_; c = c_; }
    __host__ __device__ bool next(int i, Unit& u) const {
        const long L = (long)i * G + c; if (L >= nwg) return false;
        int wgid = (int)L; { const int q = nwg / NXCD, r = nwg % NXCD, xcd = wgid % NXCD, off = wgid / NXCD; wgid = (xcd < r ? xcd * (q + 1) : r * (q + 1) + (xcd - r) * q) + off; }
        const int nig = WGM * nN, gid = wgid / nig, fm = gid * WGM, gsz = (nM - fm) < WGM ? (nM - fm) : WGM;
        u.pm = fm + ((wgid % nig) % gsz); u.pn = (wgid % nig) / gsz; return true;
    }
    __device__ __forceinline__ void a_ready(const Unit&) const {}
    __device__ __forceinline__ void done(const Unit&) const {}
};
template <class Epi, class Sched>
__device__ __forceinline__ void gemm_phase(PG8_LAS unsigned char* lds, const Gemm g, const Sched& S, const Epi& E, const int tid) {
    const int wid = __builtin_amdgcn_readfirstlane(tid >> 6), lane = tid & 63, wr = wid >> 2, wc = wid & 3, fr = lane & 15, fq = lane >> 4;
    const int K = g.K, nt = K / BK;
    unsigned voffA[2], voffB[2];
#pragma unroll
    for (int i = 0; i < 2; ++i) { int R, C; stage_rc(tid * 16 + i * 8192, R, C); const int Rb = Epi::PERM ? ((R & ~31) + perm32(R & 31)) : R;
        voffA[i] = (unsigned)(R * K + C) * 2u; voffB[i] = (unsigned)(Rb * K + C) * 2u; }
    const size_t kstep = (size_t)(BK * 2);
    const size_t hstep = (size_t)HALF * K * 2;
    const size_t tstep = 2 * hstep;
    const unsigned ldsw = (unsigned)wid * 1024u;
    const int aoff = lds_byte(wr * 64 + fr, fq * 8), boff = lds_byte(wc * 32 + fr, fq * 8);
#define PG8_SA(b, h) (((b) * 2 + (h)) * HTB)
#define PG8_SB(b, h) ((4 + (b) * 2 + (h)) * HTB)
#define PG8_STAGE(bufoff, gbase, voff) do { _Pragma("unroll") for (int _i = 0; _i < 2; ++_i) \
        __builtin_amdgcn_global_load_lds((const unsigned*)((const char*)(gbase) + (voff)[_i]), (PG8_LAS unsigned*)(lds + (bufoff) + ldsw + _i * 8192), 16, 0, 0); } while (0)
#define PG8_LDA(dst, b, h) do { _Pragma("unroll") for (int m = 0; m < 4; ++m) _Pragma("unroll") for (int k = 0; k < 2; ++k) dst[m][k] = *(const PG8_LAS bf16x8*)(lds + PG8_SA(b, h) + aoff + m * 2048 + k * 1024); } while (0)
#define PG8_LDB(dst, b, h) do { _Pragma("unroll") for (int n = 0; n < 2; ++n) _Pragma("unroll") for (int k = 0; k < 2; ++k) dst[n][k] = *(const PG8_LAS bf16x8*)(lds + PG8_SB(b, h) + boff + n * 2048 + k * 1024); } while (0)
#define PG8_MMA(ai, bj, At, Bt) do { __builtin_amdgcn_s_setprio(1); _Pragma("unroll") for (int m = 0; m < 4; ++m) _Pragma("unroll") for (int n = 0; n < 2; ++n) _Pragma("unroll") for (int k = 0; k < 2; ++k) \
        acc[ai][bj][m][n] = __builtin_amdgcn_mfma_f32_16x16x32_bf16(Bt[n][k], At[m][k], acc[ai][bj][m][n], 0, 0, 0); __builtin_amdgcn_s_setprio(0); } while (0)
#define PG8_WAIT_V(n) asm volatile("s_waitcnt vmcnt(" #n ")" ::: "memory")
#define PG8_WAIT_L(n) asm volatile("s_waitcnt lgkmcnt(" #n ")" ::: "memory")
#define PG8_BAR __builtin_amdgcn_s_barrier()
#define PG8_SCHED __builtin_amdgcn_sched_barrier(0)
    Unit cur, nxt; int ui = 0;
    if (!S.next(0, cur)) return;
    f32x4 acc[2][2][4][2];
#pragma unroll
    for (int a = 0; a < 2; ++a)
#pragma unroll
        for (int b = 0; b < 2; ++b)
#pragma unroll
            for (int m = 0; m < 4; ++m)
#pragma unroll
                for (int n = 0; n < 2; ++n) acc[a][b][m][n] = (f32x4){0.f, 0.f, 0.f, 0.f};
    bf16x8 At[4][2], B0[2][2], B1[2][2];
    const char* cA = (const char*)g.A + (size_t)cur.pm * tstep; const char* cB = (const char*)g.Bt + (size_t)cur.pn * tstep;
    S.a_ready(cur);
    PG8_STAGE(PG8_SB(0, 0), cB, voffB); PG8_STAGE(PG8_SA(0, 0), cA, voffA); PG8_STAGE(PG8_SB(0, 1), cB + hstep, voffB); PG8_STAGE(PG8_SA(0, 1), cA + hstep, voffA);
    if (wr == 1) PG8_BAR;
    PG8_WAIT_V(4); PG8_BAR;
    PG8_STAGE(PG8_SB(1, 0), cB + kstep, voffB); PG8_STAGE(PG8_SA(1, 0), cA + kstep, voffA); PG8_STAGE(PG8_SB(1, 1), cB + hstep + kstep, voffB);
    PG8_WAIT_V(6); PG8_BAR;
    for (;;) {
        const bool has_next = S.next(ui + 1, nxt);
        const char* nA = has_next ? (const char*)g.A + (size_t)nxt.pm * tstep : cA; const char* nB = has_next ? (const char*)g.Bt + (size_t)nxt.pn * tstep : cB;
        for (int t = 0; t < nt; t += 2) {
            const bool last = (t == nt - 2);
            const char* a1 = cA + (size_t)(t + 1) * kstep;
            const char* a2 = last ? nA : cA + (size_t)(t + 2) * kstep; const char* b2 = last ? nB : cB + (size_t)(t + 2) * kstep;
            const char* a3 = a2 + kstep; const char* b3 = b2 + kstep;
            if (last && has_next) S.a_ready(nxt);
            PG8_LDB(B0, 0, 0); PG8_SCHED; PG8_LDA(At, 0, 0); PG8_STAGE(PG8_SA(1, 1), a1 + hstep, voffA);
            PG8_WAIT_L(8); PG8_BAR; PG8_WAIT_L(0); PG8_MMA(0, 0, At, B0); PG8_BAR; PG8_SCHED;
            PG8_LDB(B1, 0, 1); PG8_STAGE(PG8_SB(0, 0), b2, voffB);
            PG8_BAR; PG8_WAIT_L(0); PG8_MMA(0, 1, At, B1); PG8_BAR;
            PG8_LDA(At, 0, 1); PG8_STAGE(PG8_SA(0, 0), a2, voffA);
            PG8_BAR; PG8_WAIT_L(0); PG8_MMA(1, 0, At, B0); PG8_BAR; PG8_SCHED;
            PG8_STAGE(PG8_SB(0, 1), b2 + hstep, voffB);
            PG8_WAIT_V(6); PG8_BAR; PG8_MMA(1, 1, At, B1); PG8_BAR;
            PG8_LDB(B0, 1, 0); PG8_SCHED; PG8_LDA(At, 1, 0); PG8_STAGE(PG8_SA(0, 1), a2 + hstep, voffA);
            PG8_WAIT_L(8); PG8_BAR; PG8_WAIT_L(0); PG8_MMA(0, 0, At, B0); PG8_BAR; PG8_SCHED;
            PG8_LDB(B1, 1, 1); PG8_STAGE(PG8_SB(1, 0), b3, voffB);
            PG8_BAR; PG8_WAIT_L(0); PG8_MMA(0, 1, At, B1); PG8_BAR;
            PG8_LDA(At, 1, 1); PG8_STAGE(PG8_SA(1, 0), a3, voffA);
            PG8_BAR; PG8_WAIT_L(0); PG8_MMA(1, 0, At, B0); PG8_BAR; PG8_SCHED;
            PG8_STAGE(PG8_SB(1, 1), b3 + hstep, voffB);
            PG8_WAIT_V(6); PG8_BAR; PG8_MMA(1, 1, At, B1); PG8_BAR;
        }
        E(acc, cur, wr, wc, fr, fq); S.done(cur);
        if (!has_next) break;
#pragma unroll
        for (int a = 0; a < 2; ++a)
#pragma unroll
            for (int b = 0; b < 2; ++b)
#pragma unroll
                for (int m = 0; m < 4; ++m)
#pragma unroll
                    for (int n = 0; n < 2; ++n) acc[a][b][m][n] = (f32x4){0.f, 0.f, 0.f, 0.f};
        cur = nxt; cA = nA; cB = nB; ++ui;
    }
    PG8_WAIT_V(0);
    if (wr == 0) PG8_BAR;
    PG8_BAR;
#undef PG8_SA
#undef PG8_SB
#undef PG8_STAGE
#undef PG8_LDA
#undef PG8_LDB
#undef PG8_MMA
#undef PG8_WAIT_V
#undef PG8_WAIT_L
#undef PG8_BAR
#undef PG8_SCHED
}
struct EpiF32 {
    static constexpr bool PERM = false;
    float* C; int ldc;
    __device__ __forceinline__ void operator()(const f32x4 (&acc)[2][2][4][2], const Unit& u, int wr, int wc, int fr, int fq) const {
        const int row0 = u.pm * BM + wr * 64 + fr, col0 = u.pn * BM + wc * 32 + 4 * fq;
#pragma unroll
        for (int ai = 0; ai < 2; ++ai)
#pragma unroll
            for (int m = 0; m < 4; ++m) { float* rowp = C + (size_t)(row0 + ai * HALF + m * 16) * ldc + col0;
#pragma unroll
                for (int bj = 0; bj < 2; ++bj)
#pragma unroll
                    for (int n = 0; n < 2; ++n) *(f32x4*)(rowp + bj * HALF + n * 16) = acc[ai][bj][m][n]; }
    }
};
struct EpiBf16P {
    static constexpr bool PERM = true;
    bf16_t* O; int ldc;
    __device__ __forceinline__ void operator()(const f32x4 (&acc)[2][2][4][2], const Unit& u, int wr, int wc, int fr, int fq) const {
        const int row0 = u.pm * BM + wr * 64 + fr, col0 = u.pn * BM + wc * 32 + 8 * fq;
#pragma unroll
        for (int ai = 0; ai < 2; ++ai)
#pragma unroll
            for (int m = 0; m < 4; ++m) { bf16_t* rowp = O + (size_t)(row0 + ai * HALF + m * 16) * ldc + col0;
#pragma unroll
                for (int bj = 0; bj < 2; ++bj) { const f32x4 v0 = acc[ai][bj][m][0], v1 = acc[ai][bj][m][1];
                    u32x4 w; w.x = cvt_pk_bf16(v0[0], v0[1]); w.y = cvt_pk_bf16(v0[2], v0[3]); w.z = cvt_pk_bf16(v1[0], v1[1]); w.w = cvt_pk_bf16(v1[2], v1[3]);
                    *(u32x4*)(rowp + bj * HALF) = w; } }
    }
};
struct EpiHgrn {
    static constexpr bool PERM = true;
    bf16_t* planes; size_t plane_elems; const float* lb;
    __device__ __forceinline__ void operator()(const f32x4 (&acc)[2][2][4][2], const Unit& u, int wr, int wc, int fr, int fq) const {
        const int plane = u.pn >> 2;
        const int row0 = u.pm * BM + wr * 64 + fr, col0 = (u.pn & 3) * BM + wc * 32 + 8 * fq;
        bf16_t* base = planes + (size_t)plane * plane_elems;
        float lbv[2][8];
        if (plane == 1 || plane == 2) {
#pragma unroll
            for (int bj = 0; bj < 2; ++bj)
#pragma unroll
                for (int e = 0; e < 8; ++e) lbv[bj][e] = lb[(plane - 1) * 1024 + col0 + bj * HALF + e];
        } else {
#pragma unroll
            for (int bj = 0; bj < 2; ++bj)
#pragma unroll
                for (int e = 0; e < 8; ++e) lbv[bj][e] = 0.f;
        }
#pragma unroll
        for (int ai = 0; ai < 2; ++ai)
#pragma unroll
            for (int m = 0; m < 4; ++m) { bf16_t* rowp = base + (size_t)(row0 + ai * HALF + m * 16) * 1024 + col0;
#pragma unroll
                for (int bj = 0; bj < 2; ++bj) { float v[8];
#pragma unroll
                    for (int e = 0; e < 4; ++e) { v[e] = acc[ai][bj][m][0][e]; v[4 + e] = acc[ai][bj][m][1][e]; }
                    if (plane == 0 || plane == 4) {
#pragma unroll
                        for (int e = 0; e < 8; ++e) v[e] = siluf_(v[e]);
                    } else if (plane == 1 || plane == 2) {
#pragma unroll
                        for (int e = 0; e < 8; ++e) { const float l = lbv[bj][e]; const float f = l + (1.0f - l) * sigmoidf_(v[e]); v[e] = fast_log(fmaxf(f, 1e-30f)); }
                    }
                    u32x4 w; w.x = cvt_pk_bf16(v[0], v[1]); w.y = cvt_pk_bf16(v[2], v[3]); w.z = cvt_pk_bf16(v[4], v[5]); w.w = cvt_pk_bf16(v[6], v[7]);
                    *(u32x4*)(rowp + bj * HALF) = w; } }
    }
};
struct EpiPle {
    static constexpr bool PERM = false;
    const bf16_t* Xin; const bf16_t* PP; const float* bias; bf16_t* XbOut; float* Fout;
    __device__ __forceinline__ void operator()(const f32x4 (&acc)[2][2][4][2], const Unit& u, int wr, int wc, int fr, int fq) const {
        const int row0 = u.pm * BM + wr * 64 + fr, col0 = u.pn * BM + wc * 32 + 4 * fq;
        f32x4 bv[2][2];
#pragma unroll
        for (int bj = 0; bj < 2; ++bj)
#pragma unroll
            for (int n = 0; n < 2; ++n) bv[bj][n] = *(const f32x4*)(bias + col0 + bj * HALF + n * 16);
#pragma unroll
        for (int ai = 0; ai < 2; ++ai)
#pragma unroll
            for (int m = 0; m < 4; ++m) { const size_t off = (size_t)(row0 + ai * HALF + m * 16) * 1024 + col0;
#pragma unroll
                for (int bj = 0; bj < 2; ++bj)
#pragma unroll
                    for (int n = 0; n < 2; ++n) { const size_t o2 = off + bj * HALF + n * 16;
                        const u32x2 xw = *(const u32x2*)(Xin + o2); const u32x2 pw = *(const u32x2*)(PP + o2); const f32x4 z = acc[ai][bj][m][n] + bv[bj][n];
                        f32x4 o; o[0] = bflo(xw.x) + sigmoidf_(z[0]) * bflo(pw.x); o[1] = bfhi(xw.x) + sigmoidf_(z[1]) * bfhi(pw.x); o[2] = bflo(xw.y) + sigmoidf_(z[2]) * bflo(pw.y); o[3] = bfhi(xw.y) + sigmoidf_(z[3]) * bfhi(pw.y);
                        if (Fout) *(f32x4*)(Fout + o2) = o; else { u32x2 w; w.x = cvt_pk_bf16(o[0], o[1]); w.y = cvt_pk_bf16(o[2], o[3]); *(u32x2*)(XbOut + o2) = w; } }
                asm volatile("" ::: "memory"); }
    }
};
}
namespace attn {
constexpr int DV = 128, DQK = 192, NW = 8, QBLK = 32, KVBLK = 64;
constexpr float SCALE = MLA_SCALE;
constexpr float THR = 8.f;
constexpr int LDQ = 8 * DQK, LDKV = 8 * 256, LDKR = 64, LDO = 1024;
constexpr int KROWB = 400;
constexpr int SHM_V = KVBLK * DV * 2, SHM_K = KVBLK * KROWB, SHM_ATTN = 2 * SHM_V + 2 * SHM_K + NW * 64 * 4;
#define SBAR() __builtin_amdgcn_sched_barrier(0)
__device__ __forceinline__ int crow(int r, int hi) { return (r & 3) + 8 * (r >> 2) + 4 * hi; }

__device__ __forceinline__ void partialSM(f32x16& p0, f32x16& p1, float& m_reg, float& mn, float& alpha) {
  constexpr float C = SCALE * 1.4426950408889634f;
  float pmax = p0[0];
#pragma unroll
  for (int r = 1; r < 16; ++r) pmax = fmaxf(pmax, p0[r]);
#pragma unroll
  for (int r = 0; r < 16; ++r) pmax = fmaxf(pmax, p1[r]);
  { auto rr = __builtin_amdgcn_permlane32_swap(__float_as_uint(pmax), __float_as_uint(pmax), false, false);
    pmax = fmaxf(__uint_as_float(rr[0]), __uint_as_float(rr[1])); }
  if (__builtin_expect(__all(pmax - m_reg <= THR / SCALE), 1)) { mn = m_reg; alpha = 1.f; }
  else { mn = fmaxf(m_reg, pmax); alpha = __builtin_amdgcn_exp2f((m_reg - mn) * C); m_reg = mn; }
  float mnC = -mn * C;
#pragma unroll
  for (int r = 0; r < 16; ++r) p0[r] = fmaf(p0[r], C, mnC);
#pragma unroll
  for (int r = 0; r < 16; ++r) p1[r] = fmaf(p1[r], C, mnC);
#pragma unroll
  for (int r = 0; r < 16; ++r) p0[r] = __builtin_amdgcn_exp2f(p0[r]);
}
__device__ __forceinline__ void finishSM(f32x16& p0, f32x16& p1, float alpha, float& l_reg, bf16x8& pa0, bf16x8& pa1, bf16x8& pa2, bf16x8& pa3) {
#pragma unroll
  for (int r = 0; r < 16; ++r) p1[r] = __builtin_amdgcn_exp2f(p1[r]);
  float ps = 0;
#pragma unroll
  for (int r = 0; r < 16; ++r) ps += p0[r];
#pragma unroll
  for (int r = 0; r < 16; ++r) ps += p1[r];
  { auto rr = __builtin_amdgcn_permlane32_swap(__float_as_uint(ps), __float_as_uint(ps), false, false);
    ps = __uint_as_float(rr[0]) + __uint_as_float(rr[1]); }
  l_reg = l_reg * alpha + ps;
#define PK4(P, BASE, OUT) do { unsigned a0 = cvt_pk_bf16(P[BASE + 0], P[BASE + 1]), a1 = cvt_pk_bf16(P[BASE + 2], P[BASE + 3]);   \
    unsigned b0 = cvt_pk_bf16(P[BASE + 4], P[BASE + 5]), b1 = cvt_pk_bf16(P[BASE + 6], P[BASE + 7]);                              \
    auto r0 = __builtin_amdgcn_permlane32_swap(a0, b0, false, false); auto r1 = __builtin_amdgcn_permlane32_swap(a1, b1, false, false); \
    u32x4 w = {r0[0], r1[0], r0[1], r1[1]}; OUT = *reinterpret_cast<bf16x8*>(&w); } while (0)
  PK4(p0, 0, pa0); PK4(p0, 8, pa1); PK4(p1, 0, pa2); PK4(p1, 8, pa3);
#undef PK4
}
__device__ __forceinline__ void qkt(f32x16& p0, f32x16& p1, const char* Ks, const bf16x8* qr, int r32, int hi) {
  p0 = f32x16{}; p1 = f32x16{};
#pragma unroll
  for (int d0 = 0; d0 < 12; ++d0) { const int cb = (d0 * 16 + hi * 8) * 2;
    bf16x8 b0 = *reinterpret_cast<const bf16x8*>(Ks + r32 * KROWB + cb);
    bf16x8 b1 = *reinterpret_cast<const bf16x8*>(Ks + (32 + r32) * KROWB + cb);
    p0 = __builtin_amdgcn_mfma_f32_32x32x16_bf16(b0, qr[d0], p0, 0, 0, 0);
    p1 = __builtin_amdgcn_mfma_f32_32x32x16_bf16(b1, qr[d0], p1, 0, 0, 0);
    if ((d0 & 3) == 3) SBAR(); }
}
__device__ __forceinline__ int v_st(int k, int c) { const int kk = (k & ~0xC) | ((k & 4) << 1) | ((k & 8) >> 1); return ((kk >> 3) * 4 + (c >> 5)) * 512 + ((kk & 7) * 32 + (c & 31)) * 2; }
__device__ __forceinline__ int v_rd_base(int lane) { return ((lane & 3) << 3) | (((lane >> 2) & 3) << 6) | (((lane >> 4) & 1) << 5) | (((lane >> 5) & 1) << 8); }
constexpr int v_rd_off(int d0, int ks, int half) { return d0 * 512 + ks * 4096 + half * 2048; }
template <int OFF> __device__ __forceinline__ s16x4 tr_read(int vb) {
  s16x4 r; asm volatile("ds_read_b64_tr_b16 %0, %1 offset:%2" : "=&v"(r) : "v"(vb), "i"(OFF) : "memory"); return r;
}
template <int D0> __device__ __forceinline__ void pv_one(f32x16& od, int vb, bf16x8 pa0, bf16x8 pa1, bf16x8 pa2, bf16x8 pa3) {
  const s16x4 l0 = tr_read<v_rd_off(D0, 0, 0)>(vb), h0 = tr_read<v_rd_off(D0, 0, 1)>(vb), l1 = tr_read<v_rd_off(D0, 1, 0)>(vb), h1 = tr_read<v_rd_off(D0, 1, 1)>(vb);
  const s16x4 l2 = tr_read<v_rd_off(D0, 2, 0)>(vb), h2 = tr_read<v_rd_off(D0, 2, 1)>(vb), l3 = tr_read<v_rd_off(D0, 3, 0)>(vb), h3 = tr_read<v_rd_off(D0, 3, 1)>(vb);
  asm volatile("s_waitcnt lgkmcnt(0)" ::: "memory"); SBAR();
#define PK(L, H) (bf16x8){L[0], L[1], L[2], L[3], H[0], H[1], H[2], H[3]}
  od = __builtin_amdgcn_mfma_f32_32x32x16_bf16(pa0, PK(l0, h0), od, 0, 0, 0);
  od = __builtin_amdgcn_mfma_f32_32x32x16_bf16(pa1, PK(l1, h1), od, 0, 0, 0);
  od = __builtin_amdgcn_mfma_f32_32x32x16_bf16(pa2, PK(l2, h2), od, 0, 0, 0);
  od = __builtin_amdgcn_mfma_f32_32x32x16_bf16(pa3, PK(l3, h3), od, 0, 0, 0);
#undef PK
}
__device__ __forceinline__ void pv_d0(f32x16* o, int vb, bf16x8 pa0, bf16x8 pa1, bf16x8 pa2, bf16x8 pa3) {
  pv_one<0>(o[0], vb, pa0, pa1, pa2, pa3); pv_one<1>(o[1], vb, pa0, pa1, pa2, pa3); pv_one<2>(o[2], vb, pa0, pa1, pa2, pa3); pv_one<3>(o[3], vb, pa0, pa1, pa2, pa3);
}

__device__ __forceinline__ void attn_body(const bf16_t* __restrict__ Qb, const bf16_t* __restrict__ Kn, const bf16_t* __restrict__ Kr,
                                          bf16_t* __restrict__ Ob, int seq, char* lds, int tid, int pos0, const float* __restrict__ ropeT) {
  asm volatile("" : "+v"(tid));
  const int wid = tid >> 6, lane = tid & 63, r32 = lane & 31, hi = lane >> 5;
  char* V_lds = lds; char* K_lds = lds + 2 * SHM_V;
  float* ws = (float*)(lds + 2 * SHM_V + 2 * SHM_K) + wid * 64; float* li_l = ws; float* al_l = ws + 32;
  float m_reg = -1e30f, l_reg = 0; f32x16 o[4] = {}; bf16x8 qr[12];
  const bf16_t* Qw = Qb + (long)(wid * QBLK + r32) * LDQ + hi * 8;
#pragma unroll
  for (int d0 = 0; d0 < 12; ++d0) qr[d0] = *reinterpret_cast<const bf16x8*>(Qw + d0 * 16);
  { const float* cp = ropeT + (size_t)(pos0 + wid * QBLK + r32) * 32 + hi * 8; const float* sp = cp + 8192 * 32;
#pragma unroll
    for (int dd = 0; dd < 2; ++dd) { const f32x4 c0 = *(const f32x4*)(cp + 16 * dd), c1 = *(const f32x4*)(cp + 16 * dd + 4), s0 = *(const f32x4*)(sp + 16 * dd), s1 = *(const f32x4*)(sp + 16 * dd + 4);
      const u32x4 A = *reinterpret_cast<const u32x4*>(&qr[8 + dd]), B = *reinterpret_cast<const u32x4*>(&qr[10 + dd]); u32x4 An, Bn;
#pragma unroll
      for (int w2 = 0; w2 < 4; ++w2) { const float cs0 = w2 < 2 ? c0[2 * w2] : c1[2 * w2 - 4], cs1 = w2 < 2 ? c0[2 * w2 + 1] : c1[2 * w2 - 3], sn0 = w2 < 2 ? s0[2 * w2] : s1[2 * w2 - 4], sn1 = w2 < 2 ? s0[2 * w2 + 1] : s1[2 * w2 - 3];
        const float a0 = bflo(A[w2]), a1 = bfhi(A[w2]), b0 = bflo(B[w2]), b1 = bfhi(B[w2]);
        An[w2] = cvt_pk_bf16(a0 * cs0 - b0 * sn0, a1 * cs1 - b1 * sn1); Bn[w2] = cvt_pk_bf16(b0 * cs0 + a0 * sn0, b1 * cs1 + a1 * sn1); }
      qr[8 + dd] = *reinterpret_cast<const bf16x8*>(&An); qr[10 + dd] = *reinterpret_cast<const bf16x8*>(&Bn); } }
  const bf16_t* Vh = Kn + 128;
  const int sr = tid >> 4, sc = (tid & 15) * 8, vst0 = v_st(sr, sc), vst1 = v_st(32 + sr, sc);
  int krow[3], kcc[3];
#pragma unroll
  for (int i = 0; i < 3; ++i) { const int id = tid + 512 * i; krow[i] = id / 24; kcc[i] = id % 24; }
  const int vb0 = (int)(uintptr_t)V_lds + v_rd_base(lane);
  bf16x8 vs0, vs1, ks0, ks1, ks2;
#define KSRC(i, k0) (kcc[i] < 16 ? (Kn + (long)((k0) + krow[i]) * LDKV + kcc[i] * 8) : (Kr + (long)((k0) + krow[i]) * LDKR + (kcc[i] - 16) * 8))
#define SLOAD(k0) do { vs0 = *reinterpret_cast<const bf16x8*>(&Vh[(long)((k0) + sr) * LDKV + sc]); vs1 = *reinterpret_cast<const bf16x8*>(&Vh[(long)((k0) + 32 + sr) * LDKV + sc]); \
    ks0 = *reinterpret_cast<const bf16x8*>(KSRC(0, k0)); ks1 = *reinterpret_cast<const bf16x8*>(KSRC(1, k0)); ks2 = *reinterpret_cast<const bf16x8*>(KSRC(2, k0)); } while (0)
#define SWRITE(b) do { *(bf16x8*)(V_lds + (b) * SHM_V + vst0) = vs0; *(bf16x8*)(V_lds + (b) * SHM_V + vst1) = vs1; \
    *(bf16x8*)(K_lds + (b) * SHM_K + krow[0] * KROWB + kcc[0] * 16) = ks0; *(bf16x8*)(K_lds + (b) * SHM_K + krow[1] * KROWB + kcc[1] * 16) = ks1; \
    *(bf16x8*)(K_lds + (b) * SHM_K + krow[2] * KROWB + kcc[2] * 16) = ks2; } while (0)
#define SWAIT() asm volatile("s_waitcnt vmcnt(0)" ::: "memory")
#define RESC(a) do { if (__any((a) < 1.f)) { if (hi == 0) al_l[r32] = (a); asm volatile("s_waitcnt lgkmcnt(0)" ::: "memory"); \
    _Pragma("unroll") for (int d = 0; d < 4; ++d) _Pragma("unroll") for (int r = 0; r < 16; ++r) o[d][r] *= al_l[crow(r, hi)]; } } while (0)
  f32x16 pA0, pA1; float mnA, alA; bf16x8 pa0, pa1, pa2, pa3; const int NT = seq / KVBLK;
  SLOAD(0); SWAIT(); SWRITE(0); __syncthreads();
  for (int j = 0; j < NT; ++j) {
    const int b = j & 1;
    if (j + 1 < NT) SLOAD((j + 1) * KVBLK);
    SBAR(); qkt(pA0, pA1, K_lds + b * SHM_K, qr, r32, hi);
    partialSM(pA0, pA1, m_reg, mnA, alA);
    RESC(alA);
    finishSM(pA0, pA1, alA, l_reg, pa0, pa1, pa2, pa3); SBAR();
    pv_d0(o, vb0 + b * (int)SHM_V, pa0, pa1, pa2, pa3);
    if (j + 1 < NT) { SWAIT(); SWRITE(b ^ 1); }
    __syncthreads();
  }
  if (hi == 0) li_l[r32] = l_reg; asm volatile("s_waitcnt lgkmcnt(0)" ::: "memory");
  float rli[16];
#pragma unroll
  for (int r = 0; r < 16; ++r) rli[r] = __builtin_amdgcn_rcpf(li_l[crow(r, hi)]);
  bf16_t* Ow = Ob + (long)(wid * QBLK) * LDO;
#pragma unroll
  for (int r = 0; r < 16; ++r) { const int orow = crow(r, hi);
#pragma unroll
    for (int d0 = 0; d0 < 4; ++d0) Ow[(long)orow * LDO + d0 * 32 + r32] = f2bf(o[d0][r] * rli[r]); }
#undef KSRC
#undef SLOAD
#undef SWRITE
#undef SWAIT
#undef RESC
}
#undef SBAR
}
typedef const __attribute__((address_space(4))) Args* KArgs;
struct Ctx {
    KArgs a; float* out; unsigned char* ws;
    LAS unsigned char* lds;
    int tid, lane, wave, vcu, G, gw, NGW, bid;
    __device__ __forceinline__ const float* in(int i) const { return a->in[i]; }
};
__device__ __forceinline__ Ctx mk_ctx(unsigned char* lds_raw, int wave_s) {
    Ctx c; KArgs a = (KArgs)__builtin_amdgcn_kernarg_segment_ptr(); asm volatile("" : "+s"(a));
    c.a = a; c.out = a->out; c.ws = a->ws; c.lds = (LAS unsigned char*)lds_raw;
    c.tid = opaque_tid(wave_s); c.lane = c.tid & 63; c.wave = __builtin_amdgcn_readfirstlane(c.tid >> 6);
    c.G = (int)gridDim.x; c.bid = opaque_bid(); c.vcu = (c.G % 8 == 0) ? (c.bid % 8) * (c.G / 8) + c.bid / 8 : c.bid;
    c.gw = c.vcu * NWAVES + c.wave; c.NGW = c.G * NWAVES;
    return c;
}
__device__ __forceinline__ int tok_pos(int t) { return t < TP ? (t & (SP - 1)) : ((t - TP) & (SS - 1)); }

__device__ __forceinline__ void transpose_item(const float* W, int K, int N, bf16_t* WT, LAS float* scr, int item, int lane) {
    const int nblk = N / 32, kb = item / nblk, nb = item % nblk, k0 = 64 * kb, n0 = 32 * nb;
#pragma unroll 8
    for (int i = 0; i < 32; ++i) { const int kk = 2 * i + (lane >> 5); scr[kk * 33 + (lane & 31)] = W[(size_t)(k0 + kk) * N + n0 + (lane & 31)]; }
    LDS_WAIT(); asm volatile("" ::: "memory");
    const int c = lane & 7;
#pragma unroll
    for (int j = 0; j < 4; ++j) { const int n = (lane >> 3) + 8 * j; const LAS float* s = scr + (8 * c) * 33 + n;
        u32x4 o; o.x = cvt_pk_bf16(s[0 * 33], s[1 * 33]); o.y = cvt_pk_bf16(s[2 * 33], s[3 * 33]); o.z = cvt_pk_bf16(s[4 * 33], s[5 * 33]); o.w = cvt_pk_bf16(s[6 * 33], s[7 * 33]);
        *(u32x4*)(WT + (size_t)(n0 + n) * K + k0 + 8 * c) = o; }
    LDS_WAIT(); asm volatile("" ::: "memory");
}
struct MatDesc { int in_idx, K, N, Npad, copies; size_t dst; };
__device__ __forceinline__ void p0_prologue(const Ctx& c) {
    LAS float* scr = (LAS float*)(c.lds + c.wave * 16384);
    const MatDesc MATS[9] = {
        {4, 1024, 704, 768, 2, W_WA}, {7, 384, 1536, 1536, 2, W_WUQ}, {8, 256, 2048, 2048, 2, W_WUKV}, {9, 1024, 1024, 1024, 2, W_WO},
        {10, 1024, 5120, 5120, 2, W_HIN}, {13, 1024, 1024, 1024, 2, W_HO}, {14, 1024, 2048, 2048, 4, W_PQ}, {22, 1024, 1024, 1024, 4, W_GW}, {24, 256, 1024, 1024, 4, W_PP}};
    int total = 0;
#pragma unroll
    for (int m = 0; m < 9; ++m) total += MATS[m].copies * (MATS[m].K / 64) * (MATS[m].N / 32);
    for (int it = c.gw; it < total; it += c.NGW) {
        int r = it;
#pragma unroll
        for (int m = 0; m < 9; ++m) {
            const int per = (MATS[m].K / 64) * (MATS[m].N / 32), cnt = MATS[m].copies * per;
            if (r >= 0 && r < cnt) { const int cp = r / per, item = r % per;
                transpose_item(c.in(MATS[m].in_idx) + (size_t)cp * MATS[m].K * MATS[m].N, MATS[m].K, MATS[m].N,
                               (bf16_t*)(c.ws + MATS[m].dst) + (size_t)cp * MATS[m].Npad * MATS[m].K, scr, item, c.lane);
                r = -1; }
            else if (r >= 0) r -= cnt;
        }
    }
    const int gt = c.gw * 64 + c.lane, NGT = c.NGW * 64;
    for (int i = gt; i < 2 * 64 * 1024 / 8; i += NGT) { const int cp = i / (64 * 1024 / 8), o = i % (64 * 1024 / 8);
        *(u32x4*)((bf16_t*)(c.ws + W_WA) + (size_t)cp * 768 * 1024 + (size_t)704 * 1024 + o * 8) = (u32x4){0u, 0u, 0u, 0u}; }
    for (int i = gt; i < 4 * 2 * 128 * 128 / 4; i += NGT) { const f32x4 v = *(const f32x4*)(c.in(15) + (size_t)i * 4);
        u32x2 w; w.x = cvt_pk_bf16(v[0], v[1]); w.y = cvt_pk_bf16(v[2], v[3]); *(u32x2*)((bf16_t*)(c.ws + W_KEYS) + (size_t)i * 4) = w; }
    for (int i = gt; i < 8192 * 32; i += NGT) { const int pos = i >> 5, f = i & 31;
        const float inv = 1.0f / powf(10000.0f, (float)(2 * f) / 64.0f); const float ang = (float)pos * inv;
        ((float*)(c.ws + WS_ROPE))[i] = cosf(ang); ((float*)(c.ws + WS_ROPE))[8192 * 32 + i] = sinf(ang); }
    for (int i = gt; i < 2 * 1024; i += NGT) { const int dir = i >> 10, k = i & 1023;
        const float l0 = c.in(11)[(dir * 2 + 0) * 1024 + k], l1 = c.in(11)[(dir * 2 + 1) * 1024 + k];
        float* lb = (float*)(c.ws + WS_MISC);
        lb[(0 * 2 + dir) * 1024 + k] = 0.f; lb[(1 * 2 + dir) * 1024 + k] = 1.0f / (1.0f + expf(l0 - l1)); }
    for (int t = c.gw; t < T; t += c.NGW) {
        const float* xr = t < TP ? c.in(0) + (size_t)t * D : c.in(1) + (size_t)(t - TP) * D;
        bf16_t* brow = (bf16_t*)c.out + (size_t)t * D;
#pragma unroll
        for (int j = 0; j < 4; ++j) { const f32x4 v = *(const f32x4*)(xr + 256 * j + 4 * c.lane);
            u32x2 w; w.x = cvt_pk_bf16(v[0], v[1]); w.y = cvt_pk_bf16(v[2], v[3]); *(u32x2*)(brow + 256 * j + 4 * c.lane) = w; }
    }
}

__device__ __forceinline__ void cvt_range(const float* src, bf16_t* dst, size_t n8, int gt, int NGT) {
    for (size_t i = gt; i < n8; i += NGT) { const f32x4 a = *(const f32x4*)(src + i * 8), b = *(const f32x4*)(src + i * 8 + 4);
        u32x4 w; w.x = cvt_pk_bf16(a[0], a[1]); w.y = cvt_pk_bf16(a[2], a[3]); w.z = cvt_pk_bf16(b[0], b[1]); w.w = cvt_pk_bf16(b[2], b[3]); *(u32x4*)(dst + i * 8) = w; }
}
__device__ __forceinline__ void l0_convert(const Ctx& c, int layer) {
    const int gt = c.gw * 64 + c.lane, NGT = c.NGW * 64;
    for (int r = c.gw; r < 2 * NEXP; r += c.NGW) {
        const int m = r >= NEXP, e = r - m * NEXP;
        const float* src = c.in(16 + m) + ((size_t)layer * NEXP + e) * D + 16 * c.lane;
        f32x4 v[4]; float am = 0.f;
#pragma unroll
        for (int j = 0; j < 4; ++j) { v[j] = *(const f32x4*)(src + 4 * j); am = fmaxf(am, fmaxf(fmaxf(fabsf(v[j][0]), fabsf(v[j][1])), fmaxf(fabsf(v[j][2]), fabsf(v[j][3])))); }
        am = wave_max(am);
        const float sc = fmaxf(am, 1e-30f) * (1.0f / 440.0f), inv = 1.0f / sc;
        u32x4 w;
#pragma unroll
        for (int j = 0; j < 4; ++j) { int p = 0; p = __builtin_amdgcn_cvt_pk_fp8_f32(v[j][0] * inv, v[j][1] * inv, p, false); p = __builtin_amdgcn_cvt_pk_fp8_f32(v[j][2] * inv, v[j][3] * inv, p, true); w[j] = (unsigned)p; }
        *(u32x4*)(c.ws + (m ? R2_VB : R2_UB) + (size_t)e * D + 16 * c.lane) = w;
        if (c.lane == 0) ((float*)(c.ws + (m ? R2_SV : R2_SU)))[e] = sc;
    }
    cvt_range(c.in(2) + (size_t)layer * TP * 256, (bf16_t*)(c.ws + R2_PB), (size_t)TP * 256 / 8, gt, NGT);
    cvt_range(c.in(3) + (size_t)layer * TS * 256, (bf16_t*)(c.ws + R2_PB) + (size_t)TP * 256, (size_t)TS * 256 / 8, gt, NGT);
}

__device__ __forceinline__ void mla_e1(const Ctx& c, int j) {
    const float* a32 = (const float*)(c.ws + B_A32); bf16_t* cqn = (bf16_t*)(c.ws + B_CQN); bf16_t* ckvn = (bf16_t*)(c.ws + B_CKVN); bf16_t* krope = (bf16_t*)(c.ws + B_KROPE);
    const float* qnw = c.in(5) + j * 384; const float* kvnw = c.in(6) + j * 256;
    const float* cosT = (const float*)(c.ws + WS_ROPE); const float* sinT = cosT + 8192 * 32;
    LAS float* scr = (LAS float*)(c.lds + c.wave * 1024);
    const int lane = c.lane;
    for (int t = c.gw; t < T; t += c.NGW) {
        const float* ar = a32 + (size_t)t * 768;
        const f32x4 v0 = *(const f32x4*)(ar + 4 * lane), v1 = *(const f32x4*)(ar + 256 + 4 * lane), v2 = *(const f32x4*)(ar + 512 + 4 * lane);
        const float s0 = v0[0] * v0[0] + v0[1] * v0[1] + v0[2] * v0[2] + v0[3] * v0[3];
        const float s1 = v1[0] * v1[0] + v1[1] * v1[1] + v1[2] * v1[2] + v1[3] * v1[3];
        const float s2 = v2[0] * v2[0] + v2[1] * v2[1] + v2[2] * v2[2] + v2[3] * v2[3];
        const float ssq = wave_sum(s0 + (lane < 32 ? s1 : 0.f));
        const float sskv = wave_sum((lane >= 32 ? s1 : 0.f) + (lane < 32 ? s2 : 0.f));
        const float rq = 1.0f / sqrtf(ssq * (1.0f / 384.0f) + RMS_EPS), rkv = 1.0f / sqrtf(sskv * (1.0f / 256.0f) + RMS_EPS);
        { const f32x4 w = *(const f32x4*)(qnw + 4 * lane); u32x2 o; o.x = cvt_pk_bf16(v0[0] * rq * w[0], v0[1] * rq * w[1]); o.y = cvt_pk_bf16(v0[2] * rq * w[2], v0[3] * rq * w[3]);
          *(u32x2*)(cqn + (size_t)t * 384 + 4 * lane) = o; }
        if (lane < 32) { const f32x4 w = *(const f32x4*)(qnw + 256 + 4 * lane); u32x2 o; o.x = cvt_pk_bf16(v1[0] * rq * w[0], v1[1] * rq * w[1]); o.y = cvt_pk_bf16(v1[2] * rq * w[2], v1[3] * rq * w[3]);
          *(u32x2*)(cqn + (size_t)t * 384 + 256 + 4 * lane) = o; }
        else { const int ix = 4 * (lane - 32); const f32x4 w = *(const f32x4*)(kvnw + ix); u32x2 o; o.x = cvt_pk_bf16(v1[0] * rkv * w[0], v1[1] * rkv * w[1]); o.y = cvt_pk_bf16(v1[2] * rkv * w[2], v1[3] * rkv * w[3]);
          *(u32x2*)(ckvn + (size_t)t * 256 + ix) = o; }
        if (lane < 32) { const int ix = 128 + 4 * lane; const f32x4 w = *(const f32x4*)(kvnw + ix); u32x2 o; o.x = cvt_pk_bf16(v2[0] * rkv * w[0], v2[1] * rkv * w[1]); o.y = cvt_pk_bf16(v2[2] * rkv * w[2], v2[3] * rkv * w[3]);
          *(u32x2*)(ckvn + (size_t)t * 256 + ix) = o; }
        else if (lane < 48) { *(LAS f32x4*)(scr + 4 * (lane - 32)) = v2; }
        LDS_WAIT(); asm volatile("" ::: "memory");
        if (lane < 32) { const int pos = tok_pos(t); const float a = scr[lane], b = scr[lane + 32], cs = cosT[pos * 32 + lane], sn = sinT[pos * 32 + lane];
            krope[(size_t)t * 64 + lane] = f2bf(a * cs - b * sn); krope[(size_t)t * 64 + 32 + lane] = f2bf(b * cs + a * sn); }
        LDS_WAIT(); asm volatile("" ::: "memory");
    }
}
__device__ __forceinline__ void mla_qrope(const Ctx& c) {
    bf16_t* q = (bf16_t*)(c.ws + B_Q);
    const float* cosT = (const float*)(c.ws + WS_ROPE); const float* sinT = cosT + 8192 * 32;
    const int lane = c.lane, i = lane & 31;
    for (int t = c.gw; t < T; t += c.NGW) {
        const int pos = tok_pos(t); const float cs = cosT[pos * 32 + i], sn = sinT[pos * 32 + i];
#pragma unroll
        for (int k = 0; k < 4; ++k) { const int h = (lane >> 5) + 2 * k; bf16_t* p = q + (size_t)t * 1536 + h * 192 + 128 + i;
            const float a = bf2f(p[0]), b = bf2f(p[32]); p[0] = f2bf(a * cs - b * sn); p[32] = f2bf(b * cs + a * sn); }
    }
}
__device__ __forceinline__ void mla_attention(const Ctx& c) {
    const bf16_t* Q = (const bf16_t*)(c.ws + B_Q); const bf16_t* KV = (const bf16_t*)(c.ws + B_KV); const bf16_t* KR = (const bf16_t*)(c.ws + B_KROPE); bf16_t* O = (bf16_t*)(c.ws + B_O);
    const int NU = 512 + 2048;
    for (int u = c.bid; u < NU; u += c.G) {
        int tok0, qb, h, seq;
        if (u < 512) { const int round = u >> 8, cc = u & 255, bh = round * 8 + (cc & 7); tok0 = (bh >> 3) * SP; h = bh & 7; qb = cc >> 3; seq = SP; }
        else { const int us = u - 512, round = us >> 8, cc = us & 255, r = cc >> 3, bh = round * 32 + (cc & 7) * 4 + (r >> 3); tok0 = TP + (bh >> 3) * SS; h = bh & 7; qb = r & 7; seq = SS; }
        attn::attn_body(Q + (size_t)(tok0 + qb * 256) * 1536 + h * 192, KV + (size_t)tok0 * 2048 + h * 256, KR + (size_t)tok0 * 64,
                        O + (size_t)(tok0 + qb * 256) * 1024 + h * 128, seq, (char*)c.lds, c.tid, qb * 256, (const float*)(c.ws + WS_ROPE));
        __syncthreads();
    }
}
template <int NU, bool W8> __device__ __forceinline__ void ln_rows(f32x4 (&v)[NU][4], const float* g, const float* b, int lane, bf16_t* const (&dst)[NU], unsigned char* const (&dst8)[NU], float* const (&dsc)[NU]) {
    float s[NU], s2[NU];
#pragma unroll
    for (int u = 0; u < NU; ++u) { s[u] = 0.f;
#pragma unroll
        for (int j = 0; j < 4; ++j) s[u] += (v[u][j][0] + v[u][j][1]) + (v[u][j][2] + v[u][j][3]); }
#pragma unroll
    for (int u = 0; u < NU; ++u) s[u] = wave_sum(s[u]) * (1.0f / D);
#pragma unroll
    for (int u = 0; u < NU; ++u) { s2[u] = 0.f;
#pragma unroll
        for (int j = 0; j < 4; ++j) { v[u][j] = v[u][j] - s[u]; s2[u] += (v[u][j][0] * v[u][j][0] + v[u][j][1] * v[u][j][1]) + (v[u][j][2] * v[u][j][2] + v[u][j][3] * v[u][j][3]); } }
#pragma unroll
    for (int u = 0; u < NU; ++u) s2[u] = 1.0f / sqrtf(wave_sum(s2[u]) * (1.0f / D) + LN_EPS);
    float am[NU];
#pragma unroll
    for (int u = 0; u < NU; ++u) am[u] = 0.f;
#pragma unroll
    for (int j = 0; j < 4; ++j) { const f32x4 gg = *(const f32x4*)(g + 256 * j + 4 * lane), bb = *(const f32x4*)(b + 256 * j + 4 * lane);
#pragma unroll
        for (int u = 0; u < NU; ++u) { const f32x4 o = v[u][j] * s2[u] * gg + bb; u32x2 w; w.x = cvt_pk_bf16(o[0], o[1]); w.y = cvt_pk_bf16(o[2], o[3]); *(u32x2*)(dst[u] + 256 * j + 4 * lane) = w;
            if (W8) { v[u][j] = o; am[u] = fmaxf(am[u], fmaxf(fmaxf(fabsf(o[0]), fabsf(o[1])), fmaxf(fabsf(o[2]), fabsf(o[3])))); } } }
    if (W8) {
#pragma unroll
        for (int u = 0; u < NU; ++u) { const float mx = fmaxf(wave_max(am[u]), 1e-20f), inv = 240.0f / mx;
#pragma unroll
            for (int j = 0; j < 4; ++j) { int q = 0; q = __builtin_amdgcn_cvt_pk_fp8_f32(v[u][j][0] * inv, v[u][j][1] * inv, q, false); q = __builtin_amdgcn_cvt_pk_fp8_f32(v[u][j][2] * inv, v[u][j][3] * inv, q, true);
                *(unsigned*)(dst8[u] + 256 * j + 4 * lane) = (unsigned)q; }
            if (lane == 0) *dsc[u] = mx * (1.0f / 240.0f); }
    }
}
__device__ __forceinline__ void ln_residual(const Ctx& c, const bf16_t* hb, const float* g, const float* b) {
    const bf16_t* xm = (const bf16_t*)c.out; bf16_t* xa = (bf16_t*)(c.ws + WS_XB); const int lane = c.lane;
    constexpr int NU = 4;
    for (int t0 = c.gw * NU; t0 < T; t0 += c.NGW * NU) {
        f32x4 v[NU][4]; bf16_t* dst[NU]; unsigned char* dst8[NU]; float* dsc[NU];
#pragma unroll
        for (int u = 0; u < NU; ++u) { const bf16_t* xr = xm + (size_t)(t0 + u) * D; const bf16_t* hr = hb + (size_t)(t0 + u) * D; dst[u] = xa + (size_t)(t0 + u) * D;
            dst8[u] = c.ws + B_X8 + (size_t)(t0 + u) * D; dsc[u] = (float*)(c.ws + B_XS) + (t0 + u);
#pragma unroll
            for (int j = 0; j < 4; ++j) { const u32x2 xw = *(const u32x2*)(xr + 256 * j + 4 * lane), hw = *(const u32x2*)(hr + 256 * j + 4 * lane);
                v[u][j] = (f32x4){bflo(xw.x), bfhi(xw.x), bflo(xw.y), bfhi(xw.y)} * DN_ALPHA + (f32x4){bflo(hw.x), bfhi(hw.x), bflo(hw.y), bfhi(hw.y)}; } }
        ln_rows<NU, false>(v, g, b, lane, dst, dst8, dsc);
    }
}
__device__ __forceinline__ void hgrn_post(const Ctx& c, int j) {
    bf16_t* pl = (bf16_t*)(c.ws + B_PLANE); const size_t PE = (size_t)T * 1024;
    const bf16_t* of = pl + 1 * PE; const bf16_t* ob = pl + 2 * PE; const bf16_t* sg = pl + 4 * PE; bf16_t* on = pl;
    const float* nw = c.in(12) + j * 128; const int lane = c.lane;
    const int cw = (8 * lane) & 127; const f32x4 w0 = *(const f32x4*)(nw + cw), w1 = *(const f32x4*)(nw + cw + 4);
    constexpr int NU = 4;
    for (int t0 = c.gw * NU; t0 < T; t0 += c.NGW * NU) {
        u32x4 a[NU][2], b[NU][2], g[NU][2];
#pragma unroll
        for (int u = 0; u < NU; ++u)
#pragma unroll
            for (int k = 0; k < 2; ++k) { const size_t off = (size_t)(t0 + u) * 1024 + 512 * k + 8 * lane;
                a[u][k] = *(const u32x4*)(of + off); b[u][k] = *(const u32x4*)(ob + off); g[u][k] = *(const u32x4*)(sg + off); }
#pragma unroll
        for (int u = 0; u < NU; ++u)
#pragma unroll
            for (int k = 0; k < 2; ++k) { const size_t off = (size_t)(t0 + u) * 1024 + 512 * k + 8 * lane;
                float o[8], gg[8]; float ss = 0.f;
#pragma unroll
                for (int q = 0; q < 4; ++q) { o[2 * q] = bflo(a[u][k][q]) + bflo(b[u][k][q]); o[2 * q + 1] = bfhi(a[u][k][q]) + bfhi(b[u][k][q]); gg[2 * q] = bflo(g[u][k][q]); gg[2 * q + 1] = bfhi(g[u][k][q]); }
#pragma unroll
                for (int e = 0; e < 8; ++e) ss += o[e] * o[e];
                ss = row16_sum(ss);
                const float r = 1.0f / sqrtf(ss * (1.0f / 128.0f) + RMS_EPS);
                u32x4 w; w.x = cvt_pk_bf16(o[0] * r * w0[0] * gg[0], o[1] * r * w0[1] * gg[1]); w.y = cvt_pk_bf16(o[2] * r * w0[2] * gg[2], o[3] * r * w0[3] * gg[3]);
                w.z = cvt_pk_bf16(o[4] * r * w1[0] * gg[4], o[5] * r * w1[1] * gg[5]); w.w = cvt_pk_bf16(o[6] * r * w1[2] * gg[6], o[7] * r * w1[3] * gg[7]);
                *(u32x4*)(on + off) = w; }
    }
}
namespace scan {
constexpr size_t D_F = R2_IDX, D_B = R2_IDX + 12 * MiB;
constexpr int NCH = T / 32;
__device__ __forceinline__ void hgrn_prep(const Ctx& c, int dup) {
    bf16_t* pl = (bf16_t*)(c.ws + B_PLANE); const size_t PE = (size_t)T * 1024;
    bf16_t* qs = pl; bf16_t* lff = pl + PE; bf16_t* lfb = pl + 2 * PE; bf16_t* qtb = (bf16_t*)(c.ws + WS_XB);
    float* dF = (float*)(c.ws + D_F); float* dB = (float*)(c.ws + D_B);
    const int lane = c.lane;
#define PREP_STEP(LW, QW, QDST, KDST, R0, R1) { const unsigned lw = (LW), qw = (QW); const float l0 = bflo(lw), l1 = bfhi(lw); R0 += l0; R1 += l1; \
        const float k0 = 1.0f - fast_exp(l0), k1 = 1.0f - fast_exp(l1); \
        *(unsigned*)(QDST) = cvt_pk_bf16(bflo(qw) * fast_exp(R0), bfhi(qw) * fast_exp(R1)); \
        *(unsigned*)(KDST) = cvt_pk_bf16(k0 * fast_exp(fminf(-R0, 80.f)), k1 * fast_exp(fminf(-R1, 80.f))); }
    const char* qsB = (const char*)qs; const char* lffB = (const char*)lff; const char* lfbB = (const char*)lfb; const char* qtbB = (const char*)qtb;
    char* dmy = (char*)((bf16_t*)c.out + (size_t)T * 1024);
    char* qsW = dup ? dmy : (char*)qs; char* lffW = dup ? dmy : (char*)lff; char* lfbW = dup ? dmy : (char*)lfb; char* qtbW = dup ? dmy : (char*)qtb;
    if (dup) { dF = (float*)dmy; dB = (float*)dmy; }
    for (int it = c.gw; it < NCH * 8; it += c.NGW) {
        const int chunk = it >> 3, h = it & 7; const unsigned base = ((unsigned)chunk * 32u * 1024u + (unsigned)h * 128u + 2u * (unsigned)lane) * 2u;
        float b0 = 0.f, b1 = 0.f, f0 = 0.f, f1 = 0.f;
#define LDW(P, O) (*(const unsigned*)((P) + (O)))
#define STP(P, O) ((unsigned*)((char*)(P) + (O)))
        { unsigned wb[16], wq[16];
#pragma unroll
          for (int i = 0; i < 16; ++i) { const unsigned o = base + (unsigned)(16 + i) * 2048u; wb[i] = LDW(lfbB, o); wq[i] = LDW(qsB, o); }
#pragma unroll
          for (int i = 15; i >= 0; --i) { const unsigned o = base + (unsigned)(16 + i) * 2048u; PREP_STEP(wb[i], wq[i], STP(qtbW, o), STP(lfbW, o), b0, b1) } }
        { unsigned wb[16], wq[16], wf[16];
#pragma unroll
          for (int i = 0; i < 16; ++i) { const unsigned o = base + (unsigned)i * 2048u; wb[i] = LDW(lfbB, o); wq[i] = LDW(qsB, o); wf[i] = LDW(lffB, o); }
#pragma unroll
          for (int i = 15; i >= 0; --i) { const unsigned o = base + (unsigned)i * 2048u; PREP_STEP(wb[i], wq[i], STP(qtbW, o), STP(lfbW, o), b0, b1) }
          *(f32x2*)(dB + (size_t)chunk * 1024 + h * 128 + 2 * lane) = (f32x2){fast_exp(b0), fast_exp(b1)};
#pragma unroll
          for (int i = 0; i < 16; ++i) { const unsigned o = base + (unsigned)i * 2048u; PREP_STEP(wf[i], wq[i], STP(qsW, o), STP(lffW, o), f0, f1) } }
        { unsigned wf[16], wq[16];
#pragma unroll
          for (int i = 0; i < 16; ++i) { const unsigned o = base + (unsigned)(16 + i) * 2048u; wf[i] = LDW(lffB, o); wq[i] = LDW(qsB, o); }
#pragma unroll
          for (int i = 0; i < 16; ++i) { const unsigned o = base + (unsigned)(16 + i) * 2048u; PREP_STEP(wf[i], wq[i], STP(qsW, o), STP(lffW, o), f0, f1) }
          *(f32x2*)(dF + (size_t)chunk * 1024 + h * 128 + 2 * lane) = (f32x2){fast_exp(f0), fast_exp(f1)}; }
    }
#undef LDW
#undef STP
#undef PREP_STEP
}

constexpr int QT_OFF = 0, KT_OFF = 8192, V_OFF = 16384, P_OFF = 24576, ST_OFF = 34816, DV_OFF = 69632, CHAIN_BYTES = 70144;
constexpr int RS = 272, RS2 = 80;
__device__ __forceinline__ int crow(int r, int hi) { return (r & 3) + 8 * (r >> 2) + 4 * hi; }
__device__ __forceinline__ unsigned off_b(unsigned row, unsigned ch) { return 256u * row + 16u * (ch ^ (((row & 3) << 2) | ((row >> 2) & 3))); }
__device__ __forceinline__ unsigned row_read_addr(unsigned lane, unsigned s) { return off_b(lane & 31, 2 * s + (lane >> 5)); }
__device__ __forceinline__ unsigned tr_read_addr(unsigned lane, unsigned cc, unsigned ks, unsigned t) {
    const unsigned h = lane >> 5, blk = (lane >> 4) & 1, q = (lane & 15) >> 2, p = lane & 3;
    return off_b(16 * ks + 8 * h + 4 * t + q, 4 * cc + 2 * blk + (p >> 1)) + 8 * (p & 1);
}
__device__ __forceinline__ s16x4 tr_rd(unsigned addr) { s16x4 r; asm volatile("ds_read_b64_tr_b16 %0, %1" : "=&v"(r) : "v"(addr) : "memory"); return r; }
#define TRPK(L, H) (bf16x8){L[0], L[1], L[2], L[3], H[0], H[1], H[2], H[3]}

__device__ __forceinline__ void run_pair(const Ctx& c, int tok0, int L, int h, int dirsel, bool dummy) {
    bf16_t* pl = (bf16_t*)(c.ws + B_PLANE); const size_t PE = (size_t)T * 1024;
    const int tid = c.tid, lane = c.lane, wave = c.wave, ch = dirsel < 0 ? (wave >> 2) : dirsel, w = wave & 3, r32 = lane & 31, hi = lane >> 5;
    const bool active = dirsel < 0 || wave < 4;
    const int NCs = L / 32;
    if (!active) { __syncthreads(); for (int ci = 0; ci < NCs; ++ci) { __syncthreads(); __syncthreads(); } return; }
    const bf16_t* qt = ch ? (const bf16_t*)(c.ws + WS_XB) : pl; bf16_t* kt = pl + (size_t)(1 + ch) * PE; const bf16_t* vv = pl + 3 * PE;
    const float* dd = (const float*)(c.ws + (ch ? D_B : D_F));
    bf16_t* odst = dummy ? (bf16_t*)c.out + (size_t)T * 1024 : kt;
    LAS unsigned char* base = c.lds + (wave >> 2) * CHAIN_BYTES;
    const unsigned lbase = (unsigned)(uintptr_t)base;
    const int ctid = tid & 255;
    const int NC = L / 32;
    const int vcol = 32 * w + r32;
    LAS unsigned char* Pw = base + P_OFF + w * 2560;
    const int s_r0 = ctid >> 4, s_chn = ctid & 15;
    u32x4 sreg[6]; f32x4 dreg = (f32x4){0.f, 0.f, 0.f, 0.f};
#define SCAN_LOAD(cidx) do { const size_t rowb = (size_t)(tok0 + 32 * (cidx)) * 1024 + h * 128; \
        _Pragma("unroll") for (int i = 0; i < 6; ++i) { const bf16_t* src = ((i >> 1) == 0 ? qt : ((i >> 1) == 1 ? (const bf16_t*)kt : vv)) + rowb + (size_t)(s_r0 + 16 * (i & 1)) * 1024 + s_chn * 8; sreg[i] = *(const u32x4*)src; } \
        if (ctid < 32) dreg = *(const f32x4*)(dd + (size_t)((tok0 >> 5) + (cidx)) * 1024 + h * 128 + 4 * ctid); } while (0)
#define SCAN_WRITE() do { _Pragma("unroll") for (int i = 0; i < 6; ++i) *(LAS u32x4*)(base + (i >> 1) * 8192 + off_b(s_r0 + 16 * (i & 1), s_chn)) = sreg[i]; \
        if (ctid < 32) *(LAS f32x4*)(base + DV_OFF + 16 * ctid) = dreg; } while (0)
    { LAS u32x4* st = (LAS u32x4*)(base + ST_OFF + (32 * w) * RS); for (int i = lane; i < 32 * RS / 16; i += 64) st[i] = (u32x4){0u, 0u, 0u, 0u}; }
    f32x16 S[4];
#pragma unroll
    for (int kt2 = 0; kt2 < 4; ++kt2) S[kt2] = f32x16{};
    SCAN_LOAD(ch ? NC - 1 : 0); SCAN_WRITE();
    __syncthreads();
    for (int ci = 0; ci < NC; ++ci) {
        const int cidx = ch ? NC - 1 - ci : ci;
        if (ci + 1 < NC) SCAN_LOAD(ch ? cidx - 1 : cidx + 1);
        f32x16 X = f32x16{};
#pragma unroll
        for (int ks = 0; ks < 8; ++ks) { const bf16x8 qa = *(const LAS bf16x8*)(base + QT_OFF + row_read_addr(lane, ks));
            const bf16x8 kb = *(const LAS bf16x8*)(base + KT_OFF + row_read_addr(lane, ks));
            X = __builtin_amdgcn_mfma_f32_32x32x16_bf16(qa, kb, X, 0, 0, 0); }
#pragma unroll
        for (int r = 0; r < 16; ++r) { const int t = crow(r, hi); const bool keep = ch ? (t <= r32) : (t >= r32); *(LAS bf16_t*)(Pw + t * RS2 + r32 * 2) = f2bf(keep ? X[r] : 0.f); }
        s16x4 vl[2], vh[2];
#pragma unroll
        for (int ks = 0; ks < 2; ++ks) { vl[ks] = tr_rd(lbase + V_OFF + tr_read_addr(lane, w, ks, 0)); vh[ks] = tr_rd(lbase + V_OFF + tr_read_addr(lane, w, ks, 1)); }
        asm volatile("s_waitcnt lgkmcnt(0)" ::: "memory"); __builtin_amdgcn_sched_barrier(0);
        bf16x8 vb[2];
#pragma unroll
        for (int ks = 0; ks < 2; ++ks) vb[ks] = TRPK(vl[ks], vh[ks]);
        f32x16 O = f32x16{};
#pragma unroll
        for (int ks = 0; ks < 2; ++ks) { const bf16x8 pa = *(const LAS bf16x8*)(Pw + r32 * RS2 + (16 * ks + 8 * hi) * 2);
            O = __builtin_amdgcn_mfma_f32_32x32x16_bf16(pa, vb[ks], O, 0, 0, 0); }
#pragma unroll
        for (int ks = 0; ks < 8; ++ks) { const bf16x8 sb = *(const LAS bf16x8*)(base + ST_OFF + vcol * RS + (16 * ks + 8 * hi) * 2);
            const bf16x8 qa = *(const LAS bf16x8*)(base + QT_OFF + row_read_addr(lane, ks));
            O = __builtin_amdgcn_mfma_f32_32x32x16_bf16(qa, sb, O, 0, 0, 0); }
#pragma unroll
        for (int r = 0; r < 16; ++r) { const int t = tok0 + 32 * cidx + crow(r, hi); odst[(size_t)t * 1024 + h * 128 + vcol] = f2bf(O[r]); }
#pragma unroll
        for (int kt2 = 0; kt2 < 4; ++kt2) {
            s16x4 al[2], ah[2];
#pragma unroll
            for (int ks = 0; ks < 2; ++ks) { al[ks] = tr_rd(lbase + KT_OFF + tr_read_addr(lane, kt2, ks, 0)); ah[ks] = tr_rd(lbase + KT_OFF + tr_read_addr(lane, kt2, ks, 1)); }
            asm volatile("s_waitcnt lgkmcnt(0)" ::: "memory"); __builtin_amdgcn_sched_barrier(0);
#pragma unroll
            for (int ks = 0; ks < 2; ++ks) S[kt2] = __builtin_amdgcn_mfma_f32_32x32x16_bf16(TRPK(al[ks], ah[ks]), vb[ks], S[kt2], 0, 0, 0);
#pragma unroll
            for (int g = 0; g < 4; ++g) { const f32x4 d4 = *(const LAS f32x4*)(base + DV_OFF + (32 * kt2 + 8 * g + 4 * hi) * 4);
#pragma unroll
                for (int e = 0; e < 4; ++e) S[kt2][4 * g + e] *= d4[e];
                u32x2 pk; pk.x = cvt_pk_bf16(S[kt2][4 * g], S[kt2][4 * g + 1]); pk.y = cvt_pk_bf16(S[kt2][4 * g + 2], S[kt2][4 * g + 3]);
                *(LAS u32x2*)(base + ST_OFF + vcol * RS + (32 * kt2 + 8 * g + 4 * hi) * 2) = pk; }
        }
        __syncthreads();
        if (ci + 1 < NC) SCAN_WRITE();
        __syncthreads();
    }
#undef SCAN_LOAD
#undef SCAN_WRITE
}
#undef TRPK
__device__ __forceinline__ void hgrn_scan(const Ctx& c, bool dummy) {
    const int NI = 32 + 256;
    for (int rnd = 0;; ++rnd) {
        if (rnd * c.G >= NI) break;
        const int it = (rnd & 1) ? (rnd * c.G + (c.G - 1 - c.bid)) : (rnd * c.G + c.bid);
        if (it < NI) {
            const bool pr = it < 32;
            run_pair(c, pr ? (it >> 4) * SP : TP + ((it - 32) >> 3) * SS, pr ? SP : SS, pr ? ((it >> 1) & 7) : ((it - 32) & 7), pr ? (it & 1) : -1, dummy);
        }
    }
}
}
#define CE_(a, i, j) { const unsigned _x = a[i] > a[j] ? a[i] : a[j], _y = a[i] > a[j] ? a[j] : a[i]; a[i] = _x; a[j] = _y; }
__device__ __forceinline__ void sort16_desc(unsigned (&a)[16]) {
    CE_(a, 0, 1) CE_(a, 2, 3) CE_(a, 0, 2) CE_(a, 1, 3) CE_(a, 1, 2) CE_(a, 4, 5) CE_(a, 6, 7) CE_(a, 4, 6) CE_(a, 5, 7) CE_(a, 5, 6) CE_(a, 0, 4) CE_(a, 2, 6) CE_(a, 2, 4) CE_(a, 1, 5) CE_(a, 3, 7) CE_(a, 3, 5) CE_(a, 1, 2) CE_(a, 3, 4) CE_(a, 5, 6) CE_(a, 8, 9) CE_(a, 10, 11) CE_(a, 8, 10) CE_(a, 9, 11) CE_(a, 9, 10) CE_(a, 12, 13) CE_(a, 14, 15) CE_(a, 12, 14) CE_(a, 13, 15) CE_(a, 13, 14) CE_(a, 8, 12) CE_(a, 10, 14) CE_(a, 10, 12) CE_(a, 9, 13) CE_(a, 11, 15) CE_(a, 11, 13) CE_(a, 9, 10) CE_(a, 11, 12) CE_(a, 13, 14) CE_(a, 0, 8) CE_(a, 4, 12) CE_(a, 4, 8) CE_(a, 2, 10) CE_(a, 6, 14) CE_(a, 6, 10) CE_(a, 2, 4) CE_(a, 6, 8) CE_(a, 10, 12) CE_(a, 1, 9) CE_(a, 5, 13) CE_(a, 5, 9) CE_(a, 3, 11) CE_(a, 7, 15) CE_(a, 7, 11) CE_(a, 3, 5) CE_(a, 7, 9) CE_(a, 11, 13) CE_(a, 1, 2) CE_(a, 3, 4) CE_(a, 5, 6) CE_(a, 7, 8) CE_(a, 9, 10) CE_(a, 11, 12) CE_(a, 13, 14)
}
__device__ __forceinline__ void merge16_top(unsigned (&a)[16], const unsigned (&b)[16]) {
    a[0] = a[0] > b[15] ? a[0] : b[15]; a[1] = a[1] > b[14] ? a[1] : b[14]; a[2] = a[2] > b[13] ? a[2] : b[13]; a[3] = a[3] > b[12] ? a[3] : b[12]; a[4] = a[4] > b[11] ? a[4] : b[11]; a[5] = a[5] > b[10] ? a[5] : b[10]; a[6] = a[6] > b[9] ? a[6] : b[9]; a[7] = a[7] > b[8] ? a[7] : b[8]; a[8] = a[8] > b[7] ? a[8] : b[7]; a[9] = a[9] > b[6] ? a[9] : b[6]; a[10] = a[10] > b[5] ? a[10] : b[5]; a[11] = a[11] > b[4] ? a[11] : b[4]; a[12] = a[12] > b[3] ? a[12] : b[3]; a[13] = a[13] > b[2] ? a[13] : b[2]; a[14] = a[14] > b[1] ? a[14] : b[1]; a[15] = a[15] > b[0] ? a[15] : b[0];
    CE_(a, 0, 8) CE_(a, 1, 9) CE_(a, 2, 10) CE_(a, 3, 11) CE_(a, 4, 12) CE_(a, 5, 13) CE_(a, 6, 14) CE_(a, 7, 15) CE_(a, 0, 4) CE_(a, 1, 5) CE_(a, 2, 6) CE_(a, 3, 7) CE_(a, 8, 12) CE_(a, 9, 13) CE_(a, 10, 14) CE_(a, 11, 15) CE_(a, 0, 2) CE_(a, 1, 3) CE_(a, 4, 6) CE_(a, 5, 7) CE_(a, 8, 10) CE_(a, 9, 11) CE_(a, 12, 14) CE_(a, 13, 15) CE_(a, 0, 1) CE_(a, 2, 3) CE_(a, 4, 5) CE_(a, 6, 7) CE_(a, 8, 9) CE_(a, 10, 11) CE_(a, 12, 13) CE_(a, 14, 15)
}
namespace peer {
constexpr int KEY_RS = 272;
constexpr int KEYS_BYTES = 2 * 128 * KEY_RS;
constexpr int SI_OFF = KEYS_BYTES;
__device__ __forceinline__ int crow(int r, int hi) { return (r & 3) + 8 * (r >> 2) + 4 * hi; }
__device__ __forceinline__ unsigned sortable(float f) { const unsigned u = __float_as_uint(f); return u ^ ((u >> 31) ? 0xFFFFFFFFu : 0x80000000u); }
__device__ __forceinline__ float unsortable(unsigned s) { const unsigned u = (s >> 31) ? (s ^ 0x80000000u) : ~s; return __uint_as_float(u); }
__device__ __forceinline__ unsigned pair_max(unsigned m) { auto rr = __builtin_amdgcn_permlane32_swap(m, m, false, false); return rr[0] > rr[1] ? rr[0] : rr[1]; }

__device__ __forceinline__ void top16_half(const Ctx& c, const bf16_t* pq_rows, int half, LAS unsigned char* keys, unsigned (&sel)[16]) {
    const int lane = c.lane, r32 = lane & 31, hi = lane >> 5;
    f32x16 acc[4];
#pragma unroll
    for (int nt = 0; nt < 4; ++nt) acc[nt] = f32x16{};
    const bf16_t* qrow = pq_rows + (size_t)r32 * 256 + half * 128;
#pragma unroll 1
    for (int ks = 0; ks < 8; ++ks) { const bf16x8 qb = *reinterpret_cast<const bf16x8*>(qrow + 16 * ks + 8 * hi);
#pragma unroll
        for (int nt = 0; nt < 4; ++nt) { const bf16x8 ka = *(const LAS bf16x8*)(keys + (half * 128 + 32 * nt + r32) * KEY_RS + (16 * ks + 8 * hi) * 2);
            acc[nt] = __builtin_amdgcn_mfma_f32_32x32x16_bf16(ka, qb, acc[nt], 0, 0, 0); } }
    unsigned p[64];
#pragma unroll
    for (int nt = 0; nt < 4; ++nt)
#pragma unroll
        for (int r = 0; r < 16; ++r) { const int n = 32 * nt + crow(r, hi); p[nt * 16 + r] = (sortable(acc[nt][r]) & ~127u) | (unsigned)(127 - n); }
    unsigned g0[16], g1[16], g2[16], g3[16];
#pragma unroll
    for (int i = 0; i < 16; ++i) { g0[i] = p[i]; g1[i] = p[16 + i]; g2[i] = p[32 + i]; g3[i] = p[48 + i]; }
    sort16_desc(g0); sort16_desc(g1); sort16_desc(g2); sort16_desc(g3);
    merge16_top(g0, g1); merge16_top(g2, g3); merge16_top(g0, g2);
    unsigned pb[16];
#pragma unroll
    for (int i = 0; i < 16; ++i) { auto rr = __builtin_amdgcn_permlane32_swap(g0[i], g0[i], false, false); sel[i] = rr[0]; pb[i] = rr[1]; }
    merge16_top(sel, pb);
}
__device__ __forceinline__ void route(const Ctx& c, int layer) {
    const bf16_t* pq = (const bf16_t*)(c.ws + B_PQ); unsigned short* idx_out = (unsigned short*)(c.ws + R2_IDX); float* gate_out = (float*)(c.ws + R2_GATE);
    const bf16_t* keys_g = (const bf16_t*)(c.ws + W_KEYS) + (size_t)layer * 2 * 128 * 128;
    LAS unsigned char* keys = c.lds;
    const int lane = c.lane, r32 = lane & 31, hi = lane >> 5;
    for (int i = c.tid; i < 2 * 128 * 16; i += NTHR) { const int row = i >> 4, ch = i & 15; *(LAS u32x4*)(keys + row * KEY_RS + ch * 16) = *(const u32x4*)(keys_g + (size_t)row * 128 + ch * 8); }
    __syncthreads();
    LAS int* si = (LAS int*)(c.lds + SI_OFF + c.wave * 4096) + r32 * 32;
    for (int grp = c.gw; grp < T / 4; grp += c.NGW) {
        const bf16_t* rows = pq + (size_t)grp * 4 * 2048;
        unsigned s1[16], s2[16];
        top16_half(c, rows, 0, keys, s1);
        top16_half(c, rows, 1, keys, s2);
        float v1[16], v2[16];
#pragma unroll
        for (int i = 0; i < 16; ++i) { v1[i] = unsortable(s1[i] & ~127u); v2[i] = unsortable(s2[i] & ~127u); }
        if (hi == 0) {
#pragma unroll
            for (int i = 0; i < 16; ++i) { si[i] = 127 - (int)(s1[i] & 127u); si[16 + i] = 127 - (int)(s2[i] & 127u); }
        }
        float A[16], B[16];
#pragma unroll
        for (int i = 0; i < 16; ++i) { A[i] = hi ? v2[i] : v1[i]; B[i] = hi ? v1[i] : v2[i]; }
        unsigned cd[27]; int nc = 0;
#pragma unroll
        for (int i = 0; i < 16; ++i)
#pragma unroll
            for (int j = i; j < 16; ++j) if ((i + 1) * (j + 1) <= 16) {
                const unsigned flat = hi ? (unsigned)(j * 16 + i) : (unsigned)(i * 16 + j);
                unsigned pk = (sortable(A[i] + B[j]) & ~255u) | (255u - flat);
                if (i == j) pk = hi ? 0u : pk;
                cd[nc++] = pk; }
        unsigned sel[16], c1[16], pb[16];
#pragma unroll
        for (int i = 0; i < 16; ++i) { sel[i] = cd[i]; c1[i] = (16 + i < 27) ? cd[(16 + i < 27) ? 16 + i : 0] : 0u; }
        sort16_desc(sel); sort16_desc(c1); merge16_top(sel, c1);
#pragma unroll
        for (int i = 0; i < 16; ++i) { auto rr = __builtin_amdgcn_permlane32_swap(sel[i], sel[i], false, false); sel[i] = rr[0]; pb[i] = rr[1]; }
        merge16_top(sel, pb);
        LDS_WAIT(); asm volatile("" ::: "memory");
        const float vmax = unsortable(sel[0] & ~255u);
        float e[16], es = 0.f;
#pragma unroll
        for (int i = 0; i < 16; ++i) { e[i] = fast_exp(unsortable(sel[i] & ~255u) - vmax); es += e[i]; }
        const float inv = 1.0f / es;
        const size_t obase = ((size_t)grp * 4 + (r32 >> 3)) * 128 + (r32 & 7) * 16 + 8 * hi;
        int oi[8]; float og[8];
#pragma unroll
        for (int q = 0; q < 8; ++q) { const unsigned sv = hi ? sel[8 + q] : sel[q]; const float ev = hi ? e[8 + q] : e[q];
            const int flat = 255 - (int)(sv & 255u); oi[q] = si[flat >> 4] * 128 + si[16 + (flat & 15)]; og[q] = ev * inv; }
        *(u32x4*)(idx_out + obase) = (u32x4){(unsigned)oi[0] | ((unsigned)oi[1] << 16), (unsigned)oi[2] | ((unsigned)oi[3] << 16), (unsigned)oi[4] | ((unsigned)oi[5] << 16), (unsigned)oi[6] | ((unsigned)oi[7] << 16)};
        *(f32x4*)(gate_out + obase) = (f32x4){og[0], og[1], og[2], og[3]};
        *(f32x4*)(gate_out + obase + 4) = (f32x4){og[4], og[5], og[6], og[7]};
        LDS_WAIT(); asm volatile("" ::: "memory");
    }
    __syncthreads();
}

__device__ __forceinline__ float gelu_exact(float x) { return 0.5f * x * (1.0f + erff(x * 0.70710678118654752f)); }
template <int IDXMASK> __device__ __forceinline__ void gather_ln(const Ctx& c, int layer, float* xout, bf16_t* xb) {
    const unsigned char* U8 = c.ws + R2_UB; const unsigned char* V8 = c.ws + R2_VB;
    const float* su = (const float*)(c.ws + R2_SU); const float* sv = (const float*)(c.ws + R2_SV);
    const int* idx = (const int*)(c.ws + R2_IDX); const float* gate = (const float*)(c.ws + R2_GATE);
    const float* lg = c.in(20) + layer * D; const float* lbv = c.in(21) + layer * D;
    const int lane = c.lane;
    for (int t = c.gw; t < T; t += c.NGW) {
        const float* xr = c.out + (size_t)t * D + 16 * lane; float* xw = xout + (size_t)t * D + 16 * lane;
        float x[16], acc[16];
#pragma unroll
        for (int j = 0; j < 4; ++j) { const f32x4 a = *(const f32x4*)(xr + 4 * j); x[4 * j] = a[0]; x[4 * j + 1] = a[1]; x[4 * j + 2] = a[2]; x[4 * j + 3] = a[3]; }
#pragma unroll
        for (int e = 0; e < 16; ++e) acc[e] = 0.f;
        const int myidx0 = idx[(size_t)t * 128 + lane] & IDXMASK, myidx1 = idx[(size_t)t * 128 + 64 + lane] & IDXMASK;
        const float myg0 = gate[(size_t)t * 128 + lane], myg1 = gate[(size_t)t * 128 + 64 + lane];
        for (int eb = 0; eb < 128; eb += 8) {
            float part[8]; int ei[8];
#pragma unroll
            for (int q = 0; q < 8; ++q) { const int e = eb + q; ei[q] = __builtin_amdgcn_readlane(e < 64 ? myidx0 : myidx1, e & 63); }
            u32x4 vr[8];
#pragma unroll
            for (int q = 0; q < 8; ++q) vr[q] = *(const u32x4*)(V8 + (size_t)ei[q] * D + 16 * lane);
#pragma unroll
            for (int q = 0; q < 8; ++q) { const u32x4 a = *(const u32x4*)(U8 + (size_t)ei[q] * D + 16 * lane);
                float s = 0.f;
#pragma unroll
                for (int j = 0; j < 4; ++j) { const f32x2 lo = __builtin_amdgcn_cvt_pk_f32_fp8((int)a[j], false), hi = __builtin_amdgcn_cvt_pk_f32_fp8((int)a[j], true);
                    s = fmaf(lo[0], x[4 * j], s); s = fmaf(lo[1], x[4 * j + 1], s); s = fmaf(hi[0], x[4 * j + 2], s); s = fmaf(hi[1], x[4 * j + 3], s); }
                part[q] = s; }
            float r4[4], r2[2], r1;
            { const bool up = (lane & 32) != 0;
#pragma unroll
              for (int i = 0; i < 4; ++i) { const float send = up ? part[i] : part[4 + i]; const float keep = up ? part[4 + i] : part[i]; r4[i] = keep + __shfl_xor(send, 32); } }
            { const bool up = (lane & 16) != 0;
#pragma unroll
              for (int i = 0; i < 2; ++i) { const float send = up ? r4[i] : r4[2 + i]; const float keep = up ? r4[2 + i] : r4[i]; r2[i] = keep + __shfl_xor(send, 16); } }
            { const bool up = (lane & 8) != 0; const float send = up ? r2[0] : r2[1]; const float keep = up ? r2[1] : r2[0]; r1 = keep + __shfl_xor(send, 8); }
            r1 += __shfl_xor(r1, 4); r1 += __shfl_xor(r1, 2); r1 += __shfl_xor(r1, 1);
            const int myq = ((lane >> 5) & 1) * 4 + ((lane >> 4) & 1) * 2 + ((lane >> 3) & 1);
            const int me = eb + myq;
            const float g = __shfl(me < 64 ? myg0 : myg1, me & 63);
            const int mye = __shfl(me < 64 ? myidx0 : myidx1, me & 63);
            const float cf = g * gelu_exact(r1 * su[mye]) * sv[mye];
            float cq[8];
#pragma unroll
            for (int q = 0; q < 8; ++q) cq[q] = __int_as_float(__builtin_amdgcn_readlane(__float_as_int(cf), ((q >> 2) & 1) * 32 + ((q >> 1) & 1) * 16 + (q & 1) * 8));
#pragma unroll
            for (int q = 0; q < 8; ++q) { const float s = cq[q];
#pragma unroll
                for (int j = 0; j < 4; ++j) { const f32x2 lo = __builtin_amdgcn_cvt_pk_f32_fp8((int)vr[q][j], false), hi = __builtin_amdgcn_cvt_pk_f32_fp8((int)vr[q][j], true);
                    acc[4 * j] = fmaf(s, lo[0], acc[4 * j]); acc[4 * j + 1] = fmaf(s, lo[1], acc[4 * j + 1]); acc[4 * j + 2] = fmaf(s, hi[0], acc[4 * j + 2]); acc[4 * j + 3] = fmaf(s, hi[1], acc[4 * j + 3]); } }
        }
        float s = 0.f;
#pragma unroll
        for (int e = 0; e < 16; ++e) { acc[e] = fmaf(DN_ALPHA, x[e], acc[e]); s += acc[e]; }
        const float mean = wave_sum(s) * (1.0f / D); float s2 = 0.f;
#pragma unroll
        for (int e = 0; e < 16; ++e) { acc[e] -= mean; s2 += acc[e] * acc[e]; }
        const float rstd = 1.0f / sqrtf(wave_sum(s2) * (1.0f / D) + LN_EPS);
        float o[16];
#pragma unroll
        for (int j = 0; j < 4; ++j) { const f32x4 g4 = *(const f32x4*)(lg + 16 * lane + 4 * j), b4 = *(const f32x4*)(lbv + 16 * lane + 4 * j);
#pragma unroll
            for (int e = 0; e < 4; ++e) o[4 * j + e] = acc[4 * j + e] * rstd * g4[e] + b4[e];
            *(f32x4*)(xw + 4 * j) = (f32x4){o[4 * j], o[4 * j + 1], o[4 * j + 2], o[4 * j + 3]}; }
        u32x4 w0, w1; w0.x = cvt_pk_bf16(o[0], o[1]); w0.y = cvt_pk_bf16(o[2], o[3]); w0.z = cvt_pk_bf16(o[4], o[5]); w0.w = cvt_pk_bf16(o[6], o[7]);
        w1.x = cvt_pk_bf16(o[8], o[9]); w1.y = cvt_pk_bf16(o[10], o[11]); w1.z = cvt_pk_bf16(o[12], o[13]); w1.w = cvt_pk_bf16(o[14], o[15]);
        *(u32x4*)(xb + (size_t)t * D + 16 * lane) = w0; *(u32x4*)(xb + (size_t)t * D + 16 * lane + 8) = w1;
    }
}
}
namespace peer {
constexpr size_t HP_OFF = WS_BIG;
constexpr size_t COEF_OFF = WS_R2 + 36 * MiB;
constexpr int QW_BASE = 4096;
constexpr int ITEM_TOK = 128, NBLK = T / ITEM_TOK;
constexpr int GT = 1;
#define DPP_F(v, ctrl) __int_as_float(__builtin_amdgcn_update_dpp(0, __float_as_int(v), (ctrl), 0xf, 0xf, true))

template <class F> __device__ __forceinline__ void for_items(const Ctx& c, int layer, int phase, F body) {
    unsigned* qw = (unsigned*)(c.ws + WS_CTL) + QW_BASE + (size_t)((layer * 4 + phase) * 8) * 16;
    volatile LAS int* slot = (volatile LAS int*)(c.lds + LDS_MISC_OFF + 128);
    const int home = (int)(xb_xcc_id() & 7u);
    for (int k = 0; k < 8; ++k) {
        const int s = (home + k) & 7;
        if (c.tid == 0) slot[0] = (int)__hip_atomic_fetch_add(qw + s * 16, 1u, __ATOMIC_RELAXED, __HIP_MEMORY_SCOPE_AGENT);
        __syncthreads();
        int cur = slot[0];
        __syncthreads();
        while (cur < NBLK) {
            if (c.tid == 0) slot[0] = (int)__hip_atomic_fetch_add(qw + s * 16, 1u, __ATOMIC_RELAXED, __HIP_MEMORY_SCOPE_AGENT);
            body(s, cur);
            __syncthreads();
            cur = slot[0];
            __syncthreads();
        }
    }
}

__device__ __forceinline__ void g1_udot(const Ctx& c, int layer, int dup) {
    const unsigned char* U8 = c.ws + R2_UB; const unsigned short* idx = (const unsigned short*)(c.ws + R2_IDX); bf16_t* hp = (bf16_t*)(c.ws + HP_OFF);
    for_items(c, layer, 0 + 2 * dup, [&](int s, int blk) {
        int lane = c.lane; asm volatile("" : "+v"(lane));
        const int g = lane >> 3, c8 = lane & 7;
        const int co = 128 * s + 16 * c8;
#pragma unroll 1
        for (int i = 0; i < ITEM_TOK / NWAVES; i += GT) {
            const int t0 = blk * ITEM_TOK + c.wave * (ITEM_TOK / NWAVES) + i;
            float x[GT][16]; int id[GT][16];
#pragma unroll
            for (int u = 0; u < GT; ++u)
#pragma unroll
            for (int j = 0; j < 4; ++j) { const u32x2 a = *(const u32x2*)((const bf16_t*)(c.ws + WS_XB) + (size_t)(t0 + u) * D + co + 4 * j); x[u][4 * j] = bflo(a.x); x[u][4 * j + 1] = bfhi(a.x); x[u][4 * j + 2] = bflo(a.y); x[u][4 * j + 3] = bfhi(a.y);
                if (j < 2) { const u32x4 q = *(const u32x4*)(idx + (size_t)(t0 + u) * 128 + 16 * g + 8 * j);
#pragma unroll
                    for (int e = 0; e < 4; ++e) { id[u][8 * j + 2 * e] = (int)(q[e] & 0xffffu); id[u][8 * j + 2 * e + 1] = (int)(q[e] >> 16); } } }
            u32x4 row[GT][16];
#pragma unroll
            for (int u = 0; u < GT; ++u)
#pragma unroll
            for (int j = 0; j < 16; ++j) row[u][j] = *(const u32x4*)(U8 + (size_t)id[u][j] * D + co);
#pragma unroll
            for (int u = 0; u < GT; ++u) {
            float V[16];
#pragma unroll
            for (int j = 0; j < 16; ++j) { f32x2 acc2 = (f32x2){0.f, 0.f};
                if (dup) { V[j] = __uint_as_float((row[u][j][0] ^ row[u][j][1] ^ row[u][j][2] ^ row[u][j][3]) & 0x3fffffffu); continue; }
#pragma unroll
                for (int q = 0; q < 4; ++q) { const f32x2 lo = __builtin_amdgcn_cvt_pk_f32_fp8((int)row[u][j][q], false), hi = __builtin_amdgcn_cvt_pk_f32_fp8((int)row[u][j][q], true);
                    acc2 = __builtin_elementwise_fma(lo, (f32x2){x[u][4 * q], x[u][4 * q + 1]}, acc2); acc2 = __builtin_elementwise_fma(hi, (f32x2){x[u][4 * q + 2], x[u][4 * q + 3]}, acc2); }
                V[j] = acc2[0] + acc2[1]; }
            float W[8], Y[4], Z[2];
            { const bool hiA = (lane & 4) != 0;
#pragma unroll
              for (int m = 0; m < 8; ++m) { const float send = hiA ? V[m] : V[8 + m], keep = hiA ? V[8 + m] : V[m]; W[m] = keep + DPP_F(send, 0x141); } }
            { const bool hiB = (lane & 2) != 0;
#pragma unroll
              for (int m = 0; m < 4; ++m) { const float send = hiB ? W[m] : W[4 + m], keep = hiB ? W[4 + m] : W[m]; Y[m] = keep + DPP_F(send, 0x1B); } }
            { const bool hiC = (lane & 1) != 0;
#pragma unroll
              for (int m = 0; m < 2; ++m) { const float send = hiC ? Y[m] : Y[2 + m], keep = hiC ? Y[2 + m] : Y[m]; Z[m] = keep + DPP_F(send, 0xB1); } }
            *(unsigned*)((dup ? hp + (size_t)320 * MiB : hp) + ((size_t)(dup ? 0 : s) * T + t0 + u) * 128 + 16 * g + 2 * c8) = cvt_pk_bf16(Z[0], Z[1]);
            }
        }
    });
}
__device__ __forceinline__ void g2_coef(const Ctx& c, int dup) {
    const unsigned short* idx = (const unsigned short*)(c.ws + R2_IDX); const float* gate = (const float*)(c.ws + R2_GATE); const bf16_t* hp = (const bf16_t*)(c.ws + HP_OFF);
    const float* su = (const float*)(c.ws + R2_SU); const float* sv = (const float*)(c.ws + R2_SV);
    bf16_t* dstb = dup ? (bf16_t*)(c.ws + HP_OFF) + (size_t)340 * MiB : (bf16_t*)(c.ws + COEF_OFF);
    const int lane = c.lane;
    constexpr int NU = 4;
    for (int t0 = c.gw * NU; t0 < T; t0 += c.NGW * NU) {
        float h[NU][2]; unsigned ew[NU]; f32x2 gt[NU];
#pragma unroll
        for (int u = 0; u < NU; ++u) { const size_t o = (size_t)(t0 + u) * 128 + 2 * lane; ew[u] = *(const unsigned*)(idx + o); gt[u] = *(const f32x2*)(gate + o); float a0 = 0.f, a1 = 0.f;
#pragma unroll
            for (int s = 0; s < 8; ++s) { const unsigned w = *(const unsigned*)(hp + (size_t)s * T * 128 + o); a0 += bflo(w); a1 += bfhi(w); }
            h[u][0] = a0; h[u][1] = a1; }
        float s1[NU][2], s2[NU][2];
#pragma unroll
        for (int u = 0; u < NU; ++u) { const int e0 = (int)(ew[u] & 0xffffu), e1 = (int)(ew[u] >> 16); s1[u][0] = su[e0]; s1[u][1] = su[e1]; s2[u][0] = sv[e0]; s2[u][1] = sv[e1]; }
#pragma unroll
        for (int u = 0; u < NU; ++u) *(unsigned*)(dstb + (size_t)(t0 + u) * 128 + 2 * lane) = cvt_pk_bf16(gt[u][0] * gelu_exact(h[u][0] * s1[u][0]) * s2[u][0], gt[u][1] * gelu_exact(h[u][1] * s1[u][1]) * s2[u][1]);
    }
}
__device__ __forceinline__ void g3_vaxpy(const Ctx& c, int layer, int dup) {
    const unsigned char* V8 = c.ws + R2_VB; const unsigned short* idx = (const unsigned short*)(c.ws + R2_IDX); const bf16_t* coef = (const bf16_t*)(c.ws + COEF_OFF);
    for_items(c, layer, 1 + 2 * dup, [&](int s, int blk) {
        int lane = c.lane; asm volatile("" : "+v"(lane));
        const int g = lane >> 3, c8 = lane & 7;
        const int co = 128 * s + 16 * c8;
        constexpr int N = ITEM_TOK / NWAVES;
        const int t0 = blk * ITEM_TOK + c.wave * N;
        auto load_idx = [&](int t, int (&id)[16]) {
#pragma unroll
            for (int j = 0; j < 2; ++j) { const u32x4 q = *(const u32x4*)(idx + (size_t)t * 128 + 16 * g + 8 * j);
#pragma unroll
                for (int e = 0; e < 4; ++e) { id[8 * j + 2 * e] = (int)(q[e] & 0xffffu); id[8 * j + 2 * e + 1] = (int)(q[e] >> 16); } } };
        auto load_rows = [&](int t, const int (&id)[16], u32x4 (&row)[16], f32x4 (&cf)[4]) {
#pragma unroll
            for (int j = 0; j < 2; ++j) { const u32x4 q = *(const u32x4*)(coef + (size_t)t * 128 + 16 * g + 8 * j); cf[2 * j] = (f32x4){bflo(q[0]), bfhi(q[0]), bflo(q[1]), bfhi(q[1])}; cf[2 * j + 1] = (f32x4){bflo(q[2]), bfhi(q[2]), bflo(q[3]), bfhi(q[3])}; }
#pragma unroll
            for (int j = 0; j < 16; ++j) row[j] = *(const u32x4*)(V8 + ((unsigned)id[j] * 1024u + (unsigned)co)); };
        auto compute = [&](int t, const u32x4 (&row)[16], const f32x4 (&cf)[4]) {
            f32x2 A2[8];
#pragma unroll
            for (int e = 0; e < 8; ++e) A2[e] = (f32x2){0.f, 0.f};
#pragma unroll
            for (int j = 0; j < 16; ++j) { const float cj = cf[j >> 2][j & 3]; const f32x2 sc = (f32x2){cj, cj};
#pragma unroll
                for (int q = 0; q < 4; ++q) { const f32x2 lo = __builtin_amdgcn_cvt_pk_f32_fp8((int)row[j][q], false), hi = __builtin_amdgcn_cvt_pk_f32_fp8((int)row[j][q], true);
                    A2[2 * q] = __builtin_elementwise_fma(sc, lo, A2[2 * q]); A2[2 * q + 1] = __builtin_elementwise_fma(sc, hi, A2[2 * q + 1]); } }
            float A[16];
#pragma unroll
            for (int e = 0; e < 8; ++e) { A[2 * e] = A2[e][0]; A[2 * e + 1] = A2[e][1]; }
            float R[8], S2[4], Y[2];
#pragma unroll
            for (int m = 0; m < 8; ++m) { auto rr = __builtin_amdgcn_permlane32_swap(__float_as_uint(A[m]), __float_as_uint(A[8 + m]), false, false); R[m] = __uint_as_float(rr[0]) + __uint_as_float(rr[1]); }
#pragma unroll
            for (int m = 0; m < 4; ++m) { auto rr = __builtin_amdgcn_permlane16_swap(__float_as_uint(R[m]), __float_as_uint(R[4 + m]), false, false); S2[m] = __uint_as_float(rr[0]) + __uint_as_float(rr[1]); }
            { const bool hi8 = (lane & 8) != 0;
#pragma unroll
              for (int m = 0; m < 2; ++m) { const float send = hi8 ? S2[m] : S2[2 + m], keep = hi8 ? S2[2 + m] : S2[m]; Y[m] = keep + DPP_F(send, 0x128); } }
            const size_t yo = (size_t)t * D + co + 8 * ((lane >> 5) & 1) + 4 * ((lane >> 4) & 1) + 2 * ((lane >> 3) & 1);
            const unsigned xo = *(const unsigned*)((const bf16_t*)(c.ws + WS_XB) + yo);
            *(unsigned*)((bf16_t*)c.out + yo) = cvt_pk_bf16(fmaf(DN_ALPHA, bflo(xo), Y[0]), fmaf(DN_ALPHA, bfhi(xo), Y[1])); };
        int idA[16], idB[16]; u32x4 rowA[16], rowB[16]; f32x4 cfA[4], cfB[4];
        load_idx(t0, idA); load_rows(t0, idA, rowA, cfA); load_idx(t0 + 1, idB);
#pragma unroll 1
        for (int i = 0; i < N; i += 2) {
            load_rows(t0 + i + 1, idB, rowB, cfB);
            if (i + 2 < N) load_idx(t0 + i + 2, idA);
            __builtin_amdgcn_sched_barrier(0);
            compute(t0 + i, rowA, cfA);
            __builtin_amdgcn_sched_barrier(0);
            if (i + 2 < N) load_rows(t0 + i + 2, idA, rowA, cfA);
            if (i + 3 < N) load_idx(t0 + i + 3, idB);
            __builtin_amdgcn_sched_barrier(0);
            compute(t0 + i + 1, rowB, cfB);
            __builtin_amdgcn_sched_barrier(0);
        }
    });
}
__device__ __forceinline__ void ln_pass(const Ctx& c, const float* g, const float* b) {
    const bf16_t* ym = (const bf16_t*)c.out; bf16_t* xa = (bf16_t*)(c.ws + WS_XB); const int lane = c.lane;
    constexpr int NU = 4;
    for (int t0 = c.gw * NU; t0 < T; t0 += c.NGW * NU) {
        f32x4 v[NU][4]; bf16_t* dst[NU]; unsigned char* dst8[NU]; float* dsc[NU];
#pragma unroll
        for (int u = 0; u < NU; ++u) { dst8[u] = nullptr; dsc[u] = nullptr; const bf16_t* yr = ym + (size_t)(t0 + u) * D; dst[u] = xa + (size_t)(t0 + u) * D;
#pragma unroll
            for (int j = 0; j < 4; ++j) { const u32x2 w = *(const u32x2*)(yr + 256 * j + 4 * lane); v[u][j] = (f32x4){bflo(w.x), bfhi(w.x), bflo(w.y), bfhi(w.y)}; } }
        ln_rows<NU, false>(v, g, b, lane, dst, dst8, dsc);
    }
}
#undef DPP_F
}
__global__ void __launch_bounds__(256) k_checksum(const unsigned* p, size_t nwords, unsigned long long* dst) {
    unsigned long long acc = 0;
    for (size_t i = (size_t)blockIdx.x * 256 + threadIdx.x; i < nwords; i += (size_t)gridDim.x * 256) acc += (unsigned long long)p[i] * (unsigned long long)(2 * i + 1);
    for (int o = 32; o >= 1; o >>= 1) acc += __shfl_xor(acc, o);
    if ((threadIdx.x & 63) == 0) atomicAdd(dst, acc);
}
__global__ void __launch_bounds__(256) k_zero_out(float* out, size_t n) { for (size_t i = (size_t)blockIdx.x * 256 + threadIdx.x; i < n; i += (size_t)gridDim.x * 256) out[i] = 0.f; }
__global__ void k_report(const unsigned long long* tab, int nent, float* out) {
    if (threadIdx.x == 0 && blockIdx.x == 0) { int first = -1; for (int i = 0; i < nent; ++i) if (tab[i] != tab[nent + i]) { first = i; break; }
        out[0] = first < 0 ? 99000.f : 1000.f * (float)(first / 4 + 1); out[1] = first < 0 ? 0.f : (float)(first % 4); }
}
struct Reg { size_t off; size_t bytes; int in_out; };
static int phase_regions(int p, Reg* r) {
    int n = 0;
    auto add = [&](size_t off, size_t mib) { r[n].off = off; r[n].bytes = mib * MiB; r[n].in_out = 0; ++n; };
    auto addout = [&]() { r[n].off = 0; r[n].bytes = (size_t)T * D * 4; r[n].in_out = 1; ++n; };
    if (p == 0) { add(WS_W, 61); add(WS_R2, 160); addout(); return n; }
    int q = p - 1;
    for (int layer = 0; layer < NL; ++layer) {
        const int nm = (layer & 1) ? 5 : 7;
        if (q < nm) {
            if ((layer & 1) == 0) { switch (q) { case 0: add(B_A32, 240); break; case 1: add(R2_UB, 34); add(R2_PB, 40); add(B_CQN, 100); add(B_KROPE, 10); break; case 2: add(B_Q, 240); break; case 3: add(B_KV, 320); break;
                case 4: add(B_Q, 240); break; case 5: add(B_O, 160); break; case 6: add(B_H32_MLA, 320); break; } }
            else { switch (q) { case 0: add(B_PLANE, 800); break; case 1: add(R2_UB, 34); add(R2_PB, 40); break; case 2: add(B_PLANE + 160 * MiB, 320); break; case 3: add(B_PLANE, 160); break; case 4: add(B_H32_HGRN, 320); break; } }
            return n;
        }
        q -= nm;
        if (q < 6) { switch (q) { case 0: addout(); add(WS_XB, 160); break; case 1: add(B_PQ, 320); break; case 2: add(R2_IDX, 80); break; case 3: addout(); add(WS_XB, 160); break; case 4: add(B_PP, 160); break; case 5: addout(); add(WS_R2, 160); break; }
            return n; }
        q -= 6;
    }
    return n;
}
constexpr int CHK_NR = 64;
__global__ void __launch_bounds__(256) k_attn_naive(const unsigned char* ws, float* scratch, float* result) {
    const bf16_t* Q = (const bf16_t*)(ws + B_Q); const bf16_t* KV = (const bf16_t*)(ws + B_KV); const bf16_t* KR = (const bf16_t*)(ws + B_KROPE); const bf16_t* O = (const bf16_t*)(ws + B_O);
    const float* cosT = (const float*)(ws + WS_ROPE); const float* sinT = cosT + 8192 * 32;
    const int which = blockIdx.x / CHK_NR, ri = blockIdx.x % CHK_NR;
    const int tok0 = which == 0 ? 1 * SP : TP + 5 * SS, seq = which == 0 ? SP : SS, h = which == 0 ? 3 : 6, pos = (which == 0 ? 4000 : 1000) + ri;
    const int tq = tok0 + pos;
    __shared__ float qs[192]; __shared__ float red[256]; __shared__ float pr[8192];
    const int tid = threadIdx.x;
    if (tid < 128) qs[tid] = bf2f(Q[(size_t)tq * 1536 + h * 192 + tid]);
    if (tid < 32) { const float a = bf2f(Q[(size_t)tq * 1536 + h * 192 + 128 + tid]), b = bf2f(Q[(size_t)tq * 1536 + h * 192 + 160 + tid]); const float cs = cosT[pos * 32 + tid], sn = sinT[pos * 32 + tid];
        qs[128 + tid] = bf2f(f2bf(a * cs - b * sn)); qs[160 + tid] = bf2f(f2bf(b * cs + a * sn)); }
    __syncthreads();
    float mx = -1e30f;
    for (int k = tid; k < seq; k += 256) { const size_t tk = (size_t)(tok0 + k); float s = 0.f;
        for (int d = 0; d < 128; ++d) s += qs[d] * bf2f(KV[tk * 2048 + h * 256 + d]);
        for (int d = 0; d < 64; ++d) s += qs[128 + d] * bf2f(KR[tk * 64 + d]);
        s *= MLA_SCALE; pr[k] = s; mx = fmaxf(mx, s); }
    red[tid] = mx; __syncthreads();
    for (int o = 128; o >= 1; o >>= 1) { if (tid < o) red[tid] = fmaxf(red[tid], red[tid + o]); __syncthreads(); }
    mx = red[0]; __syncthreads();
    float sm = 0.f;
    for (int k = tid; k < seq; k += 256) { const float p = expf(pr[k] - mx); pr[k] = p; sm += p; }
    red[tid] = sm; __syncthreads();
    for (int o = 128; o >= 1; o >>= 1) { if (tid < o) red[tid] += red[tid + o]; __syncthreads(); }
    sm = red[0]; __syncthreads();
    if (tid < 128) { float o = 0.f; for (int k = 0; k < seq; ++k) o += pr[k] * bf2f(KV[(size_t)(tok0 + k) * 2048 + h * 256 + 128 + tid]);
        o /= sm; const float got = bf2f(O[(size_t)tq * 1024 + h * 128 + tid]);
        const float err = fabsf(got - o); atomicMax((unsigned*)result, __float_as_uint(err)); atomicMax((unsigned*)result + 1, __float_as_uint(fabsf(o))); }
    (void)scratch;
}
__global__ void k_attn_report(const float* result, float* out) { if (threadIdx.x == 0 && blockIdx.x == 0) { out[0] = 1000.f + 1e6f * result[0]; out[1] = 0.f; } }
constexpr int N_PHASES = 1 + 2 * (6 + 8) + 2 * (5 + 8);

#ifndef PROBE_SITE
#define PROBE_SITE -1
#endif
#ifndef PROBE_LN
#define PROBE_LN 0
#endif
#define GEMM_PHASE(EPI, Aptr, Bptr, NN, KK, ...) { pg8::Gemm g{(const bf16_t*)(Aptr), (const bf16_t*)(Bptr), T, (NN), (KK)}; pg8::StaticOrder S; S.init(T, (NN), c.G, c.bid); \
        pg8::EPI E{__VA_ARGS__}; pg8::gemm_phase<pg8::EPI, pg8::StaticOrder>(c.lds, g, S, E, c.tid); }

__global__ void __launch_bounds__(NTHR, 2) fwd_kernel(Args args) {
    extern __shared__ __attribute__((aligned(16))) unsigned char lds_raw[];
    volatile LAS unsigned* misc = (volatile LAS unsigned*)((LAS unsigned char*)lds_raw + LDS_MISC_OFF);
    if (threadIdx.x < 64) misc[threadIdx.x] = 0u;
    __syncthreads();
    const int wave_s = __builtin_amdgcn_readfirstlane((int)threadIdx.x >> 6);
    const int lo = args.ph_lo, hi = args.ph_hi;
    XcdBarrier bar; bar.bar = (unsigned*)(args.ws + WS_CTL); bar.x = 0; bar.st = nullptr;
    if (hi - lo > 1) bar = xcd_barrier_post((unsigned*)(args.ws + WS_CTL), misc + 8);
    int ph = 0;
#define PHASE(site, ...) if (ph >= lo && ph < hi) { const Ctx c = mk_ctx(lds_raw, wave_s); unsigned char* const ws = c.ws; (void)ws; { constexpr int dup = 0; (void)dup; __VA_ARGS__ } \
        if constexpr (PROBE_SITE == (site)) { __syncthreads(); constexpr int dup = 1; (void)dup; __VA_ARGS__ } if (ph + 1 < hi) xcd_barrier(bar); } ++ph;

    PHASE(0, p0_prologue(c);)

    for (int layer = 0; layer < NL; ++layer) {
        const int j = layer >> 1;
        if ((layer & 1) == 0) {
            PHASE(1, GEMM_PHASE(EpiF32, c.out, (const bf16_t*)(ws + W_WA) + (size_t)j * 768 * 1024, 768, 1024, (float*)(ws + B_A32), 768))
            PHASE(2, l0_convert(c, layer); mla_e1(c, j);)
            PHASE(3, GEMM_PHASE(EpiBf16P, ws + B_CQN, (const bf16_t*)(ws + W_WUQ) + (size_t)j * 1536 * 384, 1536, 384, (bf16_t*)(ws + B_Q), 1536))
            PHASE(4, GEMM_PHASE(EpiBf16P, ws + B_CKVN, (const bf16_t*)(ws + W_WUKV) + (size_t)j * 2048 * 256, 2048, 256, (bf16_t*)(ws + B_KV), 2048))
            PHASE(5, mla_attention(c);)
            PHASE(6, GEMM_PHASE(EpiBf16P, ws + B_O, (const bf16_t*)(ws + W_WO) + (size_t)j * 1024 * 1024, 1024, 1024, (bf16_t*)(ws + B_H32_MLA), 1024))
        } else {
            PHASE(7, GEMM_PHASE(EpiHgrn, c.out, (const bf16_t*)(ws + W_HIN) + (size_t)j * 5120 * 1024, 5120, 1024, (bf16_t*)(ws + B_PLANE), (size_t)T * 1024, (const float*)(ws + WS_MISC) + (size_t)j * 2048))
            PHASE(8, if (dup == 0) { l0_convert(c, layer); scan::hgrn_prep(c, 0); } else { scan::hgrn_prep(c, 1); })
            PHASE(9, scan::hgrn_scan(c, dup != 0);)
            PHASE(10, hgrn_post(c, j);)
            PHASE(11, GEMM_PHASE(EpiBf16P, ws + B_PLANE, (const bf16_t*)(ws + W_HO) + (size_t)j * 1024 * 1024, 1024, 1024, (bf16_t*)(ws + B_H32_HGRN), 1024))
        }
        PHASE(12, ln_residual(c, (const bf16_t*)(ws + ((layer & 1) ? B_H32_HGRN : B_H32_MLA)), c.in(18) + layer * D, c.in(19) + layer * D);)
        PHASE(13, GEMM_PHASE(EpiBf16P, ws + WS_XB, (const bf16_t*)(ws + W_PQ) + (size_t)layer * 2048 * 1024, 2048, 1024, (bf16_t*)(ws + B_PQ), 2048))
        PHASE(14, peer::route(c, layer);)
        PHASE(15, peer::g1_udot(c, layer, dup);)
        PHASE(16, peer::g2_coef(c, dup);)
        PHASE(17, peer::g3_vaxpy(c, layer, dup);)
        PHASE(18, if (dup == 0 || PROBE_LN == 0) GEMM_PHASE(EpiBf16P, ws + R2_PB, (const bf16_t*)(ws + W_PP) + (size_t)layer * 1024 * 256, 1024, 256, (bf16_t*)(ws + B_PP), 1024) if (dup == 0 || PROBE_LN == 1) peer::ln_pass(c, c.in(20) + layer * D, c.in(21) + layer * D);)
        PHASE(19, GEMM_PHASE(EpiPle, ws + WS_XB, (const bf16_t*)(ws + W_GW) + (size_t)layer * 1024 * 1024, 1024, 1024, (const bf16_t*)(ws + WS_XB), (const bf16_t*)(ws + B_PP), c.in(23) + layer * D, (bf16_t*)c.out, (layer == NL - 1) ? c.out : (float*)nullptr))
    }
#undef PHASE
}

extern "C" void kernel_launch(void* const* d_in, const int* in_sizes, int n_in, void* d_out, int out_size, void* d_ws, size_t ws_size, hipStream_t stream) {
    static int grid = 0;
    if (grid == 0) {
        if (n_in != 25 || out_size != T * D || ws_size < WS_END) { fprintf(stderr, "kernel_launch: unexpected shapes: n_in %d out %d ws %zu (need %zu)\n", n_in, out_size, ws_size, (size_t)WS_END); grid = -1; return; }
        int dev = 0, cus = 0, per_cu = 0;
        if (hipGetDevice(&dev) != hipSuccess || hipDeviceGetAttribute(&cus, hipDeviceAttributeMultiprocessorCount, dev) != hipSuccess) { grid = -1; return; }
        if (hipFuncSetAttribute((const void*)fwd_kernel, hipFuncAttributeMaxDynamicSharedMemorySize, LDS_BYTES) != hipSuccess) { fprintf(stderr, "kernel_launch: hipFuncSetAttribute failed\n"); grid = -1; return; }
        if (hipOccupancyMaxActiveBlocksPerMultiprocessor(&per_cu, (const void*)fwd_kernel, NTHR, LDS_BYTES) != hipSuccess || per_cu < 1) { fprintf(stderr, "kernel_launch: occupancy query says %d\n", per_cu); }
        (void)hipGetLastError();
        grid = cus;
    }
    if (grid < 0) return;
    (void)hipMemsetAsync((char*)d_ws + WS_CTL, 0, CTL_ZERO_BYTES, stream);
    Args a{};
    for (int i = 0; i < 25; ++i) a.in[i] = (const float*)d_in[i];
    a.out = (float*)d_out; a.ws = (unsigned char*)d_ws;
#if defined(MK_DEBUG_ATTN)
    float* res = (float*)((char*)d_ws + WS_CTL + 48 * 1024);
    for (int p = 0; p < 6; ++p) { a.ph_lo = p; a.ph_hi = p + 1; hipLaunchKernelGGL(fwd_kernel, dim3(grid), dim3(NTHR), LDS_BYTES, stream, a); }
    hipLaunchKernelGGL(k_zero_out, dim3(2048), dim3(256), 0, stream, (float*)d_out, (size_t)T * D);
    hipLaunchKernelGGL(k_attn_naive, dim3(2 * CHK_NR), dim3(256), 0, stream, (const unsigned char*)d_ws, (float*)nullptr, res);
    hipLaunchKernelGGL(k_attn_report, dim3(1), dim3(64), 0, stream, (const float*)res, (float*)d_out);
#elif defined(MK_DEBUG_DET)
    unsigned long long* tab = (unsigned long long*)((char*)d_ws + WS_CTL + 32 * 1024);
    for (int pass = 0; pass < 2; ++pass)
        for (int p = 0; p < N_PHASES; ++p) { a.ph_lo = p; a.ph_hi = p + 1; hipLaunchKernelGGL(fwd_kernel, dim3(grid), dim3(NTHR), LDS_BYTES, stream, a);
            Reg r[4]; const int nr = phase_regions(p, r);
            for (int i = 0; i < nr; ++i) hipLaunchKernelGGL(k_checksum, dim3(2048), dim3(256), 0, stream, (const unsigned*)(r[i].in_out ? (char*)d_out : (char*)d_ws + r[i].off), r[i].bytes / 4, tab + (size_t)pass * N_PHASES * 4 + p * 4 + i); }
    hipLaunchKernelGGL(k_zero_out, dim3(2048), dim3(256), 0, stream, (float*)d_out, (size_t)T * D);
    hipLaunchKernelGGL(k_report, dim3(1), dim3(64), 0, stream, tab, N_PHASES * 4, (float*)d_out);
#elif MK_ONE_LAUNCH
    a.ph_lo = 0; a.ph_hi = N_PHASES;
    hipLaunchKernelGGL(fwd_kernel, dim3(grid), dim3(NTHR), LDS_BYTES, stream, a);
#else
    for (int p = 0; p < N_PHASES; ++p) { a.ph_lo = p; a.ph_hi = p + 1; hipLaunchKernelGGL(fwd_kernel, dim3(grid), dim3(NTHR), LDS_BYTES, stream, a); }
#endif
}
```

```cpp
#include <hip/hip_runtime.h>
#include <cstdio>
#include <cstdint>

#ifndef MK_ONE_LAUNCH
#define MK_ONE_LAUNCH 1
#endif

#define GAS __attribute__((address_space(1)))
#define LAS __attribute__((address_space(3)))
typedef unsigned short bf16_t;
typedef short bf16x8 __attribute__((ext_vector_type(8)));
typedef short s16x4 __attribute__((ext_vector_type(4)));
typedef float f32x4 __attribute__((ext_vector_type(4)));
typedef float f32x2 __attribute__((ext_vector_type(2)));
typedef float f32x16 __attribute__((ext_vector_type(16)));
typedef unsigned u32x4 __attribute__((ext_vector_type(4)));
typedef unsigned u32x2 __attribute__((ext_vector_type(2)));

constexpr int D = 1024, TP = 16384, TS = 65536, T = TP + TS, SP = 8192, SS = 2048;
constexpr int NL = 4;
constexpr int NWAVES = 8, NTHR = 512;
constexpr float DN_ALPHA = 1.681792830507429f;
constexpr float LN_EPS = 1e-5f, RMS_EPS = 1e-6f;
constexpr float MLA_SCALE = 0.07216878364870323f;
constexpr int NEXP = 16384;

constexpr size_t MiB = 1u << 20;
constexpr size_t WS_CTL = 0, CTL_ZERO_BYTES = 64 * 1024;
constexpr size_t WS_ROPE = 1 * MiB;
constexpr size_t WS_MISC = 3 * MiB;
constexpr size_t WS_W = 4 * MiB;
constexpr size_t W_WA = WS_W;
constexpr size_t W_WUQ = W_WA + 2 * (size_t)768 * 1024 * 2;
constexpr size_t W_WUKV = W_WUQ + 2 * (size_t)1536 * 384 * 2;
constexpr size_t W_WO = W_WUKV + 2 * (size_t)2048 * 256 * 2;
constexpr size_t W_HIN = W_WO + 2 * (size_t)1024 * 1024 * 2;
constexpr size_t W_HO = W_HIN + 2 * (size_t)5120 * 1024 * 2;
constexpr size_t W_PQ = W_HO + 2 * (size_t)1024 * 1024 * 2;
constexpr size_t W_GW = W_PQ + 4 * (size_t)2048 * 1024 * 2;
constexpr size_t W_PP = W_GW + 4 * (size_t)1024 * 1024 * 2;
constexpr size_t W_KEYS = W_PP + 4 * (size_t)1024 * 256 * 2;
constexpr size_t W_END = W_KEYS + 4 * (size_t)2 * 128 * 128 * 2;
static_assert(W_END <= 68 * MiB, "weights region");
constexpr size_t WS_R2 = 68 * MiB;
constexpr size_t R2_UB = WS_R2, R2_VB = WS_R2 + 16 * MiB, R2_SU = WS_R2 + 32 * MiB, R2_SV = WS_R2 + 33 * MiB, R2_IDX = WS_R2 + 64 * MiB, R2_GATE = WS_R2 + 104 * MiB, R2_PB = WS_R2 + 144 * MiB;
constexpr size_t WS_XB = 252 * MiB;
constexpr size_t WS_BIG = 412 * MiB;
constexpr size_t WS_END = WS_BIG + 800 * MiB;
constexpr size_t B_Q = WS_BIG, B_KV = WS_BIG + 240 * MiB, B_O = WS_BIG + 560 * MiB, B_KROPE = WS_BIG + 720 * MiB;
constexpr size_t B_A32 = WS_BIG + 240 * MiB, B_CQN = WS_BIG + 560 * MiB, B_CKVN = WS_BIG + 620 * MiB, B_H32_MLA = WS_BIG;
constexpr size_t B_PLANE = WS_BIG, PLANE_BYTES = 160 * MiB, B_H32_HGRN = WS_BIG + 160 * MiB;
constexpr size_t B_PQ = WS_BIG, B_PP = WS_BIG + 320 * MiB, B_X8 = WS_BIG + 480 * MiB, B_XS = WS_BIG + 560 * MiB;

constexpr int LDS_BYTES = 160 * 1024;
constexpr int LDS_MISC_OFF = LDS_BYTES - 256;

typedef __bf16 bf16x2_n __attribute__((ext_vector_type(2)));
__device__ __forceinline__ unsigned cvt_pk_bf16(float lo, float hi) { const f32x2 v = {lo, hi}; const bf16x2_n b = __builtin_convertvector(v, bf16x2_n); return __builtin_bit_cast(unsigned, b); }
__device__ __forceinline__ bf16_t f2bf(float f) { return (bf16_t)(cvt_pk_bf16(f, 0.f) & 0xffffu); }
__device__ __forceinline__ float bf2f(bf16_t b) { return __uint_as_float(((unsigned)b) << 16); }
__device__ __forceinline__ float bflo(unsigned w) { return __uint_as_float(w << 16); }
__device__ __forceinline__ float bfhi(unsigned w) { return __uint_as_float(w & 0xffff0000u); }
#define DPPF(v, ctrl) __int_as_float(__builtin_amdgcn_update_dpp(0, __float_as_int(v), (ctrl), 0xf, 0xf, true))
__device__ __forceinline__ float row16_sum(float v) { v += DPPF(v, 0xB1); v += DPPF(v, 0x4E); v += DPPF(v, 0x141); v += DPPF(v, 0x140); return v; }
__device__ __forceinline__ float wave_sum(float v) { v = row16_sum(v);
    { auto r = __builtin_amdgcn_permlane16_swap(__float_as_uint(v), __float_as_uint(v), false, false); v = __uint_as_float(r[0]) + __uint_as_float(r[1]); }
    { auto r = __builtin_amdgcn_permlane32_swap(__float_as_uint(v), __float_as_uint(v), false, false); v = __uint_as_float(r[0]) + __uint_as_float(r[1]); }
    return v; }
__device__ __forceinline__ float wave_max(float v) { v = fmaxf(v, DPPF(v, 0xB1)); v = fmaxf(v, DPPF(v, 0x4E)); v = fmaxf(v, DPPF(v, 0x141)); v = fmaxf(v, DPPF(v, 0x140));
    { auto r = __builtin_amdgcn_permlane16_swap(__float_as_uint(v), __float_as_uint(v), false, false); v = fmaxf(__uint_as_float(r[0]), __uint_as_float(r[1])); }
    { auto r = __builtin_amdgcn_permlane32_swap(__float_as_uint(v), __float_as_uint(v), false, false); v = fmaxf(__uint_as_float(r[0]), __uint_as_float(r[1])); }
    return v; }
__device__ __forceinline__ float fast_exp(float x) { return __builtin_amdgcn_exp2f(x * 1.4426950408889634f); }
__device__ __forceinline__ float fast_log(float x) { return __builtin_amdgcn_logf(x) * 0.6931471805599453f; }
__device__ __forceinline__ float fast_rcp(float x) { return __builtin_amdgcn_rcpf(x); }
__device__ __forceinline__ float sigmoidf_(float x) { return fast_rcp(1.0f + fast_exp(-x)); }
__device__ __forceinline__ float siluf_(float x) { return x * sigmoidf_(x); }
#define LDS_WAIT() asm volatile("s_waitcnt lgkmcnt(0)" ::: "memory")
#define VM_WAIT() asm volatile("s_waitcnt vmcnt(0)" ::: "memory")
__device__ __forceinline__ int opaque_lane() { int l; asm volatile("v_mbcnt_lo_u32_b32 %0, -1, 0\n\tv_mbcnt_hi_u32_b32 %0, -1, %0" : "=v"(l)); return l; }
__device__ __forceinline__ int opaque_tid(int wave_s) { asm volatile("" : "+s"(wave_s)); return (wave_s << 6) + opaque_lane(); }
__device__ __forceinline__ int opaque_bid() { int b = (int)blockIdx.x; asm volatile("" : "+s"(b)); return b; }
struct Args { const float* in[25]; float* out; unsigned char* ws; int ph_lo, ph_hi; };
#define XB_TMO      128
#define XB_XCNT(j)  (256  + 64 * (j))
#define XB_XSUB(j)  (1280 + 64 * (j))
#define XB_XGEN(j)  (2304 + 64 * (j))
#define XB_TOP      3328
#define XB_TOPGEN   3392
#define XCD_BAR_WORDS 3456
#define XB_SPIN_CAP (1u << 23)

__device__ __forceinline__ unsigned xb_ld(unsigned* p)              { return __hip_atomic_load(p, __ATOMIC_RELAXED, __HIP_MEMORY_SCOPE_AGENT); }
__device__ __forceinline__ unsigned xb_add(unsigned* p, unsigned v) { return __hip_atomic_fetch_add(p, v, __ATOMIC_RELAXED, __HIP_MEMORY_SCOPE_AGENT); }
__device__ __forceinline__ unsigned xb_xcc_id() { return (unsigned)__builtin_amdgcn_s_getreg((3 << 11) | 20) & 0xFu; }
#define XB_SPIN(cond, bar) do { unsigned _sp = 0; while (cond) { __builtin_amdgcn_s_sleep(1); \
    if ((++_sp & 255u) == 0u) { if (xb_ld(&(bar)[XB_TMO])) break; if (_sp > XB_SPIN_CAP) { atomicAdd(&(bar)[XB_TMO], 1u); break; } } } } while (0)

struct XcdBarrier {
    unsigned* bar; unsigned x;
    volatile LAS unsigned* st;
};

__device__ __forceinline__ XcdBarrier xcd_barrier_post(unsigned* bar, volatile LAS unsigned* st) {
    XcdBarrier b; b.bar = bar; b.x = xb_xcc_id(); b.st = st;
    if (threadIdx.x == 0) (void)xb_add(&bar[XB_XCNT(b.x)], 1u);
    return b;
}
__device__ __forceinline__ void xcd_barrier_complete(unsigned* bar, unsigned x, unsigned& nloc, unsigned& nx) {
    const unsigned G = gridDim.x * gridDim.y * gridDim.z;
    unsigned sum, cnt, mine, sp = 0u;
    for (;;) {
        sum = 0u; cnt = 0u; mine = 0u;
#pragma unroll
        for (unsigned j = 0; j < 16; ++j) { const unsigned c = xb_ld(&bar[XB_XCNT(j)]); sum += c; cnt += (c > 0u) ? 1u : 0u; mine = (j == x) ? c : mine; }
        if (sum == G) break;
        __builtin_amdgcn_s_sleep(1);
        if ((++sp & 255u) == 0u) { if (xb_ld(&bar[XB_TMO])) break; if (sp > XB_SPIN_CAP) { atomicAdd(&bar[XB_TMO], 1u); break; } }
    }
    nloc = mine > 0u ? mine : 1u; nx = cnt > 0u ? cnt : 1u;
}

__device__ __forceinline__ void xcd_barrier(const XcdBarrier& b) {
    asm volatile("s_waitcnt vmcnt(0)" ::: "memory");
    __syncthreads();
    if (threadIdx.x == 0) {
        unsigned* bar = b.bar;
        __builtin_amdgcn_s_waitcnt(0);
        unsigned nloc = b.st[0], nx = b.st[1];
        if (nloc == 0u) { xcd_barrier_complete(bar, b.x, nloc, nx); b.st[0] = nloc; b.st[1] = nx; }
        const unsigned old = xb_add(&bar[XB_XSUB(b.x)], 1u);
        const unsigned gen = old / nloc;
        if (old + 1u == (gen + 1u) * nloc) {
            __builtin_amdgcn_fence(__ATOMIC_RELEASE, "agent");
            asm volatile("s_waitcnt vmcnt(0)" ::: "memory");
            const unsigned og = xb_add(&bar[XB_TOP], 1u);
            const unsigned tg = og / nx;
            if (og + 1u == (tg + 1u) * nx) xb_add(&bar[XB_TOPGEN], 1u);
            else XB_SPIN(xb_ld(&bar[XB_TOPGEN]) == tg, bar);
            __builtin_amdgcn_fence(__ATOMIC_ACQUIRE, "agent");
            xb_add(&bar[XB_XGEN(b.x)], 1u);
            asm volatile("s_waitcnt vmcnt(0)" ::: "memory");
        } else {
            XB_SPIN(xb_ld(&bar[XB_XGEN(b.x)]) == gen, bar);
            __builtin_amdgcn_fence(__ATOMIC_ACQUIRE, "agent");
            asm volatile("s_waitcnt vmcnt(0)" ::: "memory");
        }
    }
    __syncthreads();
}
namespace pg8 {
#define PG8_LAS __attribute__((address_space(3)))
constexpr int BM = 256, BK = 64, HALF = 128, HTB = HALF * BK * 2  , STAGE_BYTES = 8 * HTB, NXCD = 8, WGM = 8;

__host__ __device__ __forceinline__ int lds_byte(int r, int c) { const int st = (r >> 4) * 2 + (c >> 5), rr = r & 15, cc = c & 31, ob = rr * 64 + cc * 2; return st * 1024 + (ob ^ (((ob >> 9) & 1) << 5)); }
__host__ __device__ __forceinline__ void stage_rc(int b, int& R, int& C) { const int st = b / 1024, sb = b % 1024, swz = sb ^ (((sb >> 9) & 1) << 5); R = (st >> 1) * 16 + swz / 64; C = (st & 1) * 32 + (swz % 64) / 2; }
__host__ __device__ __forceinline__ int perm32(int rho) { const int n = rho >> 4, i = rho & 15; return 8 * (i >> 2) + 4 * n + (i & 3); }

struct Unit { int pm, pn; };
struct Gemm { const bf16_t* A; const bf16_t* Bt; int M, N, K; };

struct StaticOrder {
    int nM, nN, nwg, G, c;
    __host__ __device__ void init(int M, int N, int G_, int c_) { nM = M / BM; nN = N / BM; nwg = nM * nN; G = G_; c = c_; }
    __host__ __device__ bool next(int i, Unit& u) const {
        const long L = (long)i * G + c; if (L >= nwg) return false;
        int wgid = (int)L; { const int q = nwg / NXCD, r = nwg % NXCD, xcd = wgid % NXCD, off = wgid / NXCD; wgid = (xcd < r ? xcd * (q + 1) : r * (q + 1) + (xcd - r) * q) + off; }
        const int nig = WGM * nN, gid = wgid / nig, fm = gid * WGM, gsz = (nM - fm) < WGM ? (nM - fm) : WGM;
        u.pm = fm + ((wgid % nig) % gsz); u.pn = (wgid % nig) / gsz; return true;
    }
    __device__ __forceinline__ void a_ready(const Unit&) const {}
    __device__ __forceinline__ void done(const Unit&) const {}
};
template <class Epi, class Sched>
__device__ __forceinline__ void gemm_phase(PG8_LAS unsigned char* lds, const Gemm g, const Sched& S, const Epi& E, const int tid) {
    const int wid = __builtin_amdgcn_readfirstlane(tid >> 6), lane = tid & 63, wr = wid >> 2, wc = wid & 3, fr = lane & 15, fq = lane >> 4;
    const int K = g.K, nt = K / BK;
    unsigned voffA[2], voffB[2];
#pragma unroll
    for (int i = 0; i < 2; ++i) { int R, C; stage_rc(tid * 16 + i * 8192, R, C); const int Rb = Epi::PERM ? ((R & ~31) + perm32(R & 31)) : R;
        voffA[i] = (unsigned)(R * K + C) * 2u; voffB[i] = (unsigned)(Rb * K + C) * 2u; }
    const size_t kstep = (size_t)(BK * 2);
    const size_t hstep = (size_t)HALF * K * 2;
    const size_t tstep = 2 * hstep;
    const unsigned ldsw = (unsigned)wid * 1024u;
    const int aoff = lds_byte(wr * 64 + fr, fq * 8), boff = lds_byte(wc * 32 + fr, fq * 8);
#define PG8_SA(b, h) (((b) * 2 + (h)) * HTB)
#define PG8_SB(b, h) ((4 + (b) * 2 + (h)) * HTB)
#define PG8_STAGE(bufoff, gbase, voff) do { _Pragma("unroll") for (int _i = 0; _i < 2; ++_i) \
        __builtin_amdgcn_global_load_lds((const unsigned*)((const char*)(gbase) + (voff)[_i]), (PG8_LAS unsigned*)(lds + (bufoff) + ldsw + _i * 8192), 16, 0, 0); } while (0)
#define PG8_LDA(dst, b, h) do { _Pragma("unroll") for (int m = 0; m < 4; ++m) _Pragma("unroll") for (int k = 0; k < 2; ++k) dst[m][k] = *(const PG8_LAS bf16x8*)(lds + PG8_SA(b, h) + aoff + m * 2048 + k * 1024); } while (0)
#define PG8_LDB(dst, b, h) do { _Pragma("unroll") for (int n = 0; n < 2; ++n) _Pragma("unroll") for (int k = 0; k < 2; ++k) dst[n][k] = *(const PG8_LAS bf16x8*)(lds + PG8_SB(b, h) + boff + n * 2048 + k * 1024); } while (0)
#define PG8_MMA(ai, bj, At, Bt) do { __builtin_amdgcn_s_setprio(1); _Pragma("unroll") for (int m = 0; m < 4; ++m) _Pragma("unroll") for (int n = 0; n < 2; ++n) _Pragma("unroll") for (int k = 0; k < 2; ++k) \
        acc[ai][bj][m][n] = __builtin_amdgcn_mfma_f32_16x16x32_bf16(Bt[n][k], At[m][k], acc[ai][bj][m][n], 0, 0, 0); __builtin_amdgcn_s_setprio(0); } while (0)
#define PG8_WAIT_V(n) asm volatile("s_waitcnt vmcnt(" #n ")" ::: "memory")
#define PG8_WAIT_L(n) asm volatile("s_waitcnt lgkmcnt(" #n ")" ::: "memory")
#define PG8_BAR __builtin_amdgcn_s_barrier()
#define PG8_SCHED __builtin_amdgcn_sched_barrier(0)
    Unit cur, nxt; int ui = 0;
    if (!S.next(0, cur)) return;
    f32x4 acc[2][2][4][2];
#pragma unroll
    for (int a = 0; a < 2; ++a)
#pragma unroll
        for (int b = 0; b < 2; ++b)
#pragma unroll
            for (int m = 0; m < 4; ++m)
#pragma unroll
                for (int n = 0; n < 2; ++n) acc[a][b][m][n] = (f32x4){0.f, 0.f, 0.f, 0.f};
    bf16x8 At[4][2], B0[2][2], B1[2][2];
    const char* cA = (const char*)g.A + (size_t)cur.pm * tstep; const char* cB = (const char*)g.Bt + (size_t)cur.pn * tstep;
    S.a_ready(cur);
    PG8_STAGE(PG8_SB(0, 0), cB, voffB); PG8_STAGE(PG8_SA(0, 0), cA, voffA); PG8_STAGE(PG8_SB(0, 1), cB + hstep, voffB); PG8_STAGE(PG8_SA(0, 1), cA + hstep, voffA);
    if (wr == 1) PG8_BAR;
    PG8_WAIT_V(4); PG8_BAR;
    PG8_STAGE(PG8_SB(1, 0), cB + kstep, voffB); PG8_STAGE(PG8_SA(1, 0), cA + kstep, voffA); PG8_STAGE(PG8_SB(1, 1), cB + hstep + kstep, voffB);
    PG8_WAIT_V(6); PG8_BAR;
    for (;;) {
        const bool has_next = S.next(ui + 1, nxt);
        const char* nA = has_next ? (const char*)g.A + (size_t)nxt.pm * tstep : cA; const char* nB = has_next ? (const char*)g.Bt + (size_t)nxt.pn * tstep : cB;
        for (int t = 0; t < nt; t += 2) {
            const bool last = (t == nt - 2);
            const char* a1 = cA + (size_t)(t + 1) * kstep;
            const char* a2 = last ? nA : cA + (size_t)(t + 2) * kstep; const char* b2 = last ? nB : cB + (size_t)(t + 2) * kstep;
            const char* a3 = a2 + kstep; const char* b3 = b2 + kstep;
            if (last && has_next) S.a_ready(nxt);
            PG8_LDB(B0, 0, 0); PG8_SCHED; PG8_LDA(At, 0, 0); PG8_STAGE(PG8_SA(1, 1), a1 + hstep, voffA);
            PG8_WAIT_L(8); PG8_BAR; PG8_WAIT_L(0); PG8_MMA(0, 0, At, B0); PG8_BAR; PG8_SCHED;
            PG8_LDB(B1, 0, 1); PG8_STAGE(PG8_SB(0, 0), b2, voffB);
            PG8_BAR; PG8_WAIT_L(0); PG8_MMA(0, 1, At, B1); PG8_BAR;
            PG8_LDA(At, 0, 1); PG8_STAGE(PG8_SA(0, 0), a2, voffA);
            PG8_BAR; PG8_WAIT_L(0); PG8_MMA(1, 0, At, B0); PG8_BAR; PG8_SCHED;
            PG8_STAGE(PG8_SB(0, 1), b2 + hstep, voffB);
            PG8_WAIT_V(6); PG8_BAR; PG8_MMA(1, 1, At, B1); PG8_BAR;
            PG8_LDB(B0, 1, 0); PG8_SCHED; PG8_LDA(At, 1, 0); PG8_STAGE(PG8_SA(0, 1), a2 + hstep, voffA);
            PG8_WAIT_L(8); PG8_BAR; PG8_WAIT_L(0); PG8_MMA(0, 0, At, B0); PG8_BAR; PG8_SCHED;
            PG8_LDB(B1, 1, 1); PG8_STAGE(PG8_SB(1, 0), b3, voffB);
            PG8_BAR; PG8_WAIT_L(0); PG8_MMA(0, 1, At, B1); PG8_BAR;
            PG8_LDA(At, 1, 1); PG8_STAGE(PG8_SA(1, 0), a3, voffA);
            PG8_BAR; PG8_WAIT_L(0); PG8_MMA(1, 0, At, B0); PG8_BAR; PG8_SCHED;
            PG8_STAGE(PG8_SB(1, 1), b3 + hstep, voffB);
            PG8_WAIT_V(6); PG8_BAR; PG8_MMA(1, 1, At, B1); PG8_BAR;
        }
        E(acc, cur, wr, wc, fr, fq); S.done(cur);
        if (!has_next) break;
#pragma unroll
        for (int a = 0; a < 2; ++a)
#pragma unroll
            for (int b = 0; b < 2; ++b)
#pragma unroll
                for (int m = 0; m < 4; ++m)
#pragma unroll
                    for (int n = 0; n < 2; ++n) acc[a][b][m][n] = (f32x4){0.f, 0.f, 0.f, 0.f};
        cur = nxt; cA = nA; cB = nB; ++ui;
    }
    PG8_WAIT_V(0);
    if (wr == 0) PG8_BAR;
    PG8_BAR;
#undef PG8_SA
#undef PG8_SB
#undef PG8_STAGE
#undef PG8_LDA
#undef PG8_LDB
#undef PG8_MMA
#undef PG8_WAIT_V
#undef PG8_WAIT_L
#undef PG8_BAR
#undef PG8_SCHED
}
struct EpiF32 {
    static constexpr bool PERM = false;
    float* C; int ldc;
    __device__ __forceinline__ void operator()(const f32x4 (&acc)[2][2][4][2], const Unit& u, int wr, int wc, int fr, int fq) const {
        const int row0 = u.pm * BM + wr * 64 + fr, col0 = u.pn * BM + wc * 32 + 4 * fq;
#pragma unroll
        for (int ai = 0; ai < 2; ++ai)
#pragma unroll
            for (int m = 0; m < 4; ++m) { float* rowp = C + (size_t)(row0 + ai * HALF + m * 16) * ldc + col0;
#pragma unroll
                for (int bj = 0; bj < 2; ++bj)
#pragma unroll
                    for (int n = 0; n < 2; ++n) *(f32x4*)(rowp + bj * HALF + n * 16) = acc[ai][bj][m][n]; }
    }
};
struct EpiBf16P {
    static constexpr bool PERM = true;
    bf16_t* O; int ldc;
    __device__ __forceinline__ void operator()(const f32x4 (&acc)[2][2][4][2], const Unit& u, int wr, int wc, int fr, int fq) const {
        const int row0 = u.pm * BM + wr * 64 + fr, col0 = u.pn * BM + wc * 32 + 8 * fq;
#pragma unroll
        for (int ai = 0; ai < 2; ++ai)
#pragma unroll
            for (int m = 0; m < 4; ++m) { bf16_t* rowp = O + (size_t)(row0 + ai * HALF + m * 16) * ldc + col0;
#pragma unroll
                for (int bj = 0; bj < 2; ++bj) { const f32x4 v0 = acc[ai][bj][m][0], v1 = acc[ai][bj][m][1];
                    u32x4 w; w.x = cvt_pk_bf16(v0[0], v0[1]); w.y = cvt_pk_bf16(v0[2], v0[3]); w.z = cvt_pk_bf16(v1[0], v1[1]); w.w = cvt_pk_bf16(v1[2], v1[3]);
                    *(u32x4*)(rowp + bj * HALF) = w; } }
    }
};
struct EpiHgrn {
    static constexpr bool PERM = true;
    bf16_t* planes; size_t plane_elems; const float* lb;
    __device__ __forceinline__ void operator()(const f32x4 (&acc)[2][2][4][2], const Unit& u, int wr, int wc, int fr, int fq) const {
        const int plane = u.pn >> 2;
        const int row0 = u.pm * BM + wr * 64 + fr, col0 = (u.pn & 3) * BM + wc * 32 + 8 * fq;
        bf16_t* base = planes + (size_t)plane * plane_elems;
        float lbv[2][8];
        if (plane == 1 || plane == 2) {
#pragma unroll
            for (int bj = 0; bj < 2; ++bj)
#pragma unroll
                for (int e = 0; e < 8; ++e) lbv[bj][e] = lb[(plane - 1) * 1024 + col0 + bj * HALF + e];
        } else {
#pragma unroll
            for (int bj = 0; bj < 2; ++bj)
#pragma unroll
                for (int e = 0; e < 8; ++e) lbv[bj][e] = 0.f;
        }
#pragma unroll
        for (int ai = 0; ai < 2; ++ai)
#pragma unroll
            for (int m = 0; m < 4; ++m) { bf16_t* rowp = base + (size_t)(row0 + ai * HALF + m * 16) * 1024 + col0;
#pragma unroll
                for (int bj = 0; bj < 2; ++bj) { float v[8];
#pragma unroll
                    for (int e = 0; e < 4; ++e) { v[e] = acc[ai][bj][m][0][e]; v[4 + e] = acc[ai][bj][m][1][e]; }
                    if (plane == 0 || plane == 4) {
#pragma unroll
                        for (int e = 0; e < 8; ++e) v[e] = siluf_(v[e]);
                    } else if (plane == 1 || plane == 2) {
#pragma unroll
                        for (int e = 0; e < 8; ++e) { const float l = lbv[bj][e]; const float f = l + (1.0f - l) * sigmoidf_(v[e]); v[e] = fast_log(fmaxf(f, 1e-30f)); }
                    }
                    u32x4 w; w.x = cvt_pk_bf16(v[0], v[1]); w.y = cvt_pk_bf16(v[2], v[3]); w.z = cvt_pk_bf16(v[4], v[5]); w.w = cvt_pk_bf16(v[6], v[7]);
                    *(u32x4*)(rowp + bj * HALF) = w; } }
    }
};
struct EpiPle {
    static constexpr bool PERM = false;
    const bf16_t* Xin; const bf16_t* PP; const float* bias; bf16_t* XbOut; float* Fout;
    __device__ __forceinline__ void operator()(const f32x4 (&acc)[2][2][4][2], const Unit& u, int wr, int wc, int fr, int fq) const {
        const int row0 = u.pm * BM + wr * 64 + fr, col0 = u.pn * BM + wc * 32 + 4 * fq;
        f32x4 bv[2][2];
#pragma unroll
        for (int bj = 0; bj < 2; ++bj)
#pragma unroll
            for (int n = 0; n < 2; ++n) bv[bj][n] = *(const f32x4*)(bias + col0 + bj * HALF + n * 16);
#pragma unroll
        for (int ai = 0; ai < 2; ++ai)
#pragma unroll
            for (int m = 0; m < 4; ++m) { const size_t off = (size_t)(row0 + ai * HALF + m * 16) * 1024 + col0;
#pragma unroll
                for (int bj = 0; bj < 2; ++bj)
#pragma unroll
                    for (int n = 0; n < 2; ++n) { const size_t o2 = off + bj * HALF + n * 16;
                        const u32x2 xw = *(const u32x2*)(Xin + o2); const u32x2 pw = *(const u32x2*)(PP + o2); const f32x4 z = acc[ai][bj][m][n] + bv[bj][n];
                        f32x4 o; o[0] = bflo(xw.x) + sigmoidf_(z[0]) * bflo(pw.x); o[1] = bfhi(xw.x) + sigmoidf_(z[1]) * bfhi(pw.x); o[2] = bflo(xw.y) + sigmoidf_(z[2]) * bflo(pw.y); o[3] = bfhi(xw.y) + sigmoidf_(z[3]) * bfhi(pw.y);
                        if (Fout) *(f32x4*)(Fout + o2) = o; else { u32x2 w; w.x = cvt_pk_bf16(o[0], o[1]); w.y = cvt_pk_bf16(o[2], o[3]); *(u32x2*)(XbOut + o2) = w; } }
                if (m & 1) asm volatile("" ::: "memory"); }
    }
};
}
namespace attn {
constexpr int DV = 128, DQK = 192, NW = 8, QBLK = 32, KVBLK = 64;
constexpr float SCALE = MLA_SCALE;
constexpr float THR = 8.f;
constexpr int LDQ = 8 * DQK, LDKV = 8 * 256, LDKR = 64, LDO = 1024;
constexpr int KROWB = 400;
constexpr int SHM_V = KVBLK * DV * 2, SHM_K = KVBLK * KROWB, SHM_ATTN = 2 * SHM_V + 2 * SHM_K + NW * 64 * 4 + NW * 4096;
#define SBAR() __builtin_amdgcn_sched_barrier(0)
__device__ __forceinline__ int crow(int r, int hi) { return (r & 3) + 8 * (r >> 2) + 4 * hi; }

__device__ __forceinline__ void partialSM(f32x16& p0, f32x16& p1, float& m_reg, float& mn, float& alpha) {
  constexpr float C = SCALE * 1.4426950408889634f;
  float pmax = p0[0];
#pragma unroll
  for (int r = 1; r < 16; ++r) pmax = fmaxf(pmax, p0[r]);
#pragma unroll
  for (int r = 0; r < 16; ++r) pmax = fmaxf(pmax, p1[r]);
  { auto rr = __builtin_amdgcn_permlane32_swap(__float_as_uint(pmax), __float_as_uint(pmax), false, false);
    pmax = fmaxf(__uint_as_float(rr[0]), __uint_as_float(rr[1])); }
  if (__builtin_expect(__all(pmax - m_reg <= THR / SCALE), 1)) { mn = m_reg; alpha = 1.f; }
  else { mn = fmaxf(m_reg, pmax); alpha = __builtin_amdgcn_exp2f((m_reg - mn) * C); m_reg = mn; }
  float mnC = -mn * C;
#pragma unroll
  for (int r = 0; r < 16; ++r) p0[r] = fmaf(p0[r], C, mnC);
#pragma unroll
  for (int r = 0; r < 16; ++r) p1[r] = fmaf(p1[r], C, mnC);
#pragma unroll
  for (int r = 0; r < 16; ++r) p0[r] = __builtin_amdgcn_exp2f(p0[r]);
}
__device__ __forceinline__ void finishSM(f32x16& p0, f32x16& p1, float alpha, float& l_reg, bf16x8& pa0, bf16x8& pa1, bf16x8& pa2, bf16x8& pa3) {
#pragma unroll
  for (int r = 0; r < 16; ++r) p1[r] = __builtin_amdgcn_exp2f(p1[r]);
  float ps = 0;
#pragma unroll
  for (int r = 0; r < 16; ++r) ps += p0[r];
#pragma unroll
  for (int r = 0; r < 16; ++r) ps += p1[r];
  { auto rr = __builtin_amdgcn_permlane32_swap(__float_as_uint(ps), __float_as_uint(ps), false, false);
    ps = __uint_as_float(rr[0]) + __uint_as_float(rr[1]); }
  l_reg = l_reg * alpha + ps;
#define PK4(P, BASE, OUT) do { unsigned a0 = cvt_pk_bf16(P[BASE + 0], P[BASE + 1]), a1 = cvt_pk_bf16(P[BASE + 2], P[BASE + 3]);   \
    unsigned b0 = cvt_pk_bf16(P[BASE + 4], P[BASE + 5]), b1 = cvt_pk_bf16(P[BASE + 6], P[BASE + 7]);                              \
    auto r0 = __builtin_amdgcn_permlane32_swap(a0, b0, false, false); auto r1 = __builtin_amdgcn_permlane32_swap(a1, b1, false, false); \
    u32x4 w = {r0[0], r1[0], r0[1], r1[1]}; OUT = *reinterpret_cast<bf16x8*>(&w); } while (0)
  PK4(p0, 0, pa0); PK4(p0, 8, pa1); PK4(p1, 0, pa2); PK4(p1, 8, pa3);
#undef PK4
}
__device__ __forceinline__ void qkt(f32x16& p0, f32x16& p1, const char* Ks, const bf16x8* qr, const char* qrl, int r32, int hi) {
  p0 = f32x16{}; p1 = f32x16{};
  const char* k0 = Ks + r32 * KROWB + hi * 16; const char* k1 = Ks + (32 + r32) * KROWB + hi * 16;
  bf16x8 fa[2], fb[2], ga[2], gb[2], qx[2], qy[2];
#define QK_LD(FA, FB, QX, G) _Pragma("unroll") for (int i = 0; i < 2; ++i) { FA[i] = *reinterpret_cast<const bf16x8*>(k0 + ((G) * 2 + i) * 32); FB[i] = *reinterpret_cast<const bf16x8*>(k1 + ((G) * 2 + i) * 32); \
      if ((G) * 2 + i >= 8) QX[i] = *reinterpret_cast<const bf16x8*>(qrl + ((G) * 2 + i - 8) * 1024); }
#define QK_MM(FA, FB, QX, G) _Pragma("unroll") for (int i = 0; i < 2; ++i) { const bf16x8 qf = ((G) * 2 + i < 8) ? qr[((G) * 2 + i < 8) ? (G) * 2 + i : 0] : QX[i]; \
      p0 = __builtin_amdgcn_mfma_f32_32x32x16_bf16(FA[i], qf, p0, 0, 0, 0); p1 = __builtin_amdgcn_mfma_f32_32x32x16_bf16(FB[i], qf, p1, 0, 0, 0); }
  QK_LD(fa, fb, qx, 0) SBAR();
  QK_LD(ga, gb, qy, 1) SBAR(); QK_MM(fa, fb, qx, 0) SBAR();
  QK_LD(fa, fb, qx, 2) SBAR(); QK_MM(ga, gb, qy, 1) SBAR();
  QK_LD(ga, gb, qy, 3) SBAR(); QK_MM(fa, fb, qx, 2) SBAR();
  QK_LD(fa, fb, qx, 4) SBAR(); QK_MM(ga, gb, qy, 3) SBAR();
  QK_LD(ga, gb, qy, 5) SBAR(); QK_MM(fa, fb, qx, 4) SBAR();
  QK_MM(ga, gb, qy, 5) SBAR();
#undef QK_LD
#undef QK_MM
}
__device__ __forceinline__ int v_st(int k, int c) { const int kk = (k & ~0xC) | ((k & 4) << 1) | ((k & 8) >> 1); return ((kk >> 3) * 4 + (c >> 5)) * 512 + ((kk & 7) * 32 + (c & 31)) * 2; }
__device__ __forceinline__ int v_rd_base(int lane) { return ((lane & 3) << 3) | (((lane >> 2) & 3) << 6) | (((lane >> 4) & 1) << 5) | (((lane >> 5) & 1) << 8); }
constexpr int v_rd_off(int d0, int ks, int half) { return d0 * 512 + ks * 4096 + half * 2048; }
template <int OFF> __device__ __forceinline__ s16x4 tr_read(int vb) {
  s16x4 r; asm volatile("ds_read_b64_tr_b16 %0, %1 offset:%2" : "=&v"(r) : "v"(vb), "i"(OFF) : "memory"); return r;
}
template <int D0> __device__ __forceinline__ void pv_one(f32x16& od, int vb, bf16x8 pa0, bf16x8 pa1, bf16x8 pa2, bf16x8 pa3) {
  const s16x4 l0 = tr_read<v_rd_off(D0, 0, 0)>(vb), h0 = tr_read<v_rd_off(D0, 0, 1)>(vb), l1 = tr_read<v_rd_off(D0, 1, 0)>(vb), h1 = tr_read<v_rd_off(D0, 1, 1)>(vb);
  const s16x4 l2 = tr_read<v_rd_off(D0, 2, 0)>(vb), h2 = tr_read<v_rd_off(D0, 2, 1)>(vb), l3 = tr_read<v_rd_off(D0, 3, 0)>(vb), h3 = tr_read<v_rd_off(D0, 3, 1)>(vb);
  asm volatile("s_waitcnt lgkmcnt(0)" ::: "memory"); SBAR();
#define PK(L, H) (bf16x8){L[0], L[1], L[2], L[3], H[0], H[1], H[2], H[3]}
  od = __builtin_amdgcn_mfma_f32_32x32x16_bf16(pa0, PK(l0, h0), od, 0, 0, 0);
  od = __builtin_amdgcn_mfma_f32_32x32x16_bf16(pa1, PK(l1, h1), od, 0, 0, 0);
  od = __builtin_amdgcn_mfma_f32_32x32x16_bf16(pa2, PK(l2, h2), od, 0, 0, 0);
  od = __builtin_amdgcn_mfma_f32_32x32x16_bf16(pa3, PK(l3, h3), od, 0, 0, 0);
#undef PK
}
__device__ __forceinline__ void pv_d0(f32x16* o, int vb, bf16x8 pa0, bf16x8 pa1, bf16x8 pa2, bf16x8 pa3) {
  pv_one<0>(o[0], vb, pa0, pa1, pa2, pa3); pv_one<1>(o[1], vb, pa0, pa1, pa2, pa3); pv_one<2>(o[2], vb, pa0, pa1, pa2, pa3); pv_one<3>(o[3], vb, pa0, pa1, pa2, pa3);
}

template <int VAR> __device__ __forceinline__ void attn_body(const bf16_t* __restrict__ Qb, const bf16_t* __restrict__ Kn, const bf16_t* __restrict__ Kr,
                                          bf16_t* __restrict__ Ob, int seq, char* lds, int tid, int pos0, const float* __restrict__ ropeT) {
  asm volatile("" : "+v"(tid));
  const int wid = tid >> 6, lane = tid & 63, r32 = lane & 31, hi = lane >> 5;
  char* V_lds = lds; char* K_lds = lds + 2 * SHM_V;
  float* ws = (float*)(lds + 2 * SHM_V + 2 * SHM_K) + wid * 64; float* li_l = ws; float* al_l = ws + 32;
  float m_reg = -1e30f, l_reg = 0; f32x16 o[4] = {}; bf16x8 qr[8];
  char* qrl = lds + 2 * SHM_V + 2 * SHM_K + NW * 64 * 4 + wid * 4096 + lane * 16;
  const bf16_t* Qw = Qb + (long)(wid * QBLK + r32) * LDQ + hi * 8;
#pragma unroll
  for (int d0 = 0; d0 < 8; ++d0) qr[d0] = *reinterpret_cast<const bf16x8*>(Qw + d0 * 16);
  { const float* cp = ropeT + (size_t)(pos0 + wid * QBLK + r32) * 32 + hi * 8; const float* sp = cp + 8192 * 32;
#pragma unroll
    for (int dd = 0; dd < 2; ++dd) { const f32x4 c0 = *(const f32x4*)(cp + 16 * dd), c1 = *(const f32x4*)(cp + 16 * dd + 4), s0 = *(const f32x4*)(sp + 16 * dd), s1 = *(const f32x4*)(sp + 16 * dd + 4);
      const u32x4 A = *reinterpret_cast<const u32x4*>(Qw + (8 + dd) * 16), B = *reinterpret_cast<const u32x4*>(Qw + (10 + dd) * 16); u32x4 An, Bn;
#pragma unroll
      for (int w2 = 0; w2 < 4; ++w2) { const float cs0 = w2 < 2 ? c0[2 * w2] : c1[2 * w2 - 4], cs1 = w2 < 2 ? c0[2 * w2 + 1] : c1[2 * w2 - 3], sn0 = w2 < 2 ? s0[2 * w2] : s1[2 * w2 - 4], sn1 = w2 < 2 ? s0[2 * w2 + 1] : s1[2 * w2 - 3];
        const float a0 = bflo(A[w2]), a1 = bfhi(A[w2]), b0 = bflo(B[w2]), b1 = bfhi(B[w2]);
        An[w2] = cvt_pk_bf16(a0 * cs0 - b0 * sn0, a1 * cs1 - b1 * sn1); Bn[w2] = cvt_pk_bf16(b0 * cs0 + a0 * sn0, b1 * cs1 + a1 * sn1); }
      *reinterpret_cast<u32x4*>(qrl + dd * 1024) = An; *reinterpret_cast<u32x4*>(qrl + (2 + dd) * 1024) = Bn; } }
  const bf16_t* Vh = Kn + 128;
  const int sr = tid >> 4, sc = (tid & 15) * 8, vst0 = v_st(sr, sc), vst1 = v_st(32 + sr, sc);
  int krow[3], kcc[3];
#pragma unroll
  for (int i = 0; i < 3; ++i) { const int id = tid + 512 * i; krow[i] = id / 24; kcc[i] = id % 24; }
  const int vb0 = (int)(uintptr_t)V_lds + v_rd_base(lane);
  bf16x8 vs0, vs1, ks0, ks1, ks2;
#define KSRC(i, k0) (kcc[i] < 16 ? (Kn + (long)((k0) + krow[i]) * LDKV + kcc[i] * 8) : (Kr + (long)((k0) + krow[i]) * LDKR + (kcc[i] - 16) * 8))
#define SLOAD(k0) do { vs0 = *reinterpret_cast<const bf16x8*>(&Vh[(long)((k0) + sr) * LDKV + sc]); vs1 = *reinterpret_cast<const bf16x8*>(&Vh[(long)((k0) + 32 + sr) * LDKV + sc]); \
    ks0 = *reinterpret_cast<const bf16x8*>(KSRC(0, k0)); ks1 = *reinterpret_cast<const bf16x8*>(KSRC(1, k0)); ks2 = *reinterpret_cast<const bf16x8*>(KSRC(2, k0)); } while (0)
#define SWRITE(b) do { *(bf16x8*)(V_lds + (b) * SHM_V + vst0) = vs0; *(bf16x8*)(V_lds + (b) * SHM_V + vst1) = vs1; \
    *(bf16x8*)(K_lds + (b) * SHM_K + krow[0] * KROWB + kcc[0] * 16) = ks0; *(bf16x8*)(K_lds + (b) * SHM_K + krow[1] * KROWB + kcc[1] * 16) = ks1; \
    *(bf16x8*)(K_lds + (b) * SHM_K + krow[2] * KROWB + kcc[2] * 16) = ks2; } while (0)
#define SWAIT() asm volatile("s_waitcnt vmcnt(0)" ::: "memory")
#define RESC(a) do { if (__any((a) < 1.f)) { if (hi == 0) al_l[r32] = (a); asm volatile("s_waitcnt lgkmcnt(0)" ::: "memory"); \
    _Pragma("unroll") for (int d = 0; d < 4; ++d) _Pragma("unroll") for (int r = 0; r < 16; ++r) o[d][r] *= al_l[crow(r, hi)]; } } while (0)
  f32x16 pA0, pA1; float mnA, alA; bf16x8 pa0, pa1, pa2, pa3; const int NT = seq / KVBLK;
  SLOAD(0); SWAIT(); SWRITE(0); __syncthreads();
  for (int j = 0; j < NT; ++j) {
    const int b = j & 1;
    if (VAR != 4) { if (j + 1 < NT) SLOAD((j + 1) * KVBLK); }
    if (VAR != 3) { SBAR(); qkt(pA0, pA1, K_lds + b * SHM_K, qr, qrl, r32, hi); } else { pA0 = f32x16{}; pA1 = f32x16{}; pA0[0] = (float)j; }
    if (VAR != 2) { partialSM(pA0, pA1, m_reg, mnA, alA);
      RESC(alA);
      finishSM(pA0, pA1, alA, l_reg, pa0, pa1, pa2, pa3); SBAR(); }
    else { u32x4 w0 = {__float_as_uint(pA0[0]), __float_as_uint(pA0[5]), __float_as_uint(pA1[3]), __float_as_uint(pA1[9])}; pa0 = *reinterpret_cast<bf16x8*>(&w0); pa1 = pa0; pa2 = pa0; pa3 = pa0; l_reg += pA0[1]; }
    if (VAR != 1) pv_d0(o, vb0 + b * (int)SHM_V, pa0, pa1, pa2, pa3); else o[0][0] += bf2f((bf16_t)pa0[0]) + bf2f((bf16_t)pa3[7]);
    if (VAR != 4) { if (j + 1 < NT) { SWAIT(); SWRITE(b ^ 1); } }
    __syncthreads();
  }
  if (hi == 0) li_l[r32] = l_reg; asm volatile("s_waitcnt lgkmcnt(0)" ::: "memory");
  float rli[16];
#pragma unroll
  for (int r = 0; r < 16; ++r) rli[r] = __builtin_amdgcn_rcpf(li_l[crow(r, hi)]);
  bf16_t* Ow = Ob + (long)(wid * QBLK) * LDO;
#pragma unroll
  for (int r = 0; r < 16; ++r) { const int orow = crow(r, hi);
#pragma unroll
    for (int d0 = 0; d0 < 4; ++d0) Ow[(long)orow * LDO + d0 * 32 + r32] = f2bf(o[d0][r] * rli[r]); }
#undef KSRC
#undef SLOAD
#undef SWRITE
#undef SWAIT
#undef RESC
}
#undef SBAR
}
typedef const __attribute__((address_space(4))) Args* KArgs;
struct Ctx {
    KArgs a; float* out; unsigned char* ws;
    LAS unsigned char* lds;
    int tid, lane, wave, vcu, G, gw, NGW, bid;
    __device__ __forceinline__ const float* in(int i) const { return a->in[i]; }
};
__device__ __forceinline__ Ctx mk_ctx(unsigned char* lds_raw, int wave_s) {
    Ctx c; KArgs a = (KArgs)__builtin_amdgcn_kernarg_segment_ptr(); asm volatile("" : "+s"(a));
    c.a = a; c.out = a->out; c.ws = a->ws; c.lds = (LAS unsigned char*)lds_raw;
    c.tid = opaque_tid(wave_s); c.lane = c.tid & 63; c.wave = __builtin_amdgcn_readfirstlane(c.tid >> 6);
    c.G = (int)gridDim.x; c.bid = opaque_bid(); c.vcu = (c.G % 8 == 0) ? (c.bid % 8) * (c.G / 8) + c.bid / 8 : c.bid;
    c.gw = c.vcu * NWAVES + c.wave; c.NGW = c.G * NWAVES;
    return c;
}
__device__ __forceinline__ int tok_pos(int t) { return t < TP ? (t & (SP - 1)) : ((t - TP) & (SS - 1)); }

__device__ __forceinline__ void transpose_item(const float* W, int K, int N, bf16_t* WT, LAS float* scr, int item, int lane) {
    const int nblk = N / 32, kb = item / nblk, nb = item % nblk, k0 = 64 * kb, n0 = 32 * nb;
#pragma unroll 8
    for (int i = 0; i < 32; ++i) { const int kk = 2 * i + (lane >> 5); scr[kk * 33 + (lane & 31)] = W[(size_t)(k0 + kk) * N + n0 + (lane & 31)]; }
    LDS_WAIT(); asm volatile("" ::: "memory");
    const int c = lane & 7;
#pragma unroll
    for (int j = 0; j < 4; ++j) { const int n = (lane >> 3) + 8 * j; const LAS float* s = scr + (8 * c) * 33 + n;
        u32x4 o; o.x = cvt_pk_bf16(s[0 * 33], s[1 * 33]); o.y = cvt_pk_bf16(s[2 * 33], s[3 * 33]); o.z = cvt_pk_bf16(s[4 * 33], s[5 * 33]); o.w = cvt_pk_bf16(s[6 * 33], s[7 * 33]);
        *(u32x4*)(WT + (size_t)(n0 + n) * K + k0 + 8 * c) = o; }
    LDS_WAIT(); asm volatile("" ::: "memory");
}
struct MatDesc { int in_idx, K, N, Npad, copies; size_t dst; };
__device__ __forceinline__ void p0_prologue(const Ctx& c) {
    LAS float* scr = (LAS float*)(c.lds + c.wave * 16384);
    const MatDesc MATS[9] = {
        {4, 1024, 704, 768, 2, W_WA}, {7, 384, 1536, 1536, 2, W_WUQ}, {8, 256, 2048, 2048, 2, W_WUKV}, {9, 1024, 1024, 1024, 2, W_WO},
        {10, 1024, 5120, 5120, 2, W_HIN}, {13, 1024, 1024, 1024, 2, W_HO}, {14, 1024, 2048, 2048, 4, W_PQ}, {22, 1024, 1024, 1024, 4, W_GW}, {24, 256, 1024, 1024, 4, W_PP}};
    int total = 0;
#pragma unroll
    for (int m = 0; m < 9; ++m) total += MATS[m].copies * (MATS[m].K / 64) * (MATS[m].N / 32);
    for (int it = c.gw; it < total; it += c.NGW) {
        int r = it;
#pragma unroll
        for (int m = 0; m < 9; ++m) {
            const int per = (MATS[m].K / 64) * (MATS[m].N / 32), cnt = MATS[m].copies * per;
            if (r >= 0 && r < cnt) { const int cp = r / per, item = r % per;
                transpose_item(c.in(MATS[m].in_idx) + (size_t)cp * MATS[m].K * MATS[m].N, MATS[m].K, MATS[m].N,
                               (bf16_t*)(c.ws + MATS[m].dst) + (size_t)cp * MATS[m].Npad * MATS[m].K, scr, item, c.lane);
                r = -1; }
            else if (r >= 0) r -= cnt;
        }
    }
    const int gt = c.gw * 64 + c.lane, NGT = c.NGW * 64;
    for (int i = gt; i < 2 * 64 * 1024 / 8; i += NGT) { const int cp = i / (64 * 1024 / 8), o = i % (64 * 1024 / 8);
        *(u32x4*)((bf16_t*)(c.ws + W_WA) + (size_t)cp * 768 * 1024 + (size_t)704 * 1024 + o * 8) = (u32x4){0u, 0u, 0u, 0u}; }
    for (int i = gt; i < 4 * 2 * 128 * 128 / 4; i += NGT) { const f32x4 v = *(const f32x4*)(c.in(15) + (size_t)i * 4);
        u32x2 w; w.x = cvt_pk_bf16(v[0], v[1]); w.y = cvt_pk_bf16(v[2], v[3]); *(u32x2*)((bf16_t*)(c.ws + W_KEYS) + (size_t)i * 4) = w; }
    for (int i = gt; i < 8192 * 32; i += NGT) { const int pos = i >> 5, f = i & 31;
        const float inv = 1.0f / powf(10000.0f, (float)(2 * f) / 64.0f); const float ang = (float)pos * inv;
        ((float*)(c.ws + WS_ROPE))[i] = cosf(ang); ((float*)(c.ws + WS_ROPE))[8192 * 32 + i] = sinf(ang); }
    for (int i = gt; i < 2 * 1024; i += NGT) { const int dir = i >> 10, k = i & 1023;
        const float l0 = c.in(11)[(dir * 2 + 0) * 1024 + k], l1 = c.in(11)[(dir * 2 + 1) * 1024 + k];
        float* lb = (float*)(c.ws + WS_MISC);
        lb[(0 * 2 + dir) * 1024 + k] = 0.f; lb[(1 * 2 + dir) * 1024 + k] = 1.0f / (1.0f + expf(l0 - l1)); }
    for (int t = c.gw; t < T; t += c.NGW) {
        const float* xr = t < TP ? c.in(0) + (size_t)t * D : c.in(1) + (size_t)(t - TP) * D;
        bf16_t* brow = (bf16_t*)c.out + (size_t)t * D;
#pragma unroll
        for (int j = 0; j < 4; ++j) { const f32x4 v = *(const f32x4*)(xr + 256 * j + 4 * c.lane);
            u32x2 w; w.x = cvt_pk_bf16(v[0], v[1]); w.y = cvt_pk_bf16(v[2], v[3]); *(u32x2*)(brow + 256 * j + 4 * c.lane) = w; }
    }
}

__device__ __forceinline__ void cvt_range(const float* src, bf16_t* dst, size_t n8, int gt, int NGT) {
    for (size_t i = gt; i < n8; i += NGT) { const f32x4 a = *(const f32x4*)(src + i * 8), b = *(const f32x4*)(src + i * 8 + 4);
        u32x4 w; w.x = cvt_pk_bf16(a[0], a[1]); w.y = cvt_pk_bf16(a[2], a[3]); w.z = cvt_pk_bf16(b[0], b[1]); w.w = cvt_pk_bf16(b[2], b[3]); *(u32x4*)(dst + i * 8) = w; }
}
__device__ __forceinline__ void l0_convert(const Ctx& c, int layer) {
    const int gt = c.gw * 64 + c.lane, NGT = c.NGW * 64;
    for (int r = c.gw; r < 2 * NEXP; r += c.NGW) {
        const int m = r >= NEXP, e = r - m * NEXP;
        const float* src = c.in(16 + m) + ((size_t)layer * NEXP + e) * D + 16 * c.lane;
        f32x4 v[4]; float am = 0.f;
#pragma unroll
        for (int j = 0; j < 4; ++j) { v[j] = *(const f32x4*)(src + 4 * j); am = fmaxf(am, fmaxf(fmaxf(fabsf(v[j][0]), fabsf(v[j][1])), fmaxf(fabsf(v[j][2]), fabsf(v[j][3])))); }
        am = wave_max(am);
        const float sc = fmaxf(am, 1e-30f) * (1.0f / 440.0f), inv = 1.0f / sc;
        u32x4 w;
#pragma unroll
        for (int j = 0; j < 4; ++j) { int p = 0; p = __builtin_amdgcn_cvt_pk_fp8_f32(v[j][0] * inv, v[j][1] * inv, p, false); p = __builtin_amdgcn_cvt_pk_fp8_f32(v[j][2] * inv, v[j][3] * inv, p, true); w[j] = (unsigned)p; }
        *(u32x4*)(c.ws + (m ? R2_VB : R2_UB) + (size_t)e * D + 16 * c.lane) = w;
        if (c.lane == 0) ((float*)(c.ws + (m ? R2_SV : R2_SU)))[e] = sc;
    }
    cvt_range(c.in(2) + (size_t)layer * TP * 256, (bf16_t*)(c.ws + R2_PB), (size_t)TP * 256 / 8, gt, NGT);
    cvt_range(c.in(3) + (size_t)layer * TS * 256, (bf16_t*)(c.ws + R2_PB) + (size_t)TP * 256, (size_t)TS * 256 / 8, gt, NGT);
}

__device__ __forceinline__ void mla_e1(const Ctx& c, int j) {
    const float* a32 = (const float*)(c.ws + B_A32); bf16_t* cqn = (bf16_t*)(c.ws + B_CQN); bf16_t* ckvn = (bf16_t*)(c.ws + B_CKVN); bf16_t* krope = (bf16_t*)(c.ws + B_KROPE);
    const float* qnw = c.in(5) + j * 384; const float* kvnw = c.in(6) + j * 256;
    const float* cosT = (const float*)(c.ws + WS_ROPE); const float* sinT = cosT + 8192 * 32;
    LAS float* scr = (LAS float*)(c.lds + c.wave * 1024);
    const int lane = c.lane;
    for (int t = c.gw; t < T; t += c.NGW) {
        const float* ar = a32 + (size_t)t * 768;
        const f32x4 v0 = *(const f32x4*)(ar + 4 * lane), v1 = *(const f32x4*)(ar + 256 + 4 * lane), v2 = *(const f32x4*)(ar + 512 + 4 * lane);
        const float s0 = v0[0] * v0[0] + v0[1] * v0[1] + v0[2] * v0[2] + v0[3] * v0[3];
        const float s1 = v1[0] * v1[0] + v1[1] * v1[1] + v1[2] * v1[2] + v1[3] * v1[3];
        const float s2 = v2[0] * v2[0] + v2[1] * v2[1] + v2[2] * v2[2] + v2[3] * v2[3];
        const float ssq = wave_sum(s0 + (lane < 32 ? s1 : 0.f));
        const float sskv = wave_sum((lane >= 32 ? s1 : 0.f) + (lane < 32 ? s2 : 0.f));
        const float rq = 1.0f / sqrtf(ssq * (1.0f / 384.0f) + RMS_EPS), rkv = 1.0f / sqrtf(sskv * (1.0f / 256.0f) + RMS_EPS);
        { const f32x4 w = *(const f32x4*)(qnw + 4 * lane); u32x2 o; o.x = cvt_pk_bf16(v0[0] * rq * w[0], v0[1] * rq * w[1]); o.y = cvt_pk_bf16(v0[2] * rq * w[2], v0[3] * rq * w[3]);
          *(u32x2*)(cqn + (size_t)t * 384 + 4 * lane) = o; }
        if (lane < 32) { const f32x4 w = *(const f32x4*)(qnw + 256 + 4 * lane); u32x2 o; o.x = cvt_pk_bf16(v1[0] * rq * w[0], v1[1] * rq * w[1]); o.y = cvt_pk_bf16(v1[2] * rq * w[2], v1[3] * rq * w[3]);
          *(u32x2*)(cqn + (size_t)t * 384 + 256 + 4 * lane) = o; }
        else { const int ix = 4 * (lane - 32); const f32x4 w = *(const f32x4*)(kvnw + ix); u32x2 o; o.x = cvt_pk_bf16(v1[0] * rkv * w[0], v1[1] * rkv * w[1]); o.y = cvt_pk_bf16(v1[2] * rkv * w[2], v1[3] * rkv * w[3]);
          *(u32x2*)(ckvn + (size_t)t * 256 + ix) = o; }
        if (lane < 32) { const int ix = 128 + 4 * lane; const f32x4 w = *(const f32x4*)(kvnw + ix); u32x2 o; o.x = cvt_pk_bf16(v2[0] * rkv * w[0], v2[1] * rkv * w[1]); o.y = cvt_pk_bf16(v2[2] * rkv * w[2], v2[3] * rkv * w[3]);
          *(u32x2*)(ckvn + (size_t)t * 256 + ix) = o; }
        else if (lane < 48) { *(LAS f32x4*)(scr + 4 * (lane - 32)) = v2; }
        LDS_WAIT(); asm volatile("" ::: "memory");
        if (lane < 32) { const int pos = tok_pos(t); const float a = scr[lane], b = scr[lane + 32], cs = cosT[pos * 32 + lane], sn = sinT[pos * 32 + lane];
            krope[(size_t)t * 64 + lane] = f2bf(a * cs - b * sn); krope[(size_t)t * 64 + 32 + lane] = f2bf(b * cs + a * sn); }
        LDS_WAIT(); asm volatile("" ::: "memory");
    }
}
__device__ __forceinline__ void mla_qrope(const Ctx& c) {
    bf16_t* q = (bf16_t*)(c.ws + B_Q);
    const float* cosT = (const float*)(c.ws + WS_ROPE); const float* sinT = cosT + 8192 * 32;
    const int lane = c.lane, i = lane & 31;
    for (int t = c.gw; t < T; t += c.NGW) {
        const int pos = tok_pos(t); const float cs = cosT[pos * 32 + i], sn = sinT[pos * 32 + i];
#pragma unroll
        for (int k = 0; k < 4; ++k) { const int h = (lane >> 5) + 2 * k; bf16_t* p = q + (size_t)t * 1536 + h * 192 + 128 + i;
            const float a = bf2f(p[0]), b = bf2f(p[32]); p[0] = f2bf(a * cs - b * sn); p[32] = f2bf(b * cs + a * sn); }
    }
}
template <int VAR> __device__ __forceinline__ void mla_attention(const Ctx& c) {
    const bf16_t* Q = (const bf16_t*)(c.ws + B_Q); const bf16_t* KV = (const bf16_t*)(c.ws + B_KV); const bf16_t* KR = (const bf16_t*)(c.ws + B_KROPE); bf16_t* O = VAR ? (bf16_t*)c.out + (size_t)T * 1024 : (bf16_t*)(c.ws + B_O);
    const int NU = 512 + 2048;
    for (int u = c.bid; u < NU; u += c.G) {
        int tok0, qb, h, seq;
        if (u < 512) { const int round = u >> 8, cc = u & 255, bh = round * 8 + (cc & 7); tok0 = (bh >> 3) * SP; h = bh & 7; qb = cc >> 3; seq = SP; }
        else { const int us = u - 512, round = us >> 8, cc = us & 255, r = cc >> 3, bh = round * 32 + (cc & 7) * 4 + (r >> 3); tok0 = TP + (bh >> 3) * SS; h = bh & 7; qb = r & 7; seq = SS; }
        attn::attn_body<VAR>(Q + (size_t)(tok0 + qb * 256) * 1536 + h * 192, KV + (size_t)tok0 * 2048 + h * 256, KR + (size_t)tok0 * 64,
                        O + (size_t)(tok0 + qb * 256) * 1024 + h * 128, seq, (char*)c.lds, c.tid, qb * 256, (const float*)(c.ws + WS_ROPE));
        __syncthreads();
    }
}
template <int NU, bool W8> __device__ __forceinline__ void ln_rows(f32x4 (&v)[NU][4], const float* g, const float* b, int lane, bf16_t* const (&dst)[NU], unsigned char* const (&dst8)[NU], float* const (&dsc)[NU]) {
    float s[NU], s2[NU];
#pragma unroll
    for (int u = 0; u < NU; ++u) { s[u] = 0.f;
#pragma unroll
        for (int j = 0; j < 4; ++j) s[u] += (v[u][j][0] + v[u][j][1]) + (v[u][j][2] + v[u][j][3]); }
#pragma unroll
    for (int u = 0; u < NU; ++u) s[u] = wave_sum(s[u]) * (1.0f / D);
#pragma unroll
    for (int u = 0; u < NU; ++u) { s2[u] = 0.f;
#pragma unroll
        for (int j = 0; j < 4; ++j) { v[u][j] = v[u][j] - s[u]; s2[u] += (v[u][j][0] * v[u][j][0] + v[u][j][1] * v[u][j][1]) + (v[u][j][2] * v[u][j][2] + v[u][j][3] * v[u][j][3]); } }
#pragma unroll
    for (int u = 0; u < NU; ++u) s2[u] = 1.0f / sqrtf(wave_sum(s2[u]) * (1.0f / D) + LN_EPS);
    float am[NU];
#pragma unroll
    for (int u = 0; u < NU; ++u) am[u] = 0.f;
#pragma unroll
    for (int j = 0; j < 4; ++j) { const f32x4 gg = *(const f32x4*)(g + 256 * j + 4 * lane), bb = *(const f32x4*)(b + 256 * j + 4 * lane);
#pragma unroll
        for (int u = 0; u < NU; ++u) { const f32x4 o = v[u][j] * s2[u] * gg + bb; u32x2 w; w.x = cvt_pk_bf16(o[0], o[1]); w.y = cvt_pk_bf16(o[2], o[3]); *(u32x2*)(dst[u] + 256 * j + 4 * lane) = w;
            if (W8) { v[u][j] = o; am[u] = fmaxf(am[u], fmaxf(fmaxf(fabsf(o[0]), fabsf(o[1])), fmaxf(fabsf(o[2]), fabsf(o[3])))); } } }
    if (W8) {
#pragma unroll
        for (int u = 0; u < NU; ++u) { const float mx = fmaxf(wave_max(am[u]), 1e-20f), inv = 240.0f / mx;
#pragma unroll
            for (int j = 0; j < 4; ++j) { int q = 0; q = __builtin_amdgcn_cvt_pk_fp8_f32(v[u][j][0] * inv, v[u][j][1] * inv, q, false); q = __builtin_amdgcn_cvt_pk_fp8_f32(v[u][j][2] * inv, v[u][j][3] * inv, q, true);
                *(unsigned*)(dst8[u] + 256 * j + 4 * lane) = (unsigned)q; }
            if (lane == 0) *dsc[u] = mx * (1.0f / 240.0f); }
    }
}
__device__ __forceinline__ void ln_residual(const Ctx& c, const bf16_t* hb, const float* g, const float* b) {
    const bf16_t* xm = (const bf16_t*)c.out; bf16_t* xa = (bf16_t*)(c.ws + WS_XB); const int lane = c.lane;
    constexpr int NU = 4;
    for (int t0 = c.gw * NU; t0 < T; t0 += c.NGW * NU) {
        f32x4 v[NU][4]; bf16_t* dst[NU]; unsigned char* dst8[NU]; float* dsc[NU];
#pragma unroll
        for (int u = 0; u < NU; ++u) { const bf16_t* xr = xm + (size_t)(t0 + u) * D; const bf16_t* hr = hb + (size_t)(t0 + u) * D; dst[u] = xa + (size_t)(t0 + u) * D;
            dst8[u] = c.ws + B_X8 + (size_t)(t0 + u) * D; dsc[u] = (float*)(c.ws + B_XS) + (t0 + u);
#pragma unroll
            for (int j = 0; j < 4; ++j) { const u32x2 xw = *(const u32x2*)(xr + 256 * j + 4 * lane), hw = *(const u32x2*)(hr + 256 * j + 4 * lane);
                v[u][j] = (f32x4){bflo(xw.x), bfhi(xw.x), bflo(xw.y), bfhi(xw.y)} * DN_ALPHA + (f32x4){bflo(hw.x), bfhi(hw.x), bflo(hw.y), bfhi(hw.y)}; } }
        ln_rows<NU, false>(v, g, b, lane, dst, dst8, dsc);
    }
}
__device__ __forceinline__ void hgrn_post(const Ctx& c, int j) {
    bf16_t* pl = (bf16_t*)(c.ws + B_PLANE); const size_t PE = (size_t)T * 1024;
    const bf16_t* of = pl + 1 * PE; const bf16_t* ob = pl + 2 * PE; const bf16_t* sg = pl + 4 * PE; bf16_t* on = pl;
    const float* nw = c.in(12) + j * 128; const int lane = c.lane;
    const int cw = (8 * lane) & 127; const f32x4 w0 = *(const f32x4*)(nw + cw), w1 = *(const f32x4*)(nw + cw + 4);
    constexpr int NU = 4;
    for (int t0 = c.gw * NU; t0 < T; t0 += c.NGW * NU) {
        u32x4 a[NU][2], b[NU][2], g[NU][2];
#pragma unroll
        for (int u = 0; u < NU; ++u)
#pragma unroll
            for (int k = 0; k < 2; ++k) { const size_t off = (size_t)(t0 + u) * 1024 + 512 * k + 8 * lane;
                a[u][k] = *(const u32x4*)(of + off); b[u][k] = *(const u32x4*)(ob + off); g[u][k] = *(const u32x4*)(sg + off); }
#pragma unroll
        for (int u = 0; u < NU; ++u)
#pragma unroll
            for (int k = 0; k < 2; ++k) { const size_t off = (size_t)(t0 + u) * 1024 + 512 * k + 8 * lane;
                float o[8], gg[8]; float ss = 0.f;
#pragma unroll
                for (int q = 0; q < 4; ++q) { o[2 * q] = bflo(a[u][k][q]) + bflo(b[u][k][q]); o[2 * q + 1] = bfhi(a[u][k][q]) + bfhi(b[u][k][q]); gg[2 * q] = bflo(g[u][k][q]); gg[2 * q + 1] = bfhi(g[u][k][q]); }
#pragma unroll
                for (int e = 0; e < 8; ++e) ss += o[e] * o[e];
                ss = row16_sum(ss);
                const float r = 1.0f / sqrtf(ss * (1.0f / 128.0f) + RMS_EPS);
                u32x4 w; w.x = cvt_pk_bf16(o[0] * r * w0[0] * gg[0], o[1] * r * w0[1] * gg[1]); w.y = cvt_pk_bf16(o[2] * r * w0[2] * gg[2], o[3] * r * w0[3] * gg[3]);
                w.z = cvt_pk_bf16(o[4] * r * w1[0] * gg[4], o[5] * r * w1[1] * gg[5]); w.w = cvt_pk_bf16(o[6] * r * w1[2] * gg[6], o[7] * r * w1[3] * gg[7]);
                *(u32x4*)(on + off) = w; }
    }
}
namespace scan {
constexpr size_t D_F = R2_IDX, D_B = R2_IDX + 12 * MiB;
constexpr int NCH = T / 32;
__device__ __forceinline__ void hgrn_prep(const Ctx& c, int dup) {
    bf16_t* pl = (bf16_t*)(c.ws + B_PLANE); const size_t PE = (size_t)T * 1024;
    bf16_t* qs = pl; bf16_t* lff = pl + PE; bf16_t* lfb = pl + 2 * PE; bf16_t* qtb = (bf16_t*)(c.ws + WS_XB);
    float* dF = (float*)(c.ws + D_F); float* dB = (float*)(c.ws + D_B);
    const int lane = c.lane;
#define PREP_STEP(LW, QW, QDST, KDST, R0, R1) { const unsigned lw = (LW), qw = (QW); const float l0 = bflo(lw), l1 = bfhi(lw); R0 += l0; R1 += l1; \
        const float k0 = 1.0f - fast_exp(l0), k1 = 1.0f - fast_exp(l1); \
        *(unsigned*)(QDST) = cvt_pk_bf16(bflo(qw) * fast_exp(R0), bfhi(qw) * fast_exp(R1)); \
        *(unsigned*)(KDST) = cvt_pk_bf16(k0 * fast_exp(fminf(-R0, 80.f)), k1 * fast_exp(fminf(-R1, 80.f))); }
    const char* qsB = (const char*)qs; const char* lffB = (const char*)lff; const char* lfbB = (const char*)lfb; const char* qtbB = (const char*)qtb;
    char* dmy = (char*)((bf16_t*)c.out + (size_t)T * 1024);
    char* qsW = dup ? dmy : (char*)qs; char* lffW = dup ? dmy : (char*)lff; char* lfbW = dup ? dmy : (char*)lfb; char* qtbW = dup ? dmy : (char*)qtb;
    if (dup) { dF = (float*)dmy; dB = (float*)dmy; }
    for (int it = c.gw; it < NCH * 8; it += c.NGW) {
        const int chunk = it >> 3, h = it & 7; const unsigned base = ((unsigned)chunk * 32u * 1024u + (unsigned)h * 128u + 2u * (unsigned)lane) * 2u;
        float b0 = 0.f, b1 = 0.f, f0 = 0.f, f1 = 0.f;
#define LDW(P, O) (*(const unsigned*)((P) + (O)))
#define STP(P, O) ((unsigned*)((char*)(P) + (O)))
        { unsigned wb[16], wq[16];
#pragma unroll
          for (int i = 0; i < 16; ++i) { const unsigned o = base + (unsigned)(16 + i) * 2048u; wb[i] = LDW(lfbB, o); wq[i] = LDW(qsB, o); }
#pragma unroll
          for (int i = 15; i >= 0; --i) { const unsigned o = base + (unsigned)(16 + i) * 2048u; PREP_STEP(wb[i], wq[i], STP(qtbW, o), STP(lfbW, o), b0, b1) } }
        { unsigned wb[16], wq[16], wf[16];
#pragma unroll
          for (int i = 0; i < 16; ++i) { const unsigned o = base + (unsigned)i * 2048u; wb[i] = LDW(lfbB, o); wq[i] = LDW(qsB, o); wf[i] = LDW(lffB, o); }
#pragma unroll
          for (int i = 15; i >= 0; --i) { const unsigned o = base + (unsigned)i * 2048u; PREP_STEP(wb[i], wq[i], STP(qtbW, o), STP(lfbW, o), b0, b1) }
          *(f32x2*)(dB + (size_t)chunk * 1024 + h * 128 + 2 * lane) = (f32x2){fast_exp(b0), fast_exp(b1)};
#pragma unroll
          for (int i = 0; i < 16; ++i) { const unsigned o = base + (unsigned)i * 2048u; PREP_STEP(wf[i], wq[i], STP(qsW, o), STP(lffW, o), f0, f1) } }
        { unsigned wf[16], wq[16];
#pragma unroll
          for (int i = 0; i < 16; ++i) { const unsigned o = base + (unsigned)(16 + i) * 2048u; wf[i] = LDW(lffB, o); wq[i] = LDW(qsB, o); }
#pragma unroll
          for (int i = 0; i < 16; ++i) { const unsigned o = base + (unsigned)(16 + i) * 2048u; PREP_STEP(wf[i], wq[i], STP(qsW, o), STP(lffW, o), f0, f1) }
          *(f32x2*)(dF + (size_t)chunk * 1024 + h * 128 + 2 * lane) = (f32x2){fast_exp(f0), fast_exp(f1)}; }
    }
#undef LDW
#undef STP
#undef PREP_STEP
}

constexpr int QT_OFF = 0, KT_OFF = 8192, V_OFF = 16384, P_OFF = 24576, ST_OFF = 34816, DV_OFF = 69632, CHAIN_BYTES = 70144;
constexpr int RS = 272, RS2 = 80;
__device__ __forceinline__ int crow(int r, int hi) { return (r & 3) + 8 * (r >> 2) + 4 * hi; }
__device__ __forceinline__ unsigned off_b(unsigned row, unsigned ch) { return 256u * row + 16u * (ch ^ (((row & 3) << 2) | ((row >> 2) & 3))); }
__device__ __forceinline__ unsigned row_read_addr(unsigned lane, unsigned s) { return off_b(lane & 31, 2 * s + (lane >> 5)); }
__device__ __forceinline__ unsigned tr_read_addr(unsigned lane, unsigned cc, unsigned ks, unsigned t) {
    const unsigned h = lane >> 5, blk = (lane >> 4) & 1, q = (lane & 15) >> 2, p = lane & 3;
    return off_b(16 * ks + 8 * h + 4 * t + q, 4 * cc + 2 * blk + (p >> 1)) + 8 * (p & 1);
}
__device__ __forceinline__ s16x4 tr_rd(unsigned addr) { s16x4 r; asm volatile("ds_read_b64_tr_b16 %0, %1" : "=&v"(r) : "v"(addr) : "memory"); return r; }
#define TRPK(L, H) (bf16x8){L[0], L[1], L[2], L[3], H[0], H[1], H[2], H[3]}

__device__ __forceinline__ void run_pair(const Ctx& c, int tok0, int L, int h, int dirsel, bool dummy) {
    bf16_t* pl = (bf16_t*)(c.ws + B_PLANE); const size_t PE = (size_t)T * 1024;
    const int tid = c.tid, lane = c.lane, wave = c.wave, ch = dirsel < 0 ? (wave >> 2) : dirsel, w = wave & 3, r32 = lane & 31, hi = lane >> 5;
    const bool active = dirsel < 0 || wave < 4;
    const int NCs = L / 32;
    if (!active) { __syncthreads(); for (int ci = 0; ci < NCs; ++ci) { __syncthreads(); __syncthreads(); } return; }
    const bf16_t* qt = ch ? (const bf16_t*)(c.ws + WS_XB) : pl; bf16_t* kt = pl + (size_t)(1 + ch) * PE; const bf16_t* vv = pl + 3 * PE;
    const float* dd = (const float*)(c.ws + (ch ? D_B : D_F));
    bf16_t* odst = dummy ? (bf16_t*)c.out + (size_t)T * 1024 : kt;
    LAS unsigned char* base = c.lds + (wave >> 2) * CHAIN_BYTES;
    const unsigned lbase = (unsigned)(uintptr_t)base;
    const int ctid = tid & 255;
    const int NC = L / 32;
    const int vcol = 32 * w + r32;
    LAS unsigned char* Pw = base + P_OFF + w * 2560;
    const int s_r0 = ctid >> 4, s_chn = ctid & 15;
    u32x4 sreg[6]; f32x4 dreg = (f32x4){0.f, 0.f, 0.f, 0.f};
#define SCAN_LOAD(cidx) do { const size_t rowb = (size_t)(tok0 + 32 * (cidx)) * 1024 + h * 128; \
        _Pragma("unroll") for (int i = 0; i < 6; ++i) { const bf16_t* src = ((i >> 1) == 0 ? qt : ((i >> 1) == 1 ? (const bf16_t*)kt : vv)) + rowb + (size_t)(s_r0 + 16 * (i & 1)) * 1024 + s_chn * 8; sreg[i] = *(const u32x4*)src; } \
        if (ctid < 32) dreg = *(const f32x4*)(dd + (size_t)((tok0 >> 5) + (cidx)) * 1024 + h * 128 + 4 * ctid); } while (0)
#define SCAN_WRITE() do { _Pragma("unroll") for (int i = 0; i < 6; ++i) *(LAS u32x4*)(base + (i >> 1) * 8192 + off_b(s_r0 + 16 * (i & 1), s_chn)) = sreg[i]; \
        if (ctid < 32) *(LAS f32x4*)(base + DV_OFF + 16 * ctid) = dreg; } while (0)
    { LAS u32x4* st = (LAS u32x4*)(base + ST_OFF + (32 * w) * RS); for (int i = lane; i < 32 * RS / 16; i += 64) st[i] = (u32x4){0u, 0u, 0u, 0u}; }
    f32x16 S[4];
#pragma unroll
    for (int kt2 = 0; kt2 < 4; ++kt2) S[kt2] = f32x16{};
    SCAN_LOAD(ch ? NC - 1 : 0); SCAN_WRITE();
    __syncthreads();
    for (int ci = 0; ci < NC; ++ci) {
        const int cidx = ch ? NC - 1 - ci : ci;
        if (ci + 1 < NC) SCAN_LOAD(ch ? cidx - 1 : cidx + 1);
        f32x16 X = f32x16{};
#pragma unroll
        for (int ks = 0; ks < 8; ++ks) { const bf16x8 qa = *(const LAS bf16x8*)(base + QT_OFF + row_read_addr(lane, ks));
            const bf16x8 kb = *(const LAS bf16x8*)(base + KT_OFF + row_read_addr(lane, ks));
            X = __builtin_amdgcn_mfma_f32_32x32x16_bf16(qa, kb, X, 0, 0, 0); }
#pragma unroll
        for (int r = 0; r < 16; ++r) { const int t = crow(r, hi); const bool keep = ch ? (t <= r32) : (t >= r32); *(LAS bf16_t*)(Pw + t * RS2 + r32 * 2) = f2bf(keep ? X[r] : 0.f); }
        s16x4 vl[2], vh[2];
#pragma unroll
        for (int ks = 0; ks < 2; ++ks) { vl[ks] = tr_rd(lbase + V_OFF + tr_read_addr(lane, w, ks, 0)); vh[ks] = tr_rd(lbase + V_OFF + tr_read_addr(lane, w, ks, 1)); }
        asm volatile("s_waitcnt lgkmcnt(0)" ::: "memory"); __builtin_amdgcn_sched_barrier(0);
        bf16x8 vb[2];
#pragma unroll
        for (int ks = 0; ks < 2; ++ks) vb[ks] = TRPK(vl[ks], vh[ks]);
        f32x16 O = f32x16{};
#pragma unroll
        for (int ks = 0; ks < 2; ++ks) { const bf16x8 pa = *(const LAS bf16x8*)(Pw + r32 * RS2 + (16 * ks + 8 * hi) * 2);
            O = __builtin_amdgcn_mfma_f32_32x32x16_bf16(pa, vb[ks], O, 0, 0, 0); }
#pragma unroll
        for (int ks = 0; ks < 8; ++ks) { const bf16x8 sb = *(const LAS bf16x8*)(base + ST_OFF + vcol * RS + (16 * ks + 8 * hi) * 2);
            const bf16x8 qa = *(const LAS bf16x8*)(base + QT_OFF + row_read_addr(lane, ks));
            O = __builtin_amdgcn_mfma_f32_32x32x16_bf16(qa, sb, O, 0, 0, 0); }
#pragma unroll
        for (int r = 0; r < 16; ++r) { const int t = tok0 + 32 * cidx + crow(r, hi); odst[(size_t)t * 1024 + h * 128 + vcol] = f2bf(O[r]); }
#pragma unroll
        for (int kt2 = 0; kt2 < 4; ++kt2) {
            s16x4 al[2], ah[2];
#pragma unroll
            for (int ks = 0; ks < 2; ++ks) { al[ks] = tr_rd(lbase + KT_OFF + tr_read_addr(lane, kt2, ks, 0)); ah[ks] = tr_rd(lbase + KT_OFF + tr_read_addr(lane, kt2, ks, 1)); }
            asm volatile("s_waitcnt lgkmcnt(0)" ::: "memory"); __builtin_amdgcn_sched_barrier(0);
#pragma unroll
            for (int ks = 0; ks < 2; ++ks) S[kt2] = __builtin_amdgcn_mfma_f32_32x32x16_bf16(TRPK(al[ks], ah[ks]), vb[ks], S[kt2], 0, 0, 0);
#pragma unroll
            for (int g = 0; g < 4; ++g) { const f32x4 d4 = *(const LAS f32x4*)(base + DV_OFF + (32 * kt2 + 8 * g + 4 * hi) * 4);
#pragma unroll
                for (int e = 0; e < 4; ++e) S[kt2][4 * g + e] *= d4[e];
                u32x2 pk; pk.x = cvt_pk_bf16(S[kt2][4 * g], S[kt2][4 * g + 1]); pk.y = cvt_pk_bf16(S[kt2][4 * g + 2], S[kt2][4 * g + 3]);
                *(LAS u32x2*)(base + ST_OFF + vcol * RS + (32 * kt2 + 8 * g + 4 * hi) * 2) = pk; }
        }
        __syncthreads();
        if (ci + 1 < NC) SCAN_WRITE();
        __syncthreads();
    }
#undef SCAN_LOAD
#undef SCAN_WRITE
}
#undef TRPK
__device__ __forceinline__ void hgrn_scan(const Ctx& c, bool dummy) {
    const int NI = 32 + 256;
    for (int rnd = 0;; ++rnd) {
        if (rnd * c.G >= NI) break;
        const int it = (rnd & 1) ? (rnd * c.G + (c.G - 1 - c.bid)) : (rnd * c.G + c.bid);
        if (it < NI) {
            const bool pr = it < 32;
            run_pair(c, pr ? (it >> 4) * SP : TP + ((it - 32) >> 3) * SS, pr ? SP : SS, pr ? ((it >> 1) & 7) : ((it - 32) & 7), pr ? (it & 1) : -1, dummy);
        }
    }
}
}
#define CE_(a, i, j) { const unsigned _x = a[i] > a[j] ? a[i] : a[j], _y = a[i] > a[j] ? a[j] : a[i]; a[i] = _x; a[j] = _y; }
__device__ __forceinline__ void sort16_desc(unsigned (&a)[16]) {
    CE_(a, 0, 1) CE_(a, 2, 3) CE_(a, 0, 2) CE_(a, 1, 3) CE_(a, 1, 2) CE_(a, 4, 5) CE_(a, 6, 7) CE_(a, 4, 6) CE_(a, 5, 7) CE_(a, 5, 6) CE_(a, 0, 4) CE_(a, 2, 6) CE_(a, 2, 4) CE_(a, 1, 5) CE_(a, 3, 7) CE_(a, 3, 5) CE_(a, 1, 2) CE_(a, 3, 4) CE_(a, 5, 6) CE_(a, 8, 9) CE_(a, 10, 11) CE_(a, 8, 10) CE_(a, 9, 11) CE_(a, 9, 10) CE_(a, 12, 13) CE_(a, 14, 15) CE_(a, 12, 14) CE_(a, 13, 15) CE_(a, 13, 14) CE_(a, 8, 12) CE_(a, 10, 14) CE_(a, 10, 12) CE_(a, 9, 13) CE_(a, 11, 15) CE_(a, 11, 13) CE_(a, 9, 10) CE_(a, 11, 12) CE_(a, 13, 14) CE_(a, 0, 8) CE_(a, 4, 12) CE_(a, 4, 8) CE_(a, 2, 10) CE_(a, 6, 14) CE_(a, 6, 10) CE_(a, 2, 4) CE_(a, 6, 8) CE_(a, 10, 12) CE_(a, 1, 9) CE_(a, 5, 13) CE_(a, 5, 9) CE_(a, 3, 11) CE_(a, 7, 15) CE_(a, 7, 11) CE_(a, 3, 5) CE_(a, 7, 9) CE_(a, 11, 13) CE_(a, 1, 2) CE_(a, 3, 4) CE_(a, 5, 6) CE_(a, 7, 8) CE_(a, 9, 10) CE_(a, 11, 12) CE_(a, 13, 14)
}
__device__ __forceinline__ void merge16_top(unsigned (&a)[16], const unsigned (&b)[16]) {
    a[0] = a[0] > b[15] ? a[0] : b[15]; a[1] = a[1] > b[14] ? a[1] : b[14]; a[2] = a[2] > b[13] ? a[2] : b[13]; a[3] = a[3] > b[12] ? a[3] : b[12]; a[4] = a[4] > b[11] ? a[4] : b[11]; a[5] = a[5] > b[10] ? a[5] : b[10]; a[6] = a[6] > b[9] ? a[6] : b[9]; a[7] = a[7] > b[8] ? a[7] : b[8]; a[8] = a[8] > b[7] ? a[8] : b[7]; a[9] = a[9] > b[6] ? a[9] : b[6]; a[10] = a[10] > b[5] ? a[10] : b[5]; a[11] = a[11] > b[4] ? a[11] : b[4]; a[12] = a[12] > b[3] ? a[12] : b[3]; a[13] = a[13] > b[2] ? a[13] : b[2]; a[14] = a[14] > b[1] ? a[14] : b[1]; a[15] = a[15] > b[0] ? a[15] : b[0];
    CE_(a, 0, 8) CE_(a, 1, 9) CE_(a, 2, 10) CE_(a, 3, 11) CE_(a, 4, 12) CE_(a, 5, 13) CE_(a, 6, 14) CE_(a, 7, 15) CE_(a, 0, 4) CE_(a, 1, 5) CE_(a, 2, 6) CE_(a, 3, 7) CE_(a, 8, 12) CE_(a, 9, 13) CE_(a, 10, 14) CE_(a, 11, 15) CE_(a, 0, 2) CE_(a, 1, 3) CE_(a, 4, 6) CE_(a, 5, 7) CE_(a, 8, 10) CE_(a, 9, 11) CE_(a, 12, 14) CE_(a, 13, 15) CE_(a, 0, 1) CE_(a, 2, 3) CE_(a, 4, 5) CE_(a, 6, 7) CE_(a, 8, 9) CE_(a, 10, 11) CE_(a, 12, 13) CE_(a, 14, 15)
}
namespace peer {
constexpr int KEY_RS = 272;
constexpr int KEYS_BYTES = 2 * 128 * KEY_RS;
constexpr int SI_OFF = KEYS_BYTES;
__device__ __forceinline__ int crow(int r, int hi) { return (r & 3) + 8 * (r >> 2) + 4 * hi; }
__device__ __forceinline__ unsigned sortable(float f) { const unsigned u = __float_as_uint(f); return u ^ ((u >> 31) ? 0xFFFFFFFFu : 0x80000000u); }
__device__ __forceinline__ float unsortable(unsigned s) { const unsigned u = (s >> 31) ? (s ^ 0x80000000u) : ~s; return __uint_as_float(u); }
__device__ __forceinline__ unsigned pair_max(unsigned m) { auto rr = __builtin_amdgcn_permlane32_swap(m, m, false, false); return rr[0] > rr[1] ? rr[0] : rr[1]; }

__device__ __forceinline__ void top16_half(const Ctx& c, const bf16_t* pq_rows, int half, LAS unsigned char* keys, unsigned (&sel)[16]) {
    const int lane = c.lane, r32 = lane & 31, hi = lane >> 5;
    f32x16 acc[4];
#pragma unroll
    for (int nt = 0; nt < 4; ++nt) acc[nt] = f32x16{};
    const bf16_t* qrow = pq_rows + (size_t)r32 * 256 + half * 128;
    bf16x8 qb[8];
#pragma unroll
    for (int ks = 0; ks < 8; ++ks) qb[ks] = *reinterpret_cast<const bf16x8*>(qrow + 16 * ks + 8 * hi);
#pragma unroll
    for (int ks = 0; ks < 8; ++ks) {
#pragma unroll
        for (int nt = 0; nt < 4; ++nt) { const bf16x8 ka = *(const LAS bf16x8*)(keys + (half * 128 + 32 * nt + r32) * KEY_RS + (16 * ks + 8 * hi) * 2);
            acc[nt] = __builtin_amdgcn_mfma_f32_32x32x16_bf16(ka, qb[ks], acc[nt], 0, 0, 0); }
        if (ks & 1) __builtin_amdgcn_sched_barrier(0); }
    unsigned p[64];
#pragma unroll
    for (int nt = 0; nt < 4; ++nt)
#pragma unroll
        for (int r = 0; r < 16; ++r) { const int n = 32 * nt + crow(r, hi); p[nt * 16 + r] = (sortable(acc[nt][r]) & ~127u) | (unsigned)(127 - n); }
    unsigned g0[16], g1[16], g2[16], g3[16];
#pragma unroll
    for (int i = 0; i < 16; ++i) { g0[i] = p[i]; g1[i] = p[16 + i]; g2[i] = p[32 + i]; g3[i] = p[48 + i]; }
    sort16_desc(g0); sort16_desc(g1); sort16_desc(g2); sort16_desc(g3);
    merge16_top(g0, g1); merge16_top(g2, g3); merge16_top(g0, g2);
    unsigned pb[16];
#pragma unroll
    for (int i = 0; i < 16; ++i) { auto rr = __builtin_amdgcn_permlane32_swap(g0[i], g0[i], false, false); sel[i] = rr[0]; pb[i] = rr[1]; }
    merge16_top(sel, pb);
}
__device__ __forceinline__ void route(const Ctx& c, int layer) {
    const bf16_t* pq = (const bf16_t*)(c.ws + B_PQ); unsigned short* idx_out = (unsigned short*)(c.ws + R2_IDX); float* gate_out = (float*)(c.ws + R2_GATE);
    const bf16_t* keys_g = (const bf16_t*)(c.ws + W_KEYS) + (size_t)layer * 2 * 128 * 128;
    LAS unsigned char* keys = c.lds;
    const int lane = c.lane, r32 = lane & 31, hi = lane >> 5;
    for (int i = c.tid; i < 2 * 128 * 16; i += NTHR) { const int row = i >> 4, ch = i & 15; *(LAS u32x4*)(keys + row * KEY_RS + ch * 16) = *(const u32x4*)(keys_g + (size_t)row * 128 + ch * 8); }
    __syncthreads();
    LAS int* si = (LAS int*)(c.lds + SI_OFF + c.wave * 4096) + r32 * 32;
    for (int grp = c.gw; grp < T / 4; grp += c.NGW) {
        const bf16_t* rows = pq + (size_t)grp * 4 * 2048;
        unsigned s1[16], s2[16];
        top16_half(c, rows, 0, keys, s1);
        top16_half(c, rows, 1, keys, s2);
        float v1[16], v2[16];
#pragma unroll
        for (int i = 0; i < 16; ++i) { v1[i] = unsortable(s1[i] & ~127u); v2[i] = unsortable(s2[i] & ~127u); }
        if (hi == 0) {
#pragma unroll
            for (int i = 0; i < 16; ++i) { si[i] = 127 - (int)(s1[i] & 127u); si[16 + i] = 127 - (int)(s2[i] & 127u); }
        }
        float A[16], B[16];
#pragma unroll
        for (int i = 0; i < 16; ++i) { A[i] = hi ? v2[i] : v1[i]; B[i] = hi ? v1[i] : v2[i]; }
        unsigned cd[27]; int nc = 0;
#pragma unroll
        for (int i = 0; i < 16; ++i)
#pragma unroll
            for (int j = i; j < 16; ++j) if ((i + 1) * (j + 1) <= 16) {
                const unsigned flat = hi ? (unsigned)(j * 16 + i) : (unsigned)(i * 16 + j);
                unsigned pk = (sortable(A[i] + B[j]) & ~255u) | (255u - flat);
                if (i == j) pk = hi ? 0u : pk;
                cd[nc++] = pk; }
        unsigned sel[16], c1[16], pb[16];
#pragma unroll
        for (int i = 0; i < 16; ++i) { sel[i] = cd[i]; c1[i] = (16 + i < 27) ? cd[(16 + i < 27) ? 16 + i : 0] : 0u; }
        sort16_desc(sel); sort16_desc(c1); merge16_top(sel, c1);
#pragma unroll
        for (int i = 0; i < 16; ++i) { auto rr = __builtin_amdgcn_permlane32_swap(sel[i], sel[i], false, false); sel[i] = rr[0]; pb[i] = rr[1]; }
        merge16_top(sel, pb);
        LDS_WAIT(); asm volatile("" ::: "memory");
        const float vmax = unsortable(sel[0] & ~255u);
        float e[16], es = 0.f;
#pragma unroll
        for (int i = 0; i < 16; ++i) { e[i] = fast_exp(unsortable(sel[i] & ~255u) - vmax); es += e[i]; }
        const float inv = 1.0f / es;
        const size_t obase = ((size_t)grp * 4 + (r32 >> 3)) * 128 + (r32 & 7) * 16 + 8 * hi;
        int oi[8]; float og[8];
#pragma unroll
        for (int q = 0; q < 8; ++q) { const unsigned sv = hi ? sel[8 + q] : sel[q]; const float ev = hi ? e[8 + q] : e[q];
            const int flat = 255 - (int)(sv & 255u); oi[q] = si[flat >> 4] * 128 + si[16 + (flat & 15)]; og[q] = ev * inv; }
        *(u32x4*)(idx_out + obase) = (u32x4){(unsigned)oi[0] | ((unsigned)oi[1] << 16), (unsigned)oi[2] | ((unsigned)oi[3] << 16), (unsigned)oi[4] | ((unsigned)oi[5] << 16), (unsigned)oi[6] | ((unsigned)oi[7] << 16)};
        *(f32x4*)(gate_out + obase) = (f32x4){og[0], og[1], og[2], og[3]};
        *(f32x4*)(gate_out + obase + 4) = (f32x4){og[4], og[5], og[6], og[7]};
        LDS_WAIT(); asm volatile("" ::: "memory");
    }
    __syncthreads();
}

__device__ __forceinline__ float gelu_exact(float x) { return 0.5f * x * (1.0f + erff(x * 0.70710678118654752f)); }
template <int IDXMASK> __device__ __forceinline__ void gather_ln(const Ctx& c, int layer, float* xout, bf16_t* xb) {
    const unsigned char* U8 = c.ws + R2_UB; const unsigned char* V8 = c.ws + R2_VB;
    const float* su = (const float*)(c.ws + R2_SU); const float* sv = (const float*)(c.ws + R2_SV);
    const int* idx = (const int*)(c.ws + R2_IDX); const float* gate = (const float*)(c.ws + R2_GATE);
    const float* lg = c.in(20) + layer * D; const float* lbv = c.in(21) + layer * D;
    const int lane = c.lane;
    for (int t = c.gw; t < T; t += c.NGW) {
        const float* xr = c.out + (size_t)t * D + 16 * lane; float* xw = xout + (size_t)t * D + 16 * lane;
        float x[16], acc[16];
#pragma unroll
        for (int j = 0; j < 4; ++j) { const f32x4 a = *(const f32x4*)(xr + 4 * j); x[4 * j] = a[0]; x[4 * j + 1] = a[1]; x[4 * j + 2] = a[2]; x[4 * j + 3] = a[3]; }
#pragma unroll
        for (int e = 0; e < 16; ++e) acc[e] = 0.f;
        const int myidx0 = idx[(size_t)t * 128 + lane] & IDXMASK, myidx1 = idx[(size_t)t * 128 + 64 + lane] & IDXMASK;
        const float myg0 = gate[(size_t)t * 128 + lane], myg1 = gate[(size_t)t * 128 + 64 + lane];
        for (int eb = 0; eb < 128; eb += 8) {
            float part[8]; int ei[8];
#pragma unroll
            for (int q = 0; q < 8; ++q) { const int e = eb + q; ei[q] = __builtin_amdgcn_readlane(e < 64 ? myidx0 : myidx1, e & 63); }
            u32x4 vr[8];
#pragma unroll
            for (int q = 0; q < 8; ++q) vr[q] = *(const u32x4*)(V8 + (size_t)ei[q] * D + 16 * lane);
#pragma unroll
            for (int q = 0; q < 8; ++q) { const u32x4 a = *(const u32x4*)(U8 + (size_t)ei[q] * D + 16 * lane);
                float s = 0.f;
#pragma unroll
                for (int j = 0; j < 4; ++j) { const f32x2 lo = __builtin_amdgcn_cvt_pk_f32_fp8((int)a[j], false), hi = __builtin_amdgcn_cvt_pk_f32_fp8((int)a[j], true);
                    s = fmaf(lo[0], x[4 * j], s); s = fmaf(lo[1], x[4 * j + 1], s); s = fmaf(hi[0], x[4 * j + 2], s); s = fmaf(hi[1], x[4 * j + 3], s); }
                part[q] = s; }
            float r4[4], r2[2], r1;
            { const bool up = (lane & 32) != 0;
#pragma unroll
              for (int i = 0; i < 4; ++i) { const float send = up ? part[i] : part[4 + i]; const float keep = up ? part[4 + i] : part[i]; r4[i] = keep + __shfl_xor(send, 32); } }
            { const bool up = (lane & 16) != 0;
#pragma unroll
              for (int i = 0; i < 2; ++i) { const float send = up ? r4[i] : r4[2 + i]; const float keep = up ? r4[2 + i] : r4[i]; r2[i] = keep + __shfl_xor(send, 16); } }
            { const bool up = (lane & 8) != 0; const float send = up ? r2[0] : r2[1]; const float keep = up ? r2[1] : r2[0]; r1 = keep + __shfl_xor(send, 8); }
            r1 += __shfl_xor(r1, 4); r1 += __shfl_xor(r1, 2); r1 += __shfl_xor(r1, 1);
            const int myq = ((lane >> 5) & 1) * 4 + ((lane >> 4) & 1) * 2 + ((lane >> 3) & 1);
            const int me = eb + myq;
            const float g = __shfl(me < 64 ? myg0 : myg1, me & 63);
            const int mye = __shfl(me < 64 ? myidx0 : myidx1, me & 63);
            const float cf = g * gelu_exact(r1 * su[mye]) * sv[mye];
            float cq[8];
#pragma unroll
            for (int q = 0; q < 8; ++q) cq[q] = __int_as_float(__builtin_amdgcn_readlane(__float_as_int(cf), ((q >> 2) & 1) * 32 + ((q >> 1) & 1) * 16 + (q & 1) * 8));
#pragma unroll
            for (int q = 0; q < 8; ++q) { const float s = cq[q];
#pragma unroll
                for (int j = 0; j < 4; ++j) { const f32x2 lo = __builtin_amdgcn_cvt_pk_f32_fp8((int)vr[q][j], false), hi = __builtin_amdgcn_cvt_pk_f32_fp8((int)vr[q][j], true);
                    acc[4 * j] = fmaf(s, lo[0], acc[4 * j]); acc[4 * j + 1] = fmaf(s, lo[1], acc[4 * j + 1]); acc[4 * j + 2] = fmaf(s, hi[0], acc[4 * j + 2]); acc[4 * j + 3] = fmaf(s, hi[1], acc[4 * j + 3]); } }
        }
        float s = 0.f;
#pragma unroll
        for (int e = 0; e < 16; ++e) { acc[e] = fmaf(DN_ALPHA, x[e], acc[e]); s += acc[e]; }
        const float mean = wave_sum(s) * (1.0f / D); float s2 = 0.f;
#pragma unroll
        for (int e = 0; e < 16; ++e) { acc[e] -= mean; s2 += acc[e] * acc[e]; }
        const float rstd = 1.0f / sqrtf(wave_sum(s2) * (1.0f / D) + LN_EPS);
        float o[16];
#pragma unroll
        for (int j = 0; j < 4; ++j) { const f32x4 g4 = *(const f32x4*)(lg + 16 * lane + 4 * j), b4 = *(const f32x4*)(lbv + 16 * lane + 4 * j);
#pragma unroll
            for (int e = 0; e < 4; ++e) o[4 * j + e] = acc[4 * j + e] * rstd * g4[e] + b4[e];
            *(f32x4*)(xw + 4 * j) = (f32x4){o[4 * j], o[4 * j + 1], o[4 * j + 2], o[4 * j + 3]}; }
        u32x4 w0, w1; w0.x = cvt_pk_bf16(o[0], o[1]); w0.y = cvt_pk_bf16(o[2], o[3]); w0.z = cvt_pk_bf16(o[4], o[5]); w0.w = cvt_pk_bf16(o[6], o[7]);
        w1.x = cvt_pk_bf16(o[8], o[9]); w1.y = cvt_pk_bf16(o[10], o[11]); w1.z = cvt_pk_bf16(o[12], o[13]); w1.w = cvt_pk_bf16(o[14], o[15]);
        *(u32x4*)(xb + (size_t)t * D + 16 * lane) = w0; *(u32x4*)(xb + (size_t)t * D + 16 * lane + 8) = w1;
    }
}
}
namespace peer {
constexpr size_t HP_OFF = WS_BIG;
constexpr size_t COEF_OFF = WS_R2 + 36 * MiB;
constexpr int QW_BASE = 4096;
constexpr int ITEM_TOK = 128, NBLK = T / ITEM_TOK;
constexpr int GT = 1;
#define DPP_F(v, ctrl) __int_as_float(__builtin_amdgcn_update_dpp(0, __float_as_int(v), (ctrl), 0xf, 0xf, true))

template <class F> __device__ __forceinline__ void for_items(const Ctx& c, int layer, int phase, F body) {
    unsigned* qw = (unsigned*)(c.ws + WS_CTL) + QW_BASE + (size_t)((layer * 4 + phase) * 8) * 16;
    volatile LAS int* slot = (volatile LAS int*)(c.lds + LDS_MISC_OFF + 128);
    const int home = (int)(xb_xcc_id() & 7u);
    for (int k = 0; k < 8; ++k) {
        const int s = (home + k) & 7;
        if (c.tid == 0) slot[0] = (int)__hip_atomic_fetch_add(qw + s * 16, 1u, __ATOMIC_RELAXED, __HIP_MEMORY_SCOPE_AGENT);
        __syncthreads();
        int cur = slot[0];
        __syncthreads();
        while (cur < NBLK) {
            if (c.tid == 0) slot[0] = (int)__hip_atomic_fetch_add(qw + s * 16, 1u, __ATOMIC_RELAXED, __HIP_MEMORY_SCOPE_AGENT);
            body(s, cur);
            __syncthreads();
            cur = slot[0];
            __syncthreads();
        }
    }
}

__device__ __forceinline__ void g1_udot(const Ctx& c, int layer, int dup) {
    const unsigned char* U8 = c.ws + R2_UB; const unsigned short* idx = (const unsigned short*)(c.ws + R2_IDX); bf16_t* hp = (bf16_t*)(c.ws + HP_OFF);
    for_items(c, layer, 0 + 2 * dup, [&](int s, int blk) {
        int lane = c.lane; asm volatile("" : "+v"(lane));
        const int g = lane >> 3, c8 = lane & 7;
        const int co = 128 * s + 16 * c8;
#pragma unroll 1
        for (int i = 0; i < ITEM_TOK / NWAVES; i += GT) {
            const int t0 = blk * ITEM_TOK + c.wave * (ITEM_TOK / NWAVES) + i;
            float x[GT][16]; int id[GT][16];
#pragma unroll
            for (int u = 0; u < GT; ++u)
#pragma unroll
            for (int j = 0; j < 4; ++j) { const u32x2 a = *(const u32x2*)((const bf16_t*)(c.ws + WS_XB) + (size_t)(t0 + u) * D + co + 4 * j); x[u][4 * j] = bflo(a.x); x[u][4 * j + 1] = bfhi(a.x); x[u][4 * j + 2] = bflo(a.y); x[u][4 * j + 3] = bfhi(a.y);
                if (j < 2) { const u32x4 q = *(const u32x4*)(idx + (size_t)(t0 + u) * 128 + 16 * g + 8 * j);
#pragma unroll
                    for (int e = 0; e < 4; ++e) { id[u][8 * j + 2 * e] = (int)(q[e] & 0xffffu); id[u][8 * j + 2 * e + 1] = (int)(q[e] >> 16); } } }
            u32x4 row[GT][16];
#pragma unroll
            for (int u = 0; u < GT; ++u)
#pragma unroll
            for (int j = 0; j < 16; ++j) row[u][j] = *(const u32x4*)(U8 + (size_t)id[u][j] * D + co);
#pragma unroll
            for (int u = 0; u < GT; ++u) {
            float V[16];
#pragma unroll
            for (int j = 0; j < 16; ++j) { f32x2 acc2 = (f32x2){0.f, 0.f};
                if (dup) { V[j] = __uint_as_float((row[u][j][0] ^ row[u][j][1] ^ row[u][j][2] ^ row[u][j][3]) & 0x3fffffffu); continue; }
#pragma unroll
                for (int q = 0; q < 4; ++q) { const f32x2 lo = __builtin_amdgcn_cvt_pk_f32_fp8((int)row[u][j][q], false), hi = __builtin_amdgcn_cvt_pk_f32_fp8((int)row[u][j][q], true);
                    acc2 = __builtin_elementwise_fma(lo, (f32x2){x[u][4 * q], x[u][4 * q + 1]}, acc2); acc2 = __builtin_elementwise_fma(hi, (f32x2){x[u][4 * q + 2], x[u][4 * q + 3]}, acc2); }
                V[j] = acc2[0] + acc2[1]; }
            float W[8], Y[4], Z[2];
            { const bool hiA = (lane & 4) != 0;
#pragma unroll
              for (int m = 0; m < 8; ++m) { const float send = hiA ? V[m] : V[8 + m], keep = hiA ? V[8 + m] : V[m]; W[m] = keep + DPP_F(send, 0x141); } }
            { const bool hiB = (lane & 2) != 0;
#pragma unroll
              for (int m = 0; m < 4; ++m) { const float send = hiB ? W[m] : W[4 + m], keep = hiB ? W[4 + m] : W[m]; Y[m] = keep + DPP_F(send, 0x1B); } }
            { const bool hiC = (lane & 1) != 0;
#pragma unroll
              for (int m = 0; m < 2; ++m) { const float send = hiC ? Y[m] : Y[2 + m], keep = hiC ? Y[2 + m] : Y[m]; Z[m] = keep + DPP_F(send, 0xB1); } }
            *(unsigned*)((dup ? hp + (size_t)320 * MiB : hp) + ((size_t)(dup ? 0 : s) * T + t0 + u) * 128 + 16 * g + 2 * c8) = cvt_pk_bf16(Z[0], Z[1]);
            }
        }
    });
}
__device__ __forceinline__ void g2_coef(const Ctx& c, int dup) {
    const unsigned short* idx = (const unsigned short*)(c.ws + R2_IDX); const float* gate = (const float*)(c.ws + R2_GATE); const bf16_t* hp = (const bf16_t*)(c.ws + HP_OFF);
    const float* su = (const float*)(c.ws + R2_SU); const float* sv = (const float*)(c.ws + R2_SV);
    bf16_t* dstb = dup ? (bf16_t*)(c.ws + HP_OFF) + (size_t)340 * MiB : (bf16_t*)(c.ws + COEF_OFF);
    const int lane = c.lane;
    constexpr int NU = 4;
    for (int t0 = c.gw * NU; t0 < T; t0 += c.NGW * NU) {
        float h[NU][2]; unsigned ew[NU]; f32x2 gt[NU];
#pragma unroll
        for (int u = 0; u < NU; ++u) { const size_t o = (size_t)(t0 + u) * 128 + 2 * lane; ew[u] = *(const unsigned*)(idx + o); gt[u] = *(const f32x2*)(gate + o); float a0 = 0.f, a1 = 0.f;
#pragma unroll
            for (int s = 0; s < 8; ++s) { const unsigned w = *(const unsigned*)(hp + (size_t)s * T * 128 + o); a0 += bflo(w); a1 += bfhi(w); }
            h[u][0] = a0; h[u][1] = a1; }
        float s1[NU][2], s2[NU][2];
#pragma unroll
        for (int u = 0; u < NU; ++u) { const int e0 = (int)(ew[u] & 0xffffu), e1 = (int)(ew[u] >> 16); s1[u][0] = su[e0]; s1[u][1] = su[e1]; s2[u][0] = sv[e0]; s2[u][1] = sv[e1]; }
#pragma unroll
        for (int u = 0; u < NU; ++u) *(unsigned*)(dstb + (size_t)(t0 + u) * 128 + 2 * lane) = cvt_pk_bf16(gt[u][0] * gelu_exact(h[u][0] * s1[u][0]) * s2[u][0], gt[u][1] * gelu_exact(h[u][1] * s1[u][1]) * s2[u][1]);
    }
}
__device__ __forceinline__ void g3_vaxpy(const Ctx& c, int layer, int dup) {
    const unsigned char* V8 = c.ws + R2_VB; const unsigned short* idx = (const unsigned short*)(c.ws + R2_IDX); const bf16_t* coef = (const bf16_t*)(c.ws + COEF_OFF);
    for_items(c, layer, 1 + 2 * dup, [&](int s, int blk) {
        int lane = c.lane; asm volatile("" : "+v"(lane));
        const int g = lane >> 3, c8 = lane & 7;
        const int co = 128 * s + 16 * c8;
        constexpr int N = ITEM_TOK / NWAVES;
        const int t0 = blk * ITEM_TOK + c.wave * N;
        auto load_idx = [&](int t, int (&id)[16]) {
#pragma unroll
            for (int j = 0; j < 2; ++j) { const u32x4 q = *(const u32x4*)(idx + (size_t)t * 128 + 16 * g + 8 * j);
#pragma unroll
                for (int e = 0; e < 4; ++e) { id[8 * j + 2 * e] = (int)(q[e] & 0xffffu); id[8 * j + 2 * e + 1] = (int)(q[e] >> 16); } } };
        auto load_rows = [&](int t, const int (&id)[16], u32x4 (&row)[16], f32x4 (&cf)[4]) {
#pragma unroll
            for (int j = 0; j < 2; ++j) { const u32x4 q = *(const u32x4*)(coef + (size_t)t * 128 + 16 * g + 8 * j); cf[2 * j] = (f32x4){bflo(q[0]), bfhi(q[0]), bflo(q[1]), bfhi(q[1])}; cf[2 * j + 1] = (f32x4){bflo(q[2]), bfhi(q[2]), bflo(q[3]), bfhi(q[3])}; }
#pragma unroll
            for (int j = 0; j < 16; ++j) row[j] = *(const u32x4*)(V8 + ((unsigned)id[j] * 1024u + (unsigned)co)); };
        auto compute = [&](int t, const u32x4 (&row)[16], const f32x4 (&cf)[4]) {
            f32x2 A2[8];
#pragma unroll
            for (int e = 0; e < 8; ++e) A2[e] = (f32x2){0.f, 0.f};
#pragma unroll
            for (int j = 0; j < 16; ++j) { const float cj = cf[j >> 2][j & 3]; const f32x2 sc = (f32x2){cj, cj};
#pragma unroll
                for (int q = 0; q < 4; ++q) { const f32x2 lo = __builtin_amdgcn_cvt_pk_f32_fp8((int)row[j][q], false), hi = __builtin_amdgcn_cvt_pk_f32_fp8((int)row[j][q], true);
                    A2[2 * q] = __builtin_elementwise_fma(sc, lo, A2[2 * q]); A2[2 * q + 1] = __builtin_elementwise_fma(sc, hi, A2[2 * q + 1]); } }
            float A[16];
#pragma unroll
            for (int e = 0; e < 8; ++e) { A[2 * e] = A2[e][0]; A[2 * e + 1] = A2[e][1]; }
            float R[8], S2[4], Y[2];
#pragma unroll
            for (int m = 0; m < 8; ++m) { auto rr = __builtin_amdgcn_permlane32_swap(__float_as_uint(A[m]), __float_as_uint(A[8 + m]), false, false); R[m] = __uint_as_float(rr[0]) + __uint_as_float(rr[1]); }
#pragma unroll
            for (int m = 0; m < 4; ++m) { auto rr = __builtin_amdgcn_permlane16_swap(__float_as_uint(R[m]), __float_as_uint(R[4 + m]), false, false); S2[m] = __uint_as_float(rr[0]) + __uint_as_float(rr[1]); }
            { const bool hi8 = (lane & 8) != 0;
#pragma unroll
              for (int m = 0; m < 2; ++m) { const float send = hi8 ? S2[m] : S2[2 + m], keep = hi8 ? S2[2 + m] : S2[m]; Y[m] = keep + DPP_F(send, 0x128); } }
            const size_t yo = (size_t)t * D + co + 8 * ((lane >> 5) & 1) + 4 * ((lane >> 4) & 1) + 2 * ((lane >> 3) & 1);
            const unsigned xo = *(const unsigned*)((const bf16_t*)(c.ws + WS_XB) + yo);
            *(unsigned*)((bf16_t*)c.out + yo) = cvt_pk_bf16(fmaf(DN_ALPHA, bflo(xo), Y[0]), fmaf(DN_ALPHA, bfhi(xo), Y[1])); };
        int idA[16], idB[16]; u32x4 rowA[16], rowB[16]; f32x4 cfA[4], cfB[4];
        load_idx(t0, idA); load_rows(t0, idA, rowA, cfA); load_idx(t0 + 1, idB);
#pragma unroll 1
        for (int i = 0; i < N; i += 2) {
            load_rows(t0 + i + 1, idB, rowB, cfB);
            if (i + 2 < N) load_idx(t0 + i + 2, idA);
            __builtin_amdgcn_sched_barrier(0);
            compute(t0 + i, rowA, cfA);
            __builtin_amdgcn_sched_barrier(0);
            if (i + 2 < N) load_rows(t0 + i + 2, idA, rowA, cfA);
            if (i + 3 < N) load_idx(t0 + i + 3, idB);
            __builtin_amdgcn_sched_barrier(0);
            compute(t0 + i + 1, rowB, cfB);
            __builtin_amdgcn_sched_barrier(0);
        }
    });
}
__device__ __forceinline__ void ln_pass(const Ctx& c, const float* g, const float* b) {
    const bf16_t* ym = (const bf16_t*)c.out; bf16_t* xa = (bf16_t*)(c.ws + WS_XB); const int lane = c.lane;
    constexpr int NU = 4;
    for (int t0 = c.gw * NU; t0 < T; t0 += c.NGW * NU) {
        f32x4 v[NU][4]; bf16_t* dst[NU]; unsigned char* dst8[NU]; float* dsc[NU];
#pragma unroll
        for (int u = 0; u < NU; ++u) { dst8[u] = nullptr; dsc[u] = nullptr; const bf16_t* yr = ym + (size_t)(t0 + u) * D; dst[u] = xa + (size_t)(t0 + u) * D;
#pragma unroll
            for (int j = 0; j < 4; ++j) { const u32x2 w = *(const u32x2*)(yr + 256 * j + 4 * lane); v[u][j] = (f32x4){bflo(w.x), bfhi(w.x), bflo(w.y), bfhi(w.y)}; } }
        ln_rows<NU, false>(v, g, b, lane, dst, dst8, dsc);
    }
}
#undef DPP_F
}
constexpr int N_PHASES = 1 + 2 * (5 + 8) + 2 * (5 + 8);

#ifndef PROBE_SITE
#define PROBE_SITE -1
#endif
#ifndef PROBE_LN
#define PROBE_LN 0
#endif
#ifndef PROBE_VAR
#define PROBE_VAR 5
#endif
#define GEMM_PHASE(EPI, Aptr, Bptr, NN, KK, ...) { pg8::Gemm g{(const bf16_t*)(Aptr), (const bf16_t*)(Bptr), T, (NN), (KK)}; pg8::StaticOrder S; S.init(T, (NN), c.G, c.bid); \
        pg8::EPI E{__VA_ARGS__}; pg8::gemm_phase<pg8::EPI, pg8::StaticOrder>(c.lds, g, S, E, c.tid); }

__global__ void __launch_bounds__(NTHR, 2) fwd_kernel(Args args) {
    extern __shared__ __attribute__((aligned(16))) unsigned char lds_raw[];
    volatile LAS unsigned* misc = (volatile LAS unsigned*)((LAS unsigned char*)lds_raw + LDS_MISC_OFF);
    if (threadIdx.x < 64) misc[threadIdx.x] = 0u;
    __syncthreads();
    const int wave_s = __builtin_amdgcn_readfirstlane((int)threadIdx.x >> 6);
    const int lo = args.ph_lo, hi = args.ph_hi;
    XcdBarrier bar; bar.bar = (unsigned*)(args.ws + WS_CTL); bar.x = 0; bar.st = nullptr;
    if (hi - lo > 1) bar = xcd_barrier_post((unsigned*)(args.ws + WS_CTL), misc + 8);
    int ph = 0;
#define PHASE(site, ...) if (ph >= lo && ph < hi) { const Ctx c = mk_ctx(lds_raw, wave_s); unsigned char* const ws = c.ws; (void)ws; { constexpr int dup = 0; (void)dup; __VA_ARGS__ } \
        if constexpr (PROBE_SITE == (site)) { __syncthreads(); constexpr int dup = 1; (void)dup; __VA_ARGS__ } if (ph + 1 < hi) xcd_barrier(bar); } ++ph;

    PHASE(0, p0_prologue(c);)

    for (int layer = 0; layer < NL; ++layer) {
        const int j = layer >> 1;
        if ((layer & 1) == 0) {
            PHASE(1, GEMM_PHASE(EpiF32, c.out, (const bf16_t*)(ws + W_WA) + (size_t)j * 768 * 1024, 768, 1024, (float*)(ws + B_A32), 768))
            PHASE(2, l0_convert(c, layer); mla_e1(c, j);)
            PHASE(3, GEMM_PHASE(EpiBf16P, ws + B_CQN, (const bf16_t*)(ws + W_WUQ) + (size_t)j * 1536 * 384, 1536, 384, (bf16_t*)(ws + B_Q), 1536) __syncthreads();
                     GEMM_PHASE(EpiBf16P, ws + B_CKVN, (const bf16_t*)(ws + W_WUKV) + (size_t)j * 2048 * 256, 2048, 256, (bf16_t*)(ws + B_KV), 2048))
            PHASE(5, if (dup == 0) mla_attention<0>(c); else mla_attention<PROBE_VAR>(c);)
            PHASE(6, GEMM_PHASE(EpiBf16P, ws + B_O, (const bf16_t*)(ws + W_WO) + (size_t)j * 1024 * 1024, 1024, 1024, (bf16_t*)(ws + B_H32_MLA), 1024))
        } else {
            PHASE(7, GEMM_PHASE(EpiHgrn, c.out, (const bf16_t*)(ws + W_HIN) + (size_t)j * 5120 * 1024, 5120, 1024, (bf16_t*)(ws + B_PLANE), (size_t)T * 1024, (const float*)(ws + WS_MISC) + (size_t)j * 2048))
            PHASE(8, if (dup == 0) { l0_convert(c, layer); scan::hgrn_prep(c, 0); } else { scan::hgrn_prep(c, 1); })
            PHASE(9, scan::hgrn_scan(c, dup != 0);)
            PHASE(10, hgrn_post(c, j);)
            PHASE(11, GEMM_PHASE(EpiBf16P, ws + B_PLANE, (const bf16_t*)(ws + W_HO) + (size_t)j * 1024 * 1024, 1024, 1024, (bf16_t*)(ws + B_H32_HGRN), 1024))
        }
        PHASE(12, ln_residual(c, (const bf16_t*)(ws + ((layer & 1) ? B_H32_HGRN : B_H32_MLA)), c.in(18) + layer * D, c.in(19) + layer * D);)
        PHASE(13, GEMM_PHASE(EpiBf16P, ws + WS_XB, (const bf16_t*)(ws + W_PQ) + (size_t)layer * 2048 * 1024, 2048, 1024, (bf16_t*)(ws + B_PQ), 2048))
        PHASE(14, peer::route(c, layer);)
        PHASE(15, peer::g1_udot(c, layer, dup);)
        PHASE(16, peer::g2_coef(c, dup);)
        PHASE(17, peer::g3_vaxpy(c, layer, dup);)
        PHASE(18, if (dup == 0 || PROBE_LN == 0) GEMM_PHASE(EpiBf16P, ws + R2_PB, (const bf16_t*)(ws + W_PP) + (size_t)layer * 1024 * 256, 1024, 256, (bf16_t*)(ws + B_PP), 1024) if (dup == 0 || PROBE_LN == 1) peer::ln_pass(c, c.in(20) + layer * D, c.in(21) + layer * D);)
        PHASE(19, GEMM_PHASE(EpiPle, ws + WS_XB, (const bf16_t*)(ws + W_GW) + (size_t)layer * 1024 * 1024, 1024, 1024, (const bf16_t*)(ws + WS_XB), (const bf16_t*)(ws + B_PP), c.in(23) + layer * D, (bf16_t*)c.out, (layer == NL - 1) ? c.out : (float*)nullptr))
    }
#undef PHASE
}

extern "C" void kernel_launch(void* const* d_in, const int* in_sizes, int n_in, void* d_out, int out_size, void* d_ws, size_t ws_size, hipStream_t stream) {
    static int grid = 0;
    if (grid == 0) {
        if (n_in != 25 || out_size != T * D || ws_size < WS_END) { fprintf(stderr, "kernel_launch: unexpected shapes: n_in %d out %d ws %zu (need %zu)\n", n_in, out_size, ws_size, (size_t)WS_END); grid = -1; return; }
        int dev = 0, cus = 0, per_cu = 0;
        if (hipGetDevice(&dev) != hipSuccess || hipDeviceGetAttribute(&cus, hipDeviceAttributeMultiprocessorCount, dev) != hipSuccess) { grid = -1; return; }
        if (hipFuncSetAttribute((const void*)fwd_kernel, hipFuncAttributeMaxDynamicSharedMemorySize, LDS_BYTES) != hipSuccess) { fprintf(stderr, "kernel_launch: hipFuncSetAttribute failed\n"); grid = -1; return; }
        if (hipOccupancyMaxActiveBlocksPerMultiprocessor(&per_cu, (const void*)fwd_kernel, NTHR, LDS_BYTES) != hipSuccess || per_cu < 1) { fprintf(stderr, "kernel_launch: occupancy query says %d\n", per_cu); }
        (void)hipGetLastError();
        grid = cus;
    }
    if (grid < 0) return;
    (void)hipMemsetAsync((char*)d_ws + WS_CTL, 0, CTL_ZERO_BYTES, stream);
    Args a{};
    for (int i = 0; i < 25; ++i) a.in[i] = (const float*)d_in[i];
    a.out = (float*)d_out; a.ws = (unsigned char*)d_ws;
#if defined(MK_DEBUG_MLA)
    float* res = (float*)((char*)d_ws + WS_CTL + 48 * 1024);
    for (int p = 0; p < 4; ++p) { a.ph_lo = p; a.ph_hi = p + 1; hipLaunchKernelGGL(fwd_kernel, dim3(grid), dim3(NTHR), LDS_BYTES, stream, a); }
    hipLaunchKernelGGL(k_zero_out, dim3(2048), dim3(256), 0, stream, (float*)d_out, (size_t)T * D);
    hipLaunchKernelGGL(k_mla_naive, dim3(2), dim3(256), 0, stream, (const float*)d_in[0], (const float*)d_in[1], (const float*)d_in[4], (const float*)d_in[5], (const float*)d_in[6], (const float*)d_in[7], (const float*)d_in[8], (const unsigned char*)d_ws, res);
    hipLaunchKernelGGL(k_mla_report, dim3(1), dim3(64), 0, stream, (const float*)res, (float*)d_out);
#elif defined(MK_DEBUG_ATTN)
    float* res = (float*)((char*)d_ws + WS_CTL + 48 * 1024);
    for (int p = 0; p < 5; ++p) { a.ph_lo = p; a.ph_hi = p + 1; hipLaunchKernelGGL(fwd_kernel, dim3(grid), dim3(NTHR), LDS_BYTES, stream, a); }
    hipLaunchKernelGGL(k_zero_out, dim3(2048), dim3(256), 0, stream, (float*)d_out, (size_t)T * D);
    hipLaunchKernelGGL(k_attn_naive, dim3(2 * CHK_NR), dim3(256), 0, stream, (const unsigned char*)d_ws, (float*)nullptr, res);
    hipLaunchKernelGGL(k_attn_report, dim3(1), dim3(64), 0, stream, (const float*)res, (float*)d_out);
#elif defined(MK_DEBUG_DET)
    unsigned long long* tab = (unsigned long long*)((char*)d_ws + WS_CTL + 32 * 1024);
    for (int pass = 0; pass < 2; ++pass)
        for (int p = 0; p < N_PHASES; ++p) { a.ph_lo = p; a.ph_hi = p + 1; hipLaunchKernelGGL(fwd_kernel, dim3(grid), dim3(NTHR), LDS_BYTES, stream, a);
            Reg r[4]; const int nr = phase_regions(p, r);
            for (int i = 0; i < nr; ++i) hipLaunchKernelGGL(k_checksum, dim3(2048), dim3(256), 0, stream, (const unsigned*)(r[i].in_out ? (char*)d_out : (char*)d_ws + r[i].off), r[i].bytes / 4, tab + (size_t)pass * N_PHASES * 4 + p * 4 + i); }
    hipLaunchKernelGGL(k_zero_out, dim3(2048), dim3(256), 0, stream, (float*)d_out, (size_t)T * D);
    hipLaunchKernelGGL(k_report, dim3(1), dim3(64), 0, stream, tab, N_PHASES * 4, (float*)d_out);
#elif MK_ONE_LAUNCH
    a.ph_lo = 0; a.ph_hi = N_PHASES;
    hipLaunchKernelGGL(fwd_kernel, dim3(grid), dim3(NTHR), LDS_BYTES, stream, a);
#else
    for (int p = 0; p < N_PHASES; ++p) { a.ph_lo = p; a.ph_hi = p + 1; hipLaunchKernelGGL(fwd_kernel, dim3(grid), dim3(NTHR), LDS_BYTES, stream, a); }
#endif
}
```

```cpp
#include <hip/hip_runtime.h>
#include <cstdio>
#include <cstdint>

#ifndef MK_ONE_LAUNCH
#define MK_ONE_LAUNCH 1
#endif

#define GAS __attribute__((address_space(1)))
#define LAS __attribute__((address_space(3)))
typedef unsigned short bf16_t;
typedef short bf16x8 __attribute__((ext_vector_type(8)));
typedef short s16x4 __attribute__((ext_vector_type(4)));
typedef float f32x4 __attribute__((ext_vector_type(4)));
typedef float f32x2 __attribute__((ext_vector_type(2)));
typedef float f32x16 __attribute__((ext_vector_type(16)));
typedef unsigned u32x4 __attribute__((ext_vector_type(4)));
typedef unsigned u32x2 __attribute__((ext_vector_type(2)));

constexpr int D = 1024, TP = 16384, TS = 65536, T = TP + TS, SP = 8192, SS = 2048;
constexpr int NL = 4;
constexpr int NWAVES = 8, NTHR = 512;
constexpr float DN_ALPHA = 1.681792830507429f;
constexpr float LN_EPS = 1e-5f, RMS_EPS = 1e-6f;
constexpr float MLA_SCALE = 0.07216878364870323f;
constexpr int NEXP = 16384;

constexpr size_t MiB = 1u << 20;
constexpr size_t WS_CTL = 0, CTL_ZERO_BYTES = 64 * 1024;
constexpr size_t WS_ROPE = 1 * MiB;
constexpr size_t WS_MISC = 3 * MiB;
constexpr size_t WS_W = 4 * MiB;
constexpr size_t W_WA = WS_W;
constexpr size_t W_WUQ = W_WA + 2 * (size_t)768 * 1024 * 2;
constexpr size_t W_WUKV = W_WUQ + 2 * (size_t)1536 * 384 * 2;
constexpr size_t W_WO = W_WUKV + 2 * (size_t)2048 * 256 * 2;
constexpr size_t W_HIN = W_WO + 2 * (size_t)1024 * 1024 * 2;
constexpr size_t W_HO = W_HIN + 2 * (size_t)5120 * 1024 * 2;
constexpr size_t W_PQ = W_HO + 2 * (size_t)1024 * 1024 * 2;
constexpr size_t W_GW = W_PQ + 4 * (size_t)2048 * 1024 * 2;
constexpr size_t W_PP = W_GW + 4 * (size_t)1024 * 1024 * 2;
constexpr size_t W_KEYS = W_PP + 4 * (size_t)1024 * 256 * 2;
constexpr size_t W_END = W_KEYS + 4 * (size_t)2 * 128 * 128 * 2;
static_assert(W_END <= 68 * MiB, "weights region");
constexpr size_t WS_R2 = 68 * MiB;
constexpr size_t R2_UB = WS_R2, R2_VB = WS_R2 + 16 * MiB, R2_SU = WS_R2 + 32 * MiB, R2_SV = WS_R2 + 33 * MiB, R2_IDX = WS_R2 + 64 * MiB, R2_GATE = WS_R2 + 104 * MiB, R2_PB = WS_R2 + 144 * MiB;
constexpr size_t WS_XB = 252 * MiB;
constexpr size_t WS_BIG = 412 * MiB;
constexpr size_t WS_END = WS_BIG + 800 * MiB;
constexpr size_t B_Q = WS_BIG, B_KV = WS_BIG + 240 * MiB, B_O = WS_BIG + 560 * MiB, B_KROPE = WS_BIG + 720 * MiB;
constexpr size_t B_A32 = WS_BIG + 240 * MiB, B_CQN = WS_BIG + 560 * MiB, B_CKVN = WS_BIG + 620 * MiB, B_H32_MLA = WS_BIG;
constexpr size_t B_PLANE = WS_BIG, PLANE_BYTES = 160 * MiB, B_H32_HGRN = WS_BIG + 160 * MiB;
constexpr size_t B_PQ = WS_BIG, B_PP = WS_BIG + 320 * MiB, B_X8 = WS_BIG + 480 * MiB, B_XS = WS_BIG + 560 * MiB;

constexpr int LDS_BYTES = 160 * 1024;
constexpr int LDS_MISC_OFF = LDS_BYTES - 256;

typedef __bf16 bf16x2_n __attribute__((ext_vector_type(2)));
__device__ __forceinline__ unsigned cvt_pk_bf16(float lo, float hi) { const f32x2 v = {lo, hi}; const bf16x2_n b = __builtin_convertvector(v, bf16x2_n); return __builtin_bit_cast(unsigned, b); }
__device__ __forceinline__ bf16_t f2bf(float f) { return (bf16_t)(cvt_pk_bf16(f, 0.f) & 0xffffu); }
__device__ __forceinline__ float bf2f(bf16_t b) { return __uint_as_float(((unsigned)b) << 16); }
__device__ __forceinline__ float bflo(unsigned w) { return __uint_as_float(w << 16); }
__device__ __forceinline__ float bfhi(unsigned w) { return __uint_as_float(w & 0xffff0000u); }
#define DPPF(v, ctrl) __int_as_float(__builtin_amdgcn_update_dpp(0, __float_as_int(v), (ctrl), 0xf, 0xf, true))
__device__ __forceinline__ float row16_sum(float v) { v += DPPF(v, 0xB1); v += DPPF(v, 0x4E); v += DPPF(v, 0x141); v += DPPF(v, 0x140); return v; }
__device__ __forceinline__ float wave_sum(float v) { v = row16_sum(v);
    { auto r = __builtin_amdgcn_permlane16_swap(__float_as_uint(v), __float_as_uint(v), false, false); v = __uint_as_float(r[0]) + __uint_as_float(r[1]); }
    { auto r = __builtin_amdgcn_permlane32_swap(__float_as_uint(v), __float_as_uint(v), false, false); v = __uint_as_float(r[0]) + __uint_as_float(r[1]); }
    return v; }
__device__ __forceinline__ float wave_max(float v) { v = fmaxf(v, DPPF(v, 0xB1)); v = fmaxf(v, DPPF(v, 0x4E)); v = fmaxf(v, DPPF(v, 0x141)); v = fmaxf(v, DPPF(v, 0x140));
    { auto r = __builtin_amdgcn_permlane16_swap(__float_as_uint(v), __float_as_uint(v), false, false); v = fmaxf(__uint_as_float(r[0]), __uint_as_float(r[1])); }
    { auto r = __builtin_amdgcn_permlane32_swap(__float_as_uint(v), __float_as_uint(v), false, false); v = fmaxf(__uint_as_float(r[0]), __uint_as_float(r[1])); }
    return v; }
__device__ __forceinline__ float fast_exp(float x) { return __builtin_amdgcn_exp2f(x * 1.4426950408889634f); }
__device__ __forceinline__ float fast_log(float x) { return __builtin_amdgcn_logf(x) * 0.6931471805599453f; }
__device__ __forceinline__ float fast_rcp(float x) { return __builtin_amdgcn_rcpf(x); }
__device__ __forceinline__ float sigmoidf_(float x) { return fast_rcp(1.0f + fast_exp(-x)); }
__device__ __forceinline__ float siluf_(float x) { return x * sigmoidf_(x); }
#define LDS_WAIT() asm volatile("s_waitcnt lgkmcnt(0)" ::: "memory")
#define VM_WAIT() asm volatile("s_waitcnt vmcnt(0)" ::: "memory")
__device__ __forceinline__ int opaque_lane() { int l; asm volatile("v_mbcnt_lo_u32_b32 %0, -1, 0\n\tv_mbcnt_hi_u32_b32 %0, -1, %0" : "=v"(l)); return l; }
__device__ __forceinline__ int opaque_tid(int wave_s) { asm volatile("" : "+s"(wave_s)); return (wave_s << 6) + opaque_lane(); }
__device__ __forceinline__ int opaque_bid() { int b = (int)blockIdx.x; asm volatile("" : "+s"(b)); return b; }
struct Args { const float* in[25]; float* out; unsigned char* ws; int ph_lo, ph_hi; };
#define XB_TMO      128
#define XB_XCNT(j)  (256  + 64 * (j))
#define XB_XSUB(j)  (1280 + 64 * (j))
#define XB_XGEN(j)  (2304 + 64 * (j))
#define XB_TOP      3328
#define XB_TOPGEN   3392
#define XCD_BAR_WORDS 3456
#define XB_SPIN_CAP (1u << 23)

__device__ __forceinline__ unsigned xb_ld(unsigned* p)              { return __hip_atomic_load(p, __ATOMIC_RELAXED, __HIP_MEMORY_SCOPE_AGENT); }
__device__ __forceinline__ unsigned xb_add(unsigned* p, unsigned v) { return __hip_atomic_fetch_add(p, v, __ATOMIC_RELAXED, __HIP_MEMORY_SCOPE_AGENT); }
__device__ __forceinline__ unsigned xb_xcc_id() { return (unsigned)__builtin_amdgcn_s_getreg((3 << 11) | 20) & 0xFu; }
#define XB_SPIN(cond, bar) do { unsigned _sp = 0; while (cond) { __builtin_amdgcn_s_sleep(1); \
    if ((++_sp & 255u) == 0u) { if (xb_ld(&(bar)[XB_TMO])) break; if (_sp > XB_SPIN_CAP) { atomicAdd(&(bar)[XB_TMO], 1u); break; } } } } while (0)

struct XcdBarrier {
    unsigned* bar; unsigned x;
    volatile LAS unsigned* st;
};

__device__ __forceinline__ XcdBarrier xcd_barrier_post(unsigned* bar, volatile LAS unsigned* st) {
    XcdBarrier b; b.bar = bar; b.x = xb_xcc_id(); b.st = st;
    if (threadIdx.x == 0) (void)xb_add(&bar[XB_XCNT(b.x)], 1u);
    return b;
}
__device__ __forceinline__ void xcd_barrier_complete(unsigned* bar, unsigned x, unsigned& nloc, unsigned& nx) {
    const unsigned G = gridDim.x * gridDim.y * gridDim.z;
    unsigned sum, cnt, mine, sp = 0u;
    for (;;) {
        sum = 0u; cnt = 0u; mine = 0u;
#pragma unroll
        for (unsigned j = 0; j < 16; ++j) { const unsigned c = xb_ld(&bar[XB_XCNT(j)]); sum += c; cnt += (c > 0u) ? 1u : 0u; mine = (j == x) ? c : mine; }
        if (sum == G) break;
        __builtin_amdgcn_s_sleep(1);
        if ((++sp & 255u) == 0u) { if (xb_ld(&bar[XB_TMO])) break; if (sp > XB_SPIN_CAP) { atomicAdd(&bar[XB_TMO], 1u); break; } }
    }
    nloc = mine > 0u ? mine : 1u; nx = cnt > 0u ? cnt : 1u;
}

__device__ __forceinline__ void xcd_barrier(const XcdBarrier& b) {
    asm volatile("s_waitcnt vmcnt(0)" ::: "memory");
    __syncthreads();
    if (threadIdx.x == 0) {
        unsigned* bar = b.bar;
        __builtin_amdgcn_s_waitcnt(0);
        unsigned nloc = b.st[0], nx = b.st[1];
        if (nloc == 0u) { xcd_barrier_complete(bar, b.x, nloc, nx); b.st[0] = nloc; b.st[1] = nx; }
        const unsigned old = xb_add(&bar[XB_XSUB(b.x)], 1u);
        const unsigned gen = old / nloc;
        if (old + 1u == (gen + 1u) * nloc) {
            __builtin_amdgcn_fence(__ATOMIC_RELEASE, "agent");
            asm volatile("s_waitcnt vmcnt(0)" ::: "memory");
            const unsigned og = xb_add(&bar[XB_TOP], 1u);
            const unsigned tg = og / nx;
            if (og + 1u == (tg + 1u) * nx) xb_add(&bar[XB_TOPGEN], 1u);
            else XB_SPIN(xb_ld(&bar[XB_TOPGEN]) == tg, bar);
            __builtin_amdgcn_fence(__ATOMIC_ACQUIRE, "agent");
            xb_add(&bar[XB_XGEN(b.x)], 1u);
            asm volatile("s_waitcnt vmcnt(0)" ::: "memory");
        } else {
            XB_SPIN(xb_ld(&bar[XB_XGEN(b.x)]) == gen, bar);
            __builtin_amdgcn_fence(__ATOMIC_ACQUIRE, "agent");
            asm volatile("s_waitcnt vmcnt(0)" ::: "memory");
        }
    }
    __syncthreads();
}
namespace pg8 {
#define PG8_LAS __attribute__((address_space(3)))
constexpr int BM = 256, BK = 64, HALF = 128, HTB = HALF * BK * 2  , STAGE_BYTES = 8 * HTB, NXCD = 8, WGM = 8;

__host__ __device__ __forceinline__ int lds_byte(int r, int c) { const int st = (r >> 4) * 2 + (c >> 5), rr = r & 15, cc = c & 31, ob = rr * 64 + cc * 2; return st * 1024 + (ob ^ (((ob >> 9) & 1) << 5)); }
__host__ __device__ __forceinline__ void stage_rc(int b, int& R, int& C) { const int st = b / 1024, sb = b % 1024, swz = sb ^ (((sb >> 9) & 1) << 5); R = (st >> 1) * 16 + swz / 64; C = (st & 1) * 32 + (swz % 64) / 2; }
__host__ __device__ __forceinline__ int perm32(int rho) { const int n = rho >> 4, i = rho & 15; return 8 * (i >> 2) + 4 * n + (i & 3); }

struct Unit { int pm, pn; };
struct Gemm { const bf16_t* A; const bf16_t* Bt; int M, N, K; };

struct StaticOrder {
    int nM, nN, nwg, G, c;
    __host__ __device__ void init(int M, int N, int G_, int c_) { nM = M / BM; nN = N / BM; nwg = nM * nN; G = G_; c = c_; }
    __host__ __device__ bool next(int i, Unit& u) const {
        const long L = (long)i * G + c; if (L >= nwg) return false;
        int wgid = (int)L; { const int q = nwg / NXCD, r = nwg % NXCD, xcd = wgid % NXCD, off = wgid / NXCD; wgid = (xcd < r ? xcd * (q + 1) : r * (q + 1) + (xcd - r) * q) + off; }
        const int nig = WGM * nN, gid = wgid / nig, fm = gid * WGM, gsz = (nM - fm) < WGM ? (nM - fm) : WGM;
        u.pm = fm + ((wgid % nig) % gsz); u.pn = (wgid % nig) / gsz; return true;
    }
    __device__ __forceinline__ void a_ready(const Unit&) const {}
    __device__ __forceinline__ void done(const Unit&) const {}
};
template <class Epi, class Sched>
__device__ __forceinline__ void gemm_phase(PG8_LAS unsigned char* lds, const Gemm g, const Sched& S, const Epi& E, const int tid) {
    const int wid = __builtin_amdgcn_readfirstlane(tid >> 6), lane = tid & 63, wr = wid >> 2, wc = wid & 3, fr = lane & 15, fq = lane >> 4;
    const int K = g.K, nt = K / BK;
    unsigned voffA[2], voffB[2];
#pragma unroll
    for (int i = 0; i < 2; ++i) { int R, C; stage_rc(tid * 16 + i * 8192, R, C); const int Rb = Epi::PERM ? ((R & ~31) + perm32(R & 31)) : R;
        voffA[i] = (unsigned)(R * K + C) * 2u; voffB[i] = (unsigned)(Rb * K + C) * 2u; }
    const size_t kstep = (size_t)(BK * 2);
    const size_t hstep = (size_t)HALF * K * 2;
    const size_t tstep = 2 * hstep;
    const unsigned ldsw = (unsigned)wid * 1024u;
    const int aoff = lds_byte(wr * 64 + fr, fq * 8), boff = lds_byte(wc * 32 + fr, fq * 8);
#define PG8_SA(b, h) (((b) * 2 + (h)) * HTB)
#define PG8_SB(b, h) ((4 + (b) * 2 + (h)) * HTB)
#define PG8_STAGE(bufoff, gbase, voff) do { _Pragma("unroll") for (int _i = 0; _i < 2; ++_i) \
        __builtin_amdgcn_global_load_lds((const unsigned*)((const char*)(gbase) + (voff)[_i]), (PG8_LAS unsigned*)(lds + (bufoff) + ldsw + _i * 8192), 16, 0, 0); } while (0)
#define PG8_LDA(dst, b, h) do { _Pragma("unroll") for (int m = 0; m < 4; ++m) _Pragma("unroll") for (int k = 0; k < 2; ++k) dst[m][k] = *(const PG8_LAS bf16x8*)(lds + PG8_SA(b, h) + aoff + m * 2048 + k * 1024); } while (0)
#define PG8_LDB(dst, b, h) do { _Pragma("unroll") for (int n = 0; n < 2; ++n) _Pragma("unroll") for (int k = 0; k < 2; ++k) dst[n][k] = *(const PG8_LAS bf16x8*)(lds + PG8_SB(b, h) + boff + n * 2048 + k * 1024); } while (0)
#define PG8_MMA(ai, bj, At, Bt) do { __builtin_amdgcn_s_setprio(1); _Pragma("unroll") for (int m = 0; m < 4; ++m) _Pragma("unroll") for (int n = 0; n < 2; ++n) _Pragma("unroll") for (int k = 0; k < 2; ++k) \
        acc[ai][bj][m][n] = __builtin_amdgcn_mfma_f32_16x16x32_bf16(Bt[n][k], At[m][k], acc[ai][bj][m][n], 0, 0, 0); __builtin_amdgcn_s_setprio(0); } while (0)
#define PG8_WAIT_V(n) asm volatile("s_waitcnt vmcnt(" #n ")" ::: "memory")
#define PG8_WAIT_L(n) asm volatile("s_waitcnt lgkmcnt(" #n ")" ::: "memory")
#define PG8_BAR __builtin_amdgcn_s_barrier()
#define PG8_SCHED __builtin_amdgcn_sched_barrier(0)
    Unit cur, nxt; int ui = 0;
    if (!S.next(0, cur)) return;
    f32x4 acc[2][2][4][2];
#pragma unroll
    for (int a = 0; a < 2; ++a)
#pragma unroll
        for (int b = 0; b < 2; ++b)
#pragma unroll
            for (int m = 0; m < 4; ++m)
#pragma unroll
                for (int n = 0; n < 2; ++n) acc[a][b][m][n] = (f32x4){0.f, 0.f, 0.f, 0.f};
    bf16x8 At[4][2], B0[2][2], B1[2][2];
    const char* cA = (const char*)g.A + (size_t)cur.pm * tstep; const char* cB = (const char*)g.Bt + (size_t)cur.pn * tstep;
    S.a_ready(cur);
    PG8_STAGE(PG8_SB(0, 0), cB, voffB); PG8_STAGE(PG8_SA(0, 0), cA, voffA); PG8_STAGE(PG8_SB(0, 1), cB + hstep, voffB); PG8_STAGE(PG8_SA(0, 1), cA + hstep, voffA);
    if (wr == 1) PG8_BAR;
    PG8_WAIT_V(4); PG8_BAR;
    PG8_STAGE(PG8_SB(1, 0), cB + kstep, voffB); PG8_STAGE(PG8_SA(1, 0), cA + kstep, voffA); PG8_STAGE(PG8_SB(1, 1), cB + hstep + kstep, voffB);
    PG8_WAIT_V(6); PG8_BAR;
    for (;;) {
        const bool has_next = S.next(ui + 1, nxt);
        const char* nA = has_next ? (const char*)g.A + (size_t)nxt.pm * tstep : cA; const char* nB = has_next ? (const char*)g.Bt + (size_t)nxt.pn * tstep : cB;
        for (int t = 0; t < nt; t += 2) {
            const bool last = (t == nt - 2);
            const char* a1 = cA + (size_t)(t + 1) * kstep;
            const char* a2 = last ? nA : cA + (size_t)(t + 2) * kstep; const char* b2 = last ? nB : cB + (size_t)(t + 2) * kstep;
            const char* a3 = a2 + kstep; const char* b3 = b2 + kstep;
            if (last && has_next) S.a_ready(nxt);
            PG8_LDB(B0, 0, 0); PG8_SCHED; PG8_LDA(At, 0, 0); PG8_STAGE(PG8_SA(1, 1), a1 + hstep, voffA);
            PG8_WAIT_L(8); PG8_BAR; PG8_WAIT_L(0); PG8_MMA(0, 0, At, B0); PG8_BAR; PG8_SCHED;
            PG8_LDB(B1, 0, 1); PG8_STAGE(PG8_SB(0, 0), b2, voffB);
            PG8_BAR; PG8_WAIT_L(0); PG8_MMA(0, 1, At, B1); PG8_BAR;
            PG8_LDA(At, 0, 1); PG8_STAGE(PG8_SA(0, 0), a2, voffA);
            PG8_BAR; PG8_WAIT_L(0); PG8_MMA(1, 0, At, B0); PG8_BAR; PG8_SCHED;
            PG8_STAGE(PG8_SB(0, 1), b2 + hstep, voffB);
            PG8_WAIT_V(6); PG8_BAR; PG8_MMA(1, 1, At, B1); PG8_BAR;
            PG8_LDB(B0, 1, 0); PG8_SCHED; PG8_LDA(At, 1, 0); PG8_STAGE(PG8_SA(0, 1), a2 + hstep, voffA);
            PG8_WAIT_L(8); PG8_BAR; PG8_WAIT_L(0); PG8_MMA(0, 0, At, B0); PG8_BAR; PG8_SCHED;
            PG8_LDB(B1, 1, 1); PG8_STAGE(PG8_SB(1, 0), b3, voffB);
            PG8_BAR; PG8_WAIT_L(0); PG8_MMA(0, 1, At, B1); PG8_BAR;
            PG8_LDA(At, 1, 1); PG8_STAGE(PG8_SA(1, 0), a3, voffA);
            PG8_BAR; PG8_WAIT_L(0); PG8_MMA(1, 0, At, B0); PG8_BAR; PG8_SCHED;
            PG8_STAGE(PG8_SB(1, 1), b3 + hstep, voffB);
            PG8_WAIT_V(6); PG8_BAR; PG8_MMA(1, 1, At, B1); PG8_BAR;
        }
        E(acc, cur, wr, wc, fr, fq); S.done(cur);
        if (!has_next) break;
#pragma unroll
        for (int a = 0; a < 2; ++a)
#pragma unroll
            for (int b = 0; b < 2; ++b)
#pragma unroll
                for (int m = 0; m < 4; ++m)
#pragma unroll
                    for (int n = 0; n < 2; ++n) acc[a][b][m][n] = (f32x4){0.f, 0.f, 0.f, 0.f};
        cur = nxt; cA = nA; cB = nB; ++ui;
    }
    PG8_WAIT_V(0);
    if (wr == 0) PG8_BAR;
    PG8_BAR;
#undef PG8_SA
#undef PG8_SB
#undef PG8_STAGE
#undef PG8_LDA
#undef PG8_LDB
#undef PG8_MMA
#undef PG8_WAIT_V
#undef PG8_WAIT_L
#undef PG8_BAR
#undef PG8_SCHED
}
struct EpiF32 {
    static constexpr bool PERM = false;
    float* C; int ldc;
    __device__ __forceinline__ void operator()(const f32x4 (&acc)[2][2][4][2], const Unit& u, int wr, int wc, int fr, int fq) const {
        const int row0 = u.pm * BM + wr * 64 + fr, col0 = u.pn * BM + wc * 32 + 4 * fq;
#pragma unroll
        for (int ai = 0; ai < 2; ++ai)
#pragma unroll
            for (int m = 0; m < 4; ++m) { float* rowp = C + (size_t)(row0 + ai * HALF + m * 16) * ldc + col0;
#pragma unroll
                for (int bj = 0; bj < 2; ++bj)
#pragma unroll
                    for (int n = 0; n < 2; ++n) *(f32x4*)(rowp + bj * HALF + n * 16) = acc[ai][bj][m][n]; }
    }
};
struct EpiBf16P {
    static constexpr bool PERM = true;
    bf16_t* O; int ldc;
    __device__ __forceinline__ void operator()(const f32x4 (&acc)[2][2][4][2], const Unit& u, int wr, int wc, int fr, int fq) const {
        const int row0 = u.pm * BM + wr * 64 + fr, col0 = u.pn * BM + wc * 32 + 8 * fq;
#pragma unroll
        for (int ai = 0; ai < 2; ++ai)
#pragma unroll
            for (int m = 0; m < 4; ++m) { bf16_t* rowp = O + (size_t)(row0 + ai * HALF + m * 16) * ldc + col0;
#pragma unroll
                for (int bj = 0; bj < 2; ++bj) { const f32x4 v0 = acc[ai][bj][m][0], v1 = acc[ai][bj][m][1];
                    u32x4 w; w.x = cvt_pk_bf16(v0[0], v0[1]); w.y = cvt_pk_bf16(v0[2], v0[3]); w.z = cvt_pk_bf16(v1[0], v1[1]); w.w = cvt_pk_bf16(v1[2], v1[3]);
                    *(u32x4*)(rowp + bj * HALF) = w; } }
    }
};
struct EpiHgrn {
    static constexpr bool PERM = true;
    bf16_t* planes; size_t plane_elems; const float* lb;
    __device__ __forceinline__ void operator()(const f32x4 (&acc)[2][2][4][2], const Unit& u, int wr, int wc, int fr, int fq) const {
        const int plane = u.pn >> 2;
        const int row0 = u.pm * BM + wr * 64 + fr, col0 = (u.pn & 3) * BM + wc * 32 + 8 * fq;
        bf16_t* base = planes + (size_t)plane * plane_elems;
        float lbv[2][8];
        if (plane == 1 || plane == 2) {
#pragma unroll
            for (int bj = 0; bj < 2; ++bj)
#pragma unroll
                for (int e = 0; e < 8; ++e) lbv[bj][e] = lb[(plane - 1) * 1024 + col0 + bj * HALF + e];
        } else {
#pragma unroll
            for (int bj = 0; bj < 2; ++bj)
#pragma unroll
                for (int e = 0; e < 8; ++e) lbv[bj][e] = 0.f;
        }
#pragma unroll
        for (int ai = 0; ai < 2; ++ai)
#pragma unroll
            for (int m = 0; m < 4; ++m) { bf16_t* rowp = base + (size_t)(row0 + ai * HALF + m * 16) * 1024 + col0;
#pragma unroll
                for (int bj = 0; bj < 2; ++bj) { float v[8];
#pragma unroll
                    for (int e = 0; e < 4; ++e) { v[e] = acc[ai][bj][m][0][e]; v[4 + e] = acc[ai][bj][m][1][e]; }
                    if (plane == 0 || plane == 4) {
#pragma unroll
                        for (int e = 0; e < 8; ++e) v[e] = siluf_(v[e]);
                    } else if (plane == 1 || plane == 2) {
#pragma unroll
                        for (int e = 0; e < 8; ++e) { const float l = lbv[bj][e]; const float f = l + (1.0f - l) * sigmoidf_(v[e]); v[e] = fast_log(fmaxf(f, 1e-30f)); }
                    }
                    u32x4 w; w.x = cvt_pk_bf16(v[0], v[1]); w.y = cvt_pk_bf16(v[2], v[3]); w.z = cvt_pk_bf16(v[4], v[5]); w.w = cvt_pk_bf16(v[6], v[7]);
                    *(u32x4*)(rowp + bj * HALF) = w; } }
    }
};
struct EpiPle {
    static constexpr bool PERM = false;
    const bf16_t* Xin; const bf16_t* PP; const float* bias; bf16_t* XbOut; float* Fout;
    __device__ __forceinline__ void operator()(const f32x4 (&acc)[2][2][4][2], const Unit& u, int wr, int wc, int fr, int fq) const {
        const int row0 = u.pm * BM + wr * 64 + fr, col0 = u.pn * BM + wc * 32 + 4 * fq;
        f32x4 bv[2][2];
#pragma unroll
        for (int bj = 0; bj < 2; ++bj)
#pragma unroll
            for (int n = 0; n < 2; ++n) bv[bj][n] = *(const f32x4*)(bias + col0 + bj * HALF + n * 16);
#pragma unroll
        for (int ai = 0; ai < 2; ++ai)
#pragma unroll
            for (int m = 0; m < 4; ++m) { const size_t off = (size_t)(row0 + ai * HALF + m * 16) * 1024 + col0;
#pragma unroll
                for (int bj = 0; bj < 2; ++bj)
#pragma unroll
                    for (int n = 0; n < 2; ++n) { const size_t o2 = off + bj * HALF + n * 16;
                        const u32x2 xw = *(const u32x2*)(Xin + o2); const u32x2 pw = *(const u32x2*)(PP + o2); const f32x4 z = acc[ai][bj][m][n] + bv[bj][n];
                        f32x4 o; o[0] = bflo(xw.x) + sigmoidf_(z[0]) * bflo(pw.x); o[1] = bfhi(xw.x) + sigmoidf_(z[1]) * bfhi(pw.x); o[2] = bflo(xw.y) + sigmoidf_(z[2]) * bflo(pw.y); o[3] = bfhi(xw.y) + sigmoidf_(z[3]) * bfhi(pw.y);
                        if (Fout) *(f32x4*)(Fout + o2) = o; else { u32x2 w; w.x = cvt_pk_bf16(o[0], o[1]); w.y = cvt_pk_bf16(o[2], o[3]); *(u32x2*)(XbOut + o2) = w; } }
                if (m & 1) asm volatile("" ::: "memory"); }
    }
};
}
namespace attn {
constexpr int DV = 128, DQK = 192, NW = 8, QBLK = 32, KVBLK = 64;
constexpr float SCALE = MLA_SCALE;
constexpr float THR = 8.f;
constexpr int LDQ = 8 * DQK, LDKV = 8 * 256, LDKR = 64, LDO = 1024;
constexpr int KROWB = 400;
constexpr int SHM_V = KVBLK * DV * 2, SHM_K = KVBLK * KROWB, SHM_ATTN = 2 * SHM_V + 2 * SHM_K + NW * 64 * 4 + NW * 4096;
#define SBAR() __builtin_amdgcn_sched_barrier(0)
__device__ __forceinline__ int crow(int r, int hi) { return (r & 3) + 8 * (r >> 2) + 4 * hi; }

__device__ __forceinline__ void partialSM(f32x16& p0, f32x16& p1, float& m_reg, float& mn, float& alpha) {
  constexpr float C = SCALE * 1.4426950408889634f;
  float pmax = p0[0];
#pragma unroll
  for (int r = 1; r < 16; ++r) pmax = fmaxf(pmax, p0[r]);
#pragma unroll
  for (int r = 0; r < 16; ++r) pmax = fmaxf(pmax, p1[r]);
  { auto rr = __builtin_amdgcn_permlane32_swap(__float_as_uint(pmax), __float_as_uint(pmax), false, false);
    pmax = fmaxf(__uint_as_float(rr[0]), __uint_as_float(rr[1])); }
  if (__builtin_expect(__all(pmax - m_reg <= THR / SCALE), 1)) { mn = m_reg; alpha = 1.f; }
  else { mn = fmaxf(m_reg, pmax); alpha = __builtin_amdgcn_exp2f((m_reg - mn) * C); m_reg = mn; }
  float mnC = -mn * C;
#pragma unroll
  for (int r = 0; r < 16; ++r) p0[r] = fmaf(p0[r], C, mnC);
#pragma unroll
  for (int r = 0; r < 16; ++r) p1[r] = fmaf(p1[r], C, mnC);
#pragma unroll
  for (int r = 0; r < 16; ++r) p0[r] = __builtin_amdgcn_exp2f(p0[r]);
}
__device__ __forceinline__ void finishSM(f32x16& p0, f32x16& p1, float alpha, float& l_reg, bf16x8& pa0, bf16x8& pa1, bf16x8& pa2, bf16x8& pa3) {
#pragma unroll
  for (int r = 0; r < 16; ++r) p1[r] = __builtin_amdgcn_exp2f(p1[r]);
  float ps = 0;
#pragma unroll
  for (int r = 0; r < 16; ++r) ps += p0[r];
#pragma unroll
  for (int r = 0; r < 16; ++r) ps += p1[r];
  { auto rr = __builtin_amdgcn_permlane32_swap(__float_as_uint(ps), __float_as_uint(ps), false, false);
    ps = __uint_as_float(rr[0]) + __uint_as_float(rr[1]); }
  l_reg = l_reg * alpha + ps;
#define PK4(P, BASE, OUT) do { unsigned a0 = cvt_pk_bf16(P[BASE + 0], P[BASE + 1]), a1 = cvt_pk_bf16(P[BASE + 2], P[BASE + 3]);   \
    unsigned b0 = cvt_pk_bf16(P[BASE + 4], P[BASE + 5]), b1 = cvt_pk_bf16(P[BASE + 6], P[BASE + 7]);                              \
    auto r0 = __builtin_amdgcn_permlane32_swap(a0, b0, false, false); auto r1 = __builtin_amdgcn_permlane32_swap(a1, b1, false, false); \
    u32x4 w = {r0[0], r1[0], r0[1], r1[1]}; OUT = *reinterpret_cast<bf16x8*>(&w); } while (0)
  PK4(p0, 0, pa0); PK4(p0, 8, pa1); PK4(p1, 0, pa2); PK4(p1, 8, pa3);
#undef PK4
}
__device__ __forceinline__ void qkt(f32x16& p0, f32x16& p1, const char* Ks, const bf16x8* qr, const char* qrl, int r32, int hi) {
  p0 = f32x16{}; p1 = f32x16{};
  const char* k0 = Ks + r32 * KROWB + hi * 16; const char* k1 = Ks + (32 + r32) * KROWB + hi * 16;
  bf16x8 fa[2], fb[2], ga[2], gb[2], qx[2], qy[2];
#define QK_LD(FA, FB, QX, G) _Pragma("unroll") for (int i = 0; i < 2; ++i) { FA[i] = *reinterpret_cast<const bf16x8*>(k0 + ((G) * 2 + i) * 32); FB[i] = *reinterpret_cast<const bf16x8*>(k1 + ((G) * 2 + i) * 32); \
      if ((G) * 2 + i >= 8) QX[i] = *reinterpret_cast<const bf16x8*>(qrl + ((G) * 2 + i - 8) * 1024); }
#define QK_MM(FA, FB, QX, G) _Pragma("unroll") for (int i = 0; i < 2; ++i) { const bf16x8 qf = ((G) * 2 + i < 8) ? qr[((G) * 2 + i < 8) ? (G) * 2 + i : 0] : QX[i]; \
      p0 = __builtin_amdgcn_mfma_f32_32x32x16_bf16(FA[i], qf, p0, 0, 0, 0); p1 = __builtin_amdgcn_mfma_f32_32x32x16_bf16(FB[i], qf, p1, 0, 0, 0); }
  QK_LD(fa, fb, qx, 0) SBAR();
  QK_LD(ga, gb, qy, 1) SBAR(); QK_MM(fa, fb, qx, 0) SBAR();
  QK_LD(fa, fb, qx, 2) SBAR(); QK_MM(ga, gb, qy, 1) SBAR();
  QK_LD(ga, gb, qy, 3) SBAR(); QK_MM(fa, fb, qx, 2) SBAR();
  QK_LD(fa, fb, qx, 4) SBAR(); QK_MM(ga, gb, qy, 3) SBAR();
  QK_LD(ga, gb, qy, 5) SBAR(); QK_MM(fa, fb, qx, 4) SBAR();
  QK_MM(ga, gb, qy, 5) SBAR();
#undef QK_LD
#undef QK_MM
}
__device__ __forceinline__ int v_st(int k, int c) { const int kk = (k & ~0xC) | ((k & 4) << 1) | ((k & 8) >> 1); return ((kk >> 3) * 4 + (c >> 5)) * 512 + ((kk & 7) * 32 + (c & 31)) * 2; }
__device__ __forceinline__ int v_rd_base(int lane) { return ((lane & 3) << 3) | (((lane >> 2) & 3) << 6) | (((lane >> 4) & 1) << 5) | (((lane >> 5) & 1) << 8); }
constexpr int v_rd_off(int d0, int ks, int half) { return d0 * 512 + ks * 4096 + half * 2048; }
template <int OFF> __device__ __forceinline__ s16x4 tr_read(int vb) {
  s16x4 r; asm volatile("ds_read_b64_tr_b16 %0, %1 offset:%2" : "=&v"(r) : "v"(vb), "i"(OFF) : "memory"); return r;
}
template <int D0> __device__ __forceinline__ void pv_one(f32x16& od, int vb, bf16x8 pa0, bf16x8 pa1, bf16x8 pa2, bf16x8 pa3) {
  const s16x4 l0 = tr_read<v_rd_off(D0, 0, 0)>(vb), h0 = tr_read<v_rd_off(D0, 0, 1)>(vb), l1 = tr_read<v_rd_off(D0, 1, 0)>(vb), h1 = tr_read<v_rd_off(D0, 1, 1)>(vb);
  const s16x4 l2 = tr_read<v_rd_off(D0, 2, 0)>(vb), h2 = tr_read<v_rd_off(D0, 2, 1)>(vb), l3 = tr_read<v_rd_off(D0, 3, 0)>(vb), h3 = tr_read<v_rd_off(D0, 3, 1)>(vb);
  asm volatile("s_waitcnt lgkmcnt(0)" ::: "memory"); SBAR();
#define PK(L, H) (bf16x8){L[0], L[1], L[2], L[3], H[0], H[1], H[2], H[3]}
  od = __builtin_amdgcn_mfma_f32_32x32x16_bf16(pa0, PK(l0, h0), od, 0, 0, 0);
  od = __builtin_amdgcn_mfma_f32_32x32x16_bf16(pa1, PK(l1, h1), od, 0, 0, 0);
  od = __builtin_amdgcn_mfma_f32_32x32x16_bf16(pa2, PK(l2, h2), od, 0, 0, 0);
  od = __builtin_amdgcn_mfma_f32_32x32x16_bf16(pa3, PK(l3, h3), od, 0, 0, 0);
#undef PK
}
__device__ __forceinline__ void pv_d0(f32x16* o, int vb, bf16x8 pa0, bf16x8 pa1, bf16x8 pa2, bf16x8 pa3) {
  pv_one<0>(o[0], vb, pa0, pa1, pa2, pa3); pv_one<1>(o[1], vb, pa0, pa1, pa2, pa3); pv_one<2>(o[2], vb, pa0, pa1, pa2, pa3); pv_one<3>(o[3], vb, pa0, pa1, pa2, pa3);
}

template <int VAR> __device__ __forceinline__ void attn_body(const bf16_t* __restrict__ Qb, const bf16_t* __restrict__ Kn, const bf16_t* __restrict__ Kr,
                                          bf16_t* __restrict__ Ob, int seq, char* lds, int tid, int pos0, const float* __restrict__ ropeT) {
  asm volatile("" : "+v"(tid));
  const int wid = tid >> 6, lane = tid & 63, r32 = lane & 31, hi = lane >> 5;
  char* V_lds = lds; char* K_lds = lds + 2 * SHM_V;
  float* ws = (float*)(lds + 2 * SHM_V + 2 * SHM_K) + wid * 64; float* li_l = ws; float* al_l = ws + 32;
  float m_reg = -1e30f, l_reg = 0; f32x16 o[4] = {}; bf16x8 qr[8];
  char* qrl = lds + 2 * SHM_V + 2 * SHM_K + NW * 64 * 4 + wid * 4096 + lane * 16;
  const bf16_t* Qw = Qb + (long)(wid * QBLK + r32) * LDQ + hi * 8;
#pragma unroll
  for (int d0 = 0; d0 < 8; ++d0) qr[d0] = *reinterpret_cast<const bf16x8*>(Qw + d0 * 16);
  { const float* cp = ropeT + (size_t)(pos0 + wid * QBLK + r32) * 32 + hi * 8; const float* sp = cp + 8192 * 32;
#pragma unroll
    for (int dd = 0; dd < 2; ++dd) { const f32x4 c0 = *(const f32x4*)(cp + 16 * dd), c1 = *(const f32x4*)(cp + 16 * dd + 4), s0 = *(const f32x4*)(sp + 16 * dd), s1 = *(const f32x4*)(sp + 16 * dd + 4);
      const u32x4 A = *reinterpret_cast<const u32x4*>(Qw + (8 + dd) * 16), B = *reinterpret_cast<const u32x4*>(Qw + (10 + dd) * 16); u32x4 An, Bn;
#pragma unroll
      for (int w2 = 0; w2 < 4; ++w2) { const float cs0 = w2 < 2 ? c0[2 * w2] : c1[2 * w2 - 4], cs1 = w2 < 2 ? c0[2 * w2 + 1] : c1[2 * w2 - 3], sn0 = w2 < 2 ? s0[2 * w2] : s1[2 * w2 - 4], sn1 = w2 < 2 ? s0[2 * w2 + 1] : s1[2 * w2 - 3];
        const float a0 = bflo(A[w2]), a1 = bfhi(A[w2]), b0 = bflo(B[w2]), b1 = bfhi(B[w2]);
        An[w2] = cvt_pk_bf16(a0 * cs0 - b0 * sn0, a1 * cs1 - b1 * sn1); Bn[w2] = cvt_pk_bf16(b0 * cs0 + a0 * sn0, b1 * cs1 + a1 * sn1); }
      *reinterpret_cast<u32x4*>(qrl + dd * 1024) = An; *reinterpret_cast<u32x4*>(qrl + (2 + dd) * 1024) = Bn; } }
  const bf16_t* Vh = Kn + 128;
  const int sr = tid >> 4, sc = (tid & 15) * 8, vst0 = v_st(sr, sc), vst1 = v_st(32 + sr, sc);
  int krow[3], kcc[3];
#pragma unroll
  for (int i = 0; i < 3; ++i) { const int id = tid + 512 * i; krow[i] = id / 24; kcc[i] = id % 24; }
  const int vb0 = (int)(uintptr_t)V_lds + v_rd_base(lane);
  bf16x8 vs0, vs1, ks0, ks1, ks2;
#define KSRC(i, k0) (kcc[i] < 16 ? (Kn + (long)((k0) + krow[i]) * LDKV + kcc[i] * 8) : (Kr + (long)((k0) + krow[i]) * LDKR + (kcc[i] - 16) * 8))
#define SLOAD(k0) do { vs0 = *reinterpret_cast<const bf16x8*>(&Vh[(long)((k0) + sr) * LDKV + sc]); vs1 = *reinterpret_cast<const bf16x8*>(&Vh[(long)((k0) + 32 + sr) * LDKV + sc]); \
    ks0 = *reinterpret_cast<const bf16x8*>(KSRC(0, k0)); ks1 = *reinterpret_cast<const bf16x8*>(KSRC(1, k0)); ks2 = *reinterpret_cast<const bf16x8*>(KSRC(2, k0)); } while (0)
#define SWRITE(b) do { *(bf16x8*)(V_lds + (b) * SHM_V + vst0) = vs0; *(bf16x8*)(V_lds + (b) * SHM_V + vst1) = vs1; \
    *(bf16x8*)(K_lds + (b) * SHM_K + krow[0] * KROWB + kcc[0] * 16) = ks0; *(bf16x8*)(K_lds + (b) * SHM_K + krow[1] * KROWB + kcc[1] * 16) = ks1; \
    *(bf16x8*)(K_lds + (b) * SHM_K + krow[2] * KROWB + kcc[2] * 16) = ks2; } while (0)
#define SWAIT() asm volatile("s_waitcnt vmcnt(0)" ::: "memory")
#define RESC(a) do { if (__any((a) < 1.f)) { if (hi == 0) al_l[r32] = (a); asm volatile("s_waitcnt lgkmcnt(0)" ::: "memory"); \
    _Pragma("unroll") for (int d = 0; d < 4; ++d) _Pragma("unroll") for (int r = 0; r < 16; ++r) o[d][r] *= al_l[crow(r, hi)]; } } while (0)
  f32x16 pA0, pA1; float mnA, alA; bf16x8 pa0, pa1, pa2, pa3; const int NT = seq / KVBLK;
  SLOAD(0); SWAIT(); SWRITE(0); __syncthreads();
  for (int j = 0; j < NT; ++j) {
    const int b = j & 1;
    if (VAR != 4) { if (j + 1 < NT) SLOAD((j + 1) * KVBLK); }
    if (VAR != 3) { SBAR(); qkt(pA0, pA1, K_lds + b * SHM_K, qr, qrl, r32, hi); } else { pA0 = f32x16{}; pA1 = f32x16{}; pA0[0] = (float)j; }
    if (VAR != 2) { partialSM(pA0, pA1, m_reg, mnA, alA);
      RESC(alA);
      finishSM(pA0, pA1, alA, l_reg, pa0, pa1, pa2, pa3); SBAR(); }
    else { u32x4 w0 = {__float_as_uint(pA0[0]), __float_as_uint(pA0[5]), __float_as_uint(pA1[3]), __float_as_uint(pA1[9])}; pa0 = *reinterpret_cast<bf16x8*>(&w0); pa1 = pa0; pa2 = pa0; pa3 = pa0; l_reg += pA0[1]; }
    if (VAR != 1) pv_d0(o, vb0 + b * (int)SHM_V, pa0, pa1, pa2, pa3); else o[0][0] += bf2f((bf16_t)pa0[0]) + bf2f((bf16_t)pa3[7]);
    if (VAR != 4) { if (j + 1 < NT) { SWAIT(); SWRITE(b ^ 1); } }
    __syncthreads();
  }
  if (hi == 0) li_l[r32] = l_reg; asm volatile("s_waitcnt lgkmcnt(0)" ::: "memory");
  float rli[16];
#pragma unroll
  for (int r = 0; r < 16; ++r) rli[r] = __builtin_amdgcn_rcpf(li_l[crow(r, hi)]);
  bf16_t* Ow = Ob + (long)(wid * QBLK) * LDO;
#pragma unroll
  for (int r = 0; r < 16; ++r) { const int orow = crow(r, hi);
#pragma unroll
    for (int d0 = 0; d0 < 4; ++d0) Ow[(long)orow * LDO + d0 * 32 + r32] = f2bf(o[d0][r] * rli[r]); }
#undef KSRC
#undef SLOAD
#undef SWRITE
#undef SWAIT
#undef RESC
}
#undef SBAR
}
typedef const __attribute__((address_space(4))) Args* KArgs;
struct Ctx {
    KArgs a; float* out; unsigned char* ws;
    LAS unsigned char* lds;
    int tid, lane, wave, vcu, G, gw, NGW, bid;
    __device__ __forceinline__ const float* in(int i) const { return a->in[i]; }
};
__device__ __forceinline__ Ctx mk_ctx(unsigned char* lds_raw, int wave_s) {
    Ctx c; KArgs a = (KArgs)__builtin_amdgcn_kernarg_segment_ptr(); asm volatile("" : "+s"(a));
    c.a = a; c.out = a->out; c.ws = a->ws; c.lds = (LAS unsigned char*)lds_raw;
    c.tid = opaque_tid(wave_s); c.lane = c.tid & 63; c.wave = __builtin_amdgcn_readfirstlane(c.tid >> 6);
    c.G = (int)gridDim.x; c.bid = opaque_bid(); c.vcu = (c.G % 8 == 0) ? (c.bid % 8) * (c.G / 8) + c.bid / 8 : c.bid;
    c.gw = c.vcu * NWAVES + c.wave; c.NGW = c.G * NWAVES;
    return c;
}
__device__ __forceinline__ int tok_pos(int t) { return t < TP ? (t & (SP - 1)) : ((t - TP) & (SS - 1)); }

__device__ __forceinline__ void transpose_item(const float* W, int K, int N, bf16_t* WT, LAS float* scr, int item, int lane) {
    const int nblk = N / 32, kb = item / nblk, nb = item % nblk, k0 = 64 * kb, n0 = 32 * nb;
#pragma unroll 8
    for (int i = 0; i < 32; ++i) { const int kk = 2 * i + (lane >> 5); scr[kk * 33 + (lane & 31)] = W[(size_t)(k0 + kk) * N + n0 + (lane & 31)]; }
    LDS_WAIT(); asm volatile("" ::: "memory");
    const int c = lane & 7;
#pragma unroll
    for (int j = 0; j < 4; ++j) { const int n = (lane >> 3) + 8 * j; const LAS float* s = scr + (8 * c) * 33 + n;
        u32x4 o; o.x = cvt_pk_bf16(s[0 * 33], s[1 * 33]); o.y = cvt_pk_bf16(s[2 * 33], s[3 * 33]); o.z = cvt_pk_bf16(s[4 * 33], s[5 * 33]); o.w = cvt_pk_bf16(s[6 * 33], s[7 * 33]);
        *(u32x4*)(WT + (size_t)(n0 + n) * K + k0 + 8 * c) = o; }
    LDS_WAIT(); asm volatile("" ::: "memory");
}
struct MatDesc { int in_idx, K, N, Npad, copies; size_t dst; };
__device__ __forceinline__ void p0_prologue(const Ctx& c) {
    LAS float* scr = (LAS float*)(c.lds + c.wave * 16384);
    const MatDesc MATS[9] = {
        {4, 1024, 704, 768, 2, W_WA}, {7, 384, 1536, 1536, 2, W_WUQ}, {8, 256, 2048, 2048, 2, W_WUKV}, {9, 1024, 1024, 1024, 2, W_WO},
        {10, 1024, 5120, 5120, 2, W_HIN}, {13, 1024, 1024, 1024, 2, W_HO}, {14, 1024, 2048, 2048, 4, W_PQ}, {22, 1024, 1024, 1024, 4, W_GW}, {24, 256, 1024, 1024, 4, W_PP}};
    int total = 0;
#pragma unroll
    for (int m = 0; m < 9; ++m) total += MATS[m].copies * (MATS[m].K / 64) * (MATS[m].N / 32);
    for (int it = c.gw; it < total; it += c.NGW) {
        int r = it;
#pragma unroll
        for (int m = 0; m < 9; ++m) {
            const int per = (MATS[m].K / 64) * (MATS[m].N / 32), cnt = MATS[m].copies * per;
            if (r >= 0 && r < cnt) { const int cp = r / per, item = r % per;
                transpose_item(c.in(MATS[m].in_idx) + (size_t)cp * MATS[m].K * MATS[m].N, MATS[m].K, MATS[m].N,
                               (bf16_t*)(c.ws + MATS[m].dst) + (size_t)cp * MATS[m].Npad * MATS[m].K, scr, item, c.lane);
                r = -1; }
            else if (r >= 0) r -= cnt;
        }
    }
    const int gt = c.gw * 64 + c.lane, NGT = c.NGW * 64;
    for (int i = gt; i < 2 * 64 * 1024 / 8; i += NGT) { const int cp = i / (64 * 1024 / 8), o = i % (64 * 1024 / 8);
        *(u32x4*)((bf16_t*)(c.ws + W_WA) + (size_t)cp * 768 * 1024 + (size_t)704 * 1024 + o * 8) = (u32x4){0u, 0u, 0u, 0u}; }
    for (int i = gt; i < 4 * 2 * 128 * 128 / 4; i += NGT) { const f32x4 v = *(const f32x4*)(c.in(15) + (size_t)i * 4);
        u32x2 w; w.x = cvt_pk_bf16(v[0], v[1]); w.y = cvt_pk_bf16(v[2], v[3]); *(u32x2*)((bf16_t*)(c.ws + W_KEYS) + (size_t)i * 4) = w; }
    for (int i = gt; i < 8192 * 32; i += NGT) { const int pos = i >> 5, f = i & 31;
        const float inv = 1.0f / powf(10000.0f, (float)(2 * f) / 64.0f); const float ang = (float)pos * inv;
        ((float*)(c.ws + WS_ROPE))[i] = cosf(ang); ((float*)(c.ws + WS_ROPE))[8192 * 32 + i] = sinf(ang); }
    for (int i = gt; i < 2 * 1024; i += NGT) { const int dir = i >> 10, k = i & 1023;
        const float l0 = c.in(11)[(dir * 2 + 0) * 1024 + k], l1 = c.in(11)[(dir * 2 + 1) * 1024 + k];
        float* lb = (float*)(c.ws + WS_MISC);
        lb[(0 * 2 + dir) * 1024 + k] = 0.f; lb[(1 * 2 + dir) * 1024 + k] = 1.0f / (1.0f + expf(l0 - l1)); }
    for (int t = c.gw; t < T; t += c.NGW) {
        const float* xr = t < TP ? c.in(0) + (size_t)t * D : c.in(1) + (size_t)(t - TP) * D;
        bf16_t* brow = (bf16_t*)c.out + (size_t)t * D;
#pragma unroll
        for (int j = 0; j < 4; ++j) { const f32x4 v = *(const f32x4*)(xr + 256 * j + 4 * c.lane);
            u32x2 w; w.x = cvt_pk_bf16(v[0], v[1]); w.y = cvt_pk_bf16(v[2], v[3]); *(u32x2*)(brow + 256 * j + 4 * c.lane) = w; }
    }
}

__device__ __forceinline__ void cvt_range(const float* src, bf16_t* dst, size_t n8, int gt, int NGT) {
    for (size_t i = gt; i < n8; i += NGT) { const f32x4 a = *(const f32x4*)(src + i * 8), b = *(const f32x4*)(src + i * 8 + 4);
        u32x4 w; w.x = cvt_pk_bf16(a[0], a[1]); w.y = cvt_pk_bf16(a[2], a[3]); w.z = cvt_pk_bf16(b[0], b[1]); w.w = cvt_pk_bf16(b[2], b[3]); *(u32x4*)(dst + i * 8) = w; }
}
__device__ __forceinline__ void l0_convert(const Ctx& c, int layer) {
    const int gt = c.gw * 64 + c.lane, NGT = c.NGW * 64;
    for (int r = c.gw; r < 2 * NEXP; r += c.NGW) {
        const int m = r >= NEXP, e = r - m * NEXP;
        const float* src = c.in(16 + m) + ((size_t)layer * NEXP + e) * D + 16 * c.lane;
        f32x4 v[4]; float am = 0.f;
#pragma unroll
        for (int j = 0; j < 4; ++j) { v[j] = *(const f32x4*)(src + 4 * j); am = fmaxf(am, fmaxf(fmaxf(fabsf(v[j][0]), fabsf(v[j][1])), fmaxf(fabsf(v[j][2]), fabsf(v[j][3])))); }
        am = wave_max(am);
        const float sc = fmaxf(am, 1e-30f) * (1.0f / 440.0f), inv = 1.0f / sc;
        u32x4 w;
#pragma unroll
        for (int j = 0; j < 4; ++j) { int p = 0; p = __builtin_amdgcn_cvt_pk_fp8_f32(v[j][0] * inv, v[j][1] * inv, p, false); p = __builtin_amdgcn_cvt_pk_fp8_f32(v[j][2] * inv, v[j][3] * inv, p, true); w[j] = (unsigned)p; }
        *(u32x4*)(c.ws + (m ? R2_VB : R2_UB) + (size_t)e * D + 16 * c.lane) = w;
        if (c.lane == 0) ((float*)(c.ws + (m ? R2_SV : R2_SU)))[e] = sc;
    }
    cvt_range(c.in(2) + (size_t)layer * TP * 256, (bf16_t*)(c.ws + R2_PB), (size_t)TP * 256 / 8, gt, NGT);
    cvt_range(c.in(3) + (size_t)layer * TS * 256, (bf16_t*)(c.ws + R2_PB) + (size_t)TP * 256, (size_t)TS * 256 / 8, gt, NGT);
}

__device__ __forceinline__ void mla_e1(const Ctx& c, int j) {
    const bf16_t* a16 = (const bf16_t*)(c.ws + B_A32); bf16_t* cqn = (bf16_t*)(c.ws + B_CQN); bf16_t* ckvn = (bf16_t*)(c.ws + B_CKVN); bf16_t* krope = (bf16_t*)(c.ws + B_KROPE);
    const float* qnw = c.in(5) + j * 384; const float* kvnw = c.in(6) + j * 256;
    const float* cosT = (const float*)(c.ws + WS_ROPE); const float* sinT = cosT + 8192 * 32;
    const int lane = c.lane;
    constexpr int NU = 2;
    LAS float* scr = (LAS float*)(c.lds + c.wave * 1024);
    for (int t0 = c.gw * NU; t0 < T; t0 += c.NGW * NU) {
        f32x4 v0[NU], v1[NU], v2[NU];
#pragma unroll
        for (int u = 0; u < NU; ++u) { const bf16_t* ar = a16 + (size_t)(t0 + u) * 768;
            const u32x2 w0 = *(const u32x2*)(ar + 4 * lane), w1 = *(const u32x2*)(ar + 256 + 4 * lane), w2 = *(const u32x2*)(ar + 512 + 4 * lane);
            v0[u] = (f32x4){bflo(w0.x), bfhi(w0.x), bflo(w0.y), bfhi(w0.y)}; v1[u] = (f32x4){bflo(w1.x), bfhi(w1.x), bflo(w1.y), bfhi(w1.y)}; v2[u] = (f32x4){bflo(w2.x), bfhi(w2.x), bflo(w2.y), bfhi(w2.y)}; }
#pragma unroll
        for (int u = 0; u < NU; ++u) { const int t = t0 + u;
            const float s0 = v0[u][0] * v0[u][0] + v0[u][1] * v0[u][1] + v0[u][2] * v0[u][2] + v0[u][3] * v0[u][3];
            const float s1 = v1[u][0] * v1[u][0] + v1[u][1] * v1[u][1] + v1[u][2] * v1[u][2] + v1[u][3] * v1[u][3];
            const float s2 = v2[u][0] * v2[u][0] + v2[u][1] * v2[u][1] + v2[u][2] * v2[u][2] + v2[u][3] * v2[u][3];
            const float ssq = wave_sum(s0 + (lane < 32 ? s1 : 0.f));
            const float sskv = wave_sum((lane >= 32 ? s1 : 0.f) + (lane < 32 ? s2 : 0.f));
            const float rq = 1.0f / sqrtf(ssq * (1.0f / 384.0f) + RMS_EPS), rkv = 1.0f / sqrtf(sskv * (1.0f / 256.0f) + RMS_EPS);
            { const f32x4 w = *(const f32x4*)(qnw + 4 * lane); u32x2 o; o.x = cvt_pk_bf16(v0[u][0] * rq * w[0], v0[u][1] * rq * w[1]); o.y = cvt_pk_bf16(v0[u][2] * rq * w[2], v0[u][3] * rq * w[3]);
              *(u32x2*)(cqn + (size_t)t * 384 + 4 * lane) = o; }
            if (lane < 32) { const f32x4 w = *(const f32x4*)(qnw + 256 + 4 * lane); u32x2 o; o.x = cvt_pk_bf16(v1[u][0] * rq * w[0], v1[u][1] * rq * w[1]); o.y = cvt_pk_bf16(v1[u][2] * rq * w[2], v1[u][3] * rq * w[3]);
              *(u32x2*)(cqn + (size_t)t * 384 + 256 + 4 * lane) = o; }
            else { const int ix = 4 * (lane - 32); const f32x4 w = *(const f32x4*)(kvnw + ix); u32x2 o; o.x = cvt_pk_bf16(v1[u][0] * rkv * w[0], v1[u][1] * rkv * w[1]); o.y = cvt_pk_bf16(v1[u][2] * rkv * w[2], v1[u][3] * rkv * w[3]);
              *(u32x2*)(ckvn + (size_t)t * 256 + ix) = o; }
            if (lane < 32) { const int ix = 128 + 4 * lane; const f32x4 w = *(const f32x4*)(kvnw + ix); u32x2 o; o.x = cvt_pk_bf16(v2[u][0] * rkv * w[0], v2[u][1] * rkv * w[1]); o.y = cvt_pk_bf16(v2[u][2] * rkv * w[2], v2[u][3] * rkv * w[3]);
              *(u32x2*)(ckvn + (size_t)t * 256 + ix) = o; }
            else if (lane < 48) { *(LAS f32x4*)(scr + 4 * (lane - 32)) = v2[u]; }
            LDS_WAIT(); asm volatile("" ::: "memory");
            if (lane < 32) { const int pos = tok_pos(t); const float a = scr[lane], b = scr[lane + 32], cs = cosT[pos * 32 + lane], sn = sinT[pos * 32 + lane];
                krope[(size_t)t * 64 + lane] = f2bf(a * cs - b * sn); krope[(size_t)t * 64 + 32 + lane] = f2bf(b * cs + a * sn); }
            LDS_WAIT(); asm volatile("" ::: "memory"); }
    }
}
__device__ __forceinline__ void mla_qrope(const Ctx& c) {
    bf16_t* q = (bf16_t*)(c.ws + B_Q);
    const float* cosT = (const float*)(c.ws + WS_ROPE); const float* sinT = cosT + 8192 * 32;
    const int lane = c.lane, i = lane & 31;
    for (int t = c.gw; t < T; t += c.NGW) {
        const int pos = tok_pos(t); const float cs = cosT[pos * 32 + i], sn = sinT[pos * 32 + i];
#pragma unroll
        for (int k = 0; k < 4; ++k) { const int h = (lane >> 5) + 2 * k; bf16_t* p = q + (size_t)t * 1536 + h * 192 + 128 + i;
            const float a = bf2f(p[0]), b = bf2f(p[32]); p[0] = f2bf(a * cs - b * sn); p[32] = f2bf(b * cs + a * sn); }
    }
}
template <int VAR> __device__ __forceinline__ void mla_attention(const Ctx& c) {
    const bf16_t* Q = (const bf16_t*)(c.ws + B_Q); const bf16_t* KV = (const bf16_t*)(c.ws + B_KV); const bf16_t* KR = (const bf16_t*)(c.ws + B_KROPE); bf16_t* O = VAR ? (bf16_t*)c.out + (size_t)T * 1024 : (bf16_t*)(c.ws + B_O);
    const int NU = 512 + 2048;
    for (int u = c.bid; u < NU; u += c.G) {
        int tok0, qb, h, seq;
        if (u < 512) { const int round = u >> 8, cc = u & 255, bh = round * 8 + (cc & 7); tok0 = (bh >> 3) * SP; h = bh & 7; qb = cc >> 3; seq = SP; }
        else { const int us = u - 512, round = us >> 8, cc = us & 255, r = cc >> 3, bh = round * 32 + (cc & 7) * 4 + (r >> 3); tok0 = TP + (bh >> 3) * SS; h = bh & 7; qb = r & 7; seq = SS; }
        attn::attn_body<VAR>(Q + (size_t)(tok0 + qb * 256) * 1536 + h * 192, KV + (size_t)tok0 * 2048 + h * 256, KR + (size_t)tok0 * 64,
                        O + (size_t)(tok0 + qb * 256) * 1024 + h * 128, seq, (char*)c.lds, c.tid, qb * 256, (const float*)(c.ws + WS_ROPE));
        __syncthreads();
    }
}
template <int NU, bool W8> __device__ __forceinline__ void ln_rows(f32x4 (&v)[NU][4], const float* g, const float* b, int lane, bf16_t* const (&dst)[NU], unsigned char* const (&dst8)[NU], float* const (&dsc)[NU]) {
    float s[NU], s2[NU];
#pragma unroll
    for (int u = 0; u < NU; ++u) { s[u] = 0.f;
#pragma unroll
        for (int j = 0; j < 4; ++j) s[u] += (v[u][j][0] + v[u][j][1]) + (v[u][j][2] + v[u][j][3]); }
#pragma unroll
    for (int u = 0; u < NU; ++u) s[u] = wave_sum(s[u]) * (1.0f / D);
#pragma unroll
    for (int u = 0; u < NU; ++u) { s2[u] = 0.f;
#pragma unroll
        for (int j = 0; j < 4; ++j) { v[u][j] = v[u][j] - s[u]; s2[u] += (v[u][j][0] * v[u][j][0] + v[u][j][1] * v[u][j][1]) + (v[u][j][2] * v[u][j][2] + v[u][j][3] * v[u][j][3]); } }
#pragma unroll
    for (int u = 0; u < NU; ++u) s2[u] = 1.0f / sqrtf(wave_sum(s2[u]) * (1.0f / D) + LN_EPS);
    float am[NU];
#pragma unroll
    for (int u = 0; u < NU; ++u) am[u] = 0.f;
#pragma unroll
    for (int j = 0; j < 4; ++j) { const f32x4 gg = *(const f32x4*)(g + 256 * j + 4 * lane), bb = *(const f32x4*)(b + 256 * j + 4 * lane);
#pragma unroll
        for (int u = 0; u < NU; ++u) { const f32x4 o = v[u][j] * s2[u] * gg + bb; u32x2 w; w.x = cvt_pk_bf16(o[0], o[1]); w.y = cvt_pk_bf16(o[2], o[3]); *(u32x2*)(dst[u] + 256 * j + 4 * lane) = w;
            if (W8) { v[u][j] = o; am[u] = fmaxf(am[u], fmaxf(fmaxf(fabsf(o[0]), fabsf(o[1])), fmaxf(fabsf(o[2]), fabsf(o[3])))); } } }
    if (W8) {
#pragma unroll
        for (int u = 0; u < NU; ++u) { const float mx = fmaxf(wave_max(am[u]), 1e-20f), inv = 240.0f / mx;
#pragma unroll
            for (int j = 0; j < 4; ++j) { int q = 0; q = __builtin_amdgcn_cvt_pk_fp8_f32(v[u][j][0] * inv, v[u][j][1] * inv, q, false); q = __builtin_amdgcn_cvt_pk_fp8_f32(v[u][j][2] * inv, v[u][j][3] * inv, q, true);
                *(unsigned*)(dst8[u] + 256 * j + 4 * lane) = (unsigned)q; }
            if (lane == 0) *dsc[u] = mx * (1.0f / 240.0f); }
    }
}
__device__ __forceinline__ void ln_residual(const Ctx& c, const bf16_t* hb, const float* g, const float* b) {
    const bf16_t* xm = (const bf16_t*)c.out; bf16_t* xa = (bf16_t*)(c.ws + WS_XB); const int lane = c.lane;
    constexpr int NU = 4;
    for (int t0 = c.gw * NU; t0 < T; t0 += c.NGW * NU) {
        f32x4 v[NU][4]; bf16_t* dst[NU]; unsigned char* dst8[NU]; float* dsc[NU];
#pragma unroll
        for (int u = 0; u < NU; ++u) { const bf16_t* xr = xm + (size_t)(t0 + u) * D; const bf16_t* hr = hb + (size_t)(t0 + u) * D; dst[u] = xa + (size_t)(t0 + u) * D;
            dst8[u] = c.ws + B_X8 + (size_t)(t0 + u) * D; dsc[u] = (float*)(c.ws + B_XS) + (t0 + u);
#pragma unroll
            for (int j = 0; j < 4; ++j) { const u32x2 xw = *(const u32x2*)(xr + 256 * j + 4 * lane), hw = *(const u32x2*)(hr + 256 * j + 4 * lane);
                v[u][j] = (f32x4){bflo(xw.x), bfhi(xw.x), bflo(xw.y), bfhi(xw.y)} * DN_ALPHA + (f32x4){bflo(hw.x), bfhi(hw.x), bflo(hw.y), bfhi(hw.y)}; } }
        ln_rows<NU, false>(v, g, b, lane, dst, dst8, dsc);
    }
}
__device__ __forceinline__ void hgrn_post(const Ctx& c, int j) {
    bf16_t* pl = (bf16_t*)(c.ws + B_PLANE); const size_t PE = (size_t)T * 1024;
    const bf16_t* of = pl + 1 * PE; const bf16_t* ob = pl + 2 * PE; const bf16_t* sg = pl + 4 * PE; bf16_t* on = pl;
    const float* nw = c.in(12) + j * 128; const int lane = c.lane;
    const int cw = (8 * lane) & 127; const f32x4 w0 = *(const f32x4*)(nw + cw), w1 = *(const f32x4*)(nw + cw + 4);
    constexpr int NU = 4;
    for (int t0 = c.gw * NU; t0 < T; t0 += c.NGW * NU) {
        u32x4 a[NU][2], b[NU][2], g[NU][2];
#pragma unroll
        for (int u = 0; u < NU; ++u)
#pragma unroll
            for (int k = 0; k < 2; ++k) { const size_t off = (size_t)(t0 + u) * 1024 + 512 * k + 8 * lane;
                a[u][k] = *(const u32x4*)(of + off); b[u][k] = *(const u32x4*)(ob + off); g[u][k] = *(const u32x4*)(sg + off); }
#pragma unroll
        for (int u = 0; u < NU; ++u)
#pragma unroll
            for (int k = 0; k < 2; ++k) { const size_t off = (size_t)(t0 + u) * 1024 + 512 * k + 8 * lane;
                float o[8], gg[8]; float ss = 0.f;
#pragma unroll
                for (int q = 0; q < 4; ++q) { o[2 * q] = bflo(a[u][k][q]) + bflo(b[u][k][q]); o[2 * q + 1] = bfhi(a[u][k][q]) + bfhi(b[u][k][q]); gg[2 * q] = bflo(g[u][k][q]); gg[2 * q + 1] = bfhi(g[u][k][q]); }
#pragma unroll
                for (int e = 0; e < 8; ++e) ss += o[e] * o[e];
                ss = row16_sum(ss);
                const float r = 1.0f / sqrtf(ss * (1.0f / 128.0f) + RMS_EPS);
                u32x4 w; w.x = cvt_pk_bf16(o[0] * r * w0[0] * gg[0], o[1] * r * w0[1] * gg[1]); w.y = cvt_pk_bf16(o[2] * r * w0[2] * gg[2], o[3] * r * w0[3] * gg[3]);
                w.z = cvt_pk_bf16(o[4] * r * w1[0] * gg[4], o[5] * r * w1[1] * gg[5]); w.w = cvt_pk_bf16(o[6] * r * w1[2] * gg[6], o[7] * r * w1[3] * gg[7]);
                *(u32x4*)(on + off) = w; }
    }
}
namespace scan {
constexpr size_t D_F = R2_IDX, D_B = R2_IDX + 12 * MiB;
constexpr int NCH = T / 32;
__device__ __forceinline__ void hgrn_prep(const Ctx& c, int dup) {
    bf16_t* pl = (bf16_t*)(c.ws + B_PLANE); const size_t PE = (size_t)T * 1024;
    bf16_t* qs = pl; bf16_t* lff = pl + PE; bf16_t* lfb = pl + 2 * PE; bf16_t* qtb = (bf16_t*)(c.ws + WS_XB);
    float* dF = (float*)(c.ws + D_F); float* dB = (float*)(c.ws + D_B);
    const int lane = c.lane;
#define PREP_STEP(LW, QW, QDST, KDST, R0, R1) { const unsigned lw = (LW), qw = (QW); const float l0 = bflo(lw), l1 = bfhi(lw); R0 += l0; R1 += l1; \
        const float k0 = 1.0f - fast_exp(l0), k1 = 1.0f - fast_exp(l1); \
        *(unsigned*)(QDST) = cvt_pk_bf16(bflo(qw) * fast_exp(R0), bfhi(qw) * fast_exp(R1)); \
        *(unsigned*)(KDST) = cvt_pk_bf16(k0 * fast_exp(fminf(-R0, 80.f)), k1 * fast_exp(fminf(-R1, 80.f))); }
    const char* qsB = (const char*)qs; const char* lffB = (const char*)lff; const char* lfbB = (const char*)lfb; const char* qtbB = (const char*)qtb;
    char* dmy = (char*)((bf16_t*)c.out + (size_t)T * 1024);
    char* qsW = dup ? dmy : (char*)qs; char* lffW = dup ? dmy : (char*)lff; char* lfbW = dup ? dmy : (char*)lfb; char* qtbW = dup ? dmy : (char*)qtb;
    if (dup) { dF = (float*)dmy; dB = (float*)dmy; }
    for (int it = c.gw; it < NCH * 8; it += c.NGW) {
        const int chunk = it >> 3, h = it & 7; const unsigned base = ((unsigned)chunk * 32u * 1024u + (unsigned)h * 128u + 2u * (unsigned)lane) * 2u;
        float b0 = 0.f, b1 = 0.f, f0 = 0.f, f1 = 0.f;
#define LDW(P, O) (*(const unsigned*)((P) + (O)))
#define STP(P, O) ((unsigned*)((char*)(P) + (O)))
        { unsigned wb[16], wq[16];
#pragma unroll
          for (int i = 0; i < 16; ++i) { const unsigned o = base + (unsigned)(16 + i) * 2048u; wb[i] = LDW(lfbB, o); wq[i] = LDW(qsB, o); }
#pragma unroll
          for (int i = 15; i >= 0; --i) { const unsigned o = base + (unsigned)(16 + i) * 2048u; PREP_STEP(wb[i], wq[i], STP(qtbW, o), STP(lfbW, o), b0, b1) } }
        { unsigned wb[16], wq[16], wf[16];
#pragma unroll
          for (int i = 0; i < 16; ++i) { const unsigned o = base + (unsigned)i * 2048u; wb[i] = LDW(lfbB, o); wq[i] = LDW(qsB, o); wf[i] = LDW(lffB, o); }
#pragma unroll
          for (int i = 15; i >= 0; --i) { const unsigned o = base + (unsigned)i * 2048u; PREP_STEP(wb[i], wq[i], STP(qtbW, o), STP(lfbW, o), b0, b1) }
          *(f32x2*)(dB + (size_t)chunk * 1024 + h * 128 + 2 * lane) = (f32x2){fast_exp(b0), fast_exp(b1)};
#pragma unroll
          for (int i = 0; i < 16; ++i) { const unsigned o = base + (unsigned)i * 2048u; PREP_STEP(wf[i], wq[i], STP(qsW, o), STP(lffW, o), f0, f1) } }
        { unsigned wf[16], wq[16];
#pragma unroll
          for (int i = 0; i < 16; ++i) { const unsigned o = base + (unsigned)(16 + i) * 2048u; wf[i] = LDW(lffB, o); wq[i] = LDW(qsB, o); }
#pragma unroll
          for (int i = 0; i < 16; ++i) { const unsigned o = base + (unsigned)(16 + i) * 2048u; PREP_STEP(wf[i], wq[i], STP(qsW, o), STP(lffW, o), f0, f1) }
          *(f32x2*)(dF + (size_t)chunk * 1024 + h * 128 + 2 * lane) = (f32x2){fast_exp(f0), fast_exp(f1)}; }
    }
#undef LDW
#undef STP
#undef PREP_STEP
}

constexpr int QT_OFF = 0, KT_OFF = 8192, V_OFF = 16384, P_OFF = 24576, ST_OFF = 34816, DV_OFF = 69632, CHAIN_BYTES = 70144;
constexpr int RS = 272, RS2 = 80;
__device__ __forceinline__ int crow(int r, int hi) { return (r & 3) + 8 * (r >> 2) + 4 * hi; }
__device__ __forceinline__ unsigned off_b(unsigned row, unsigned ch) { return 256u * row + 16u * (ch ^ (((row & 3) << 2) | ((row >> 2) & 3))); }
__device__ __forceinline__ unsigned row_read_addr(unsigned lane, unsigned s) { return off_b(lane & 31, 2 * s + (lane >> 5)); }
__device__ __forceinline__ unsigned tr_read_addr(unsigned lane, unsigned cc, unsigned ks, unsigned t) {
    const unsigned h = lane >> 5, blk = (lane >> 4) & 1, q = (lane & 15) >> 2, p = lane & 3;
    return off_b(16 * ks + 8 * h + 4 * t + q, 4 * cc + 2 * blk + (p >> 1)) + 8 * (p & 1);
}
__device__ __forceinline__ s16x4 tr_rd(unsigned addr) { s16x4 r; asm volatile("ds_read_b64_tr_b16 %0, %1" : "=&v"(r) : "v"(addr) : "memory"); return r; }
#define TRPK(L, H) (bf16x8){L[0], L[1], L[2], L[3], H[0], H[1], H[2], H[3]}

__device__ __forceinline__ void run_pair(const Ctx& c, int tok0, int L, int h, int dirsel, bool dummy) {
    bf16_t* pl = (bf16_t*)(c.ws + B_PLANE); const size_t PE = (size_t)T * 1024;
    const int tid = c.tid, lane = c.lane, wave = c.wave, ch = dirsel < 0 ? (wave >> 2) : dirsel, w = wave & 3, r32 = lane & 31, hi = lane >> 5;
    const bool active = dirsel < 0 || wave < 4;
    const int NCs = L / 32;
    if (!active) { __syncthreads(); for (int ci = 0; ci < NCs; ++ci) { __syncthreads(); __syncthreads(); } return; }
    const bf16_t* qt = ch ? (const bf16_t*)(c.ws + WS_XB) : pl; bf16_t* kt = pl + (size_t)(1 + ch) * PE; const bf16_t* vv = pl + 3 * PE;
    const float* dd = (const float*)(c.ws + (ch ? D_B : D_F));
    bf16_t* odst = dummy ? (bf16_t*)c.out + (size_t)T * 1024 : kt;
    LAS unsigned char* base = c.lds + (wave >> 2) * CHAIN_BYTES;
    const unsigned lbase = (unsigned)(uintptr_t)base;
    const int ctid = tid & 255;
    const int NC = L / 32;
    const int vcol = 32 * w + r32;
    LAS unsigned char* Pw = base + P_OFF + w * 2560;
    const int s_r0 = ctid >> 4, s_chn = ctid & 15;
    u32x4 sreg[6]; f32x4 dreg = (f32x4){0.f, 0.f, 0.f, 0.f};
#define SCAN_LOAD(cidx) do { const size_t rowb = (size_t)(tok0 + 32 * (cidx)) * 1024 + h * 128; \
        _Pragma("unroll") for (int i = 0; i < 6; ++i) { const bf16_t* src = ((i >> 1) == 0 ? qt : ((i >> 1) == 1 ? (const bf16_t*)kt : vv)) + rowb + (size_t)(s_r0 + 16 * (i & 1)) * 1024 + s_chn * 8; sreg[i] = *(const u32x4*)src; } \
        if (ctid < 32) dreg = *(const f32x4*)(dd + (size_t)((tok0 >> 5) + (cidx)) * 1024 + h * 128 + 4 * ctid); } while (0)
#define SCAN_WRITE() do { _Pragma("unroll") for (int i = 0; i < 6; ++i) *(LAS u32x4*)(base + (i >> 1) * 8192 + off_b(s_r0 + 16 * (i & 1), s_chn)) = sreg[i]; \
        if (ctid < 32) *(LAS f32x4*)(base + DV_OFF + 16 * ctid) = dreg; } while (0)
    { LAS u32x4* st = (LAS u32x4*)(base + ST_OFF + (32 * w) * RS); for (int i = lane; i < 32 * RS / 16; i += 64) st[i] = (u32x4){0u, 0u, 0u, 0u}; }
    f32x16 S[4];
#pragma unroll
    for (int kt2 = 0; kt2 < 4; ++kt2) S[kt2] = f32x16{};
    SCAN_LOAD(ch ? NC - 1 : 0); SCAN_WRITE();
    __syncthreads();
    for (int ci = 0; ci < NC; ++ci) {
        const int cidx = ch ? NC - 1 - ci : ci;
        if (ci + 1 < NC) SCAN_LOAD(ch ? cidx - 1 : cidx + 1);
        f32x16 X = f32x16{};
#pragma unroll
        for (int ks = 0; ks < 8; ++ks) { const bf16x8 qa = *(const LAS bf16x8*)(base + QT_OFF + row_read_addr(lane, ks));
            const bf16x8 kb = *(const LAS bf16x8*)(base + KT_OFF + row_read_addr(lane, ks));
            X = __builtin_amdgcn_mfma_f32_32x32x16_bf16(qa, kb, X, 0, 0, 0); }
#pragma unroll
        for (int r = 0; r < 16; ++r) { const int t = crow(r, hi); const bool keep = ch ? (t <= r32) : (t >= r32); *(LAS bf16_t*)(Pw + t * RS2 + r32 * 2) = f2bf(keep ? X[r] : 0.f); }
        s16x4 vl[2], vh[2];
#pragma unroll
        for (int ks = 0; ks < 2; ++ks) { vl[ks] = tr_rd(lbase + V_OFF + tr_read_addr(lane, w, ks, 0)); vh[ks] = tr_rd(lbase + V_OFF + tr_read_addr(lane, w, ks, 1)); }
        asm volatile("s_waitcnt lgkmcnt(0)" ::: "memory"); __builtin_amdgcn_sched_barrier(0);
        bf16x8 vb[2];
#pragma unroll
        for (int ks = 0; ks < 2; ++ks) vb[ks] = TRPK(vl[ks], vh[ks]);
        f32x16 O = f32x16{};
#pragma unroll
        for (int ks = 0; ks < 2; ++ks) { const bf16x8 pa = *(const LAS bf16x8*)(Pw + r32 * RS2 + (16 * ks + 8 * hi) * 2);
            O = __builtin_amdgcn_mfma_f32_32x32x16_bf16(pa, vb[ks], O, 0, 0, 0); }
#pragma unroll
        for (int ks = 0; ks < 8; ++ks) { const bf16x8 sb = *(const LAS bf16x8*)(base + ST_OFF + vcol * RS + (16 * ks + 8 * hi) * 2);
            const bf16x8 qa = *(const LAS bf16x8*)(base + QT_OFF + row_read_addr(lane, ks));
            O = __builtin_amdgcn_mfma_f32_32x32x16_bf16(qa, sb, O, 0, 0, 0); }
#pragma unroll
        for (int r = 0; r < 16; ++r) { const int t = tok0 + 32 * cidx + crow(r, hi); odst[(size_t)t * 1024 + h * 128 + vcol] = f2bf(O[r]); }
#pragma unroll
        for (int kt2 = 0; kt2 < 4; ++kt2) {
            s16x4 al[2], ah[2];
#pragma unroll
            for (int ks = 0; ks < 2; ++ks) { al[ks] = tr_rd(lbase + KT_OFF + tr_read_addr(lane, kt2, ks, 0)); ah[ks] = tr_rd(lbase + KT_OFF + tr_read_addr(lane, kt2, ks, 1)); }
            asm volatile("s_waitcnt lgkmcnt(0)" ::: "memory"); __builtin_amdgcn_sched_barrier(0);
#pragma unroll
            for (int ks = 0; ks < 2; ++ks) S[kt2] = __builtin_amdgcn_mfma_f32_32x32x16_bf16(TRPK(al[ks], ah[ks]), vb[ks], S[kt2], 0, 0, 0);
#pragma unroll
            for (int g = 0; g < 4; ++g) { const f32x4 d4 = *(const LAS f32x4*)(base + DV_OFF + (32 * kt2 + 8 * g + 4 * hi) * 4);
#pragma unroll
                for (int e = 0; e < 4; ++e) S[kt2][4 * g + e] *= d4[e];
                u32x2 pk; pk.x = cvt_pk_bf16(S[kt2][4 * g], S[kt2][4 * g + 1]); pk.y = cvt_pk_bf16(S[kt2][4 * g + 2], S[kt2][4 * g + 3]);
                *(LAS u32x2*)(base + ST_OFF + vcol * RS + (32 * kt2 + 8 * g + 4 * hi) * 2) = pk; }
        }
        __syncthreads();
        if (ci + 1 < NC) SCAN_WRITE();
        __syncthreads();
    }
#undef SCAN_LOAD
#undef SCAN_WRITE
}
#undef TRPK
__device__ __forceinline__ void hgrn_scan(const Ctx& c, bool dummy) {
    const int NI = 32 + 256;
    for (int rnd = 0;; ++rnd) {
        if (rnd * c.G >= NI) break;
        const int it = (rnd & 1) ? (rnd * c.G + (c.G - 1 - c.bid)) : (rnd * c.G + c.bid);
        if (it < NI) {
            const bool pr = it < 32;
            run_pair(c, pr ? (it >> 4) * SP : TP + ((it - 32) >> 3) * SS, pr ? SP : SS, pr ? ((it >> 1) & 7) : ((it - 32) & 7), pr ? (it & 1) : -1, dummy);
        }
    }
}
}
#define CE_(a, i, j) { const unsigned _x = a[i] > a[j] ? a[i] : a[j], _y = a[i] > a[j] ? a[j] : a[i]; a[i] = _x; a[j] = _y; }
__device__ __forceinline__ void sort16_desc(unsigned (&a)[16]) {
    CE_(a, 0, 1) CE_(a, 2, 3) CE_(a, 0, 2) CE_(a, 1, 3) CE_(a, 1, 2) CE_(a, 4, 5) CE_(a, 6, 7) CE_(a, 4, 6) CE_(a, 5, 7) CE_(a, 5, 6) CE_(a, 0, 4) CE_(a, 2, 6) CE_(a, 2, 4) CE_(a, 1, 5) CE_(a, 3, 7) CE_(a, 3, 5) CE_(a, 1, 2) CE_(a, 3, 4) CE_(a, 5, 6) CE_(a, 8, 9) CE_(a, 10, 11) CE_(a, 8, 10) CE_(a, 9, 11) CE_(a, 9, 10) CE_(a, 12, 13) CE_(a, 14, 15) CE_(a, 12, 14) CE_(a, 13, 15) CE_(a, 13, 14) CE_(a, 8, 12) CE_(a, 10, 14) CE_(a, 10, 12) CE_(a, 9, 13) CE_(a, 11, 15) CE_(a, 11, 13) CE_(a, 9, 10) CE_(a, 11, 12) CE_(a, 13, 14) CE_(a, 0, 8) CE_(a, 4, 12) CE_(a, 4, 8) CE_(a, 2, 10) CE_(a, 6, 14) CE_(a, 6, 10) CE_(a, 2, 4) CE_(a, 6, 8) CE_(a, 10, 12) CE_(a, 1, 9) CE_(a, 5, 13) CE_(a, 5, 9) CE_(a, 3, 11) CE_(a, 7, 15) CE_(a, 7, 11) CE_(a, 3, 5) CE_(a, 7, 9) CE_(a, 11, 13) CE_(a, 1, 2) CE_(a, 3, 4) CE_(a, 5, 6) CE_(a, 7, 8) CE_(a, 9, 10) CE_(a, 11, 12) CE_(a, 13, 14)
}
__device__ __forceinline__ void merge16_top(unsigned (&a)[16], const unsigned (&b)[16]) {
    a[0] = a[0] > b[15] ? a[0] : b[15]; a[1] = a[1] > b[14] ? a[1] : b[14]; a[2] = a[2] > b[13] ? a[2] : b[13]; a[3] = a[3] > b[12] ? a[3] : b[12]; a[4] = a[4] > b[11] ? a[4] : b[11]; a[5] = a[5] > b[10] ? a[5] : b[10]; a[6] = a[6] > b[9] ? a[6] : b[9]; a[7] = a[7] > b[8] ? a[7] : b[8]; a[8] = a[8] > b[7] ? a[8] : b[7]; a[9] = a[9] > b[6] ? a[9] : b[6]; a[10] = a[10] > b[5] ? a[10] : b[5]; a[11] = a[11] > b[4] ? a[11] : b[4]; a[12] = a[12] > b[3] ? a[12] : b[3]; a[13] = a[13] > b[2] ? a[13] : b[2]; a[14] = a[14] > b[1] ? a[14] : b[1]; a[15] = a[15] > b[0] ? a[15] : b[0];
    CE_(a, 0, 8) CE_(a, 1, 9) CE_(a, 2, 10) CE_(a, 3, 11) CE_(a, 4, 12) CE_(a, 5, 13) CE_(a, 6, 14) CE_(a, 7, 15) CE_(a, 0, 4) CE_(a, 1, 5) CE_(a, 2, 6) CE_(a, 3, 7) CE_(a, 8, 12) CE_(a, 9, 13) CE_(a, 10, 14) CE_(a, 11, 15) CE_(a, 0, 2) CE_(a, 1, 3) CE_(a, 4, 6) CE_(a, 5, 7) CE_(a, 8, 10) CE_(a, 9, 11) CE_(a, 12, 14) CE_(a, 13, 15) CE_(a, 0, 1) CE_(a, 2, 3) CE_(a, 4, 5) CE_(a, 6, 7) CE_(a, 8, 9) CE_(a, 10, 11) CE_(a, 12, 13) CE_(a, 14, 15)
}
namespace peer {
constexpr int KEY_RS = 272;
constexpr int KEYS_BYTES = 2 * 128 * KEY_RS;
constexpr int SI_OFF = KEYS_BYTES;
__device__ __forceinline__ int crow(int r, int hi) { return (r & 3) + 8 * (r >> 2) + 4 * hi; }
__device__ __forceinline__ unsigned sortable(float f) { const unsigned u = __float_as_uint(f); return u ^ ((u >> 31) ? 0xFFFFFFFFu : 0x80000000u); }
__device__ __forceinline__ float unsortable(unsigned s) { const unsigned u = (s >> 31) ? (s ^ 0x80000000u) : ~s; return __uint_as_float(u); }
__device__ __forceinline__ unsigned pair_max(unsigned m) { auto rr = __builtin_amdgcn_permlane32_swap(m, m, false, false); return rr[0] > rr[1] ? rr[0] : rr[1]; }

__device__ __forceinline__ void top16_half(const Ctx& c, const bf16_t* pq_rows, int half, LAS unsigned char* keys, unsigned (&sel)[16]) {
    const int lane = c.lane, r32 = lane & 31, hi = lane >> 5;
    f32x16 acc[4];
#pragma unroll
    for (int nt = 0; nt < 4; ++nt) acc[nt] = f32x16{};
    const bf16_t* qrow = pq_rows + (size_t)r32 * 256 + half * 128;
    bf16x8 qb[8];
#pragma unroll
    for (int ks = 0; ks < 8; ++ks) qb[ks] = *reinterpret_cast<const bf16x8*>(qrow + 16 * ks + 8 * hi);
#pragma unroll
    for (int ks = 0; ks < 8; ++ks) {
#pragma unroll
        for (int nt = 0; nt < 4; ++nt) { const bf16x8 ka = *(const LAS bf16x8*)(keys + (half * 128 + 32 * nt + r32) * KEY_RS + (16 * ks + 8 * hi) * 2);
            acc[nt] = __builtin_amdgcn_mfma_f32_32x32x16_bf16(ka, qb[ks], acc[nt], 0, 0, 0); }
        if (ks & 1) __builtin_amdgcn_sched_barrier(0); }
    unsigned p[64];
#pragma unroll
    for (int nt = 0; nt < 4; ++nt)
#pragma unroll
        for (int r = 0; r < 16; ++r) { const int n = 32 * nt + crow(r, hi); p[nt * 16 + r] = (sortable(acc[nt][r]) & ~127u) | (unsigned)(127 - n); }
    unsigned g0[16], g1[16], g2[16], g3[16];
#pragma unroll
    for (int i = 0; i < 16; ++i) { g0[i] = p[i]; g1[i] = p[16 + i]; g2[i] = p[32 + i]; g3[i] = p[48 + i]; }
    sort16_desc(g0); sort16_desc(g1); sort16_desc(g2); sort16_desc(g3);
    merge16_top(g0, g1); merge16_top(g2, g3); merge16_top(g0, g2);
    unsigned pb[16];
#pragma unroll
    for (int i = 0; i < 16; ++i) { auto rr = __builtin_amdgcn_permlane32_swap(g0[i], g0[i], false, false); sel[i] = rr[0]; pb[i] = rr[1]; }
    merge16_top(sel, pb);
}
__device__ __forceinline__ void route(const Ctx& c, int layer) {
    const bf16_t* pq = (const bf16_t*)(c.ws + B_PQ); unsigned short* idx_out = (unsigned short*)(c.ws + R2_IDX); float* gate_out = (float*)(c.ws + R2_GATE);
    const bf16_t* keys_g = (const bf16_t*)(c.ws + W_KEYS) + (size_t)layer * 2 * 128 * 128;
    LAS unsigned char* keys = c.lds;
    const int lane = c.lane, r32 = lane & 31, hi = lane >> 5;
    for (int i = c.tid; i < 2 * 128 * 16; i += NTHR) { const int row = i >> 4, ch = i & 15; *(LAS u32x4*)(keys + row * KEY_RS + ch * 16) = *(const u32x4*)(keys_g + (size_t)row * 128 + ch * 8); }
    __syncthreads();
    LAS int* si = (LAS int*)(c.lds + SI_OFF + c.wave * 4096) + r32 * 32;
    for (int grp = c.gw; grp < T / 4; grp += c.NGW) {
        const bf16_t* rows = pq + (size_t)grp * 4 * 2048;
        unsigned s1[16], s2[16];
        top16_half(c, rows, 0, keys, s1);
        top16_half(c, rows, 1, keys, s2);
        float v1[16], v2[16];
#pragma unroll
        for (int i = 0; i < 16; ++i) { v1[i] = unsortable(s1[i] & ~127u); v2[i] = unsortable(s2[i] & ~127u); }
        if (hi == 0) {
#pragma unroll
            for (int i = 0; i < 16; ++i) { si[i] = 127 - (int)(s1[i] & 127u); si[16 + i] = 127 - (int)(s2[i] & 127u); }
        }
        float A[16], B[16];
#pragma unroll
        for (int i = 0; i < 16; ++i) { A[i] = hi ? v2[i] : v1[i]; B[i] = hi ? v1[i] : v2[i]; }
        unsigned cd[27]; int nc = 0;
#pragma unroll
        for (int i = 0; i < 16; ++i)
#pragma unroll
            for (int j = i; j < 16; ++j) if ((i + 1) * (j + 1) <= 16) {
                const unsigned flat = hi ? (unsigned)(j * 16 + i) : (unsigned)(i * 16 + j);
                unsigned pk = (sortable(A[i] + B[j]) & ~255u) | (255u - flat);
                if (i == j) pk = hi ? 0u : pk;
                cd[nc++] = pk; }
        unsigned sel[16], c1[16], pb[16];
#pragma unroll
        for (int i = 0; i < 16; ++i) { sel[i] = cd[i]; c1[i] = (16 + i < 27) ? cd[(16 + i < 27) ? 16 + i : 0] : 0u; }
        sort16_desc(sel); sort16_desc(c1); merge16_top(sel, c1);
#pragma unroll
        for (int i = 0; i < 16; ++i) { auto rr = __builtin_amdgcn_permlane32_swap(sel[i], sel[i], false, false); sel[i] = rr[0]; pb[i] = rr[1]; }
        merge16_top(sel, pb);
        LDS_WAIT(); asm volatile("" ::: "memory");
        const float vmax = unsortable(sel[0] & ~255u);
        float e[16], es = 0.f;
#pragma unroll
        for (int i = 0; i < 16; ++i) { e[i] = fast_exp(unsortable(sel[i] & ~255u) - vmax); es += e[i]; }
        const float inv = 1.0f / es;
        const size_t obase = ((size_t)grp * 4 + (r32 >> 3)) * 128 + (r32 & 7) * 16 + 8 * hi;
        int oi[8]; float og[8];
#pragma unroll
        for (int q = 0; q < 8; ++q) { const unsigned sv = hi ? sel[8 + q] : sel[q]; const float ev = hi ? e[8 + q] : e[q];
            const int flat = 255 - (int)(sv & 255u); oi[q] = si[flat >> 4] * 128 + si[16 + (flat & 15)]; og[q] = ev * inv; }
        *(u32x4*)(idx_out + obase) = (u32x4){(unsigned)oi[0] | ((unsigned)oi[1] << 16), (unsigned)oi[2] | ((unsigned)oi[3] << 16), (unsigned)oi[4] | ((unsigned)oi[5] << 16), (unsigned)oi[6] | ((unsigned)oi[7] << 16)};
        *(f32x4*)(gate_out + obase) = (f32x4){og[0], og[1], og[2], og[3]};
        *(f32x4*)(gate_out + obase + 4) = (f32x4){og[4], og[5], og[6], og[7]};
        LDS_WAIT(); asm volatile("" ::: "memory");
    }
    __syncthreads();
}

__device__ __forceinline__ float gelu_exact(float x) { return 0.5f * x * (1.0f + erff(x * 0.70710678118654752f)); }
template <int IDXMASK> __device__ __forceinline__ void gather_ln(const Ctx& c, int layer, float* xout, bf16_t* xb) {
    const unsigned char* U8 = c.ws + R2_UB; const unsigned char* V8 = c.ws + R2_VB;
    const float* su = (const float*)(c.ws + R2_SU); const float* sv = (const float*)(c.ws + R2_SV);
    const int* idx = (const int*)(c.ws + R2_IDX); const float* gate = (const float*)(c.ws + R2_GATE);
    const float* lg = c.in(20) + layer * D; const float* lbv = c.in(21) + layer * D;
    const int lane = c.lane;
    for (int t = c.gw; t < T; t += c.NGW) {
        const float* xr = c.out + (size_t)t * D + 16 * lane; float* xw = xout + (size_t)t * D + 16 * lane;
        float x[16], acc[16];
#pragma unroll
        for (int j = 0; j < 4; ++j) { const f32x4 a = *(const f32x4*)(xr + 4 * j); x[4 * j] = a[0]; x[4 * j + 1] = a[1]; x[4 * j + 2] = a[2]; x[4 * j + 3] = a[3]; }
#pragma unroll
        for (int e = 0; e < 16; ++e) acc[e] = 0.f;
        const int myidx0 = idx[(size_t)t * 128 + lane] & IDXMASK, myidx1 = idx[(size_t)t * 128 + 64 + lane] & IDXMASK;
        const float myg0 = gate[(size_t)t * 128 + lane], myg1 = gate[(size_t)t * 128 + 64 + lane];
        for (int eb = 0; eb < 128; eb += 8) {
            float part[8]; int ei[8];
#pragma unroll
            for (int q = 0; q < 8; ++q) { const int e = eb + q; ei[q] = __builtin_amdgcn_readlane(e < 64 ? myidx0 : myidx1, e & 63); }
            u32x4 vr[8];
#pragma unroll
            for (int q = 0; q < 8; ++q) vr[q] = *(const u32x4*)(V8 + (size_t)ei[q] * D + 16 * lane);
#pragma unroll
            for (int q = 0; q < 8; ++q) { const u32x4 a = *(const u32x4*)(U8 + (size_t)ei[q] * D + 16 * lane);
                float s = 0.f;
#pragma unroll
                for (int j = 0; j < 4; ++j) { const f32x2 lo = __builtin_amdgcn_cvt_pk_f32_fp8((int)a[j], false), hi = __builtin_amdgcn_cvt_pk_f32_fp8((int)a[j], true);
                    s = fmaf(lo[0], x[4 * j], s); s = fmaf(lo[1], x[4 * j + 1], s); s = fmaf(hi[0], x[4 * j + 2], s); s = fmaf(hi[1], x[4 * j + 3], s); }
                part[q] = s; }
            float r4[4], r2[2], r1;
            { const bool up = (lane & 32) != 0;
#pragma unroll
              for (int i = 0; i < 4; ++i) { const float send = up ? part[i] : part[4 + i]; const float keep = up ? part[4 + i] : part[i]; r4[i] = keep + __shfl_xor(send, 32); } }
            { const bool up = (lane & 16) != 0;
#pragma unroll
              for (int i = 0; i < 2; ++i) { const float send = up ? r4[i] : r4[2 + i]; const float keep = up ? r4[2 + i] : r4[i]; r2[i] = keep + __shfl_xor(send, 16); } }
            { const bool up = (lane & 8) != 0; const float send = up ? r2[0] : r2[1]; const float keep = up ? r2[1] : r2[0]; r1 = keep + __shfl_xor(send, 8); }
            r1 += __shfl_xor(r1, 4); r1 += __shfl_xor(r1, 2); r1 += __shfl_xor(r1, 1);
            const int myq = ((lane >> 5) & 1) * 4 + ((lane >> 4) & 1) * 2 + ((lane >> 3) & 1);
            const int me = eb + myq;
            const float g = __shfl(me < 64 ? myg0 : myg1, me & 63);
            const int mye = __shfl(me < 64 ? myidx0 : myidx1, me & 63);
            const float cf = g * gelu_exact(r1 * su[mye]) * sv[mye];
            float cq[8];
#pragma unroll
            for (int q = 0; q < 8; ++q) cq[q] = __int_as_float(__builtin_amdgcn_readlane(__float_as_int(cf), ((q >> 2) & 1) * 32 + ((q >> 1) & 1) * 16 + (q & 1) * 8));
#pragma unroll
            for (int q = 0; q < 8; ++q) { const float s = cq[q];
#pragma unroll
                for (int j = 0; j < 4; ++j) { const f32x2 lo = __builtin_amdgcn_cvt_pk_f32_fp8((int)vr[q][j], false), hi = __builtin_amdgcn_cvt_pk_f32_fp8((int)vr[q][j], true);
                    acc[4 * j] = fmaf(s, lo[0], acc[4 * j]); acc[4 * j + 1] = fmaf(s, lo[1], acc[4 * j + 1]); acc[4 * j + 2] = fmaf(s, hi[0], acc[4 * j + 2]); acc[4 * j + 3] = fmaf(s, hi[1], acc[4 * j + 3]); } }
        }
        float s = 0.f;
#pragma unroll
        for (int e = 0; e < 16; ++e) { acc[e] = fmaf(DN_ALPHA, x[e], acc[e]); s += acc[e]; }
        const float mean = wave_sum(s) * (1.0f / D); float s2 = 0.f;
#pragma unroll
        for (int e = 0; e < 16; ++e) { acc[e] -= mean; s2 += acc[e] * acc[e]; }
        const float rstd = 1.0f / sqrtf(wave_sum(s2) * (1.0f / D) + LN_EPS);
        float o[16];
#pragma unroll
        for (int j = 0; j < 4; ++j) { const f32x4 g4 = *(const f32x4*)(lg + 16 * lane + 4 * j), b4 = *(const f32x4*)(lbv + 16 * lane + 4 * j);
#pragma unroll
            for (int e = 0; e < 4; ++e) o[4 * j + e] = acc[4 * j + e] * rstd * g4[e] + b4[e];
            *(f32x4*)(xw + 4 * j) = (f32x4){o[4 * j], o[4 * j + 1], o[4 * j + 2], o[4 * j + 3]}; }
        u32x4 w0, w1; w0.x = cvt_pk_bf16(o[0], o[1]); w0.y = cvt_pk_bf16(o[2], o[3]); w0.z = cvt_pk_bf16(o[4], o[5]); w0.w = cvt_pk_bf16(o[6], o[7]);
        w1.x = cvt_pk_bf16(o[8], o[9]); w1.y = cvt_pk_bf16(o[10], o[11]); w1.z = cvt_pk_bf16(o[12], o[13]); w1.w = cvt_pk_bf16(o[14], o[15]);
        *(u32x4*)(xb + (size_t)t * D + 16 * lane) = w0; *(u32x4*)(xb + (size_t)t * D + 16 * lane + 8) = w1;
    }
}
}
namespace peer {
constexpr size_t HP_OFF = WS_BIG;
constexpr size_t COEF_OFF = WS_R2 + 36 * MiB;
constexpr int QW_BASE = 4096;
constexpr int ITEM_TOK = 128, NBLK = T / ITEM_TOK;
constexpr int GT = 1;
#define DPP_F(v, ctrl) __int_as_float(__builtin_amdgcn_update_dpp(0, __float_as_int(v), (ctrl), 0xf, 0xf, true))

template <class F> __device__ __forceinline__ void for_items(const Ctx& c, int layer, int phase, F body) {
    unsigned* qw = (unsigned*)(c.ws + WS_CTL) + QW_BASE + (size_t)((layer * 4 + phase) * 8) * 16;
    volatile LAS int* slot = (volatile LAS int*)(c.lds + LDS_MISC_OFF + 128);
    const int home = (int)(xb_xcc_id() & 7u);
    for (int k = 0; k < 8; ++k) {
        const int s = (home + k) & 7;
        if (c.tid == 0) slot[0] = (int)__hip_atomic_fetch_add(qw + s * 16, 1u, __ATOMIC_RELAXED, __HIP_MEMORY_SCOPE_AGENT);
        __syncthreads();
        int cur = slot[0];
        __syncthreads();
        while (cur < NBLK) {
            if (c.tid == 0) slot[0] = (int)__hip_atomic_fetch_add(qw + s * 16, 1u, __ATOMIC_RELAXED, __HIP_MEMORY_SCOPE_AGENT);
            body(s, cur);
            __syncthreads();
            cur = slot[0];
            __syncthreads();
        }
    }
}

__device__ __forceinline__ void g1_udot(const Ctx& c, int layer, int dup) {
    const unsigned char* U8 = c.ws + R2_UB; const unsigned short* idx = (const unsigned short*)(c.ws + R2_IDX); bf16_t* hp = (bf16_t*)(c.ws + HP_OFF);
    for_items(c, layer, 0 + 2 * dup, [&](int s, int blk) {
        int lane = c.lane; asm volatile("" : "+v"(lane));
        const int g = lane >> 3, c8 = lane & 7;
        const int co = 128 * s + 16 * c8;
#pragma unroll 1
        for (int i = 0; i < ITEM_TOK / NWAVES; i += GT) {
            const int t0 = blk * ITEM_TOK + c.wave * (ITEM_TOK / NWAVES) + i;
            float x[GT][16]; int id[GT][16];
#pragma unroll
            for (int u = 0; u < GT; ++u)
#pragma unroll
            for (int j = 0; j < 4; ++j) { const u32x2 a = *(const u32x2*)((const bf16_t*)(c.ws + WS_XB) + (size_t)(t0 + u) * D + co + 4 * j); x[u][4 * j] = bflo(a.x); x[u][4 * j + 1] = bfhi(a.x); x[u][4 * j + 2] = bflo(a.y); x[u][4 * j + 3] = bfhi(a.y);
                if (j < 2) { const u32x4 q = *(const u32x4*)(idx + (size_t)(t0 + u) * 128 + 16 * g + 8 * j);
#pragma unroll
                    for (int e = 0; e < 4; ++e) { id[u][8 * j + 2 * e] = (int)(q[e] & 0xffffu); id[u][8 * j + 2 * e + 1] = (int)(q[e] >> 16); } } }
            u32x4 row[GT][16];
#pragma unroll
            for (int u = 0; u < GT; ++u)
#pragma unroll
            for (int j = 0; j < 16; ++j) row[u][j] = *(const u32x4*)(U8 + (size_t)id[u][j] * D + co);
#pragma unroll
            for (int u = 0; u < GT; ++u) {
            float V[16];
#pragma unroll
            for (int j = 0; j < 16; ++j) { f32x2 acc2 = (f32x2){0.f, 0.f};
                if (dup) { V[j] = __uint_as_float((row[u][j][0] ^ row[u][j][1] ^ row[u][j][2] ^ row[u][j][3]) & 0x3fffffffu); continue; }
#pragma unroll
                for (int q = 0; q < 4; ++q) { const f32x2 lo = __builtin_amdgcn_cvt_pk_f32_fp8((int)row[u][j][q], false), hi = __builtin_amdgcn_cvt_pk_f32_fp8((int)row[u][j][q], true);
                    acc2 = __builtin_elementwise_fma(lo, (f32x2){x[u][4 * q], x[u][4 * q + 1]}, acc2); acc2 = __builtin_elementwise_fma(hi, (f32x2){x[u][4 * q + 2], x[u][4 * q + 3]}, acc2); }
                V[j] = acc2[0] + acc2[1]; }
            float W[8], Y[4], Z[2];
            { const bool hiA = (lane & 4) != 0;
#pragma unroll
              for (int m = 0; m < 8; ++m) { const float send = hiA ? V[m] : V[8 + m], keep = hiA ? V[8 + m] : V[m]; W[m] = keep + DPP_F(send, 0x141); } }
            { const bool hiB = (lane & 2) != 0;
#pragma unroll
              for (int m = 0; m < 4; ++m) { const float send = hiB ? W[m] : W[4 + m], keep = hiB ? W[4 + m] : W[m]; Y[m] = keep + DPP_F(send, 0x1B); } }
            { const bool hiC = (lane & 1) != 0;
#pragma unroll
              for (int m = 0; m < 2; ++m) { const float send = hiC ? Y[m] : Y[2 + m], keep = hiC ? Y[2 + m] : Y[m]; Z[m] = keep + DPP_F(send, 0xB1); } }
            *(unsigned*)((dup ? hp + (size_t)320 * MiB : hp) + ((size_t)(dup ? 0 : s) * T + t0 + u) * 128 + 16 * g + 2 * c8) = cvt_pk_bf16(Z[0], Z[1]);
            }
        }
    });
}
__device__ __forceinline__ void g2_coef(const Ctx& c, int dup) {
    const unsigned short* idx = (const unsigned short*)(c.ws + R2_IDX); const float* gate = (const float*)(c.ws + R2_GATE); const bf16_t* hp = (const bf16_t*)(c.ws + HP_OFF);
    const float* su = (const float*)(c.ws + R2_SU); const float* sv = (const float*)(c.ws + R2_SV);
    bf16_t* dstb = dup ? (bf16_t*)(c.ws + HP_OFF) + (size_t)340 * MiB : (bf16_t*)(c.ws + COEF_OFF);
    const int lane = c.lane;
    constexpr int NU = 4;
    for (int t0 = c.gw * NU; t0 < T; t0 += c.NGW * NU) {
        float h[NU][2]; unsigned ew[NU]; f32x2 gt[NU];
#pragma unroll
        for (int u = 0; u < NU; ++u) { const size_t o = (size_t)(t0 + u) * 128 + 2 * lane; ew[u] = *(const unsigned*)(idx + o); gt[u] = *(const f32x2*)(gate + o); float a0 = 0.f, a1 = 0.f;
#pragma unroll
            for (int s = 0; s < 8; ++s) { const unsigned w = *(const unsigned*)(hp + (size_t)s * T * 128 + o); a0 += bflo(w); a1 += bfhi(w); }
            h[u][0] = a0; h[u][1] = a1; }
        float s1[NU][2], s2[NU][2];
#pragma unroll
        for (int u = 0; u < NU; ++u) { const int e0 = (int)(ew[u] & 0xffffu), e1 = (int)(ew[u] >> 16); s1[u][0] = su[e0]; s1[u][1] = su[e1]; s2[u][0] = sv[e0]; s2[u][1] = sv[e1]; }
#pragma unroll
        for (int u = 0; u < NU; ++u) *(unsigned*)(dstb + (size_t)(t0 + u) * 128 + 2 * lane) = cvt_pk_bf16(gt[u][0] * gelu_exact(h[u][0] * s1[u][0]) * s2[u][0], gt[u][1] * gelu_exact(h[u][1] * s1[u][1]) * s2[u][1]);
    }
}
__device__ __forceinline__ void g3_vaxpy(const Ctx& c, int layer, int dup) {
    const unsigned char* V8 = c.ws + R2_VB; const unsigned short* idx = (const unsigned short*)(c.ws + R2_IDX); const bf16_t* coef = (const bf16_t*)(c.ws + COEF_OFF);
    for_items(c, layer, 1 + 2 * dup, [&](int s, int blk) {
        int lane = c.lane; asm volatile("" : "+v"(lane));
        const int g = lane >> 3, c8 = lane & 7;
        const int co = 128 * s + 16 * c8;
        constexpr int N = ITEM_TOK / NWAVES;
        const int t0 = blk * ITEM_TOK + c.wave * N;
        auto load_idx = [&](int t, int (&id)[16]) {
#pragma unroll
            for (int j = 0; j < 2; ++j) { const u32x4 q = *(const u32x4*)(idx + (size_t)t * 128 + 16 * g + 8 * j);
#pragma unroll
                for (int e = 0; e < 4; ++e) { id[8 * j + 2 * e] = (int)(q[e] & 0xffffu); id[8 * j + 2 * e + 1] = (int)(q[e] >> 16); } } };
        auto load_rows = [&](int t, const int (&id)[16], u32x4 (&row)[16], f32x4 (&cf)[4]) {
#pragma unroll
            for (int j = 0; j < 2; ++j) { const u32x4 q = *(const u32x4*)(coef + (size_t)t * 128 + 16 * g + 8 * j); cf[2 * j] = (f32x4){bflo(q[0]), bfhi(q[0]), bflo(q[1]), bfhi(q[1])}; cf[2 * j + 1] = (f32x4){bflo(q[2]), bfhi(q[2]), bflo(q[3]), bfhi(q[3])}; }
#pragma unroll
            for (int j = 0; j < 16; ++j) row[j] = *(const u32x4*)(V8 + ((unsigned)id[j] * 1024u + (unsigned)co)); };
        auto compute = [&](int t, const u32x4 (&row)[16], const f32x4 (&cf)[4]) {
            f32x2 A2[8];
#pragma unroll
            for (int e = 0; e < 8; ++e) A2[e] = (f32x2){0.f, 0.f};
#pragma unroll
            for (int j = 0; j < 16; ++j) { const float cj = cf[j >> 2][j & 3]; const f32x2 sc = (f32x2){cj, cj};
#pragma unroll
                for (int q = 0; q < 4; ++q) { const f32x2 lo = __builtin_amdgcn_cvt_pk_f32_fp8((int)row[j][q], false), hi = __builtin_amdgcn_cvt_pk_f32_fp8((int)row[j][q], true);
                    A2[2 * q] = __builtin_elementwise_fma(sc, lo, A2[2 * q]); A2[2 * q + 1] = __builtin_elementwise_fma(sc, hi, A2[2 * q + 1]); } }
            float A[16];
#pragma unroll
            for (int e = 0; e < 8; ++e) { A[2 * e] = A2[e][0]; A[2 * e + 1] = A2[e][1]; }
            float R[8], S2[4], Y[2];
#pragma unroll
            for (int m = 0; m < 8; ++m) { auto rr = __builtin_amdgcn_permlane32_swap(__float_as_uint(A[m]), __float_as_uint(A[8 + m]), false, false); R[m] = __uint_as_float(rr[0]) + __uint_as_float(rr[1]); }
#pragma unroll
            for (int m = 0; m < 4; ++m) { auto rr = __builtin_amdgcn_permlane16_swap(__float_as_uint(R[m]), __float_as_uint(R[4 + m]), false, false); S2[m] = __uint_as_float(rr[0]) + __uint_as_float(rr[1]); }
            { const bool hi8 = (lane & 8) != 0;
#pragma unroll
              for (int m = 0; m < 2; ++m) { const float send = hi8 ? S2[m] : S2[2 + m], keep = hi8 ? S2[2 + m] : S2[m]; Y[m] = keep + DPP_F(send, 0x128); } }
            const size_t yo = (size_t)t * D + co + 8 * ((lane >> 5) & 1) + 4 * ((lane >> 4) & 1) + 2 * ((lane >> 3) & 1);
            const unsigned xo = *(const unsigned*)((const bf16_t*)(c.ws + WS_XB) + yo);
            *(unsigned*)((bf16_t*)c.out + yo) = cvt_pk_bf16(fmaf(DN_ALPHA, bflo(xo), Y[0]), fmaf(DN_ALPHA, bfhi(xo), Y[1])); };
        int idA[16], idB[16]; u32x4 rowA[16], rowB[16]; f32x4 cfA[4], cfB[4];
        load_idx(t0, idA); load_rows(t0, idA, rowA, cfA); load_idx(t0 + 1, idB);
#pragma unroll 1
        for (int i = 0; i < N; i += 2) {
            load_rows(t0 + i + 1, idB, rowB, cfB);
            if (i + 2 < N) load_idx(t0 + i + 2, idA);
            __builtin_amdgcn_sched_barrier(0);
            compute(t0 + i, rowA, cfA);
            __builtin_amdgcn_sched_barrier(0);
            if (i + 2 < N) load_rows(t0 + i + 2, idA, rowA, cfA);
            if (i + 3 < N) load_idx(t0 + i + 3, idB);
            __builtin_amdgcn_sched_barrier(0);
            compute(t0 + i + 1, rowB, cfB);
            __builtin_amdgcn_sched_barrier(0);
        }
    });
}
__device__ __forceinline__ void ln_pass(const Ctx& c, const float* g, const float* b) {
    const bf16_t* ym = (const bf16_t*)c.out; bf16_t* xa = (bf16_t*)(c.ws + WS_XB); const int lane = c.lane;
    constexpr int NU = 4;
    for (int t0 = c.gw * NU; t0 < T; t0 += c.NGW * NU) {
        f32x4 v[NU][4]; bf16_t* dst[NU]; unsigned char* dst8[NU]; float* dsc[NU];
#pragma unroll
        for (int u = 0; u < NU; ++u) { dst8[u] = nullptr; dsc[u] = nullptr; const bf16_t* yr = ym + (size_t)(t0 + u) * D; dst[u] = xa + (size_t)(t0 + u) * D;
#pragma unroll
            for (int j = 0; j < 4; ++j) { const u32x2 w = *(const u32x2*)(yr + 256 * j + 4 * lane); v[u][j] = (f32x4){bflo(w.x), bfhi(w.x), bflo(w.y), bfhi(w.y)}; } }
        ln_rows<NU, false>(v, g, b, lane, dst, dst8, dsc);
    }
}
#undef DPP_F
}
constexpr int N_PHASES = 1 + 2 * (5 + 8) + 2 * (5 + 8);

#ifndef PROBE_SITE
#define PROBE_SITE -1
#endif
#ifndef PROBE_LN
#define PROBE_LN 0
#endif
#ifndef PROBE_VAR
#define PROBE_VAR 5
#endif
#define GEMM_PHASE(EPI, Aptr, Bptr, NN, KK, ...) { pg8::Gemm g{(const bf16_t*)(Aptr), (const bf16_t*)(Bptr), T, (NN), (KK)}; pg8::StaticOrder S; S.init(T, (NN), c.G, c.bid); \
        pg8::EPI E{__VA_ARGS__}; pg8::gemm_phase<pg8::EPI, pg8::StaticOrder>(c.lds, g, S, E, c.tid); }

__global__ void __launch_bounds__(NTHR, 2) fwd_kernel(Args args) {
    extern __shared__ __attribute__((aligned(16))) unsigned char lds_raw[];
    volatile LAS unsigned* misc = (volatile LAS unsigned*)((LAS unsigned char*)lds_raw + LDS_MISC_OFF);
    if (threadIdx.x < 64) misc[threadIdx.x] = 0u;
    __syncthreads();
    const int wave_s = __builtin_amdgcn_readfirstlane((int)threadIdx.x >> 6);
    const int lo = args.ph_lo, hi = args.ph_hi;
    XcdBarrier bar; bar.bar = (unsigned*)(args.ws + WS_CTL); bar.x = 0; bar.st = nullptr;
    if (hi - lo > 1) bar = xcd_barrier_post((unsigned*)(args.ws + WS_CTL), misc + 8);
    int ph = 0;
#define PHASE(site, ...) if (ph >= lo && ph < hi) { const Ctx c = mk_ctx(lds_raw, wave_s); unsigned char* const ws = c.ws; (void)ws; { constexpr int dup = 0; (void)dup; __VA_ARGS__ } \
        if constexpr (PROBE_SITE == (site)) { __syncthreads(); constexpr int dup = 1; (void)dup; __VA_ARGS__ } if (ph + 1 < hi) xcd_barrier(bar); } ++ph;

    PHASE(0, p0_prologue(c);)

    for (int layer = 0; layer < NL; ++layer) {
        const int j = layer >> 1;
        if ((layer & 1) == 0) {
            PHASE(1, GEMM_PHASE(EpiBf16P, c.out, (const bf16_t*)(ws + W_WA) + (size_t)j * 768 * 1024, 768, 1024, (bf16_t*)(ws + B_A32), 768))
            PHASE(2, l0_convert(c, layer); mla_e1(c, j);)
            PHASE(3, GEMM_PHASE(EpiBf16P, ws + B_CQN, (const bf16_t*)(ws + W_WUQ) + (size_t)j * 1536 * 384, 1536, 384, (bf16_t*)(ws + B_Q), 1536) __syncthreads();
                     GEMM_PHASE(EpiBf16P, ws + B_CKVN, (const bf16_t*)(ws + W_WUKV) + (size_t)j * 2048 * 256, 2048, 256, (bf16_t*)(ws + B_KV), 2048))
            PHASE(5, if (dup == 0) mla_attention<0>(c); else mla_attention<PROBE_VAR>(c);)
            PHASE(6, GEMM_PHASE(EpiBf16P, ws + B_O, (const bf16_t*)(ws + W_WO) + (size_t)j * 1024 * 1024, 1024, 1024, (bf16_t*)(ws + B_H32_MLA), 1024))
        } else {
            PHASE(7, GEMM_PHASE(EpiHgrn, c.out, (const bf16_t*)(ws + W_HIN) + (size_t)j * 5120 * 1024, 5120, 1024, (bf16_t*)(ws + B_PLANE), (size_t)T * 1024, (const float*)(ws + WS_MISC) + (size_t)j * 2048))
            PHASE(8, if (dup == 0) { l0_convert(c, layer); scan::hgrn_prep(c, 0); } else { scan::hgrn_prep(c, 1); })
            PHASE(9, scan::hgrn_scan(c, dup != 0);)
            PHASE(10, hgrn_post(c, j);)
            PHASE(11, GEMM_PHASE(EpiBf16P, ws + B_PLANE, (const bf16_t*)(ws + W_HO) + (size_t)j * 1024 * 1024, 1024, 1024, (bf16_t*)(ws + B_H32_HGRN), 1024))
        }
        PHASE(12, ln_residual(c, (const bf16_t*)(ws + ((layer & 1) ? B_H32_HGRN : B_H32_MLA)), c.in(18) + layer * D, c.in(19) + layer * D);)
        PHASE(13, GEMM_PHASE(EpiBf16P, ws + WS_XB, (const bf16_t*)(ws + W_PQ) + (size_t)layer * 2048 * 1024, 2048, 1024, (bf16_t*)(ws + B_PQ), 2048))
        PHASE(14, peer::route(c, layer);)
        PHASE(15, peer::g1_udot(c, layer, dup);)
        PHASE(16, peer::g2_coef(c, dup);)
        PHASE(17, peer::g3_vaxpy(c, layer, dup);)
        PHASE(18, if (dup == 0 || PROBE_LN == 0) GEMM_PHASE(EpiBf16P, ws + R2_PB, (const bf16_t*)(ws + W_PP) + (size_t)layer * 1024 * 256, 1024, 256, (bf16_t*)(ws + B_PP), 1024) if (dup == 0 || PROBE_LN == 1) peer::ln_pass(c, c.in(20) + layer * D, c.in(21) + layer * D);)
        PHASE(19, GEMM_PHASE(EpiPle, ws + WS_XB, (const bf16_t*)(ws + W_GW) + (size_t)layer * 1024 * 1024, 1024, 1024, (const bf16_t*)(ws + WS_XB), (const bf16_t*)(ws + B_PP), c.in(23) + layer * D, (bf16_t*)c.out, (layer == NL - 1) ? c.out : (float*)nullptr))
    }
#undef PHASE
}

extern "C" void kernel_launch(void* const* d_in, const int* in_sizes, int n_in, void* d_out, int out_size, void* d_ws, size_t ws_size, hipStream_t stream) {
    static int grid = 0;
    if (grid == 0) {
        if (n_in != 25 || out_size != T * D || ws_size < WS_END) { fprintf(stderr, "kernel_launch: unexpected shapes: n_in %d out %d ws %zu (need %zu)\n", n_in, out_size, ws_size, (size_t)WS_END); grid = -1; return; }
        int dev = 0, cus = 0, per_cu = 0;
        if (hipGetDevice(&dev) != hipSuccess || hipDeviceGetAttribute(&cus, hipDeviceAttributeMultiprocessorCount, dev) != hipSuccess) { grid = -1; return; }
        if (hipFuncSetAttribute((const void*)fwd_kernel, hipFuncAttributeMaxDynamicSharedMemorySize, LDS_BYTES) != hipSuccess) { fprintf(stderr, "kernel_launch: hipFuncSetAttribute failed\n"); grid = -1; return; }
        if (hipOccupancyMaxActiveBlocksPerMultiprocessor(&per_cu, (const void*)fwd_kernel, NTHR, LDS_BYTES) != hipSuccess || per_cu < 1) { fprintf(stderr, "kernel_launch: occupancy query says %d\n", per_cu); }
        (void)hipGetLastError();
        grid = cus;
    }
    if (grid < 0) return;
    (void)hipMemsetAsync((char*)d_ws + WS_CTL, 0, CTL_ZERO_BYTES, stream);
    Args a{};
    for (int i = 0; i < 25; ++i) a.in[i] = (const float*)d_in[i];
    a.out = (float*)d_out; a.ws = (unsigned char*)d_ws;
#if defined(MK_DEBUG_MLA)
    float* res = (float*)((char*)d_ws + WS_CTL + 48 * 1024);
    for (int p = 0; p < 4; ++p) { a.ph_lo = p; a.ph_hi = p + 1; hipLaunchKernelGGL(fwd_kernel, dim3(grid), dim3(NTHR), LDS_BYTES, stream, a); }
    hipLaunchKernelGGL(k_zero_out, dim3(2048), dim3(256), 0, stream, (float*)d_out, (size_t)T * D);
    hipLaunchKernelGGL(k_mla_naive, dim3(2), dim3(256), 0, stream, (const float*)d_in[0], (const float*)d_in[1], (const float*)d_in[4], (const float*)d_in[5], (const float*)d_in[6], (const float*)d_in[7], (const float*)d_in[8], (const unsigned char*)d_ws, res);
    hipLaunchKernelGGL(k_mla_report, dim3(1), dim3(64), 0, stream, (const float*)res, (float*)d_out);
#elif defined(MK_DEBUG_ATTN)
    float* res = (float*)((char*)d_ws + WS_CTL + 48 * 1024);
    for (int p = 0; p < 5; ++p) { a.ph_lo = p; a.ph_hi = p + 1; hipLaunchKernelGGL(fwd_kernel, dim3(grid), dim3(NTHR), LDS_BYTES, stream, a); }
    hipLaunchKernelGGL(k_zero_out, dim3(2048), dim3(256), 0, stream, (float*)d_out, (size_t)T * D);
    hipLaunchKernelGGL(k_attn_naive, dim3(2 * CHK_NR), dim3(256), 0, stream, (const unsigned char*)d_ws, (float*)nullptr, res);
    hipLaunchKernelGGL(k_attn_report, dim3(1), dim3(64), 0, stream, (const float*)res, (float*)d_out);
#elif defined(MK_DEBUG_DET)
    unsigned long long* tab = (unsigned long long*)((char*)d_ws + WS_CTL + 32 * 1024);
    for (int pass = 0; pass < 2; ++pass)
        for (int p = 0; p < N_PHASES; ++p) { a.ph_lo = p; a.ph_hi = p + 1; hipLaunchKernelGGL(fwd_kernel, dim3(grid), dim3(NTHR), LDS_BYTES, stream, a);
            Reg r[4]; const int nr = phase_regions(p, r);
            for (int i = 0; i < nr; ++i) hipLaunchKernelGGL(k_checksum, dim3(2048), dim3(256), 0, stream, (const unsigned*)(r[i].in_out ? (char*)d_out : (char*)d_ws + r[i].off), r[i].bytes / 4, tab + (size_t)pass * N_PHASES * 4 + p * 4 + i); }
    hipLaunchKernelGGL(k_zero_out, dim3(2048), dim3(256), 0, stream, (float*)d_out, (size_t)T * D);
    hipLaunchKernelGGL(k_report, dim3(1), dim3(64), 0, stream, tab, N_PHASES * 4, (float*)d_out);
#elif MK_ONE_LAUNCH
    a.ph_lo = 0; a.ph_hi = N_PHASES;
    hipLaunchKernelGGL(fwd_kernel, dim3(grid), dim3(NTHR), LDS_BYTES, stream, a);
#else
    for (int p = 0; p < N_PHASES; ++p) { a.ph_lo = p; a.ph_hi = p + 1; hipLaunchKernelGGL(fwd_kernel, dim3(grid), dim3(NTHR), LDS_BYTES, stream, a); }
#endif
}
```

```cpp
#include <hip/hip_runtime.h>
#include <cstdio>
#include <cstdint>

#ifndef MK_ONE_LAUNCH
#define MK_ONE_LAUNCH 1
#endif

#define GAS __attribute__((address_space(1)))
#define LAS __attribute__((address_space(3)))
typedef unsigned short bf16_t;
typedef short bf16x8 __attribute__((ext_vector_type(8)));
typedef short s16x4 __attribute__((ext_vector_type(4)));
typedef float f32x4 __attribute__((ext_vector_type(4)));
typedef float f32x2 __attribute__((ext_vector_type(2)));
typedef float f32x16 __attribute__((ext_vector_type(16)));
typedef unsigned u32x4 __attribute__((ext_vector_type(4)));
typedef unsigned u32x2 __attribute__((ext_vector_type(2)));

constexpr int D = 1024, TP = 16384, TS = 65536, T = TP + TS, SP = 8192, SS = 2048;
constexpr int NL = 4;
constexpr int NWAVES = 8, NTHR = 512;
constexpr float DN_ALPHA = 1.681792830507429f;
constexpr float LN_EPS = 1e-5f, RMS_EPS = 1e-6f;
constexpr float MLA_SCALE = 0.07216878364870323f;
constexpr int NEXP = 16384;

constexpr size_t MiB = 1u << 20;
constexpr size_t WS_CTL = 0, CTL_ZERO_BYTES = 64 * 1024;
constexpr size_t WS_ROPE = 1 * MiB;
constexpr size_t WS_MISC = 3 * MiB;
constexpr size_t WS_W = 4 * MiB;
constexpr size_t W_WA = WS_W;
constexpr size_t W_WUQ = W_WA + 2 * (size_t)768 * 1024 * 2;
constexpr size_t W_WUKV = W_WUQ + 2 * (size_t)1536 * 384 * 2;
constexpr size_t W_WO = W_WUKV + 2 * (size_t)2048 * 256 * 2;
constexpr size_t W_HIN = W_WO + 2 * (size_t)1024 * 1024 * 2;
constexpr size_t W_HO = W_HIN + 2 * (size_t)5120 * 1024 * 2;
constexpr size_t W_PQ = W_HO + 2 * (size_t)1024 * 1024 * 2;
constexpr size_t W_GW = W_PQ + 4 * (size_t)2048 * 1024 * 2;
constexpr size_t W_PP = W_GW + 4 * (size_t)1024 * 1024 * 2;
constexpr size_t W_KEYS = W_PP + 4 * (size_t)1024 * 256 * 2;
constexpr size_t W_END = W_KEYS + 4 * (size_t)2 * 128 * 128 * 2;
static_assert(W_END <= 68 * MiB, "weights region");
constexpr size_t WS_R2 = 68 * MiB;
constexpr size_t R2_UB = WS_R2, R2_VB = WS_R2 + 16 * MiB, R2_SU = WS_R2 + 32 * MiB, R2_SV = WS_R2 + 33 * MiB, R2_IDX = WS_R2 + 64 * MiB, R2_GATE = WS_R2 + 104 * MiB, R2_PB = WS_R2 + 144 * MiB;
constexpr size_t WS_XB = 252 * MiB;
constexpr size_t WS_BIG = 412 * MiB;
constexpr size_t WS_END = WS_BIG + 800 * MiB;
constexpr size_t B_Q = WS_BIG, B_KV = WS_BIG + 240 * MiB, B_O = WS_BIG + 560 * MiB, B_KROPE = WS_BIG + 720 * MiB;
constexpr size_t B_A32 = WS_BIG + 240 * MiB, B_CQN = WS_BIG + 560 * MiB, B_CKVN = WS_BIG + 620 * MiB, B_H32_MLA = WS_BIG;
constexpr size_t B_PLANE = WS_BIG, PLANE_BYTES = 160 * MiB, B_H32_HGRN = WS_BIG + 160 * MiB;
constexpr size_t B_PQ = WS_BIG, B_PP = WS_BIG + 320 * MiB, B_X8 = WS_BIG + 480 * MiB, B_XS = WS_BIG + 560 * MiB;

constexpr int LDS_BYTES = 160 * 1024;
constexpr int LDS_MISC_OFF = LDS_BYTES - 256;

typedef __bf16 bf16x2_n __attribute__((ext_vector_type(2)));
__device__ __forceinline__ unsigned cvt_pk_bf16(float lo, float hi) { const f32x2 v = {lo, hi}; const bf16x2_n b = __builtin_convertvector(v, bf16x2_n); return __builtin_bit_cast(unsigned, b); }
__device__ __forceinline__ bf16_t f2bf(float f) { return (bf16_t)(cvt_pk_bf16(f, 0.f) & 0xffffu); }
__device__ __forceinline__ float bf2f(bf16_t b) { return __uint_as_float(((unsigned)b) << 16); }
__device__ __forceinline__ float bflo(unsigned w) { return __uint_as_float(w << 16); }
__device__ __forceinline__ float bfhi(unsigned w) { return __uint_as_float(w & 0xffff0000u); }
#define DPPF(v, ctrl) __int_as_float(__builtin_amdgcn_update_dpp(0, __float_as_int(v), (ctrl), 0xf, 0xf, true))
__device__ __forceinline__ float row16_sum(float v) { v += DPPF(v, 0xB1); v += DPPF(v, 0x4E); v += DPPF(v, 0x141); v += DPPF(v, 0x140); return v; }
__device__ __forceinline__ float wave_sum(float v) { v = row16_sum(v);
    { auto r = __builtin_amdgcn_permlane16_swap(__float_as_uint(v), __float_as_uint(v), false, false); v = __uint_as_float(r[0]) + __uint_as_float(r[1]); }
    { auto r = __builtin_amdgcn_permlane32_swap(__float_as_uint(v), __float_as_uint(v), false, false); v = __uint_as_float(r[0]) + __uint_as_float(r[1]); }
    return v; }
__device__ __forceinline__ float wave_max(float v) { v = fmaxf(v, DPPF(v, 0xB1)); v = fmaxf(v, DPPF(v, 0x4E)); v = fmaxf(v, DPPF(v, 0x141)); v = fmaxf(v, DPPF(v, 0x140));
    { auto r = __builtin_amdgcn_permlane16_swap(__float_as_uint(v), __float_as_uint(v), false, false); v = fmaxf(__uint_as_float(r[0]), __uint_as_float(r[1])); }
    { auto r = __builtin_amdgcn_permlane32_swap(__float_as_uint(v), __float_as_uint(v), false, false); v = fmaxf(__uint_as_float(r[0]), __uint_as_float(r[1])); }
    return v; }
__device__ __forceinline__ float fast_exp(float x) { return __builtin_amdgcn_exp2f(x * 1.4426950408889634f); }
__device__ __forceinline__ float fast_log(float x) { return __builtin_amdgcn_logf(x) * 0.6931471805599453f; }
__device__ __forceinline__ float fast_rcp(float x) { return __builtin_amdgcn_rcpf(x); }
__device__ __forceinline__ float sigmoidf_(float x) { return fast_rcp(1.0f + fast_exp(-x)); }
__device__ __forceinline__ float siluf_(float x) { return x * sigmoidf_(x); }
#define LDS_WAIT() asm volatile("s_waitcnt lgkmcnt(0)" ::: "memory")
#define VM_WAIT() asm volatile("s_waitcnt vmcnt(0)" ::: "memory")
__device__ __forceinline__ int opaque_lane() { int l; asm volatile("v_mbcnt_lo_u32_b32 %0, -1, 0\n\tv_mbcnt_hi_u32_b32 %0, -1, %0" : "=v"(l)); return l; }
__device__ __forceinline__ int opaque_tid(int wave_s) { asm volatile("" : "+s"(wave_s)); return (wave_s << 6) + opaque_lane(); }
__device__ __forceinline__ int opaque_bid() { int b = (int)blockIdx.x; asm volatile("" : "+s"(b)); return b; }
struct Args { const float* in[25]; float* out; unsigned char* ws; int ph_lo, ph_hi; };
#define XB_TMO      128
#define XB_XCNT(j)  (256  + 64 * (j))
#define XB_XSUB(j)  (1280 + 64 * (j))
#define XB_XGEN(j)  (2304 + 64 * (j))
#define XB_TOP      3328
#define XB_TOPGEN   3392
#define XCD_BAR_WORDS 3456
#define XB_SPIN_CAP (1u << 23)

__device__ __forceinline__ unsigned xb_ld(unsigned* p)              { return __hip_atomic_load(p, __ATOMIC_RELAXED, __HIP_MEMORY_SCOPE_AGENT); }
__device__ __forceinline__ unsigned xb_add(unsigned* p, unsigned v) { return __hip_atomic_fetch_add(p, v, __ATOMIC_RELAXED, __HIP_MEMORY_SCOPE_AGENT); }
__device__ __forceinline__ unsigned xb_xcc_id() { return (unsigned)__builtin_amdgcn_s_getreg((3 << 11) | 20) & 0xFu; }
#define XB_SPIN(cond, bar) do { unsigned _sp = 0; while (cond) { __builtin_amdgcn_s_sleep(1); \
    if ((++_sp & 255u) == 0u) { if (xb_ld(&(bar)[XB_TMO])) break; if (_sp > XB_SPIN_CAP) { atomicAdd(&(bar)[XB_TMO], 1u); break; } } } } while (0)

struct XcdBarrier {
    unsigned* bar; unsigned x;
    volatile LAS unsigned* st;
};

__device__ __forceinline__ XcdBarrier xcd_barrier_post(unsigned* bar, volatile LAS unsigned* st) {
    XcdBarrier b; b.bar = bar; b.x = xb_xcc_id(); b.st = st;
    if (threadIdx.x == 0) (void)xb_add(&bar[XB_XCNT(b.x)], 1u);
    return b;
}
__device__ __forceinline__ void xcd_barrier_complete(unsigned* bar, unsigned x, unsigned& nloc, unsigned& nx) {
    const unsigned G = gridDim.x * gridDim.y * gridDim.z;
    unsigned sum, cnt, mine, sp = 0u;
    for (;;) {
        sum = 0u; cnt = 0u; mine = 0u;
#pragma unroll
        for (unsigned j = 0; j < 16; ++j) { const unsigned c = xb_ld(&bar[XB_XCNT(j)]); sum += c; cnt += (c > 0u) ? 1u : 0u; mine = (j == x) ? c : mine; }
        if (sum == G) break;
        __builtin_amdgcn_s_sleep(1);
        if ((++sp & 255u) == 0u) { if (xb_ld(&bar[XB_TMO])) break; if (sp > XB_SPIN_CAP) { atomicAdd(&bar[XB_TMO], 1u); break; } }
    }
    nloc = mine > 0u ? mine : 1u; nx = cnt > 0u ? cnt : 1u;
}

__device__ __forceinline__ void xcd_barrier(const XcdBarrier& b) {
    asm volatile("s_waitcnt vmcnt(0)" ::: "memory");
    __syncthreads();
    if (threadIdx.x == 0) {
        unsigned* bar = b.bar;
        __builtin_amdgcn_s_waitcnt(0);
        unsigned nloc = b.st[0], nx = b.st[1];
        if (nloc == 0u) { xcd_barrier_complete(bar, b.x, nloc, nx); b.st[0] = nloc; b.st[1] = nx; }
        const unsigned old = xb_add(&bar[XB_XSUB(b.x)], 1u);
        const unsigned gen = old / nloc;
        if (old + 1u == (gen + 1u) * nloc) {
            __builtin_amdgcn_fence(__ATOMIC_RELEASE, "agent");
            asm volatile("s_waitcnt vmcnt(0)" ::: "memory");
            const unsigned og = xb_add(&bar[XB_TOP], 1u);
            const unsigned tg = og / nx;
            if (og + 1u == (tg + 1u) * nx) xb_add(&bar[XB_TOPGEN], 1u);
            else XB_SPIN(xb_ld(&bar[XB_TOPGEN]) == tg, bar);
            __builtin_amdgcn_fence(__ATOMIC_ACQUIRE, "agent");
            xb_add(&bar[XB_XGEN(b.x)], 1u);
            asm volatile("s_waitcnt vmcnt(0)" ::: "memory");
        } else {
            XB_SPIN(xb_ld(&bar[XB_XGEN(b.x)]) == gen, bar);
            __builtin_amdgcn_fence(__ATOMIC_ACQUIRE, "agent");
            asm volatile("s_waitcnt vmcnt(0)" ::: "memory");
        }
    }
    __syncthreads();
}
namespace pg8 {
#define PG8_LAS __attribute__((address_space(3)))
constexpr int BM = 256, BK = 64, HALF = 128, HTB = HALF * BK * 2  , STAGE_BYTES = 8 * HTB, NXCD = 8, WGM = 8;

__host__ __device__ __forceinline__ int lds_byte(int r, int c) { const int st = (r >> 4) * 2 + (c >> 5), rr = r & 15, cc = c & 31, ob = rr * 64 + cc * 2; return st * 1024 + (ob ^ (((ob >> 9) & 1) << 5)); }
__host__ __device__ __forceinline__ void stage_rc(int b, int& R, int& C) { const int st = b / 1024, sb = b % 1024, swz = sb ^ (((sb >> 9) & 1) << 5); R = (st >> 1) * 16 + swz / 64; C = (st & 1) * 32 + (swz % 64) / 2; }
__host__ __device__ __forceinline__ int perm32(int rho) { const int n = rho >> 4, i = rho & 15; return 8 * (i >> 2) + 4 * n + (i & 3); }

struct Unit { int pm, pn; };
struct Gemm { const bf16_t* A; const bf16_t* Bt; int M, N, K; };

struct StaticOrder {
    int nM, nN, nwg, G, c;
    __host__ __device__ void init(int M, int N, int G_, int c_) { nM = M / BM; nN = N / BM; nwg = nM * nN; G = G_; c = c_; }
    __host__ __device__ bool next(int i, Unit& u) const {
        const long L = (long)i * G + c; if (L >= nwg) return false;
        int wgid = (int)L; { const int q = nwg / NXCD, r = nwg % NXCD, xcd = wgid % NXCD, off = wgid / NXCD; wgid = (xcd < r ? xcd * (q + 1) : r * (q + 1) + (xcd - r) * q) + off; }
        const int nig = WGM * nN, gid = wgid / nig, fm = gid * WGM, gsz = (nM - fm) < WGM ? (nM - fm) : WGM;
        u.pm = fm + ((wgid % nig) % gsz); u.pn = (wgid % nig) / gsz; return true;
    }
    __device__ __forceinline__ void a_ready(const Unit&) const {}
    __device__ __forceinline__ void done(const Unit&) const {}
};
template <class Epi, class Sched>
__device__ __forceinline__ void gemm_phase(PG8_LAS unsigned char* lds, const Gemm g, const Sched& S, const Epi& E, const int tid) {
    const int wid = __builtin_amdgcn_readfirstlane(tid >> 6), lane = tid & 63, wr = wid >> 2, wc = wid & 3, fr = lane & 15, fq = lane >> 4;
    const int K = g.K, nt = K / BK;
    unsigned voffA[2], voffB[2];
#pragma unroll
    for (int i = 0; i < 2; ++i) { int R, C; stage_rc(tid * 16 + i * 8192, R, C); const int Rb = Epi::PERM ? ((R & ~31) + perm32(R & 31)) : R;
        voffA[i] = (unsigned)(R * K + C) * 2u; voffB[i] = (unsigned)(Rb * K + C) * 2u; }
    const size_t kstep = (size_t)(BK * 2);
    const size_t hstep = (size_t)HALF * K * 2;
    const size_t tstep = 2 * hstep;
    const unsigned ldsw = (unsigned)wid * 1024u;
    const int aoff = lds_byte(wr * 64 + fr, fq * 8), boff = lds_byte(wc * 32 + fr, fq * 8);
#define PG8_SA(b, h) (((b) * 2 + (h)) * HTB)
#define PG8_SB(b, h) ((4 + (b) * 2 + (h)) * HTB)
#define PG8_STAGE(bufoff, gbase, voff) do { _Pragma("unroll") for (int _i = 0; _i < 2; ++_i) \
        __builtin_amdgcn_global_load_lds((const unsigned*)((const char*)(gbase) + (voff)[_i]), (PG8_LAS unsigned*)(lds + (bufoff) + ldsw + _i * 8192), 16, 0, 0); } while (0)
#define PG8_LDA(dst, b, h) do { _Pragma("unroll") for (int m = 0; m < 4; ++m) _Pragma("unroll") for (int k = 0; k < 2; ++k) dst[m][k] = *(const PG8_LAS bf16x8*)(lds + PG8_SA(b, h) + aoff + m * 2048 + k * 1024); } while (0)
#define PG8_LDB(dst, b, h) do { _Pragma("unroll") for (int n = 0; n < 2; ++n) _Pragma("unroll") for (int k = 0; k < 2; ++k) dst[n][k] = *(const PG8_LAS bf16x8*)(lds + PG8_SB(b, h) + boff + n * 2048 + k * 1024); } while (0)
#define PG8_MMA(ai, bj, At, Bt) do { __builtin_amdgcn_s_setprio(1); _Pragma("unroll") for (int m = 0; m < 4; ++m) _Pragma("unroll") for (int n = 0; n < 2; ++n) _Pragma("unroll") for (int k = 0; k < 2; ++k) \
        acc[ai][bj][m][n] = __builtin_amdgcn_mfma_f32_16x16x32_bf16(Bt[n][k], At[m][k], acc[ai][bj][m][n], 0, 0, 0); __builtin_amdgcn_s_setprio(0); } while (0)
#define PG8_WAIT_V(n) asm volatile("s_waitcnt vmcnt(" #n ")" ::: "memory")
#define PG8_WAIT_L(n) asm volatile("s_waitcnt lgkmcnt(" #n ")" ::: "memory")
#define PG8_BAR __builtin_amdgcn_s_barrier()
#define PG8_SCHED __builtin_amdgcn_sched_barrier(0)
    Unit cur, nxt; int ui = 0;
    if (!S.next(0, cur)) return;
    f32x4 acc[2][2][4][2];
#pragma unroll
    for (int a = 0; a < 2; ++a)
#pragma unroll
        for (int b = 0; b < 2; ++b)
#pragma unroll
            for (int m = 0; m < 4; ++m)
#pragma unroll
                for (int n = 0; n < 2; ++n) acc[a][b][m][n] = (f32x4){0.f, 0.f, 0.f, 0.f};
    bf16x8 At[4][2], B0[2][2], B1[2][2];
    const char* cA = (const char*)g.A + (size_t)cur.pm * tstep; const char* cB = (const char*)g.Bt + (size_t)cur.pn * tstep;
    S.a_ready(cur);
    PG8_STAGE(PG8_SB(0, 0), cB, voffB); PG8_STAGE(PG8_SA(0, 0), cA, voffA); PG8_STAGE(PG8_SB(0, 1), cB + hstep, voffB); PG8_STAGE(PG8_SA(0, 1), cA + hstep, voffA);
    if (wr == 1) PG8_BAR;
    PG8_WAIT_V(4); PG8_BAR;
    PG8_STAGE(PG8_SB(1, 0), cB + kstep, voffB); PG8_STAGE(PG8_SA(1, 0), cA + kstep, voffA); PG8_STAGE(PG8_SB(1, 1), cB + hstep + kstep, voffB);
    PG8_WAIT_V(6); PG8_BAR;
    for (;;) {
        const bool has_next = S.next(ui + 1, nxt);
        const char* nA = has_next ? (const char*)g.A + (size_t)nxt.pm * tstep : cA; const char* nB = has_next ? (const char*)g.Bt + (size_t)nxt.pn * tstep : cB;
        for (int t = 0; t < nt; t += 2) {
            const bool last = (t == nt - 2);
            const char* a1 = cA + (size_t)(t + 1) * kstep;
            const char* a2 = last ? nA : cA + (size_t)(t + 2) * kstep; const char* b2 = last ? nB : cB + (size_t)(t + 2) * kstep;
            const char* a3 = a2 + kstep; const char* b3 = b2 + kstep;
            if (last && has_next) S.a_ready(nxt);
            PG8_LDB(B0, 0, 0); PG8_SCHED; PG8_LDA(At, 0, 0); PG8_STAGE(PG8_SA(1, 1), a1 + hstep, voffA);
            PG8_WAIT_L(8); PG8_BAR; PG8_WAIT_L(0); PG8_MMA(0, 0, At, B0); PG8_BAR; PG8_SCHED;
            PG8_LDB(B1, 0, 1); PG8_STAGE(PG8_SB(0, 0), b2, voffB);
            PG8_BAR; PG8_WAIT_L(0); PG8_MMA(0, 1, At, B1); PG8_BAR;
            PG8_LDA(At, 0, 1); PG8_STAGE(PG8_SA(0, 0), a2, voffA);
            PG8_BAR; PG8_WAIT_L(0); PG8_MMA(1, 0, At, B0); PG8_BAR; PG8_SCHED;
            PG8_STAGE(PG8_SB(0, 1), b2 + hstep, voffB);
            PG8_WAIT_V(6); PG8_BAR; PG8_MMA(1, 1, At, B1); PG8_BAR;
            PG8_LDB(B0, 1, 0); PG8_SCHED; PG8_LDA(At, 1, 0); PG8_STAGE(PG8_SA(0, 1), a2 + hstep, voffA);
            PG8_WAIT_L(8); PG8_BAR; PG8_WAIT_L(0); PG8_MMA(0, 0, At, B0); PG8_BAR; PG8_SCHED;
            PG8_LDB(B1, 1, 1); PG8_STAGE(PG8_SB(1, 0), b3, voffB);
            PG8_BAR; PG8_WAIT_L(0); PG8_MMA(0, 1, At, B1); PG8_BAR;
            PG8_LDA(At, 1, 1); PG8_STAGE(PG8_SA(1, 0), a3, voffA);
            PG8_BAR; PG8_WAIT_L(0); PG8_MMA(1, 0, At, B0); PG8_BAR; PG8_SCHED;
            PG8_STAGE(PG8_SB(1, 1), b3 + hstep, voffB);
            PG8_WAIT_V(6); PG8_BAR; PG8_MMA(1, 1, At, B1); PG8_BAR;
        }
        E(acc, cur, wr, wc, fr, fq); S.done(cur);
        if (!has_next) break;
#pragma unroll
        for (int a = 0; a < 2; ++a)
#pragma unroll
            for (int b = 0; b < 2; ++b)
#pragma unroll
                for (int m = 0; m < 4; ++m)
#pragma unroll
                    for (int n = 0; n < 2; ++n) acc[a][b][m][n] = (f32x4){0.f, 0.f, 0.f, 0.f};
        cur = nxt; cA = nA; cB = nB; ++ui;
    }
    PG8_WAIT_V(0);
    if (wr == 0) PG8_BAR;
    PG8_BAR;
#undef PG8_SA
#undef PG8_SB
#undef PG8_STAGE
#undef PG8_LDA
#undef PG8_LDB
#undef PG8_MMA
#undef PG8_WAIT_V
#undef PG8_WAIT_L
#undef PG8_BAR
#undef PG8_SCHED
}
struct EpiF32 {
    static constexpr bool PERM = false;
    float* C; int ldc;
    __device__ __forceinline__ void operator()(const f32x4 (&acc)[2][2][4][2], const Unit& u, int wr, int wc, int fr, int fq) const {
        const int row0 = u.pm * BM + wr * 64 + fr, col0 = u.pn * BM + wc * 32 + 4 * fq;
#pragma unroll
        for (int ai = 0; ai < 2; ++ai)
#pragma unroll
            for (int m = 0; m < 4; ++m) { float* rowp = C + (size_t)(row0 + ai * HALF + m * 16) * ldc + col0;
#pragma unroll
                for (int bj = 0; bj < 2; ++bj)
#pragma unroll
                    for (int n = 0; n < 2; ++n) *(f32x4*)(rowp + bj * HALF + n * 16) = acc[ai][bj][m][n]; }
    }
};
struct EpiBf16P {
    static constexpr bool PERM = true;
    bf16_t* O; int ldc;
    __device__ __forceinline__ void operator()(const f32x4 (&acc)[2][2][4][2], const Unit& u, int wr, int wc, int fr, int fq) const {
        const int row0 = u.pm * BM + wr * 64 + fr, col0 = u.pn * BM + wc * 32 + 8 * fq;
#pragma unroll
        for (int ai = 0; ai < 2; ++ai)
#pragma unroll
            for (int m = 0; m < 4; ++m) { bf16_t* rowp = O + (size_t)(row0 + ai * HALF + m * 16) * ldc + col0;
#pragma unroll
                for (int bj = 0; bj < 2; ++bj) { const f32x4 v0 = acc[ai][bj][m][0], v1 = acc[ai][bj][m][1];
                    u32x4 w; w.x = cvt_pk_bf16(v0[0], v0[1]); w.y = cvt_pk_bf16(v0[2], v0[3]); w.z = cvt_pk_bf16(v1[0], v1[1]); w.w = cvt_pk_bf16(v1[2], v1[3]);
                    *(u32x4*)(rowp + bj * HALF) = w; } }
    }
};
struct EpiHgrn {
    static constexpr bool PERM = true;
    bf16_t* planes; size_t plane_elems; const float* lb;
    __device__ __forceinline__ void operator()(const f32x4 (&acc)[2][2][4][2], const Unit& u, int wr, int wc, int fr, int fq) const {
        const int plane = u.pn >> 2;
        const int row0 = u.pm * BM + wr * 64 + fr, col0 = (u.pn & 3) * BM + wc * 32 + 8 * fq;
        bf16_t* base = planes + (size_t)plane * plane_elems;
        float lbv[2][8];
        if (plane == 1 || plane == 2) {
#pragma unroll
            for (int bj = 0; bj < 2; ++bj)
#pragma unroll
                for (int e = 0; e < 8; ++e) lbv[bj][e] = lb[(plane - 1) * 1024 + col0 + bj * HALF + e];
        } else {
#pragma unroll
            for (int bj = 0; bj < 2; ++bj)
#pragma unroll
                for (int e = 0; e < 8; ++e) lbv[bj][e] = 0.f;
        }
#pragma unroll
        for (int ai = 0; ai < 2; ++ai)
#pragma unroll
            for (int m = 0; m < 4; ++m) { bf16_t* rowp = base + (size_t)(row0 + ai * HALF + m * 16) * 1024 + col0;
#pragma unroll
                for (int bj = 0; bj < 2; ++bj) { float v[8];
#pragma unroll
                    for (int e = 0; e < 4; ++e) { v[e] = acc[ai][bj][m][0][e]; v[4 + e] = acc[ai][bj][m][1][e]; }
                    if (plane == 0 || plane == 4) {
#pragma unroll
                        for (int e = 0; e < 8; ++e) v[e] = siluf_(v[e]);
                    } else if (plane == 1 || plane == 2) {
#pragma unroll
                        for (int e = 0; e < 8; ++e) { const float l = lbv[bj][e]; const float f = l + (1.0f - l) * sigmoidf_(v[e]); v[e] = fast_log(fmaxf(f, 1e-30f)); }
                    }
                    u32x4 w; w.x = cvt_pk_bf16(v[0], v[1]); w.y = cvt_pk_bf16(v[2], v[3]); w.z = cvt_pk_bf16(v[4], v[5]); w.w = cvt_pk_bf16(v[6], v[7]);
                    *(u32x4*)(rowp + bj * HALF) = w; } }
    }
};
struct EpiPle {
    static constexpr bool PERM = false;
    const bf16_t* Xin; const bf16_t* PP; const float* bias; bf16_t* XbOut; float* Fout;
    __device__ __forceinline__ void operator()(const f32x4 (&acc)[2][2][4][2], const Unit& u, int wr, int wc, int fr, int fq) const {
        const int row0 = u.pm * BM + wr * 64 + fr, col0 = u.pn * BM + wc * 32 + 4 * fq;
        f32x4 bv[2][2];
#pragma unroll
        for (int bj = 0; bj < 2; ++bj)
#pragma unroll
            for (int n = 0; n < 2; ++n) bv[bj][n] = *(const f32x4*)(bias + col0 + bj * HALF + n * 16);
#pragma unroll
        for (int ai = 0; ai < 2; ++ai)
#pragma unroll
            for (int m = 0; m < 4; ++m) { const size_t off = (size_t)(row0 + ai * HALF + m * 16) * 1024 + col0;
#pragma unroll
                for (int bj = 0; bj < 2; ++bj)
#pragma unroll
                    for (int n = 0; n < 2; ++n) { const size_t o2 = off + bj * HALF + n * 16;
                        const u32x2 xw = *(const u32x2*)(Xin + o2); const u32x2 pw = *(const u32x2*)(PP + o2); const f32x4 z = acc[ai][bj][m][n] + bv[bj][n];
                        f32x4 o; o[0] = bflo(xw.x) + sigmoidf_(z[0]) * bflo(pw.x); o[1] = bfhi(xw.x) + sigmoidf_(z[1]) * bfhi(pw.x); o[2] = bflo(xw.y) + sigmoidf_(z[2]) * bflo(pw.y); o[3] = bfhi(xw.y) + sigmoidf_(z[3]) * bfhi(pw.y);
                        if (Fout) *(f32x4*)(Fout + o2) = o; else { u32x2 w; w.x = cvt_pk_bf16(o[0], o[1]); w.y = cvt_pk_bf16(o[2], o[3]); *(u32x2*)(XbOut + o2) = w; } }
                if (m & 1) asm volatile("" ::: "memory"); }
    }
};
}
namespace attn {
constexpr int DV = 128, DQK = 192, NW = 8, QBLK = 32, KVBLK = 64;
constexpr float SCALE = MLA_SCALE;
constexpr float THR = 8.f;
constexpr int LDQ = 8 * DQK, LDKV = 8 * 256, LDKR = 64, LDO = 1024;
constexpr int KROWB = 400;
constexpr int SHM_V = KVBLK * DV * 2, SHM_K = KVBLK * KROWB, SHM_ATTN = 2 * SHM_V + 2 * SHM_K + NW * 64 * 4 + NW * 4096;
#define SBAR() __builtin_amdgcn_sched_barrier(0)
__device__ __forceinline__ int crow(int r, int hi) { return (r & 3) + 8 * (r >> 2) + 4 * hi; }

__device__ __forceinline__ void partialSM(f32x16& p0, f32x16& p1, float& m_reg, float& mn, float& alpha) {
  constexpr float C = SCALE * 1.4426950408889634f;
  float pmax = p0[0];
#pragma unroll
  for (int r = 1; r < 16; ++r) pmax = fmaxf(pmax, p0[r]);
#pragma unroll
  for (int r = 0; r < 16; ++r) pmax = fmaxf(pmax, p1[r]);
  { auto rr = __builtin_amdgcn_permlane32_swap(__float_as_uint(pmax), __float_as_uint(pmax), false, false);
    pmax = fmaxf(__uint_as_float(rr[0]), __uint_as_float(rr[1])); }
  if (__builtin_expect(__all(pmax - m_reg <= THR / SCALE), 1)) { mn = m_reg; alpha = 1.f; }
  else { mn = fmaxf(m_reg, pmax); alpha = __builtin_amdgcn_exp2f((m_reg - mn) * C); m_reg = mn; }
  float mnC = -mn * C;
#pragma unroll
  for (int r = 0; r < 16; ++r) p0[r] = fmaf(p0[r], C, mnC);
#pragma unroll
  for (int r = 0; r < 16; ++r) p1[r] = fmaf(p1[r], C, mnC);
#pragma unroll
  for (int r = 0; r < 16; ++r) p0[r] = __builtin_amdgcn_exp2f(p0[r]);
}
__device__ __forceinline__ void finishSM(f32x16& p0, f32x16& p1, float alpha, float& l_reg, bf16x8& pa0, bf16x8& pa1, bf16x8& pa2, bf16x8& pa3) {
#pragma unroll
  for (int r = 0; r < 16; ++r) p1[r] = __builtin_amdgcn_exp2f(p1[r]);
  float ps = 0;
#pragma unroll
  for (int r = 0; r < 16; ++r) ps += p0[r];
#pragma unroll
  for (int r = 0; r < 16; ++r) ps += p1[r];
  { auto rr = __builtin_amdgcn_permlane32_swap(__float_as_uint(ps), __float_as_uint(ps), false, false);
    ps = __uint_as_float(rr[0]) + __uint_as_float(rr[1]); }
  l_reg = l_reg * alpha + ps;
#define PK4(P, BASE, OUT) do { unsigned a0 = cvt_pk_bf16(P[BASE + 0], P[BASE + 1]), a1 = cvt_pk_bf16(P[BASE + 2], P[BASE + 3]);   \
    unsigned b0 = cvt_pk_bf16(P[BASE + 4], P[BASE + 5]), b1 = cvt_pk_bf16(P[BASE + 6], P[BASE + 7]);                              \
    auto r0 = __builtin_amdgcn_permlane32_swap(a0, b0, false, false); auto r1 = __builtin_amdgcn_permlane32_swap(a1, b1, false, false); \
    u32x4 w = {r0[0], r1[0], r0[1], r1[1]}; OUT = *reinterpret_cast<bf16x8*>(&w); } while (0)
  PK4(p0, 0, pa0); PK4(p0, 8, pa1); PK4(p1, 0, pa2); PK4(p1, 8, pa3);
#undef PK4
}
__device__ __forceinline__ void qkt(f32x16& p0, f32x16& p1, const char* Ks, const bf16x8* qr, const char* qrl, int r32, int hi) {
  p0 = f32x16{}; p1 = f32x16{};
  const char* k0 = Ks + r32 * KROWB + hi * 16; const char* k1 = Ks + (32 + r32) * KROWB + hi * 16;
  bf16x8 fa[2], fb[2], ga[2], gb[2], qx[2], qy[2];
#define QK_LD(FA, FB, QX, G) _Pragma("unroll") for (int i = 0; i < 2; ++i) { FA[i] = *reinterpret_cast<const bf16x8*>(k0 + ((G) * 2 + i) * 32); FB[i] = *reinterpret_cast<const bf16x8*>(k1 + ((G) * 2 + i) * 32); \
      if ((G) * 2 + i >= 8) QX[i] = *reinterpret_cast<const bf16x8*>(qrl + ((G) * 2 + i - 8) * 1024); }
#define QK_MM(FA, FB, QX, G) _Pragma("unroll") for (int i = 0; i < 2; ++i) { const bf16x8 qf = ((G) * 2 + i < 8) ? qr[((G) * 2 + i < 8) ? (G) * 2 + i : 0] : QX[i]; \
      p0 = __builtin_amdgcn_mfma_f32_32x32x16_bf16(FA[i], qf, p0, 0, 0, 0); p1 = __builtin_amdgcn_mfma_f32_32x32x16_bf16(FB[i], qf, p1, 0, 0, 0); }
  QK_LD(fa, fb, qx, 0) SBAR();
  QK_LD(ga, gb, qy, 1) SBAR(); QK_MM(fa, fb, qx, 0) SBAR();
  QK_LD(fa, fb, qx, 2) SBAR(); QK_MM(ga, gb, qy, 1) SBAR();
  QK_LD(ga, gb, qy, 3) SBAR(); QK_MM(fa, fb, qx, 2) SBAR();
  QK_LD(fa, fb, qx, 4) SBAR(); QK_MM(ga, gb, qy, 3) SBAR();
  QK_LD(ga, gb, qy, 5) SBAR(); QK_MM(fa, fb, qx, 4) SBAR();
  QK_MM(ga, gb, qy, 5) SBAR();
#undef QK_LD
#undef QK_MM
}
__device__ __forceinline__ int v_st(int k, int c) { const int kk = (k & ~0xC) | ((k & 4) << 1) | ((k & 8) >> 1); return ((kk >> 3) * 4 + (c >> 5)) * 512 + ((kk & 7) * 32 + (c & 31)) * 2; }
__device__ __forceinline__ int v_rd_base(int lane) { return ((lane & 3) << 3) | (((lane >> 2) & 3) << 6) | (((lane >> 4) & 1) << 5) | (((lane >> 5) & 1) << 8); }
constexpr int v_rd_off(int d0, int ks, int half) { return d0 * 512 + ks * 4096 + half * 2048; }
template <int OFF> __device__ __forceinline__ s16x4 tr_read(int vb) {
  s16x4 r; asm volatile("ds_read_b64_tr_b16 %0, %1 offset:%2" : "=&v"(r) : "v"(vb), "i"(OFF) : "memory"); return r;
}
template <int D0> __device__ __forceinline__ void pv_one(f32x16& od, int vb, bf16x8 pa0, bf16x8 pa1, bf16x8 pa2, bf16x8 pa3) {
  const s16x4 l0 = tr_read<v_rd_off(D0, 0, 0)>(vb), h0 = tr_read<v_rd_off(D0, 0, 1)>(vb), l1 = tr_read<v_rd_off(D0, 1, 0)>(vb), h1 = tr_read<v_rd_off(D0, 1, 1)>(vb);
  const s16x4 l2 = tr_read<v_rd_off(D0, 2, 0)>(vb), h2 = tr_read<v_rd_off(D0, 2, 1)>(vb), l3 = tr_read<v_rd_off(D0, 3, 0)>(vb), h3 = tr_read<v_rd_off(D0, 3, 1)>(vb);
  asm volatile("s_waitcnt lgkmcnt(0)" ::: "memory"); SBAR();
#define PK(L, H) (bf16x8){L[0], L[1], L[2], L[3], H[0], H[1], H[2], H[3]}
  od = __builtin_amdgcn_mfma_f32_32x32x16_bf16(pa0, PK(l0, h0), od, 0, 0, 0);
  od = __builtin_amdgcn_mfma_f32_32x32x16_bf16(pa1, PK(l1, h1), od, 0, 0, 0);
  od = __builtin_amdgcn_mfma_f32_32x32x16_bf16(pa2, PK(l2, h2), od, 0, 0, 0);
  od = __builtin_amdgcn_mfma_f32_32x32x16_bf16(pa3, PK(l3, h3), od, 0, 0, 0);
#undef PK
}
__device__ __forceinline__ void pv_d0(f32x16* o, int vb, bf16x8 pa0, bf16x8 pa1, bf16x8 pa2, bf16x8 pa3) {
  pv_one<0>(o[0], vb, pa0, pa1, pa2, pa3); pv_one<1>(o[1], vb, pa0, pa1, pa2, pa3); pv_one<2>(o[2], vb, pa0, pa1, pa2, pa3); pv_one<3>(o[3], vb, pa0, pa1, pa2, pa3);
}

template <int VAR> __device__ __forceinline__ void attn_body(const bf16_t* __restrict__ Qb, const bf16_t* __restrict__ Kn, const bf16_t* __restrict__ Kr,
                                          bf16_t* __restrict__ Ob, int seq, char* lds, int tid, int pos0, const float* __restrict__ ropeT) {
  asm volatile("" : "+v"(tid));
  const int wid = tid >> 6, lane = tid & 63, r32 = lane & 31, hi = lane >> 5;
  char* V_lds = lds; char* K_lds = lds + 2 * SHM_V;
  float* ws = (float*)(lds + 2 * SHM_V + 2 * SHM_K) + wid * 64; float* li_l = ws; float* al_l = ws + 32;
  float m_reg = -1e30f, l_reg = 0; f32x16 o[4] = {}; bf16x8 qr[8];
  char* qrl = lds + 2 * SHM_V + 2 * SHM_K + NW * 64 * 4 + wid * 4096 + lane * 16;
  const bf16_t* Qw = Qb + (long)(wid * QBLK + r32) * LDQ + hi * 8;
#pragma unroll
  for (int d0 = 0; d0 < 8; ++d0) qr[d0] = *reinterpret_cast<const bf16x8*>(Qw + d0 * 16);
  { const float* cp = ropeT + (size_t)(pos0 + wid * QBLK + r32) * 32 + hi * 8; const float* sp = cp + 8192 * 32;
#pragma unroll
    for (int dd = 0; dd < 2; ++dd) { const f32x4 c0 = *(const f32x4*)(cp + 16 * dd), c1 = *(const f32x4*)(cp + 16 * dd + 4), s0 = *(const f32x4*)(sp + 16 * dd), s1 = *(const f32x4*)(sp + 16 * dd + 4);
      const u32x4 A = *reinterpret_cast<const u32x4*>(Qw + (8 + dd) * 16), B = *reinterpret_cast<const u32x4*>(Qw + (10 + dd) * 16); u32x4 An, Bn;
#pragma unroll
      for (int w2 = 0; w2 < 4; ++w2) { const float cs0 = w2 < 2 ? c0[2 * w2] : c1[2 * w2 - 4], cs1 = w2 < 2 ? c0[2 * w2 + 1] : c1[2 * w2 - 3], sn0 = w2 < 2 ? s0[2 * w2] : s1[2 * w2 - 4], sn1 = w2 < 2 ? s0[2 * w2 + 1] : s1[2 * w2 - 3];
        const float a0 = bflo(A[w2]), a1 = bfhi(A[w2]), b0 = bflo(B[w2]), b1 = bfhi(B[w2]);
        An[w2] = cvt_pk_bf16(a0 * cs0 - b0 * sn0, a1 * cs1 - b1 * sn1); Bn[w2] = cvt_pk_bf16(b0 * cs0 + a0 * sn0, b1 * cs1 + a1 * sn1); }
      *reinterpret_cast<u32x4*>(qrl + dd * 1024) = An; *reinterpret_cast<u32x4*>(qrl + (2 + dd) * 1024) = Bn; } }
  const bf16_t* Vh = Kn + 128;
  const int sr = tid >> 4, sc = (tid & 15) * 8, vst0 = v_st(sr, sc), vst1 = v_st(32 + sr, sc);
  int krow[3], kcc[3];
#pragma unroll
  for (int i = 0; i < 3; ++i) { const int id = tid + 512 * i; krow[i] = id / 24; kcc[i] = id % 24; }
  const int vb0 = (int)(uintptr_t)V_lds + v_rd_base(lane);
  bf16x8 vs0, vs1, ks0, ks1, ks2;
#define KSRC(i, k0) (kcc[i] < 16 ? (Kn + (long)((k0) + krow[i]) * LDKV + kcc[i] * 8) : (Kr + (long)((k0) + krow[i]) * LDKR + (kcc[i] - 16) * 8))
#define SLOAD(k0) do { vs0 = *reinterpret_cast<const bf16x8*>(&Vh[(long)((k0) + sr) * LDKV + sc]); vs1 = *reinterpret_cast<const bf16x8*>(&Vh[(long)((k0) + 32 + sr) * LDKV + sc]); \
    ks0 = *reinterpret_cast<const bf16x8*>(KSRC(0, k0)); ks1 = *reinterpret_cast<const bf16x8*>(KSRC(1, k0)); ks2 = *reinterpret_cast<const bf16x8*>(KSRC(2, k0)); } while (0)
#define SWRITE(b) do { *(bf16x8*)(V_lds + (b) * SHM_V + vst0) = vs0; *(bf16x8*)(V_lds + (b) * SHM_V + vst1) = vs1; \
    *(bf16x8*)(K_lds + (b) * SHM_K + krow[0] * KROWB + kcc[0] * 16) = ks0; *(bf16x8*)(K_lds + (b) * SHM_K + krow[1] * KROWB + kcc[1] * 16) = ks1; \
    *(bf16x8*)(K_lds + (b) * SHM_K + krow[2] * KROWB + kcc[2] * 16) = ks2; } while (0)
#define SWAIT() asm volatile("s_waitcnt vmcnt(0)" ::: "memory")
#define RESC(a) do { if (__any((a) < 1.f)) { if (hi == 0) al_l[r32] = (a); asm volatile("s_waitcnt lgkmcnt(0)" ::: "memory"); \
    _Pragma("unroll") for (int d = 0; d < 4; ++d) _Pragma("unroll") for (int r = 0; r < 16; ++r) o[d][r] *= al_l[crow(r, hi)]; } } while (0)
  f32x16 pA0, pA1; float mnA, alA; bf16x8 pa0, pa1, pa2, pa3; const int NT = seq / KVBLK;
  SLOAD(0); SWAIT(); SWRITE(0); __syncthreads();
  for (int j = 0; j < NT; ++j) {
    const int b = j & 1;
    if (VAR != 4) { if (j + 1 < NT) SLOAD((j + 1) * KVBLK); }
    if (VAR != 3) { SBAR(); qkt(pA0, pA1, K_lds + b * SHM_K, qr, qrl, r32, hi); } else { pA0 = f32x16{}; pA1 = f32x16{}; pA0[0] = (float)j; }
    if (VAR != 2) { partialSM(pA0, pA1, m_reg, mnA, alA);
      RESC(alA);
      finishSM(pA0, pA1, alA, l_reg, pa0, pa1, pa2, pa3); SBAR(); }
    else { u32x4 w0 = {__float_as_uint(pA0[0]), __float_as_uint(pA0[5]), __float_as_uint(pA1[3]), __float_as_uint(pA1[9])}; pa0 = *reinterpret_cast<bf16x8*>(&w0); pa1 = pa0; pa2 = pa0; pa3 = pa0; l_reg += pA0[1]; }
    if (VAR != 1) pv_d0(o, vb0 + b * (int)SHM_V, pa0, pa1, pa2, pa3); else o[0][0] += bf2f((bf16_t)pa0[0]) + bf2f((bf16_t)pa3[7]);
    if (VAR != 4) { if (j + 1 < NT) { SWAIT(); SWRITE(b ^ 1); } }
    __syncthreads();
  }
  if (hi == 0) li_l[r32] = l_reg; asm volatile("s_waitcnt lgkmcnt(0)" ::: "memory");
  float rli[16];
#pragma unroll
  for (int r = 0; r < 16; ++r) rli[r] = __builtin_amdgcn_rcpf(li_l[crow(r, hi)]);
  bf16_t* Ow = Ob + (long)(wid * QBLK) * LDO;
#pragma unroll
  for (int r = 0; r < 16; ++r) { const int orow = crow(r, hi);
#pragma unroll
    for (int d0 = 0; d0 < 4; ++d0) Ow[(long)orow * LDO + d0 * 32 + r32] = f2bf(o[d0][r] * rli[r]); }
#undef KSRC
#undef SLOAD
#undef SWRITE
#undef SWAIT
#undef RESC
}
#undef SBAR
}
typedef const __attribute__((address_space(4))) Args* KArgs;
struct Ctx {
    KArgs a; float* out; unsigned char* ws;
    LAS unsigned char* lds;
    int tid, lane, wave, vcu, G, gw, NGW, bid;
    __device__ __forceinline__ const float* in(int i) const { return a->in[i]; }
};
__device__ __forceinline__ Ctx mk_ctx(unsigned char* lds_raw, int wave_s) {
    Ctx c; KArgs a = (KArgs)__builtin_amdgcn_kernarg_segment_ptr(); asm volatile("" : "+s"(a));
    c.a = a; c.out = a->out; c.ws = a->ws; c.lds = (LAS unsigned char*)lds_raw;
    c.tid = opaque_tid(wave_s); c.lane = c.tid & 63; c.wave = __builtin_amdgcn_readfirstlane(c.tid >> 6);
    c.G = (int)gridDim.x; c.bid = opaque_bid(); c.vcu = (c.G % 8 == 0) ? (c.bid % 8) * (c.G / 8) + c.bid / 8 : c.bid;
    c.gw = c.vcu * NWAVES + c.wave; c.NGW = c.G * NWAVES;
    return c;
}
__device__ __forceinline__ int tok_pos(int t) { return t < TP ? (t & (SP - 1)) : ((t - TP) & (SS - 1)); }

__device__ __forceinline__ void transpose_item(const float* W, int K, int N, bf16_t* WT, LAS float* scr, int item, int lane) {
    const int nblk = N / 32, kb = item / nblk, nb = item % nblk, k0 = 64 * kb, n0 = 32 * nb;
#pragma unroll 8
    for (int i = 0; i < 32; ++i) { const int kk = 2 * i + (lane >> 5); scr[kk * 33 + (lane & 31)] = W[(size_t)(k0 + kk) * N + n0 + (lane & 31)]; }
    LDS_WAIT(); asm volatile("" ::: "memory");
    const int c = lane & 7;
#pragma unroll
    for (int j = 0; j < 4; ++j) { const int n = (lane >> 3) + 8 * j; const LAS float* s = scr + (8 * c) * 33 + n;
        u32x4 o; o.x = cvt_pk_bf16(s[0 * 33], s[1 * 33]); o.y = cvt_pk_bf16(s[2 * 33], s[3 * 33]); o.z = cvt_pk_bf16(s[4 * 33], s[5 * 33]); o.w = cvt_pk_bf16(s[6 * 33], s[7 * 33]);
        *(u32x4*)(WT + (size_t)(n0 + n) * K + k0 + 8 * c) = o; }
    LDS_WAIT(); asm volatile("" ::: "memory");
}
struct MatDesc { int in_idx, K, N, Npad, copies; size_t dst; };
__device__ __forceinline__ void p0_prologue(const Ctx& c) {
    LAS float* scr = (LAS float*)(c.lds + c.wave * 16384);
    const MatDesc MATS[9] = {
        {4, 1024, 704, 768, 2, W_WA}, {7, 384, 1536, 1536, 2, W_WUQ}, {8, 256, 2048, 2048, 2, W_WUKV}, {9, 1024, 1024, 1024, 2, W_WO},
        {10, 1024, 5120, 5120, 2, W_HIN}, {13, 1024, 1024, 1024, 2, W_HO}, {14, 1024, 2048, 2048, 4, W_PQ}, {22, 1024, 1024, 1024, 4, W_GW}, {24, 256, 1024, 1024, 4, W_PP}};
    int total = 0;
#pragma unroll
    for (int m = 0; m < 9; ++m) total += MATS[m].copies * (MATS[m].K / 64) * (MATS[m].N / 32);
    for (int it = c.gw; it < total; it += c.NGW) {
        int r = it;
#pragma unroll
        for (int m = 0; m < 9; ++m) {
            const int per = (MATS[m].K / 64) * (MATS[m].N / 32), cnt = MATS[m].copies * per;
            if (r >= 0 && r < cnt) { const int cp = r / per, item = r % per;
                transpose_item(c.in(MATS[m].in_idx) + (size_t)cp * MATS[m].K * MATS[m].N, MATS[m].K, MATS[m].N,
                               (bf16_t*)(c.ws + MATS[m].dst) + (size_t)cp * MATS[m].Npad * MATS[m].K, scr, item, c.lane);
                r = -1; }
            else if (r >= 0) r -= cnt;
        }
    }
    const int gt = c.gw * 64 + c.lane, NGT = c.NGW * 64;
    for (int i = gt; i < 2 * 64 * 1024 / 8; i += NGT) { const int cp = i / (64 * 1024 / 8), o = i % (64 * 1024 / 8);
        *(u32x4*)((bf16_t*)(c.ws + W_WA) + (size_t)cp * 768 * 1024 + (size_t)704 * 1024 + o * 8) = (u32x4){0u, 0u, 0u, 0u}; }
    for (int i = gt; i < 4 * 2 * 128 * 128 / 4; i += NGT) { const f32x4 v = *(const f32x4*)(c.in(15) + (size_t)i * 4);
        u32x2 w; w.x = cvt_pk_bf16(v[0], v[1]); w.y = cvt_pk_bf16(v[2], v[3]); *(u32x2*)((bf16_t*)(c.ws + W_KEYS) + (size_t)i * 4) = w; }
    for (int i = gt; i < 8192 * 32; i += NGT) { const int pos = i >> 5, f = i & 31;
        const float inv = 1.0f / powf(10000.0f, (float)(2 * f) / 64.0f); const float ang = (float)pos * inv;
        ((float*)(c.ws + WS_ROPE))[i] = cosf(ang); ((float*)(c.ws + WS_ROPE))[8192 * 32 + i] = sinf(ang); }
    for (int i = gt; i < 2 * 1024; i += NGT) { const int dir = i >> 10, k = i & 1023;
        const float l0 = c.in(11)[(dir * 2 + 0) * 1024 + k], l1 = c.in(11)[(dir * 2 + 1) * 1024 + k];
        float* lb = (float*)(c.ws + WS_MISC);
        lb[(0 * 2 + dir) * 1024 + k] = 0.f; lb[(1 * 2 + dir) * 1024 + k] = 1.0f / (1.0f + expf(l0 - l1)); }
    for (int t = c.gw; t < T; t += c.NGW) {
        const float* xr = t < TP ? c.in(0) + (size_t)t * D : c.in(1) + (size_t)(t - TP) * D;
        bf16_t* brow = (bf16_t*)c.out + (size_t)t * D;
#pragma unroll
        for (int j = 0; j < 4; ++j) { const f32x4 v = *(const f32x4*)(xr + 256 * j + 4 * c.lane);
            u32x2 w; w.x = cvt_pk_bf16(v[0], v[1]); w.y = cvt_pk_bf16(v[2], v[3]); *(u32x2*)(brow + 256 * j + 4 * c.lane) = w; }
    }
}

__device__ __forceinline__ void cvt_range(const float* src, bf16_t* dst, size_t n8, int gt, int NGT) {
    for (size_t i = gt; i < n8; i += NGT) { const f32x4 a = *(const f32x4*)(src + i * 8), b = *(const f32x4*)(src + i * 8 + 4);
        u32x4 w; w.x = cvt_pk_bf16(a[0], a[1]); w.y = cvt_pk_bf16(a[2], a[3]); w.z = cvt_pk_bf16(b[0], b[1]); w.w = cvt_pk_bf16(b[2], b[3]); *(u32x4*)(dst + i * 8) = w; }
}
__device__ __forceinline__ void l0_convert(const Ctx& c, int layer) {
    const int gt = c.gw * 64 + c.lane, NGT = c.NGW * 64;
    for (int r = c.gw; r < 2 * NEXP; r += c.NGW) {
        const int m = r >= NEXP, e = r - m * NEXP;
        const float* src = c.in(16 + m) + ((size_t)layer * NEXP + e) * D + 16 * c.lane;
        f32x4 v[4]; float am = 0.f;
#pragma unroll
        for (int j = 0; j < 4; ++j) { v[j] = *(const f32x4*)(src + 4 * j); am = fmaxf(am, fmaxf(fmaxf(fabsf(v[j][0]), fabsf(v[j][1])), fmaxf(fabsf(v[j][2]), fabsf(v[j][3])))); }
        am = wave_max(am);
        const float sc = fmaxf(am, 1e-30f) * (1.0f / 440.0f), inv = 1.0f / sc;
        u32x4 w;
#pragma unroll
        for (int j = 0; j < 4; ++j) { int p = 0; p = __builtin_amdgcn_cvt_pk_fp8_f32(v[j][0] * inv, v[j][1] * inv, p, false); p = __builtin_amdgcn_cvt_pk_fp8_f32(v[j][2] * inv, v[j][3] * inv, p, true); w[j] = (unsigned)p; }
        *(u32x4*)(c.ws + (m ? R2_VB : R2_UB) + (size_t)e * D + 16 * c.lane) = w;
        if (c.lane == 0) ((float*)(c.ws + (m ? R2_SV : R2_SU)))[e] = sc;
    }
    cvt_range(c.in(2) + (size_t)layer * TP * 256, (bf16_t*)(c.ws + R2_PB), (size_t)TP * 256 / 8, gt, NGT);
    cvt_range(c.in(3) + (size_t)layer * TS * 256, (bf16_t*)(c.ws + R2_PB) + (size_t)TP * 256, (size_t)TS * 256 / 8, gt, NGT);
}

__device__ __forceinline__ void mla_e1(const Ctx& c, int j) {
    const bf16_t* a16 = (const bf16_t*)(c.ws + B_A32); bf16_t* cqn = (bf16_t*)(c.ws + B_CQN); bf16_t* ckvn = (bf16_t*)(c.ws + B_CKVN); bf16_t* krope = (bf16_t*)(c.ws + B_KROPE);
    const float* qnw = c.in(5) + j * 384; const float* kvnw = c.in(6) + j * 256;
    const float* cosT = (const float*)(c.ws + WS_ROPE); const float* sinT = cosT + 8192 * 32;
    const int lane = c.lane;
    constexpr int NU = 2;
    LAS float* scr = (LAS float*)(c.lds + c.wave * 1024);
    for (int t0 = c.gw * NU; t0 < T; t0 += c.NGW * NU) {
        f32x4 v0[NU], v1[NU], v2[NU];
#pragma unroll
        for (int u = 0; u < NU; ++u) { const bf16_t* ar = a16 + (size_t)(t0 + u) * 768;
            const u32x2 w0 = *(const u32x2*)(ar + 4 * lane), w1 = *(const u32x2*)(ar + 256 + 4 * lane), w2 = *(const u32x2*)(ar + 512 + 4 * lane);
            v0[u] = (f32x4){bflo(w0.x), bfhi(w0.x), bflo(w0.y), bfhi(w0.y)}; v1[u] = (f32x4){bflo(w1.x), bfhi(w1.x), bflo(w1.y), bfhi(w1.y)}; v2[u] = (f32x4){bflo(w2.x), bfhi(w2.x), bflo(w2.y), bfhi(w2.y)}; }
#pragma unroll
        for (int u = 0; u < NU; ++u) { const int t = t0 + u;
            const float s0 = v0[u][0] * v0[u][0] + v0[u][1] * v0[u][1] + v0[u][2] * v0[u][2] + v0[u][3] * v0[u][3];
            const float s1 = v1[u][0] * v1[u][0] + v1[u][1] * v1[u][1] + v1[u][2] * v1[u][2] + v1[u][3] * v1[u][3];
            const float s2 = v2[u][0] * v2[u][0] + v2[u][1] * v2[u][1] + v2[u][2] * v2[u][2] + v2[u][3] * v2[u][3];
            const float ssq = wave_sum(s0 + (lane < 32 ? s1 : 0.f));
            const float sskv = wave_sum((lane >= 32 ? s1 : 0.f) + (lane < 32 ? s2 : 0.f));
            const float rq = 1.0f / sqrtf(ssq * (1.0f / 384.0f) + RMS_EPS), rkv = 1.0f / sqrtf(sskv * (1.0f / 256.0f) + RMS_EPS);
            { const f32x4 w = *(const f32x4*)(qnw + 4 * lane); u32x2 o; o.x = cvt_pk_bf16(v0[u][0] * rq * w[0], v0[u][1] * rq * w[1]); o.y = cvt_pk_bf16(v0[u][2] * rq * w[2], v0[u][3] * rq * w[3]);
              *(u32x2*)(cqn + (size_t)t * 384 + 4 * lane) = o; }
            if (lane < 32) { const f32x4 w = *(const f32x4*)(qnw + 256 + 4 * lane); u32x2 o; o.x = cvt_pk_bf16(v1[u][0] * rq * w[0], v1[u][1] * rq * w[1]); o.y = cvt_pk_bf16(v1[u][2] * rq * w[2], v1[u][3] * rq * w[3]);
              *(u32x2*)(cqn + (size_t)t * 384 + 256 + 4 * lane) = o; }
            else { const int ix = 4 * (lane - 32); const f32x4 w = *(const f32x4*)(kvnw + ix); u32x2 o; o.x = cvt_pk_bf16(v1[u][0] * rkv * w[0], v1[u][1] * rkv * w[1]); o.y = cvt_pk_bf16(v1[u][2] * rkv * w[2], v1[u][3] * rkv * w[3]);
              *(u32x2*)(ckvn + (size_t)t * 256 + ix) = o; }
            if (lane < 32) { const int ix = 128 + 4 * lane; const f32x4 w = *(const f32x4*)(kvnw + ix); u32x2 o; o.x = cvt_pk_bf16(v2[u][0] * rkv * w[0], v2[u][1] * rkv * w[1]); o.y = cvt_pk_bf16(v2[u][2] * rkv * w[2], v2[u][3] * rkv * w[3]);
              *(u32x2*)(ckvn + (size_t)t * 256 + ix) = o; }
            else if (lane < 48) { *(LAS f32x4*)(scr + 4 * (lane - 32)) = v2[u]; }
            LDS_WAIT(); asm volatile("" ::: "memory");
            if (lane < 32) { const int pos = tok_pos(t); const float a = scr[lane], b = scr[lane + 32], cs = cosT[pos * 32 + lane], sn = sinT[pos * 32 + lane];
                krope[(size_t)t * 64 + lane] = f2bf(a * cs - b * sn); krope[(size_t)t * 64 + 32 + lane] = f2bf(b * cs + a * sn); }
            LDS_WAIT(); asm volatile("" ::: "memory"); }
    }
}
__device__ __forceinline__ void mla_qrope(const Ctx& c) {
    bf16_t* q = (bf16_t*)(c.ws + B_Q);
    const float* cosT = (const float*)(c.ws + WS_ROPE); const float* sinT = cosT + 8192 * 32;
    const int lane = c.lane, i = lane & 31;
    for (int t = c.gw; t < T; t += c.NGW) {
        const int pos = tok_pos(t); const float cs = cosT[pos * 32 + i], sn = sinT[pos * 32 + i];
#pragma unroll
        for (int k = 0; k < 4; ++k) { const int h = (lane >> 5) + 2 * k; bf16_t* p = q + (size_t)t * 1536 + h * 192 + 128 + i;
            const float a = bf2f(p[0]), b = bf2f(p[32]); p[0] = f2bf(a * cs - b * sn); p[32] = f2bf(b * cs + a * sn); }
    }
}
template <int VAR> __device__ __forceinline__ void mla_attention(const Ctx& c) {
    const bf16_t* Q = (const bf16_t*)(c.ws + B_Q); const bf16_t* KV = (const bf16_t*)(c.ws + B_KV); const bf16_t* KR = (const bf16_t*)(c.ws + B_KROPE); bf16_t* O = VAR ? (bf16_t*)c.out + (size_t)T * 1024 : (bf16_t*)(c.ws + B_O);
    const int NU = 512 + 2048;
    for (int u = c.bid; u < NU; u += c.G) {
        int tok0, qb, h, seq;
        if (u < 512) { const int round = u >> 8, cc = u & 255, bh = round * 8 + (cc & 7); tok0 = (bh >> 3) * SP; h = bh & 7; qb = cc >> 3; seq = SP; }
        else { const int us = u - 512, round = us >> 8, cc = us & 255, r = cc >> 3, bh = round * 32 + (cc & 7) * 4 + (r >> 3); tok0 = TP + (bh >> 3) * SS; h = bh & 7; qb = r & 7; seq = SS; }
        attn::attn_body<VAR>(Q + (size_t)(tok0 + qb * 256) * 1536 + h * 192, KV + (size_t)tok0 * 2048 + h * 256, KR + (size_t)tok0 * 64,
                        O + (size_t)(tok0 + qb * 256) * 1024 + h * 128, seq, (char*)c.lds, c.tid, qb * 256, (const float*)(c.ws + WS_ROPE));
        __syncthreads();
    }
}
template <int NU, bool W8> __device__ __forceinline__ void ln_rows(f32x4 (&v)[NU][4], const float* g, const float* b, int lane, bf16_t* const (&dst)[NU], unsigned char* const (&dst8)[NU], float* const (&dsc)[NU]) {
    float s[NU], s2[NU];
#pragma unroll
    for (int u = 0; u < NU; ++u) { s[u] = 0.f;
#pragma unroll
        for (int j = 0; j < 4; ++j) s[u] += (v[u][j][0] + v[u][j][1]) + (v[u][j][2] + v[u][j][3]); }
#pragma unroll
    for (int u = 0; u < NU; ++u) s[u] = wave_sum(s[u]) * (1.0f / D);
#pragma unroll
    for (int u = 0; u < NU; ++u) { s2[u] = 0.f;
#pragma unroll
        for (int j = 0; j < 4; ++j) { v[u][j] = v[u][j] - s[u]; s2[u] += (v[u][j][0] * v[u][j][0] + v[u][j][1] * v[u][j][1]) + (v[u][j][2] * v[u][j][2] + v[u][j][3] * v[u][j][3]); } }
#pragma unroll
    for (int u = 0; u < NU; ++u) s2[u] = 1.0f / sqrtf(wave_sum(s2[u]) * (1.0f / D) + LN_EPS);
    float am[NU];
#pragma unroll
    for (int u = 0; u < NU; ++u) am[u] = 0.f;
#pragma unroll
    for (int j = 0; j < 4; ++j) { const f32x4 gg = *(const f32x4*)(g + 256 * j + 4 * lane), bb = *(const f32x4*)(b + 256 * j + 4 * lane);
#pragma unroll
        for (int u = 0; u < NU; ++u) { const f32x4 o = v[u][j] * s2[u] * gg + bb; u32x2 w; w.x = cvt_pk_bf16(o[0], o[1]); w.y = cvt_pk_bf16(o[2], o[3]); *(u32x2*)(dst[u] + 256 * j + 4 * lane) = w;
            if (W8) { v[u][j] = o; am[u] = fmaxf(am[u], fmaxf(fmaxf(fabsf(o[0]), fabsf(o[1])), fmaxf(fabsf(o[2]), fabsf(o[3])))); } } }
    if (W8) {
#pragma unroll
        for (int u = 0; u < NU; ++u) { const float mx = fmaxf(wave_max(am[u]), 1e-20f), inv = 240.0f / mx;
#pragma unroll
            for (int j = 0; j < 4; ++j) { int q = 0; q = __builtin_amdgcn_cvt_pk_fp8_f32(v[u][j][0] * inv, v[u][j][1] * inv, q, false); q = __builtin_amdgcn_cvt_pk_fp8_f32(v[u][j][2] * inv, v[u][j][3] * inv, q, true);
                *(unsigned*)(dst8[u] + 256 * j + 4 * lane) = (unsigned)q; }
            if (lane == 0) *dsc[u] = mx * (1.0f / 240.0f); }
    }
}
__device__ __forceinline__ void ln_residual(const Ctx& c, const bf16_t* hb, const float* g, const float* b) {
    const bf16_t* xm = (const bf16_t*)c.out; bf16_t* xa = (bf16_t*)(c.ws + WS_XB); const int lane = c.lane;
    constexpr int NU = 4;
    for (int t0 = c.gw * NU; t0 < T; t0 += c.NGW * NU) {
        f32x4 v[NU][4]; bf16_t* dst[NU]; unsigned char* dst8[NU]; float* dsc[NU];
#pragma unroll
        for (int u = 0; u < NU; ++u) { const bf16_t* xr = xm + (size_t)(t0 + u) * D; const bf16_t* hr = hb + (size_t)(t0 + u) * D; dst[u] = xa + (size_t)(t0 + u) * D;
            dst8[u] = c.ws + B_X8 + (size_t)(t0 + u) * D; dsc[u] = (float*)(c.ws + B_XS) + (t0 + u);
#pragma unroll
            for (int j = 0; j < 4; ++j) { const u32x2 xw = *(const u32x2*)(xr + 256 * j + 4 * lane), hw = *(const u32x2*)(hr + 256 * j + 4 * lane);
                v[u][j] = (f32x4){bflo(xw.x), bfhi(xw.x), bflo(xw.y), bfhi(xw.y)} * DN_ALPHA + (f32x4){bflo(hw.x), bfhi(hw.x), bflo(hw.y), bfhi(hw.y)}; } }
        ln_rows<NU, false>(v, g, b, lane, dst, dst8, dsc);
    }
}
__device__ __forceinline__ void hgrn_post(const Ctx& c, int j) {
    bf16_t* pl = (bf16_t*)(c.ws + B_PLANE); const size_t PE = (size_t)T * 1024;
    const bf16_t* of = pl + 1 * PE; const bf16_t* ob = pl + 2 * PE; const bf16_t* sg = pl + 4 * PE; bf16_t* on = pl;
    const float* nw = c.in(12) + j * 128; const int lane = c.lane;
    const int cw = (8 * lane) & 127; const f32x4 w0 = *(const f32x4*)(nw + cw), w1 = *(const f32x4*)(nw + cw + 4);
    constexpr int NU = 4;
    for (int t0 = c.gw * NU; t0 < T; t0 += c.NGW * NU) {
        u32x4 a[NU][2], b[NU][2], g[NU][2];
#pragma unroll
        for (int u = 0; u < NU; ++u)
#pragma unroll
            for (int k = 0; k < 2; ++k) { const size_t off = (size_t)(t0 + u) * 1024 + 512 * k + 8 * lane;
                a[u][k] = *(const u32x4*)(of + off); b[u][k] = *(const u32x4*)(ob + off); g[u][k] = *(const u32x4*)(sg + off); }
#pragma unroll
        for (int u = 0; u < NU; ++u)
#pragma unroll
            for (int k = 0; k < 2; ++k) { const size_t off = (size_t)(t0 + u) * 1024 + 512 * k + 8 * lane;
                float o[8], gg[8]; float ss = 0.f;
#pragma unroll
                for (int q = 0; q < 4; ++q) { o[2 * q] = bflo(a[u][k][q]) + bflo(b[u][k][q]); o[2 * q + 1] = bfhi(a[u][k][q]) + bfhi(b[u][k][q]); gg[2 * q] = bflo(g[u][k][q]); gg[2 * q + 1] = bfhi(g[u][k][q]); }
#pragma unroll
                for (int e = 0; e < 8; ++e) ss += o[e] * o[e];
                ss = row16_sum(ss);
                const float r = 1.0f / sqrtf(ss * (1.0f / 128.0f) + RMS_EPS);
                u32x4 w; w.x = cvt_pk_bf16(o[0] * r * w0[0] * gg[0], o[1] * r * w0[1] * gg[1]); w.y = cvt_pk_bf16(o[2] * r * w0[2] * gg[2], o[3] * r * w0[3] * gg[3]);
                w.z = cvt_pk_bf16(o[4] * r * w1[0] * gg[4], o[5] * r * w1[1] * gg[5]); w.w = cvt_pk_bf16(o[6] * r * w1[2] * gg[6], o[7] * r * w1[3] * gg[7]);
                *(u32x4*)(on + off) = w; }
    }
}
namespace scan {
constexpr size_t D_F = R2_IDX, D_B = R2_IDX + 12 * MiB;
constexpr int NCH = T / 32;
__device__ __forceinline__ void hgrn_prep(const Ctx& c, int dup) {
    bf16_t* pl = (bf16_t*)(c.ws + B_PLANE); const size_t PE = (size_t)T * 1024;
    bf16_t* qs = pl; bf16_t* lff = pl + PE; bf16_t* lfb = pl + 2 * PE; bf16_t* qtb = (bf16_t*)(c.ws + WS_XB);
    float* dF = (float*)(c.ws + D_F); float* dB = (float*)(c.ws + D_B);
    const int lane = c.lane;
#define PREP_STEP(LW, QW, QDST, KDST, R0, R1) { const unsigned lw = (LW), qw = (QW); const float l0 = bflo(lw), l1 = bfhi(lw); R0 += l0; R1 += l1; \
        const float k0 = 1.0f - fast_exp(l0), k1 = 1.0f - fast_exp(l1); \
        *(unsigned*)(QDST) = cvt_pk_bf16(bflo(qw) * fast_exp(R0), bfhi(qw) * fast_exp(R1)); \
        *(unsigned*)(KDST) = cvt_pk_bf16(k0 * fast_exp(fminf(-R0, 80.f)), k1 * fast_exp(fminf(-R1, 80.f))); }
    const char* qsB = (const char*)qs; const char* lffB = (const char*)lff; const char* lfbB = (const char*)lfb; const char* qtbB = (const char*)qtb;
    char* dmy = (char*)((bf16_t*)c.out + (size_t)T * 1024);
    char* qsW = dup ? dmy : (char*)qs; char* lffW = dup ? dmy : (char*)lff; char* lfbW = dup ? dmy : (char*)lfb; char* qtbW = dup ? dmy : (char*)qtb;
    if (dup) { dF = (float*)dmy; dB = (float*)dmy; }
    for (int it = c.gw; it < NCH * 8; it += c.NGW) {
        const int chunk = it >> 3, h = it & 7; const unsigned base = ((unsigned)chunk * 32u * 1024u + (unsigned)h * 128u + 2u * (unsigned)lane) * 2u;
        float b0 = 0.f, b1 = 0.f, f0 = 0.f, f1 = 0.f;
#define LDW(P, O) (*(const unsigned*)((P) + (O)))
#define STP(P, O) ((unsigned*)((char*)(P) + (O)))
        { unsigned wb[16], wq[16];
#pragma unroll
          for (int i = 0; i < 16; ++i) { const unsigned o = base + (unsigned)(16 + i) * 2048u; wb[i] = LDW(lfbB, o); wq[i] = LDW(qsB, o); }
#pragma unroll
          for (int i = 15; i >= 0; --i) { const unsigned o = base + (unsigned)(16 + i) * 2048u; PREP_STEP(wb[i], wq[i], STP(qtbW, o), STP(lfbW, o), b0, b1) } }
        { unsigned wb[16], wq[16], wf[16];
#pragma unroll
          for (int i = 0; i < 16; ++i) { const unsigned o = base + (unsigned)i * 2048u; wb[i] = LDW(lfbB, o); wq[i] = LDW(qsB, o); wf[i] = LDW(lffB, o); }
#pragma unroll
          for (int i = 15; i >= 0; --i) { const unsigned o = base + (unsigned)i * 2048u; PREP_STEP(wb[i], wq[i], STP(qtbW, o), STP(lfbW, o), b0, b1) }
          *(f32x2*)(dB + (size_t)chunk * 1024 + h * 128 + 2 * lane) = (f32x2){fast_exp(b0), fast_exp(b1)};
#pragma unroll
          for (int i = 0; i < 16; ++i) { const unsigned o = base + (unsigned)i * 2048u; PREP_STEP(wf[i], wq[i], STP(qsW, o), STP(lffW, o), f0, f1) } }
        { unsigned wf[16], wq[16];
#pragma unroll
          for (int i = 0; i < 16; ++i) { const unsigned o = base + (unsigned)(16 + i) * 2048u; wf[i] = LDW(lffB, o); wq[i] = LDW(qsB, o); }
#pragma unroll
          for (int i = 0; i < 16; ++i) { const unsigned o = base + (unsigned)(16 + i) * 2048u; PREP_STEP(wf[i], wq[i], STP(qsW, o), STP(lffW, o), f0, f1) }
          *(f32x2*)(dF + (size_t)chunk * 1024 + h * 128 + 2 * lane) = (f32x2){fast_exp(f0), fast_exp(f1)}; }
    }
#undef LDW
#undef STP
#undef PREP_STEP
}

constexpr int QT_OFF = 0, KT_OFF = 8192, V_OFF = 16384, P_OFF = 24576, ST_OFF = 34816, DV_OFF = 69632, CHAIN_BYTES = 70144;
constexpr int RS = 272, RS2 = 80;
__device__ __forceinline__ int crow(int r, int hi) { return (r & 3) + 8 * (r >> 2) + 4 * hi; }
__device__ __forceinline__ unsigned off_b(unsigned row, unsigned ch) { return 256u * row + 16u * (ch ^ (((row & 3) << 2) | ((row >> 2) & 3))); }
__device__ __forceinline__ unsigned row_read_addr(unsigned lane, unsigned s) { return off_b(lane & 31, 2 * s + (lane >> 5)); }
__device__ __forceinline__ unsigned tr_read_addr(unsigned lane, unsigned cc, unsigned ks, unsigned t) {
    const unsigned h = lane >> 5, blk = (lane >> 4) & 1, q = (lane & 15) >> 2, p = lane & 3;
    return off_b(16 * ks + 8 * h + 4 * t + q, 4 * cc + 2 * blk + (p >> 1)) + 8 * (p & 1);
}
__device__ __forceinline__ s16x4 tr_rd(unsigned addr) { s16x4 r; asm volatile("ds_read_b64_tr_b16 %0, %1" : "=&v"(r) : "v"(addr) : "memory"); return r; }
#define TRPK(L, H) (bf16x8){L[0], L[1], L[2], L[3], H[0], H[1], H[2], H[3]}

template <int VAR> __device__ __forceinline__ void run_pair(const Ctx& c, int tok0, int L, int h, int dirsel, bool dummy) {
    bf16_t* pl = (bf16_t*)(c.ws + B_PLANE); const size_t PE = (size_t)T * 1024;
    const int tid = c.tid, lane = c.lane, wave = c.wave, ch = dirsel < 0 ? (wave >> 2) : dirsel, w = wave & 3, r32 = lane & 31, hi = lane >> 5;
    const bool active = dirsel < 0 || wave < 4;
    const int NCs = L / 32;
    if (!active) { __syncthreads(); for (int ci = 0; ci < NCs; ++ci) { __syncthreads(); __syncthreads(); } return; }
    const bf16_t* qt = ch ? (const bf16_t*)(c.ws + WS_XB) : pl; bf16_t* kt = pl + (size_t)(1 + ch) * PE; const bf16_t* vv = pl + 3 * PE;
    const float* dd = (const float*)(c.ws + (ch ? D_B : D_F));
    bf16_t* odst = dummy ? (bf16_t*)c.out + (size_t)T * 1024 : kt;
    LAS unsigned char* base = c.lds + (wave >> 2) * CHAIN_BYTES;
    const unsigned lbase = (unsigned)(uintptr_t)base;
    const int ctid = tid & 255;
    const int NC = L / 32;
    const int vcol = 32 * w + r32;
    LAS unsigned char* Pw = base + P_OFF + w * 2560;
    const int s_r0 = ctid >> 4, s_chn = ctid & 15;
    u32x4 sreg[6]; f32x4 dreg = (f32x4){0.f, 0.f, 0.f, 0.f};
#define SCAN_LOAD(cidx) do { const size_t rowb = (size_t)(tok0 + 32 * (cidx)) * 1024 + h * 128; \
        _Pragma("unroll") for (int i = 0; i < 6; ++i) { const bf16_t* src = ((i >> 1) == 0 ? qt : ((i >> 1) == 1 ? (const bf16_t*)kt : vv)) + rowb + (size_t)(s_r0 + 16 * (i & 1)) * 1024 + s_chn * 8; sreg[i] = *(const u32x4*)src; } \
        if (ctid < 32) dreg = *(const f32x4*)(dd + (size_t)((tok0 >> 5) + (cidx)) * 1024 + h * 128 + 4 * ctid); } while (0)
#define SCAN_WRITE() do { _Pragma("unroll") for (int i = 0; i < 6; ++i) *(LAS u32x4*)(base + (i >> 1) * 8192 + off_b(s_r0 + 16 * (i & 1), s_chn)) = sreg[i]; \
        if (ctid < 32) *(LAS f32x4*)(base + DV_OFF + 16 * ctid) = dreg; } while (0)
    { LAS u32x4* st = (LAS u32x4*)(base + ST_OFF + (32 * w) * RS); for (int i = lane; i < 32 * RS / 16; i += 64) st[i] = (u32x4){0u, 0u, 0u, 0u}; }
    f32x16 S[4];
#pragma unroll
    for (int kt2 = 0; kt2 < 4; ++kt2) S[kt2] = f32x16{};
    SCAN_LOAD(ch ? NC - 1 : 0); SCAN_WRITE();
    __syncthreads();
    for (int ci = 0; ci < NC; ++ci) {
        const int cidx = ch ? NC - 1 - ci : ci;
        if (VAR != 4) { if (ci + 1 < NC) SCAN_LOAD(ch ? cidx - 1 : cidx + 1); }
        f32x16 X = f32x16{};
        if (VAR != 3) {
#pragma unroll
        for (int ks = 0; ks < 8; ++ks) { const bf16x8 qa = *(const LAS bf16x8*)(base + QT_OFF + row_read_addr(lane, ks));
            const bf16x8 kb = *(const LAS bf16x8*)(base + KT_OFF + row_read_addr(lane, ks));
            X = __builtin_amdgcn_mfma_f32_32x32x16_bf16(qa, kb, X, 0, 0, 0); }
        }
        if (VAR != 3)
#pragma unroll
        for (int r = 0; r < 16; ++r) { const int t = crow(r, hi); const bool keep = ch ? (t <= r32) : (t >= r32); *(LAS bf16_t*)(Pw + t * RS2 + r32 * 2) = f2bf(keep ? X[r] : 0.f); }
        s16x4 vl[2], vh[2];
#pragma unroll
        for (int ks = 0; ks < 2; ++ks) { vl[ks] = tr_rd(lbase + V_OFF + tr_read_addr(lane, w, ks, 0)); vh[ks] = tr_rd(lbase + V_OFF + tr_read_addr(lane, w, ks, 1)); }
        asm volatile("s_waitcnt lgkmcnt(0)" ::: "memory"); __builtin_amdgcn_sched_barrier(0);
        bf16x8 vb[2];
#pragma unroll
        for (int ks = 0; ks < 2; ++ks) vb[ks] = TRPK(vl[ks], vh[ks]);
        f32x16 O = f32x16{};
#pragma unroll
        for (int ks = 0; ks < 2; ++ks) { const bf16x8 pa = *(const LAS bf16x8*)(Pw + r32 * RS2 + (16 * ks + 8 * hi) * 2);
            O = __builtin_amdgcn_mfma_f32_32x32x16_bf16(pa, vb[ks], O, 0, 0, 0); }
#pragma unroll
        for (int ks = 0; ks < 8; ++ks) { const bf16x8 sb = *(const LAS bf16x8*)(base + ST_OFF + vcol * RS + (16 * ks + 8 * hi) * 2);
            const bf16x8 qa = *(const LAS bf16x8*)(base + QT_OFF + row_read_addr(lane, ks));
            O = __builtin_amdgcn_mfma_f32_32x32x16_bf16(qa, sb, O, 0, 0, 0); }
#pragma unroll
        for (int r = 0; r < 16; ++r) { const int t = tok0 + 32 * cidx + crow(r, hi); if (VAR != 1 || r == 0) odst[(size_t)t * 1024 + h * 128 + vcol] = f2bf(O[r] + (VAR == 1 ? O[(r + 5) & 15] + O[(r + 11) & 15] : 0.f)); }
        if (VAR != 2) {
            s16x4 al[4][2], ah[4][2];
#pragma unroll
            for (int kt2 = 0; kt2 < 4; ++kt2)
#pragma unroll
                for (int ks = 0; ks < 2; ++ks) { al[kt2][ks] = tr_rd(lbase + KT_OFF + tr_read_addr(lane, kt2, ks, 0)); ah[kt2][ks] = tr_rd(lbase + KT_OFF + tr_read_addr(lane, kt2, ks, 1)); }
            asm volatile("s_waitcnt lgkmcnt(0)" ::: "memory"); __builtin_amdgcn_sched_barrier(0);
#pragma unroll
            for (int kt2 = 0; kt2 < 4; ++kt2)
#pragma unroll
                for (int ks = 0; ks < 2; ++ks) S[kt2] = __builtin_amdgcn_mfma_f32_32x32x16_bf16(TRPK(al[kt2][ks], ah[kt2][ks]), vb[ks], S[kt2], 0, 0, 0);
            unsigned stw = (unsigned)(vcol * RS + 8 * hi), dvo = (unsigned)(16 * hi); asm volatile("" : "+v"(stw), "+v"(dvo));
            f32x4 dq[2][4];
#define SCAN_DLOAD(KT2) _Pragma("unroll") for (int g = 0; g < 4; ++g) dq[(KT2) & 1][g] = *(const LAS f32x4*)(base + DV_OFF + dvo + 128 * (KT2) + 32 * g);
#define SCAN_DECAY(KT2) _Pragma("unroll") for (int g = 0; g < 4; ++g) { const f32x4 d4 = dq[(KT2) & 1][g]; \
                _Pragma("unroll") for (int e = 0; e < 4; ++e) S[KT2][4 * g + e] *= d4[e]; \
                u32x2 pk; pk.x = cvt_pk_bf16(S[KT2][4 * g], S[KT2][4 * g + 1]); pk.y = cvt_pk_bf16(S[KT2][4 * g + 2], S[KT2][4 * g + 3]); \
                *(LAS u32x2*)(base + ST_OFF + stw + 64 * (KT2) + 16 * g) = pk; }
            SCAN_DLOAD(0) SCAN_DLOAD(1)
            SCAN_DECAY(0) SCAN_DLOAD(2)
            SCAN_DECAY(1) SCAN_DLOAD(3)
            SCAN_DECAY(2) SCAN_DECAY(3)
#undef SCAN_DLOAD
#undef SCAN_DECAY
        }
        __syncthreads();
        if (VAR != 4) { if (ci + 1 < NC) SCAN_WRITE(); }
        __syncthreads();
    }
#undef SCAN_LOAD
#undef SCAN_WRITE
}
#undef TRPK
template <int VAR> __device__ __forceinline__ void hgrn_scan(const Ctx& c, bool dummy) {
    const int NI = 32 + 256;
    for (int rnd = 0;; ++rnd) {
        if (rnd * c.G >= NI) break;
        const int it = (rnd & 1) ? (rnd * c.G + (c.G - 1 - c.bid)) : (rnd * c.G + c.bid);
        if (it < NI) {
            const bool pr = it < 32;
            run_pair<VAR>(c, pr ? (it >> 4) * SP : TP + ((it - 32) >> 3) * SS, pr ? SP : SS, pr ? ((it >> 1) & 7) : ((it - 32) & 7), pr ? (it & 1) : -1, dummy);
        }
    }
}
}
#define CE_(a, i, j) { const unsigned _x = a[i] > a[j] ? a[i] : a[j], _y = a[i] > a[j] ? a[j] : a[i]; a[i] = _x; a[j] = _y; }
__device__ __forceinline__ void sort16_desc(unsigned (&a)[16]) {
    CE_(a, 0, 1) CE_(a, 2, 3) CE_(a, 0, 2) CE_(a, 1, 3) CE_(a, 1, 2) CE_(a, 4, 5) CE_(a, 6, 7) CE_(a, 4, 6) CE_(a, 5, 7) CE_(a, 5, 6) CE_(a, 0, 4) CE_(a, 2, 6) CE_(a, 2, 4) CE_(a, 1, 5) CE_(a, 3, 7) CE_(a, 3, 5) CE_(a, 1, 2) CE_(a, 3, 4) CE_(a, 5, 6) CE_(a, 8, 9) CE_(a, 10, 11) CE_(a, 8, 10) CE_(a, 9, 11) CE_(a, 9, 10) CE_(a, 12, 13) CE_(a, 14, 15) CE_(a, 12, 14) CE_(a, 13, 15) CE_(a, 13, 14) CE_(a, 8, 12) CE_(a, 10, 14) CE_(a, 10, 12) CE_(a, 9, 13) CE_(a, 11, 15) CE_(a, 11, 13) CE_(a, 9, 10) CE_(a, 11, 12) CE_(a, 13, 14) CE_(a, 0, 8) CE_(a, 4, 12) CE_(a, 4, 8) CE_(a, 2, 10) CE_(a, 6, 14) CE_(a, 6, 10) CE_(a, 2, 4) CE_(a, 6, 8) CE_(a, 10, 12) CE_(a, 1, 9) CE_(a, 5, 13) CE_(a, 5, 9) CE_(a, 3, 11) CE_(a, 7, 15) CE_(a, 7, 11) CE_(a, 3, 5) CE_(a, 7, 9) CE_(a, 11, 13) CE_(a, 1, 2) CE_(a, 3, 4) CE_(a, 5, 6) CE_(a, 7, 8) CE_(a, 9, 10) CE_(a, 11, 12) CE_(a, 13, 14)
}
__device__ __forceinline__ void merge16_top(unsigned (&a)[16], const unsigned (&b)[16]) {
    a[0] = a[0] > b[15] ? a[0] : b[15]; a[1] = a[1] > b[14] ? a[1] : b[14]; a[2] = a[2] > b[13] ? a[2] : b[13]; a[3] = a[3] > b[12] ? a[3] : b[12]; a[4] = a[4] > b[11] ? a[4] : b[11]; a[5] = a[5] > b[10] ? a[5] : b[10]; a[6] = a[6] > b[9] ? a[6] : b[9]; a[7] = a[7] > b[8] ? a[7] : b[8]; a[8] = a[8] > b[7] ? a[8] : b[7]; a[9] = a[9] > b[6] ? a[9] : b[6]; a[10] = a[10] > b[5] ? a[10] : b[5]; a[11] = a[11] > b[4] ? a[11] : b[4]; a[12] = a[12] > b[3] ? a[12] : b[3]; a[13] = a[13] > b[2] ? a[13] : b[2]; a[14] = a[14] > b[1] ? a[14] : b[1]; a[15] = a[15] > b[0] ? a[15] : b[0];
    CE_(a, 0, 8) CE_(a, 1, 9) CE_(a, 2, 10) CE_(a, 3, 11) CE_(a, 4, 12) CE_(a, 5, 13) CE_(a, 6, 14) CE_(a, 7, 15) CE_(a, 0, 4) CE_(a, 1, 5) CE_(a, 2, 6) CE_(a, 3, 7) CE_(a, 8, 12) CE_(a, 9, 13) CE_(a, 10, 14) CE_(a, 11, 15) CE_(a, 0, 2) CE_(a, 1, 3) CE_(a, 4, 6) CE_(a, 5, 7) CE_(a, 8, 10) CE_(a, 9, 11) CE_(a, 12, 14) CE_(a, 13, 15) CE_(a, 0, 1) CE_(a, 2, 3) CE_(a, 4, 5) CE_(a, 6, 7) CE_(a, 8, 9) CE_(a, 10, 11) CE_(a, 12, 13) CE_(a, 14, 15)
}
namespace peer {
constexpr int KEY_RS = 272;
constexpr int KEYS_BYTES = 2 * 128 * KEY_RS;
constexpr int SI_OFF = KEYS_BYTES;
__device__ __forceinline__ int crow(int r, int hi) { return (r & 3) + 8 * (r >> 2) + 4 * hi; }
__device__ __forceinline__ unsigned sortable(float f) { const unsigned u = __float_as_uint(f); return u ^ ((u >> 31) ? 0xFFFFFFFFu : 0x80000000u); }
__device__ __forceinline__ float unsortable(unsigned s) { const unsigned u = (s >> 31) ? (s ^ 0x80000000u) : ~s; return __uint_as_float(u); }
__device__ __forceinline__ unsigned pair_max(unsigned m) { auto rr = __builtin_amdgcn_permlane32_swap(m, m, false, false); return rr[0] > rr[1] ? rr[0] : rr[1]; }

__device__ __forceinline__ void top16_half(const Ctx& c, const bf16_t* pq_rows, int half, LAS unsigned char* keys, unsigned (&sel)[16]) {
    const int lane = c.lane, r32 = lane & 31, hi = lane >> 5;
    f32x16 acc[4];
#pragma unroll
    for (int nt = 0; nt < 4; ++nt) acc[nt] = f32x16{};
    const bf16_t* qrow = pq_rows + (size_t)r32 * 256 + half * 128;
    bf16x8 qb[8];
#pragma unroll
    for (int ks = 0; ks < 8; ++ks) qb[ks] = *reinterpret_cast<const bf16x8*>(qrow + 16 * ks + 8 * hi);
#pragma unroll
    for (int ks = 0; ks < 8; ++ks) {
#pragma unroll
        for (int nt = 0; nt < 4; ++nt) { const bf16x8 ka = *(const LAS bf16x8*)(keys + (half * 128 + 32 * nt + r32) * KEY_RS + (16 * ks + 8 * hi) * 2);
            acc[nt] = __builtin_amdgcn_mfma_f32_32x32x16_bf16(ka, qb[ks], acc[nt], 0, 0, 0); }
        if (ks & 1) __builtin_amdgcn_sched_barrier(0); }
    unsigned p[64];
#pragma unroll
    for (int nt = 0; nt < 4; ++nt)
#pragma unroll
        for (int r = 0; r < 16; ++r) { const int n = 32 * nt + crow(r, hi); p[nt * 16 + r] = (sortable(acc[nt][r]) & ~127u) | (unsigned)(127 - n); }
    unsigned g0[16], g1[16], g2[16], g3[16];
#pragma unroll
    for (int i = 0; i < 16; ++i) { g0[i] = p[i]; g1[i] = p[16 + i]; g2[i] = p[32 + i]; g3[i] = p[48 + i]; }
    sort16_desc(g0); sort16_desc(g1); sort16_desc(g2); sort16_desc(g3);
    merge16_top(g0, g1); merge16_top(g2, g3); merge16_top(g0, g2);
    unsigned pb[16];
#pragma unroll
    for (int i = 0; i < 16; ++i) { auto rr = __builtin_amdgcn_permlane32_swap(g0[i], g0[i], false, false); sel[i] = rr[0]; pb[i] = rr[1]; }
    merge16_top(sel, pb);
}
__device__ __forceinline__ void route(const Ctx& c, int layer) {
    const bf16_t* pq = (const bf16_t*)(c.ws + B_PQ); unsigned short* idx_out = (unsigned short*)(c.ws + R2_IDX); float* gate_out = (float*)(c.ws + R2_GATE);
    const bf16_t* keys_g = (const bf16_t*)(c.ws + W_KEYS) + (size_t)layer * 2 * 128 * 128;
    LAS unsigned char* keys = c.lds;
    const int lane = c.lane, r32 = lane & 31, hi = lane >> 5;
    for (int i = c.tid; i < 2 * 128 * 16; i += NTHR) { const int row = i >> 4, ch = i & 15; *(LAS u32x4*)(keys + row * KEY_RS + ch * 16) = *(const u32x4*)(keys_g + (size_t)row * 128 + ch * 8); }
    __syncthreads();
    LAS int* si = (LAS int*)(c.lds + SI_OFF + c.wave * 4096) + r32 * 32;
    for (int grp = c.gw; grp < T / 4; grp += c.NGW) {
        const bf16_t* rows = pq + (size_t)grp * 4 * 2048;
        unsigned s1[16], s2[16];
        top16_half(c, rows, 0, keys, s1);
        top16_half(c, rows, 1, keys, s2);
        float v1[16], v2[16];
#pragma unroll
        for (int i = 0; i < 16; ++i) { v1[i] = unsortable(s1[i] & ~127u); v2[i] = unsortable(s2[i] & ~127u); }
        if (hi == 0) {
#pragma unroll
            for (int i = 0; i < 16; ++i) { si[i] = 127 - (int)(s1[i] & 127u); si[16 + i] = 127 - (int)(s2[i] & 127u); }
        }
        float A[16], B[16];
#pragma unroll
        for (int i = 0; i < 16; ++i) { A[i] = hi ? v2[i] : v1[i]; B[i] = hi ? v1[i] : v2[i]; }
        unsigned cd[27]; int nc = 0;
#pragma unroll
        for (int i = 0; i < 16; ++i)
#pragma unroll
            for (int j = i; j < 16; ++j) if ((i + 1) * (j + 1) <= 16) {
                const unsigned flat = hi ? (unsigned)(j * 16 + i) : (unsigned)(i * 16 + j);
                unsigned pk = (sortable(A[i] + B[j]) & ~255u) | (255u - flat);
                if (i == j) pk = hi ? 0u : pk;
                cd[nc++] = pk; }
        unsigned sel[16], c1[16], pb[16];
#pragma unroll
        for (int i = 0; i < 16; ++i) { sel[i] = cd[i]; c1[i] = (16 + i < 27) ? cd[(16 + i < 27) ? 16 + i : 0] : 0u; }
        sort16_desc(sel); sort16_desc(c1); merge16_top(sel, c1);
#pragma unroll
        for (int i = 0; i < 16; ++i) { auto rr = __builtin_amdgcn_permlane32_swap(sel[i], sel[i], false, false); sel[i] = rr[0]; pb[i] = rr[1]; }
        merge16_top(sel, pb);
        LDS_WAIT(); asm volatile("" ::: "memory");
        const float vmax = unsortable(sel[0] & ~255u);
        float e[16], es = 0.f;
#pragma unroll
        for (int i = 0; i < 16; ++i) { e[i] = fast_exp(unsortable(sel[i] & ~255u) - vmax); es += e[i]; }
        const float inv = 1.0f / es;
        const size_t obase = ((size_t)grp * 4 + (r32 >> 3)) * 128 + (r32 & 7) * 16 + 8 * hi;
        int oi[8]; float og[8];
#pragma unroll
        for (int q = 0; q < 8; ++q) { const unsigned sv = hi ? sel[8 + q] : sel[q]; const float ev = hi ? e[8 + q] : e[q];
            const int flat = 255 - (int)(sv & 255u); oi[q] = si[flat >> 4] * 128 + si[16 + (flat & 15)]; og[q] = ev * inv; }
        *(u32x4*)(idx_out + obase) = (u32x4){(unsigned)oi[0] | ((unsigned)oi[1] << 16), (unsigned)oi[2] | ((unsigned)oi[3] << 16), (unsigned)oi[4] | ((unsigned)oi[5] << 16), (unsigned)oi[6] | ((unsigned)oi[7] << 16)};
        *(f32x4*)(gate_out + obase) = (f32x4){og[0], og[1], og[2], og[3]};
        *(f32x4*)(gate_out + obase + 4) = (f32x4){og[4], og[5], og[6], og[7]};
        LDS_WAIT(); asm volatile("" ::: "memory");
    }
    __syncthreads();
}

__device__ __forceinline__ float gelu_exact(float x) { return 0.5f * x * (1.0f + erff(x * 0.70710678118654752f)); }
template <int IDXMASK> __device__ __forceinline__ void gather_ln(const Ctx& c, int layer, float* xout, bf16_t* xb) {
    const unsigned char* U8 = c.ws + R2_UB; const unsigned char* V8 = c.ws + R2_VB;
    const float* su = (const float*)(c.ws + R2_SU); const float* sv = (const float*)(c.ws + R2_SV);
    const int* idx = (const int*)(c.ws + R2_IDX); const float* gate = (const float*)(c.ws + R2_GATE);
    const float* lg = c.in(20) + layer * D; const float* lbv = c.in(21) + layer * D;
    const int lane = c.lane;
    for (int t = c.gw; t < T; t += c.NGW) {
        const float* xr = c.out + (size_t)t * D + 16 * lane; float* xw = xout + (size_t)t * D + 16 * lane;
        float x[16], acc[16];
#pragma unroll
        for (int j = 0; j < 4; ++j) { const f32x4 a = *(const f32x4*)(xr + 4 * j); x[4 * j] = a[0]; x[4 * j + 1] = a[1]; x[4 * j + 2] = a[2]; x[4 * j + 3] = a[3]; }
#pragma unroll
        for (int e = 0; e < 16; ++e) acc[e] = 0.f;
        const int myidx0 = idx[(size_t)t * 128 + lane] & IDXMASK, myidx1 = idx[(size_t)t * 128 + 64 + lane] & IDXMASK;
        const float myg0 = gate[(size_t)t * 128 + lane], myg1 = gate[(size_t)t * 128 + 64 + lane];
        for (int eb = 0; eb < 128; eb += 8) {
            float part[8]; int ei[8];
#pragma unroll
            for (int q = 0; q < 8; ++q) { const int e = eb + q; ei[q] = __builtin_amdgcn_readlane(e < 64 ? myidx0 : myidx1, e & 63); }
            u32x4 vr[8];
#pragma unroll
            for (int q = 0; q < 8; ++q) vr[q] = *(const u32x4*)(V8 + (size_t)ei[q] * D + 16 * lane);
#pragma unroll
            for (int q = 0; q < 8; ++q) { const u32x4 a = *(const u32x4*)(U8 + (size_t)ei[q] * D + 16 * lane);
                float s = 0.f;
#pragma unroll
                for (int j = 0; j < 4; ++j) { const f32x2 lo = __builtin_amdgcn_cvt_pk_f32_fp8((int)a[j], false), hi = __builtin_amdgcn_cvt_pk_f32_fp8((int)a[j], true);
                    s = fmaf(lo[0], x[4 * j], s); s = fmaf(lo[1], x[4 * j + 1], s); s = fmaf(hi[0], x[4 * j + 2], s); s = fmaf(hi[1], x[4 * j + 3], s); }
                part[q] = s; }
            float r4[4], r2[2], r1;
            { const bool up = (lane & 32) != 0;
#pragma unroll
              for (int i = 0; i < 4; ++i) { const float send = up ? part[i] : part[4 + i]; const float keep = up ? part[4 + i] : part[i]; r4[i] = keep + __shfl_xor(send, 32); } }
            { const bool up = (lane & 16) != 0;
#pragma unroll
              for (int i = 0; i < 2; ++i) { const float send = up ? r4[i] : r4[2 + i]; const float keep = up ? r4[2 + i] : r4[i]; r2[i] = keep + __shfl_xor(send, 16); } }
            { const bool up = (lane & 8) != 0; const float send = up ? r2[0] : r2[1]; const float keep = up ? r2[1] : r2[0]; r1 = keep + __shfl_xor(send, 8); }
            r1 += __shfl_xor(r1, 4); r1 += __shfl_xor(r1, 2); r1 += __shfl_xor(r1, 1);
            const int myq = ((lane >> 5) & 1) * 4 + ((lane >> 4) & 1) * 2 + ((lane >> 3) & 1);
            const int me = eb + myq;
            const float g = __shfl(me < 64 ? myg0 : myg1, me & 63);
            const int mye = __shfl(me < 64 ? myidx0 : myidx1, me & 63);
            const float cf = g * gelu_exact(r1 * su[mye]) * sv[mye];
            float cq[8];
#pragma unroll
            for (int q = 0; q < 8; ++q) cq[q] = __int_as_float(__builtin_amdgcn_readlane(__float_as_int(cf), ((q >> 2) & 1) * 32 + ((q >> 1) & 1) * 16 + (q & 1) * 8));
#pragma unroll
            for (int q = 0; q < 8; ++q) { const float s = cq[q];
#pragma unroll
                for (int j = 0; j < 4; ++j) { const f32x2 lo = __builtin_amdgcn_cvt_pk_f32_fp8((int)vr[q][j], false), hi = __builtin_amdgcn_cvt_pk_f32_fp8((int)vr[q][j], true);
                    acc[4 * j] = fmaf(s, lo[0], acc[4 * j]); acc[4 * j + 1] = fmaf(s, lo[1], acc[4 * j + 1]); acc[4 * j + 2] = fmaf(s, hi[0], acc[4 * j + 2]); acc[4 * j + 3] = fmaf(s, hi[1], acc[4 * j + 3]); } }
        }
        float s = 0.f;
#pragma unroll
        for (int e = 0; e < 16; ++e) { acc[e] = fmaf(DN_ALPHA, x[e], acc[e]); s += acc[e]; }
        const float mean = wave_sum(s) * (1.0f / D); float s2 = 0.f;
#pragma unroll
        for (int e = 0; e < 16; ++e) { acc[e] -= mean; s2 += acc[e] * acc[e]; }
        const float rstd = 1.0f / sqrtf(wave_sum(s2) * (1.0f / D) + LN_EPS);
        float o[16];
#pragma unroll
        for (int j = 0; j < 4; ++j) { const f32x4 g4 = *(const f32x4*)(lg + 16 * lane + 4 * j), b4 = *(const f32x4*)(lbv + 16 * lane + 4 * j);
#pragma unroll
            for (int e = 0; e < 4; ++e) o[4 * j + e] = acc[4 * j + e] * rstd * g4[e] + b4[e];
            *(f32x4*)(xw + 4 * j) = (f32x4){o[4 * j], o[4 * j + 1], o[4 * j + 2], o[4 * j + 3]}; }
        u32x4 w0, w1; w0.x = cvt_pk_bf16(o[0], o[1]); w0.y = cvt_pk_bf16(o[2], o[3]); w0.z = cvt_pk_bf16(o[4], o[5]); w0.w = cvt_pk_bf16(o[6], o[7]);
        w1.x = cvt_pk_bf16(o[8], o[9]); w1.y = cvt_pk_bf16(o[10], o[11]); w1.z = cvt_pk_bf16(o[12], o[13]); w1.w = cvt_pk_bf16(o[14], o[15]);
        *(u32x4*)(xb + (size_t)t * D + 16 * lane) = w0; *(u32x4*)(xb + (size_t)t * D + 16 * lane + 8) = w1;
    }
}
}
namespace peer {
constexpr size_t HP_OFF = WS_BIG;
constexpr size_t COEF_OFF = WS_R2 + 36 * MiB;
constexpr int QW_BASE = 4096;
constexpr int ITEM_TOK = 128, NBLK = T / ITEM_TOK;
constexpr int GT = 1;
#define DPP_F(v, ctrl) __int_as_float(__builtin_amdgcn_update_dpp(0, __float_as_int(v), (ctrl), 0xf, 0xf, true))

template <class F> __device__ __forceinline__ void for_items(const Ctx& c, int layer, int phase, F body) {
    unsigned* qw = (unsigned*)(c.ws + WS_CTL) + QW_BASE + (size_t)((layer * 4 + phase) * 8) * 16;
    volatile LAS int* slot = (volatile LAS int*)(c.lds + LDS_MISC_OFF + 128);
    const int home = (int)(xb_xcc_id() & 7u);
    for (int k = 0; k < 8; ++k) {
        const int s = (home + k) & 7;
        if (c.tid == 0) slot[0] = (int)__hip_atomic_fetch_add(qw + s * 16, 1u, __ATOMIC_RELAXED, __HIP_MEMORY_SCOPE_AGENT);
        __syncthreads();
        int cur = slot[0];
        __syncthreads();
        while (cur < NBLK) {
            if (c.tid == 0) slot[0] = (int)__hip_atomic_fetch_add(qw + s * 16, 1u, __ATOMIC_RELAXED, __HIP_MEMORY_SCOPE_AGENT);
            body(s, cur);
            __syncthreads();
            cur = slot[0];
            __syncthreads();
        }
    }
}

__device__ __forceinline__ void g1_udot(const Ctx& c, int layer, int dup) {
    const unsigned char* U8 = c.ws + R2_UB; const unsigned short* idx = (const unsigned short*)(c.ws + R2_IDX); bf16_t* hp = (bf16_t*)(c.ws + HP_OFF);
    for_items(c, layer, 0 + 2 * dup, [&](int s, int blk) {
        int lane = c.lane; asm volatile("" : "+v"(lane));
        const int g = lane >> 3, c8 = lane & 7;
        const int co = 128 * s + 16 * c8;
#pragma unroll 1
        for (int i = 0; i < ITEM_TOK / NWAVES; i += GT) {
            const int t0 = blk * ITEM_TOK + c.wave * (ITEM_TOK / NWAVES) + i;
            float x[GT][16]; int id[GT][16];
#pragma unroll
            for (int u = 0; u < GT; ++u)
#pragma unroll
            for (int j = 0; j < 4; ++j) { const u32x2 a = *(const u32x2*)((const bf16_t*)(c.ws + WS_XB) + (size_t)(t0 + u) * D + co + 4 * j); x[u][4 * j] = bflo(a.x); x[u][4 * j + 1] = bfhi(a.x); x[u][4 * j + 2] = bflo(a.y); x[u][4 * j + 3] = bfhi(a.y);
                if (j < 2) { const u32x4 q = *(const u32x4*)(idx + (size_t)(t0 + u) * 128 + 16 * g + 8 * j);
#pragma unroll
                    for (int e = 0; e < 4; ++e) { id[u][8 * j + 2 * e] = (int)(q[e] & 0xffffu); id[u][8 * j + 2 * e + 1] = (int)(q[e] >> 16); } } }
            u32x4 row[GT][16];
#pragma unroll
            for (int u = 0; u < GT; ++u)
#pragma unroll
            for (int j = 0; j < 16; ++j) row[u][j] = *(const u32x4*)(U8 + (size_t)id[u][j] * D + co);
#pragma unroll
            for (int u = 0; u < GT; ++u) {
            float V[16];
#pragma unroll
            for (int j = 0; j < 16; ++j) { f32x2 acc2 = (f32x2){0.f, 0.f};
                if (dup) { V[j] = __uint_as_float((row[u][j][0] ^ row[u][j][1] ^ row[u][j][2] ^ row[u][j][3]) & 0x3fffffffu); continue; }
#pragma unroll
                for (int q = 0; q < 4; ++q) { const f32x2 lo = __builtin_amdgcn_cvt_pk_f32_fp8((int)row[u][j][q], false), hi = __builtin_amdgcn_cvt_pk_f32_fp8((int)row[u][j][q], true);
                    acc2 = __builtin_elementwise_fma(lo, (f32x2){x[u][4 * q], x[u][4 * q + 1]}, acc2); acc2 = __builtin_elementwise_fma(hi, (f32x2){x[u][4 * q + 2], x[u][4 * q + 3]}, acc2); }
                V[j] = acc2[0] + acc2[1]; }
            float W[8], Y[4], Z[2];
            { const bool hiA = (lane & 4) != 0;
#pragma unroll
              for (int m = 0; m < 8; ++m) { const float send = hiA ? V[m] : V[8 + m], keep = hiA ? V[8 + m] : V[m]; W[m] = keep + DPP_F(send, 0x141); } }
            { const bool hiB = (lane & 2) != 0;
#pragma unroll
              for (int m = 0; m < 4; ++m) { const float send = hiB ? W[m] : W[4 + m], keep = hiB ? W[4 + m] : W[m]; Y[m] = keep + DPP_F(send, 0x1B); } }
            { const bool hiC = (lane & 1) != 0;
#pragma unroll
              for (int m = 0; m < 2; ++m) { const float send = hiC ? Y[m] : Y[2 + m], keep = hiC ? Y[2 + m] : Y[m]; Z[m] = keep + DPP_F(send, 0xB1); } }
            *(unsigned*)((dup ? hp + (size_t)320 * MiB : hp) + ((size_t)(dup ? 0 : s) * T + t0 + u) * 128 + 16 * g + 2 * c8) = cvt_pk_bf16(Z[0], Z[1]);
            }
        }
    });
}
__device__ __forceinline__ void g2_coef(const Ctx& c, int dup) {
    const unsigned short* idx = (const unsigned short*)(c.ws + R2_IDX); const float* gate = (const float*)(c.ws + R2_GATE); const bf16_t* hp = (const bf16_t*)(c.ws + HP_OFF);
    const float* su = (const float*)(c.ws + R2_SU); const float* sv = (const float*)(c.ws + R2_SV);
    bf16_t* dstb = dup ? (bf16_t*)(c.ws + HP_OFF) + (size_t)340 * MiB : (bf16_t*)(c.ws + COEF_OFF);
    const int lane = c.lane;
    constexpr int NU = 4;
    for (int t0 = c.gw * NU; t0 < T; t0 += c.NGW * NU) {
        float h[NU][2]; unsigned ew[NU]; f32x2 gt[NU];
#pragma unroll
        for (int u = 0; u < NU; ++u) { const size_t o = (size_t)(t0 + u) * 128 + 2 * lane; ew[u] = *(const unsigned*)(idx + o); gt[u] = *(const f32x2*)(gate + o); float a0 = 0.f, a1 = 0.f;
#pragma unroll
            for (int s = 0; s < 8; ++s) { const unsigned w = *(const unsigned*)(hp + (size_t)s * T * 128 + o); a0 += bflo(w); a1 += bfhi(w); }
            h[u][0] = a0; h[u][1] = a1; }
        float s1[NU][2], s2[NU][2];
#pragma unroll
        for (int u = 0; u < NU; ++u) { const int e0 = (int)(ew[u] & 0xffffu), e1 = (int)(ew[u] >> 16); s1[u][0] = su[e0]; s1[u][1] = su[e1]; s2[u][0] = sv[e0]; s2[u][1] = sv[e1]; }
#pragma unroll
        for (int u = 0; u < NU; ++u) *(unsigned*)(dstb + (size_t)(t0 + u) * 128 + 2 * lane) = cvt_pk_bf16(gt[u][0] * gelu_exact(h[u][0] * s1[u][0]) * s2[u][0], gt[u][1] * gelu_exact(h[u][1] * s1[u][1]) * s2[u][1]);
    }
}
__device__ __forceinline__ void g3_vaxpy(const Ctx& c, int layer, int dup) {
    const unsigned char* V8 = c.ws + R2_VB; const unsigned short* idx = (const unsigned short*)(c.ws + R2_IDX); const bf16_t* coef = (const bf16_t*)(c.ws + COEF_OFF);
    for_items(c, layer, 1 + 2 * dup, [&](int s, int blk) {
        int lane = c.lane; asm volatile("" : "+v"(lane));
        const int g = lane >> 3, c8 = lane & 7;
        const int co = 128 * s + 16 * c8;
        constexpr int N = ITEM_TOK / NWAVES;
        const int t0 = blk * ITEM_TOK + c.wave * N;
        auto load_idx = [&](int t, int (&id)[16]) {
#pragma unroll
            for (int j = 0; j < 2; ++j) { const u32x4 q = *(const u32x4*)(idx + (size_t)t * 128 + 16 * g + 8 * j);
#pragma unroll
                for (int e = 0; e < 4; ++e) { id[8 * j + 2 * e] = (int)(q[e] & 0xffffu); id[8 * j + 2 * e + 1] = (int)(q[e] >> 16); } } };
        auto load_rows = [&](int t, const int (&id)[16], u32x4 (&row)[16], f32x4 (&cf)[4]) {
#pragma unroll
            for (int j = 0; j < 2; ++j) { const u32x4 q = *(const u32x4*)(coef + (size_t)t * 128 + 16 * g + 8 * j); cf[2 * j] = (f32x4){bflo(q[0]), bfhi(q[0]), bflo(q[1]), bfhi(q[1])}; cf[2 * j + 1] = (f32x4){bflo(q[2]), bfhi(q[2]), bflo(q[3]), bfhi(q[3])}; }
#pragma unroll
            for (int j = 0; j < 16; ++j) row[j] = *(const u32x4*)(V8 + ((unsigned)id[j] * 1024u + (unsigned)co)); };
        auto compute = [&](int t, const u32x4 (&row)[16], const f32x4 (&cf)[4]) {
            f32x2 A2[8];
#pragma unroll
            for (int e = 0; e < 8; ++e) A2[e] = (f32x2){0.f, 0.f};
#pragma unroll
            for (int j = 0; j < 16; ++j) { const float cj = cf[j >> 2][j & 3]; const f32x2 sc = (f32x2){cj, cj};
#pragma unroll
                for (int q = 0; q < 4; ++q) { const f32x2 lo = __builtin_amdgcn_cvt_pk_f32_fp8((int)row[j][q], false), hi = __builtin_amdgcn_cvt_pk_f32_fp8((int)row[j][q], true);
                    A2[2 * q] = __builtin_elementwise_fma(sc, lo, A2[2 * q]); A2[2 * q + 1] = __builtin_elementwise_fma(sc, hi, A2[2 * q + 1]); } }
            float A[16];
#pragma unroll
            for (int e = 0; e < 8; ++e) { A[2 * e] = A2[e][0]; A[2 * e + 1] = A2[e][1]; }
            float R[8], S2[4], Y[2];
#pragma unroll
            for (int m = 0; m < 8; ++m) { auto rr = __builtin_amdgcn_permlane32_swap(__float_as_uint(A[m]), __float_as_uint(A[8 + m]), false, false); R[m] = __uint_as_float(rr[0]) + __uint_as_float(rr[1]); }
#pragma unroll
            for (int m = 0; m < 4; ++m) { auto rr = __builtin_amdgcn_permlane16_swap(__float_as_uint(R[m]), __float_as_uint(R[4 + m]), false, false); S2[m] = __uint_as_float(rr[0]) + __uint_as_float(rr[1]); }
            { const bool hi8 = (lane & 8) != 0;
#pragma unroll
              for (int m = 0; m < 2; ++m) { const float send = hi8 ? S2[m] : S2[2 + m], keep = hi8 ? S2[2 + m] : S2[m]; Y[m] = keep + DPP_F(send, 0x128); } }
            const size_t yo = (size_t)t * D + co + 8 * ((lane >> 5) & 1) + 4 * ((lane >> 4) & 1) + 2 * ((lane >> 3) & 1);
            const unsigned xo = *(const unsigned*)((const bf16_t*)(c.ws + WS_XB) + yo);
            *(unsigned*)((bf16_t*)c.out + yo) = cvt_pk_bf16(fmaf(DN_ALPHA, bflo(xo), Y[0]), fmaf(DN_ALPHA, bfhi(xo), Y[1])); };
        int idA[16], idB[16]; u32x4 rowA[16], rowB[16]; f32x4 cfA[4], cfB[4];
        load_idx(t0, idA); load_rows(t0, idA, rowA, cfA); load_idx(t0 + 1, idB);
#pragma unroll 1
        for (int i = 0; i < N; i += 2) {
            load_rows(t0 + i + 1, idB, rowB, cfB);
            if (i + 2 < N) load_idx(t0 + i + 2, idA);
            __builtin_amdgcn_sched_barrier(0);
            compute(t0 + i, rowA, cfA);
            __builtin_amdgcn_sched_barrier(0);
            if (i + 2 < N) load_rows(t0 + i + 2, idA, rowA, cfA);
            if (i + 3 < N) load_idx(t0 + i + 3, idB);
            __builtin_amdgcn_sched_barrier(0);
            compute(t0 + i + 1, rowB, cfB);
            __builtin_amdgcn_sched_barrier(0);
        }
    });
}
__device__ __forceinline__ void ln_pass(const Ctx& c, const float* g, const float* b) {
    const bf16_t* ym = (const bf16_t*)c.out; bf16_t* xa = (bf16_t*)(c.ws + WS_XB); const int lane = c.lane;
    constexpr int NU = 4;
    for (int t0 = c.gw * NU; t0 < T; t0 += c.NGW * NU) {
        f32x4 v[NU][4]; bf16_t* dst[NU]; unsigned char* dst8[NU]; float* dsc[NU];
#pragma unroll
        for (int u = 0; u < NU; ++u) { dst8[u] = nullptr; dsc[u] = nullptr; const bf16_t* yr = ym + (size_t)(t0 + u) * D; dst[u] = xa + (size_t)(t0 + u) * D;
#pragma unroll
            for (int j = 0; j < 4; ++j) { const u32x2 w = *(const u32x2*)(yr + 256 * j + 4 * lane); v[u][j] = (f32x4){bflo(w.x), bfhi(w.x), bflo(w.y), bfhi(w.y)}; } }
        ln_rows<NU, false>(v, g, b, lane, dst, dst8, dsc);
    }
}
#undef DPP_F
}
constexpr int N_PHASES = 1 + 2 * (5 + 8) + 2 * (5 + 8);

#ifndef PROBE_SITE
#define PROBE_SITE -1
#endif
#ifndef PROBE_LN
#define PROBE_LN 0
#endif
#ifndef PROBE_VAR
#define PROBE_VAR 9
#endif
#define GEMM_PHASE(EPI, Aptr, Bptr, NN, KK, ...) { pg8::Gemm g{(const bf16_t*)(Aptr), (const bf16_t*)(Bptr), T, (NN), (KK)}; pg8::StaticOrder S; S.init(T, (NN), c.G, c.bid); \
        pg8::EPI E{__VA_ARGS__}; pg8::gemm_phase<pg8::EPI, pg8::StaticOrder>(c.lds, g, S, E, c.tid); }

__global__ void __launch_bounds__(NTHR, 2) fwd_kernel(Args args) {
    extern __shared__ __attribute__((aligned(16))) unsigned char lds_raw[];
    volatile LAS unsigned* misc = (volatile LAS unsigned*)((LAS unsigned char*)lds_raw + LDS_MISC_OFF);
    if (threadIdx.x < 64) misc[threadIdx.x] = 0u;
    __syncthreads();
    const int wave_s = __builtin_amdgcn_readfirstlane((int)threadIdx.x >> 6);
    const int lo = args.ph_lo, hi = args.ph_hi;
    XcdBarrier bar; bar.bar = (unsigned*)(args.ws + WS_CTL); bar.x = 0; bar.st = nullptr;
    if (hi - lo > 1) bar = xcd_barrier_post((unsigned*)(args.ws + WS_CTL), misc + 8);
    int ph = 0;
#define PHASE(site, ...) if (ph >= lo && ph < hi) { const Ctx c = mk_ctx(lds_raw, wave_s); unsigned char* const ws = c.ws; (void)ws; { constexpr int dup = 0; (void)dup; __VA_ARGS__ } \
        if constexpr (PROBE_SITE == (site)) { __syncthreads(); constexpr int dup = 1; (void)dup; __VA_ARGS__ } if (ph + 1 < hi) xcd_barrier(bar); } ++ph;

    PHASE(0, p0_prologue(c);)

    for (int layer = 0; layer < NL; ++layer) {
        const int j = layer >> 1;
        if ((layer & 1) == 0) {
            PHASE(1, GEMM_PHASE(EpiBf16P, c.out, (const bf16_t*)(ws + W_WA) + (size_t)j * 768 * 1024, 768, 1024, (bf16_t*)(ws + B_A32), 768))
            PHASE(2, l0_convert(c, layer); mla_e1(c, j);)
            PHASE(3, GEMM_PHASE(EpiBf16P, ws + B_CQN, (const bf16_t*)(ws + W_WUQ) + (size_t)j * 1536 * 384, 1536, 384, (bf16_t*)(ws + B_Q), 1536) __syncthreads();
                     GEMM_PHASE(EpiBf16P, ws + B_CKVN, (const bf16_t*)(ws + W_WUKV) + (size_t)j * 2048 * 256, 2048, 256, (bf16_t*)(ws + B_KV), 2048))
            PHASE(5, if (dup == 0) mla_attention<0>(c); else mla_attention<(PROBE_VAR > 4 ? 0 : PROBE_VAR)>(c);)
            PHASE(6, GEMM_PHASE(EpiBf16P, ws + B_O, (const bf16_t*)(ws + W_WO) + (size_t)j * 1024 * 1024, 1024, 1024, (bf16_t*)(ws + B_H32_MLA), 1024))
        } else {
            PHASE(7, GEMM_PHASE(EpiHgrn, c.out, (const bf16_t*)(ws + W_HIN) + (size_t)j * 5120 * 1024, 5120, 1024, (bf16_t*)(ws + B_PLANE), (size_t)T * 1024, (const float*)(ws + WS_MISC) + (size_t)j * 2048))
            PHASE(8, if (dup == 0) { l0_convert(c, layer); scan::hgrn_prep(c, 0); } else { scan::hgrn_prep(c, 1); })
            PHASE(9, if (dup == 0) scan::hgrn_scan<0>(c, false); else scan::hgrn_scan<(PROBE_VAR > 6 ? 0 : PROBE_VAR)>(c, true);)
            PHASE(10, hgrn_post(c, j);)
            PHASE(11, GEMM_PHASE(EpiBf16P, ws + B_PLANE, (const bf16_t*)(ws + W_HO) + (size_t)j * 1024 * 1024, 1024, 1024, (bf16_t*)(ws + B_H32_HGRN), 1024))
        }
        PHASE(12, ln_residual(c, (const bf16_t*)(ws + ((layer & 1) ? B_H32_HGRN : B_H32_MLA)), c.in(18) + layer * D, c.in(19) + layer * D);)
        PHASE(13, GEMM_PHASE(EpiBf16P, ws + WS_XB, (const bf16_t*)(ws + W_PQ) + (size_t)layer * 2048 * 1024, 2048, 1024, (bf16_t*)(ws + B_PQ), 2048))
        PHASE(14, peer::route(c, layer);)
        PHASE(15, peer::g1_udot(c, layer, dup);)
        PHASE(16, peer::g2_coef(c, dup);)
        PHASE(17, peer::g3_vaxpy(c, layer, dup);)
        PHASE(18, if (dup == 0 || PROBE_LN == 0) GEMM_PHASE(EpiBf16P, ws + R2_PB, (const bf16_t*)(ws + W_PP) + (size_t)layer * 1024 * 256, 1024, 256, (bf16_t*)(ws + B_PP), 1024) if (dup == 0 || PROBE_LN == 1) peer::ln_pass(c, c.in(20) + layer * D, c.in(21) + layer * D);)
        PHASE(19, GEMM_PHASE(EpiPle, ws + WS_XB, (const bf16_t*)(ws + W_GW) + (size_t)layer * 1024 * 1024, 1024, 1024, (const bf16_t*)(ws + WS_XB), (const bf16_t*)(ws + B_PP), c.in(23) + layer * D, (bf16_t*)c.out, (layer == NL - 1) ? c.out : (float*)nullptr))
    }
#undef PHASE
}

extern "C" void kernel_launch(void* const* d_in, const int* in_sizes, int n_in, void* d_out, int out_size, void* d_ws, size_t ws_size, hipStream_t stream) {
    static int grid = 0;
    if (grid == 0) {
        if (n_in != 25 || out_size != T * D || ws_size < WS_END) { fprintf(stderr, "kernel_launch: unexpected shapes: n_in %d out %d ws %zu (need %zu)\n", n_in, out_size, ws_size, (size_t)WS_END); grid = -1; return; }
        int dev = 0, cus = 0, per_cu = 0;
        if (hipGetDevice(&dev) != hipSuccess || hipDeviceGetAttribute(&cus, hipDeviceAttributeMultiprocessorCount, dev) != hipSuccess) { grid = -1; return; }
        if (hipFuncSetAttribute((const void*)fwd_kernel, hipFuncAttributeMaxDynamicSharedMemorySize, LDS_BYTES) != hipSuccess) { fprintf(stderr, "kernel_launch: hipFuncSetAttribute failed\n"); grid = -1; return; }
        if (hipOccupancyMaxActiveBlocksPerMultiprocessor(&per_cu, (const void*)fwd_kernel, NTHR, LDS_BYTES) != hipSuccess || per_cu < 1) { fprintf(stderr, "kernel_launch: occupancy query says %d\n", per_cu); }
        (void)hipGetLastError();
        grid = cus;
    }
    if (grid < 0) return;
    (void)hipMemsetAsync((char*)d_ws + WS_CTL, 0, CTL_ZERO_BYTES, stream);
    Args a{};
    for (int i = 0; i < 25; ++i) a.in[i] = (const float*)d_in[i];
    a.out = (float*)d_out; a.ws = (unsigned char*)d_ws;
#if defined(MK_DEBUG_MLA)
    float* res = (float*)((char*)d_ws + WS_CTL + 48 * 1024);
    for (int p = 0; p < 4; ++p) { a.ph_lo = p; a.ph_hi = p + 1; hipLaunchKernelGGL(fwd_kernel, dim3(grid), dim3(NTHR), LDS_BYTES, stream, a); }
    hipLaunchKernelGGL(k_zero_out, dim3(2048), dim3(256), 0, stream, (float*)d_out, (size_t)T * D);
    hipLaunchKernelGGL(k_mla_naive, dim3(2), dim3(256), 0, stream, (const float*)d_in[0], (const float*)d_in[1], (const float*)d_in[4], (const float*)d_in[5], (const float*)d_in[6], (const float*)d_in[7], (const float*)d_in[8], (const unsigned char*)d_ws, res);
    hipLaunchKernelGGL(k_mla_report, dim3(1), dim3(64), 0, stream, (const float*)res, (float*)d_out);
#elif defined(MK_DEBUG_ATTN)
    float* res = (float*)((char*)d_ws + WS_CTL + 48 * 1024);
    for (int p = 0; p < 5; ++p) { a.ph_lo = p; a.ph_hi = p + 1; hipLaunchKernelGGL(fwd_kernel, dim3(grid), dim3(NTHR), LDS_BYTES, stream, a); }
    hipLaunchKernelGGL(k_zero_out, dim3(2048), dim3(256), 0, stream, (float*)d_out, (size_t)T * D);
    hipLaunchKernelGGL(k_attn_naive, dim3(2 * CHK_NR), dim3(256), 0, stream, (const unsigned char*)d_ws, (float*)nullptr, res);
    hipLaunchKernelGGL(k_attn_report, dim3(1), dim3(64), 0, stream, (const float*)res, (float*)d_out);
#elif defined(MK_DEBUG_DET)
    unsigned long long* tab = (unsigned long long*)((char*)d_ws + WS_CTL + 32 * 1024);
    for (int pass = 0; pass < 2; ++pass)
        for (int p = 0; p < N_PHASES; ++p) { a.ph_lo = p; a.ph_hi = p + 1; hipLaunchKernelGGL(fwd_kernel, dim3(grid), dim3(NTHR), LDS_BYTES, stream, a);
            Reg r[4]; const int nr = phase_regions(p, r);
            for (int i = 0; i < nr; ++i) hipLaunchKernelGGL(k_checksum, dim3(2048), dim3(256), 0, stream, (const unsigned*)(r[i].in_out ? (char*)d_out : (char*)d_ws + r[i].off), r[i].bytes / 4, tab + (size_t)pass * N_PHASES * 4 + p * 4 + i); }
    hipLaunchKernelGGL(k_zero_out, dim3(2048), dim3(256), 0, stream, (float*)d_out, (size_t)T * D);
    hipLaunchKernelGGL(k_report, dim3(1), dim3(64), 0, stream, tab, N_PHASES * 4, (float*)d_out);
#elif MK_ONE_LAUNCH
    a.ph_lo = 0; a.ph_hi = N_PHASES;
    hipLaunchKernelGGL(fwd_kernel, dim3(grid), dim3(NTHR), LDS_BYTES, stream, a);
#else
    for (int p = 0; p < N_PHASES; ++p) { a.ph_lo = p; a.ph_hi = p + 1; hipLaunchKernelGGL(fwd_kernel, dim3(grid), dim3(NTHR), LDS_BYTES, stream, a); }
#endif
}
```

```cpp
#include <hip/hip_runtime.h>
#include <cstdio>
#include <cstdint>

#ifndef MK_ONE_LAUNCH
#define MK_ONE_LAUNCH 1
#endif

#define GAS __attribute__((address_space(1)))
#define LAS __attribute__((address_space(3)))
typedef unsigned short bf16_t;
typedef short bf16x8 __attribute__((ext_vector_type(8)));
typedef short s16x4 __attribute__((ext_vector_type(4)));
typedef float f32x4 __attribute__((ext_vector_type(4)));
typedef float f32x2 __attribute__((ext_vector_type(2)));
typedef float f32x16 __attribute__((ext_vector_type(16)));
typedef unsigned u32x4 __attribute__((ext_vector_type(4)));
typedef unsigned u32x2 __attribute__((ext_vector_type(2)));

constexpr int D = 1024, TP = 16384, TS = 65536, T = TP + TS, SP = 8192, SS = 2048;
constexpr int NL = 4;
constexpr int NWAVES = 8, NTHR = 512;
constexpr float DN_ALPHA = 1.681792830507429f;
constexpr float LN_EPS = 1e-5f, RMS_EPS = 1e-6f;
constexpr float MLA_SCALE = 0.07216878364870323f;
constexpr int NEXP = 16384;

constexpr size_t MiB = 1u << 20;
constexpr size_t WS_CTL = 0, CTL_ZERO_BYTES = 64 * 1024;
constexpr size_t WS_ROPE = 1 * MiB;
constexpr size_t WS_MISC = 3 * MiB;
constexpr size_t WS_W = 4 * MiB;
constexpr size_t W_WA = WS_W;
constexpr size_t W_WUQ = W_WA + 2 * (size_t)768 * 1024 * 2;
constexpr size_t W_WUKV = W_WUQ + 2 * (size_t)1536 * 384 * 2;
constexpr size_t W_WO = W_WUKV + 2 * (size_t)2048 * 256 * 2;
constexpr size_t W_HIN = W_WO + 2 * (size_t)1024 * 1024 * 2;
constexpr size_t W_HO = W_HIN + 2 * (size_t)5120 * 1024 * 2;
constexpr size_t W_PQ = W_HO + 2 * (size_t)1024 * 1024 * 2;
constexpr size_t W_GW = W_PQ + 4 * (size_t)2048 * 1024 * 2;
constexpr size_t W_PP = W_GW + 4 * (size_t)1024 * 1024 * 2;
constexpr size_t W_KEYS = W_PP + 4 * (size_t)1024 * 256 * 2;
constexpr size_t W_END = W_KEYS + 4 * (size_t)2 * 128 * 128 * 2;
static_assert(W_END <= 68 * MiB, "weights region");
constexpr size_t WS_R2 = 68 * MiB;
constexpr size_t R2_UB = WS_R2, R2_VB = WS_R2 + 16 * MiB, R2_SU = WS_R2 + 32 * MiB, R2_SV = WS_R2 + 33 * MiB, R2_IDX = WS_R2 + 64 * MiB, R2_GATE = WS_R2 + 104 * MiB, R2_PB = WS_R2 + 144 * MiB;
constexpr size_t WS_XB = 252 * MiB;
constexpr size_t WS_BIG = 412 * MiB;
constexpr size_t WS_END = WS_BIG + 800 * MiB;
constexpr size_t B_Q = WS_BIG, B_KV = WS_BIG + 240 * MiB, B_O = WS_BIG + 560 * MiB, B_KROPE = WS_BIG + 720 * MiB;
constexpr size_t B_A32 = WS_BIG + 240 * MiB, B_CQN = WS_BIG + 560 * MiB, B_CKVN = WS_BIG + 620 * MiB, B_H32_MLA = WS_BIG;
constexpr size_t B_PLANE = WS_BIG, PLANE_BYTES = 160 * MiB, B_H32_HGRN = WS_BIG + 160 * MiB;
constexpr size_t B_PQ = WS_BIG, B_PP = WS_BIG + 320 * MiB, B_X8 = WS_BIG + 480 * MiB, B_XS = WS_BIG + 560 * MiB;

constexpr int LDS_BYTES = 160 * 1024;
constexpr int LDS_MISC_OFF = LDS_BYTES - 256;

typedef __bf16 bf16x2_n __attribute__((ext_vector_type(2)));
__device__ __forceinline__ unsigned cvt_pk_bf16(float lo, float hi) { const f32x2 v = {lo, hi}; const bf16x2_n b = __builtin_convertvector(v, bf16x2_n); return __builtin_bit_cast(unsigned, b); }
__device__ __forceinline__ bf16_t f2bf(float f) { return (bf16_t)(cvt_pk_bf16(f, 0.f) & 0xffffu); }
__device__ __forceinline__ float bf2f(bf16_t b) { return __uint_as_float(((unsigned)b) << 16); }
__device__ __forceinline__ float bflo(unsigned w) { return __uint_as_float(w << 16); }
__device__ __forceinline__ float bfhi(unsigned w) { return __uint_as_float(w & 0xffff0000u); }
#define DPPF(v, ctrl) __int_as_float(__builtin_amdgcn_update_dpp(0, __float_as_int(v), (ctrl), 0xf, 0xf, true))
__device__ __forceinline__ float row16_sum(float v) { v += DPPF(v, 0xB1); v += DPPF(v, 0x4E); v += DPPF(v, 0x141); v += DPPF(v, 0x140); return v; }
__device__ __forceinline__ float wave_sum(float v) { v = row16_sum(v);
    { auto r = __builtin_amdgcn_permlane16_swap(__float_as_uint(v), __float_as_uint(v), false, false); v = __uint_as_float(r[0]) + __uint_as_float(r[1]); }
    { auto r = __builtin_amdgcn_permlane32_swap(__float_as_uint(v), __float_as_uint(v), false, false); v = __uint_as_float(r[0]) + __uint_as_float(r[1]); }
    return v; }
__device__ __forceinline__ float wave_max(float v) { v = fmaxf(v, DPPF(v, 0xB1)); v = fmaxf(v, DPPF(v, 0x4E)); v = fmaxf(v, DPPF(v, 0x141)); v = fmaxf(v, DPPF(v, 0x140));
    { auto r = __builtin_amdgcn_permlane16_swap(__float_as_uint(v), __float_as_uint(v), false, false); v = fmaxf(__uint_as_float(r[0]), __uint_as_float(r[1])); }
    { auto r = __builtin_amdgcn_permlane32_swap(__float_as_uint(v), __float_as_uint(v), false, false); v = fmaxf(__uint_as_float(r[0]), __uint_as_float(r[1])); }
    return v; }
__device__ __forceinline__ float fast_exp(float x) { return __builtin_amdgcn_exp2f(x * 1.4426950408889634f); }
__device__ __forceinline__ float fast_log(float x) { return __builtin_amdgcn_logf(x) * 0.6931471805599453f; }
__device__ __forceinline__ float fast_rcp(float x) { return __builtin_amdgcn_rcpf(x); }
__device__ __forceinline__ float sigmoidf_(float x) { return fast_rcp(1.0f + fast_exp(-x)); }
__device__ __forceinline__ float siluf_(float x) { return x * sigmoidf_(x); }
#define LDS_WAIT() asm volatile("s_waitcnt lgkmcnt(0)" ::: "memory")
#define VM_WAIT() asm volatile("s_waitcnt vmcnt(0)" ::: "memory")
__device__ __forceinline__ int opaque_lane() { int l; asm volatile("v_mbcnt_lo_u32_b32 %0, -1, 0\n\tv_mbcnt_hi_u32_b32 %0, -1, %0" : "=v"(l)); return l; }
__device__ __forceinline__ int opaque_tid(int wave_s) { asm volatile("" : "+s"(wave_s)); return (wave_s << 6) + opaque_lane(); }
__device__ __forceinline__ int opaque_bid() { int b = (int)blockIdx.x; asm volatile("" : "+s"(b)); return b; }
struct Args { const float* in[25]; float* out; unsigned char* ws; int ph_lo, ph_hi; };
#define XB_TMO      128
#define XB_XCNT(j)  (256  + 64 * (j))
#define XB_XSUB(j)  (1280 + 64 * (j))
#define XB_XGEN(j)  (2304 + 64 * (j))
#define XB_TOP      3328
#define XB_TOPGEN   3392
#define XCD_BAR_WORDS 3456
#define XB_SPIN_CAP (1u << 23)

__device__ __forceinline__ unsigned xb_ld(unsigned* p)              { return __hip_atomic_load(p, __ATOMIC_RELAXED, __HIP_MEMORY_SCOPE_AGENT); }
__device__ __forceinline__ unsigned xb_add(unsigned* p, unsigned v) { return __hip_atomic_fetch_add(p, v, __ATOMIC_RELAXED, __HIP_MEMORY_SCOPE_AGENT); }
__device__ __forceinline__ unsigned xb_xcc_id() { return (unsigned)__builtin_amdgcn_s_getreg((3 << 11) | 20) & 0xFu; }
#define XB_SPIN(cond, bar) do { unsigned _sp = 0; while (cond) { __builtin_amdgcn_s_sleep(1); \
    if ((++_sp & 255u) == 0u) { if (xb_ld(&(bar)[XB_TMO])) break; if (_sp > XB_SPIN_CAP) { atomicAdd(&(bar)[XB_TMO], 1u); break; } } } } while (0)

struct XcdBarrier {
    unsigned* bar; unsigned x;
    volatile LAS unsigned* st;
};

__device__ __forceinline__ XcdBarrier xcd_barrier_post(unsigned* bar, volatile LAS unsigned* st) {
    XcdBarrier b; b.bar = bar; b.x = xb_xcc_id(); b.st = st;
    if (threadIdx.x == 0) (void)xb_add(&bar[XB_XCNT(b.x)], 1u);
    return b;
}
__device__ __forceinline__ void xcd_barrier_complete(unsigned* bar, unsigned x, unsigned& nloc, unsigned& nx) {
    const unsigned G = gridDim.x * gridDim.y * gridDim.z;
    unsigned sum, cnt, mine, sp = 0u;
    for (;;) {
        sum = 0u; cnt = 0u; mine = 0u;
#pragma unroll
        for (unsigned j = 0; j < 16; ++j) { const unsigned c = xb_ld(&bar[XB_XCNT(j)]); sum += c; cnt += (c > 0u) ? 1u : 0u; mine = (j == x) ? c : mine; }
        if (sum == G) break;
        __builtin_amdgcn_s_sleep(1);
        if ((++sp & 255u) == 0u) { if (xb_ld(&bar[XB_TMO])) break; if (sp > XB_SPIN_CAP) { atomicAdd(&bar[XB_TMO], 1u); break; } }
    }
    nloc = mine > 0u ? mine : 1u; nx = cnt > 0u ? cnt : 1u;
}

__device__ __forceinline__ void xcd_barrier(const XcdBarrier& b) {
    asm volatile("s_waitcnt vmcnt(0)" ::: "memory");
    __syncthreads();
    if (threadIdx.x == 0) {
        unsigned* bar = b.bar;
        __builtin_amdgcn_s_waitcnt(0);
        unsigned nloc = b.st[0], nx = b.st[1];
        if (nloc == 0u) { xcd_barrier_complete(bar, b.x, nloc, nx); b.st[0] = nloc; b.st[1] = nx; }
        const unsigned old = xb_add(&bar[XB_XSUB(b.x)], 1u);
        const unsigned gen = old / nloc;
        if (old + 1u == (gen + 1u) * nloc) {
            __builtin_amdgcn_fence(__ATOMIC_RELEASE, "agent");
            asm volatile("s_waitcnt vmcnt(0)" ::: "memory");
            const unsigned og = xb_add(&bar[XB_TOP], 1u);
            const unsigned tg = og / nx;
            if (og + 1u == (tg + 1u) * nx) xb_add(&bar[XB_TOPGEN], 1u);
            else XB_SPIN(xb_ld(&bar[XB_TOPGEN]) == tg, bar);
            __builtin_amdgcn_fence(__ATOMIC_ACQUIRE, "agent");
            xb_add(&bar[XB_XGEN(b.x)], 1u);
            asm volatile("s_waitcnt vmcnt(0)" ::: "memory");
        } else {
            XB_SPIN(xb_ld(&bar[XB_XGEN(b.x)]) == gen, bar);
            __builtin_amdgcn_fence(__ATOMIC_ACQUIRE, "agent");
            asm volatile("s_waitcnt vmcnt(0)" ::: "memory");
        }
    }
    __syncthreads();
}
namespace pg8 {
#define PG8_LAS __attribute__((address_space(3)))
constexpr int BM = 256, BK = 64, HALF = 128, HTB = HALF * BK * 2  , STAGE_BYTES = 8 * HTB, NXCD = 8, WGM = 8;

__host__ __device__ __forceinline__ int lds_byte(int r, int c) { const int st = (r >> 4) * 2 + (c >> 5), rr = r & 15, cc = c & 31, ob = rr * 64 + cc * 2; return st * 1024 + (ob ^ (((ob >> 9) & 1) << 5)); }
__host__ __device__ __forceinline__ void stage_rc(int b, int& R, int& C) { const int st = b / 1024, sb = b % 1024, swz = sb ^ (((sb >> 9) & 1) << 5); R = (st >> 1) * 16 + swz / 64; C = (st & 1) * 32 + (swz % 64) / 2; }
__host__ __device__ __forceinline__ int perm32(int rho) { const int n = rho >> 4, i = rho & 15; return 8 * (i >> 2) + 4 * n + (i & 3); }

struct Unit { int pm, pn; };
struct Gemm { const bf16_t* A; const bf16_t* Bt; int M, N, K; };

struct StaticOrder {
    int nM, nN, nwg, G, c;
    __host__ __device__ void init(int M, int N, int G_, int c_) { nM = M / BM; nN = N / BM; nwg = nM * nN; G = G_; c = c_; }
    __host__ __device__ bool next(int i, Unit& u) const {
        const long L = (long)i * G + c; if (L >= nwg) return false;
        int wgid = (int)L; { const int q = nwg / NXCD, r = nwg % NXCD, xcd = wgid % NXCD, off = wgid / NXCD; wgid = (xcd < r ? xcd * (q + 1) : r * (q + 1) + (xcd - r) * q) + off; }
        const int nig = WGM * nN, gid = wgid / nig, fm = gid * WGM, gsz = (nM - fm) < WGM ? (nM - fm) : WGM;
        u.pm = fm + ((wgid % nig) % gsz); u.pn = (wgid % nig) / gsz; return true;
    }
    __device__ __forceinline__ void a_ready(const Unit&) const {}
    __device__ __forceinline__ void done(const Unit&) const {}
};
template <class Epi, class Sched>
__device__ __forceinline__ void gemm_phase(PG8_LAS unsigned char* lds, const Gemm g, const Sched& S, const Epi& E, const int tid) {
    const int wid = __builtin_amdgcn_readfirstlane(tid >> 6), lane = tid & 63, wr = wid >> 2, wc = wid & 3, fr = lane & 15, fq = lane >> 4;
    const int K = g.K, nt = K / BK;
    unsigned voffA[2], voffB[2];
#pragma unroll
    for (int i = 0; i < 2; ++i) { int R, C; stage_rc(tid * 16 + i * 8192, R, C); const int Rb = Epi::PERM ? ((R & ~31) + perm32(R & 31)) : R;
        voffA[i] = (unsigned)(R * K + C) * 2u; voffB[i] = (unsigned)(Rb * K + C) * 2u; }
    const size_t kstep = (size_t)(BK * 2);
    const size_t hstep = (size_t)HALF * K * 2;
    const size_t tstep = 2 * hstep;
    const unsigned ldsw = (unsigned)wid * 1024u;
    const int aoff = lds_byte(wr * 64 + fr, fq * 8), boff = lds_byte(wc * 32 + fr, fq * 8);
#define PG8_SA(b, h) (((b) * 2 + (h)) * HTB)
#define PG8_SB(b, h) ((4 + (b) * 2 + (h)) * HTB)
#define PG8_STAGE(bufoff, gbase, voff) do { _Pragma("unroll") for (int _i = 0; _i < 2; ++_i) \
        __builtin_amdgcn_global_load_lds((const unsigned*)((const char*)(gbase) + (voff)[_i]), (PG8_LAS unsigned*)(lds + (bufoff) + ldsw + _i * 8192), 16, 0, 0); } while (0)
#define PG8_LDA(dst, b, h) do { _Pragma("unroll") for (int m = 0; m < 4; ++m) _Pragma("unroll") for (int k = 0; k < 2; ++k) dst[m][k] = *(const PG8_LAS bf16x8*)(lds + PG8_SA(b, h) + aoff + m * 2048 + k * 1024); } while (0)
#define PG8_LDB(dst, b, h) do { _Pragma("unroll") for (int n = 0; n < 2; ++n) _Pragma("unroll") for (int k = 0; k < 2; ++k) dst[n][k] = *(const PG8_LAS bf16x8*)(lds + PG8_SB(b, h) + boff + n * 2048 + k * 1024); } while (0)
#define PG8_MMA(ai, bj, At, Bt) do { __builtin_amdgcn_s_setprio(1); _Pragma("unroll") for (int m = 0; m < 4; ++m) _Pragma("unroll") for (int n = 0; n < 2; ++n) _Pragma("unroll") for (int k = 0; k < 2; ++k) \
        acc[ai][bj][m][n] = __builtin_amdgcn_mfma_f32_16x16x32_bf16(Bt[n][k], At[m][k], acc[ai][bj][m][n], 0, 0, 0); __builtin_amdgcn_s_setprio(0); } while (0)
#define PG8_WAIT_V(n) asm volatile("s_waitcnt vmcnt(" #n ")" ::: "memory")
#define PG8_WAIT_L(n) asm volatile("s_waitcnt lgkmcnt(" #n ")" ::: "memory")
#define PG8_BAR __builtin_amdgcn_s_barrier()
#define PG8_SCHED __builtin_amdgcn_sched_barrier(0)
    Unit cur, nxt; int ui = 0;
    if (!S.next(0, cur)) return;
    f32x4 acc[2][2][4][2];
#pragma unroll
    for (int a = 0; a < 2; ++a)
#pragma unroll
        for (int b = 0; b < 2; ++b)
#pragma unroll
            for (int m = 0; m < 4; ++m)
#pragma unroll
                for (int n = 0; n < 2; ++n) acc[a][b][m][n] = (f32x4){0.f, 0.f, 0.f, 0.f};
    bf16x8 At[4][2], B0[2][2], B1[2][2];
    const char* cA = (const char*)g.A + (size_t)cur.pm * tstep; const char* cB = (const char*)g.Bt + (size_t)cur.pn * tstep;
    S.a_ready(cur);
    PG8_STAGE(PG8_SB(0, 0), cB, voffB); PG8_STAGE(PG8_SA(0, 0), cA, voffA); PG8_STAGE(PG8_SB(0, 1), cB + hstep, voffB); PG8_STAGE(PG8_SA(0, 1), cA + hstep, voffA);
    if (wr == 1) PG8_BAR;
    PG8_WAIT_V(4); PG8_BAR;
    PG8_STAGE(PG8_SB(1, 0), cB + kstep, voffB); PG8_STAGE(PG8_SA(1, 0), cA + kstep, voffA); PG8_STAGE(PG8_SB(1, 1), cB + hstep + kstep, voffB);
    PG8_WAIT_V(6); PG8_BAR;
    for (;;) {
        const bool has_next = S.next(ui + 1, nxt);
        const char* nA = has_next ? (const char*)g.A + (size_t)nxt.pm * tstep : cA; const char* nB = has_next ? (const char*)g.Bt + (size_t)nxt.pn * tstep : cB;
        for (int t = 0; t < nt; t += 2) {
            const bool last = (t == nt - 2);
            const char* a1 = cA + (size_t)(t + 1) * kstep;
            const char* a2 = last ? nA : cA + (size_t)(t + 2) * kstep; const char* b2 = last ? nB : cB + (size_t)(t + 2) * kstep;
            const char* a3 = a2 + kstep; const char* b3 = b2 + kstep;
            if (last && has_next) S.a_ready(nxt);
            PG8_LDB(B0, 0, 0); PG8_SCHED; PG8_LDA(At, 0, 0); PG8_STAGE(PG8_SA(1, 1), a1 + hstep, voffA);
            PG8_WAIT_L(8); PG8_BAR; PG8_WAIT_L(0); PG8_MMA(0, 0, At, B0); PG8_BAR; PG8_SCHED;
            PG8_LDB(B1, 0, 1); PG8_STAGE(PG8_SB(0, 0), b2, voffB);
            PG8_BAR; PG8_WAIT_L(0); PG8_MMA(0, 1, At, B1); PG8_BAR;
            PG8_LDA(At, 0, 1); PG8_STAGE(PG8_SA(0, 0), a2, voffA);
            PG8_BAR; PG8_WAIT_L(0); PG8_MMA(1, 0, At, B0); PG8_BAR; PG8_SCHED;
            PG8_STAGE(PG8_SB(0, 1), b2 + hstep, voffB);
            PG8_WAIT_V(6); PG8_BAR; PG8_MMA(1, 1, At, B1); PG8_BAR;
            PG8_LDB(B0, 1, 0); PG8_SCHED; PG8_LDA(At, 1, 0); PG8_STAGE(PG8_SA(0, 1), a2 + hstep, voffA);
            PG8_WAIT_L(8); PG8_BAR; PG8_WAIT_L(0); PG8_MMA(0, 0, At, B0); PG8_BAR; PG8_SCHED;
            PG8_LDB(B1, 1, 1); PG8_STAGE(PG8_SB(1, 0), b3, voffB);
            PG8_BAR; PG8_WAIT_L(0); PG8_MMA(0, 1, At, B1); PG8_BAR;
            PG8_LDA(At, 1, 1); PG8_STAGE(PG8_SA(1, 0), a3, voffA);
            PG8_BAR; PG8_WAIT_L(0); PG8_MMA(1, 0, At, B0); PG8_BAR; PG8_SCHED;
            PG8_STAGE(PG8_SB(1, 1), b3 + hstep, voffB);
            PG8_WAIT_V(6); PG8_BAR; PG8_MMA(1, 1, At, B1); PG8_BAR;
        }
        E(acc, cur, wr, wc, fr, fq); S.done(cur);
        if (!has_next) break;
#pragma unroll
        for (int a = 0; a < 2; ++a)
#pragma unroll
            for (int b = 0; b < 2; ++b)
#pragma unroll
                for (int m = 0; m < 4; ++m)
#pragma unroll
                    for (int n = 0; n < 2; ++n) acc[a][b][m][n] = (f32x4){0.f, 0.f, 0.f, 0.f};
        cur = nxt; cA = nA; cB = nB; ++ui;
    }
    PG8_WAIT_V(0);
    if (wr == 0) PG8_BAR;
    PG8_BAR;
#undef PG8_SA
#undef PG8_SB
#undef PG8_STAGE
#undef PG8_LDA
#undef PG8_LDB
#undef PG8_MMA
#undef PG8_WAIT_V
#undef PG8_WAIT_L
#undef PG8_BAR
#undef PG8_SCHED
}
struct EpiF32 {
    static constexpr bool PERM = false;
    float* C; int ldc;
    __device__ __forceinline__ void operator()(const f32x4 (&acc)[2][2][4][2], const Unit& u, int wr, int wc, int fr, int fq) const {
        const int row0 = u.pm * BM + wr * 64 + fr, col0 = u.pn * BM + wc * 32 + 4 * fq;
#pragma unroll
        for (int ai = 0; ai < 2; ++ai)
#pragma unroll
            for (int m = 0; m < 4; ++m) { float* rowp = C + (size_t)(row0 + ai * HALF + m * 16) * ldc + col0;
#pragma unroll
                for (int bj = 0; bj < 2; ++bj)
#pragma unroll
                    for (int n = 0; n < 2; ++n) *(f32x4*)(rowp + bj * HALF + n * 16) = acc[ai][bj][m][n]; }
    }
};
struct EpiBf16P {
    static constexpr bool PERM = true;
    bf16_t* O; int ldc;
    __device__ __forceinline__ void operator()(const f32x4 (&acc)[2][2][4][2], const Unit& u, int wr, int wc, int fr, int fq) const {
        const int row0 = u.pm * BM + wr * 64 + fr, col0 = u.pn * BM + wc * 32 + 8 * fq;
#pragma unroll
        for (int ai = 0; ai < 2; ++ai)
#pragma unroll
            for (int m = 0; m < 4; ++m) { bf16_t* rowp = O + (size_t)(row0 + ai * HALF + m * 16) * ldc + col0;
#pragma unroll
                for (int bj = 0; bj < 2; ++bj) { const f32x4 v0 = acc[ai][bj][m][0], v1 = acc[ai][bj][m][1];
                    u32x4 w; w.x = cvt_pk_bf16(v0[0], v0[1]); w.y = cvt_pk_bf16(v0[2], v0[3]); w.z = cvt_pk_bf16(v1[0], v1[1]); w.w = cvt_pk_bf16(v1[2], v1[3]);
                    *(u32x4*)(rowp + bj * HALF) = w; } }
    }
};
struct EpiHgrn {
    static constexpr bool PERM = true;
    bf16_t* planes; size_t plane_elems; const float* lb;
    __device__ __forceinline__ void operator()(const f32x4 (&acc)[2][2][4][2], const Unit& u, int wr, int wc, int fr, int fq) const {
        const int plane = u.pn >> 2;
        const int row0 = u.pm * BM + wr * 64 + fr, col0 = (u.pn & 3) * BM + wc * 32 + 8 * fq;
        bf16_t* base = planes + (size_t)plane * plane_elems;
        float lbv[2][8];
        if (plane == 1 || plane == 2) {
#pragma unroll
            for (int bj = 0; bj < 2; ++bj)
#pragma unroll
                for (int e = 0; e < 8; ++e) lbv[bj][e] = lb[(plane - 1) * 1024 + col0 + bj * HALF + e];
        } else {
#pragma unroll
            for (int bj = 0; bj < 2; ++bj)
#pragma unroll
                for (int e = 0; e < 8; ++e) lbv[bj][e] = 0.f;
        }
#pragma unroll
        for (int ai = 0; ai < 2; ++ai)
#pragma unroll
            for (int m = 0; m < 4; ++m) { bf16_t* rowp = base + (size_t)(row0 + ai * HALF + m * 16) * 1024 + col0;
#pragma unroll
                for (int bj = 0; bj < 2; ++bj) { float v[8];
#pragma unroll
                    for (int e = 0; e < 4; ++e) { v[e] = acc[ai][bj][m][0][e]; v[4 + e] = acc[ai][bj][m][1][e]; }
                    if (plane == 0 || plane == 4) {
#pragma unroll
                        for (int e = 0; e < 8; ++e) v[e] = siluf_(v[e]);
                    } else if (plane == 1 || plane == 2) {
#pragma unroll
                        for (int e = 0; e < 8; ++e) { const float l = lbv[bj][e]; const float f = l + (1.0f - l) * sigmoidf_(v[e]); v[e] = fast_log(fmaxf(f, 1e-30f)); }
                    }
                    u32x4 w; w.x = cvt_pk_bf16(v[0], v[1]); w.y = cvt_pk_bf16(v[2], v[3]); w.z = cvt_pk_bf16(v[4], v[5]); w.w = cvt_pk_bf16(v[6], v[7]);
                    *(u32x4*)(rowp + bj * HALF) = w; } }
    }
};
struct EpiPle {
    static constexpr bool PERM = false;
    const bf16_t* Xin; const bf16_t* PP; const float* bias; bf16_t* XbOut; float* Fout;
    __device__ __forceinline__ void operator()(const f32x4 (&acc)[2][2][4][2], const Unit& u, int wr, int wc, int fr, int fq) const {
        const int row0 = u.pm * BM + wr * 64 + fr, col0 = u.pn * BM + wc * 32 + 4 * fq;
        f32x4 bv[2][2];
#pragma unroll
        for (int bj = 0; bj < 2; ++bj)
#pragma unroll
            for (int n = 0; n < 2; ++n) bv[bj][n] = *(const f32x4*)(bias + col0 + bj * HALF + n * 16);
#pragma unroll
        for (int ai = 0; ai < 2; ++ai)
#pragma unroll
            for (int m = 0; m < 4; ++m) { const size_t off = (size_t)(row0 + ai * HALF + m * 16) * 1024 + col0;
#pragma unroll
                for (int bj = 0; bj < 2; ++bj)
#pragma unroll
                    for (int n = 0; n < 2; ++n) { const size_t o2 = off + bj * HALF + n * 16;
                        const u32x2 xw = *(const u32x2*)(Xin + o2); const u32x2 pw = *(const u32x2*)(PP + o2); const f32x4 z = acc[ai][bj][m][n] + bv[bj][n];
                        f32x4 o; o[0] = bflo(xw.x) + sigmoidf_(z[0]) * bflo(pw.x); o[1] = bfhi(xw.x) + sigmoidf_(z[1]) * bfhi(pw.x); o[2] = bflo(xw.y) + sigmoidf_(z[2]) * bflo(pw.y); o[3] = bfhi(xw.y) + sigmoidf_(z[3]) * bfhi(pw.y);
                        if (Fout) *(f32x4*)(Fout + o2) = o; else { u32x2 w; w.x = cvt_pk_bf16(o[0], o[1]); w.y = cvt_pk_bf16(o[2], o[3]); *(u32x2*)(XbOut + o2) = w; } }
                if (m & 1) asm volatile("" ::: "memory"); }
    }
};
}
namespace attn {
constexpr int DV = 128, DQK = 192, NW = 8, QBLK = 32, KVBLK = 64;
constexpr float SCALE = MLA_SCALE;
constexpr float THR = 8.f;
constexpr int LDQ = 8 * DQK, LDKV = 8 * 256, LDKR = 64, LDO = 1024;
constexpr int KROWB = 400;
constexpr int SHM_V = KVBLK * DV * 2, SHM_K = KVBLK * KROWB, SHM_ATTN = 2 * SHM_V + 2 * SHM_K + NW * 64 * 4 + NW * 4096;
#define SBAR() __builtin_amdgcn_sched_barrier(0)
__device__ __forceinline__ int crow(int r, int hi) { return (r & 3) + 8 * (r >> 2) + 4 * hi; }

__device__ __forceinline__ void partialSM(f32x16& p0, f32x16& p1, float& m_reg, float& mn, float& alpha) {
  constexpr float C = SCALE * 1.4426950408889634f;
  float pmax = p0[0];
#pragma unroll
  for (int r = 1; r < 16; ++r) pmax = fmaxf(pmax, p0[r]);
#pragma unroll
  for (int r = 0; r < 16; ++r) pmax = fmaxf(pmax, p1[r]);
  { auto rr = __builtin_amdgcn_permlane32_swap(__float_as_uint(pmax), __float_as_uint(pmax), false, false);
    pmax = fmaxf(__uint_as_float(rr[0]), __uint_as_float(rr[1])); }
  if (__builtin_expect(__all(pmax - m_reg <= THR / SCALE), 1)) { mn = m_reg; alpha = 1.f; }
  else { mn = fmaxf(m_reg, pmax); alpha = __builtin_amdgcn_exp2f((m_reg - mn) * C); m_reg = mn; }
  float mnC = -mn * C;
#pragma unroll
  for (int r = 0; r < 16; ++r) p0[r] = fmaf(p0[r], C, mnC);
#pragma unroll
  for (int r = 0; r < 16; ++r) p1[r] = fmaf(p1[r], C, mnC);
#pragma unroll
  for (int r = 0; r < 16; ++r) p0[r] = __builtin_amdgcn_exp2f(p0[r]);
}
__device__ __forceinline__ void finishSM(f32x16& p0, f32x16& p1, float alpha, float& l_reg, bf16x8& pa0, bf16x8& pa1, bf16x8& pa2, bf16x8& pa3) {
#pragma unroll
  for (int r = 0; r < 16; ++r) p1[r] = __builtin_amdgcn_exp2f(p1[r]);
  float ps = 0;
#pragma unroll
  for (int r = 0; r < 16; ++r) ps += p0[r];
#pragma unroll
  for (int r = 0; r < 16; ++r) ps += p1[r];
  { auto rr = __builtin_amdgcn_permlane32_swap(__float_as_uint(ps), __float_as_uint(ps), false, false);
    ps = __uint_as_float(rr[0]) + __uint_as_float(rr[1]); }
  l_reg = l_reg * alpha + ps;
#define PK4(P, BASE, OUT) do { unsigned a0 = cvt_pk_bf16(P[BASE + 0], P[BASE + 1]), a1 = cvt_pk_bf16(P[BASE + 2], P[BASE + 3]);   \
    unsigned b0 = cvt_pk_bf16(P[BASE + 4], P[BASE + 5]), b1 = cvt_pk_bf16(P[BASE + 6], P[BASE + 7]);                              \
    auto r0 = __builtin_amdgcn_permlane32_swap(a0, b0, false, false); auto r1 = __builtin_amdgcn_permlane32_swap(a1, b1, false, false); \
    u32x4 w = {r0[0], r1[0], r0[1], r1[1]}; OUT = *reinterpret_cast<bf16x8*>(&w); } while (0)
  PK4(p0, 0, pa0); PK4(p0, 8, pa1); PK4(p1, 0, pa2); PK4(p1, 8, pa3);
#undef PK4
}
__device__ __forceinline__ void qkt(f32x16& p0, f32x16& p1, const char* Ks, const bf16x8* qr, const char* qrl, int r32, int hi) {
  p0 = f32x16{}; p1 = f32x16{};
  const char* k0 = Ks + r32 * KROWB + hi * 16; const char* k1 = Ks + (32 + r32) * KROWB + hi * 16;
  bf16x8 fa[2], fb[2], ga[2], gb[2], qx[2], qy[2];
#define QK_LD(FA, FB, QX, G) _Pragma("unroll") for (int i = 0; i < 2; ++i) { FA[i] = *reinterpret_cast<const bf16x8*>(k0 + ((G) * 2 + i) * 32); FB[i] = *reinterpret_cast<const bf16x8*>(k1 + ((G) * 2 + i) * 32); \
      if ((G) * 2 + i >= 8) QX[i] = *reinterpret_cast<const bf16x8*>(qrl + ((G) * 2 + i - 8) * 1024); }
#define QK_MM(FA, FB, QX, G) _Pragma("unroll") for (int i = 0; i < 2; ++i) { const bf16x8 qf = ((G) * 2 + i < 8) ? qr[((G) * 2 + i < 8) ? (G) * 2 + i : 0] : QX[i]; \
      p0 = __builtin_amdgcn_mfma_f32_32x32x16_bf16(FA[i], qf, p0, 0, 0, 0); p1 = __builtin_amdgcn_mfma_f32_32x32x16_bf16(FB[i], qf, p1, 0, 0, 0); }
  QK_LD(fa, fb, qx, 0) SBAR();
  QK_LD(ga, gb, qy, 1) SBAR(); QK_MM(fa, fb, qx, 0) SBAR();
  QK_LD(fa, fb, qx, 2) SBAR(); QK_MM(ga, gb, qy, 1) SBAR();
  QK_LD(ga, gb, qy, 3) SBAR(); QK_MM(fa, fb, qx, 2) SBAR();
  QK_LD(fa, fb, qx, 4) SBAR(); QK_MM(ga, gb, qy, 3) SBAR();
  QK_LD(ga, gb, qy, 5) SBAR(); QK_MM(fa, fb, qx, 4) SBAR();
  QK_MM(ga, gb, qy, 5) SBAR();
#undef QK_LD
#undef QK_MM
}
__device__ __forceinline__ int v_st(int k, int c) { const int kk = (k & ~0xC) | ((k & 4) << 1) | ((k & 8) >> 1); return ((kk >> 3) * 4 + (c >> 5)) * 512 + ((kk & 7) * 32 + (c & 31)) * 2; }
__device__ __forceinline__ int v_rd_base(int lane) { return ((lane & 3) << 3) | (((lane >> 2) & 3) << 6) | (((lane >> 4) & 1) << 5) | (((lane >> 5) & 1) << 8); }
constexpr int v_rd_off(int d0, int ks, int half) { return d0 * 512 + ks * 4096 + half * 2048; }
template <int OFF> __device__ __forceinline__ s16x4 tr_read(int vb) {
  s16x4 r; asm volatile("ds_read_b64_tr_b16 %0, %1 offset:%2" : "=&v"(r) : "v"(vb), "i"(OFF) : "memory"); return r;
}
template <int D0> __device__ __forceinline__ void pv_one(f32x16& od, int vb, bf16x8 pa0, bf16x8 pa1, bf16x8 pa2, bf16x8 pa3) {
  const s16x4 l0 = tr_read<v_rd_off(D0, 0, 0)>(vb), h0 = tr_read<v_rd_off(D0, 0, 1)>(vb), l1 = tr_read<v_rd_off(D0, 1, 0)>(vb), h1 = tr_read<v_rd_off(D0, 1, 1)>(vb);
  const s16x4 l2 = tr_read<v_rd_off(D0, 2, 0)>(vb), h2 = tr_read<v_rd_off(D0, 2, 1)>(vb), l3 = tr_read<v_rd_off(D0, 3, 0)>(vb), h3 = tr_read<v_rd_off(D0, 3, 1)>(vb);
  asm volatile("s_waitcnt lgkmcnt(0)" ::: "memory"); SBAR();
#define PK(L, H) (bf16x8){L[0], L[1], L[2], L[3], H[0], H[1], H[2], H[3]}
  od = __builtin_amdgcn_mfma_f32_32x32x16_bf16(pa0, PK(l0, h0), od, 0, 0, 0);
  od = __builtin_amdgcn_mfma_f32_32x32x16_bf16(pa1, PK(l1, h1), od, 0, 0, 0);
  od = __builtin_amdgcn_mfma_f32_32x32x16_bf16(pa2, PK(l2, h2), od, 0, 0, 0);
  od = __builtin_amdgcn_mfma_f32_32x32x16_bf16(pa3, PK(l3, h3), od, 0, 0, 0);
#undef PK
}
__device__ __forceinline__ void pv_d0(f32x16* o, int vb, bf16x8 pa0, bf16x8 pa1, bf16x8 pa2, bf16x8 pa3) {
  pv_one<0>(o[0], vb, pa0, pa1, pa2, pa3); pv_one<1>(o[1], vb, pa0, pa1, pa2, pa3); pv_one<2>(o[2], vb, pa0, pa1, pa2, pa3); pv_one<3>(o[3], vb, pa0, pa1, pa2, pa3);
}

template <int VAR> __device__ __forceinline__ void attn_body(const bf16_t* __restrict__ Qb, const bf16_t* __restrict__ Kn, const bf16_t* __restrict__ Kr,
                                          bf16_t* __restrict__ Ob, int seq, char* lds, int tid, int pos0, const float* __restrict__ ropeT) {
  asm volatile("" : "+v"(tid));
  const int wid = tid >> 6, lane = tid & 63, r32 = lane & 31, hi = lane >> 5;
  char* V_lds = lds; char* K_lds = lds + 2 * SHM_V;
  float* ws = (float*)(lds + 2 * SHM_V + 2 * SHM_K) + wid * 64; float* li_l = ws; float* al_l = ws + 32;
  float m_reg = -1e30f, l_reg = 0; f32x16 o[4] = {}; bf16x8 qr[8];
  char* qrl = lds + 2 * SHM_V + 2 * SHM_K + NW * 64 * 4 + wid * 4096 + lane * 16;
  const bf16_t* Qw = Qb + (long)(wid * QBLK + r32) * LDQ + hi * 8;
#pragma unroll
  for (int d0 = 0; d0 < 8; ++d0) qr[d0] = *reinterpret_cast<const bf16x8*>(Qw + d0 * 16);
  { const float* cp = ropeT + (size_t)(pos0 + wid * QBLK + r32) * 32 + hi * 8; const float* sp = cp + 8192 * 32;
#pragma unroll
    for (int dd = 0; dd < 2; ++dd) { const f32x4 c0 = *(const f32x4*)(cp + 16 * dd), c1 = *(const f32x4*)(cp + 16 * dd + 4), s0 = *(const f32x4*)(sp + 16 * dd), s1 = *(const f32x4*)(sp + 16 * dd + 4);
      const u32x4 A = *reinterpret_cast<const u32x4*>(Qw + (8 + dd) * 16), B = *reinterpret_cast<const u32x4*>(Qw + (10 + dd) * 16); u32x4 An, Bn;
#pragma unroll
      for (int w2 = 0; w2 < 4; ++w2) { const float cs0 = w2 < 2 ? c0[2 * w2] : c1[2 * w2 - 4], cs1 = w2 < 2 ? c0[2 * w2 + 1] : c1[2 * w2 - 3], sn0 = w2 < 2 ? s0[2 * w2] : s1[2 * w2 - 4], sn1 = w2 < 2 ? s0[2 * w2 + 1] : s1[2 * w2 - 3];
        const float a0 = bflo(A[w2]), a1 = bfhi(A[w2]), b0 = bflo(B[w2]), b1 = bfhi(B[w2]);
        An[w2] = cvt_pk_bf16(a0 * cs0 - b0 * sn0, a1 * cs1 - b1 * sn1); Bn[w2] = cvt_pk_bf16(b0 * cs0 + a0 * sn0, b1 * cs1 + a1 * sn1); }
      *reinterpret_cast<u32x4*>(qrl + dd * 1024) = An; *reinterpret_cast<u32x4*>(qrl + (2 + dd) * 1024) = Bn; } }
  const bf16_t* Vh = Kn + 128;
  const int sr = tid >> 4, sc = (tid & 15) * 8, vst0 = v_st(sr, sc), vst1 = v_st(32 + sr, sc);
  int krow[3], kcc[3];
#pragma unroll
  for (int i = 0; i < 3; ++i) { const int id = tid + 512 * i; krow[i] = id / 24; kcc[i] = id % 24; }
  const int vb0 = (int)(uintptr_t)V_lds + v_rd_base(lane);
  bf16x8 vs0, vs1, ks0, ks1, ks2;
#define KSRC(i, k0) (kcc[i] < 16 ? (Kn + (long)((k0) + krow[i]) * LDKV + kcc[i] * 8) : (Kr + (long)((k0) + krow[i]) * LDKR + (kcc[i] - 16) * 8))
#define SLOAD(k0) do { vs0 = *reinterpret_cast<const bf16x8*>(&Vh[(long)((k0) + sr) * LDKV + sc]); vs1 = *reinterpret_cast<const bf16x8*>(&Vh[(long)((k0) + 32 + sr) * LDKV + sc]); \
    ks0 = *reinterpret_cast<const bf16x8*>(KSRC(0, k0)); ks1 = *reinterpret_cast<const bf16x8*>(KSRC(1, k0)); ks2 = *reinterpret_cast<const bf16x8*>(KSRC(2, k0)); } while (0)
#define SWRITE(b) do { *(bf16x8*)(V_lds + (b) * SHM_V + vst0) = vs0; *(bf16x8*)(V_lds + (b) * SHM_V + vst1) = vs1; \
    *(bf16x8*)(K_lds + (b) * SHM_K + krow[0] * KROWB + kcc[0] * 16) = ks0; *(bf16x8*)(K_lds + (b) * SHM_K + krow[1] * KROWB + kcc[1] * 16) = ks1; \
    *(bf16x8*)(K_lds + (b) * SHM_K + krow[2] * KROWB + kcc[2] * 16) = ks2; } while (0)
#define SWAIT() asm volatile("s_waitcnt vmcnt(0)" ::: "memory")
#define RESC(a) do { if (__any((a) < 1.f)) { if (hi == 0) al_l[r32] = (a); asm volatile("s_waitcnt lgkmcnt(0)" ::: "memory"); \
    _Pragma("unroll") for (int d = 0; d < 4; ++d) _Pragma("unroll") for (int r = 0; r < 16; ++r) o[d][r] *= al_l[crow(r, hi)]; } } while (0)
  f32x16 pA0, pA1; float mnA, alA; bf16x8 pa0, pa1, pa2, pa3; const int NT = seq / KVBLK;
  SLOAD(0); SWAIT(); SWRITE(0); __syncthreads();
  for (int j = 0; j < NT; ++j) {
    const int b = j & 1;
    if (VAR != 4) { if (j + 1 < NT) SLOAD((j + 1) * KVBLK); }
    if (VAR != 3) { SBAR(); qkt(pA0, pA1, K_lds + b * SHM_K, qr, qrl, r32, hi); } else { pA0 = f32x16{}; pA1 = f32x16{}; pA0[0] = (float)j; }
    if (VAR != 2) { partialSM(pA0, pA1, m_reg, mnA, alA);
      RESC(alA);
      finishSM(pA0, pA1, alA, l_reg, pa0, pa1, pa2, pa3); SBAR(); }
    else { u32x4 w0 = {__float_as_uint(pA0[0]), __float_as_uint(pA0[5]), __float_as_uint(pA1[3]), __float_as_uint(pA1[9])}; pa0 = *reinterpret_cast<bf16x8*>(&w0); pa1 = pa0; pa2 = pa0; pa3 = pa0; l_reg += pA0[1]; }
    if (VAR != 1) pv_d0(o, vb0 + b * (int)SHM_V, pa0, pa1, pa2, pa3); else o[0][0] += bf2f((bf16_t)pa0[0]) + bf2f((bf16_t)pa3[7]);
    if (VAR != 4) { if (j + 1 < NT) { SWAIT(); SWRITE(b ^ 1); } }
    __syncthreads();
  }
  if (hi == 0) li_l[r32] = l_reg; asm volatile("s_waitcnt lgkmcnt(0)" ::: "memory");
  float rli[16];
#pragma unroll
  for (int r = 0; r < 16; ++r) rli[r] = __builtin_amdgcn_rcpf(li_l[crow(r, hi)]);
  bf16_t* Ow = Ob + (long)(wid * QBLK) * LDO;
#pragma unroll
  for (int r = 0; r < 16; ++r) { const int orow = crow(r, hi);
#pragma unroll
    for (int d0 = 0; d0 < 4; ++d0) Ow[(long)orow * LDO + d0 * 32 + r32] = f2bf(o[d0][r] * rli[r]); }
#undef KSRC
#undef SLOAD
#undef SWRITE
#undef SWAIT
#undef RESC
}
#undef SBAR
}
typedef const __attribute__((address_space(4))) Args* KArgs;
struct Ctx {
    KArgs a; float* out; unsigned char* ws;
    LAS unsigned char* lds;
    int tid, lane, wave, vcu, G, gw, NGW, bid;
    __device__ __forceinline__ const float* in(int i) const { return a->in[i]; }
};
__device__ __forceinline__ Ctx mk_ctx(unsigned char* lds_raw, int wave_s) {
    Ctx c; KArgs a = (KArgs)__builtin_amdgcn_kernarg_segment_ptr(); asm volatile("" : "+s"(a));
    c.a = a; c.out = a->out; c.ws = a->ws; c.lds = (LAS unsigned char*)lds_raw;
    c.tid = opaque_tid(wave_s); c.lane = c.tid & 63; c.wave = __builtin_amdgcn_readfirstlane(c.tid >> 6);
    c.G = (int)gridDim.x; c.bid = opaque_bid(); c.vcu = (c.G % 8 == 0) ? (c.bid % 8) * (c.G / 8) + c.bid / 8 : c.bid;
    c.gw = c.vcu * NWAVES + c.wave; c.NGW = c.G * NWAVES;
    return c;
}
__device__ __forceinline__ int tok_pos(int t) { return t < TP ? (t & (SP - 1)) : ((t - TP) & (SS - 1)); }

__device__ __forceinline__ void transpose_item(const float* W, int K, int N, bf16_t* WT, LAS float* scr, int item, int lane) {
    const int nblk = N / 32, kb = item / nblk, nb = item % nblk, k0 = 64 * kb, n0 = 32 * nb;
#pragma unroll 8
    for (int i = 0; i < 32; ++i) { const int kk = 2 * i + (lane >> 5); scr[kk * 33 + (lane & 31)] = W[(size_t)(k0 + kk) * N + n0 + (lane & 31)]; }
    LDS_WAIT(); asm volatile("" ::: "memory");
    const int c = lane & 7;
#pragma unroll
    for (int j = 0; j < 4; ++j) { const int n = (lane >> 3) + 8 * j; const LAS float* s = scr + (8 * c) * 33 + n;
        u32x4 o; o.x = cvt_pk_bf16(s[0 * 33], s[1 * 33]); o.y = cvt_pk_bf16(s[2 * 33], s[3 * 33]); o.z = cvt_pk_bf16(s[4 * 33], s[5 * 33]); o.w = cvt_pk_bf16(s[6 * 33], s[7 * 33]);
        *(u32x4*)(WT + (size_t)(n0 + n) * K + k0 + 8 * c) = o; }
    LDS_WAIT(); asm volatile("" ::: "memory");
}
struct MatDesc { int in_idx, K, N, Npad, copies; size_t dst; };
__device__ __forceinline__ void p0_prologue(const Ctx& c) {
    LAS float* scr = (LAS float*)(c.lds + c.wave * 16384);
    const MatDesc MATS[9] = {
        {4, 1024, 704, 768, 2, W_WA}, {7, 384, 1536, 1536, 2, W_WUQ}, {8, 256, 2048, 2048, 2, W_WUKV}, {9, 1024, 1024, 1024, 2, W_WO},
        {10, 1024, 5120, 5120, 2, W_HIN}, {13, 1024, 1024, 1024, 2, W_HO}, {14, 1024, 2048, 2048, 4, W_PQ}, {22, 1024, 1024, 1024, 4, W_GW}, {24, 256, 1024, 1024, 4, W_PP}};
    int total = 0;
#pragma unroll
    for (int m = 0; m < 9; ++m) total += MATS[m].copies * (MATS[m].K / 64) * (MATS[m].N / 32);
    for (int it = c.gw; it < total; it += c.NGW) {
        int r = it;
#pragma unroll
        for (int m = 0; m < 9; ++m) {
            const int per = (MATS[m].K / 64) * (MATS[m].N / 32), cnt = MATS[m].copies * per;
            if (r >= 0 && r < cnt) { const int cp = r / per, item = r % per;
                transpose_item(c.in(MATS[m].in_idx) + (size_t)cp * MATS[m].K * MATS[m].N, MATS[m].K, MATS[m].N,
                               (bf16_t*)(c.ws + MATS[m].dst) + (size_t)cp * MATS[m].Npad * MATS[m].K, scr, item, c.lane);
                r = -1; }
            else if (r >= 0) r -= cnt;
        }
    }
    const int gt = c.gw * 64 + c.lane, NGT = c.NGW * 64;
    for (int i = gt; i < 2 * 64 * 1024 / 8; i += NGT) { const int cp = i / (64 * 1024 / 8), o = i % (64 * 1024 / 8);
        *(u32x4*)((bf16_t*)(c.ws + W_WA) + (size_t)cp * 768 * 1024 + (size_t)704 * 1024 + o * 8) = (u32x4){0u, 0u, 0u, 0u}; }
    for (int i = gt; i < 4 * 2 * 128 * 128 / 4; i += NGT) { const f32x4 v = *(const f32x4*)(c.in(15) + (size_t)i * 4);
        u32x2 w; w.x = cvt_pk_bf16(v[0], v[1]); w.y = cvt_pk_bf16(v[2], v[3]); *(u32x2*)((bf16_t*)(c.ws + W_KEYS) + (size_t)i * 4) = w; }
    for (int i = gt; i < 8192 * 32; i += NGT) { const int pos = i >> 5, f = i & 31;
        const float inv = 1.0f / powf(10000.0f, (float)(2 * f) / 64.0f); const float ang = (float)pos * inv;
        ((float*)(c.ws + WS_ROPE))[i] = cosf(ang); ((float*)(c.ws + WS_ROPE))[8192 * 32 + i] = sinf(ang); }
    for (int i = gt; i < 2 * 1024; i += NGT) { const int dir = i >> 10, k = i & 1023;
        const float l0 = c.in(11)[(dir * 2 + 0) * 1024 + k], l1 = c.in(11)[(dir * 2 + 1) * 1024 + k];
        float* lb = (float*)(c.ws + WS_MISC);
        lb[(0 * 2 + dir) * 1024 + k] = 0.f; lb[(1 * 2 + dir) * 1024 + k] = 1.0f / (1.0f + expf(l0 - l1)); }
    for (int t = c.gw; t < T; t += c.NGW) {
        const float* xr = t < TP ? c.in(0) + (size_t)t * D : c.in(1) + (size_t)(t - TP) * D;
        bf16_t* brow = (bf16_t*)c.out + (size_t)t * D;
#pragma unroll
        for (int j = 0; j < 4; ++j) { const f32x4 v = *(const f32x4*)(xr + 256 * j + 4 * c.lane);
            u32x2 w; w.x = cvt_pk_bf16(v[0], v[1]); w.y = cvt_pk_bf16(v[2], v[3]); *(u32x2*)(brow + 256 * j + 4 * c.lane) = w; }
    }
}

__device__ __forceinline__ void cvt_range(const float* src, bf16_t* dst, size_t n8, int gt, int NGT) {
    for (size_t i = gt; i < n8; i += NGT) { const f32x4 a = *(const f32x4*)(src + i * 8), b = *(const f32x4*)(src + i * 8 + 4);
        u32x4 w; w.x = cvt_pk_bf16(a[0], a[1]); w.y = cvt_pk_bf16(a[2], a[3]); w.z = cvt_pk_bf16(b[0], b[1]); w.w = cvt_pk_bf16(b[2], b[3]); *(u32x4*)(dst + i * 8) = w; }
}
__device__ __forceinline__ void l0_convert(const Ctx& c, int layer) {
    const int gt = c.gw * 64 + c.lane, NGT = c.NGW * 64;
    for (int r = c.gw; r < 2 * NEXP; r += c.NGW) {
        const int m = r >= NEXP, e = r - m * NEXP;
        const float* src = c.in(16 + m) + ((size_t)layer * NEXP + e) * D + 16 * c.lane;
        f32x4 v[4]; float am = 0.f;
#pragma unroll
        for (int j = 0; j < 4; ++j) { v[j] = *(const f32x4*)(src + 4 * j); am = fmaxf(am, fmaxf(fmaxf(fabsf(v[j][0]), fabsf(v[j][1])), fmaxf(fabsf(v[j][2]), fabsf(v[j][3])))); }
        am = wave_max(am);
        const float sc = fmaxf(am, 1e-30f) * (1.0f / 440.0f), inv = 1.0f / sc;
        u32x4 w;
#pragma unroll
        for (int j = 0; j < 4; ++j) { int p = 0; p = __builtin_amdgcn_cvt_pk_fp8_f32(v[j][0] * inv, v[j][1] * inv, p, false); p = __builtin_amdgcn_cvt_pk_fp8_f32(v[j][2] * inv, v[j][3] * inv, p, true); w[j] = (unsigned)p; }
        *(u32x4*)(c.ws + (m ? R2_VB : R2_UB) + (size_t)e * D + 16 * c.lane) = w;
        if (c.lane == 0) ((float*)(c.ws + (m ? R2_SV : R2_SU)))[e] = sc;
    }
    cvt_range(c.in(2) + (size_t)layer * TP * 256, (bf16_t*)(c.ws + R2_PB), (size_t)TP * 256 / 8, gt, NGT);
    cvt_range(c.in(3) + (size_t)layer * TS * 256, (bf16_t*)(c.ws + R2_PB) + (size_t)TP * 256, (size_t)TS * 256 / 8, gt, NGT);
}

__device__ __forceinline__ void mla_e1(const Ctx& c, int j) {
    const bf16_t* a16 = (const bf16_t*)(c.ws + B_A32); bf16_t* cqn = (bf16_t*)(c.ws + B_CQN); bf16_t* ckvn = (bf16_t*)(c.ws + B_CKVN); bf16_t* krope = (bf16_t*)(c.ws + B_KROPE);
    const float* qnw = c.in(5) + j * 384; const float* kvnw = c.in(6) + j * 256;
    const float* cosT = (const float*)(c.ws + WS_ROPE); const float* sinT = cosT + 8192 * 32;
    const int lane = c.lane;
    constexpr int NU = 2;
    LAS float* scr = (LAS float*)(c.lds + c.wave * 1024);
    for (int t0 = c.gw * NU; t0 < T; t0 += c.NGW * NU) {
        f32x4 v0[NU], v1[NU], v2[NU];
#pragma unroll
        for (int u = 0; u < NU; ++u) { const bf16_t* ar = a16 + (size_t)(t0 + u) * 768;
            const u32x2 w0 = *(const u32x2*)(ar + 4 * lane), w1 = *(const u32x2*)(ar + 256 + 4 * lane), w2 = *(const u32x2*)(ar + 512 + 4 * lane);
            v0[u] = (f32x4){bflo(w0.x), bfhi(w0.x), bflo(w0.y), bfhi(w0.y)}; v1[u] = (f32x4){bflo(w1.x), bfhi(w1.x), bflo(w1.y), bfhi(w1.y)}; v2[u] = (f32x4){bflo(w2.x), bfhi(w2.x), bflo(w2.y), bfhi(w2.y)}; }
#pragma unroll
        for (int u = 0; u < NU; ++u) { const int t = t0 + u;
            const float s0 = v0[u][0] * v0[u][0] + v0[u][1] * v0[u][1] + v0[u][2] * v0[u][2] + v0[u][3] * v0[u][3];
            const float s1 = v1[u][0] * v1[u][0] + v1[u][1] * v1[u][1] + v1[u][2] * v1[u][2] + v1[u][3] * v1[u][3];
            const float s2 = v2[u][0] * v2[u][0] + v2[u][1] * v2[u][1] + v2[u][2] * v2[u][2] + v2[u][3] * v2[u][3];
            const float ssq = wave_sum(s0 + (lane < 32 ? s1 : 0.f));
            const float sskv = wave_sum((lane >= 32 ? s1 : 0.f) + (lane < 32 ? s2 : 0.f));
            const float rq = 1.0f / sqrtf(ssq * (1.0f / 384.0f) + RMS_EPS), rkv = 1.0f / sqrtf(sskv * (1.0f / 256.0f) + RMS_EPS);
            { const f32x4 w = *(const f32x4*)(qnw + 4 * lane); u32x2 o; o.x = cvt_pk_bf16(v0[u][0] * rq * w[0], v0[u][1] * rq * w[1]); o.y = cvt_pk_bf16(v0[u][2] * rq * w[2], v0[u][3] * rq * w[3]);
              *(u32x2*)(cqn + (size_t)t * 384 + 4 * lane) = o; }
            if (lane < 32) { const f32x4 w = *(const f32x4*)(qnw + 256 + 4 * lane); u32x2 o; o.x = cvt_pk_bf16(v1[u][0] * rq * w[0], v1[u][1] * rq * w[1]); o.y = cvt_pk_bf16(v1[u][2] * rq * w[2], v1[u][3] * rq * w[3]);
              *(u32x2*)(cqn + (size_t)t * 384 + 256 + 4 * lane) = o; }
            else { const int ix = 4 * (lane - 32); const f32x4 w = *(const f32x4*)(kvnw + ix); u32x2 o; o.x = cvt_pk_bf16(v1[u][0] * rkv * w[0], v1[u][1] * rkv * w[1]); o.y = cvt_pk_bf16(v1[u][2] * rkv * w[2], v1[u][3] * rkv * w[3]);
              *(u32x2*)(ckvn + (size_t)t * 256 + ix) = o; }
            if (lane < 32) { const int ix = 128 + 4 * lane; const f32x4 w = *(const f32x4*)(kvnw + ix); u32x2 o; o.x = cvt_pk_bf16(v2[u][0] * rkv * w[0], v2[u][1] * rkv * w[1]); o.y = cvt_pk_bf16(v2[u][2] * rkv * w[2], v2[u][3] * rkv * w[3]);
              *(u32x2*)(ckvn + (size_t)t * 256 + ix) = o; }
            else if (lane < 48) { *(LAS f32x4*)(scr + 4 * (lane - 32)) = v2[u]; }
            LDS_WAIT(); asm volatile("" ::: "memory");
            if (lane < 32) { const int pos = tok_pos(t); const float a = scr[lane], b = scr[lane + 32], cs = cosT[pos * 32 + lane], sn = sinT[pos * 32 + lane];
                krope[(size_t)t * 64 + lane] = f2bf(a * cs - b * sn); krope[(size_t)t * 64 + 32 + lane] = f2bf(b * cs + a * sn); }
            LDS_WAIT(); asm volatile("" ::: "memory"); }
    }
}
__device__ __forceinline__ void mla_qrope(const Ctx& c) {
    bf16_t* q = (bf16_t*)(c.ws + B_Q);
    const float* cosT = (const float*)(c.ws + WS_ROPE); const float* sinT = cosT + 8192 * 32;
    const int lane = c.lane, i = lane & 31;
    for (int t = c.gw; t < T; t += c.NGW) {
        const int pos = tok_pos(t); const float cs = cosT[pos * 32 + i], sn = sinT[pos * 32 + i];
#pragma unroll
        for (int k = 0; k < 4; ++k) { const int h = (lane >> 5) + 2 * k; bf16_t* p = q + (size_t)t * 1536 + h * 192 + 128 + i;
            const float a = bf2f(p[0]), b = bf2f(p[32]); p[0] = f2bf(a * cs - b * sn); p[32] = f2bf(b * cs + a * sn); }
    }
}
template <int VAR> __device__ __forceinline__ void mla_attention(const Ctx& c) {
    const bf16_t* Q = (const bf16_t*)(c.ws + B_Q); const bf16_t* KV = (const bf16_t*)(c.ws + B_KV); const bf16_t* KR = (const bf16_t*)(c.ws + B_KROPE); bf16_t* O = VAR ? (bf16_t*)c.out + (size_t)T * 1024 : (bf16_t*)(c.ws + B_O);
    const int NU = 512 + 2048;
    for (int u = c.bid; u < NU; u += c.G) {
        int tok0, qb, h, seq;
        if (u < 512) { const int round = u >> 8, cc = u & 255, bh = round * 8 + (cc & 7); tok0 = (bh >> 3) * SP; h = bh & 7; qb = cc >> 3; seq = SP; }
        else { const int us = u - 512, round = us >> 8, cc = us & 255, r = cc >> 3, bh = round * 32 + (cc & 7) * 4 + (r >> 3); tok0 = TP + (bh >> 3) * SS; h = bh & 7; qb = r & 7; seq = SS; }
        attn::attn_body<VAR>(Q + (size_t)(tok0 + qb * 256) * 1536 + h * 192, KV + (size_t)tok0 * 2048 + h * 256, KR + (size_t)tok0 * 64,
                        O + (size_t)(tok0 + qb * 256) * 1024 + h * 128, seq, (char*)c.lds, c.tid, qb * 256, (const float*)(c.ws + WS_ROPE));
        __syncthreads();
    }
}
template <int NU, bool W8> __device__ __forceinline__ void ln_rows(f32x4 (&v)[NU][4], const float* g, const float* b, int lane, bf16_t* const (&dst)[NU], unsigned char* const (&dst8)[NU], float* const (&dsc)[NU]) {
    float s[NU], s2[NU];
#pragma unroll
    for (int u = 0; u < NU; ++u) { s[u] = 0.f;
#pragma unroll
        for (int j = 0; j < 4; ++j) s[u] += (v[u][j][0] + v[u][j][1]) + (v[u][j][2] + v[u][j][3]); }
#pragma unroll
    for (int u = 0; u < NU; ++u) s[u] = wave_sum(s[u]) * (1.0f / D);
#pragma unroll
    for (int u = 0; u < NU; ++u) { s2[u] = 0.f;
#pragma unroll
        for (int j = 0; j < 4; ++j) { v[u][j] = v[u][j] - s[u]; s2[u] += (v[u][j][0] * v[u][j][0] + v[u][j][1] * v[u][j][1]) + (v[u][j][2] * v[u][j][2] + v[u][j][3] * v[u][j][3]); } }
#pragma unroll
    for (int u = 0; u < NU; ++u) s2[u] = 1.0f / sqrtf(wave_sum(s2[u]) * (1.0f / D) + LN_EPS);
    float am[NU];
#pragma unroll
    for (int u = 0; u < NU; ++u) am[u] = 0.f;
#pragma unroll
    for (int j = 0; j < 4; ++j) { const f32x4 gg = *(const f32x4*)(g + 256 * j + 4 * lane), bb = *(const f32x4*)(b + 256 * j + 4 * lane);
#pragma unroll
        for (int u = 0; u < NU; ++u) { const f32x4 o = v[u][j] * s2[u] * gg + bb; u32x2 w; w.x = cvt_pk_bf16(o[0], o[1]); w.y = cvt_pk_bf16(o[2], o[3]); *(u32x2*)(dst[u] + 256 * j + 4 * lane) = w;
            if (W8) { v[u][j] = o; am[u] = fmaxf(am[u], fmaxf(fmaxf(fabsf(o[0]), fabsf(o[1])), fmaxf(fabsf(o[2]), fabsf(o[3])))); } } }
    if (W8) {
#pragma unroll
        for (int u = 0; u < NU; ++u) { const float mx = fmaxf(wave_max(am[u]), 1e-20f), inv = 240.0f / mx;
#pragma unroll
            for (int j = 0; j < 4; ++j) { int q = 0; q = __builtin_amdgcn_cvt_pk_fp8_f32(v[u][j][0] * inv, v[u][j][1] * inv, q, false); q = __builtin_amdgcn_cvt_pk_fp8_f32(v[u][j][2] * inv, v[u][j][3] * inv, q, true);
                *(unsigned*)(dst8[u] + 256 * j + 4 * lane) = (unsigned)q; }
            if (lane == 0) *dsc[u] = mx * (1.0f / 240.0f); }
    }
}
__device__ __forceinline__ void ln_residual(const Ctx& c, const bf16_t* hb, const float* g, const float* b) {
    const bf16_t* xm = (const bf16_t*)c.out; bf16_t* xa = (bf16_t*)(c.ws + WS_XB); const int lane = c.lane;
    constexpr int NU = 4;
    for (int t0 = c.gw * NU; t0 < T; t0 += c.NGW * NU) {
        f32x4 v[NU][4]; bf16_t* dst[NU]; unsigned char* dst8[NU]; float* dsc[NU];
#pragma unroll
        for (int u = 0; u < NU; ++u) { const bf16_t* xr = xm + (size_t)(t0 + u) * D; const bf16_t* hr = hb + (size_t)(t0 + u) * D; dst[u] = xa + (size_t)(t0 + u) * D;
            dst8[u] = c.ws + B_X8 + (size_t)(t0 + u) * D; dsc[u] = (float*)(c.ws + B_XS) + (t0 + u);
#pragma unroll
            for (int j = 0; j < 4; ++j) { const u32x2 xw = *(const u32x2*)(xr + 256 * j + 4 * lane), hw = *(const u32x2*)(hr + 256 * j + 4 * lane);
                v[u][j] = (f32x4){bflo(xw.x), bfhi(xw.x), bflo(xw.y), bfhi(xw.y)} * DN_ALPHA + (f32x4){bflo(hw.x), bfhi(hw.x), bflo(hw.y), bfhi(hw.y)}; } }
        ln_rows<NU, false>(v, g, b, lane, dst, dst8, dsc);
    }
}
__device__ __forceinline__ void hgrn_post(const Ctx& c, int j) {
    bf16_t* pl = (bf16_t*)(c.ws + B_PLANE); const size_t PE = (size_t)T * 1024;
    const bf16_t* of = pl + 1 * PE; const bf16_t* ob = pl + 2 * PE; const bf16_t* sg = pl + 4 * PE; bf16_t* on = pl;
    const float* nw = c.in(12) + j * 128; const int lane = c.lane;
    const int cw = (8 * lane) & 127; const f32x4 w0 = *(const f32x4*)(nw + cw), w1 = *(const f32x4*)(nw + cw + 4);
    constexpr int NU = 4;
    for (int t0 = c.gw * NU; t0 < T; t0 += c.NGW * NU) {
        u32x4 a[NU][2], b[NU][2], g[NU][2];
#pragma unroll
        for (int u = 0; u < NU; ++u)
#pragma unroll
            for (int k = 0; k < 2; ++k) { const size_t off = (size_t)(t0 + u) * 1024 + 512 * k + 8 * lane;
                a[u][k] = *(const u32x4*)(of + off); b[u][k] = *(const u32x4*)(ob + off); g[u][k] = *(const u32x4*)(sg + off); }
#pragma unroll
        for (int u = 0; u < NU; ++u)
#pragma unroll
            for (int k = 0; k < 2; ++k) { const size_t off = (size_t)(t0 + u) * 1024 + 512 * k + 8 * lane;
                float o[8], gg[8]; float ss = 0.f;
#pragma unroll
                for (int q = 0; q < 4; ++q) { o[2 * q] = bflo(a[u][k][q]) + bflo(b[u][k][q]); o[2 * q + 1] = bfhi(a[u][k][q]) + bfhi(b[u][k][q]); gg[2 * q] = bflo(g[u][k][q]); gg[2 * q + 1] = bfhi(g[u][k][q]); }
#pragma unroll
                for (int e = 0; e < 8; ++e) ss += o[e] * o[e];
                ss = row16_sum(ss);
                const float r = 1.0f / sqrtf(ss * (1.0f / 128.0f) + RMS_EPS);
                u32x4 w; w.x = cvt_pk_bf16(o[0] * r * w0[0] * gg[0], o[1] * r * w0[1] * gg[1]); w.y = cvt_pk_bf16(o[2] * r * w0[2] * gg[2], o[3] * r * w0[3] * gg[3]);
                w.z = cvt_pk_bf16(o[4] * r * w1[0] * gg[4], o[5] * r * w1[1] * gg[5]); w.w = cvt_pk_bf16(o[6] * r * w1[2] * gg[6], o[7] * r * w1[3] * gg[7]);
                *(u32x4*)(on + off) = w; }
    }
}
namespace scan {
constexpr size_t D_F = R2_IDX, D_B = R2_IDX + 12 * MiB;
constexpr int NCH = T / 32;
__device__ __forceinline__ void hgrn_prep(const Ctx& c, int dup) {
    bf16_t* pl = (bf16_t*)(c.ws + B_PLANE); const size_t PE = (size_t)T * 1024;
    bf16_t* qs = pl; bf16_t* lff = pl + PE; bf16_t* lfb = pl + 2 * PE; bf16_t* qtb = (bf16_t*)(c.ws + WS_XB);
    float* dF = (float*)(c.ws + D_F); float* dB = (float*)(c.ws + D_B);
    const int lane = c.lane;
#define PREP_STEP(LW, QW, QDST, KDST, R0, R1) { const unsigned lw = (LW), qw = (QW); const float l0 = bflo(lw), l1 = bfhi(lw); R0 += l0; R1 += l1; \
        const float k0 = 1.0f - fast_exp(l0), k1 = 1.0f - fast_exp(l1); \
        *(unsigned*)(QDST) = cvt_pk_bf16(bflo(qw) * fast_exp(R0), bfhi(qw) * fast_exp(R1)); \
        *(unsigned*)(KDST) = cvt_pk_bf16(k0 * fast_exp(fminf(-R0, 80.f)), k1 * fast_exp(fminf(-R1, 80.f))); }
    const char* qsB = (const char*)qs; const char* lffB = (const char*)lff; const char* lfbB = (const char*)lfb; const char* qtbB = (const char*)qtb;
    char* dmy = (char*)((bf16_t*)c.out + (size_t)T * 1024);
    char* qsW = dup ? dmy : (char*)qs; char* lffW = dup ? dmy : (char*)lff; char* lfbW = dup ? dmy : (char*)lfb; char* qtbW = dup ? dmy : (char*)qtb;
    if (dup) { dF = (float*)dmy; dB = (float*)dmy; }
    for (int it = c.gw; it < NCH * 8; it += c.NGW) {
        const int chunk = it >> 3, h = it & 7; const unsigned base = ((unsigned)chunk * 32u * 1024u + (unsigned)h * 128u + 2u * (unsigned)lane) * 2u;
        float b0 = 0.f, b1 = 0.f, f0 = 0.f, f1 = 0.f;
#define LDW(P, O) (*(const unsigned*)((P) + (O)))
#define STP(P, O) ((unsigned*)((char*)(P) + (O)))
        { unsigned wb[16], wq[16];
#pragma unroll
          for (int i = 0; i < 16; ++i) { const unsigned o = base + (unsigned)(16 + i) * 2048u; wb[i] = LDW(lfbB, o); wq[i] = LDW(qsB, o); }
#pragma unroll
          for (int i = 15; i >= 0; --i) { const unsigned o = base + (unsigned)(16 + i) * 2048u; PREP_STEP(wb[i], wq[i], STP(qtbW, o), STP(lfbW, o), b0, b1) } }
        { unsigned wb[16], wq[16], wf[16];
#pragma unroll
          for (int i = 0; i < 16; ++i) { const unsigned o = base + (unsigned)i * 2048u; wb[i] = LDW(lfbB, o); wq[i] = LDW(qsB, o); wf[i] = LDW(lffB, o); }
#pragma unroll
          for (int i = 15; i >= 0; --i) { const unsigned o = base + (unsigned)i * 2048u; PREP_STEP(wb[i], wq[i], STP(qtbW, o), STP(lfbW, o), b0, b1) }
          *(f32x2*)(dB + (size_t)chunk * 1024 + h * 128 + 2 * lane) = (f32x2){fast_exp(b0), fast_exp(b1)};
#pragma unroll
          for (int i = 0; i < 16; ++i) { const unsigned o = base + (unsigned)i * 2048u; PREP_STEP(wf[i], wq[i], STP(qsW, o), STP(lffW, o), f0, f1) } }
        { unsigned wf[16], wq[16];
#pragma unroll
          for (int i = 0; i < 16; ++i) { const unsigned o = base + (unsigned)(16 + i) * 2048u; wf[i] = LDW(lffB, o); wq[i] = LDW(qsB, o); }
#pragma unroll
          for (int i = 0; i < 16; ++i) { const unsigned o = base + (unsigned)(16 + i) * 2048u; PREP_STEP(wf[i], wq[i], STP(qsW, o), STP(lffW, o), f0, f1) }
          *(f32x2*)(dF + (size_t)chunk * 1024 + h * 128 + 2 * lane) = (f32x2){fast_exp(f0), fast_exp(f1)}; }
    }
#undef LDW
#undef STP
#undef PREP_STEP
}

constexpr int QT_OFF = 0, KT_OFF = 8192, V_OFF = 16384, DV_OFF = 24576, TILE_SET = 25088, P_OFF = 2 * TILE_SET, ST_OFF = P_OFF + 10240, ST_BYTES = 34816, SCAN_LDS_END = ST_OFF + 2 * ST_BYTES;
static_assert(SCAN_LDS_END <= LDS_MISC_OFF, "scan LDS layout");
constexpr int RS = 272, RS2 = 80;
__device__ __forceinline__ int crow(int r, int hi) { return (r & 3) + 8 * (r >> 2) + 4 * hi; }
__device__ __forceinline__ unsigned off_b(unsigned row, unsigned ch) { return 256u * row + 16u * (ch ^ (((row & 3) << 2) | ((row >> 2) & 3))); }
__device__ __forceinline__ unsigned row_read_addr(unsigned lane, unsigned s) { return off_b(lane & 31, 2 * s + (lane >> 5)); }
__device__ __forceinline__ unsigned tr_read_addr(unsigned lane, unsigned cc, unsigned ks, unsigned t) {
    const unsigned h = lane >> 5, blk = (lane >> 4) & 1, q = (lane & 15) >> 2, p = lane & 3;
    return off_b(16 * ks + 8 * h + 4 * t + q, 4 * cc + 2 * blk + (p >> 1)) + 8 * (p & 1);
}
template <int OFF> __device__ __forceinline__ s16x4 tr_rd(unsigned addr) { s16x4 r; asm volatile("ds_read_b64_tr_b16 %0, %1 offset:%2" : "=&v"(r) : "v"(addr), "n"(OFF) : "memory"); return r; }
template <int N> struct IC { static constexpr int value = N; };
#define TRPK(L, H) (bf16x8){L[0], L[1], L[2], L[3], H[0], H[1], H[2], H[3]}

__device__ __forceinline__ void run_chain(const Ctx& c, int tok0, int L, int h, int ch, bool dummy) {
    bf16_t* pl = (bf16_t*)(c.ws + B_PLANE); const size_t PE = (size_t)T * 1024;
    const int tid = c.tid, lane = c.lane, wave = c.wave, w = wave & 3, r32 = lane & 31, hi = lane >> 5;
    const bf16_t* qt = ch ? (const bf16_t*)(c.ws + WS_XB) : pl; bf16_t* kt = pl + (size_t)(1 + ch) * PE; const bf16_t* vv = pl + 3 * PE;
    const float* dd = (const float*)(c.ws + (ch ? D_B : D_F));
    bf16_t* odst = dummy ? (bf16_t*)c.out + (size_t)T * 1024 : kt;
    LAS unsigned char* base = c.lds;
    const unsigned lbase = (unsigned)(uintptr_t)base;
    const int NC = L / 32;
    const int vcol = 32 * w + r32;
    LAS unsigned char* Pw = base + P_OFF + w * 2560;
    unsigned trv[2], trk[4][2];
#pragma unroll
    for (int t = 0; t < 2; ++t) { trv[t] = lbase + tr_read_addr(lane, w, 0, t);
#pragma unroll
        for (int cc = 0; cc < 4; ++cc) trk[cc][t] = lbase + tr_read_addr(lane, cc, 0, t); }
    const int s_r0 = tid >> 4, s_chn = tid & 15;
    u32x4 sreg[3]; f32x4 dreg = (f32x4){0.f, 0.f, 0.f, 0.f};
#define SCAN_LOAD(cidx) do { const size_t rowb = (size_t)(tok0 + 32 * (cidx) + s_r0) * 1024 + h * 128 + s_chn * 8; \
        sreg[0] = *(const u32x4*)(qt + rowb); sreg[1] = *(const u32x4*)((const bf16_t*)kt + rowb); sreg[2] = *(const u32x4*)(vv + rowb); \
        if (tid < 32) dreg = *(const f32x4*)(dd + (size_t)((tok0 >> 5) + (cidx)) * 1024 + h * 128 + 4 * tid); } while (0)
#define SCAN_WRITE(set) do { LAS unsigned char* tb_ = base + (set) * TILE_SET; _Pragma("unroll") for (int i = 0; i < 3; ++i) *(LAS u32x4*)(tb_ + i * 8192 + off_b(s_r0, s_chn)) = sreg[i]; \
        if (tid < 32) *(LAS f32x4*)(tb_ + DV_OFF + 16 * tid) = dreg; } while (0)
    { LAS u32x4* st = (LAS u32x4*)(base + ST_OFF + ST_BYTES); for (int i = tid; i < ST_BYTES / 16; i += NTHR) st[i] = (u32x4){0u, 0u, 0u, 0u}; }
    f32x16 S[4];
#pragma unroll
    for (int kt2 = 0; kt2 < 4; ++kt2) S[kt2] = f32x16{};
    SCAN_LOAD(ch ? NC - 1 : 0); SCAN_WRITE(0);
    __syncthreads();
    auto chunk_body = [&](auto subc, auto rolec, const int ci) {
        constexpr int sub = decltype(subc)::value; constexpr bool og = decltype(rolec)::value == 0;
        const int cidx = ch ? NC - 1 - ci : ci;
        if (ci + 1 < NC) SCAN_LOAD(ch ? cidx - 1 : cidx + 1);
        LAS unsigned char* tb = base + sub * TILE_SET;
        if constexpr (og) {
            f32x16 X = f32x16{};
#pragma unroll
            for (int ks = 0; ks < 8; ++ks) { const bf16x8 qa = *(const LAS bf16x8*)(tb + QT_OFF + row_read_addr(lane, ks));
                const bf16x8 kb = *(const LAS bf16x8*)(tb + KT_OFF + row_read_addr(lane, ks));
                X = __builtin_amdgcn_mfma_f32_32x32x16_bf16(qa, kb, X, 0, 0, 0); }
#pragma unroll
            for (int r = 0; r < 16; ++r) { const int t = crow(r, hi); const bool keep = ch ? (t <= r32) : (t >= r32); *(LAS bf16_t*)(Pw + t * RS2 + r32 * 2) = f2bf(keep ? X[r] : 0.f); }
            s16x4 vl[2], vh[2];
            vl[0] = tr_rd<sub * TILE_SET + V_OFF>(trv[0]); vh[0] = tr_rd<sub * TILE_SET + V_OFF>(trv[1]); vl[1] = tr_rd<sub * TILE_SET + V_OFF + 4096>(trv[0]); vh[1] = tr_rd<sub * TILE_SET + V_OFF + 4096>(trv[1]);
            asm volatile("s_waitcnt lgkmcnt(0)" ::: "memory"); __builtin_amdgcn_sched_barrier(0);
            f32x16 O = f32x16{};
#pragma unroll
            for (int ks = 0; ks < 2; ++ks) { const bf16x8 pa = *(const LAS bf16x8*)(Pw + r32 * RS2 + (16 * ks + 8 * hi) * 2);
                O = __builtin_amdgcn_mfma_f32_32x32x16_bf16(pa, TRPK(vl[ks], vh[ks]), O, 0, 0, 0); }
            const LAS unsigned char* strd = base + ST_OFF + (sub ? 0 : ST_BYTES);
#pragma unroll
            for (int ks = 0; ks < 8; ++ks) { const bf16x8 sb = *(const LAS bf16x8*)(strd + vcol * RS + (16 * ks + 8 * hi) * 2);
                const bf16x8 qa = *(const LAS bf16x8*)(tb + QT_OFF + row_read_addr(lane, ks));
                O = __builtin_amdgcn_mfma_f32_32x32x16_bf16(qa, sb, O, 0, 0, 0); }
#pragma unroll
            for (int r = 0; r < 16; ++r) { const int t = tok0 + 32 * cidx + crow(r, hi); odst[(size_t)t * 1024 + h * 128 + vcol] = f2bf(O[r]); }
        } else {
            s16x4 vl[2], vh[2];
            vl[0] = tr_rd<sub * TILE_SET + V_OFF>(trv[0]); vh[0] = tr_rd<sub * TILE_SET + V_OFF>(trv[1]); vl[1] = tr_rd<sub * TILE_SET + V_OFF + 4096>(trv[0]); vh[1] = tr_rd<sub * TILE_SET + V_OFF + 4096>(trv[1]);
            s16x4 al[4][2], ah[4][2];
#define SCAN_KTRD(KT2) al[KT2][0] = tr_rd<sub * TILE_SET + KT_OFF>(trk[KT2][0]); ah[KT2][0] = tr_rd<sub * TILE_SET + KT_OFF>(trk[KT2][1]); \
            al[KT2][1] = tr_rd<sub * TILE_SET + KT_OFF + 4096>(trk[KT2][0]); ah[KT2][1] = tr_rd<sub * TILE_SET + KT_OFF + 4096>(trk[KT2][1]);
            SCAN_KTRD(0) SCAN_KTRD(1) SCAN_KTRD(2) SCAN_KTRD(3)
#undef SCAN_KTRD
            asm volatile("s_waitcnt lgkmcnt(0)" ::: "memory"); __builtin_amdgcn_sched_barrier(0);
            bf16x8 vb[2];
#pragma unroll
            for (int ks = 0; ks < 2; ++ks) vb[ks] = TRPK(vl[ks], vh[ks]);
#pragma unroll
            for (int kt2 = 0; kt2 < 4; ++kt2)
#pragma unroll
                for (int ks = 0; ks < 2; ++ks) S[kt2] = __builtin_amdgcn_mfma_f32_32x32x16_bf16(TRPK(al[kt2][ks], ah[kt2][ks]), vb[ks], S[kt2], 0, 0, 0);
            unsigned stw = (unsigned)(vcol * RS + 8 * hi) + (unsigned)(ST_OFF + (sub ? ST_BYTES : 0)), dvo = (unsigned)(16 * hi) + (unsigned)(sub * TILE_SET + DV_OFF); asm volatile("" : "+v"(stw), "+v"(dvo));
            f32x4 dq[2][4];
#define SCAN_DLOAD(KT2) _Pragma("unroll") for (int g = 0; g < 4; ++g) dq[(KT2) & 1][g] = *(const LAS f32x4*)(base + dvo + 128 * (KT2) + 32 * g);
#define SCAN_DECAY(KT2) _Pragma("unroll") for (int g = 0; g < 4; ++g) { const f32x4 d4 = dq[(KT2) & 1][g]; \
                _Pragma("unroll") for (int e = 0; e < 4; ++e) S[KT2][4 * g + e] *= d4[e]; \
                u32x2 pk; pk.x = cvt_pk_bf16(S[KT2][4 * g], S[KT2][4 * g + 1]); pk.y = cvt_pk_bf16(S[KT2][4 * g + 2], S[KT2][4 * g + 3]); \
                *(LAS u32x2*)(base + stw + 64 * (KT2) + 16 * g) = pk; }
            SCAN_DLOAD(0) SCAN_DLOAD(1)
            SCAN_DECAY(0) SCAN_DLOAD(2)
            SCAN_DECAY(1) SCAN_DLOAD(3)
            SCAN_DECAY(2) SCAN_DECAY(3)
#undef SCAN_DLOAD
#undef SCAN_DECAY
        }
        if (ci + 1 < NC) SCAN_WRITE(1 - sub);
        __syncthreads();
    };
    if (wave < 4) { for (int cj = 0; cj < NC; cj += 2) { chunk_body(IC<0>{}, IC<0>{}, cj); chunk_body(IC<1>{}, IC<0>{}, cj + 1); } }
    else          { for (int cj = 0; cj < NC; cj += 2) { chunk_body(IC<0>{}, IC<1>{}, cj); chunk_body(IC<1>{}, IC<1>{}, cj + 1); } }
#undef SCAN_LOAD
#undef SCAN_WRITE
}
#undef TRPK
__device__ __forceinline__ void hgrn_scan(const Ctx& c, bool dummy) {
    const int NI = 32 + 512;
    const bool split = c.G > 64;
    const int first = split ? (c.bid < 32 ? c.bid : 32 + (c.bid - 32)) : c.bid, step = split ? (c.bid < 32 ? NI : c.G - 32) : c.G;
    for (int it = first; it < NI; it += step) {
        const bool pr = it < 32; const int si = it - 32;
        run_chain(c, pr ? (it >> 4) * SP : TP + (si >> 4) * SS, pr ? SP : SS, pr ? ((it >> 1) & 7) : ((si >> 1) & 7), pr ? (it & 1) : (si & 1), dummy);
    }
}
}
#define CE_(a, i, j) { const unsigned _x = a[i] > a[j] ? a[i] : a[j], _y = a[i] > a[j] ? a[j] : a[i]; a[i] = _x; a[j] = _y; }
__device__ __forceinline__ void sort16_desc(unsigned (&a)[16]) {
    CE_(a, 0, 1) CE_(a, 2, 3) CE_(a, 0, 2) CE_(a, 1, 3) CE_(a, 1, 2) CE_(a, 4, 5) CE_(a, 6, 7) CE_(a, 4, 6) CE_(a, 5, 7) CE_(a, 5, 6) CE_(a, 0, 4) CE_(a, 2, 6) CE_(a, 2, 4) CE_(a, 1, 5) CE_(a, 3, 7) CE_(a, 3, 5) CE_(a, 1, 2) CE_(a, 3, 4) CE_(a, 5, 6) CE_(a, 8, 9) CE_(a, 10, 11) CE_(a, 8, 10) CE_(a, 9, 11) CE_(a, 9, 10) CE_(a, 12, 13) CE_(a, 14, 15) CE_(a, 12, 14) CE_(a, 13, 15) CE_(a, 13, 14) CE_(a, 8, 12) CE_(a, 10, 14) CE_(a, 10, 12) CE_(a, 9, 13) CE_(a, 11, 15) CE_(a, 11, 13) CE_(a, 9, 10) CE_(a, 11, 12) CE_(a, 13, 14) CE_(a, 0, 8) CE_(a, 4, 12) CE_(a, 4, 8) CE_(a, 2, 10) CE_(a, 6, 14) CE_(a, 6, 10) CE_(a, 2, 4) CE_(a, 6, 8) CE_(a, 10, 12) CE_(a, 1, 9) CE_(a, 5, 13) CE_(a, 5, 9) CE_(a, 3, 11) CE_(a, 7, 15) CE_(a, 7, 11) CE_(a, 3, 5) CE_(a, 7, 9) CE_(a, 11, 13) CE_(a, 1, 2) CE_(a, 3, 4) CE_(a, 5, 6) CE_(a, 7, 8) CE_(a, 9, 10) CE_(a, 11, 12) CE_(a, 13, 14)
}
__device__ __forceinline__ void merge16_top(unsigned (&a)[16], const unsigned (&b)[16]) {
    a[0] = a[0] > b[15] ? a[0] : b[15]; a[1] = a[1] > b[14] ? a[1] : b[14]; a[2] = a[2] > b[13] ? a[2] : b[13]; a[3] = a[3] > b[12] ? a[3] : b[12]; a[4] = a[4] > b[11] ? a[4] : b[11]; a[5] = a[5] > b[10] ? a[5] : b[10]; a[6] = a[6] > b[9] ? a[6] : b[9]; a[7] = a[7] > b[8] ? a[7] : b[8]; a[8] = a[8] > b[7] ? a[8] : b[7]; a[9] = a[9] > b[6] ? a[9] : b[6]; a[10] = a[10] > b[5] ? a[10] : b[5]; a[11] = a[11] > b[4] ? a[11] : b[4]; a[12] = a[12] > b[3] ? a[12] : b[3]; a[13] = a[13] > b[2] ? a[13] : b[2]; a[14] = a[14] > b[1] ? a[14] : b[1]; a[15] = a[15] > b[0] ? a[15] : b[0];
    CE_(a, 0, 8) CE_(a, 1, 9) CE_(a, 2, 10) CE_(a, 3, 11) CE_(a, 4, 12) CE_(a, 5, 13) CE_(a, 6, 14) CE_(a, 7, 15) CE_(a, 0, 4) CE_(a, 1, 5) CE_(a, 2, 6) CE_(a, 3, 7) CE_(a, 8, 12) CE_(a, 9, 13) CE_(a, 10, 14) CE_(a, 11, 15) CE_(a, 0, 2) CE_(a, 1, 3) CE_(a, 4, 6) CE_(a, 5, 7) CE_(a, 8, 10) CE_(a, 9, 11) CE_(a, 12, 14) CE_(a, 13, 15) CE_(a, 0, 1) CE_(a, 2, 3) CE_(a, 4, 5) CE_(a, 6, 7) CE_(a, 8, 9) CE_(a, 10, 11) CE_(a, 12, 13) CE_(a, 14, 15)
}
namespace peer {
constexpr int KEY_RS = 272;
constexpr int KEYS_BYTES = 2 * 128 * KEY_RS;
constexpr int SI_OFF = KEYS_BYTES;
__device__ __forceinline__ int crow(int r, int hi) { return (r & 3) + 8 * (r >> 2) + 4 * hi; }
__device__ __forceinline__ unsigned sortable(float f) { const unsigned u = __float_as_uint(f); return u ^ ((u >> 31) ? 0xFFFFFFFFu : 0x80000000u); }
__device__ __forceinline__ float unsortable(unsigned s) { const unsigned u = (s >> 31) ? (s ^ 0x80000000u) : ~s; return __uint_as_float(u); }
__device__ __forceinline__ unsigned pair_max(unsigned m) { auto rr = __builtin_amdgcn_permlane32_swap(m, m, false, false); return rr[0] > rr[1] ? rr[0] : rr[1]; }

__device__ __forceinline__ void top16_half(const Ctx& c, const bf16_t* pq_rows, int half, LAS unsigned char* keys, unsigned (&sel)[16]) {
    const int lane = c.lane, r32 = lane & 31, hi = lane >> 5;
    f32x16 acc[4];
#pragma unroll
    for (int nt = 0; nt < 4; ++nt) acc[nt] = f32x16{};
    const bf16_t* qrow = pq_rows + (size_t)r32 * 256 + half * 128;
    bf16x8 qb[8];
#pragma unroll
    for (int ks = 0; ks < 8; ++ks) qb[ks] = *reinterpret_cast<const bf16x8*>(qrow + 16 * ks + 8 * hi);
#pragma unroll
    for (int ks = 0; ks < 8; ++ks) {
#pragma unroll
        for (int nt = 0; nt < 4; ++nt) { const bf16x8 ka = *(const LAS bf16x8*)(keys + (half * 128 + 32 * nt + r32) * KEY_RS + (16 * ks + 8 * hi) * 2);
            acc[nt] = __builtin_amdgcn_mfma_f32_32x32x16_bf16(ka, qb[ks], acc[nt], 0, 0, 0); }
        if (ks & 1) __builtin_amdgcn_sched_barrier(0); }
    unsigned p[64];
#pragma unroll
    for (int nt = 0; nt < 4; ++nt)
#pragma unroll
        for (int r = 0; r < 16; ++r) { const int n = 32 * nt + crow(r, hi); p[nt * 16 + r] = (sortable(acc[nt][r]) & ~127u) | (unsigned)(127 - n); }
    unsigned g0[16], g1[16], g2[16], g3[16];
#pragma unroll
    for (int i = 0; i < 16; ++i) { g0[i] = p[i]; g1[i] = p[16 + i]; g2[i] = p[32 + i]; g3[i] = p[48 + i]; }
    sort16_desc(g0); sort16_desc(g1); sort16_desc(g2); sort16_desc(g3);
    merge16_top(g0, g1); merge16_top(g2, g3); merge16_top(g0, g2);
    unsigned pb[16];
#pragma unroll
    for (int i = 0; i < 16; ++i) { auto rr = __builtin_amdgcn_permlane32_swap(g0[i], g0[i], false, false); sel[i] = rr[0]; pb[i] = rr[1]; }
    merge16_top(sel, pb);
}
__device__ __forceinline__ void route(const Ctx& c, int layer) {
    const bf16_t* pq = (const bf16_t*)(c.ws + B_PQ); unsigned short* idx_out = (unsigned short*)(c.ws + R2_IDX); float* gate_out = (float*)(c.ws + R2_GATE);
    const bf16_t* keys_g = (const bf16_t*)(c.ws + W_KEYS) + (size_t)layer * 2 * 128 * 128;
    LAS unsigned char* keys = c.lds;
    const int lane = c.lane, r32 = lane & 31, hi = lane >> 5;
    for (int i = c.tid; i < 2 * 128 * 16; i += NTHR) { const int row = i >> 4, ch = i & 15; *(LAS u32x4*)(keys + row * KEY_RS + ch * 16) = *(const u32x4*)(keys_g + (size_t)row * 128 + ch * 8); }
    __syncthreads();
    LAS int* si = (LAS int*)(c.lds + SI_OFF + c.wave * 4096) + r32 * 32;
    for (int grp = c.gw; grp < T / 4; grp += c.NGW) {
        const bf16_t* rows = pq + (size_t)grp * 4 * 2048;
        unsigned s1[16], s2[16];
        top16_half(c, rows, 0, keys, s1);
        top16_half(c, rows, 1, keys, s2);
        float v1[16], v2[16];
#pragma unroll
        for (int i = 0; i < 16; ++i) { v1[i] = unsortable(s1[i] & ~127u); v2[i] = unsortable(s2[i] & ~127u); }
        if (hi == 0) {
#pragma unroll
            for (int i = 0; i < 16; ++i) { si[i] = 127 - (int)(s1[i] & 127u); si[16 + i] = 127 - (int)(s2[i] & 127u); }
        }
        float A[16], B[16];
#pragma unroll
        for (int i = 0; i < 16; ++i) { A[i] = hi ? v2[i] : v1[i]; B[i] = hi ? v1[i] : v2[i]; }
        unsigned cd[27]; int nc = 0;
#pragma unroll
        for (int i = 0; i < 16; ++i)
#pragma unroll
            for (int j = i; j < 16; ++j) if ((i + 1) * (j + 1) <= 16) {
                const unsigned flat = hi ? (unsigned)(j * 16 + i) : (unsigned)(i * 16 + j);
                unsigned pk = (sortable(A[i] + B[j]) & ~255u) | (255u - flat);
                if (i == j) pk = hi ? 0u : pk;
                cd[nc++] = pk; }
        unsigned sel[16], c1[16], pb[16];
#pragma unroll
        for (int i = 0; i < 16; ++i) { sel[i] = cd[i]; c1[i] = (16 + i < 27) ? cd[(16 + i < 27) ? 16 + i : 0] : 0u; }
        sort16_desc(sel); sort16_desc(c1); merge16_top(sel, c1);
#pragma unroll
        for (int i = 0; i < 16; ++i) { auto rr = __builtin_amdgcn_permlane32_swap(sel[i], sel[i], false, false); sel[i] = rr[0]; pb[i] = rr[1]; }
        merge16_top(sel, pb);
        LDS_WAIT(); asm volatile("" ::: "memory");
        const float vmax = unsortable(sel[0] & ~255u);
        float e[16], es = 0.f;
#pragma unroll
        for (int i = 0; i < 16; ++i) { e[i] = fast_exp(unsortable(sel[i] & ~255u) - vmax); es += e[i]; }
        const float inv = 1.0f / es;
        const size_t obase = ((size_t)grp * 4 + (r32 >> 3)) * 128 + (r32 & 7) * 16 + 8 * hi;
        int oi[8]; float og[8];
#pragma unroll
        for (int q = 0; q < 8; ++q) { const unsigned sv = hi ? sel[8 + q] : sel[q]; const float ev = hi ? e[8 + q] : e[q];
            const int flat = 255 - (int)(sv & 255u); oi[q] = si[flat >> 4] * 128 + si[16 + (flat & 15)]; og[q] = ev * inv; }
        *(u32x4*)(idx_out + obase) = (u32x4){(unsigned)oi[0] | ((unsigned)oi[1] << 16), (unsigned)oi[2] | ((unsigned)oi[3] << 16), (unsigned)oi[4] | ((unsigned)oi[5] << 16), (unsigned)oi[6] | ((unsigned)oi[7] << 16)};
        *(f32x4*)(gate_out + obase) = (f32x4){og[0], og[1], og[2], og[3]};
        *(f32x4*)(gate_out + obase + 4) = (f32x4){og[4], og[5], og[6], og[7]};
        LDS_WAIT(); asm volatile("" ::: "memory");
    }
    __syncthreads();
}

__device__ __forceinline__ float gelu_exact(float x) { return 0.5f * x * (1.0f + erff(x * 0.70710678118654752f)); }
template <int IDXMASK> __device__ __forceinline__ void gather_ln(const Ctx& c, int layer, float* xout, bf16_t* xb) {
    const unsigned char* U8 = c.ws + R2_UB; const unsigned char* V8 = c.ws + R2_VB;
    const float* su = (const float*)(c.ws + R2_SU); const float* sv = (const float*)(c.ws + R2_SV);
    const int* idx = (const int*)(c.ws + R2_IDX); const float* gate = (const float*)(c.ws + R2_GATE);
    const float* lg = c.in(20) + layer * D; const float* lbv = c.in(21) + layer * D;
    const int lane = c.lane;
    for (int t = c.gw; t < T; t += c.NGW) {
        const float* xr = c.out + (size_t)t * D + 16 * lane; float* xw = xout + (size_t)t * D + 16 * lane;
        float x[16], acc[16];
#pragma unroll
        for (int j = 0; j < 4; ++j) { const f32x4 a = *(const f32x4*)(xr + 4 * j); x[4 * j] = a[0]; x[4 * j + 1] = a[1]; x[4 * j + 2] = a[2]; x[4 * j + 3] = a[3]; }
#pragma unroll
        for (int e = 0; e < 16; ++e) acc[e] = 0.f;
        const int myidx0 = idx[(size_t)t * 128 + lane] & IDXMASK, myidx1 = idx[(size_t)t * 128 + 64 + lane] & IDXMASK;
        const float myg0 = gate[(size_t)t * 128 + lane], myg1 = gate[(size_t)t * 128 + 64 + lane];
        for (int eb = 0; eb < 128; eb += 8) {
            float part[8]; int ei[8];
#pragma unroll
            for (int q = 0; q < 8; ++q) { const int e = eb + q; ei[q] = __builtin_amdgcn_readlane(e < 64 ? myidx0 : myidx1, e & 63); }
            u32x4 vr[8];
#pragma unroll
            for (int q = 0; q < 8; ++q) vr[q] = *(const u32x4*)(V8 + (size_t)ei[q] * D + 16 * lane);
#pragma unroll
            for (int q = 0; q < 8; ++q) { const u32x4 a = *(const u32x4*)(U8 + (size_t)ei[q] * D + 16 * lane);
                float s = 0.f;
#pragma unroll
                for (int j = 0; j < 4; ++j) { const f32x2 lo = __builtin_amdgcn_cvt_pk_f32_fp8((int)a[j], false), hi = __builtin_amdgcn_cvt_pk_f32_fp8((int)a[j], true);
                    s = fmaf(lo[0], x[4 * j], s); s = fmaf(lo[1], x[4 * j + 1], s); s = fmaf(hi[0], x[4 * j + 2], s); s = fmaf(hi[1], x[4 * j + 3], s); }
                part[q] = s; }
            float r4[4], r2[2], r1;
            { const bool up = (lane & 32) != 0;
#pragma unroll
              for (int i = 0; i < 4; ++i) { const float send = up ? part[i] : part[4 + i]; const float keep = up ? part[4 + i] : part[i]; r4[i] = keep + __shfl_xor(send, 32); } }
            { const bool up = (lane & 16) != 0;
#pragma unroll
              for (int i = 0; i < 2; ++i) { const float send = up ? r4[i] : r4[2 + i]; const float keep = up ? r4[2 + i] : r4[i]; r2[i] = keep + __shfl_xor(send, 16); } }
            { const bool up = (lane & 8) != 0; const float send = up ? r2[0] : r2[1]; const float keep = up ? r2[1] : r2[0]; r1 = keep + __shfl_xor(send, 8); }
            r1 += __shfl_xor(r1, 4); r1 += __shfl_xor(r1, 2); r1 += __shfl_xor(r1, 1);
            const int myq = ((lane >> 5) & 1) * 4 + ((lane >> 4) & 1) * 2 + ((lane >> 3) & 1);
            const int me = eb + myq;
            const float g = __shfl(me < 64 ? myg0 : myg1, me & 63);
            const int mye = __shfl(me < 64 ? myidx0 : myidx1, me & 63);
            const float cf = g * gelu_exact(r1 * su[mye]) * sv[mye];
            float cq[8];
#pragma unroll
            for (int q = 0; q < 8; ++q) cq[q] = __int_as_float(__builtin_amdgcn_readlane(__float_as_int(cf), ((q >> 2) & 1) * 32 + ((q >> 1) & 1) * 16 + (q & 1) * 8));
#pragma unroll
            for (int q = 0; q < 8; ++q) { const float s = cq[q];
#pragma unroll
                for (int j = 0; j < 4; ++j) { const f32x2 lo = __builtin_amdgcn_cvt_pk_f32_fp8((int)vr[q][j], false), hi = __builtin_amdgcn_cvt_pk_f32_fp8((int)vr[q][j], true);
                    acc[4 * j] = fmaf(s, lo[0], acc[4 * j]); acc[4 * j + 1] = fmaf(s, lo[1], acc[4 * j + 1]); acc[4 * j + 2] = fmaf(s, hi[0], acc[4 * j + 2]); acc[4 * j + 3] = fmaf(s, hi[1], acc[4 * j + 3]); } }
        }
        float s = 0.f;
#pragma unroll
        for (int e = 0; e < 16; ++e) { acc[e] = fmaf(DN_ALPHA, x[e], acc[e]); s += acc[e]; }
        const float mean = wave_sum(s) * (1.0f / D); float s2 = 0.f;
#pragma unroll
        for (int e = 0; e < 16; ++e) { acc[e] -= mean; s2 += acc[e] * acc[e]; }
        const float rstd = 1.0f / sqrtf(wave_sum(s2) * (1.0f / D) + LN_EPS);
        float o[16];
#pragma unroll
        for (int j = 0; j < 4; ++j) { const f32x4 g4 = *(const f32x4*)(lg + 16 * lane + 4 * j), b4 = *(const f32x4*)(lbv + 16 * lane + 4 * j);
#pragma unroll
            for (int e = 0; e < 4; ++e) o[4 * j + e] = acc[4 * j + e] * rstd * g4[e] + b4[e];
            *(f32x4*)(xw + 4 * j) = (f32x4){o[4 * j], o[4 * j + 1], o[4 * j + 2], o[4 * j + 3]}; }
        u32x4 w0, w1; w0.x = cvt_pk_bf16(o[0], o[1]); w0.y = cvt_pk_bf16(o[2], o[3]); w0.z = cvt_pk_bf16(o[4], o[5]); w0.w = cvt_pk_bf16(o[6], o[7]);
        w1.x = cvt_pk_bf16(o[8], o[9]); w1.y = cvt_pk_bf16(o[10], o[11]); w1.z = cvt_pk_bf16(o[12], o[13]); w1.w = cvt_pk_bf16(o[14], o[15]);
        *(u32x4*)(xb + (size_t)t * D + 16 * lane) = w0; *(u32x4*)(xb + (size_t)t * D + 16 * lane + 8) = w1;
    }
}
}
namespace peer {
constexpr size_t HP_OFF = WS_BIG;
constexpr size_t COEF_OFF = WS_R2 + 36 * MiB;
constexpr int QW_BASE = 4096;
constexpr int ITEM_TOK = 128, NBLK = T / ITEM_TOK;
constexpr int GT = 1;
#define DPP_F(v, ctrl) __int_as_float(__builtin_amdgcn_update_dpp(0, __float_as_int(v), (ctrl), 0xf, 0xf, true))

template <class F> __device__ __forceinline__ void for_items(const Ctx& c, int layer, int phase, F body) {
    unsigned* qw = (unsigned*)(c.ws + WS_CTL) + QW_BASE + (size_t)((layer * 4 + phase) * 8) * 16;
    volatile LAS int* slot = (volatile LAS int*)(c.lds + LDS_MISC_OFF + 128);
    const int home = (int)(xb_xcc_id() & 7u);
    for (int k = 0; k < 8; ++k) {
        const int s = (home + k) & 7;
        if (c.tid == 0) slot[0] = (int)__hip_atomic_fetch_add(qw + s * 16, 1u, __ATOMIC_RELAXED, __HIP_MEMORY_SCOPE_AGENT);
        __syncthreads();
        int cur = slot[0];
        __syncthreads();
        while (cur < NBLK) {
            if (c.tid == 0) slot[0] = (int)__hip_atomic_fetch_add(qw + s * 16, 1u, __ATOMIC_RELAXED, __HIP_MEMORY_SCOPE_AGENT);
            body(s, cur);
            __syncthreads();
            cur = slot[0];
            __syncthreads();
        }
    }
}

__device__ __forceinline__ void g1_udot(const Ctx& c, int layer, int dup) {
    const unsigned char* U8 = c.ws + R2_UB; const unsigned short* idx = (const unsigned short*)(c.ws + R2_IDX); bf16_t* hp = (bf16_t*)(c.ws + HP_OFF);
    for_items(c, layer, 0 + 2 * dup, [&](int s, int blk) {
        int lane = c.lane; asm volatile("" : "+v"(lane));
        const int g = lane >> 3, c8 = lane & 7;
        const int co = 128 * s + 16 * c8;
#pragma unroll 1
        for (int i = 0; i < ITEM_TOK / NWAVES; i += GT) {
            const int t0 = blk * ITEM_TOK + c.wave * (ITEM_TOK / NWAVES) + i;
            float x[GT][16]; int id[GT][16];
#pragma unroll
            for (int u = 0; u < GT; ++u)
#pragma unroll
            for (int j = 0; j < 4; ++j) { const u32x2 a = *(const u32x2*)((const bf16_t*)(c.ws + WS_XB) + (size_t)(t0 + u) * D + co + 4 * j); x[u][4 * j] = bflo(a.x); x[u][4 * j + 1] = bfhi(a.x); x[u][4 * j + 2] = bflo(a.y); x[u][4 * j + 3] = bfhi(a.y);
                if (j < 2) { const u32x4 q = *(const u32x4*)(idx + (size_t)(t0 + u) * 128 + 16 * g + 8 * j);
#pragma unroll
                    for (int e = 0; e < 4; ++e) { id[u][8 * j + 2 * e] = (int)(q[e] & 0xffffu); id[u][8 * j + 2 * e + 1] = (int)(q[e] >> 16); } } }
            u32x4 row[GT][16];
#pragma unroll
            for (int u = 0; u < GT; ++u)
#pragma unroll
            for (int j = 0; j < 16; ++j) row[u][j] = *(const u32x4*)(U8 + (size_t)id[u][j] * D + co);
#pragma unroll
            for (int u = 0; u < GT; ++u) {
            float V[16];
#pragma unroll
            for (int j = 0; j < 16; ++j) { f32x2 acc2 = (f32x2){0.f, 0.f};
                if (dup) { V[j] = __uint_as_float((row[u][j][0] ^ row[u][j][1] ^ row[u][j][2] ^ row[u][j][3]) & 0x3fffffffu); continue; }
#pragma unroll
                for (int q = 0; q < 4; ++q) { const f32x2 lo = __builtin_amdgcn_cvt_pk_f32_fp8((int)row[u][j][q], false), hi = __builtin_amdgcn_cvt_pk_f32_fp8((int)row[u][j][q], true);
                    acc2 = __builtin_elementwise_fma(lo, (f32x2){x[u][4 * q], x[u][4 * q + 1]}, acc2); acc2 = __builtin_elementwise_fma(hi, (f32x2){x[u][4 * q + 2], x[u][4 * q + 3]}, acc2); }
                V[j] = acc2[0] + acc2[1]; }
            float W[8], Y[4], Z[2];
            { const bool hiA = (lane & 4) != 0;
#pragma unroll
              for (int m = 0; m < 8; ++m) { const float send = hiA ? V[m] : V[8 + m], keep = hiA ? V[8 + m] : V[m]; W[m] = keep + DPP_F(send, 0x141); } }
            { const bool hiB = (lane & 2) != 0;
#pragma unroll
              for (int m = 0; m < 4; ++m) { const float send = hiB ? W[m] : W[4 + m], keep = hiB ? W[4 + m] : W[m]; Y[m] = keep + DPP_F(send, 0x1B); } }
            { const bool hiC = (lane & 1) != 0;
#pragma unroll
              for (int m = 0; m < 2; ++m) { const float send = hiC ? Y[m] : Y[2 + m], keep = hiC ? Y[2 + m] : Y[m]; Z[m] = keep + DPP_F(send, 0xB1); } }
            *(unsigned*)((dup ? hp + (size_t)320 * MiB : hp) + ((size_t)(dup ? 0 : s) * T + t0 + u) * 128 + 16 * g + 2 * c8) = cvt_pk_bf16(Z[0], Z[1]);
            }
        }
    });
}
__device__ __forceinline__ void g2_coef(const Ctx& c, int dup) {
    const unsigned short* idx = (const unsigned short*)(c.ws + R2_IDX); const float* gate = (const float*)(c.ws + R2_GATE); const bf16_t* hp = (const bf16_t*)(c.ws + HP_OFF);
    const float* su = (const float*)(c.ws + R2_SU); const float* sv = (const float*)(c.ws + R2_SV);
    bf16_t* dstb = dup ? (bf16_t*)(c.ws + HP_OFF) + (size_t)340 * MiB : (bf16_t*)(c.ws + COEF_OFF);
    const int lane = c.lane;
    constexpr int NU = 4;
    for (int t0 = c.gw * NU; t0 < T; t0 += c.NGW * NU) {
        float h[NU][2]; unsigned ew[NU]; f32x2 gt[NU];
#pragma unroll
        for (int u = 0; u < NU; ++u) { const size_t o = (size_t)(t0 + u) * 128 + 2 * lane; ew[u] = *(const unsigned*)(idx + o); gt[u] = *(const f32x2*)(gate + o); float a0 = 0.f, a1 = 0.f;
#pragma unroll
            for (int s = 0; s < 8; ++s) { const unsigned w = *(const unsigned*)(hp + (size_t)s * T * 128 + o); a0 += bflo(w); a1 += bfhi(w); }
            h[u][0] = a0; h[u][1] = a1; }
        float s1[NU][2], s2[NU][2];
#pragma unroll
        for (int u = 0; u < NU; ++u) { const int e0 = (int)(ew[u] & 0xffffu), e1 = (int)(ew[u] >> 16); s1[u][0] = su[e0]; s1[u][1] = su[e1]; s2[u][0] = sv[e0]; s2[u][1] = sv[e1]; }
#pragma unroll
        for (int u = 0; u < NU; ++u) *(unsigned*)(dstb + (size_t)(t0 + u) * 128 + 2 * lane) = cvt_pk_bf16(gt[u][0] * gelu_exact(h[u][0] * s1[u][0]) * s2[u][0], gt[u][1] * gelu_exact(h[u][1] * s1[u][1]) * s2[u][1]);
    }
}
__device__ __forceinline__ void g3_vaxpy(const Ctx& c, int layer, int dup) {
    const unsigned char* V8 = c.ws + R2_VB; const unsigned short* idx = (const unsigned short*)(c.ws + R2_IDX); const bf16_t* coef = (const bf16_t*)(c.ws + COEF_OFF);
    for_items(c, layer, 1 + 2 * dup, [&](int s, int blk) {
        int lane = c.lane; asm volatile("" : "+v"(lane));
        const int g = lane >> 3, c8 = lane & 7;
        const int co = 128 * s + 16 * c8;
        constexpr int N = ITEM_TOK / NWAVES;
        const int t0 = blk * ITEM_TOK + c.wave * N;
        auto load_idx = [&](int t, int (&id)[16]) {
#pragma unroll
            for (int j = 0; j < 2; ++j) { const u32x4 q = *(const u32x4*)(idx + (size_t)t * 128 + 16 * g + 8 * j);
#pragma unroll
                for (int e = 0; e < 4; ++e) { id[8 * j + 2 * e] = (int)(q[e] & 0xffffu); id[8 * j + 2 * e + 1] = (int)(q[e] >> 16); } } };
        auto load_rows = [&](int t, const int (&id)[16], u32x4 (&row)[16], f32x4 (&cf)[4]) {
#pragma unroll
            for (int j = 0; j < 2; ++j) { const u32x4 q = *(const u32x4*)(coef + (size_t)t * 128 + 16 * g + 8 * j); cf[2 * j] = (f32x4){bflo(q[0]), bfhi(q[0]), bflo(q[1]), bfhi(q[1])}; cf[2 * j + 1] = (f32x4){bflo(q[2]), bfhi(q[2]), bflo(q[3]), bfhi(q[3])}; }
#pragma unroll
            for (int j = 0; j < 16; ++j) row[j] = *(const u32x4*)(V8 + ((unsigned)id[j] * 1024u + (unsigned)co)); };
        auto compute = [&](int t, const u32x4 (&row)[16], const f32x4 (&cf)[4]) {
            f32x2 A2[8];
#pragma unroll
            for (int e = 0; e < 8; ++e) A2[e] = (f32x2){0.f, 0.f};
#pragma unroll
            for (int j = 0; j < 16; ++j) { const float cj = cf[j >> 2][j & 3]; const f32x2 sc = (f32x2){cj, cj};
#pragma unroll
                for (int q = 0; q < 4; ++q) { const f32x2 lo = __builtin_amdgcn_cvt_pk_f32_fp8((int)row[j][q], false), hi = __builtin_amdgcn_cvt_pk_f32_fp8((int)row[j][q], true);
                    A2[2 * q] = __builtin_elementwise_fma(sc, lo, A2[2 * q]); A2[2 * q + 1] = __builtin_elementwise_fma(sc, hi, A2[2 * q + 1]); } }
            float A[16];
#pragma unroll
            for (int e = 0; e < 8; ++e) { A[2 * e] = A2[e][0]; A[2 * e + 1] = A2[e][1]; }
            float R[8], S2[4], Y[2];
#pragma unroll
            for (int m = 0; m < 8; ++m) { auto rr = __builtin_amdgcn_permlane32_swap(__float_as_uint(A[m]), __float_as_uint(A[8 + m]), false, false); R[m] = __uint_as_float(rr[0]) + __uint_as_float(rr[1]); }
#pragma unroll
            for (int m = 0; m < 4; ++m) { auto rr = __builtin_amdgcn_permlane16_swap(__float_as_uint(R[m]), __float_as_uint(R[4 + m]), false, false); S2[m] = __uint_as_float(rr[0]) + __uint_as_float(rr[1]); }
            { const bool hi8 = (lane & 8) != 0;
#pragma unroll
              for (int m = 0; m < 2; ++m) { const float send = hi8 ? S2[m] : S2[2 + m], keep = hi8 ? S2[2 + m] : S2[m]; Y[m] = keep + DPP_F(send, 0x128); } }
            const size_t yo = (size_t)t * D + co + 8 * ((lane >> 5) & 1) + 4 * ((lane >> 4) & 1) + 2 * ((lane >> 3) & 1);
            const unsigned xo = *(const unsigned*)((const bf16_t*)(c.ws + WS_XB) + yo);
            *(unsigned*)((bf16_t*)c.out + yo) = cvt_pk_bf16(fmaf(DN_ALPHA, bflo(xo), Y[0]), fmaf(DN_ALPHA, bfhi(xo), Y[1])); };
        int idA[16], idB[16]; u32x4 rowA[16], rowB[16]; f32x4 cfA[4], cfB[4];
        load_idx(t0, idA); load_rows(t0, idA, rowA, cfA); load_idx(t0 + 1, idB);
#pragma unroll 1
        for (int i = 0; i < N; i += 2) {
            load_rows(t0 + i + 1, idB, rowB, cfB);
            if (i + 2 < N) load_idx(t0 + i + 2, idA);
            __builtin_amdgcn_sched_barrier(0);
            compute(t0 + i, rowA, cfA);
            __builtin_amdgcn_sched_barrier(0);
            if (i + 2 < N) load_rows(t0 + i + 2, idA, rowA, cfA);
            if (i + 3 < N) load_idx(t0 + i + 3, idB);
            __builtin_amdgcn_sched_barrier(0);
            compute(t0 + i + 1, rowB, cfB);
            __builtin_amdgcn_sched_barrier(0);
        }
    });
}
__device__ __forceinline__ void ln_pass(const Ctx& c, const float* g, const float* b) {
    const bf16_t* ym = (const bf16_t*)c.out; bf16_t* xa = (bf16_t*)(c.ws + WS_XB); const int lane = c.lane;
    constexpr int NU = 4;
    for (int t0 = c.gw * NU; t0 < T; t0 += c.NGW * NU) {
        f32x4 v[NU][4]; bf16_t* dst[NU]; unsigned char* dst8[NU]; float* dsc[NU];
#pragma unroll
        for (int u = 0; u < NU; ++u) { dst8[u] = nullptr; dsc[u] = nullptr; const bf16_t* yr = ym + (size_t)(t0 + u) * D; dst[u] = xa + (size_t)(t0 + u) * D;
#pragma unroll
            for (int j = 0; j < 4; ++j) { const u32x2 w = *(const u32x2*)(yr + 256 * j + 4 * lane); v[u][j] = (f32x4){bflo(w.x), bfhi(w.x), bflo(w.y), bfhi(w.y)}; } }
        ln_rows<NU, false>(v, g, b, lane, dst, dst8, dsc);
    }
}
#undef DPP_F
}
constexpr int N_PHASES = 1 + 2 * (5 + 8) + 2 * (5 + 8);

#ifndef PROBE_SITE
#define PROBE_SITE -1
#endif
#ifndef PROBE_LN
#define PROBE_LN 0
#endif
#ifndef PROBE_VAR
#define PROBE_VAR 9
#endif
#define GEMM_PHASE(EPI, Aptr, Bptr, NN, KK, ...) { pg8::Gemm g{(const bf16_t*)(Aptr), (const bf16_t*)(Bptr), T, (NN), (KK)}; pg8::StaticOrder S; S.init(T, (NN), c.G, c.bid); \
        pg8::EPI E{__VA_ARGS__}; pg8::gemm_phase<pg8::EPI, pg8::StaticOrder>(c.lds, g, S, E, c.tid); }

__global__ void __launch_bounds__(NTHR, 2) fwd_kernel(Args args) {
    extern __shared__ __attribute__((aligned(16))) unsigned char lds_raw[];
    volatile LAS unsigned* misc = (volatile LAS unsigned*)((LAS unsigned char*)lds_raw + LDS_MISC_OFF);
    if (threadIdx.x < 64) misc[threadIdx.x] = 0u;
    __syncthreads();
    const int wave_s = __builtin_amdgcn_readfirstlane((int)threadIdx.x >> 6);
    const int lo = args.ph_lo, hi = args.ph_hi;
    XcdBarrier bar; bar.bar = (unsigned*)(args.ws + WS_CTL); bar.x = 0; bar.st = nullptr;
    if (hi - lo > 1) bar = xcd_barrier_post((unsigned*)(args.ws + WS_CTL), misc + 8);
    int ph = 0;
#define PHASE(site, ...) if (ph >= lo && ph < hi) { const Ctx c = mk_ctx(lds_raw, wave_s); unsigned char* const ws = c.ws; (void)ws; { constexpr int dup = 0; (void)dup; __VA_ARGS__ } \
        if constexpr (PROBE_SITE == (site)) { __syncthreads(); constexpr int dup = 1; (void)dup; __VA_ARGS__ } if (ph + 1 < hi) xcd_barrier(bar); } ++ph;

    PHASE(0, p0_prologue(c);)

    for (int layer = 0; layer < NL; ++layer) {
        const int j = layer >> 1;
        if ((layer & 1) == 0) {
            PHASE(1, GEMM_PHASE(EpiBf16P, c.out, (const bf16_t*)(ws + W_WA) + (size_t)j * 768 * 1024, 768, 1024, (bf16_t*)(ws + B_A32), 768))
            PHASE(2, l0_convert(c, layer); mla_e1(c, j);)
            PHASE(3, GEMM_PHASE(EpiBf16P, ws + B_CQN, (const bf16_t*)(ws + W_WUQ) + (size_t)j * 1536 * 384, 1536, 384, (bf16_t*)(ws + B_Q), 1536) __syncthreads();
                     GEMM_PHASE(EpiBf16P, ws + B_CKVN, (const bf16_t*)(ws + W_WUKV) + (size_t)j * 2048 * 256, 2048, 256, (bf16_t*)(ws + B_KV), 2048))
            PHASE(5, if (dup == 0) mla_attention<0>(c); else mla_attention<(PROBE_VAR > 4 ? 0 : PROBE_VAR)>(c);)
            PHASE(6, GEMM_PHASE(EpiBf16P, ws + B_O, (const bf16_t*)(ws + W_WO) + (size_t)j * 1024 * 1024, 1024, 1024, (bf16_t*)(ws + B_H32_MLA), 1024))
        } else {
            PHASE(7, GEMM_PHASE(EpiHgrn, c.out, (const bf16_t*)(ws + W_HIN) + (size_t)j * 5120 * 1024, 5120, 1024, (bf16_t*)(ws + B_PLANE), (size_t)T * 1024, (const float*)(ws + WS_MISC) + (size_t)j * 2048))
            PHASE(8, if (dup == 0) { l0_convert(c, layer); scan::hgrn_prep(c, 0); } else { scan::hgrn_prep(c, 1); })
            PHASE(9, scan::hgrn_scan(c, dup != 0);)
            PHASE(10, hgrn_post(c, j);)
            PHASE(11, GEMM_PHASE(EpiBf16P, ws + B_PLANE, (const bf16_t*)(ws + W_HO) + (size_t)j * 1024 * 1024, 1024, 1024, (bf16_t*)(ws + B_H32_HGRN), 1024))
        }
        PHASE(12, ln_residual(c, (const bf16_t*)(ws + ((layer & 1) ? B_H32_HGRN : B_H32_MLA)), c.in(18) + layer * D, c.in(19) + layer * D);)
        PHASE(13, GEMM_PHASE(EpiBf16P, ws + WS_XB, (const bf16_t*)(ws + W_PQ) + (size_t)layer * 2048 * 1024, 2048, 1024, (bf16_t*)(ws + B_PQ), 2048))
        PHASE(14, peer::route(c, layer);)
        PHASE(15, peer::g1_udot(c, layer, dup);)
        PHASE(16, peer::g2_coef(c, dup);)
        PHASE(17, peer::g3_vaxpy(c, layer, dup);)
        PHASE(18, if (dup == 0 || PROBE_LN == 0) GEMM_PHASE(EpiBf16P, ws + R2_PB, (const bf16_t*)(ws + W_PP) + (size_t)layer * 1024 * 256, 1024, 256, (bf16_t*)(ws + B_PP), 1024) if (dup == 0 || PROBE_LN == 1) peer::ln_pass(c, c.in(20) + layer * D, c.in(21) + layer * D);)
        PHASE(19, GEMM_PHASE(EpiPle, ws + WS_XB, (const bf16_t*)(ws + W_GW) + (size_t)layer * 1024 * 1024, 1024, 1024, (const bf16_t*)(ws + WS_XB), (const bf16_t*)(ws + B_PP), c.in(23) + layer * D, (bf16_t*)c.out, (layer == NL - 1) ? c.out : (float*)nullptr))
    }
#undef PHASE
}

extern "C" void kernel_launch(void* const* d_in, const int* in_sizes, int n_in, void* d_out, int out_size, void* d_ws, size_t ws_size, hipStream_t stream) {
    static int grid = 0;
    if (grid == 0) {
        if (n_in != 25 || out_size != T * D || ws_size < WS_END) { fprintf(stderr, "kernel_launch: unexpected shapes: n_in %d out %d ws %zu (need %zu)\n", n_in, out_size, ws_size, (size_t)WS_END); grid = -1; return; }
        int dev = 0, cus = 0, per_cu = 0;
        if (hipGetDevice(&dev) != hipSuccess || hipDeviceGetAttribute(&cus, hipDeviceAttributeMultiprocessorCount, dev) != hipSuccess) { grid = -1; return; }
        if (hipFuncSetAttribute((const void*)fwd_kernel, hipFuncAttributeMaxDynamicSharedMemorySize, LDS_BYTES) != hipSuccess) { fprintf(stderr, "kernel_launch: hipFuncSetAttribute failed\n"); grid = -1; return; }
        if (hipOccupancyMaxActiveBlocksPerMultiprocessor(&per_cu, (const void*)fwd_kernel, NTHR, LDS_BYTES) != hipSuccess || per_cu < 1) { fprintf(stderr, "kernel_launch: occupancy query says %d\n", per_cu); }
        (void)hipGetLastError();
        grid = cus;
    }
    if (grid < 0) return;
    (void)hipMemsetAsync((char*)d_ws + WS_CTL, 0, CTL_ZERO_BYTES, stream);
    Args a{};
    for (int i = 0; i < 25; ++i) a.in[i] = (const float*)d_in[i];
    a.out = (float*)d_out; a.ws = (unsigned char*)d_ws;
#if defined(MK_DEBUG_MLA)
    float* res = (float*)((char*)d_ws + WS_CTL + 48 * 1024);
    for (int p = 0; p < 4; ++p) { a.ph_lo = p; a.ph_hi = p + 1; hipLaunchKernelGGL(fwd_kernel, dim3(grid), dim3(NTHR), LDS_BYTES, stream, a); }
    hipLaunchKernelGGL(k_zero_out, dim3(2048), dim3(256), 0, stream, (float*)d_out, (size_t)T * D);
    hipLaunchKernelGGL(k_mla_naive, dim3(2), dim3(256), 0, stream, (const float*)d_in[0], (const float*)d_in[1], (const float*)d_in[4], (const float*)d_in[5], (const float*)d_in[6], (const float*)d_in[7], (const float*)d_in[8], (const unsigned char*)d_ws, res);
    hipLaunchKernelGGL(k_mla_report, dim3(1), dim3(64), 0, stream, (const float*)res, (float*)d_out);
#elif defined(MK_DEBUG_ATTN)
    float* res = (float*)((char*)d_ws + WS_CTL + 48 * 1024);
    for (int p = 0; p < 5; ++p) { a.ph_lo = p; a.ph_hi = p + 1; hipLaunchKernelGGL(fwd_kernel, dim3(grid), dim3(NTHR), LDS_BYTES, stream, a); }
    hipLaunchKernelGGL(k_zero_out, dim3(2048), dim3(256), 0, stream, (float*)d_out, (size_t)T * D);
    hipLaunchKernelGGL(k_attn_naive, dim3(2 * CHK_NR), dim3(256), 0, stream, (const unsigned char*)d_ws, (float*)nullptr, res);
    hipLaunchKernelGGL(k_attn_report, dim3(1), dim3(64), 0, stream, (const float*)res, (float*)d_out);
#elif defined(MK_DEBUG_DET)
    unsigned long long* tab = (unsigned long long*)((char*)d_ws + WS_CTL + 32 * 1024);
    for (int pass = 0; pass < 2; ++pass)
        for (int p = 0; p < N_PHASES; ++p) { a.ph_lo = p; a.ph_hi = p + 1; hipLaunchKernelGGL(fwd_kernel, dim3(grid), dim3(NTHR), LDS_BYTES, stream, a);
            Reg r[4]; const int nr = phase_regions(p, r);
            for (int i = 0; i < nr; ++i) hipLaunchKernelGGL(k_checksum, dim3(2048), dim3(256), 0, stream, (const unsigned*)(r[i].in_out ? (char*)d_out : (char*)d_ws + r[i].off), r[i].bytes / 4, tab + (size_t)pass * N_PHASES * 4 + p * 4 + i); }
    hipLaunchKernelGGL(k_zero_out, dim3(2048), dim3(256), 0, stream, (float*)d_out, (size_t)T * D);
    hipLaunchKernelGGL(k_report, dim3(1), dim3(64), 0, stream, tab, N_PHASES * 4, (float*)d_out);
#elif MK_ONE_LAUNCH
    a.ph_lo = 0; a.ph_hi = N_PHASES;
    hipLaunchKernelGGL(fwd_kernel, dim3(grid), dim3(NTHR), LDS_BYTES, stream, a);
#else
    for (int p = 0; p < N_PHASES; ++p) { a.ph_lo = p; a.ph_hi = p + 1; hipLaunchKernelGGL(fwd_kernel, dim3(grid), dim3(NTHR), LDS_BYTES, stream, a); }
#endif
}
```

```cpp
#include <hip/hip_runtime.h>
#include <cstdio>
#include <cstdint>

#ifndef MK_ONE_LAUNCH
#define MK_ONE_LAUNCH 1
#endif

#define GAS __attribute__((address_space(1)))
#define LAS __attribute__((address_space(3)))
typedef unsigned short bf16_t;
typedef short bf16x8 __attribute__((ext_vector_type(8)));
typedef short s16x4 __attribute__((ext_vector_type(4)));
typedef float f32x4 __attribute__((ext_vector_type(4)));
typedef float f32x2 __attribute__((ext_vector_type(2)));
typedef float f32x16 __attribute__((ext_vector_type(16)));
typedef unsigned u32x4 __attribute__((ext_vector_type(4)));
typedef unsigned u32x2 __attribute__((ext_vector_type(2)));

constexpr int D = 1024, TP = 16384, TS = 65536, T = TP + TS, SP = 8192, SS = 2048;
constexpr int NL = 4;
constexpr int NWAVES = 8, NTHR = 512;
constexpr float DN_ALPHA = 1.681792830507429f;
constexpr float LN_EPS = 1e-5f, RMS_EPS = 1e-6f;
constexpr float MLA_SCALE = 0.07216878364870323f;
constexpr int NEXP = 16384;

constexpr size_t MiB = 1u << 20;
constexpr size_t WS_CTL = 0, CTL_ZERO_BYTES = 64 * 1024;
constexpr size_t WS_ROPE = 1 * MiB;
constexpr size_t WS_MISC = 3 * MiB;
constexpr size_t WS_W = 4 * MiB;
constexpr size_t W_WA = WS_W;
constexpr size_t W_WUQ = W_WA + 2 * (size_t)768 * 1024 * 2;
constexpr size_t W_WUKV = W_WUQ + 2 * (size_t)1536 * 384 * 2;
constexpr size_t W_WO = W_WUKV + 2 * (size_t)2048 * 256 * 2;
constexpr size_t W_HIN = W_WO + 2 * (size_t)1024 * 1024 * 2;
constexpr size_t W_HO = W_HIN + 2 * (size_t)5120 * 1024 * 2;
constexpr size_t W_PQ = W_HO + 2 * (size_t)1024 * 1024 * 2;
constexpr size_t W_GW = W_PQ + 4 * (size_t)2048 * 1024 * 2;
constexpr size_t W_PP = W_GW + 4 * (size_t)1024 * 1024 * 2;
constexpr size_t W_KEYS = W_PP + 4 * (size_t)1024 * 256 * 2;
constexpr size_t W_END = W_KEYS + 4 * (size_t)2 * 128 * 128 * 2;
static_assert(W_END <= 68 * MiB, "weights region");
constexpr size_t WS_R2 = 68 * MiB;
constexpr size_t R2_UB = WS_R2, R2_VB = WS_R2 + 16 * MiB, R2_SU = WS_R2 + 32 * MiB, R2_SV = WS_R2 + 33 * MiB, R2_IDX = WS_R2 + 64 * MiB, R2_GATE = WS_R2 + 104 * MiB, R2_PB = WS_R2 + 144 * MiB;
constexpr size_t WS_XB = 252 * MiB;
constexpr size_t WS_BIG = 412 * MiB;
constexpr size_t WS_END = WS_BIG + 800 * MiB;
constexpr size_t B_Q = WS_BIG, B_KV = WS_BIG + 240 * MiB, B_O = WS_BIG + 560 * MiB, B_KROPE = WS_BIG + 720 * MiB;
constexpr size_t B_A32 = WS_BIG + 240 * MiB, B_CQN = WS_BIG + 560 * MiB, B_CKVN = WS_BIG + 620 * MiB, B_H32_MLA = WS_BIG;
constexpr size_t B_PLANE = WS_BIG, PLANE_BYTES = 160 * MiB, B_H32_HGRN = WS_BIG + 160 * MiB;
constexpr size_t B_PQ = WS_BIG, B_PP = WS_BIG + 320 * MiB, B_X8 = WS_BIG + 480 * MiB, B_XS = WS_BIG + 560 * MiB;

constexpr int LDS_BYTES = 160 * 1024;
constexpr int LDS_MISC_OFF = LDS_BYTES - 256;

typedef __bf16 bf16x2_n __attribute__((ext_vector_type(2)));
__device__ __forceinline__ unsigned cvt_pk_bf16(float lo, float hi) { const f32x2 v = {lo, hi}; const bf16x2_n b = __builtin_convertvector(v, bf16x2_n); return __builtin_bit_cast(unsigned, b); }
__device__ __forceinline__ bf16_t f2bf(float f) { return (bf16_t)(cvt_pk_bf16(f, 0.f) & 0xffffu); }
__device__ __forceinline__ float bf2f(bf16_t b) { return __uint_as_float(((unsigned)b) << 16); }
__device__ __forceinline__ float bflo(unsigned w) { return __uint_as_float(w << 16); }
__device__ __forceinline__ float bfhi(unsigned w) { return __uint_as_float(w & 0xffff0000u); }
#define DPPF(v, ctrl) __int_as_float(__builtin_amdgcn_update_dpp(0, __float_as_int(v), (ctrl), 0xf, 0xf, true))
__device__ __forceinline__ float row16_sum(float v) { v += DPPF(v, 0xB1); v += DPPF(v, 0x4E); v += DPPF(v, 0x141); v += DPPF(v, 0x140); return v; }
__device__ __forceinline__ float wave_sum(float v) { v = row16_sum(v);
    { auto r = __builtin_amdgcn_permlane16_swap(__float_as_uint(v), __float_as_uint(v), false, false); v = __uint_as_float(r[0]) + __uint_as_float(r[1]); }
    { auto r = __builtin_amdgcn_permlane32_swap(__float_as_uint(v), __float_as_uint(v), false, false); v = __uint_as_float(r[0]) + __uint_as_float(r[1]); }
    return v; }
__device__ __forceinline__ float wave_max(float v) { v = fmaxf(v, DPPF(v, 0xB1)); v = fmaxf(v, DPPF(v, 0x4E)); v = fmaxf(v, DPPF(v, 0x141)); v = fmaxf(v, DPPF(v, 0x140));
    { auto r = __builtin_amdgcn_permlane16_swap(__float_as_uint(v), __float_as_uint(v), false, false); v = fmaxf(__uint_as_float(r[0]), __uint_as_float(r[1])); }
    { auto r = __builtin_amdgcn_permlane32_swap(__float_as_uint(v), __float_as_uint(v), false, false); v = fmaxf(__uint_as_float(r[0]), __uint_as_float(r[1])); }
    return v; }
__device__ __forceinline__ float fast_exp(float x) { return __builtin_amdgcn_exp2f(x * 1.4426950408889634f); }
__device__ __forceinline__ float fast_log(float x) { return __builtin_amdgcn_logf(x) * 0.6931471805599453f; }
__device__ __forceinline__ float fast_rcp(float x) { return __builtin_amdgcn_rcpf(x); }
__device__ __forceinline__ float sigmoidf_(float x) { return fast_rcp(1.0f + fast_exp(-x)); }
__device__ __forceinline__ float siluf_(float x) { return x * sigmoidf_(x); }
#define LDS_WAIT() asm volatile("s_waitcnt lgkmcnt(0)" ::: "memory")
#define VM_WAIT() asm volatile("s_waitcnt vmcnt(0)" ::: "memory")
__device__ __forceinline__ int opaque_lane() { int l; asm volatile("v_mbcnt_lo_u32_b32 %0, -1, 0\n\tv_mbcnt_hi_u32_b32 %0, -1, %0" : "=v"(l)); return l; }
__device__ __forceinline__ int opaque_tid(int wave_s) { asm volatile("" : "+s"(wave_s)); return (wave_s << 6) + opaque_lane(); }
__device__ __forceinline__ int opaque_bid() { int b = (int)blockIdx.x; asm volatile("" : "+s"(b)); return b; }
struct Args { const float* in[25]; float* out; unsigned char* ws; int ph_lo, ph_hi; };
#define XB_TMO      128
#define XB_XCNT(j)  (256  + 64 * (j))
#define XB_XSUB(j)  (1280 + 64 * (j))
#define XB_XGEN(j)  (2304 + 64 * (j))
#define XB_TOP      3328
#define XB_TOPGEN   3392
#define XCD_BAR_WORDS 3456
#define XB_SPIN_CAP (1u << 23)

__device__ __forceinline__ unsigned xb_ld(unsigned* p)              { return __hip_atomic_load(p, __ATOMIC_RELAXED, __HIP_MEMORY_SCOPE_AGENT); }
__device__ __forceinline__ unsigned xb_add(unsigned* p, unsigned v) { return __hip_atomic_fetch_add(p, v, __ATOMIC_RELAXED, __HIP_MEMORY_SCOPE_AGENT); }
__device__ __forceinline__ unsigned xb_xcc_id() { return (unsigned)__builtin_amdgcn_s_getreg((3 << 11) | 20) & 0xFu; }
#define XB_SPIN(cond, bar) do { unsigned _sp = 0; while (cond) { __builtin_amdgcn_s_sleep(1); \
    if ((++_sp & 255u) == 0u) { if (xb_ld(&(bar)[XB_TMO])) break; if (_sp > XB_SPIN_CAP) { atomicAdd(&(bar)[XB_TMO], 1u); break; } } } } while (0)

struct XcdBarrier {
    unsigned* bar; unsigned x;
    volatile LAS unsigned* st;
};

__device__ __forceinline__ XcdBarrier xcd_barrier_post(unsigned* bar, volatile LAS unsigned* st) {
    XcdBarrier b; b.bar = bar; b.x = xb_xcc_id(); b.st = st;
    if (threadIdx.x == 0) (void)xb_add(&bar[XB_XCNT(b.x)], 1u);
    return b;
}
__device__ __forceinline__ void xcd_barrier_complete(unsigned* bar, unsigned x, unsigned& nloc, unsigned& nx) {
    const unsigned G = gridDim.x * gridDim.y * gridDim.z;
    unsigned sum, cnt, mine, sp = 0u;
    for (;;) {
        sum = 0u; cnt = 0u; mine = 0u;
#pragma unroll
        for (unsigned j = 0; j < 16; ++j) { const unsigned c = xb_ld(&bar[XB_XCNT(j)]); sum += c; cnt += (c > 0u) ? 1u : 0u; mine = (j == x) ? c : mine; }
        if (sum == G) break;
        __builtin_amdgcn_s_sleep(1);
        if ((++sp & 255u) == 0u) { if (xb_ld(&bar[XB_TMO])) break; if (sp > XB_SPIN_CAP) { atomicAdd(&bar[XB_TMO], 1u); break; } }
    }
    nloc = mine > 0u ? mine : 1u; nx = cnt > 0u ? cnt : 1u;
}

__device__ __forceinline__ void xcd_barrier(const XcdBarrier& b) {
    asm volatile("s_waitcnt vmcnt(0)" ::: "memory");
    __syncthreads();
    if (threadIdx.x == 0) {
        unsigned* bar = b.bar;
        __builtin_amdgcn_s_waitcnt(0);
        unsigned nloc = b.st[0], nx = b.st[1];
        if (nloc == 0u) { xcd_barrier_complete(bar, b.x, nloc, nx); b.st[0] = nloc; b.st[1] = nx; }
        const unsigned old = xb_add(&bar[XB_XSUB(b.x)], 1u);
        const unsigned gen = old / nloc;
        if (old + 1u == (gen + 1u) * nloc) {
            __builtin_amdgcn_fence(__ATOMIC_RELEASE, "agent");
            asm volatile("s_waitcnt vmcnt(0)" ::: "memory");
            const unsigned og = xb_add(&bar[XB_TOP], 1u);
            const unsigned tg = og / nx;
            if (og + 1u == (tg + 1u) * nx) xb_add(&bar[XB_TOPGEN], 1u);
            else XB_SPIN(xb_ld(&bar[XB_TOPGEN]) == tg, bar);
            __builtin_amdgcn_fence(__ATOMIC_ACQUIRE, "agent");
            xb_add(&bar[XB_XGEN(b.x)], 1u);
            asm volatile("s_waitcnt vmcnt(0)" ::: "memory");
        } else {
            XB_SPIN(xb_ld(&bar[XB_XGEN(b.x)]) == gen, bar);
            __builtin_amdgcn_fence(__ATOMIC_ACQUIRE, "agent");
            asm volatile("s_waitcnt vmcnt(0)" ::: "memory");
        }
    }
    __syncthreads();
}
namespace pg8 {
#define PG8_LAS __attribute__((address_space(3)))
constexpr int BM = 256, BK = 64, HALF = 128, HTB = HALF * BK * 2  , STAGE_BYTES = 8 * HTB, NXCD = 8, WGM = 8;

__host__ __device__ __forceinline__ int lds_byte(int r, int c) { const int st = (r >> 4) * 2 + (c >> 5), rr = r & 15, cc = c & 31, ob = rr * 64 + cc * 2; return st * 1024 + (ob ^ (((ob >> 9) & 1) << 5)); }
__host__ __device__ __forceinline__ void stage_rc(int b, int& R, int& C) { const int st = b / 1024, sb = b % 1024, swz = sb ^ (((sb >> 9) & 1) << 5); R = (st >> 1) * 16 + swz / 64; C = (st & 1) * 32 + (swz % 64) / 2; }
__host__ __device__ __forceinline__ int perm32(int rho) { const int n = rho >> 4, i = rho & 15; return 8 * (i >> 2) + 4 * n + (i & 3); }

struct Unit { int pm, pn; };
struct Gemm { const bf16_t* A; const bf16_t* Bt; int M, N, K; };

struct StaticOrder {
    int nM, nN, nwg, G, c;
    __host__ __device__ void init(int M, int N, int G_, int c_) { nM = M / BM; nN = N / BM; nwg = nM * nN; G = G_; c = c_; }
    __host__ __device__ bool next(int i, Unit& u) const {
        const long L = (long)i * G + c; if (L >= nwg) return false;
        int wgid = (int)L; { const int q = nwg / NXCD, r = nwg % NXCD, xcd = wgid % NXCD, off = wgid / NXCD; wgid = (xcd < r ? xcd * (q + 1) : r * (q + 1) + (xcd - r) * q) + off; }
        const int nig = WGM * nN, gid = wgid / nig, fm = gid * WGM, gsz = (nM - fm) < WGM ? (nM - fm) : WGM;
        u.pm = fm + ((wgid % nig) % gsz); u.pn = (wgid % nig) / gsz; return true;
    }
    __device__ __forceinline__ void a_ready(const Unit&) const {}
    __device__ __forceinline__ void done(const Unit&) const {}
};
template <class Epi, class Sched>
__device__ __forceinline__ void gemm_phase(PG8_LAS unsigned char* lds, const Gemm g, const Sched& S, const Epi& E, const int tid) {
    const int wid = __builtin_amdgcn_readfirstlane(tid >> 6), lane = tid & 63, wr = wid >> 2, wc = wid & 3, fr = lane & 15, fq = lane >> 4;
    const int K = g.K, nt = K / BK;
    unsigned voffA[2], voffB[2];
#pragma unroll
    for (int i = 0; i < 2; ++i) { int R, C; stage_rc(tid * 16 + i * 8192, R, C); const int Rb = Epi::PERM ? ((R & ~31) + perm32(R & 31)) : R;
        voffA[i] = (unsigned)(R * K + C) * 2u; voffB[i] = (unsigned)(Rb * K + C) * 2u; }
    const size_t kstep = (size_t)(BK * 2);
    const size_t hstep = (size_t)HALF * K * 2;
    const size_t tstep = 2 * hstep;
    const unsigned ldsw = (unsigned)wid * 1024u;
    const int aoff = lds_byte(wr * 64 + fr, fq * 8), boff = lds_byte(wc * 32 + fr, fq * 8);
#define PG8_SA(b, h) (((b) * 2 + (h)) * HTB)
#define PG8_SB(b, h) ((4 + (b) * 2 + (h)) * HTB)
#define PG8_STAGE(bufoff, gbase, voff) do { _Pragma("unroll") for (int _i = 0; _i < 2; ++_i) \
        __builtin_amdgcn_global_load_lds((const unsigned*)((const char*)(gbase) + (voff)[_i]), (PG8_LAS unsigned*)(lds + (bufoff) + ldsw + _i * 8192), 16, 0, 0); } while (0)
#define PG8_LDA(dst, b, h) do { _Pragma("unroll") for (int m = 0; m < 4; ++m) _Pragma("unroll") for (int k = 0; k < 2; ++k) dst[m][k] = *(const PG8_LAS bf16x8*)(lds + PG8_SA(b, h) + aoff + m * 2048 + k * 1024); } while (0)
#define PG8_LDB(dst, b, h) do { _Pragma("unroll") for (int n = 0; n < 2; ++n) _Pragma("unroll") for (int k = 0; k < 2; ++k) dst[n][k] = *(const PG8_LAS bf16x8*)(lds + PG8_SB(b, h) + boff + n * 2048 + k * 1024); } while (0)
#define PG8_MMA(ai, bj, At, Bt) do { __builtin_amdgcn_s_setprio(1); _Pragma("unroll") for (int m = 0; m < 4; ++m) _Pragma("unroll") for (int n = 0; n < 2; ++n) _Pragma("unroll") for (int k = 0; k < 2; ++k) \
        acc[ai][bj][m][n] = __builtin_amdgcn_mfma_f32_16x16x32_bf16(Bt[n][k], At[m][k], acc[ai][bj][m][n], 0, 0, 0); __builtin_amdgcn_s_setprio(0); } while (0)
#define PG8_WAIT_V(n) asm volatile("s_waitcnt vmcnt(" #n ")" ::: "memory")
#define PG8_WAIT_L(n) asm volatile("s_waitcnt lgkmcnt(" #n ")" ::: "memory")
#define PG8_BAR __builtin_amdgcn_s_barrier()
#define PG8_SCHED __builtin_amdgcn_sched_barrier(0)
    Unit cur, nxt; int ui = 0;
    if (!S.next(0, cur)) return;
    f32x4 acc[2][2][4][2];
#pragma unroll
    for (int a = 0; a < 2; ++a)
#pragma unroll
        for (int b = 0; b < 2; ++b)
#pragma unroll
            for (int m = 0; m < 4; ++m)
#pragma unroll
                for (int n = 0; n < 2; ++n) acc[a][b][m][n] = (f32x4){0.f, 0.f, 0.f, 0.f};
    bf16x8 At[4][2], B0[2][2], B1[2][2];
    const char* cA = (const char*)g.A + (size_t)cur.pm * tstep; const char* cB = (const char*)g.Bt + (size_t)cur.pn * tstep;
    S.a_ready(cur);
    PG8_STAGE(PG8_SB(0, 0), cB, voffB); PG8_STAGE(PG8_SA(0, 0), cA, voffA); PG8_STAGE(PG8_SB(0, 1), cB + hstep, voffB); PG8_STAGE(PG8_SA(0, 1), cA + hstep, voffA);
    if (wr == 1) PG8_BAR;
    PG8_WAIT_V(4); PG8_BAR;
    PG8_STAGE(PG8_SB(1, 0), cB + kstep, voffB); PG8_STAGE(PG8_SA(1, 0), cA + kstep, voffA); PG8_STAGE(PG8_SB(1, 1), cB + hstep + kstep, voffB);
    PG8_WAIT_V(6); PG8_BAR;
    for (;;) {
        const bool has_next = S.next(ui + 1, nxt);
        const char* nA = has_next ? (const char*)g.A + (size_t)nxt.pm * tstep : cA; const char* nB = has_next ? (const char*)g.Bt + (size_t)nxt.pn * tstep : cB;
        for (int t = 0; t < nt; t += 2) {
            const bool last = (t == nt - 2);
            const char* a1 = cA + (size_t)(t + 1) * kstep;
            const char* a2 = last ? nA : cA + (size_t)(t + 2) * kstep; const char* b2 = last ? nB : cB + (size_t)(t + 2) * kstep;
            const char* a3 = a2 + kstep; const char* b3 = b2 + kstep;
            if (last && has_next) S.a_ready(nxt);
            PG8_LDB(B0, 0, 0); PG8_SCHED; PG8_LDA(At, 0, 0); PG8_STAGE(PG8_SA(1, 1), a1 + hstep, voffA);
            PG8_WAIT_L(8); PG8_BAR; PG8_WAIT_L(0); PG8_MMA(0, 0, At, B0); PG8_BAR; PG8_SCHED;
            PG8_LDB(B1, 0, 1); PG8_STAGE(PG8_SB(0, 0), b2, voffB);
            PG8_BAR; PG8_WAIT_L(0); PG8_MMA(0, 1, At, B1); PG8_BAR;
            PG8_LDA(At, 0, 1); PG8_STAGE(PG8_SA(0, 0), a2, voffA);
            PG8_BAR; PG8_WAIT_L(0); PG8_MMA(1, 0, At, B0); PG8_BAR; PG8_SCHED;
            PG8_STAGE(PG8_SB(0, 1), b2 + hstep, voffB);
            PG8_WAIT_V(6); PG8_BAR; PG8_MMA(1, 1, At, B1); PG8_BAR;
            PG8_LDB(B0, 1, 0); PG8_SCHED; PG8_LDA(At, 1, 0); PG8_STAGE(PG8_SA(0, 1), a2 + hstep, voffA);
            PG8_WAIT_L(8); PG8_BAR; PG8_WAIT_L(0); PG8_MMA(0, 0, At, B0); PG8_BAR; PG8_SCHED;
            PG8_LDB(B1, 1, 1); PG8_STAGE(PG8_SB(1, 0), b3, voffB);
            PG8_BAR; PG8_WAIT_L(0); PG8_MMA(0, 1, At, B1); PG8_BAR;
            PG8_LDA(At, 1, 1); PG8_STAGE(PG8_SA(1, 0), a3, voffA);
            PG8_BAR; PG8_WAIT_L(0); PG8_MMA(1, 0, At, B0); PG8_BAR; PG8_SCHED;
            PG8_STAGE(PG8_SB(1, 1), b3 + hstep, voffB);
            PG8_WAIT_V(6); PG8_BAR; PG8_MMA(1, 1, At, B1); PG8_BAR;
        }
        E(acc, cur, wr, wc, fr, fq); S.done(cur);
        if (!has_next) break;
#pragma unroll
        for (int a = 0; a < 2; ++a)
#pragma unroll
            for (int b = 0; b < 2; ++b)
#pragma unroll
                for (int m = 0; m < 4; ++m)
#pragma unroll
                    for (int n = 0; n < 2; ++n) acc[a][b][m][n] = (f32x4){0.f, 0.f, 0.f, 0.f};
        cur = nxt; cA = nA; cB = nB; ++ui;
    }
    PG8_WAIT_V(0);
    if (wr == 0) PG8_BAR;
    PG8_BAR;
#undef PG8_SA
#undef PG8_SB
#undef PG8_STAGE
#undef PG8_LDA
#undef PG8_LDB
#undef PG8_MMA
#undef PG8_WAIT_V
#undef PG8_WAIT_L
#undef PG8_BAR
#undef PG8_SCHED
}
struct EpiF32 {
    static constexpr bool PERM = false;
    float* C; int ldc;
    __device__ __forceinline__ void operator()(const f32x4 (&acc)[2][2][4][2], const Unit& u, int wr, int wc, int fr, int fq) const {
        const int row0 = u.pm * BM + wr * 64 + fr, col0 = u.pn * BM + wc * 32 + 4 * fq;
#pragma unroll
        for (int ai = 0; ai < 2; ++ai)
#pragma unroll
            for (int m = 0; m < 4; ++m) { float* rowp = C + (size_t)(row0 + ai * HALF + m * 16) * ldc + col0;
#pragma unroll
                for (int bj = 0; bj < 2; ++bj)
#pragma unroll
                    for (int n = 0; n < 2; ++n) *(f32x4*)(rowp + bj * HALF + n * 16) = acc[ai][bj][m][n]; }
    }
};
struct EpiBf16P {
    static constexpr bool PERM = true;
    bf16_t* O; int ldc;
    __device__ __forceinline__ void operator()(const f32x4 (&acc)[2][2][4][2], const Unit& u, int wr, int wc, int fr, int fq) const {
        const int row0 = u.pm * BM + wr * 64 + fr, col0 = u.pn * BM + wc * 32 + 8 * fq;
#pragma unroll
        for (int ai = 0; ai < 2; ++ai)
#pragma unroll
            for (int m = 0; m < 4; ++m) { bf16_t* rowp = O + (size_t)(row0 + ai * HALF + m * 16) * ldc + col0;
#pragma unroll
                for (int bj = 0; bj < 2; ++bj) { const f32x4 v0 = acc[ai][bj][m][0], v1 = acc[ai][bj][m][1];
                    u32x4 w; w.x = cvt_pk_bf16(v0[0], v0[1]); w.y = cvt_pk_bf16(v0[2], v0[3]); w.z = cvt_pk_bf16(v1[0], v1[1]); w.w = cvt_pk_bf16(v1[2], v1[3]);
                    *(u32x4*)(rowp + bj * HALF) = w; } }
    }
};
struct EpiHgrn {
    static constexpr bool PERM = true;
    bf16_t* planes; size_t plane_elems; const float* lb;
    __device__ __forceinline__ void operator()(const f32x4 (&acc)[2][2][4][2], const Unit& u, int wr, int wc, int fr, int fq) const {
        const int plane = u.pn >> 2;
        const int row0 = u.pm * BM + wr * 64 + fr, col0 = (u.pn & 3) * BM + wc * 32 + 8 * fq;
        bf16_t* base = planes + (size_t)plane * plane_elems;
        float lbv[2][8];
        if (plane == 1 || plane == 2) {
#pragma unroll
            for (int bj = 0; bj < 2; ++bj)
#pragma unroll
                for (int e = 0; e < 8; ++e) lbv[bj][e] = lb[(plane - 1) * 1024 + col0 + bj * HALF + e];
        } else {
#pragma unroll
            for (int bj = 0; bj < 2; ++bj)
#pragma unroll
                for (int e = 0; e < 8; ++e) lbv[bj][e] = 0.f;
        }
#pragma unroll
        for (int ai = 0; ai < 2; ++ai)
#pragma unroll
            for (int m = 0; m < 4; ++m) { bf16_t* rowp = base + (size_t)(row0 + ai * HALF + m * 16) * 1024 + col0;
#pragma unroll
                for (int bj = 0; bj < 2; ++bj) { float v[8];
#pragma unroll
                    for (int e = 0; e < 4; ++e) { v[e] = acc[ai][bj][m][0][e]; v[4 + e] = acc[ai][bj][m][1][e]; }
                    if (plane == 0 || plane == 4) {
#pragma unroll
                        for (int e = 0; e < 8; ++e) v[e] = siluf_(v[e]);
                    } else if (plane == 1 || plane == 2) {
#pragma unroll
                        for (int e = 0; e < 8; ++e) { const float l = lbv[bj][e]; const float f = l + (1.0f - l) * sigmoidf_(v[e]); v[e] = fast_log(fmaxf(f, 1e-30f)); }
                    }
                    u32x4 w; w.x = cvt_pk_bf16(v[0], v[1]); w.y = cvt_pk_bf16(v[2], v[3]); w.z = cvt_pk_bf16(v[4], v[5]); w.w = cvt_pk_bf16(v[6], v[7]);
                    *(u32x4*)(rowp + bj * HALF) = w; } }
    }
};
struct EpiPle {
    static constexpr bool PERM = true;
    const bf16_t* Xin; const bf16_t* PP; const float* bias; bf16_t* XbOut; float* Fout;
    __device__ __forceinline__ void operator()(const f32x4 (&acc)[2][2][4][2], const Unit& u, int wr, int wc, int fr, int fq) const {
        const int row0 = u.pm * BM + wr * 64 + fr, col0 = u.pn * BM + wc * 32 + 8 * fq;
        f32x4 bv[2][2];
#pragma unroll
        for (int bj = 0; bj < 2; ++bj)
#pragma unroll
            for (int n = 0; n < 2; ++n) bv[bj][n] = *(const f32x4*)(bias + col0 + bj * HALF + 4 * n);
        u32x4 xw[2][2], pw[2][2];
#define PLE_LD(G, B) { const size_t off_ = (size_t)(row0 + ((G) >> 2) * HALF + ((G) & 3) * 16) * 1024 + col0; \
            _Pragma("unroll") for (int bj = 0; bj < 2; ++bj) { xw[B][bj] = *(const u32x4*)(Xin + off_ + bj * HALF); pw[B][bj] = *(const u32x4*)(PP + off_ + bj * HALF); } }
        PLE_LD(0, 0)
#pragma unroll
        for (int g = 0; g < 8; ++g) {
            if (g + 1 < 8) { if ((g + 1) & 1) PLE_LD(g + 1, 1) else PLE_LD(g + 1, 0) }
            __builtin_amdgcn_sched_barrier(0);
            const int ai = g >> 2, m = g & 3; const size_t off = (size_t)(row0 + ai * HALF + m * 16) * 1024 + col0;
#pragma unroll
            for (int bj = 0; bj < 2; ++bj) { const u32x4 xv = xw[g & 1][bj], pv = pw[g & 1][bj]; float o[8];
#pragma unroll
                for (int n = 0; n < 2; ++n) { const f32x4 z = acc[ai][bj][m][n] + bv[bj][n];
                    o[4 * n + 0] = bflo(xv[2 * n]) + sigmoidf_(z[0]) * bflo(pv[2 * n]); o[4 * n + 1] = bfhi(xv[2 * n]) + sigmoidf_(z[1]) * bfhi(pv[2 * n]);
                    o[4 * n + 2] = bflo(xv[2 * n + 1]) + sigmoidf_(z[2]) * bflo(pv[2 * n + 1]); o[4 * n + 3] = bfhi(xv[2 * n + 1]) + sigmoidf_(z[3]) * bfhi(pv[2 * n + 1]); }
                const size_t o2 = off + bj * HALF;
                if (Fout) { *(f32x4*)(Fout + o2) = (f32x4){o[0], o[1], o[2], o[3]}; *(f32x4*)(Fout + o2 + 4) = (f32x4){o[4], o[5], o[6], o[7]}; }
                else { u32x4 w; w.x = cvt_pk_bf16(o[0], o[1]); w.y = cvt_pk_bf16(o[2], o[3]); w.z = cvt_pk_bf16(o[4], o[5]); w.w = cvt_pk_bf16(o[6], o[7]); *(u32x4*)(XbOut + o2) = w; } }
            __builtin_amdgcn_sched_barrier(0);
        }
#undef PLE_LD
    }
};
}
namespace attn {
constexpr int DV = 128, DQK = 192, NW = 8, QBLK = 32, KVBLK = 64;
constexpr float SCALE = MLA_SCALE;
constexpr float THR = 8.f;
constexpr int LDQ = 8 * DQK, LDKV = 8 * 256, LDKR = 64, LDO = 1024;
constexpr int KROWB = 400;
constexpr int SHM_V = KVBLK * DV * 2, SHM_K = KVBLK * KROWB, SHM_ATTN = 2 * SHM_V + 2 * SHM_K + NW * 64 * 4 + NW * 4096;
#define SBAR() __builtin_amdgcn_sched_barrier(0)
__device__ __forceinline__ int crow(int r, int hi) { return (r & 3) + 8 * (r >> 2) + 4 * hi; }

__device__ __forceinline__ void partialSM(f32x16& p0, f32x16& p1, float& m_reg, float& mn, float& alpha) {
  constexpr float C = SCALE * 1.4426950408889634f;
  float pmax = p0[0];
#pragma unroll
  for (int r = 1; r < 16; ++r) pmax = fmaxf(pmax, p0[r]);
#pragma unroll
  for (int r = 0; r < 16; ++r) pmax = fmaxf(pmax, p1[r]);
  { auto rr = __builtin_amdgcn_permlane32_swap(__float_as_uint(pmax), __float_as_uint(pmax), false, false);
    pmax = fmaxf(__uint_as_float(rr[0]), __uint_as_float(rr[1])); }
  if (__builtin_expect(__all(pmax - m_reg <= THR / SCALE), 1)) { mn = m_reg; alpha = 1.f; }
  else { mn = fmaxf(m_reg, pmax); alpha = __builtin_amdgcn_exp2f((m_reg - mn) * C); m_reg = mn; }
  float mnC = -mn * C;
#pragma unroll
  for (int r = 0; r < 16; ++r) p0[r] = fmaf(p0[r], C, mnC);
#pragma unroll
  for (int r = 0; r < 16; ++r) p1[r] = fmaf(p1[r], C, mnC);
#pragma unroll
  for (int r = 0; r < 16; ++r) p0[r] = __builtin_amdgcn_exp2f(p0[r]);
}
__device__ __forceinline__ void finishSM(f32x16& p0, f32x16& p1, float alpha, float& l_reg, bf16x8& pa0, bf16x8& pa1, bf16x8& pa2, bf16x8& pa3) {
#pragma unroll
  for (int r = 0; r < 16; ++r) p1[r] = __builtin_amdgcn_exp2f(p1[r]);
  float ps = 0;
#pragma unroll
  for (int r = 0; r < 16; ++r) ps += p0[r];
#pragma unroll
  for (int r = 0; r < 16; ++r) ps += p1[r];
  { auto rr = __builtin_amdgcn_permlane32_swap(__float_as_uint(ps), __float_as_uint(ps), false, false);
    ps = __uint_as_float(rr[0]) + __uint_as_float(rr[1]); }
  l_reg = l_reg * alpha + ps;
#define PK4(P, BASE, OUT) do { unsigned a0 = cvt_pk_bf16(P[BASE + 0], P[BASE + 1]), a1 = cvt_pk_bf16(P[BASE + 2], P[BASE + 3]);   \
    unsigned b0 = cvt_pk_bf16(P[BASE + 4], P[BASE + 5]), b1 = cvt_pk_bf16(P[BASE + 6], P[BASE + 7]);                              \
    auto r0 = __builtin_amdgcn_permlane32_swap(a0, b0, false, false); auto r1 = __builtin_amdgcn_permlane32_swap(a1, b1, false, false); \
    u32x4 w = {r0[0], r1[0], r0[1], r1[1]}; OUT = *reinterpret_cast<bf16x8*>(&w); } while (0)
  PK4(p0, 0, pa0); PK4(p0, 8, pa1); PK4(p1, 0, pa2); PK4(p1, 8, pa3);
#undef PK4
}
__device__ __forceinline__ void qkt(f32x16& p0, f32x16& p1, const char* Ks, const bf16x8* qr, const char* qrl, int r32, int hi) {
  p0 = f32x16{}; p1 = f32x16{};
  const char* k0 = Ks + r32 * KROWB + hi * 16; const char* k1 = Ks + (32 + r32) * KROWB + hi * 16;
  bf16x8 fa[2], fb[2], ga[2], gb[2], qx[2], qy[2];
#define QK_LD(FA, FB, QX, G) _Pragma("unroll") for (int i = 0; i < 2; ++i) { FA[i] = *reinterpret_cast<const bf16x8*>(k0 + ((G) * 2 + i) * 32); FB[i] = *reinterpret_cast<const bf16x8*>(k1 + ((G) * 2 + i) * 32); \
      if ((G) * 2 + i >= 8) QX[i] = *reinterpret_cast<const bf16x8*>(qrl + ((G) * 2 + i - 8) * 1024); }
#define QK_MM(FA, FB, QX, G) _Pragma("unroll") for (int i = 0; i < 2; ++i) { const bf16x8 qf = ((G) * 2 + i < 8) ? qr[((G) * 2 + i < 8) ? (G) * 2 + i : 0] : QX[i]; \
      p0 = __builtin_amdgcn_mfma_f32_32x32x16_bf16(FA[i], qf, p0, 0, 0, 0); p1 = __builtin_amdgcn_mfma_f32_32x32x16_bf16(FB[i], qf, p1, 0, 0, 0); }
  QK_LD(fa, fb, qx, 0) SBAR();
  QK_LD(ga, gb, qy, 1) SBAR(); QK_MM(fa, fb, qx, 0) SBAR();
  QK_LD(fa, fb, qx, 2) SBAR(); QK_MM(ga, gb, qy, 1) SBAR();
  QK_LD(ga, gb, qy, 3) SBAR(); QK_MM(fa, fb, qx, 2) SBAR();
  QK_LD(fa, fb, qx, 4) SBAR(); QK_MM(ga, gb, qy, 3) SBAR();
  QK_LD(ga, gb, qy, 5) SBAR(); QK_MM(fa, fb, qx, 4) SBAR();
  QK_MM(ga, gb, qy, 5) SBAR();
#undef QK_LD
#undef QK_MM
}
__device__ __forceinline__ int v_st(int k, int c) { const int kk = (k & ~0xC) | ((k & 4) << 1) | ((k & 8) >> 1); return ((kk >> 3) * 4 + (c >> 5)) * 512 + ((kk & 7) * 32 + (c & 31)) * 2; }
__device__ __forceinline__ int v_rd_base(int lane) { return ((lane & 3) << 3) | (((lane >> 2) & 3) << 6) | (((lane >> 4) & 1) << 5) | (((lane >> 5) & 1) << 8); }
constexpr int v_rd_off(int d0, int ks, int half) { return d0 * 512 + ks * 4096 + half * 2048; }
template <int OFF> __device__ __forceinline__ s16x4 tr_read(int vb) {
  s16x4 r; asm volatile("ds_read_b64_tr_b16 %0, %1 offset:%2" : "=&v"(r) : "v"(vb), "i"(OFF) : "memory"); return r;
}
template <int D0> __device__ __forceinline__ void pv_one(f32x16& od, int vb, bf16x8 pa0, bf16x8 pa1, bf16x8 pa2, bf16x8 pa3) {
  const s16x4 l0 = tr_read<v_rd_off(D0, 0, 0)>(vb), h0 = tr_read<v_rd_off(D0, 0, 1)>(vb), l1 = tr_read<v_rd_off(D0, 1, 0)>(vb), h1 = tr_read<v_rd_off(D0, 1, 1)>(vb);
  const s16x4 l2 = tr_read<v_rd_off(D0, 2, 0)>(vb), h2 = tr_read<v_rd_off(D0, 2, 1)>(vb), l3 = tr_read<v_rd_off(D0, 3, 0)>(vb), h3 = tr_read<v_rd_off(D0, 3, 1)>(vb);
  asm volatile("s_waitcnt lgkmcnt(0)" ::: "memory"); SBAR();
#define PK(L, H) (bf16x8){L[0], L[1], L[2], L[3], H[0], H[1], H[2], H[3]}
  od = __builtin_amdgcn_mfma_f32_32x32x16_bf16(pa0, PK(l0, h0), od, 0, 0, 0);
  od = __builtin_amdgcn_mfma_f32_32x32x16_bf16(pa1, PK(l1, h1), od, 0, 0, 0);
  od = __builtin_amdgcn_mfma_f32_32x32x16_bf16(pa2, PK(l2, h2), od, 0, 0, 0);
  od = __builtin_amdgcn_mfma_f32_32x32x16_bf16(pa3, PK(l3, h3), od, 0, 0, 0);
#undef PK
}
__device__ __forceinline__ void pv_d0(f32x16* o, int vb, bf16x8 pa0, bf16x8 pa1, bf16x8 pa2, bf16x8 pa3) {
  pv_one<0>(o[0], vb, pa0, pa1, pa2, pa3); pv_one<1>(o[1], vb, pa0, pa1, pa2, pa3); pv_one<2>(o[2], vb, pa0, pa1, pa2, pa3); pv_one<3>(o[3], vb, pa0, pa1, pa2, pa3);
}

template <int VAR> __device__ __forceinline__ void attn_body(const bf16_t* __restrict__ Qb, const bf16_t* __restrict__ Kn, const bf16_t* __restrict__ Kr,
                                          bf16_t* __restrict__ Ob, int seq, char* lds, int tid, int pos0, const float* __restrict__ ropeT) {
  asm volatile("" : "+v"(tid));
  const int wid = tid >> 6, lane = tid & 63, r32 = lane & 31, hi = lane >> 5;
  char* V_lds = lds; char* K_lds = lds + 2 * SHM_V;
  float* ws = (float*)(lds + 2 * SHM_V + 2 * SHM_K) + wid * 64; float* li_l = ws; float* al_l = ws + 32;
  float m_reg = -1e30f, l_reg = 0; f32x16 o[4] = {}; bf16x8 qr[8];
  char* qrl = lds + 2 * SHM_V + 2 * SHM_K + NW * 64 * 4 + wid * 4096 + lane * 16;
  const bf16_t* Qw = Qb + (long)(wid * QBLK + r32) * LDQ + hi * 8;
#pragma unroll
  for (int d0 = 0; d0 < 8; ++d0) qr[d0] = *reinterpret_cast<const bf16x8*>(Qw + d0 * 16);
  { const float* cp = ropeT + (size_t)(pos0 + wid * QBLK + r32) * 32 + hi * 8; const float* sp = cp + 8192 * 32;
#pragma unroll
    for (int dd = 0; dd < 2; ++dd) { const f32x4 c0 = *(const f32x4*)(cp + 16 * dd), c1 = *(const f32x4*)(cp + 16 * dd + 4), s0 = *(const f32x4*)(sp + 16 * dd), s1 = *(const f32x4*)(sp + 16 * dd + 4);
      const u32x4 A = *reinterpret_cast<const u32x4*>(Qw + (8 + dd) * 16), B = *reinterpret_cast<const u32x4*>(Qw + (10 + dd) * 16); u32x4 An, Bn;
#pragma unroll
      for (int w2 = 0; w2 < 4; ++w2) { const float cs0 = w2 < 2 ? c0[2 * w2] : c1[2 * w2 - 4], cs1 = w2 < 2 ? c0[2 * w2 + 1] : c1[2 * w2 - 3], sn0 = w2 < 2 ? s0[2 * w2] : s1[2 * w2 - 4], sn1 = w2 < 2 ? s0[2 * w2 + 1] : s1[2 * w2 - 3];
        const float a0 = bflo(A[w2]), a1 = bfhi(A[w2]), b0 = bflo(B[w2]), b1 = bfhi(B[w2]);
        An[w2] = cvt_pk_bf16(a0 * cs0 - b0 * sn0, a1 * cs1 - b1 * sn1); Bn[w2] = cvt_pk_bf16(b0 * cs0 + a0 * sn0, b1 * cs1 + a1 * sn1); }
      *reinterpret_cast<u32x4*>(qrl + dd * 1024) = An; *reinterpret_cast<u32x4*>(qrl + (2 + dd) * 1024) = Bn; } }
  const bf16_t* Vh = Kn + 128;
  const int sr = tid >> 4, sc = (tid & 15) * 8, vst0 = v_st(sr, sc), vst1 = v_st(32 + sr, sc);
  int krow[3], kcc[3];
#pragma unroll
  for (int i = 0; i < 3; ++i) { const int id = tid + 512 * i; krow[i] = id / 24; kcc[i] = id % 24; }
  const int vb0 = (int)(uintptr_t)V_lds + v_rd_base(lane);
  bf16x8 vs0, vs1, ks0, ks1, ks2;
#define KSRC(i, k0) (kcc[i] < 16 ? (Kn + (long)((k0) + krow[i]) * LDKV + kcc[i] * 8) : (Kr + (long)((k0) + krow[i]) * LDKR + (kcc[i] - 16) * 8))
#define SLOAD(k0) do { vs0 = *reinterpret_cast<const bf16x8*>(&Vh[(long)((k0) + sr) * LDKV + sc]); vs1 = *reinterpret_cast<const bf16x8*>(&Vh[(long)((k0) + 32 + sr) * LDKV + sc]); \
    ks0 = *reinterpret_cast<const bf16x8*>(KSRC(0, k0)); ks1 = *reinterpret_cast<const bf16x8*>(KSRC(1, k0)); ks2 = *reinterpret_cast<const bf16x8*>(KSRC(2, k0)); } while (0)
#define SWRITE(b) do { *(bf16x8*)(V_lds + (b) * SHM_V + vst0) = vs0; *(bf16x8*)(V_lds + (b) * SHM_V + vst1) = vs1; \
    *(bf16x8*)(K_lds + (b) * SHM_K + krow[0] * KROWB + kcc[0] * 16) = ks0; *(bf16x8*)(K_lds + (b) * SHM_K + krow[1] * KROWB + kcc[1] * 16) = ks1; \
    *(bf16x8*)(K_lds + (b) * SHM_K + krow[2] * KROWB + kcc[2] * 16) = ks2; } while (0)
#define SWAIT() asm volatile("s_waitcnt vmcnt(0)" ::: "memory")
#define RESC(a) do { if (__any((a) < 1.f)) { if (hi == 0) al_l[r32] = (a); asm volatile("s_waitcnt lgkmcnt(0)" ::: "memory"); \
    _Pragma("unroll") for (int d = 0; d < 4; ++d) _Pragma("unroll") for (int r = 0; r < 16; ++r) o[d][r] *= al_l[crow(r, hi)]; } } while (0)
  f32x16 pA0, pA1; float mnA, alA; bf16x8 pa0, pa1, pa2, pa3; const int NT = seq / KVBLK;
  SLOAD(0); SWAIT(); SWRITE(0); __syncthreads();
  for (int j = 0; j < NT; ++j) {
    const int b = j & 1;
    if (VAR != 4) { if (j + 1 < NT) SLOAD((j + 1) * KVBLK); }
    if (VAR != 3) { SBAR(); qkt(pA0, pA1, K_lds + b * SHM_K, qr, qrl, r32, hi); } else { pA0 = f32x16{}; pA1 = f32x16{}; pA0[0] = (float)j; }
    if (VAR != 2) { partialSM(pA0, pA1, m_reg, mnA, alA);
      RESC(alA);
      finishSM(pA0, pA1, alA, l_reg, pa0, pa1, pa2, pa3); SBAR(); }
    else { u32x4 w0 = {__float_as_uint(pA0[0]), __float_as_uint(pA0[5]), __float_as_uint(pA1[3]), __float_as_uint(pA1[9])}; pa0 = *reinterpret_cast<bf16x8*>(&w0); pa1 = pa0; pa2 = pa0; pa3 = pa0; l_reg += pA0[1]; }
    if (VAR != 1) pv_d0(o, vb0 + b * (int)SHM_V, pa0, pa1, pa2, pa3); else o[0][0] += bf2f((bf16_t)pa0[0]) + bf2f((bf16_t)pa3[7]);
    if (VAR != 4) { if (j + 1 < NT) { SWAIT(); SWRITE(b ^ 1); } }
    __syncthreads();
  }
  if (hi == 0) li_l[r32] = l_reg; asm volatile("s_waitcnt lgkmcnt(0)" ::: "memory");
  float rli[16];
#pragma unroll
  for (int r = 0; r < 16; ++r) rli[r] = __builtin_amdgcn_rcpf(li_l[crow(r, hi)]);
  bf16_t* Ow = Ob + (long)(wid * QBLK) * LDO;
#pragma unroll
  for (int r = 0; r < 16; ++r) { const int orow = crow(r, hi);
#pragma unroll
    for (int d0 = 0; d0 < 4; ++d0) Ow[(long)orow * LDO + d0 * 32 + r32] = f2bf(o[d0][r] * rli[r]); }
#undef KSRC
#undef SLOAD
#undef SWRITE
#undef SWAIT
#undef RESC
}
#undef SBAR
}
typedef const __attribute__((address_space(4))) Args* KArgs;
struct Ctx {
    KArgs a; float* out; unsigned char* ws;
    LAS unsigned char* lds;
    int tid, lane, wave, vcu, G, gw, NGW, bid;
    __device__ __forceinline__ const float* in(int i) const { return a->in[i]; }
};
__device__ __forceinline__ Ctx mk_ctx(unsigned char* lds_raw, int wave_s) {
    Ctx c; KArgs a = (KArgs)__builtin_amdgcn_kernarg_segment_ptr(); asm volatile("" : "+s"(a));
    c.a = a; c.out = a->out; c.ws = a->ws; c.lds = (LAS unsigned char*)lds_raw;
    c.tid = opaque_tid(wave_s); c.lane = c.tid & 63; c.wave = __builtin_amdgcn_readfirstlane(c.tid >> 6);
    c.G = (int)gridDim.x; c.bid = opaque_bid(); c.vcu = (c.G % 8 == 0) ? (c.bid % 8) * (c.G / 8) + c.bid / 8 : c.bid;
    c.gw = c.vcu * NWAVES + c.wave; c.NGW = c.G * NWAVES;
    return c;
}
__device__ __forceinline__ int tok_pos(int t) { return t < TP ? (t & (SP - 1)) : ((t - TP) & (SS - 1)); }

__device__ __forceinline__ void transpose_item(const float* W, int K, int N, bf16_t* WT, LAS float* scr, int item, int lane) {
    const int nblk = N / 32, kb = item / nblk, nb = item % nblk, k0 = 64 * kb, n0 = 32 * nb;
#pragma unroll 8
    for (int i = 0; i < 32; ++i) { const int kk = 2 * i + (lane >> 5); scr[kk * 33 + (lane & 31)] = W[(size_t)(k0 + kk) * N + n0 + (lane & 31)]; }
    LDS_WAIT(); asm volatile("" ::: "memory");
    const int c = lane & 7;
#pragma unroll
    for (int j = 0; j < 4; ++j) { const int n = (lane >> 3) + 8 * j; const LAS float* s = scr + (8 * c) * 33 + n;
        u32x4 o; o.x = cvt_pk_bf16(s[0 * 33], s[1 * 33]); o.y = cvt_pk_bf16(s[2 * 33], s[3 * 33]); o.z = cvt_pk_bf16(s[4 * 33], s[5 * 33]); o.w = cvt_pk_bf16(s[6 * 33], s[7 * 33]);
        *(u32x4*)(WT + (size_t)(n0 + n) * K + k0 + 8 * c) = o; }
    LDS_WAIT(); asm volatile("" ::: "memory");
}
struct MatDesc { int in_idx, K, N, Npad, copies; size_t dst; };
__device__ __forceinline__ void p0_prologue(const Ctx& c) {
    LAS float* scr = (LAS float*)(c.lds + c.wave * 16384);
    const MatDesc MATS[9] = {
        {4, 1024, 704, 768, 2, W_WA}, {7, 384, 1536, 1536, 2, W_WUQ}, {8, 256, 2048, 2048, 2, W_WUKV}, {9, 1024, 1024, 1024, 2, W_WO},
        {10, 1024, 5120, 5120, 2, W_HIN}, {13, 1024, 1024, 1024, 2, W_HO}, {14, 1024, 2048, 2048, 4, W_PQ}, {22, 1024, 1024, 1024, 4, W_GW}, {24, 256, 1024, 1024, 4, W_PP}};
    int total = 0;
#pragma unroll
    for (int m = 0; m < 9; ++m) total += MATS[m].copies * (MATS[m].K / 64) * (MATS[m].N / 32);
    for (int it = c.gw; it < total; it += c.NGW) {
        int r = it;
#pragma unroll
        for (int m = 0; m < 9; ++m) {
            const int per = (MATS[m].K / 64) * (MATS[m].N / 32), cnt = MATS[m].copies * per;
            if (r >= 0 && r < cnt) { const int cp = r / per, item = r % per;
                transpose_item(c.in(MATS[m].in_idx) + (size_t)cp * MATS[m].K * MATS[m].N, MATS[m].K, MATS[m].N,
                               (bf16_t*)(c.ws + MATS[m].dst) + (size_t)cp * MATS[m].Npad * MATS[m].K, scr, item, c.lane);
                r = -1; }
            else if (r >= 0) r -= cnt;
        }
    }
    const int gt = c.gw * 64 + c.lane, NGT = c.NGW * 64;
    for (int i = gt; i < 2 * 64 * 1024 / 8; i += NGT) { const int cp = i / (64 * 1024 / 8), o = i % (64 * 1024 / 8);
        *(u32x4*)((bf16_t*)(c.ws + W_WA) + (size_t)cp * 768 * 1024 + (size_t)704 * 1024 + o * 8) = (u32x4){0u, 0u, 0u, 0u}; }
    for (int i = gt; i < 4 * 2 * 128 * 128 / 4; i += NGT) { const f32x4 v = *(const f32x4*)(c.in(15) + (size_t)i * 4);
        u32x2 w; w.x = cvt_pk_bf16(v[0], v[1]); w.y = cvt_pk_bf16(v[2], v[3]); *(u32x2*)((bf16_t*)(c.ws + W_KEYS) + (size_t)i * 4) = w; }
    for (int i = gt; i < 8192 * 32; i += NGT) { const int pos = i >> 5, f = i & 31;
        const float inv = 1.0f / powf(10000.0f, (float)(2 * f) / 64.0f); const float ang = (float)pos * inv;
        ((float*)(c.ws + WS_ROPE))[i] = cosf(ang); ((float*)(c.ws + WS_ROPE))[8192 * 32 + i] = sinf(ang); }
    for (int i = gt; i < 2 * 1024; i += NGT) { const int dir = i >> 10, k = i & 1023;
        const float l0 = c.in(11)[(dir * 2 + 0) * 1024 + k], l1 = c.in(11)[(dir * 2 + 1) * 1024 + k];
        float* lb = (float*)(c.ws + WS_MISC);
        lb[(0 * 2 + dir) * 1024 + k] = 0.f; lb[(1 * 2 + dir) * 1024 + k] = 1.0f / (1.0f + expf(l0 - l1)); }
    for (int t = c.gw; t < T; t += c.NGW) {
        const float* xr = t < TP ? c.in(0) + (size_t)t * D : c.in(1) + (size_t)(t - TP) * D;
        bf16_t* brow = (bf16_t*)c.out + (size_t)t * D;
#pragma unroll
        for (int j = 0; j < 4; ++j) { const f32x4 v = *(const f32x4*)(xr + 256 * j + 4 * c.lane);
            u32x2 w; w.x = cvt_pk_bf16(v[0], v[1]); w.y = cvt_pk_bf16(v[2], v[3]); *(u32x2*)(brow + 256 * j + 4 * c.lane) = w; }
    }
}

__device__ __forceinline__ void cvt_range(const float* src, bf16_t* dst, size_t n8, int gt, int NGT) {
    for (size_t i = gt; i < n8; i += NGT) { const f32x4 a = *(const f32x4*)(src + i * 8), b = *(const f32x4*)(src + i * 8 + 4);
        u32x4 w; w.x = cvt_pk_bf16(a[0], a[1]); w.y = cvt_pk_bf16(a[2], a[3]); w.z = cvt_pk_bf16(b[0], b[1]); w.w = cvt_pk_bf16(b[2], b[3]); *(u32x4*)(dst + i * 8) = w; }
}
__device__ __forceinline__ void l0_convert(const Ctx& c, int layer) {
    const int gt = c.gw * 64 + c.lane, NGT = c.NGW * 64;
    for (int r = c.gw; r < 2 * NEXP; r += c.NGW) {
        const int m = r >= NEXP, e = r - m * NEXP;
        const float* src = c.in(16 + m) + ((size_t)layer * NEXP + e) * D + 16 * c.lane;
        f32x4 v[4]; float am = 0.f;
#pragma unroll
        for (int j = 0; j < 4; ++j) { v[j] = *(const f32x4*)(src + 4 * j); am = fmaxf(am, fmaxf(fmaxf(fabsf(v[j][0]), fabsf(v[j][1])), fmaxf(fabsf(v[j][2]), fabsf(v[j][3])))); }
        am = wave_max(am);
        const float sc = fmaxf(am, 1e-30f) * (1.0f / 440.0f), inv = 1.0f / sc;
        u32x4 w;
#pragma unroll
        for (int j = 0; j < 4; ++j) { int p = 0; p = __builtin_amdgcn_cvt_pk_fp8_f32(v[j][0] * inv, v[j][1] * inv, p, false); p = __builtin_amdgcn_cvt_pk_fp8_f32(v[j][2] * inv, v[j][3] * inv, p, true); w[j] = (unsigned)p; }
        *(u32x4*)(c.ws + (m ? R2_VB : R2_UB) + (size_t)e * D + 16 * c.lane) = w;
        if (c.lane == 0) ((float*)(c.ws + (m ? R2_SV : R2_SU)))[e] = sc;
    }
    cvt_range(c.in(2) + (size_t)layer * TP * 256, (bf16_t*)(c.ws + R2_PB), (size_t)TP * 256 / 8, gt, NGT);
    cvt_range(c.in(3) + (size_t)layer * TS * 256, (bf16_t*)(c.ws + R2_PB) + (size_t)TP * 256, (size_t)TS * 256 / 8, gt, NGT);
}

__device__ __forceinline__ void mla_e1(const Ctx& c, int j) {
    const bf16_t* a16 = (const bf16_t*)(c.ws + B_A32); bf16_t* cqn = (bf16_t*)(c.ws + B_CQN); bf16_t* ckvn = (bf16_t*)(c.ws + B_CKVN); bf16_t* krope = (bf16_t*)(c.ws + B_KROPE);
    const float* qnw = c.in(5) + j * 384; const float* kvnw = c.in(6) + j * 256;
    const float* cosT = (const float*)(c.ws + WS_ROPE); const float* sinT = cosT + 8192 * 32;
    const int lane = c.lane;
    constexpr int NU = 4;
    LAS float* scr = (LAS float*)(c.lds + c.wave * 1024);
    const f32x4 wA = *(const f32x4*)(qnw + 4 * lane), wB = *(const f32x4*)(lane < 32 ? qnw + 256 + 4 * lane : kvnw + 4 * (lane - 32)), wC = *(const f32x4*)(kvnw + 128 + 4 * (lane & 31));
    for (int t0 = c.gw * NU; t0 < T; t0 += c.NGW * NU) {
        f32x4 v0[NU], v1[NU], v2[NU]; float csv[NU], snv[NU];
#pragma unroll
        for (int u = 0; u < NU; ++u) { const bf16_t* ar = a16 + (size_t)(t0 + u) * 768;
            const u32x2 w0 = *(const u32x2*)(ar + 4 * lane), w1 = *(const u32x2*)(ar + 256 + 4 * lane), w2 = *(const u32x2*)(ar + 512 + 4 * lane);
            { const int pos = tok_pos(t0 + u); csv[u] = cosT[pos * 32 + (lane & 31)]; snv[u] = sinT[pos * 32 + (lane & 31)]; }
            v0[u] = (f32x4){bflo(w0.x), bfhi(w0.x), bflo(w0.y), bfhi(w0.y)}; v1[u] = (f32x4){bflo(w1.x), bfhi(w1.x), bflo(w1.y), bfhi(w1.y)}; v2[u] = (f32x4){bflo(w2.x), bfhi(w2.x), bflo(w2.y), bfhi(w2.y)}; }
#pragma unroll
        for (int u = 0; u < NU; ++u) { const int t = t0 + u;
            const float s0 = v0[u][0] * v0[u][0] + v0[u][1] * v0[u][1] + v0[u][2] * v0[u][2] + v0[u][3] * v0[u][3];
            const float s1 = v1[u][0] * v1[u][0] + v1[u][1] * v1[u][1] + v1[u][2] * v1[u][2] + v1[u][3] * v1[u][3];
            const float s2 = v2[u][0] * v2[u][0] + v2[u][1] * v2[u][1] + v2[u][2] * v2[u][2] + v2[u][3] * v2[u][3];
            const float ssq = wave_sum(s0 + (lane < 32 ? s1 : 0.f));
            const float sskv = wave_sum((lane >= 32 ? s1 : 0.f) + (lane < 32 ? s2 : 0.f));
            const float rq = 1.0f / sqrtf(ssq * (1.0f / 384.0f) + RMS_EPS), rkv = 1.0f / sqrtf(sskv * (1.0f / 256.0f) + RMS_EPS);
            { const f32x4 w = wA; u32x2 o; o.x = cvt_pk_bf16(v0[u][0] * rq * w[0], v0[u][1] * rq * w[1]); o.y = cvt_pk_bf16(v0[u][2] * rq * w[2], v0[u][3] * rq * w[3]);
              *(u32x2*)(cqn + (size_t)t * 384 + 4 * lane) = o; }
            if (lane < 32) { const f32x4 w = wB; u32x2 o; o.x = cvt_pk_bf16(v1[u][0] * rq * w[0], v1[u][1] * rq * w[1]); o.y = cvt_pk_bf16(v1[u][2] * rq * w[2], v1[u][3] * rq * w[3]);
              *(u32x2*)(cqn + (size_t)t * 384 + 256 + 4 * lane) = o; }
            else { const int ix = 4 * (lane - 32); const f32x4 w = wB; u32x2 o; o.x = cvt_pk_bf16(v1[u][0] * rkv * w[0], v1[u][1] * rkv * w[1]); o.y = cvt_pk_bf16(v1[u][2] * rkv * w[2], v1[u][3] * rkv * w[3]);
              *(u32x2*)(ckvn + (size_t)t * 256 + ix) = o; }
            if (lane < 32) { const int ix = 128 + 4 * lane; const f32x4 w = wC; u32x2 o; o.x = cvt_pk_bf16(v2[u][0] * rkv * w[0], v2[u][1] * rkv * w[1]); o.y = cvt_pk_bf16(v2[u][2] * rkv * w[2], v2[u][3] * rkv * w[3]);
              *(u32x2*)(ckvn + (size_t)t * 256 + ix) = o; }
            else if (lane < 48) { *(LAS f32x4*)(scr + 4 * (lane - 32)) = v2[u]; }
            LDS_WAIT(); asm volatile("" ::: "memory");
            if (lane < 32) { const float a = scr[lane], b = scr[lane + 32], cs = csv[u], sn = snv[u];
                krope[(size_t)t * 64 + lane] = f2bf(a * cs - b * sn); krope[(size_t)t * 64 + 32 + lane] = f2bf(b * cs + a * sn); }
            LDS_WAIT(); asm volatile("" ::: "memory"); }
    }
}
__device__ __forceinline__ void mla_qrope(const Ctx& c) {
    bf16_t* q = (bf16_t*)(c.ws + B_Q);
    const float* cosT = (const float*)(c.ws + WS_ROPE); const float* sinT = cosT + 8192 * 32;
    const int lane = c.lane, i = lane & 31;
    for (int t = c.gw; t < T; t += c.NGW) {
        const int pos = tok_pos(t); const float cs = cosT[pos * 32 + i], sn = sinT[pos * 32 + i];
#pragma unroll
        for (int k = 0; k < 4; ++k) { const int h = (lane >> 5) + 2 * k; bf16_t* p = q + (size_t)t * 1536 + h * 192 + 128 + i;
            const float a = bf2f(p[0]), b = bf2f(p[32]); p[0] = f2bf(a * cs - b * sn); p[32] = f2bf(b * cs + a * sn); }
    }
}
template <int VAR> __device__ __forceinline__ void mla_attention(const Ctx& c) {
    const bf16_t* Q = (const bf16_t*)(c.ws + B_Q); const bf16_t* KV = (const bf16_t*)(c.ws + B_KV); const bf16_t* KR = (const bf16_t*)(c.ws + B_KROPE); bf16_t* O = VAR ? (bf16_t*)c.out + (size_t)T * 1024 : (bf16_t*)(c.ws + B_O);
    const int NU = 512 + 2048;
    for (int u = c.bid; u < NU; u += c.G) {
        int tok0, qb, h, seq;
        if (u < 512) { const int round = u >> 8, cc = u & 255, bh = round * 8 + (cc & 7); tok0 = (bh >> 3) * SP; h = bh & 7; qb = cc >> 3; seq = SP; }
        else { const int us = u - 512, round = us >> 8, cc = us & 255, r = cc >> 3, bh = round * 32 + (cc & 7) * 4 + (r >> 3); tok0 = TP + (bh >> 3) * SS; h = bh & 7; qb = r & 7; seq = SS; }
        attn::attn_body<VAR>(Q + (size_t)(tok0 + qb * 256) * 1536 + h * 192, KV + (size_t)tok0 * 2048 + h * 256, KR + (size_t)tok0 * 64,
                        O + (size_t)(tok0 + qb * 256) * 1024 + h * 128, seq, (char*)c.lds, c.tid, qb * 256, (const float*)(c.ws + WS_ROPE));
        __syncthreads();
    }
}
template <int NU, bool W8> __device__ __forceinline__ void ln_rows(f32x4 (&v)[NU][4], const f32x4 (&ggv)[4], const f32x4 (&bbv)[4], int lane, bf16_t* const (&dst)[NU], unsigned char* const (&dst8)[NU], float* const (&dsc)[NU]) {
    float s[NU], s2[NU];
#pragma unroll
    for (int u = 0; u < NU; ++u) { s[u] = 0.f;
#pragma unroll
        for (int j = 0; j < 4; ++j) s[u] += (v[u][j][0] + v[u][j][1]) + (v[u][j][2] + v[u][j][3]); }
#pragma unroll
    for (int u = 0; u < NU; ++u) s[u] = wave_sum(s[u]) * (1.0f / D);
#pragma unroll
    for (int u = 0; u < NU; ++u) { s2[u] = 0.f;
#pragma unroll
        for (int j = 0; j < 4; ++j) { v[u][j] = v[u][j] - s[u]; s2[u] += (v[u][j][0] * v[u][j][0] + v[u][j][1] * v[u][j][1]) + (v[u][j][2] * v[u][j][2] + v[u][j][3] * v[u][j][3]); } }
#pragma unroll
    for (int u = 0; u < NU; ++u) s2[u] = 1.0f / sqrtf(wave_sum(s2[u]) * (1.0f / D) + LN_EPS);
    float am[NU];
#pragma unroll
    for (int u = 0; u < NU; ++u) am[u] = 0.f;
#pragma unroll
    for (int j = 0; j < 4; ++j) { const f32x4 gg = ggv[j], bb = bbv[j];
#pragma unroll
        for (int u = 0; u < NU; ++u) { const f32x4 o = v[u][j] * s2[u] * gg + bb; u32x2 w; w.x = cvt_pk_bf16(o[0], o[1]); w.y = cvt_pk_bf16(o[2], o[3]); *(u32x2*)(dst[u] + 256 * j + 4 * lane) = w;
            if (W8) { v[u][j] = o; am[u] = fmaxf(am[u], fmaxf(fmaxf(fabsf(o[0]), fabsf(o[1])), fmaxf(fabsf(o[2]), fabsf(o[3])))); } } }
    if (W8) {
#pragma unroll
        for (int u = 0; u < NU; ++u) { const float mx = fmaxf(wave_max(am[u]), 1e-20f), inv = 240.0f / mx;
#pragma unroll
            for (int j = 0; j < 4; ++j) { int q = 0; q = __builtin_amdgcn_cvt_pk_fp8_f32(v[u][j][0] * inv, v[u][j][1] * inv, q, false); q = __builtin_amdgcn_cvt_pk_fp8_f32(v[u][j][2] * inv, v[u][j][3] * inv, q, true);
                *(unsigned*)(dst8[u] + 256 * j + 4 * lane) = (unsigned)q; }
            if (lane == 0) *dsc[u] = mx * (1.0f / 240.0f); }
    }
}
__device__ __forceinline__ void ln_residual(const Ctx& c, const bf16_t* hb, const float* g, const float* b) {
    const bf16_t* xm = (const bf16_t*)c.out; bf16_t* xa = (bf16_t*)(c.ws + WS_XB); const int lane = c.lane;
    constexpr int NU = 4;
    f32x4 ggv[4], bbv[4];
#pragma unroll
    for (int j = 0; j < 4; ++j) { ggv[j] = *(const f32x4*)(g + 256 * j + 4 * lane); bbv[j] = *(const f32x4*)(b + 256 * j + 4 * lane); }
    auto ld = [&](int t0, u32x2 (&xw)[NU][4], u32x2 (&hw)[NU][4]) {
#pragma unroll
        for (int u = 0; u < NU; ++u) { const bf16_t* xr = xm + (size_t)(t0 + u) * D; const bf16_t* hr = hb + (size_t)(t0 + u) * D;
#pragma unroll
            for (int j = 0; j < 4; ++j) { xw[u][j] = *(const u32x2*)(xr + 256 * j + 4 * lane); hw[u][j] = *(const u32x2*)(hr + 256 * j + 4 * lane); } } };
    auto fin = [&](int t0, const u32x2 (&xw)[NU][4], const u32x2 (&hw)[NU][4]) {
        f32x4 v[NU][4]; bf16_t* dst[NU]; unsigned char* dst8[NU]; float* dsc[NU];
#pragma unroll
        for (int u = 0; u < NU; ++u) { dst[u] = xa + (size_t)(t0 + u) * D; dst8[u] = c.ws + B_X8 + (size_t)(t0 + u) * D; dsc[u] = (float*)(c.ws + B_XS) + (t0 + u);
#pragma unroll
            for (int j = 0; j < 4; ++j) v[u][j] = (f32x4){bflo(xw[u][j].x), bfhi(xw[u][j].x), bflo(xw[u][j].y), bfhi(xw[u][j].y)} * DN_ALPHA + (f32x4){bflo(hw[u][j].x), bfhi(hw[u][j].x), bflo(hw[u][j].y), bfhi(hw[u][j].y)}; }
        ln_rows<NU, false>(v, ggv, bbv, lane, dst, dst8, dsc); };
    const int stride = c.NGW * NU; int t0 = c.gw * NU;
    if (t0 >= T) return;
    u32x2 xA[NU][4], hA[NU][4], xB[NU][4], hB[NU][4];
    ld(t0, xA, hA);
    for (;;) {
        const int t1 = t0 + stride; ld(min(t1, T - NU), xB, hB);
        fin(t0, xA, hA);
        if (t1 >= T) break;
        const int t2 = t1 + stride; ld(min(t2, T - NU), xA, hA);
        fin(t1, xB, hB);
        if (t2 >= T) break;
        t0 = t2;
    }
}
__device__ __forceinline__ void hgrn_post(const Ctx& c, int j) {
    bf16_t* pl = (bf16_t*)(c.ws + B_PLANE); const size_t PE = (size_t)T * 1024;
    const bf16_t* of = pl + 1 * PE; const bf16_t* ob = pl + 2 * PE; const bf16_t* sg = pl + 4 * PE; bf16_t* on = pl;
    const float* nw = c.in(12) + j * 128; const int lane = c.lane;
    const int cw = (8 * lane) & 127; const f32x4 w0 = *(const f32x4*)(nw + cw), w1 = *(const f32x4*)(nw + cw + 4);
    constexpr int NU = 4;
    auto ld = [&](int t0, u32x4 (&a)[NU][2], u32x4 (&b)[NU][2], u32x4 (&g)[NU][2]) {
#pragma unroll
        for (int u = 0; u < NU; ++u)
#pragma unroll
            for (int k = 0; k < 2; ++k) { const size_t off = (size_t)(t0 + u) * 1024 + 512 * k + 8 * lane;
                a[u][k] = *(const u32x4*)(of + off); b[u][k] = *(const u32x4*)(ob + off); g[u][k] = *(const u32x4*)(sg + off); } };
    auto fin = [&](int t0, const u32x4 (&a)[NU][2], const u32x4 (&b)[NU][2], const u32x4 (&g)[NU][2]) {
#pragma unroll
        for (int u = 0; u < NU; ++u)
#pragma unroll
            for (int k = 0; k < 2; ++k) { const size_t off = (size_t)(t0 + u) * 1024 + 512 * k + 8 * lane;
                float o[8], gg[8]; float ss = 0.f;
#pragma unroll
                for (int q = 0; q < 4; ++q) { o[2 * q] = bflo(a[u][k][q]) + bflo(b[u][k][q]); o[2 * q + 1] = bfhi(a[u][k][q]) + bfhi(b[u][k][q]); gg[2 * q] = bflo(g[u][k][q]); gg[2 * q + 1] = bfhi(g[u][k][q]); }
#pragma unroll
                for (int e = 0; e < 8; ++e) ss += o[e] * o[e];
                ss = row16_sum(ss);
                const float r = 1.0f / sqrtf(ss * (1.0f / 128.0f) + RMS_EPS);
                u32x4 w; w.x = cvt_pk_bf16(o[0] * r * w0[0] * gg[0], o[1] * r * w0[1] * gg[1]); w.y = cvt_pk_bf16(o[2] * r * w0[2] * gg[2], o[3] * r * w0[3] * gg[3]);
                w.z = cvt_pk_bf16(o[4] * r * w1[0] * gg[4], o[5] * r * w1[1] * gg[5]); w.w = cvt_pk_bf16(o[6] * r * w1[2] * gg[6], o[7] * r * w1[3] * gg[7]);
                *(u32x4*)(on + off) = w; } };
    const int stride = c.NGW * NU; int t0 = c.gw * NU;
    if (t0 >= T) return;
    u32x4 aA[NU][2], bA[NU][2], gA[NU][2], aB[NU][2], bB[NU][2], gB[NU][2];
    ld(t0, aA, bA, gA);
    for (;;) {
        const int t1 = t0 + stride; ld(min(t1, T - NU), aB, bB, gB);
        fin(t0, aA, bA, gA);
        if (t1 >= T) break;
        const int t2 = t1 + stride; ld(min(t2, T - NU), aA, bA, gA);
        fin(t1, aB, bB, gB);
        if (t2 >= T) break;
        t0 = t2;
    }
}
namespace scan {
#ifndef PROBE_ROLE
#define PROBE_ROLE 0
#endif
constexpr size_t D_F = R2_IDX, D_B = R2_IDX + 12 * MiB;
constexpr int NCH = T / 32;
__device__ __forceinline__ void hgrn_prep(const Ctx& c, int dup) {
    bf16_t* pl = (bf16_t*)(c.ws + B_PLANE); const size_t PE = (size_t)T * 1024;
    bf16_t* qs = pl; bf16_t* lff = pl + PE; bf16_t* lfb = pl + 2 * PE; bf16_t* qtb = (bf16_t*)(c.ws + WS_XB);
    float* dF = (float*)(c.ws + D_F); float* dB = (float*)(c.ws + D_B);
    const int lane = c.lane;
#define PREP_STEP(LW, QW, QDST, KDST, R0, R1) { const unsigned lw = (LW), qw = (QW); const float l0 = bflo(lw), l1 = bfhi(lw); R0 += l0; R1 += l1; \
        const float k0 = 1.0f - fast_exp(l0), k1 = 1.0f - fast_exp(l1); \
        *(unsigned*)(QDST) = cvt_pk_bf16(bflo(qw) * fast_exp(R0), bfhi(qw) * fast_exp(R1)); \
        *(unsigned*)(KDST) = cvt_pk_bf16(k0 * fast_exp(fminf(-R0, 80.f)), k1 * fast_exp(fminf(-R1, 80.f))); }
    const char* qsB = (const char*)qs; const char* lffB = (const char*)lff; const char* lfbB = (const char*)lfb; const char* qtbB = (const char*)qtb;
    char* dmy = (char*)((bf16_t*)c.out + (size_t)T * 1024);
    char* qsW = dup ? dmy : (char*)qs; char* lffW = dup ? dmy : (char*)lff; char* lfbW = dup ? dmy : (char*)lfb; char* qtbW = dup ? dmy : (char*)qtb;
    if (dup) { dF = (float*)dmy; dB = (float*)dmy; }
    for (int it = c.gw; it < NCH * 8; it += c.NGW) {
        const int chunk = it >> 3, h = it & 7; const unsigned base = ((unsigned)chunk * 32u * 1024u + (unsigned)h * 128u + 2u * (unsigned)lane) * 2u;
        float b0 = 0.f, b1 = 0.f, f0 = 0.f, f1 = 0.f;
#define LDW(P, O) (*(const unsigned*)((P) + (O)))
#define STP(P, O) ((unsigned*)((char*)(P) + (O)))
        { unsigned wb[16], wq[16];
#pragma unroll
          for (int i = 0; i < 16; ++i) { const unsigned o = base + (unsigned)(16 + i) * 2048u; wb[i] = LDW(lfbB, o); wq[i] = LDW(qsB, o); }
#pragma unroll
          for (int i = 15; i >= 0; --i) { const unsigned o = base + (unsigned)(16 + i) * 2048u; PREP_STEP(wb[i], wq[i], STP(qtbW, o), STP(lfbW, o), b0, b1) } }
        { unsigned wb[16], wq[16], wf[16];
#pragma unroll
          for (int i = 0; i < 16; ++i) { const unsigned o = base + (unsigned)i * 2048u; wb[i] = LDW(lfbB, o); wq[i] = LDW(qsB, o); wf[i] = LDW(lffB, o); }
#pragma unroll
          for (int i = 15; i >= 0; --i) { const unsigned o = base + (unsigned)i * 2048u; PREP_STEP(wb[i], wq[i], STP(qtbW, o), STP(lfbW, o), b0, b1) }
          *(f32x2*)(dB + (size_t)chunk * 1024 + h * 128 + 2 * lane) = (f32x2){fast_exp(b0), fast_exp(b1)};
#pragma unroll
          for (int i = 0; i < 16; ++i) { const unsigned o = base + (unsigned)i * 2048u; PREP_STEP(wf[i], wq[i], STP(qsW, o), STP(lffW, o), f0, f1) } }
        { unsigned wf[16], wq[16];
#pragma unroll
          for (int i = 0; i < 16; ++i) { const unsigned o = base + (unsigned)(16 + i) * 2048u; wf[i] = LDW(lffB, o); wq[i] = LDW(qsB, o); }
#pragma unroll
          for (int i = 0; i < 16; ++i) { const unsigned o = base + (unsigned)(16 + i) * 2048u; PREP_STEP(wf[i], wq[i], STP(qsW, o), STP(lffW, o), f0, f1) }
          *(f32x2*)(dF + (size_t)chunk * 1024 + h * 128 + 2 * lane) = (f32x2){fast_exp(f0), fast_exp(f1)}; }
    }
#undef LDW
#undef STP
#undef PREP_STEP
}

constexpr int QT_OFF = 0, KT_OFF = 8192, V_OFF = 16384, DV_OFF = 24576, TILE_SET = 25088, ST_OFF = 2 * TILE_SET, ST_BYTES = 34816, OB_OFF = ST_OFF + 2 * ST_BYTES, ORS = 272, OB_BYTES = 32 * ORS, SCAN_LDS_END = OB_OFF + 2 * OB_BYTES;
static_assert(SCAN_LDS_END <= LDS_MISC_OFF, "scan LDS layout");
constexpr int RS = 272, RS2 = 80;
__device__ __forceinline__ int crow(int r, int hi) { return (r & 3) + 8 * (r >> 2) + 4 * hi; }
__device__ __forceinline__ unsigned off_b(unsigned row, unsigned ch) { return 256u * row + 16u * (ch ^ (((row & 3) << 2) | ((row >> 2) & 3))); }
__device__ __forceinline__ unsigned row_read_addr(unsigned lane, unsigned s) { return off_b(lane & 31, 2 * s + (lane >> 5)); }
__device__ __forceinline__ unsigned tr_read_addr(unsigned lane, unsigned cc, unsigned ks, unsigned t) {
    const unsigned h = lane >> 5, blk = (lane >> 4) & 1, q = (lane & 15) >> 2, p = lane & 3;
    return off_b(16 * ks + 8 * h + 4 * t + q, 4 * cc + 2 * blk + (p >> 1)) + 8 * (p & 1);
}
template <int OFF> __device__ __forceinline__ s16x4 tr_rd(unsigned addr) { s16x4 r; asm volatile("ds_read_b64_tr_b16 %0, %1 offset:%2" : "=&v"(r) : "v"(addr), "n"(OFF) : "memory"); return r; }
template <int N> struct IC { static constexpr int value = N; };
#define TRPK(L, H) (bf16x8){L[0], L[1], L[2], L[3], H[0], H[1], H[2], H[3]}

__device__ __forceinline__ void run_chain(const Ctx& c, int tok0, int L, int h, int ch, bool dummy) {
    bf16_t* pl = (bf16_t*)(c.ws + B_PLANE); const size_t PE = (size_t)T * 1024;
    const int tid = c.tid, lane = c.lane, wave = c.wave, w = wave & 3, r32 = lane & 31, hi = lane >> 5;
    const bf16_t* qt = ch ? (const bf16_t*)(c.ws + WS_XB) : pl; bf16_t* kt = pl + (size_t)(1 + ch) * PE; const bf16_t* vv = pl + 3 * PE;
    const float* dd = (const float*)(c.ws + (ch ? D_B : D_F));
    bf16_t* odst = dummy ? (bf16_t*)c.out + (size_t)T * 1024 : kt;
    LAS unsigned char* base = c.lds;
    const unsigned lbase = (unsigned)(uintptr_t)base;
    const int NC = L / 32;
    const int sgn = 1 - 2 * ch, mlane = sgn * (r32 - 4 * hi);
    const int vcol = 32 * w + r32;
    unsigned trv[2], trk[4][2], trp[2];
#pragma unroll
    for (int t = 0; t < 2; ++t) { trv[t] = lbase + tr_read_addr(lane, w, 0, t);
        { const unsigned blk = (lane >> 4) & 1, q = (lane & 15) >> 2, p = lane & 3; trp[t] = lbase + off_b(4 * hi + 8 * t + q, 4 * w + 2 * blk + (p >> 1)) + 8 * (p & 1); }
#pragma unroll
        for (int cc = 0; cc < 4; ++cc) trk[cc][t] = lbase + tr_read_addr(lane, cc, 0, t); }
    const int s_r0 = tid >> 4, s_chn = tid & 15;
    u32x4 sreg[2][3]; f32x4 dreg[2] = {(f32x4){0.f, 0.f, 0.f, 0.f}, (f32x4){0.f, 0.f, 0.f, 0.f}};
#define SCAN_LOAD(cidx, R) do { const size_t rowb = (size_t)(tok0 + 32 * (cidx) + s_r0) * 1024 + h * 128 + s_chn * 8; \
        sreg[R][0] = *(const u32x4*)(qt + rowb); sreg[R][1] = *(const u32x4*)((const bf16_t*)kt + rowb); sreg[R][2] = *(const u32x4*)(vv + rowb); \
        dreg[R] = *(const f32x4*)(dd + (size_t)((tok0 >> 5) + (cidx)) * 1024 + h * 128 + 4 * (tid & 31)); } while (0)
#define SCAN_WRITE(set) do { LAS unsigned char* tb_ = base + (set) * TILE_SET; _Pragma("unroll") for (int i = 0; i < 3; ++i) *(LAS u32x4*)(tb_ + i * 8192 + off_b(s_r0, s_chn)) = sreg[set][i]; \
        if (tid < 32) *(LAS f32x4*)(tb_ + DV_OFF + 16 * tid) = dreg[set]; } while (0)
#define O_STORE(cidx, buf) do { const u32x4 ov_ = *(const LAS u32x4*)(base + OB_OFF + (buf) * OB_BYTES + s_r0 * ORS + s_chn * 16); \
        *(u32x4*)(odst + (size_t)(dummy ? c.bid * 32 + s_r0 : tok0 + 32 * (cidx) + s_r0) * 1024 + h * 128 + s_chn * 8) = ov_; } while (0)
    { LAS u32x4* st = (LAS u32x4*)(base + ST_OFF + ST_BYTES); for (int i = tid; i < ST_BYTES / 16; i += NTHR) st[i] = (u32x4){0u, 0u, 0u, 0u}; }
    f32x16 S[4];
#pragma unroll
    for (int kt2 = 0; kt2 < 4; ++kt2) S[kt2] = f32x16{};
    SCAN_LOAD(ch ? NC - 1 : 0, 0); SCAN_LOAD(ch ? NC - 2 : 1, 1); SCAN_WRITE(0);
    __syncthreads();
    auto chunk_body = [&](auto subc, auto rolec, const int ci) {
        constexpr int sub = decltype(subc)::value; constexpr bool og = decltype(rolec)::value == 0;
        const int cidx = ch ? NC - 1 - ci : ci;
        SCAN_LOAD(ci + 2 < NC ? (ch ? cidx - 2 : cidx + 2) : cidx, sub);
        O_STORE(ci > 0 ? (ch ? cidx + 1 : cidx - 1) : cidx, 1 - sub);
        LAS unsigned char* tb = base + sub * TILE_SET;
        if (dummy && (PROBE_ROLE == 3 || PROBE_ROLE == (og ? 1 : 2))) {   } else
        if constexpr (og) {
            const LAS unsigned char* strd = base + ST_OFF + (sub ? 0 : ST_BYTES);
            bf16x8 sb[8], qa[8];
#pragma unroll
            for (int ks = 0; ks < 8; ++ks) sb[ks] = *(const LAS bf16x8*)(strd + vcol * RS + (16 * ks + 8 * hi) * 2);
#pragma unroll
            for (int ks = 0; ks < 8; ++ks) qa[ks] = *(const LAS bf16x8*)(tb + QT_OFF + row_read_addr(lane, ks));
            __builtin_amdgcn_sched_barrier(0);
            f32x16 X = f32x16{};
#pragma unroll
            for (int ks = 0; ks < 8; ++ks) { const bf16x8 kb = *(const LAS bf16x8*)(tb + KT_OFF + row_read_addr(lane, ks));
                X = __builtin_amdgcn_mfma_f32_32x32x16_bf16(kb, qa[ks], X, 0, 0, 0); }
            s16x4 vl[2], vh[2];
            vl[0] = tr_rd<sub * TILE_SET + V_OFF>(trp[0]); vh[0] = tr_rd<sub * TILE_SET + V_OFF>(trp[1]); vl[1] = tr_rd<sub * TILE_SET + V_OFF + 4096>(trp[0]); vh[1] = tr_rd<sub * TILE_SET + V_OFF + 4096>(trp[1]);
            bf16x8 pa[2];
#pragma unroll
            for (int ks = 0; ks < 2; ++ks) { u32x4 pw;
#pragma unroll
                for (int e = 0; e < 4; ++e) { const int r = 8 * ks + 2 * e;
                    const float x0 = (mlane >= sgn * crow(r, 0)) ? X[r] : 0.f, x1 = (mlane >= sgn * crow(r + 1, 0)) ? X[r + 1] : 0.f; pw[e] = cvt_pk_bf16(x0, x1); }
                pa[ks] = __builtin_bit_cast(bf16x8, pw); }
            asm volatile("s_waitcnt lgkmcnt(0)" ::: "memory"); __builtin_amdgcn_sched_barrier(0);
            f32x16 O = f32x16{};
#pragma unroll
            for (int ks = 0; ks < 2; ++ks) O = __builtin_amdgcn_mfma_f32_32x32x16_bf16(TRPK(vl[ks], vh[ks]), pa[ks], O, 0, 0, 0);
#pragma unroll
            for (int ks = 0; ks < 8; ++ks) O = __builtin_amdgcn_mfma_f32_32x32x16_bf16(sb[ks], qa[ks], O, 0, 0, 0);
            { LAS unsigned char* ob = base + OB_OFF + sub * OB_BYTES + r32 * ORS + (32 * w + 4 * hi) * 2;
#pragma unroll
              for (int g = 0; g < 4; ++g) { u32x2 pk; pk.x = cvt_pk_bf16(O[4 * g], O[4 * g + 1]); pk.y = cvt_pk_bf16(O[4 * g + 2], O[4 * g + 3]); *(LAS u32x2*)(ob + 16 * g) = pk; } }
        } else {
            s16x4 vl[2], vh[2];
            vl[0] = tr_rd<sub * TILE_SET + V_OFF>(trv[0]); vh[0] = tr_rd<sub * TILE_SET + V_OFF>(trv[1]); vl[1] = tr_rd<sub * TILE_SET + V_OFF + 4096>(trv[0]); vh[1] = tr_rd<sub * TILE_SET + V_OFF + 4096>(trv[1]);
            s16x4 al[4][2], ah[4][2];
#define SCAN_KTRD(KT2) al[KT2][0] = tr_rd<sub * TILE_SET + KT_OFF>(trk[KT2][0]); ah[KT2][0] = tr_rd<sub * TILE_SET + KT_OFF>(trk[KT2][1]); \
            al[KT2][1] = tr_rd<sub * TILE_SET + KT_OFF + 4096>(trk[KT2][0]); ah[KT2][1] = tr_rd<sub * TILE_SET + KT_OFF + 4096>(trk[KT2][1]);
            SCAN_KTRD(0) SCAN_KTRD(1) SCAN_KTRD(2) SCAN_KTRD(3)
#undef SCAN_KTRD
            asm volatile("s_waitcnt lgkmcnt(0)" ::: "memory"); __builtin_amdgcn_sched_barrier(0);
            bf16x8 vb[2];
#pragma unroll
            for (int ks = 0; ks < 2; ++ks) vb[ks] = TRPK(vl[ks], vh[ks]);
#pragma unroll
            for (int kt2 = 0; kt2 < 4; ++kt2)
#pragma unroll
                for (int ks = 0; ks < 2; ++ks) S[kt2] = __builtin_amdgcn_mfma_f32_32x32x16_bf16(TRPK(al[kt2][ks], ah[kt2][ks]), vb[ks], S[kt2], 0, 0, 0);
            unsigned stw = (unsigned)(vcol * RS + 8 * hi) + (unsigned)(ST_OFF + (sub ? ST_BYTES : 0)), dvo = (unsigned)(16 * hi) + (unsigned)(sub * TILE_SET + DV_OFF); asm volatile("" : "+v"(stw), "+v"(dvo));
            f32x4 dq[2][4];
#define SCAN_DLOAD(KT2) _Pragma("unroll") for (int g = 0; g < 4; ++g) dq[(KT2) & 1][g] = *(const LAS f32x4*)(base + dvo + 128 * (KT2) + 32 * g);
#define SCAN_DECAY(KT2) _Pragma("unroll") for (int g = 0; g < 4; ++g) { const f32x4 d4 = dq[(KT2) & 1][g]; \
                _Pragma("unroll") for (int e = 0; e < 4; ++e) S[KT2][4 * g + e] *= d4[e]; \
                u32x2 pk; pk.x = cvt_pk_bf16(S[KT2][4 * g], S[KT2][4 * g + 1]); pk.y = cvt_pk_bf16(S[KT2][4 * g + 2], S[KT2][4 * g + 3]); \
                *(LAS u32x2*)(base + stw + 64 * (KT2) + 16 * g) = pk; }
            SCAN_DLOAD(0) SCAN_DLOAD(1)
            SCAN_DECAY(0) SCAN_DLOAD(2)
            SCAN_DECAY(1) SCAN_DLOAD(3)
            SCAN_DECAY(2) SCAN_DECAY(3)
#undef SCAN_DLOAD
#undef SCAN_DECAY
        }
        SCAN_WRITE(1 - sub);
        __syncthreads();
    };
    if (wave < 4) { for (int cj = 0; cj < NC; cj += 2) { chunk_body(IC<0>{}, IC<0>{}, cj); chunk_body(IC<1>{}, IC<0>{}, cj + 1); } }
    else          { for (int cj = 0; cj < NC; cj += 2) { chunk_body(IC<0>{}, IC<1>{}, cj); chunk_body(IC<1>{}, IC<1>{}, cj + 1); } }
    O_STORE(ch ? 0 : NC - 1, 1);
    __builtin_amdgcn_s_waitcnt(0x0F70);
#undef SCAN_LOAD
#undef SCAN_WRITE
#undef O_STORE
}
#undef TRPK
__device__ __forceinline__ void hgrn_scan(const Ctx& c, bool dummy) {
    const int NI = 32 + 512;
    const bool split = c.G > 64;
    const int first = split ? (c.bid < 32 ? c.bid : 32 + (c.bid - 32)) : c.bid, step = split ? (c.bid < 32 ? NI : c.G - 32) : c.G;
    for (int it = first; it < NI; it += step) {
        const bool pr = it < 32; const int si = it - 32;
        run_chain(c, pr ? (it >> 4) * SP : TP + (si >> 4) * SS, pr ? SP : SS, pr ? ((it >> 1) & 7) : ((si >> 1) & 7), pr ? (it & 1) : (si & 1), dummy);
    }
}
}
#define CE_(a, i, j) { const unsigned _x = a[i] > a[j] ? a[i] : a[j], _y = a[i] > a[j] ? a[j] : a[i]; a[i] = _x; a[j] = _y; }
__device__ __forceinline__ void sort16_desc(unsigned (&a)[16]) {
    CE_(a, 0, 1) CE_(a, 2, 3) CE_(a, 0, 2) CE_(a, 1, 3) CE_(a, 1, 2) CE_(a, 4, 5) CE_(a, 6, 7) CE_(a, 4, 6) CE_(a, 5, 7) CE_(a, 5, 6) CE_(a, 0, 4) CE_(a, 2, 6) CE_(a, 2, 4) CE_(a, 1, 5) CE_(a, 3, 7) CE_(a, 3, 5) CE_(a, 1, 2) CE_(a, 3, 4) CE_(a, 5, 6) CE_(a, 8, 9) CE_(a, 10, 11) CE_(a, 8, 10) CE_(a, 9, 11) CE_(a, 9, 10) CE_(a, 12, 13) CE_(a, 14, 15) CE_(a, 12, 14) CE_(a, 13, 15) CE_(a, 13, 14) CE_(a, 8, 12) CE_(a, 10, 14) CE_(a, 10, 12) CE_(a, 9, 13) CE_(a, 11, 15) CE_(a, 11, 13) CE_(a, 9, 10) CE_(a, 11, 12) CE_(a, 13, 14) CE_(a, 0, 8) CE_(a, 4, 12) CE_(a, 4, 8) CE_(a, 2, 10) CE_(a, 6, 14) CE_(a, 6, 10) CE_(a, 2, 4) CE_(a, 6, 8) CE_(a, 10, 12) CE_(a, 1, 9) CE_(a, 5, 13) CE_(a, 5, 9) CE_(a, 3, 11) CE_(a, 7, 15) CE_(a, 7, 11) CE_(a, 3, 5) CE_(a, 7, 9) CE_(a, 11, 13) CE_(a, 1, 2) CE_(a, 3, 4) CE_(a, 5, 6) CE_(a, 7, 8) CE_(a, 9, 10) CE_(a, 11, 12) CE_(a, 13, 14)
}
__device__ __forceinline__ void merge16_top(unsigned (&a)[16], const unsigned (&b)[16]) {
    a[0] = a[0] > b[15] ? a[0] : b[15]; a[1] = a[1] > b[14] ? a[1] : b[14]; a[2] = a[2] > b[13] ? a[2] : b[13]; a[3] = a[3] > b[12] ? a[3] : b[12]; a[4] = a[4] > b[11] ? a[4] : b[11]; a[5] = a[5] > b[10] ? a[5] : b[10]; a[6] = a[6] > b[9] ? a[6] : b[9]; a[7] = a[7] > b[8] ? a[7] : b[8]; a[8] = a[8] > b[7] ? a[8] : b[7]; a[9] = a[9] > b[6] ? a[9] : b[6]; a[10] = a[10] > b[5] ? a[10] : b[5]; a[11] = a[11] > b[4] ? a[11] : b[4]; a[12] = a[12] > b[3] ? a[12] : b[3]; a[13] = a[13] > b[2] ? a[13] : b[2]; a[14] = a[14] > b[1] ? a[14] : b[1]; a[15] = a[15] > b[0] ? a[15] : b[0];
    CE_(a, 0, 8) CE_(a, 1, 9) CE_(a, 2, 10) CE_(a, 3, 11) CE_(a, 4, 12) CE_(a, 5, 13) CE_(a, 6, 14) CE_(a, 7, 15) CE_(a, 0, 4) CE_(a, 1, 5) CE_(a, 2, 6) CE_(a, 3, 7) CE_(a, 8, 12) CE_(a, 9, 13) CE_(a, 10, 14) CE_(a, 11, 15) CE_(a, 0, 2) CE_(a, 1, 3) CE_(a, 4, 6) CE_(a, 5, 7) CE_(a, 8, 10) CE_(a, 9, 11) CE_(a, 12, 14) CE_(a, 13, 15) CE_(a, 0, 1) CE_(a, 2, 3) CE_(a, 4, 5) CE_(a, 6, 7) CE_(a, 8, 9) CE_(a, 10, 11) CE_(a, 12, 13) CE_(a, 14, 15)
}
namespace peer {
constexpr int KEY_RS = 272;
constexpr int KEYS_BYTES = 2 * 128 * KEY_RS;
constexpr int SI_OFF = KEYS_BYTES;
__device__ __forceinline__ int crow(int r, int hi) { return (r & 3) + 8 * (r >> 2) + 4 * hi; }
__device__ __forceinline__ unsigned sortable(float f) { const unsigned u = __float_as_uint(f); return u ^ ((u >> 31) ? 0xFFFFFFFFu : 0x80000000u); }
__device__ __forceinline__ float unsortable(unsigned s) { const unsigned u = (s >> 31) ? (s ^ 0x80000000u) : ~s; return __uint_as_float(u); }
__device__ __forceinline__ unsigned pair_max(unsigned m) { auto rr = __builtin_amdgcn_permlane32_swap(m, m, false, false); return rr[0] > rr[1] ? rr[0] : rr[1]; }

__device__ __forceinline__ void top16_half(const Ctx& c, const bf16_t* pq_rows, int half, LAS unsigned char* keys, unsigned (&sel)[16]) {
    const int lane = c.lane, r32 = lane & 31, hi = lane >> 5;
    f32x16 acc[4];
#pragma unroll
    for (int nt = 0; nt < 4; ++nt) acc[nt] = f32x16{};
    const bf16_t* qrow = pq_rows + (size_t)r32 * 256 + half * 128;
    bf16x8 qb[8];
#pragma unroll
    for (int ks = 0; ks < 8; ++ks) qb[ks] = *reinterpret_cast<const bf16x8*>(qrow + 16 * ks + 8 * hi);
#pragma unroll
    for (int ks = 0; ks < 8; ++ks) {
#pragma unroll
        for (int nt = 0; nt < 4; ++nt) { const bf16x8 ka = *(const LAS bf16x8*)(keys + (half * 128 + 32 * nt + r32) * KEY_RS + (16 * ks + 8 * hi) * 2);
            acc[nt] = __builtin_amdgcn_mfma_f32_32x32x16_bf16(ka, qb[ks], acc[nt], 0, 0, 0); }
        if (ks & 1) __builtin_amdgcn_sched_barrier(0); }
    unsigned p[64];
#pragma unroll
    for (int nt = 0; nt < 4; ++nt)
#pragma unroll
        for (int r = 0; r < 16; ++r) { const int n = 32 * nt + crow(r, hi); p[nt * 16 + r] = (sortable(acc[nt][r]) & ~127u) | (unsigned)(127 - n); }
    unsigned g0[16], g1[16], g2[16], g3[16];
#pragma unroll
    for (int i = 0; i < 16; ++i) { g0[i] = p[i]; g1[i] = p[16 + i]; g2[i] = p[32 + i]; g3[i] = p[48 + i]; }
    sort16_desc(g0); sort16_desc(g1); sort16_desc(g2); sort16_desc(g3);
    merge16_top(g0, g1); merge16_top(g2, g3); merge16_top(g0, g2);
    unsigned pb[16];
#pragma unroll
    for (int i = 0; i < 16; ++i) { auto rr = __builtin_amdgcn_permlane32_swap(g0[i], g0[i], false, false); sel[i] = rr[0]; pb[i] = rr[1]; }
    merge16_top(sel, pb);
}
__device__ __forceinline__ void route(const Ctx& c, int layer) {
    const bf16_t* pq = (const bf16_t*)(c.ws + B_PQ); unsigned short* idx_out = (unsigned short*)(c.ws + R2_IDX); float* gate_out = (float*)(c.ws + R2_GATE);
    const bf16_t* keys_g = (const bf16_t*)(c.ws + W_KEYS) + (size_t)layer * 2 * 128 * 128;
    LAS unsigned char* keys = c.lds;
    const int lane = c.lane, r32 = lane & 31, hi = lane >> 5;
    for (int i = c.tid; i < 2 * 128 * 16; i += NTHR) { const int row = i >> 4, ch = i & 15; *(LAS u32x4*)(keys + row * KEY_RS + ch * 16) = *(const u32x4*)(keys_g + (size_t)row * 128 + ch * 8); }
    __syncthreads();
    LAS int* si = (LAS int*)(c.lds + SI_OFF + c.wave * 4096) + r32 * 32;
    for (int grp = c.gw; grp < T / 4; grp += c.NGW) {
        const bf16_t* rows = pq + (size_t)grp * 4 * 2048;
        unsigned s1[16], s2[16];
        top16_half(c, rows, 0, keys, s1);
        top16_half(c, rows, 1, keys, s2);
        float v1[16], v2[16];
#pragma unroll
        for (int i = 0; i < 16; ++i) { v1[i] = unsortable(s1[i] & ~127u); v2[i] = unsortable(s2[i] & ~127u); }
        if (hi == 0) {
#pragma unroll
            for (int i = 0; i < 16; ++i) { si[i] = 127 - (int)(s1[i] & 127u); si[16 + i] = 127 - (int)(s2[i] & 127u); }
        }
        float A[16], B[16];
#pragma unroll
        for (int i = 0; i < 16; ++i) { A[i] = hi ? v2[i] : v1[i]; B[i] = hi ? v1[i] : v2[i]; }
        unsigned cd[27]; int nc = 0;
#pragma unroll
        for (int i = 0; i < 16; ++i)
#pragma unroll
            for (int j = i; j < 16; ++j) if ((i + 1) * (j + 1) <= 16) {
                const unsigned flat = hi ? (unsigned)(j * 16 + i) : (unsigned)(i * 16 + j);
                unsigned pk = (sortable(A[i] + B[j]) & ~255u) | (255u - flat);
                if (i == j) pk = hi ? 0u : pk;
                cd[nc++] = pk; }
        unsigned sel[16], c1[16], pb[16];
#pragma unroll
        for (int i = 0; i < 16; ++i) { sel[i] = cd[i]; c1[i] = (16 + i < 27) ? cd[(16 + i < 27) ? 16 + i : 0] : 0u; }
        sort16_desc(sel); sort16_desc(c1); merge16_top(sel, c1);
#pragma unroll
        for (int i = 0; i < 16; ++i) { auto rr = __builtin_amdgcn_permlane32_swap(sel[i], sel[i], false, false); sel[i] = rr[0]; pb[i] = rr[1]; }
        merge16_top(sel, pb);
        LDS_WAIT(); asm volatile("" ::: "memory");
        const float vmax = unsortable(sel[0] & ~255u);
        float e[16], es = 0.f;
#pragma unroll
        for (int i = 0; i < 16; ++i) { e[i] = fast_exp(unsortable(sel[i] & ~255u) - vmax); es += e[i]; }
        const float inv = 1.0f / es;
        const size_t obase = ((size_t)grp * 4 + (r32 >> 3)) * 128 + (r32 & 7) * 16 + 8 * hi;
        int oi[8]; float og[8];
#pragma unroll
        for (int q = 0; q < 8; ++q) { const unsigned sv = hi ? sel[8 + q] : sel[q]; const float ev = hi ? e[8 + q] : e[q];
            const int flat = 255 - (int)(sv & 255u); oi[q] = si[flat >> 4] * 128 + si[16 + (flat & 15)]; og[q] = ev * inv; }
        *(u32x4*)(idx_out + obase) = (u32x4){(unsigned)oi[0] | ((unsigned)oi[1] << 16), (unsigned)oi[2] | ((unsigned)oi[3] << 16), (unsigned)oi[4] | ((unsigned)oi[5] << 16), (unsigned)oi[6] | ((unsigned)oi[7] << 16)};
        *(f32x4*)(gate_out + obase) = (f32x4){og[0], og[1], og[2], og[3]};
        *(f32x4*)(gate_out + obase + 4) = (f32x4){og[4], og[5], og[6], og[7]};
        LDS_WAIT(); asm volatile("" ::: "memory");
    }
    __syncthreads();
}

__device__ __forceinline__ float gelu_exact(float x) { return 0.5f * x * (1.0f + erff(x * 0.70710678118654752f)); }
template <int IDXMASK> __device__ __forceinline__ void gather_ln(const Ctx& c, int layer, float* xout, bf16_t* xb) {
    const unsigned char* U8 = c.ws + R2_UB; const unsigned char* V8 = c.ws + R2_VB;
    const float* su = (const float*)(c.ws + R2_SU); const float* sv = (const float*)(c.ws + R2_SV);
    const int* idx = (const int*)(c.ws + R2_IDX); const float* gate = (const float*)(c.ws + R2_GATE);
    const float* lg = c.in(20) + layer * D; const float* lbv = c.in(21) + layer * D;
    const int lane = c.lane;
    for (int t = c.gw; t < T; t += c.NGW) {
        const float* xr = c.out + (size_t)t * D + 16 * lane; float* xw = xout + (size_t)t * D + 16 * lane;
        float x[16], acc[16];
#pragma unroll
        for (int j = 0; j < 4; ++j) { const f32x4 a = *(const f32x4*)(xr + 4 * j); x[4 * j] = a[0]; x[4 * j + 1] = a[1]; x[4 * j + 2] = a[2]; x[4 * j + 3] = a[3]; }
#pragma unroll
        for (int e = 0; e < 16; ++e) acc[e] = 0.f;
        const int myidx0 = idx[(size_t)t * 128 + lane] & IDXMASK, myidx1 = idx[(size_t)t * 128 + 64 + lane] & IDXMASK;
        const float myg0 = gate[(size_t)t * 128 + lane], myg1 = gate[(size_t)t * 128 + 64 + lane];
        for (int eb = 0; eb < 128; eb += 8) {
            float part[8]; int ei[8];
#pragma unroll
            for (int q = 0; q < 8; ++q) { const int e = eb + q; ei[q] = __builtin_amdgcn_readlane(e < 64 ? myidx0 : myidx1, e & 63); }
            u32x4 vr[8];
#pragma unroll
            for (int q = 0; q < 8; ++q) vr[q] = *(const u32x4*)(V8 + (size_t)ei[q] * D + 16 * lane);
#pragma unroll
            for (int q = 0; q < 8; ++q) { const u32x4 a = *(const u32x4*)(U8 + (size_t)ei[q] * D + 16 * lane);
                float s = 0.f;
#pragma unroll
                for (int j = 0; j < 4; ++j) { const f32x2 lo = __builtin_amdgcn_cvt_pk_f32_fp8((int)a[j], false), hi = __builtin_amdgcn_cvt_pk_f32_fp8((int)a[j], true);
                    s = fmaf(lo[0], x[4 * j], s); s = fmaf(lo[1], x[4 * j + 1], s); s = fmaf(hi[0], x[4 * j + 2], s); s = fmaf(hi[1], x[4 * j + 3], s); }
                part[q] = s; }
            float r4[4], r2[2], r1;
            { const bool up = (lane & 32) != 0;
#pragma unroll
              for (int i = 0; i < 4; ++i) { const float send = up ? part[i] : part[4 + i]; const float keep = up ? part[4 + i] : part[i]; r4[i] = keep + __shfl_xor(send, 32); } }
            { const bool up = (lane & 16) != 0;
#pragma unroll
              for (int i = 0; i < 2; ++i) { const float send = up ? r4[i] : r4[2 + i]; const float keep = up ? r4[2 + i] : r4[i]; r2[i] = keep + __shfl_xor(send, 16); } }
            { const bool up = (lane & 8) != 0; const float send = up ? r2[0] : r2[1]; const float keep = up ? r2[1] : r2[0]; r1 = keep + __shfl_xor(send, 8); }
            r1 += __shfl_xor(r1, 4); r1 += __shfl_xor(r1, 2); r1 += __shfl_xor(r1, 1);
            const int myq = ((lane >> 5) & 1) * 4 + ((lane >> 4) & 1) * 2 + ((lane >> 3) & 1);
            const int me = eb + myq;
            const float g = __shfl(me < 64 ? myg0 : myg1, me & 63);
            const int mye = __shfl(me < 64 ? myidx0 : myidx1, me & 63);
            const float cf = g * gelu_exact(r1 * su[mye]) * sv[mye];
            float cq[8];
#pragma unroll
            for (int q = 0; q < 8; ++q) cq[q] = __int_as_float(__builtin_amdgcn_readlane(__float_as_int(cf), ((q >> 2) & 1) * 32 + ((q >> 1) & 1) * 16 + (q & 1) * 8));
#pragma unroll
            for (int q = 0; q < 8; ++q) { const float s = cq[q];
#pragma unroll
                for (int j = 0; j < 4; ++j) { const f32x2 lo = __builtin_amdgcn_cvt_pk_f32_fp8((int)vr[q][j], false), hi = __builtin_amdgcn_cvt_pk_f32_fp8((int)vr[q][j], true);
                    acc[4 * j] = fmaf(s, lo[0], acc[4 * j]); acc[4 * j + 1] = fmaf(s, lo[1], acc[4 * j + 1]); acc[4 * j + 2] = fmaf(s, hi[0], acc[4 * j + 2]); acc[4 * j + 3] = fmaf(s, hi[1], acc[4 * j + 3]); } }
        }
        float s = 0.f;
#pragma unroll
        for (int e = 0; e < 16; ++e) { acc[e] = fmaf(DN_ALPHA, x[e], acc[e]); s += acc[e]; }
        const float mean = wave_sum(s) * (1.0f / D); float s2 = 0.f;
#pragma unroll
        for (int e = 0; e < 16; ++e) { acc[e] -= mean; s2 += acc[e] * acc[e]; }
        const float rstd = 1.0f / sqrtf(wave_sum(s2) * (1.0f / D) + LN_EPS);
        float o[16];
#pragma unroll
        for (int j = 0; j < 4; ++j) { const f32x4 g4 = *(const f32x4*)(lg + 16 * lane + 4 * j), b4 = *(const f32x4*)(lbv + 16 * lane + 4 * j);
#pragma unroll
            for (int e = 0; e < 4; ++e) o[4 * j + e] = acc[4 * j + e] * rstd * g4[e] + b4[e];
            *(f32x4*)(xw + 4 * j) = (f32x4){o[4 * j], o[4 * j + 1], o[4 * j + 2], o[4 * j + 3]}; }
        u32x4 w0, w1; w0.x = cvt_pk_bf16(o[0], o[1]); w0.y = cvt_pk_bf16(o[2], o[3]); w0.z = cvt_pk_bf16(o[4], o[5]); w0.w = cvt_pk_bf16(o[6], o[7]);
        w1.x = cvt_pk_bf16(o[8], o[9]); w1.y = cvt_pk_bf16(o[10], o[11]); w1.z = cvt_pk_bf16(o[12], o[13]); w1.w = cvt_pk_bf16(o[14], o[15]);
        *(u32x4*)(xb + (size_t)t * D + 16 * lane) = w0; *(u32x4*)(xb + (size_t)t * D + 16 * lane + 8) = w1;
    }
}
}
namespace peer {
#ifndef PROBE_NOMATH
#define PROBE_NOMATH 0
#endif
constexpr size_t HP_OFF = WS_BIG;
constexpr size_t COEF_OFF = WS_R2 + 36 * MiB;
constexpr int QW_BASE = 4096;
constexpr int ITEM_TOK = 128, NBLK = T / ITEM_TOK;
constexpr int GT = 1;
#define DPP_F(v, ctrl) __int_as_float(__builtin_amdgcn_update_dpp(0, __float_as_int(v), (ctrl), 0xf, 0xf, true))

template <class F> __device__ __forceinline__ void for_items(const Ctx& c, int layer, int phase, F body) {
    unsigned* qw = (unsigned*)(c.ws + WS_CTL) + QW_BASE + (size_t)((layer * 4 + phase) * 8) * 16;
    volatile LAS int* slot = (volatile LAS int*)(c.lds + LDS_MISC_OFF + 128);
    const int home = (int)(xb_xcc_id() & 7u);
    for (int k = 0; k < 8; ++k) {
        const int s = (home + k) & 7;
        if (c.tid == 0) slot[0] = (int)__hip_atomic_fetch_add(qw + s * 16, 1u, __ATOMIC_RELAXED, __HIP_MEMORY_SCOPE_AGENT);
        __syncthreads();
        int cur = slot[0];
        __syncthreads();
        while (cur < NBLK) {
            int nxt = 0;
            if (c.tid == 0) nxt = (int)__hip_atomic_fetch_add(qw + s * 16, 1u, __ATOMIC_RELAXED, __HIP_MEMORY_SCOPE_AGENT);
            body(s, cur);
            if (c.tid == 0) slot[0] = nxt;
            __syncthreads();
            cur = slot[0];
            __syncthreads();
        }
    }
}

__device__ __forceinline__ void g1_udot(const Ctx& c, int layer, int dup) {
    const unsigned char* U8 = c.ws + R2_UB; const unsigned short* idx = (const unsigned short*)(c.ws + R2_IDX); bf16_t* hp = (bf16_t*)(c.ws + HP_OFF);
    for_items(c, layer, 0 + 2 * dup, [&](int s, int blk) {
        int lane = c.lane; asm volatile("" : "+v"(lane));
        const int g = lane >> 3, c8 = lane & 7;
        const int co = 128 * s + 16 * c8;
        constexpr int N = ITEM_TOK / NWAVES;
        const int t0 = blk * ITEM_TOK + c.wave * N;
        auto issue_idx = [&](int t, u32x4 (&q)[2]) {
#pragma unroll
            for (int j = 0; j < 2; ++j) q[j] = *(const u32x4*)(idx + (size_t)t * 128 + 16 * g + 8 * j); };
        auto unpack_idx = [&](const u32x4 (&q)[2], int (&id)[16]) {
#pragma unroll
            for (int j = 0; j < 2; ++j)
#pragma unroll
                for (int e = 0; e < 4; ++e) { id[8 * j + 2 * e] = (int)(q[j][e] & 0xffffu); id[8 * j + 2 * e + 1] = (int)(q[j][e] >> 16); } };
        auto load_rows = [&](int t, const int (&id)[16], u32x4 (&row)[16], u32x4 (&xr)[2]) {
#pragma unroll
            for (int j = 0; j < 2; ++j) xr[j] = *(const u32x4*)((const bf16_t*)(c.ws + WS_XB) + (size_t)t * D + co + 8 * j);
#pragma unroll
            for (int j = 0; j < 16; ++j) row[j] = *(const u32x4*)(U8 + ((unsigned)id[j] * 1024u + (unsigned)co)); };
        auto compute = [&](int t, const u32x4 (&row)[16], const u32x4 (&xr)[2]) {
            f32x2 x2[8];
#pragma unroll
            for (int j = 0; j < 2; ++j)
#pragma unroll
                for (int e = 0; e < 4; ++e) x2[4 * j + e] = (f32x2){bflo(xr[j][e]), bfhi(xr[j][e])};
            float V[16];
#pragma unroll
            for (int j = 0; j < 16; ++j) { f32x2 acc2 = (f32x2){0.f, 0.f};
                if (PROBE_NOMATH && dup) { V[j] = __uint_as_float((row[j][0] ^ row[j][1] ^ row[j][2] ^ row[j][3]) & 0x3fffffffu) + x2[j & 7][0]; continue; }
#pragma unroll
                for (int q = 0; q < 4; ++q) { const f32x2 lo = __builtin_amdgcn_cvt_pk_f32_fp8((int)row[j][q], false), hi = __builtin_amdgcn_cvt_pk_f32_fp8((int)row[j][q], true);
                    acc2 = __builtin_elementwise_fma(lo, x2[2 * q], acc2); acc2 = __builtin_elementwise_fma(hi, x2[2 * q + 1], acc2); }
                V[j] = acc2[0] + acc2[1]; }
            float W[8], Y[4], Z[2];
            { const bool hiA = (lane & 4) != 0;
#pragma unroll
              for (int m = 0; m < 8; ++m) { const float send = hiA ? V[m] : V[8 + m], keep = hiA ? V[8 + m] : V[m]; W[m] = keep + DPP_F(send, 0x141); } }
            { const bool hiB = (lane & 2) != 0;
#pragma unroll
              for (int m = 0; m < 4; ++m) { const float send = hiB ? W[m] : W[4 + m], keep = hiB ? W[4 + m] : W[m]; Y[m] = keep + DPP_F(send, 0x1B); } }
            { const bool hiC = (lane & 1) != 0;
#pragma unroll
              for (int m = 0; m < 2; ++m) { const float send = hiC ? Y[m] : Y[2 + m], keep = hiC ? Y[2 + m] : Y[m]; Z[m] = keep + DPP_F(send, 0xB1); } }
            *(unsigned*)((dup ? hp + (size_t)320 * MiB : hp) + ((size_t)(dup ? 0 : s) * T + t) * 128 + 16 * g + 2 * c8) = cvt_pk_bf16(Z[0], Z[1]); };
        int id[16]; u32x4 qA[2], qB[2], rowA[16], rowB[16], xA[2], xB[2];
        issue_idx(t0, qA); issue_idx(t0 + 1, qB);
        unpack_idx(qA, id); load_rows(t0, id, rowA, xA);
#pragma unroll 1
        for (int i = 0; i < N; i += 2) {
            unpack_idx(qB, id); load_rows(t0 + i + 1, id, rowB, xB);
            if (i + 2 < N) issue_idx(t0 + i + 2, qA);
            __builtin_amdgcn_sched_barrier(0);
            compute(t0 + i, rowA, xA);
            __builtin_amdgcn_sched_barrier(0);
            if (i + 2 < N) { unpack_idx(qA, id); load_rows(t0 + i + 2, id, rowA, xA); }
            if (i + 3 < N) issue_idx(t0 + i + 3, qB);
            __builtin_amdgcn_sched_barrier(0);
            compute(t0 + i + 1, rowB, xB);
            __builtin_amdgcn_sched_barrier(0);
        }
    });
}
__device__ __forceinline__ void g2_coef(const Ctx& c, int dup) {
    const unsigned short* idx = (const unsigned short*)(c.ws + R2_IDX); const float* gate = (const float*)(c.ws + R2_GATE); const bf16_t* hp = (const bf16_t*)(c.ws + HP_OFF);
    const float* su = (const float*)(c.ws + R2_SU); const float* sv = (const float*)(c.ws + R2_SV);
    bf16_t* dstb = dup ? (bf16_t*)(c.ws + HP_OFF) + (size_t)340 * MiB : (bf16_t*)(c.ws + COEF_OFF);
    const int lane = c.lane;
    constexpr int NU = 4;
    for (int t0 = c.gw * NU; t0 < T; t0 += c.NGW * NU) {
        float h[NU][2]; unsigned ew[NU]; f32x2 gt[NU];
#pragma unroll
        for (int u = 0; u < NU; ++u) { const size_t o = (size_t)(t0 + u) * 128 + 2 * lane; ew[u] = *(const unsigned*)(idx + o); gt[u] = *(const f32x2*)(gate + o); float a0 = 0.f, a1 = 0.f;
#pragma unroll
            for (int s = 0; s < 8; ++s) { const unsigned w = *(const unsigned*)(hp + (size_t)s * T * 128 + o); a0 += bflo(w); a1 += bfhi(w); }
            h[u][0] = a0; h[u][1] = a1; }
        float s1[NU][2], s2[NU][2];
#pragma unroll
        for (int u = 0; u < NU; ++u) { const int e0 = (int)(ew[u] & 0xffffu), e1 = (int)(ew[u] >> 16); s1[u][0] = su[e0]; s1[u][1] = su[e1]; s2[u][0] = sv[e0]; s2[u][1] = sv[e1]; }
#pragma unroll
        for (int u = 0; u < NU; ++u) *(unsigned*)(dstb + (size_t)(t0 + u) * 128 + 2 * lane) = cvt_pk_bf16(gt[u][0] * gelu_exact(h[u][0] * s1[u][0]) * s2[u][0], gt[u][1] * gelu_exact(h[u][1] * s1[u][1]) * s2[u][1]);
    }
}
__device__ __forceinline__ void g3_vaxpy(const Ctx& c, int layer, int dup) {
    const unsigned char* V8 = c.ws + R2_VB; const unsigned short* idx = (const unsigned short*)(c.ws + R2_IDX); const bf16_t* coef = (const bf16_t*)(c.ws + COEF_OFF);
    for_items(c, layer, 1 + 2 * dup, [&](int s, int blk) {
        int lane = c.lane; asm volatile("" : "+v"(lane));
        const int g = lane >> 3, c8 = lane & 7;
        const int co = 128 * s + 16 * c8;
        constexpr int N = ITEM_TOK / NWAVES;
        const int t0 = blk * ITEM_TOK + c.wave * N;
        auto issue_idx = [&](int t, u32x4 (&q)[2]) {
#pragma unroll
            for (int j = 0; j < 2; ++j) q[j] = *(const u32x4*)(idx + (size_t)t * 128 + 16 * g + 8 * j); };
        auto unpack_idx = [&](const u32x4 (&q)[2], int (&id)[16]) {
#pragma unroll
            for (int j = 0; j < 2; ++j)
#pragma unroll
                for (int e = 0; e < 4; ++e) { id[8 * j + 2 * e] = (int)(q[j][e] & 0xffffu); id[8 * j + 2 * e + 1] = (int)(q[j][e] >> 16); } };
        auto load_rows = [&](int t, const int (&id)[16], u32x4 (&row)[16], f32x4 (&cf)[4], unsigned& xo) {
            xo = *(const unsigned*)((const bf16_t*)(c.ws + WS_XB) + (size_t)t * D + co + 8 * ((lane >> 5) & 1) + 4 * ((lane >> 4) & 1) + 2 * ((lane >> 3) & 1));
#pragma unroll
            for (int j = 0; j < 2; ++j) { const u32x4 q = *(const u32x4*)(coef + (size_t)t * 128 + 16 * g + 8 * j); cf[2 * j] = (f32x4){bflo(q[0]), bfhi(q[0]), bflo(q[1]), bfhi(q[1])}; cf[2 * j + 1] = (f32x4){bflo(q[2]), bfhi(q[2]), bflo(q[3]), bfhi(q[3])}; }
#pragma unroll
            for (int j = 0; j < 16; ++j) row[j] = *(const u32x4*)(V8 + ((unsigned)id[j] * 1024u + (unsigned)co)); };
        auto compute = [&](int t, const u32x4 (&row)[16], const f32x4 (&cf)[4], const unsigned xo) {
            f32x2 A2[8];
#pragma unroll
            for (int e = 0; e < 8; ++e) A2[e] = (f32x2){0.f, 0.f};
#pragma unroll
            for (int j = 0; j < 16; ++j) { const float cj = cf[j >> 2][j & 3]; const f32x2 sc = (f32x2){cj, cj};
#pragma unroll
                for (int q = 0; q < 4; ++q) { const f32x2 lo = __builtin_amdgcn_cvt_pk_f32_fp8((int)row[j][q], false), hi = __builtin_amdgcn_cvt_pk_f32_fp8((int)row[j][q], true);
                    A2[2 * q] = __builtin_elementwise_fma(sc, lo, A2[2 * q]); A2[2 * q + 1] = __builtin_elementwise_fma(sc, hi, A2[2 * q + 1]); } }
            float A[16];
#pragma unroll
            for (int e = 0; e < 8; ++e) { A[2 * e] = A2[e][0]; A[2 * e + 1] = A2[e][1]; }
            float R[8], S2[4], Y[2];
#pragma unroll
            for (int m = 0; m < 8; ++m) { auto rr = __builtin_amdgcn_permlane32_swap(__float_as_uint(A[m]), __float_as_uint(A[8 + m]), false, false); R[m] = __uint_as_float(rr[0]) + __uint_as_float(rr[1]); }
#pragma unroll
            for (int m = 0; m < 4; ++m) { auto rr = __builtin_amdgcn_permlane16_swap(__float_as_uint(R[m]), __float_as_uint(R[4 + m]), false, false); S2[m] = __uint_as_float(rr[0]) + __uint_as_float(rr[1]); }
            { const bool hi8 = (lane & 8) != 0;
#pragma unroll
              for (int m = 0; m < 2; ++m) { const float send = hi8 ? S2[m] : S2[2 + m], keep = hi8 ? S2[2 + m] : S2[m]; Y[m] = keep + DPP_F(send, 0x128); } }
            const size_t yo = (size_t)t * D + co + 8 * ((lane >> 5) & 1) + 4 * ((lane >> 4) & 1) + 2 * ((lane >> 3) & 1);
            *(unsigned*)((bf16_t*)c.out + yo) = cvt_pk_bf16(fmaf(DN_ALPHA, bflo(xo), Y[0]), fmaf(DN_ALPHA, bfhi(xo), Y[1])); };
        int id[16]; u32x4 qA[2], qB[2], rowA[16], rowB[16]; f32x4 cfA[4], cfB[4]; unsigned xoA, xoB;
        issue_idx(t0, qA); issue_idx(t0 + 1, qB);
        unpack_idx(qA, id); load_rows(t0, id, rowA, cfA, xoA);
#pragma unroll 1
        for (int i = 0; i < N; i += 2) {
            unpack_idx(qB, id); load_rows(t0 + i + 1, id, rowB, cfB, xoB);
            if (i + 2 < N) issue_idx(t0 + i + 2, qA);
            __builtin_amdgcn_sched_barrier(0);
            compute(t0 + i, rowA, cfA, xoA);
            __builtin_amdgcn_sched_barrier(0);
            if (i + 2 < N) { unpack_idx(qA, id); load_rows(t0 + i + 2, id, rowA, cfA, xoA); }
            if (i + 3 < N) issue_idx(t0 + i + 3, qB);
            __builtin_amdgcn_sched_barrier(0);
            compute(t0 + i + 1, rowB, cfB, xoB);
            __builtin_amdgcn_sched_barrier(0);
        }
    });
}
__device__ __forceinline__ void ln_pass(const Ctx& c, const float* g, const float* b) {
    const bf16_t* ym = (const bf16_t*)c.out; bf16_t* xa = (bf16_t*)(c.ws + WS_XB); const int lane = c.lane;
    constexpr int NU = 4;
    f32x4 ggv[4], bbv[4];
#pragma unroll
    for (int j = 0; j < 4; ++j) { ggv[j] = *(const f32x4*)(g + 256 * j + 4 * lane); bbv[j] = *(const f32x4*)(b + 256 * j + 4 * lane); }
    auto ld = [&](int t0, u32x2 (&w)[NU][4]) {
#pragma unroll
        for (int u = 0; u < NU; ++u)
#pragma unroll
            for (int j = 0; j < 4; ++j) w[u][j] = *(const u32x2*)(ym + (size_t)(t0 + u) * D + 256 * j + 4 * lane); };
    auto fin = [&](int t0, const u32x2 (&w)[NU][4]) {
        f32x4 v[NU][4]; bf16_t* dst[NU]; unsigned char* dst8[NU]; float* dsc[NU];
#pragma unroll
        for (int u = 0; u < NU; ++u) { dst8[u] = nullptr; dsc[u] = nullptr; dst[u] = xa + (size_t)(t0 + u) * D;
#pragma unroll
            for (int j = 0; j < 4; ++j) v[u][j] = (f32x4){bflo(w[u][j].x), bfhi(w[u][j].x), bflo(w[u][j].y), bfhi(w[u][j].y)}; }
        ln_rows<NU, false>(v, ggv, bbv, lane, dst, dst8, dsc); };
    const int stride = c.NGW * NU; int t0 = c.gw * NU;
    if (t0 >= T) return;
    u32x2 wA[NU][4], wB[NU][4];
    ld(t0, wA);
    for (;;) {
        const int t1 = t0 + stride; ld(min(t1, T - NU), wB);
        fin(t0, wA);
        if (t1 >= T) break;
        const int t2 = t1 + stride; ld(min(t2, T - NU), wA);
        fin(t1, wB);
        if (t2 >= T) break;
        t0 = t2;
    }
}
#undef DPP_F
}
constexpr int N_PHASES = 1 + 2 * (5 + 8) + 2 * (5 + 8);

#ifndef PROBE_SITE
#define PROBE_SITE -1
#endif
#ifndef PROBE_LN
#define PROBE_LN 0
#endif
#ifndef PROBE_VAR
#define PROBE_VAR 9
#endif
#define GEMM_PHASE(EPI, Aptr, Bptr, NN, KK, ...) { pg8::Gemm g{(const bf16_t*)(Aptr), (const bf16_t*)(Bptr), T, (NN), (KK)}; pg8::StaticOrder S; S.init(T, (NN), c.G, c.bid); \
        pg8::EPI E{__VA_ARGS__}; pg8::gemm_phase<pg8::EPI, pg8::StaticOrder>(c.lds, g, S, E, c.tid); }

__global__ void __launch_bounds__(NTHR, 2) fwd_kernel(Args args) {
    extern __shared__ __attribute__((aligned(16))) unsigned char lds_raw[];
    volatile LAS unsigned* misc = (volatile LAS unsigned*)((LAS unsigned char*)lds_raw + LDS_MISC_OFF);
    if (threadIdx.x < 64) misc[threadIdx.x] = 0u;
    __syncthreads();
    const int wave_s = __builtin_amdgcn_readfirstlane((int)threadIdx.x >> 6);
    const int lo = args.ph_lo, hi = args.ph_hi;
    XcdBarrier bar; bar.bar = (unsigned*)(args.ws + WS_CTL); bar.x = 0; bar.st = nullptr;
    if (hi - lo > 1) bar = xcd_barrier_post((unsigned*)(args.ws + WS_CTL), misc + 8);
    int ph = 0;
#define PHASE(site, ...) if (ph >= lo && ph < hi) { const Ctx c = mk_ctx(lds_raw, wave_s); unsigned char* const ws = c.ws; (void)ws; { constexpr int dup = 0; (void)dup; __VA_ARGS__ } \
        if constexpr (PROBE_SITE == (site)) { __syncthreads(); constexpr int dup = 1; (void)dup; __VA_ARGS__ } if (ph + 1 < hi) xcd_barrier(bar); } ++ph;

    PHASE(0, p0_prologue(c);)

    for (int layer = 0; layer < NL; ++layer) {
        const int j = layer >> 1;
        if ((layer & 1) == 0) {
            PHASE(1, GEMM_PHASE(EpiBf16P, c.out, (const bf16_t*)(ws + W_WA) + (size_t)j * 768 * 1024, 768, 1024, (bf16_t*)(ws + B_A32), 768))
            PHASE(2, l0_convert(c, layer); mla_e1(c, j);)
            PHASE(3, GEMM_PHASE(EpiBf16P, ws + B_CQN, (const bf16_t*)(ws + W_WUQ) + (size_t)j * 1536 * 384, 1536, 384, (bf16_t*)(ws + B_Q), 1536) __syncthreads();
                     GEMM_PHASE(EpiBf16P, ws + B_CKVN, (const bf16_t*)(ws + W_WUKV) + (size_t)j * 2048 * 256, 2048, 256, (bf16_t*)(ws + B_KV), 2048))
            PHASE(5, if (dup == 0) mla_attention<0>(c); else mla_attention<(PROBE_VAR > 4 ? 0 : PROBE_VAR)>(c);)
            PHASE(6, GEMM_PHASE(EpiBf16P, ws + B_O, (const bf16_t*)(ws + W_WO) + (size_t)j * 1024 * 1024, 1024, 1024, (bf16_t*)(ws + B_H32_MLA), 1024))
        } else {
            PHASE(7, GEMM_PHASE(EpiHgrn, c.out, (const bf16_t*)(ws + W_HIN) + (size_t)j * 5120 * 1024, 5120, 1024, (bf16_t*)(ws + B_PLANE), (size_t)T * 1024, (const float*)(ws + WS_MISC) + (size_t)j * 2048))
            PHASE(8, if (dup == 0) { l0_convert(c, layer); scan::hgrn_prep(c, 0); } else { scan::hgrn_prep(c, 1); })
            PHASE(9, scan::hgrn_scan(c, dup != 0);)
            PHASE(10, hgrn_post(c, j);)
            PHASE(11, GEMM_PHASE(EpiBf16P, ws + B_PLANE, (const bf16_t*)(ws + W_HO) + (size_t)j * 1024 * 1024, 1024, 1024, (bf16_t*)(ws + B_H32_HGRN), 1024))
        }
        PHASE(12, ln_residual(c, (const bf16_t*)(ws + ((layer & 1) ? B_H32_HGRN : B_H32_MLA)), c.in(18) + layer * D, c.in(19) + layer * D);)
        PHASE(13, GEMM_PHASE(EpiBf16P, ws + WS_XB, (const bf16_t*)(ws + W_PQ) + (size_t)layer * 2048 * 1024, 2048, 1024, (bf16_t*)(ws + B_PQ), 2048))
        PHASE(14, peer::route(c, layer);)
        PHASE(15, peer::g1_udot(c, layer, dup);)
        PHASE(16, peer::g2_coef(c, dup);)
        PHASE(17, peer::g3_vaxpy(c, layer, dup);)
        PHASE(18, if (dup == 0 || PROBE_LN == 0) GEMM_PHASE(EpiBf16P, ws + R2_PB, (const bf16_t*)(ws + W_PP) + (size_t)layer * 1024 * 256, 1024, 256, (bf16_t*)(ws + B_PP), 1024) if (dup == 0 || PROBE_LN == 1) peer::ln_pass(c, c.in(20) + layer * D, c.in(21) + layer * D);)
        PHASE(19, GEMM_PHASE(EpiPle, ws + WS_XB, (const bf16_t*)(ws + W_GW) + (size_t)layer * 1024 * 1024, 1024, 1024, (const bf16_t*)(ws + WS_XB), (const bf16_t*)(ws + B_PP), c.in(23) + layer * D, (bf16_t*)c.out, (layer == NL - 1) ? c.out : (float*)nullptr))
    }
#undef PHASE
}

extern "C" void kernel_launch(void* const* d_in, const int* in_sizes, int n_in, void* d_out, int out_size, void* d_ws, size_t ws_size, hipStream_t stream) {
    static int grid = 0;
    if (grid == 0) {
        if (n_in != 25 || out_size != T * D || ws_size < WS_END) { fprintf(stderr, "kernel_launch: unexpected shapes: n_in %d out %d ws %zu (need %zu)\n", n_in, out_size, ws_size, (size_t)WS_END); grid = -1; return; }
        int dev = 0, cus = 0, per_cu = 0;
        if (hipGetDevice(&dev) != hipSuccess || hipDeviceGetAttribute(&cus, hipDeviceAttributeMultiprocessorCount, dev) != hipSuccess) { grid = -1; return; }
        if (hipFuncSetAttribute((const void*)fwd_kernel, hipFuncAttributeMaxDynamicSharedMemorySize, LDS_BYTES) != hipSuccess) { fprintf(stderr, "kernel_launch: hipFuncSetAttribute failed\n"); grid = -1; return; }
        if (hipOccupancyMaxActiveBlocksPerMultiprocessor(&per_cu, (const void*)fwd_kernel, NTHR, LDS_BYTES) != hipSuccess || per_cu < 1) { fprintf(stderr, "kernel_launch: occupancy query says %d\n", per_cu); }
        (void)hipGetLastError();
        grid = cus;
    }
    if (grid < 0) return;
    (void)hipMemsetAsync((char*)d_ws + WS_CTL, 0, CTL_ZERO_BYTES, stream);
    Args a{};
    for (int i = 0; i < 25; ++i) a.in[i] = (const float*)d_in[i];
    a.out = (float*)d_out; a.ws = (unsigned char*)d_ws;
#if defined(MK_DEBUG_MLA)
    float* res = (float*)((char*)d_ws + WS_CTL + 48 * 1024);
    for (int p = 0; p < 4; ++p) { a.ph_lo = p; a.ph_hi = p + 1; hipLaunchKernelGGL(fwd_kernel, dim3(grid), dim3(NTHR), LDS_BYTES, stream, a); }
    hipLaunchKernelGGL(k_zero_out, dim3(2048), dim3(256), 0, stream, (float*)d_out, (size_t)T * D);
    hipLaunchKernelGGL(k_mla_naive, dim3(2), dim3(256), 0, stream, (const float*)d_in[0], (const float*)d_in[1], (const float*)d_in[4], (const float*)d_in[5], (const float*)d_in[6], (const float*)d_in[7], (const float*)d_in[8], (const unsigned char*)d_ws, res);
    hipLaunchKernelGGL(k_mla_report, dim3(1), dim3(64), 0, stream, (const float*)res, (float*)d_out);
#elif defined(MK_DEBUG_ATTN)
    float* res = (float*)((char*)d_ws + WS_CTL + 48 * 1024);
    for (int p = 0; p < 5; ++p) { a.ph_lo = p; a.ph_hi = p + 1; hipLaunchKernelGGL(fwd_kernel, dim3(grid), dim3(NTHR), LDS_BYTES, stream, a); }
    hipLaunchKernelGGL(k_zero_out, dim3(2048), dim3(256), 0, stream, (float*)d_out, (size_t)T * D);
    hipLaunchKernelGGL(k_attn_naive, dim3(2 * CHK_NR), dim3(256), 0, stream, (const unsigned char*)d_ws, (float*)nullptr, res);
    hipLaunchKernelGGL(k_attn_report, dim3(1), dim3(64), 0, stream, (const float*)res, (float*)d_out);
#elif defined(MK_DEBUG_DET)
    unsigned long long* tab = (unsigned long long*)((char*)d_ws + WS_CTL + 32 * 1024);
    for (int pass = 0; pass < 2; ++pass)
        for (int p = 0; p < N_PHASES; ++p) { a.ph_lo = p; a.ph_hi = p + 1; hipLaunchKernelGGL(fwd_kernel, dim3(grid), dim3(NTHR), LDS_BYTES, stream, a);
            Reg r[4]; const int nr = phase_regions(p, r);
            for (int i = 0; i < nr; ++i) hipLaunchKernelGGL(k_checksum, dim3(2048), dim3(256), 0, stream, (const unsigned*)(r[i].in_out ? (char*)d_out : (char*)d_ws + r[i].off), r[i].bytes / 4, tab + (size_t)pass * N_PHASES * 4 + p * 4 + i); }
    hipLaunchKernelGGL(k_zero_out, dim3(2048), dim3(256), 0, stream, (float*)d_out, (size_t)T * D);
    hipLaunchKernelGGL(k_report, dim3(1), dim3(64), 0, stream, tab, N_PHASES * 4, (float*)d_out);
#elif MK_ONE_LAUNCH
    a.ph_lo = 0; a.ph_hi = N_PHASES;
    hipLaunchKernelGGL(fwd_kernel, dim3(grid), dim3(NTHR), LDS_BYTES, stream, a);
#else
    for (int p = 0; p < N_PHASES; ++p) { a.ph_lo = p; a.ph_hi = p + 1; hipLaunchKernelGGL(fwd_kernel, dim3(grid), dim3(NTHR), LDS_BYTES, stream, a); }
#endif
}
```

```cpp
#include <hip/hip_runtime.h>
#include <cstdio>
#include <cstdint>

#ifndef MK_ONE_LAUNCH
#define MK_ONE_LAUNCH 1
#endif

#define GAS __attribute__((address_space(1)))
#define LAS __attribute__((address_space(3)))
typedef unsigned short bf16_t;
typedef short bf16x8 __attribute__((ext_vector_type(8)));
typedef short s16x4 __attribute__((ext_vector_type(4)));
typedef float f32x4 __attribute__((ext_vector_type(4)));
typedef float f32x2 __attribute__((ext_vector_type(2)));
typedef float f32x16 __attribute__((ext_vector_type(16)));
typedef unsigned u32x4 __attribute__((ext_vector_type(4)));
typedef unsigned u32x2 __attribute__((ext_vector_type(2)));

constexpr int D = 1024, TP = 16384, TS = 65536, T = TP + TS, SP = 8192, SS = 2048;
constexpr int NL = 4;
constexpr int NWAVES = 8, NTHR = 512;
constexpr float DN_ALPHA = 1.681792830507429f;
constexpr float LN_EPS = 1e-5f, RMS_EPS = 1e-6f;
constexpr float MLA_SCALE = 0.07216878364870323f;
constexpr int NEXP = 16384;

constexpr size_t MiB = 1u << 20;
constexpr size_t WS_CTL = 0, CTL_ZERO_BYTES = 64 * 1024;
constexpr size_t WS_ROPE = 1 * MiB;
constexpr size_t WS_MISC = 3 * MiB;
constexpr size_t WS_W = 4 * MiB;
constexpr size_t W_WA = WS_W;
constexpr size_t W_WUQ = W_WA + 2 * (size_t)768 * 1024 * 2;
constexpr size_t W_WUKV = W_WUQ + 2 * (size_t)1536 * 384 * 2;
constexpr size_t W_WO = W_WUKV + 2 * (size_t)2048 * 256 * 2;
constexpr size_t W_HIN = W_WO + 2 * (size_t)1024 * 1024 * 2;
constexpr size_t W_HO = W_HIN + 2 * (size_t)5120 * 1024 * 2;
constexpr size_t W_PQ = W_HO + 2 * (size_t)1024 * 1024 * 2;
constexpr size_t W_GW = W_PQ + 4 * (size_t)2048 * 1024 * 2;
constexpr size_t W_PP = W_GW + 4 * (size_t)1024 * 1024 * 2;
constexpr size_t W_KEYS = W_PP + 4 * (size_t)1024 * 256 * 2;
constexpr size_t W_END = W_KEYS + 4 * (size_t)2 * 128 * 128 * 2;
static_assert(W_END <= 68 * MiB, "weights region");
constexpr size_t WS_R2 = 68 * MiB;
constexpr size_t R2_UB = WS_R2, R2_VB = WS_R2 + 16 * MiB, R2_SU = WS_R2 + 32 * MiB, R2_SV = WS_R2 + 33 * MiB, R2_IDX = WS_R2 + 64 * MiB, R2_GATE = WS_R2 + 104 * MiB, R2_PB = WS_R2 + 144 * MiB;
constexpr size_t WS_XB = 252 * MiB;
constexpr size_t WS_BIG = 412 * MiB;
constexpr size_t WS_END = WS_BIG + 800 * MiB;
constexpr size_t B_Q = WS_BIG, B_KV = WS_BIG + 240 * MiB, B_O = WS_BIG + 560 * MiB, B_KROPE = WS_BIG + 720 * MiB;
constexpr size_t B_A32 = WS_BIG + 240 * MiB, B_CQN = WS_BIG + 560 * MiB, B_CKVN = WS_BIG + 620 * MiB, B_H32_MLA = WS_BIG;
constexpr size_t B_PLANE = WS_BIG, PLANE_BYTES = 160 * MiB, B_H32_HGRN = WS_BIG + 160 * MiB;
constexpr size_t B_PQ = WS_BIG, B_PP = WS_BIG + 320 * MiB, B_X8 = WS_BIG + 480 * MiB, B_XS = WS_BIG + 560 * MiB;

constexpr int LDS_BYTES = 160 * 1024;
constexpr int LDS_MISC_OFF = LDS_BYTES - 256;

typedef __bf16 bf16x2_n __attribute__((ext_vector_type(2)));
__device__ __forceinline__ unsigned cvt_pk_bf16(float lo, float hi) { const f32x2 v = {lo, hi}; const bf16x2_n b = __builtin_convertvector(v, bf16x2_n); return __builtin_bit_cast(unsigned, b); }
__device__ __forceinline__ bf16_t f2bf(float f) { return (bf16_t)(cvt_pk_bf16(f, 0.f) & 0xffffu); }
__device__ __forceinline__ float bf2f(bf16_t b) { return __uint_as_float(((unsigned)b) << 16); }
__device__ __forceinline__ float bflo(unsigned w) { return __uint_as_float(w << 16); }
__device__ __forceinline__ float bfhi(unsigned w) { return __uint_as_float(w & 0xffff0000u); }
#define DPPF(v, ctrl) __int_as_float(__builtin_amdgcn_update_dpp(0, __float_as_int(v), (ctrl), 0xf, 0xf, true))
__device__ __forceinline__ float row16_sum(float v) { v += DPPF(v, 0xB1); v += DPPF(v, 0x4E); v += DPPF(v, 0x141); v += DPPF(v, 0x140); return v; }
__device__ __forceinline__ float wave_sum(float v) { v = row16_sum(v);
    { auto r = __builtin_amdgcn_permlane16_swap(__float_as_uint(v), __float_as_uint(v), false, false); v = __uint_as_float(r[0]) + __uint_as_float(r[1]); }
    { auto r = __builtin_amdgcn_permlane32_swap(__float_as_uint(v), __float_as_uint(v), false, false); v = __uint_as_float(r[0]) + __uint_as_float(r[1]); }
    return v; }
__device__ __forceinline__ float wave_max(float v) { v = fmaxf(v, DPPF(v, 0xB1)); v = fmaxf(v, DPPF(v, 0x4E)); v = fmaxf(v, DPPF(v, 0x141)); v = fmaxf(v, DPPF(v, 0x140));
    { auto r = __builtin_amdgcn_permlane16_swap(__float_as_uint(v), __float_as_uint(v), false, false); v = fmaxf(__uint_as_float(r[0]), __uint_as_float(r[1])); }
    { auto r = __builtin_amdgcn_permlane32_swap(__float_as_uint(v), __float_as_uint(v), false, false); v = fmaxf(__uint_as_float(r[0]), __uint_as_float(r[1])); }
    return v; }
__device__ __forceinline__ float fast_exp(float x) { return __builtin_amdgcn_exp2f(x * 1.4426950408889634f); }
__device__ __forceinline__ float fast_log(float x) { return __builtin_amdgcn_logf(x) * 0.6931471805599453f; }
__device__ __forceinline__ float fast_rcp(float x) { return __builtin_amdgcn_rcpf(x); }
__device__ __forceinline__ float sigmoidf_(float x) { return fast_rcp(1.0f + fast_exp(-x)); }
__device__ __forceinline__ float siluf_(float x) { return x * sigmoidf_(x); }
#define LDS_WAIT() asm volatile("s_waitcnt lgkmcnt(0)" ::: "memory")
#define VM_WAIT() asm volatile("s_waitcnt vmcnt(0)" ::: "memory")
__device__ __forceinline__ int opaque_lane() { int l; asm volatile("v_mbcnt_lo_u32_b32 %0, -1, 0\n\tv_mbcnt_hi_u32_b32 %0, -1, %0" : "=v"(l)); return l; }
__device__ __forceinline__ int opaque_tid(int wave_s) { asm volatile("" : "+s"(wave_s)); return (wave_s << 6) + opaque_lane(); }
__device__ __forceinline__ int opaque_bid() { int b = (int)blockIdx.x; asm volatile("" : "+s"(b)); return b; }
struct Args { const float* in[25]; float* out; unsigned char* ws; int ph_lo, ph_hi; };
#define XB_TMO      128
#define XB_XCNT(j)  (256  + 64 * (j))
#define XB_XSUB(j)  (1280 + 64 * (j))
#define XB_XGEN(j)  (2304 + 64 * (j))
#define XB_TOP      3328
#define XB_TOPGEN   3392
#define XCD_BAR_WORDS 3456
#define XB_SPIN_CAP (1u << 23)

__device__ __forceinline__ unsigned xb_ld(unsigned* p)              { return __hip_atomic_load(p, __ATOMIC_RELAXED, __HIP_MEMORY_SCOPE_AGENT); }
__device__ __forceinline__ unsigned xb_add(unsigned* p, unsigned v) { return __hip_atomic_fetch_add(p, v, __ATOMIC_RELAXED, __HIP_MEMORY_SCOPE_AGENT); }
__device__ __forceinline__ unsigned xb_xcc_id() { return (unsigned)__builtin_amdgcn_s_getreg((3 << 11) | 20) & 0xFu; }
#define XB_SPIN(cond, bar) do { unsigned _sp = 0; while (cond) { __builtin_amdgcn_s_sleep(1); \
    if ((++_sp & 255u) == 0u) { if (xb_ld(&(bar)[XB_TMO])) break; if (_sp > XB_SPIN_CAP) { atomicAdd(&(bar)[XB_TMO], 1u); break; } } } } while (0)

struct XcdBarrier {
    unsigned* bar; unsigned x;
    volatile LAS unsigned* st;
};

__device__ __forceinline__ XcdBarrier xcd_barrier_post(unsigned* bar, volatile LAS unsigned* st) {
    XcdBarrier b; b.bar = bar; b.x = xb_xcc_id(); b.st = st;
    if (threadIdx.x == 0) (void)xb_add(&bar[XB_XCNT(b.x)], 1u);
    return b;
}
__device__ __forceinline__ void xcd_barrier_complete(unsigned* bar, unsigned x, unsigned& nloc, unsigned& nx) {
    const unsigned G = gridDim.x * gridDim.y * gridDim.z;
    unsigned sum, cnt, mine, sp = 0u;
    for (;;) {
        sum = 0u; cnt = 0u; mine = 0u;
#pragma unroll
        for (unsigned j = 0; j < 16; ++j) { const unsigned c = xb_ld(&bar[XB_XCNT(j)]); sum += c; cnt += (c > 0u) ? 1u : 0u; mine = (j == x) ? c : mine; }
        if (sum == G) break;
        __builtin_amdgcn_s_sleep(1);
        if ((++sp & 255u) == 0u) { if (xb_ld(&bar[XB_TMO])) break; if (sp > XB_SPIN_CAP) { atomicAdd(&bar[XB_TMO], 1u); break; } }
    }
    nloc = mine > 0u ? mine : 1u; nx = cnt > 0u ? cnt : 1u;
}

__device__ __forceinline__ void xcd_barrier(const XcdBarrier& b) {
    asm volatile("s_waitcnt vmcnt(0)" ::: "memory");
    __syncthreads();
    if (threadIdx.x == 0) {
        unsigned* bar = b.bar;
        __builtin_amdgcn_s_waitcnt(0);
        unsigned nloc = b.st[0], nx = b.st[1];
        if (nloc == 0u) { xcd_barrier_complete(bar, b.x, nloc, nx); b.st[0] = nloc; b.st[1] = nx; }
        const unsigned old = xb_add(&bar[XB_XSUB(b.x)], 1u);
        const unsigned gen = old / nloc;
        if (old + 1u == (gen + 1u) * nloc) {
            __builtin_amdgcn_fence(__ATOMIC_RELEASE, "agent");
            asm volatile("s_waitcnt vmcnt(0)" ::: "memory");
            const unsigned og = xb_add(&bar[XB_TOP], 1u);
            const unsigned tg = og / nx;
            if (og + 1u == (tg + 1u) * nx) xb_add(&bar[XB_TOPGEN], 1u);
            else XB_SPIN(xb_ld(&bar[XB_TOPGEN]) == tg, bar);
            __builtin_amdgcn_fence(__ATOMIC_ACQUIRE, "agent");
            xb_add(&bar[XB_XGEN(b.x)], 1u);
            asm volatile("s_waitcnt vmcnt(0)" ::: "memory");
        } else {
            XB_SPIN(xb_ld(&bar[XB_XGEN(b.x)]) == gen, bar);
            __builtin_amdgcn_fence(__ATOMIC_ACQUIRE, "agent");
            asm volatile("s_waitcnt vmcnt(0)" ::: "memory");
        }
    }
    __syncthreads();
}
namespace pg8 {
#define PG8_LAS __attribute__((address_space(3)))
constexpr int BM = 256, BK = 64, HALF = 128, HTB = HALF * BK * 2  , STAGE_BYTES = 8 * HTB, NXCD = 8, WGM = 8;

__host__ __device__ __forceinline__ int lds_byte(int r, int c) { const int st = (r >> 4) * 2 + (c >> 5), rr = r & 15, cc = c & 31, ob = rr * 64 + cc * 2; return st * 1024 + (ob ^ (((ob >> 9) & 1) << 5)); }
__host__ __device__ __forceinline__ void stage_rc(int b, int& R, int& C) { const int st = b / 1024, sb = b % 1024, swz = sb ^ (((sb >> 9) & 1) << 5); R = (st >> 1) * 16 + swz / 64; C = (st & 1) * 32 + (swz % 64) / 2; }
__host__ __device__ __forceinline__ int perm32(int rho) { const int n = rho >> 4, i = rho & 15; return 8 * (i >> 2) + 4 * n + (i & 3); }

struct Unit { int pm, pn; };
struct Gemm { const bf16_t* A; const bf16_t* Bt; int M, N, K; };

struct StaticOrder {
    int nM, nN, nwg, G, c;
    __host__ __device__ void init(int M, int N, int G_, int c_) { nM = M / BM; nN = N / BM; nwg = nM * nN; G = G_; c = c_; }
    __host__ __device__ bool next(int i, Unit& u) const {
        const long L = (long)i * G + c; if (L >= nwg) return false;
        int wgid = (int)L; { const int q = nwg / NXCD, r = nwg % NXCD, xcd = wgid % NXCD, off = wgid / NXCD; wgid = (xcd < r ? xcd * (q + 1) : r * (q + 1) + (xcd - r) * q) + off; }
        const int nig = WGM * nN, gid = wgid / nig, fm = gid * WGM, gsz = (nM - fm) < WGM ? (nM - fm) : WGM;
        u.pm = fm + ((wgid % nig) % gsz); u.pn = (wgid % nig) / gsz; return true;
    }
    __device__ __forceinline__ void a_ready(const Unit&) const {}
    __device__ __forceinline__ void done(const Unit&) const {}
};
template <class Epi, class Sched>
__device__ __forceinline__ void gemm_phase(PG8_LAS unsigned char* lds, const Gemm g, const Sched& S, const Epi& E, const int tid) {
    const int wid = __builtin_amdgcn_readfirstlane(tid >> 6), lane = tid & 63, wr = wid >> 2, wc = wid & 3, fr = lane & 15, fq = lane >> 4;
    const int K = g.K, nt = K / BK;
    unsigned voffA[2], voffB[2];
#pragma unroll
    for (int i = 0; i < 2; ++i) { int R, C; stage_rc(tid * 16 + i * 8192, R, C); const int Rb = Epi::PERM ? ((R & ~31) + perm32(R & 31)) : R;
        voffA[i] = (unsigned)(R * K + C) * 2u; voffB[i] = (unsigned)(Rb * K + C) * 2u; }
    const size_t kstep = (size_t)(BK * 2);
    const size_t hstep = (size_t)HALF * K * 2;
    const size_t tstep = 2 * hstep;
    const unsigned ldsw = (unsigned)wid * 1024u;
    const int aoff = lds_byte(wr * 64 + fr, fq * 8), boff = lds_byte(wc * 32 + fr, fq * 8);
#define PG8_SA(b, h) (((b) * 2 + (h)) * HTB)
#define PG8_SB(b, h) ((4 + (b) * 2 + (h)) * HTB)
#define PG8_STAGE(bufoff, gbase, voff) do { _Pragma("unroll") for (int _i = 0; _i < 2; ++_i) \
        __builtin_amdgcn_global_load_lds((const unsigned*)((const char*)(gbase) + (voff)[_i]), (PG8_LAS unsigned*)(lds + (bufoff) + ldsw + _i * 8192), 16, 0, 0); } while (0)
#define PG8_LDA(dst, b, h) do { _Pragma("unroll") for (int m = 0; m < 4; ++m) _Pragma("unroll") for (int k = 0; k < 2; ++k) dst[m][k] = *(const PG8_LAS bf16x8*)(lds + PG8_SA(b, h) + aoff + m * 2048 + k * 1024); } while (0)
#define PG8_LDB(dst, b, h) do { _Pragma("unroll") for (int n = 0; n < 2; ++n) _Pragma("unroll") for (int k = 0; k < 2; ++k) dst[n][k] = *(const PG8_LAS bf16x8*)(lds + PG8_SB(b, h) + boff + n * 2048 + k * 1024); } while (0)
#define PG8_MMA(ai, bj, At, Bt) do { __builtin_amdgcn_s_setprio(1); _Pragma("unroll") for (int m = 0; m < 4; ++m) _Pragma("unroll") for (int n = 0; n < 2; ++n) _Pragma("unroll") for (int k = 0; k < 2; ++k) \
        acc[ai][bj][m][n] = __builtin_amdgcn_mfma_f32_16x16x32_bf16(Bt[n][k], At[m][k], acc[ai][bj][m][n], 0, 0, 0); __builtin_amdgcn_s_setprio(0); } while (0)
#define PG8_WAIT_V(n) asm volatile("s_waitcnt vmcnt(" #n ")" ::: "memory")
#define PG8_WAIT_L(n) asm volatile("s_waitcnt lgkmcnt(" #n ")" ::: "memory")
#define PG8_BAR __builtin_amdgcn_s_barrier()
#define PG8_SCHED __builtin_amdgcn_sched_barrier(0)
    Unit cur, nxt; int ui = 0;
    if (!S.next(0, cur)) return;
    f32x4 acc[2][2][4][2];
#pragma unroll
    for (int a = 0; a < 2; ++a)
#pragma unroll
        for (int b = 0; b < 2; ++b)
#pragma unroll
            for (int m = 0; m < 4; ++m)
#pragma unroll
                for (int n = 0; n < 2; ++n) acc[a][b][m][n] = (f32x4){0.f, 0.f, 0.f, 0.f};
    bf16x8 At[4][2], B0[2][2], B1[2][2];
    const char* cA = (const char*)g.A + (size_t)cur.pm * tstep; const char* cB = (const char*)g.Bt + (size_t)cur.pn * tstep;
    S.a_ready(cur);
    PG8_STAGE(PG8_SB(0, 0), cB, voffB); PG8_STAGE(PG8_SA(0, 0), cA, voffA); PG8_STAGE(PG8_SB(0, 1), cB + hstep, voffB); PG8_STAGE(PG8_SA(0, 1), cA + hstep, voffA);
    if (wr == 1) PG8_BAR;
    PG8_WAIT_V(4); PG8_BAR;
    PG8_STAGE(PG8_SB(1, 0), cB + kstep, voffB); PG8_STAGE(PG8_SA(1, 0), cA + kstep, voffA); PG8_STAGE(PG8_SB(1, 1), cB + hstep + kstep, voffB);
    PG8_WAIT_V(6); PG8_BAR;
    for (;;) {
        const bool has_next = S.next(ui + 1, nxt);
        const char* nA = has_next ? (const char*)g.A + (size_t)nxt.pm * tstep : cA; const char* nB = has_next ? (const char*)g.Bt + (size_t)nxt.pn * tstep : cB;
        for (int t = 0; t < nt; t += 2) {
            const bool last = (t == nt - 2);
            const char* a1 = cA + (size_t)(t + 1) * kstep;
            const char* a2 = last ? nA : cA + (size_t)(t + 2) * kstep; const char* b2 = last ? nB : cB + (size_t)(t + 2) * kstep;
            const char* a3 = a2 + kstep; const char* b3 = b2 + kstep;
            if (last && has_next) S.a_ready(nxt);
            PG8_LDB(B0, 0, 0); PG8_SCHED; PG8_LDA(At, 0, 0); PG8_STAGE(PG8_SA(1, 1), a1 + hstep, voffA);
            PG8_WAIT_L(8); PG8_BAR; PG8_WAIT_L(0); PG8_MMA(0, 0, At, B0); PG8_BAR; PG8_SCHED;
            PG8_LDB(B1, 0, 1); PG8_STAGE(PG8_SB(0, 0), b2, voffB);
            PG8_BAR; PG8_WAIT_L(0); PG8_MMA(0, 1, At, B1); PG8_BAR;
            PG8_LDA(At, 0, 1); PG8_STAGE(PG8_SA(0, 0), a2, voffA);
            PG8_BAR; PG8_WAIT_L(0); PG8_MMA(1, 0, At, B0); PG8_BAR; PG8_SCHED;
            PG8_STAGE(PG8_SB(0, 1), b2 + hstep, voffB);
            PG8_WAIT_V(6); PG8_BAR; PG8_MMA(1, 1, At, B1); PG8_BAR;
            PG8_LDB(B0, 1, 0); PG8_SCHED; PG8_LDA(At, 1, 0); PG8_STAGE(PG8_SA(0, 1), a2 + hstep, voffA);
            PG8_WAIT_L(8); PG8_BAR; PG8_WAIT_L(0); PG8_MMA(0, 0, At, B0); PG8_BAR; PG8_SCHED;
            PG8_LDB(B1, 1, 1); PG8_STAGE(PG8_SB(1, 0), b3, voffB);
            PG8_BAR; PG8_WAIT_L(0); PG8_MMA(0, 1, At, B1); PG8_BAR;
            PG8_LDA(At, 1, 1); PG8_STAGE(PG8_SA(1, 0), a3, voffA);
            PG8_BAR; PG8_WAIT_L(0); PG8_MMA(1, 0, At, B0); PG8_BAR; PG8_SCHED;
            PG8_STAGE(PG8_SB(1, 1), b3 + hstep, voffB);
            PG8_WAIT_V(6); PG8_BAR; PG8_MMA(1, 1, At, B1); PG8_BAR;
        }
        E(acc, cur, wr, wc, fr, fq); S.done(cur);
        if (!has_next) break;
#pragma unroll
        for (int a = 0; a < 2; ++a)
#pragma unroll
            for (int b = 0; b < 2; ++b)
#pragma unroll
                for (int m = 0; m < 4; ++m)
#pragma unroll
                    for (int n = 0; n < 2; ++n) acc[a][b][m][n] = (f32x4){0.f, 0.f, 0.f, 0.f};
        cur = nxt; cA = nA; cB = nB; ++ui;
    }
    PG8_WAIT_V(0);
    if (wr == 0) PG8_BAR;
    PG8_BAR;
#undef PG8_SA
#undef PG8_SB
#undef PG8_STAGE
#undef PG8_LDA
#undef PG8_LDB
#undef PG8_MMA
#undef PG8_WAIT_V
#undef PG8_WAIT_L
#undef PG8_BAR
#undef PG8_SCHED
}
struct EpiF32 {
    static constexpr bool PERM = false;
    float* C; int ldc;
    __device__ __forceinline__ void operator()(const f32x4 (&acc)[2][2][4][2], const Unit& u, int wr, int wc, int fr, int fq) const {
        const int row0 = u.pm * BM + wr * 64 + fr, col0 = u.pn * BM + wc * 32 + 4 * fq;
#pragma unroll
        for (int ai = 0; ai < 2; ++ai)
#pragma unroll
            for (int m = 0; m < 4; ++m) { float* rowp = C + (size_t)(row0 + ai * HALF + m * 16) * ldc + col0;
#pragma unroll
                for (int bj = 0; bj < 2; ++bj)
#pragma unroll
                    for (int n = 0; n < 2; ++n) *(f32x4*)(rowp + bj * HALF + n * 16) = acc[ai][bj][m][n]; }
    }
};
struct EpiBf16P {
    static constexpr bool PERM = true;
    bf16_t* O; int ldc;
    __device__ __forceinline__ void operator()(const f32x4 (&acc)[2][2][4][2], const Unit& u, int wr, int wc, int fr, int fq) const {
        const int row0 = u.pm * BM + wr * 64 + fr, col0 = u.pn * BM + wc * 32 + 8 * fq;
#pragma unroll
        for (int ai = 0; ai < 2; ++ai)
#pragma unroll
            for (int m = 0; m < 4; ++m) { bf16_t* rowp = O + (size_t)(row0 + ai * HALF + m * 16) * ldc + col0;
#pragma unroll
                for (int bj = 0; bj < 2; ++bj) { const f32x4 v0 = acc[ai][bj][m][0], v1 = acc[ai][bj][m][1];
                    u32x4 w; w.x = cvt_pk_bf16(v0[0], v0[1]); w.y = cvt_pk_bf16(v0[2], v0[3]); w.z = cvt_pk_bf16(v1[0], v1[1]); w.w = cvt_pk_bf16(v1[2], v1[3]);
                    *(u32x4*)(rowp + bj * HALF) = w; } }
    }
};
struct EpiHgrn {
    static constexpr bool PERM = true;
    bf16_t* planes; size_t plane_elems; const float* lb;
    __device__ __forceinline__ void operator()(const f32x4 (&acc)[2][2][4][2], const Unit& u, int wr, int wc, int fr, int fq) const {
        const int plane = u.pn >> 2;
        const int row0 = u.pm * BM + wr * 64 + fr, col0 = (u.pn & 3) * BM + wc * 32 + 8 * fq;
        bf16_t* base = planes + (size_t)plane * plane_elems;
        float lbv[2][8];
        if (plane == 1 || plane == 2) {
#pragma unroll
            for (int bj = 0; bj < 2; ++bj)
#pragma unroll
                for (int e = 0; e < 8; ++e) lbv[bj][e] = lb[(plane - 1) * 1024 + col0 + bj * HALF + e];
        } else {
#pragma unroll
            for (int bj = 0; bj < 2; ++bj)
#pragma unroll
                for (int e = 0; e < 8; ++e) lbv[bj][e] = 0.f;
        }
#pragma unroll
        for (int ai = 0; ai < 2; ++ai)
#pragma unroll
            for (int m = 0; m < 4; ++m) { bf16_t* rowp = base + (size_t)(row0 + ai * HALF + m * 16) * 1024 + col0;
#pragma unroll
                for (int bj = 0; bj < 2; ++bj) { float v[8];
#pragma unroll
                    for (int e = 0; e < 4; ++e) { v[e] = acc[ai][bj][m][0][e]; v[4 + e] = acc[ai][bj][m][1][e]; }
                    if (plane == 0 || plane == 4) {
#pragma unroll
                        for (int e = 0; e < 8; ++e) v[e] = siluf_(v[e]);
                    } else if (plane == 1 || plane == 2) {
#pragma unroll
                        for (int e = 0; e < 8; ++e) { const float l = lbv[bj][e]; const float f = l + (1.0f - l) * sigmoidf_(v[e]); v[e] = fast_log(fmaxf(f, 1e-30f)); }
                    }
                    u32x4 w; w.x = cvt_pk_bf16(v[0], v[1]); w.y = cvt_pk_bf16(v[2], v[3]); w.z = cvt_pk_bf16(v[4], v[5]); w.w = cvt_pk_bf16(v[6], v[7]);
                    *(u32x4*)(rowp + bj * HALF) = w; } }
    }
};
struct EpiPle {
    static constexpr bool PERM = true;
    const bf16_t* Xin; const bf16_t* PP; const float* bias; bf16_t* XbOut; float* Fout;
    __device__ __forceinline__ void operator()(const f32x4 (&acc)[2][2][4][2], const Unit& u, int wr, int wc, int fr, int fq) const {
        const int row0 = u.pm * BM + wr * 64 + fr, col0 = u.pn * BM + wc * 32 + 8 * fq;
        f32x4 bv[2][2];
#pragma unroll
        for (int bj = 0; bj < 2; ++bj)
#pragma unroll
            for (int n = 0; n < 2; ++n) bv[bj][n] = *(const f32x4*)(bias + col0 + bj * HALF + 4 * n);
        u32x4 xw[2][2], pw[2][2];
#define PLE_LD(G, B) { const size_t off_ = (size_t)(row0 + ((G) >> 2) * HALF + ((G) & 3) * 16) * 1024 + col0; \
            _Pragma("unroll") for (int bj = 0; bj < 2; ++bj) { xw[B][bj] = *(const u32x4*)(Xin + off_ + bj * HALF); pw[B][bj] = *(const u32x4*)(PP + off_ + bj * HALF); } }
        PLE_LD(0, 0)
#pragma unroll
        for (int g = 0; g < 8; ++g) {
            if (g + 1 < 8) { if ((g + 1) & 1) PLE_LD(g + 1, 1) else PLE_LD(g + 1, 0) }
            __builtin_amdgcn_sched_barrier(0);
            const int ai = g >> 2, m = g & 3; const size_t off = (size_t)(row0 + ai * HALF + m * 16) * 1024 + col0;
#pragma unroll
            for (int bj = 0; bj < 2; ++bj) { const u32x4 xv = xw[g & 1][bj], pv = pw[g & 1][bj]; float o[8];
#pragma unroll
                for (int n = 0; n < 2; ++n) { const f32x4 z = acc[ai][bj][m][n] + bv[bj][n];
                    o[4 * n + 0] = bflo(xv[2 * n]) + sigmoidf_(z[0]) * bflo(pv[2 * n]); o[4 * n + 1] = bfhi(xv[2 * n]) + sigmoidf_(z[1]) * bfhi(pv[2 * n]);
                    o[4 * n + 2] = bflo(xv[2 * n + 1]) + sigmoidf_(z[2]) * bflo(pv[2 * n + 1]); o[4 * n + 3] = bfhi(xv[2 * n + 1]) + sigmoidf_(z[3]) * bfhi(pv[2 * n + 1]); }
                const size_t o2 = off + bj * HALF;
                if (Fout) { *(f32x4*)(Fout + o2) = (f32x4){o[0], o[1], o[2], o[3]}; *(f32x4*)(Fout + o2 + 4) = (f32x4){o[4], o[5], o[6], o[7]}; }
                else { u32x4 w; w.x = cvt_pk_bf16(o[0], o[1]); w.y = cvt_pk_bf16(o[2], o[3]); w.z = cvt_pk_bf16(o[4], o[5]); w.w = cvt_pk_bf16(o[6], o[7]); *(u32x4*)(XbOut + o2) = w; } }
            __builtin_amdgcn_sched_barrier(0);
        }
#undef PLE_LD
    }
};
}
namespace attn {
constexpr int DV = 128, DQK = 192, NW = 8, QBLK = 32, KVBLK = 64;
constexpr float SCALE = MLA_SCALE;
constexpr float THR = 8.f;
constexpr int LDQ = 8 * DQK, LDKV = 8 * 256, LDKR = 64, LDO = 1024;
constexpr int KROWB = 400;
constexpr int SHM_V = KVBLK * DV * 2, SHM_K = KVBLK * KROWB, SHM_ATTN = 2 * SHM_V + 2 * SHM_K + NW * 64 * 4 + NW * 4096;
#define SBAR() __builtin_amdgcn_sched_barrier(0)
__device__ __forceinline__ int crow(int r, int hi) { return (r & 3) + 8 * (r >> 2) + 4 * hi; }

__device__ __forceinline__ void partialSM(f32x16& p0, f32x16& p1, float& m_reg, float& mn, float& alpha) {
  constexpr float C = SCALE * 1.4426950408889634f;
  float pmax = p0[0];
#pragma unroll
  for (int r = 1; r < 16; ++r) pmax = fmaxf(pmax, p0[r]);
#pragma unroll
  for (int r = 0; r < 16; ++r) pmax = fmaxf(pmax, p1[r]);
  { auto rr = __builtin_amdgcn_permlane32_swap(__float_as_uint(pmax), __float_as_uint(pmax), false, false);
    pmax = fmaxf(__uint_as_float(rr[0]), __uint_as_float(rr[1])); }
  if (__builtin_expect(__all(pmax - m_reg <= THR / SCALE), 1)) { mn = m_reg; alpha = 1.f; }
  else { mn = fmaxf(m_reg, pmax); alpha = __builtin_amdgcn_exp2f((m_reg - mn) * C); m_reg = mn; }
  float mnC = -mn * C;
#pragma unroll
  for (int r = 0; r < 16; ++r) p0[r] = fmaf(p0[r], C, mnC);
#pragma unroll
  for (int r = 0; r < 16; ++r) p1[r] = fmaf(p1[r], C, mnC);
#pragma unroll
  for (int r = 0; r < 16; ++r) p0[r] = __builtin_amdgcn_exp2f(p0[r]);
}
__device__ __forceinline__ void finishSM(f32x16& p0, f32x16& p1, float alpha, float& l_reg, bf16x8& pa0, bf16x8& pa1, bf16x8& pa2, bf16x8& pa3) {
#pragma unroll
  for (int r = 0; r < 16; ++r) p1[r] = __builtin_amdgcn_exp2f(p1[r]);
  float ps = 0;
#pragma unroll
  for (int r = 0; r < 16; ++r) ps += p0[r];
#pragma unroll
  for (int r = 0; r < 16; ++r) ps += p1[r];
  { auto rr = __builtin_amdgcn_permlane32_swap(__float_as_uint(ps), __float_as_uint(ps), false, false);
    ps = __uint_as_float(rr[0]) + __uint_as_float(rr[1]); }
  l_reg = l_reg * alpha + ps;
#define PK4(P, BASE, OUT) do { unsigned a0 = cvt_pk_bf16(P[BASE + 0], P[BASE + 1]), a1 = cvt_pk_bf16(P[BASE + 2], P[BASE + 3]);   \
    unsigned b0 = cvt_pk_bf16(P[BASE + 4], P[BASE + 5]), b1 = cvt_pk_bf16(P[BASE + 6], P[BASE + 7]);                              \
    auto r0 = __builtin_amdgcn_permlane32_swap(a0, b0, false, false); auto r1 = __builtin_amdgcn_permlane32_swap(a1, b1, false, false); \
    u32x4 w = {r0[0], r1[0], r0[1], r1[1]}; OUT = *reinterpret_cast<bf16x8*>(&w); } while (0)
  PK4(p0, 0, pa0); PK4(p0, 8, pa1); PK4(p1, 0, pa2); PK4(p1, 8, pa3);
#undef PK4
}
__device__ __forceinline__ void qkt(f32x16& p0, f32x16& p1, const char* Ks, const bf16x8* qr, const char* qrl, int r32, int hi) {
  p0 = f32x16{}; p1 = f32x16{};
  const char* k0 = Ks + r32 * KROWB + hi * 16; const char* k1 = Ks + (32 + r32) * KROWB + hi * 16;
  bf16x8 fa[2], fb[2], ga[2], gb[2], qx[2], qy[2];
#define QK_LD(FA, FB, QX, G) _Pragma("unroll") for (int i = 0; i < 2; ++i) { FA[i] = *reinterpret_cast<const bf16x8*>(k0 + ((G) * 2 + i) * 32); FB[i] = *reinterpret_cast<const bf16x8*>(k1 + ((G) * 2 + i) * 32); \
      if ((G) * 2 + i >= 8) QX[i] = *reinterpret_cast<const bf16x8*>(qrl + ((G) * 2 + i - 8) * 1024); }
#define QK_MM(FA, FB, QX, G) _Pragma("unroll") for (int i = 0; i < 2; ++i) { const bf16x8 qf = ((G) * 2 + i < 8) ? qr[((G) * 2 + i < 8) ? (G) * 2 + i : 0] : QX[i]; \
      p0 = __builtin_amdgcn_mfma_f32_32x32x16_bf16(FA[i], qf, p0, 0, 0, 0); p1 = __builtin_amdgcn_mfma_f32_32x32x16_bf16(FB[i], qf, p1, 0, 0, 0); }
  QK_LD(fa, fb, qx, 0) SBAR();
  QK_LD(ga, gb, qy, 1) SBAR(); QK_MM(fa, fb, qx, 0) SBAR();
  QK_LD(fa, fb, qx, 2) SBAR(); QK_MM(ga, gb, qy, 1) SBAR();
  QK_LD(ga, gb, qy, 3) SBAR(); QK_MM(fa, fb, qx, 2) SBAR();
  QK_LD(fa, fb, qx, 4) SBAR(); QK_MM(ga, gb, qy, 3) SBAR();
  QK_LD(ga, gb, qy, 5) SBAR(); QK_MM(fa, fb, qx, 4) SBAR();
  QK_MM(ga, gb, qy, 5) SBAR();
#undef QK_LD
#undef QK_MM
}
__device__ __forceinline__ int v_st(int k, int c) { const int kk = (k & ~0xC) | ((k & 4) << 1) | ((k & 8) >> 1); return ((kk >> 3) * 4 + (c >> 5)) * 512 + ((kk & 7) * 32 + (c & 31)) * 2; }
__device__ __forceinline__ int v_rd_base(int lane) { return ((lane & 3) << 3) | (((lane >> 2) & 3) << 6) | (((lane >> 4) & 1) << 5) | (((lane >> 5) & 1) << 8); }
constexpr int v_rd_off(int d0, int ks, int half) { return d0 * 512 + ks * 4096 + half * 2048; }
template <int OFF> __device__ __forceinline__ s16x4 tr_read(int vb) {
  s16x4 r; asm volatile("ds_read_b64_tr_b16 %0, %1 offset:%2" : "=&v"(r) : "v"(vb), "i"(OFF) : "memory"); return r;
}
template <int D0> __device__ __forceinline__ void pv_one(f32x16& od, int vb, bf16x8 pa0, bf16x8 pa1, bf16x8 pa2, bf16x8 pa3) {
  const s16x4 l0 = tr_read<v_rd_off(D0, 0, 0)>(vb), h0 = tr_read<v_rd_off(D0, 0, 1)>(vb), l1 = tr_read<v_rd_off(D0, 1, 0)>(vb), h1 = tr_read<v_rd_off(D0, 1, 1)>(vb);
  const s16x4 l2 = tr_read<v_rd_off(D0, 2, 0)>(vb), h2 = tr_read<v_rd_off(D0, 2, 1)>(vb), l3 = tr_read<v_rd_off(D0, 3, 0)>(vb), h3 = tr_read<v_rd_off(D0, 3, 1)>(vb);
  asm volatile("s_waitcnt lgkmcnt(0)" ::: "memory"); SBAR();
#define PK(L, H) (bf16x8){L[0], L[1], L[2], L[3], H[0], H[1], H[2], H[3]}
  od = __builtin_amdgcn_mfma_f32_32x32x16_bf16(pa0, PK(l0, h0), od, 0, 0, 0);
  od = __builtin_amdgcn_mfma_f32_32x32x16_bf16(pa1, PK(l1, h1), od, 0, 0, 0);
  od = __builtin_amdgcn_mfma_f32_32x32x16_bf16(pa2, PK(l2, h2), od, 0, 0, 0);
  od = __builtin_amdgcn_mfma_f32_32x32x16_bf16(pa3, PK(l3, h3), od, 0, 0, 0);
#undef PK
}
__device__ __forceinline__ void pv_d0(f32x16* o, int vb, bf16x8 pa0, bf16x8 pa1, bf16x8 pa2, bf16x8 pa3) {
  pv_one<0>(o[0], vb, pa0, pa1, pa2, pa3); pv_one<1>(o[1], vb, pa0, pa1, pa2, pa3); pv_one<2>(o[2], vb, pa0, pa1, pa2, pa3); pv_one<3>(o[3], vb, pa0, pa1, pa2, pa3);
}

template <int VAR> __device__ __forceinline__ void attn_body(const bf16_t* __restrict__ Qb, const bf16_t* __restrict__ Kn, const bf16_t* __restrict__ Kr,
                                          bf16_t* __restrict__ Ob, int seq, char* lds, int tid, int pos0, const float* __restrict__ ropeT) {
  asm volatile("" : "+v"(tid));
  const int wid = tid >> 6, lane = tid & 63, r32 = lane & 31, hi = lane >> 5;
  char* V_lds = lds; char* K_lds = lds + 2 * SHM_V;
  float* ws = (float*)(lds + 2 * SHM_V + 2 * SHM_K) + wid * 64; float* li_l = ws; float* al_l = ws + 32;
  float m_reg = -1e30f, l_reg = 0; f32x16 o[4] = {}; bf16x8 qr[8];
  char* qrl = lds + 2 * SHM_V + 2 * SHM_K + NW * 64 * 4 + wid * 4096 + lane * 16;
  const bf16_t* Qw = Qb + (long)(wid * QBLK + r32) * LDQ + hi * 8;
#pragma unroll
  for (int d0 = 0; d0 < 8; ++d0) qr[d0] = *reinterpret_cast<const bf16x8*>(Qw + d0 * 16);
  { const float* cp = ropeT + (size_t)(pos0 + wid * QBLK + r32) * 32 + hi * 8; const float* sp = cp + 8192 * 32;
#pragma unroll
    for (int dd = 0; dd < 2; ++dd) { const f32x4 c0 = *(const f32x4*)(cp + 16 * dd), c1 = *(const f32x4*)(cp + 16 * dd + 4), s0 = *(const f32x4*)(sp + 16 * dd), s1 = *(const f32x4*)(sp + 16 * dd + 4);
      const u32x4 A = *reinterpret_cast<const u32x4*>(Qw + (8 + dd) * 16), B = *reinterpret_cast<const u32x4*>(Qw + (10 + dd) * 16); u32x4 An, Bn;
#pragma unroll
      for (int w2 = 0; w2 < 4; ++w2) { const float cs0 = w2 < 2 ? c0[2 * w2] : c1[2 * w2 - 4], cs1 = w2 < 2 ? c0[2 * w2 + 1] : c1[2 * w2 - 3], sn0 = w2 < 2 ? s0[2 * w2] : s1[2 * w2 - 4], sn1 = w2 < 2 ? s0[2 * w2 + 1] : s1[2 * w2 - 3];
        const float a0 = bflo(A[w2]), a1 = bfhi(A[w2]), b0 = bflo(B[w2]), b1 = bfhi(B[w2]);
        An[w2] = cvt_pk_bf16(a0 * cs0 - b0 * sn0, a1 * cs1 - b1 * sn1); Bn[w2] = cvt_pk_bf16(b0 * cs0 + a0 * sn0, b1 * cs1 + a1 * sn1); }
      *reinterpret_cast<u32x4*>(qrl + dd * 1024) = An; *reinterpret_cast<u32x4*>(qrl + (2 + dd) * 1024) = Bn; } }
  const bf16_t* Vh = Kn + 128;
  const int sr = tid >> 4, sc = (tid & 15) * 8, vst0 = v_st(sr, sc), vst1 = v_st(32 + sr, sc);
  int krow[3], kcc[3];
#pragma unroll
  for (int i = 0; i < 3; ++i) { const int id = tid + 512 * i; krow[i] = id / 24; kcc[i] = id % 24; }
  const int vb0 = (int)(uintptr_t)V_lds + v_rd_base(lane);
  bf16x8 vs0, vs1, ks0, ks1, ks2;
#define KSRC(i, k0) (kcc[i] < 16 ? (Kn + (long)((k0) + krow[i]) * LDKV + kcc[i] * 8) : (Kr + (long)((k0) + krow[i]) * LDKR + (kcc[i] - 16) * 8))
#define SLOAD(k0) do { vs0 = *reinterpret_cast<const bf16x8*>(&Vh[(long)((k0) + sr) * LDKV + sc]); vs1 = *reinterpret_cast<const bf16x8*>(&Vh[(long)((k0) + 32 + sr) * LDKV + sc]); \
    ks0 = *reinterpret_cast<const bf16x8*>(KSRC(0, k0)); ks1 = *reinterpret_cast<const bf16x8*>(KSRC(1, k0)); ks2 = *reinterpret_cast<const bf16x8*>(KSRC(2, k0)); } while (0)
#define SWRITE(b) do { *(bf16x8*)(V_lds + (b) * SHM_V + vst0) = vs0; *(bf16x8*)(V_lds + (b) * SHM_V + vst1) = vs1; \
    *(bf16x8*)(K_lds + (b) * SHM_K + krow[0] * KROWB + kcc[0] * 16) = ks0; *(bf16x8*)(K_lds + (b) * SHM_K + krow[1] * KROWB + kcc[1] * 16) = ks1; \
    *(bf16x8*)(K_lds + (b) * SHM_K + krow[2] * KROWB + kcc[2] * 16) = ks2; } while (0)
#define SWAIT() asm volatile("s_waitcnt vmcnt(0)" ::: "memory")
#define RESC(a) do { if (__any((a) < 1.f)) { if (hi == 0) al_l[r32] = (a); asm volatile("s_waitcnt lgkmcnt(0)" ::: "memory"); \
    _Pragma("unroll") for (int d = 0; d < 4; ++d) _Pragma("unroll") for (int r = 0; r < 16; ++r) o[d][r] *= al_l[crow(r, hi)]; } } while (0)
  f32x16 pA0, pA1; float mnA, alA; bf16x8 pa0, pa1, pa2, pa3; const int NT = seq / KVBLK;
  SLOAD(0); SWAIT(); SWRITE(0); __syncthreads();
  for (int j = 0; j < NT; ++j) {
    const int b = j & 1;
    if (VAR != 4) { if (j + 1 < NT) SLOAD((j + 1) * KVBLK); }
    if (VAR != 3) { SBAR(); qkt(pA0, pA1, K_lds + b * SHM_K, qr, qrl, r32, hi); } else { pA0 = f32x16{}; pA1 = f32x16{}; pA0[0] = (float)j; }
    if (VAR != 2) { partialSM(pA0, pA1, m_reg, mnA, alA);
      RESC(alA);
      finishSM(pA0, pA1, alA, l_reg, pa0, pa1, pa2, pa3); SBAR(); }
    else { u32x4 w0 = {__float_as_uint(pA0[0]), __float_as_uint(pA0[5]), __float_as_uint(pA1[3]), __float_as_uint(pA1[9])}; pa0 = *reinterpret_cast<bf16x8*>(&w0); pa1 = pa0; pa2 = pa0; pa3 = pa0; l_reg += pA0[1]; }
    if (VAR != 1) pv_d0(o, vb0 + b * (int)SHM_V, pa0, pa1, pa2, pa3); else o[0][0] += bf2f((bf16_t)pa0[0]) + bf2f((bf16_t)pa3[7]);
    if (VAR != 4) { if (j + 1 < NT) { SWAIT(); SWRITE(b ^ 1); } }
    __syncthreads();
  }
  if (hi == 0) li_l[r32] = l_reg; asm volatile("s_waitcnt lgkmcnt(0)" ::: "memory");
  float rli[16];
#pragma unroll
  for (int r = 0; r < 16; ++r) rli[r] = __builtin_amdgcn_rcpf(li_l[crow(r, hi)]);
  bf16_t* Ow = Ob + (long)(wid * QBLK) * LDO;
#pragma unroll
  for (int r = 0; r < 16; ++r) { const int orow = crow(r, hi);
#pragma unroll
    for (int d0 = 0; d0 < 4; ++d0) Ow[(long)orow * LDO + d0 * 32 + r32] = f2bf(o[d0][r] * rli[r]); }
#undef KSRC
#undef SLOAD
#undef SWRITE
#undef SWAIT
#undef RESC
}
#undef SBAR
}
typedef const __attribute__((address_space(4))) Args* KArgs;
struct Ctx {
    KArgs a; float* out; unsigned char* ws;
    LAS unsigned char* lds;
    int tid, lane, wave, vcu, G, gw, NGW, bid;
    __device__ __forceinline__ const float* in(int i) const { return a->in[i]; }
};
__device__ __forceinline__ Ctx mk_ctx(unsigned char* lds_raw, int wave_s) {
    Ctx c; KArgs a = (KArgs)__builtin_amdgcn_kernarg_segment_ptr(); asm volatile("" : "+s"(a));
    c.a = a; c.out = a->out; c.ws = a->ws; c.lds = (LAS unsigned char*)lds_raw;
    c.tid = opaque_tid(wave_s); c.lane = c.tid & 63; c.wave = __builtin_amdgcn_readfirstlane(c.tid >> 6);
    c.G = (int)gridDim.x; c.bid = opaque_bid(); c.vcu = (c.G % 8 == 0) ? (c.bid % 8) * (c.G / 8) + c.bid / 8 : c.bid;
    c.gw = c.vcu * NWAVES + c.wave; c.NGW = c.G * NWAVES;
    return c;
}
__device__ __forceinline__ int tok_pos(int t) { return t < TP ? (t & (SP - 1)) : ((t - TP) & (SS - 1)); }

__device__ __forceinline__ void transpose_item(const float* W, int K, int N, bf16_t* WT, LAS float* scr, int item, int lane) {
    const int nblk = N / 32, kb = item / nblk, nb = item % nblk, k0 = 64 * kb, n0 = 32 * nb;
#pragma unroll 8
    for (int i = 0; i < 32; ++i) { const int kk = 2 * i + (lane >> 5); scr[kk * 33 + (lane & 31)] = W[(size_t)(k0 + kk) * N + n0 + (lane & 31)]; }
    LDS_WAIT(); asm volatile("" ::: "memory");
    const int c = lane & 7;
#pragma unroll
    for (int j = 0; j < 4; ++j) { const int n = (lane >> 3) + 8 * j; const LAS float* s = scr + (8 * c) * 33 + n;
        u32x4 o; o.x = cvt_pk_bf16(s[0 * 33], s[1 * 33]); o.y = cvt_pk_bf16(s[2 * 33], s[3 * 33]); o.z = cvt_pk_bf16(s[4 * 33], s[5 * 33]); o.w = cvt_pk_bf16(s[6 * 33], s[7 * 33]);
        *(u32x4*)(WT + (size_t)(n0 + n) * K + k0 + 8 * c) = o; }
    LDS_WAIT(); asm volatile("" ::: "memory");
}
struct MatDesc { int in_idx, K, N, Npad, copies; size_t dst; };
__device__ __forceinline__ void p0_prologue(const Ctx& c) {
    LAS float* scr = (LAS float*)(c.lds + c.wave * 16384);
    const MatDesc MATS[9] = {
        {4, 1024, 704, 768, 2, W_WA}, {7, 384, 1536, 1536, 2, W_WUQ}, {8, 256, 2048, 2048, 2, W_WUKV}, {9, 1024, 1024, 1024, 2, W_WO},
        {10, 1024, 5120, 5120, 2, W_HIN}, {13, 1024, 1024, 1024, 2, W_HO}, {14, 1024, 2048, 2048, 4, W_PQ}, {22, 1024, 1024, 1024, 4, W_GW}, {24, 256, 1024, 1024, 4, W_PP}};
    int total = 0;
#pragma unroll
    for (int m = 0; m < 9; ++m) total += MATS[m].copies * (MATS[m].K / 64) * (MATS[m].N / 32);
    for (int it = c.gw; it < total; it += c.NGW) {
        int r = it;
#pragma unroll
        for (int m = 0; m < 9; ++m) {
            const int per = (MATS[m].K / 64) * (MATS[m].N / 32), cnt = MATS[m].copies * per;
            if (r >= 0 && r < cnt) { const int cp = r / per, item = r % per;
                transpose_item(c.in(MATS[m].in_idx) + (size_t)cp * MATS[m].K * MATS[m].N, MATS[m].K, MATS[m].N,
                               (bf16_t*)(c.ws + MATS[m].dst) + (size_t)cp * MATS[m].Npad * MATS[m].K, scr, item, c.lane);
                r = -1; }
            else if (r >= 0) r -= cnt;
        }
    }
    const int gt = c.gw * 64 + c.lane, NGT = c.NGW * 64;
    for (int i = gt; i < 2 * 64 * 1024 / 8; i += NGT) { const int cp = i / (64 * 1024 / 8), o = i % (64 * 1024 / 8);
        *(u32x4*)((bf16_t*)(c.ws + W_WA) + (size_t)cp * 768 * 1024 + (size_t)704 * 1024 + o * 8) = (u32x4){0u, 0u, 0u, 0u}; }
    for (int i = gt; i < 4 * 2 * 128 * 128 / 4; i += NGT) { const f32x4 v = *(const f32x4*)(c.in(15) + (size_t)i * 4);
        u32x2 w; w.x = cvt_pk_bf16(v[0], v[1]); w.y = cvt_pk_bf16(v[2], v[3]); *(u32x2*)((bf16_t*)(c.ws + W_KEYS) + (size_t)i * 4) = w; }
    for (int i = gt; i < 8192 * 32; i += NGT) { const int pos = i >> 5, f = i & 31;
        const float inv = 1.0f / powf(10000.0f, (float)(2 * f) / 64.0f); const float ang = (float)pos * inv;
        ((float*)(c.ws + WS_ROPE))[i] = cosf(ang); ((float*)(c.ws + WS_ROPE))[8192 * 32 + i] = sinf(ang); }
    for (int i = gt; i < 2 * 1024; i += NGT) { const int dir = i >> 10, k = i & 1023;
        const float l0 = c.in(11)[(dir * 2 + 0) * 1024 + k], l1 = c.in(11)[(dir * 2 + 1) * 1024 + k];
        float* lb = (float*)(c.ws + WS_MISC);
        lb[(0 * 2 + dir) * 1024 + k] = 0.f; lb[(1 * 2 + dir) * 1024 + k] = 1.0f / (1.0f + expf(l0 - l1)); }
    for (int t = c.gw; t < T; t += c.NGW) {
        const float* xr = t < TP ? c.in(0) + (size_t)t * D : c.in(1) + (size_t)(t - TP) * D;
        bf16_t* brow = (bf16_t*)c.out + (size_t)t * D;
#pragma unroll
        for (int j = 0; j < 4; ++j) { const f32x4 v = *(const f32x4*)(xr + 256 * j + 4 * c.lane);
            u32x2 w; w.x = cvt_pk_bf16(v[0], v[1]); w.y = cvt_pk_bf16(v[2], v[3]); *(u32x2*)(brow + 256 * j + 4 * c.lane) = w; }
    }
}

__device__ __forceinline__ void cvt_range(const float* src, bf16_t* dst, size_t n8, int gt, int NGT) {
    for (size_t i = gt; i < n8; i += NGT) { const f32x4 a = *(const f32x4*)(src + i * 8), b = *(const f32x4*)(src + i * 8 + 4);
        u32x4 w; w.x = cvt_pk_bf16(a[0], a[1]); w.y = cvt_pk_bf16(a[2], a[3]); w.z = cvt_pk_bf16(b[0], b[1]); w.w = cvt_pk_bf16(b[2], b[3]); *(u32x4*)(dst + i * 8) = w; }
}
__device__ __forceinline__ void l0_convert(const Ctx& c, int layer, int gw, int NGW) {
    const int gt = gw * 64 + c.lane, NGT = NGW * 64;
    for (int r = gw; r < 2 * NEXP; r += NGW) {
        const int m = r >= NEXP, e = r - m * NEXP;
        const float* src = c.in(16 + m) + ((size_t)layer * NEXP + e) * D + 16 * c.lane;
        f32x4 v[4]; float am = 0.f;
#pragma unroll
        for (int j = 0; j < 4; ++j) { v[j] = *(const f32x4*)(src + 4 * j); am = fmaxf(am, fmaxf(fmaxf(fabsf(v[j][0]), fabsf(v[j][1])), fmaxf(fabsf(v[j][2]), fabsf(v[j][3])))); }
        am = wave_max(am);
        const float sc = fmaxf(am, 1e-30f) * (1.0f / 440.0f), inv = 1.0f / sc;
        u32x4 w;
#pragma unroll
        for (int j = 0; j < 4; ++j) { int p = 0; p = __builtin_amdgcn_cvt_pk_fp8_f32(v[j][0] * inv, v[j][1] * inv, p, false); p = __builtin_amdgcn_cvt_pk_fp8_f32(v[j][2] * inv, v[j][3] * inv, p, true); w[j] = (unsigned)p; }
        *(u32x4*)(c.ws + (m ? R2_VB : R2_UB) + (size_t)e * D + 16 * c.lane) = w;
        if (c.lane == 0) ((float*)(c.ws + (m ? R2_SV : R2_SU)))[e] = sc;
    }
    cvt_range(c.in(2) + (size_t)layer * TP * 256, (bf16_t*)(c.ws + R2_PB), (size_t)TP * 256 / 8, gt, NGT);
    cvt_range(c.in(3) + (size_t)layer * TS * 256, (bf16_t*)(c.ws + R2_PB) + (size_t)TP * 256, (size_t)TS * 256 / 8, gt, NGT);
}
__device__ __forceinline__ void l0_convert(const Ctx& c, int layer) { l0_convert(c, layer, c.gw, c.NGW); }

__device__ __forceinline__ void mla_e1(const Ctx& c, int j) {
    const bf16_t* a16 = (const bf16_t*)(c.ws + B_A32); bf16_t* cqn = (bf16_t*)(c.ws + B_CQN); bf16_t* ckvn = (bf16_t*)(c.ws + B_CKVN); bf16_t* krope = (bf16_t*)(c.ws + B_KROPE);
    const float* qnw = c.in(5) + j * 384; const float* kvnw = c.in(6) + j * 256;
    const float* cosT = (const float*)(c.ws + WS_ROPE); const float* sinT = cosT + 8192 * 32;
    const int lane = c.lane;
    constexpr int NU = 4;
    LAS float* scr = (LAS float*)(c.lds + c.wave * 1024);
    const f32x4 wA = *(const f32x4*)(qnw + 4 * lane), wB = *(const f32x4*)(lane < 32 ? qnw + 256 + 4 * lane : kvnw + 4 * (lane - 32)), wC = *(const f32x4*)(kvnw + 128 + 4 * (lane & 31));
    for (int t0 = c.gw * NU; t0 < T; t0 += c.NGW * NU) {
        f32x4 v0[NU], v1[NU], v2[NU]; float csv[NU], snv[NU];
#pragma unroll
        for (int u = 0; u < NU; ++u) { const bf16_t* ar = a16 + (size_t)(t0 + u) * 768;
            const u32x2 w0 = *(const u32x2*)(ar + 4 * lane), w1 = *(const u32x2*)(ar + 256 + 4 * lane), w2 = *(const u32x2*)(ar + 512 + 4 * lane);
            { const int pos = tok_pos(t0 + u); csv[u] = cosT[pos * 32 + (lane & 31)]; snv[u] = sinT[pos * 32 + (lane & 31)]; }
            v0[u] = (f32x4){bflo(w0.x), bfhi(w0.x), bflo(w0.y), bfhi(w0.y)}; v1[u] = (f32x4){bflo(w1.x), bfhi(w1.x), bflo(w1.y), bfhi(w1.y)}; v2[u] = (f32x4){bflo(w2.x), bfhi(w2.x), bflo(w2.y), bfhi(w2.y)}; }
#pragma unroll
        for (int u = 0; u < NU; ++u) { const int t = t0 + u;
            const float s0 = v0[u][0] * v0[u][0] + v0[u][1] * v0[u][1] + v0[u][2] * v0[u][2] + v0[u][3] * v0[u][3];
            const float s1 = v1[u][0] * v1[u][0] + v1[u][1] * v1[u][1] + v1[u][2] * v1[u][2] + v1[u][3] * v1[u][3];
            const float s2 = v2[u][0] * v2[u][0] + v2[u][1] * v2[u][1] + v2[u][2] * v2[u][2] + v2[u][3] * v2[u][3];
            const float ssq = wave_sum(s0 + (lane < 32 ? s1 : 0.f));
            const float sskv = wave_sum((lane >= 32 ? s1 : 0.f) + (lane < 32 ? s2 : 0.f));
            const float rq = 1.0f / sqrtf(ssq * (1.0f / 384.0f) + RMS_EPS), rkv = 1.0f / sqrtf(sskv * (1.0f / 256.0f) + RMS_EPS);
            { const f32x4 w = wA; u32x2 o; o.x = cvt_pk_bf16(v0[u][0] * rq * w[0], v0[u][1] * rq * w[1]); o.y = cvt_pk_bf16(v0[u][2] * rq * w[2], v0[u][3] * rq * w[3]);
              *(u32x2*)(cqn + (size_t)t * 384 + 4 * lane) = o; }
            if (lane < 32) { const f32x4 w = wB; u32x2 o; o.x = cvt_pk_bf16(v1[u][0] * rq * w[0], v1[u][1] * rq * w[1]); o.y = cvt_pk_bf16(v1[u][2] * rq * w[2], v1[u][3] * rq * w[3]);
              *(u32x2*)(cqn + (size_t)t * 384 + 256 + 4 * lane) = o; }
            else { const int ix = 4 * (lane - 32); const f32x4 w = wB; u32x2 o; o.x = cvt_pk_bf16(v1[u][0] * rkv * w[0], v1[u][1] * rkv * w[1]); o.y = cvt_pk_bf16(v1[u][2] * rkv * w[2], v1[u][3] * rkv * w[3]);
              *(u32x2*)(ckvn + (size_t)t * 256 + ix) = o; }
            if (lane < 32) { const int ix = 128 + 4 * lane; const f32x4 w = wC; u32x2 o; o.x = cvt_pk_bf16(v2[u][0] * rkv * w[0], v2[u][1] * rkv * w[1]); o.y = cvt_pk_bf16(v2[u][2] * rkv * w[2], v2[u][3] * rkv * w[3]);
              *(u32x2*)(ckvn + (size_t)t * 256 + ix) = o; }
            else if (lane < 48) { *(LAS f32x4*)(scr + 4 * (lane - 32)) = v2[u]; }
            LDS_WAIT(); asm volatile("" ::: "memory");
            if (lane < 32) { const float a = scr[lane], b = scr[lane + 32], cs = csv[u], sn = snv[u];
                krope[(size_t)t * 64 + lane] = f2bf(a * cs - b * sn); krope[(size_t)t * 64 + 32 + lane] = f2bf(b * cs + a * sn); }
            LDS_WAIT(); asm volatile("" ::: "memory"); }
    }
}
__device__ __forceinline__ void mla_qrope(const Ctx& c) {
    bf16_t* q = (bf16_t*)(c.ws + B_Q);
    const float* cosT = (const float*)(c.ws + WS_ROPE); const float* sinT = cosT + 8192 * 32;
    const int lane = c.lane, i = lane & 31;
    for (int t = c.gw; t < T; t += c.NGW) {
        const int pos = tok_pos(t); const float cs = cosT[pos * 32 + i], sn = sinT[pos * 32 + i];
#pragma unroll
        for (int k = 0; k < 4; ++k) { const int h = (lane >> 5) + 2 * k; bf16_t* p = q + (size_t)t * 1536 + h * 192 + 128 + i;
            const float a = bf2f(p[0]), b = bf2f(p[32]); p[0] = f2bf(a * cs - b * sn); p[32] = f2bf(b * cs + a * sn); }
    }
}
template <int VAR> __device__ __forceinline__ void mla_attention(const Ctx& c) {
    const bf16_t* Q = (const bf16_t*)(c.ws + B_Q); const bf16_t* KV = (const bf16_t*)(c.ws + B_KV); const bf16_t* KR = (const bf16_t*)(c.ws + B_KROPE); bf16_t* O = VAR ? (bf16_t*)c.out + (size_t)T * 1024 : (bf16_t*)(c.ws + B_O);
    const int NU = 512 + 2048;
    for (int u = c.bid; u < NU; u += c.G) {
        int tok0, qb, h, seq;
        if (u < 512) { const int round = u >> 8, cc = u & 255, bh = round * 8 + (cc & 7); tok0 = (bh >> 3) * SP; h = bh & 7; qb = cc >> 3; seq = SP; }
        else { const int us = u - 512, round = us >> 8, cc = us & 255, r = cc >> 3, bh = round * 32 + (cc & 7) * 4 + (r >> 3); tok0 = TP + (bh >> 3) * SS; h = bh & 7; qb = r & 7; seq = SS; }
        attn::attn_body<VAR>(Q + (size_t)(tok0 + qb * 256) * 1536 + h * 192, KV + (size_t)tok0 * 2048 + h * 256, KR + (size_t)tok0 * 64,
                        O + (size_t)(tok0 + qb * 256) * 1024 + h * 128, seq, (char*)c.lds, c.tid, qb * 256, (const float*)(c.ws + WS_ROPE));
        __syncthreads();
    }
}
template <int NU, bool W8> __device__ __forceinline__ void ln_rows(f32x4 (&v)[NU][4], const f32x4 (&ggv)[4], const f32x4 (&bbv)[4], int lane, bf16_t* const (&dst)[NU], unsigned char* const (&dst8)[NU], float* const (&dsc)[NU]) {
    float s[NU], s2[NU];
#pragma unroll
    for (int u = 0; u < NU; ++u) { s[u] = 0.f;
#pragma unroll
        for (int j = 0; j < 4; ++j) s[u] += (v[u][j][0] + v[u][j][1]) + (v[u][j][2] + v[u][j][3]); }
#pragma unroll
    for (int u = 0; u < NU; ++u) s[u] = wave_sum(s[u]) * (1.0f / D);
#pragma unroll
    for (int u = 0; u < NU; ++u) { s2[u] = 0.f;
#pragma unroll
        for (int j = 0; j < 4; ++j) { v[u][j] = v[u][j] - s[u]; s2[u] += (v[u][j][0] * v[u][j][0] + v[u][j][1] * v[u][j][1]) + (v[u][j][2] * v[u][j][2] + v[u][j][3] * v[u][j][3]); } }
#pragma unroll
    for (int u = 0; u < NU; ++u) s2[u] = 1.0f / sqrtf(wave_sum(s2[u]) * (1.0f / D) + LN_EPS);
    float am[NU];
#pragma unroll
    for (int u = 0; u < NU; ++u) am[u] = 0.f;
#pragma unroll
    for (int j = 0; j < 4; ++j) { const f32x4 gg = ggv[j], bb = bbv[j];
#pragma unroll
        for (int u = 0; u < NU; ++u) { const f32x4 o = v[u][j] * s2[u] * gg + bb; u32x2 w; w.x = cvt_pk_bf16(o[0], o[1]); w.y = cvt_pk_bf16(o[2], o[3]); *(u32x2*)(dst[u] + 256 * j + 4 * lane) = w;
            if (W8) { v[u][j] = o; am[u] = fmaxf(am[u], fmaxf(fmaxf(fabsf(o[0]), fabsf(o[1])), fmaxf(fabsf(o[2]), fabsf(o[3])))); } } }
    if (W8) {
#pragma unroll
        for (int u = 0; u < NU; ++u) { const float mx = fmaxf(wave_max(am[u]), 1e-20f), inv = 240.0f / mx;
#pragma unroll
            for (int j = 0; j < 4; ++j) { int q = 0; q = __builtin_amdgcn_cvt_pk_fp8_f32(v[u][j][0] * inv, v[u][j][1] * inv, q, false); q = __builtin_amdgcn_cvt_pk_fp8_f32(v[u][j][2] * inv, v[u][j][3] * inv, q, true);
                *(unsigned*)(dst8[u] + 256 * j + 4 * lane) = (unsigned)q; }
            if (lane == 0) *dsc[u] = mx * (1.0f / 240.0f); }
    }
}
__device__ __forceinline__ void ln_residual(const Ctx& c, const bf16_t* hb, const float* g, const float* b) {
    const bf16_t* xm = (const bf16_t*)c.out; bf16_t* xa = (bf16_t*)(c.ws + WS_XB); const int lane = c.lane;
    constexpr int NU = 4;
    f32x4 ggv[4], bbv[4];
#pragma unroll
    for (int j = 0; j < 4; ++j) { ggv[j] = *(const f32x4*)(g + 256 * j + 4 * lane); bbv[j] = *(const f32x4*)(b + 256 * j + 4 * lane); }
    auto ld = [&](int t0, u32x2 (&xw)[NU][4], u32x2 (&hw)[NU][4]) {
#pragma unroll
        for (int u = 0; u < NU; ++u) { const bf16_t* xr = xm + (size_t)(t0 + u) * D; const bf16_t* hr = hb + (size_t)(t0 + u) * D;
#pragma unroll
            for (int j = 0; j < 4; ++j) { xw[u][j] = *(const u32x2*)(xr + 256 * j + 4 * lane); hw[u][j] = *(const u32x2*)(hr + 256 * j + 4 * lane); } } };
    auto fin = [&](int t0, const u32x2 (&xw)[NU][4], const u32x2 (&hw)[NU][4]) {
        f32x4 v[NU][4]; bf16_t* dst[NU]; unsigned char* dst8[NU]; float* dsc[NU];
#pragma unroll
        for (int u = 0; u < NU; ++u) { dst[u] = xa + (size_t)(t0 + u) * D; dst8[u] = c.ws + B_X8 + (size_t)(t0 + u) * D; dsc[u] = (float*)(c.ws + B_XS) + (t0 + u);
#pragma unroll
            for (int j = 0; j < 4; ++j) v[u][j] = (f32x4){bflo(xw[u][j].x), bfhi(xw[u][j].x), bflo(xw[u][j].y), bfhi(xw[u][j].y)} * DN_ALPHA + (f32x4){bflo(hw[u][j].x), bfhi(hw[u][j].x), bflo(hw[u][j].y), bfhi(hw[u][j].y)}; }
        ln_rows<NU, false>(v, ggv, bbv, lane, dst, dst8, dsc); };
    const int stride = c.NGW * NU; int t0 = c.gw * NU;
    if (t0 >= T) return;
    u32x2 xA[NU][4], hA[NU][4], xB[NU][4], hB[NU][4];
    ld(t0, xA, hA);
    for (;;) {
        const int t1 = t0 + stride; ld(min(t1, T - NU), xB, hB);
        fin(t0, xA, hA);
        if (t1 >= T) break;
        const int t2 = t1 + stride; ld(min(t2, T - NU), xA, hA);
        fin(t1, xB, hB);
        if (t2 >= T) break;
        t0 = t2;
    }
}
__device__ __forceinline__ void hgrn_post(const Ctx& c, int j) {
    bf16_t* pl = (bf16_t*)(c.ws + B_PLANE); const size_t PE = (size_t)T * 1024;
    const bf16_t* of = pl + 1 * PE; const bf16_t* ob = pl + 2 * PE; const bf16_t* sg = pl + 4 * PE; bf16_t* on = pl;
    const float* nw = c.in(12) + j * 128; const int lane = c.lane;
    const int cw = (8 * lane) & 127; const f32x4 w0 = *(const f32x4*)(nw + cw), w1 = *(const f32x4*)(nw + cw + 4);
    constexpr int NU = 4;
    for (int t0 = c.gw * NU; t0 < T; t0 += c.NGW * NU) {
        u32x4 a[NU][2], b[NU][2], g[NU][2];
#pragma unroll
        for (int u = 0; u < NU; ++u)
#pragma unroll
            for (int k = 0; k < 2; ++k) { const size_t off = (size_t)(t0 + u) * 1024 + 512 * k + 8 * lane;
                a[u][k] = *(const u32x4*)(of + off); b[u][k] = *(const u32x4*)(ob + off); g[u][k] = *(const u32x4*)(sg + off); }
#pragma unroll
        for (int u = 0; u < NU; ++u)
#pragma unroll
            for (int k = 0; k < 2; ++k) { const size_t off = (size_t)(t0 + u) * 1024 + 512 * k + 8 * lane;
                float o[8], gg[8]; float ss = 0.f;
#pragma unroll
                for (int q = 0; q < 4; ++q) { o[2 * q] = bflo(a[u][k][q]) + bflo(b[u][k][q]); o[2 * q + 1] = bfhi(a[u][k][q]) + bfhi(b[u][k][q]); gg[2 * q] = bflo(g[u][k][q]); gg[2 * q + 1] = bfhi(g[u][k][q]); }
#pragma unroll
                for (int e = 0; e < 8; ++e) ss += o[e] * o[e];
                ss = row16_sum(ss);
                const float r = 1.0f / sqrtf(ss * (1.0f / 128.0f) + RMS_EPS);
                u32x4 w; w.x = cvt_pk_bf16(o[0] * r * w0[0] * gg[0], o[1] * r * w0[1] * gg[1]); w.y = cvt_pk_bf16(o[2] * r * w0[2] * gg[2], o[3] * r * w0[3] * gg[3]);
                w.z = cvt_pk_bf16(o[4] * r * w1[0] * gg[4], o[5] * r * w1[1] * gg[5]); w.w = cvt_pk_bf16(o[6] * r * w1[2] * gg[6], o[7] * r * w1[3] * gg[7]);
                *(u32x4*)(on + off) = w; }
    }
}
namespace scan {
#ifndef PROBE_ROLE
#define PROBE_ROLE 0
#endif
constexpr size_t D_F = R2_IDX, D_B = R2_IDX + 12 * MiB;
constexpr int NCH = T / 32;
__device__ __forceinline__ void hgrn_prep(const Ctx& c, int dup) {
    bf16_t* pl = (bf16_t*)(c.ws + B_PLANE); const size_t PE = (size_t)T * 1024;
    bf16_t* qs = pl; bf16_t* lff = pl + PE; bf16_t* lfb = pl + 2 * PE; bf16_t* qtb = (bf16_t*)(c.ws + WS_XB);
    float* dF = (float*)(c.ws + D_F); float* dB = (float*)(c.ws + D_B);
    const int lane = c.lane;
#define PREP_STEP(LW, QW, QDST, KDST, R0, R1) { const unsigned lw = (LW), qw = (QW); const float l0 = bflo(lw), l1 = bfhi(lw); R0 += l0; R1 += l1; \
        const float k0 = 1.0f - fast_exp(l0), k1 = 1.0f - fast_exp(l1); \
        *(unsigned*)(QDST) = cvt_pk_bf16(bflo(qw) * fast_exp(R0), bfhi(qw) * fast_exp(R1)); \
        *(unsigned*)(KDST) = cvt_pk_bf16(k0 * fast_exp(fminf(-R0, 80.f)), k1 * fast_exp(fminf(-R1, 80.f))); }
    const char* qsB = (const char*)qs; const char* lffB = (const char*)lff; const char* lfbB = (const char*)lfb; const char* qtbB = (const char*)qtb;
    char* dmy = (char*)((bf16_t*)c.out + (size_t)T * 1024);
    char* qsW = dup ? dmy : (char*)qs; char* lffW = dup ? dmy : (char*)lff; char* lfbW = dup ? dmy : (char*)lfb; char* qtbW = dup ? dmy : (char*)qtb;
    if (dup) { dF = (float*)dmy; dB = (float*)dmy; }
    for (int it = c.gw; it < NCH * 8; it += c.NGW) {
        const int chunk = it >> 3, h = it & 7; const unsigned base = ((unsigned)chunk * 32u * 1024u + (unsigned)h * 128u + 2u * (unsigned)lane) * 2u;
        float b0 = 0.f, b1 = 0.f, f0 = 0.f, f1 = 0.f;
#define LDW(P, O) (*(const unsigned*)((P) + (O)))
#define STP(P, O) ((unsigned*)((char*)(P) + (O)))
        { unsigned wb[16], wq[16];
#pragma unroll
          for (int i = 0; i < 16; ++i) { const unsigned o = base + (unsigned)(16 + i) * 2048u; wb[i] = LDW(lfbB, o); wq[i] = LDW(qsB, o); }
#pragma unroll
          for (int i = 15; i >= 0; --i) { const unsigned o = base + (unsigned)(16 + i) * 2048u; PREP_STEP(wb[i], wq[i], STP(qtbW, o), STP(lfbW, o), b0, b1) } }
        { unsigned wb[16], wq[16], wf[16];
#pragma unroll
          for (int i = 0; i < 16; ++i) { const unsigned o = base + (unsigned)i * 2048u; wb[i] = LDW(lfbB, o); wq[i] = LDW(qsB, o); wf[i] = LDW(lffB, o); }
#pragma unroll
          for (int i = 15; i >= 0; --i) { const unsigned o = base + (unsigned)i * 2048u; PREP_STEP(wb[i], wq[i], STP(qtbW, o), STP(lfbW, o), b0, b1) }
          *(f32x2*)(dB + (size_t)chunk * 1024 + h * 128 + 2 * lane) = (f32x2){fast_exp(b0), fast_exp(b1)};
#pragma unroll
          for (int i = 0; i < 16; ++i) { const unsigned o = base + (unsigned)i * 2048u; PREP_STEP(wf[i], wq[i], STP(qsW, o), STP(lffW, o), f0, f1) } }
        { unsigned wf[16], wq[16];
#pragma unroll
          for (int i = 0; i < 16; ++i) { const unsigned o = base + (unsigned)(16 + i) * 2048u; wf[i] = LDW(lffB, o); wq[i] = LDW(qsB, o); }
#pragma unroll
          for (int i = 0; i < 16; ++i) { const unsigned o = base + (unsigned)(16 + i) * 2048u; PREP_STEP(wf[i], wq[i], STP(qsW, o), STP(lffW, o), f0, f1) }
          *(f32x2*)(dF + (size_t)chunk * 1024 + h * 128 + 2 * lane) = (f32x2){fast_exp(f0), fast_exp(f1)}; }
    }
#undef LDW
#undef STP
#undef PREP_STEP
}

constexpr int QT_OFF = 0, KT_OFF = 8192, V_OFF = 16384, DV_OFF = 24576, TILE_SET = 25088, ST_OFF = 2 * TILE_SET, ST_BYTES = 34816, OB_OFF = ST_OFF + 2 * ST_BYTES, ORS = 272, OB_BYTES = 32 * ORS, SCAN_LDS_END = OB_OFF + 2 * OB_BYTES;
static_assert(SCAN_LDS_END <= LDS_MISC_OFF, "scan LDS layout");
constexpr int RS = 272, RS2 = 80;
__device__ __forceinline__ int crow(int r, int hi) { return (r & 3) + 8 * (r >> 2) + 4 * hi; }
__device__ __forceinline__ unsigned off_b(unsigned row, unsigned ch) { return 256u * row + 16u * (ch ^ (((row & 3) << 2) | ((row >> 2) & 3))); }
__device__ __forceinline__ unsigned row_read_addr(unsigned lane, unsigned s) { return off_b(lane & 31, 2 * s + (lane >> 5)); }
__device__ __forceinline__ unsigned tr_read_addr(unsigned lane, unsigned cc, unsigned ks, unsigned t) {
    const unsigned h = lane >> 5, blk = (lane >> 4) & 1, q = (lane & 15) >> 2, p = lane & 3;
    return off_b(16 * ks + 8 * h + 4 * t + q, 4 * cc + 2 * blk + (p >> 1)) + 8 * (p & 1);
}
template <int OFF> __device__ __forceinline__ s16x4 tr_rd(unsigned addr) { s16x4 r; asm volatile("ds_read_b64_tr_b16 %0, %1 offset:%2" : "=&v"(r) : "v"(addr), "n"(OFF) : "memory"); return r; }
template <int N> struct IC { static constexpr int value = N; };
#define TRPK(L, H) (bf16x8){L[0], L[1], L[2], L[3], H[0], H[1], H[2], H[3]}

__device__ __forceinline__ void run_chain(const Ctx& c, int tok0, int L, int h, int ch, bool dummy) {
    bf16_t* pl = (bf16_t*)(c.ws + B_PLANE); const size_t PE = (size_t)T * 1024;
    const int tid = c.tid, lane = c.lane, wave = c.wave, w = wave & 3, r32 = lane & 31, hi = lane >> 5;
    const bf16_t* qt = ch ? (const bf16_t*)(c.ws + WS_XB) : pl; bf16_t* kt = pl + (size_t)(1 + ch) * PE; const bf16_t* vv = pl + 3 * PE;
    const float* dd = (const float*)(c.ws + (ch ? D_B : D_F));
    bf16_t* odst = dummy ? (bf16_t*)c.out + (size_t)T * 1024 : kt;
    LAS unsigned char* base = c.lds;
    const unsigned lbase = (unsigned)(uintptr_t)base;
    const int NC = L / 32;
    const int sgn = 1 - 2 * ch, mlane = sgn * (r32 - 4 * hi);
    const int vcol = 32 * w + r32;
    unsigned trv[2], trk[4][2], trp[2];
#pragma unroll
    for (int t = 0; t < 2; ++t) { trv[t] = lbase + tr_read_addr(lane, w, 0, t);
        { const unsigned blk = (lane >> 4) & 1, q = (lane & 15) >> 2, p = lane & 3; trp[t] = lbase + off_b(4 * hi + 8 * t + q, 4 * w + 2 * blk + (p >> 1)) + 8 * (p & 1); }
#pragma unroll
        for (int cc = 0; cc < 4; ++cc) trk[cc][t] = lbase + tr_read_addr(lane, cc, 0, t); }
    const int s_r0 = tid >> 4, s_chn = tid & 15;
    u32x4 sreg[2][3]; f32x4 dreg[2] = {(f32x4){0.f, 0.f, 0.f, 0.f}, (f32x4){0.f, 0.f, 0.f, 0.f}};
#define SCAN_LOAD(cidx, R) do { const size_t rowb = (size_t)(tok0 + 32 * (cidx) + s_r0) * 1024 + h * 128 + s_chn * 8; \
        sreg[R][0] = *(const u32x4*)(qt + rowb); sreg[R][1] = *(const u32x4*)((const bf16_t*)kt + rowb); sreg[R][2] = *(const u32x4*)(vv + rowb); \
        dreg[R] = *(const f32x4*)(dd + (size_t)((tok0 >> 5) + (cidx)) * 1024 + h * 128 + 4 * (tid & 31)); } while (0)
#define SCAN_WRITE(set) do { LAS unsigned char* tb_ = base + (set) * TILE_SET; _Pragma("unroll") for (int i = 0; i < 3; ++i) *(LAS u32x4*)(tb_ + i * 8192 + off_b(s_r0, s_chn)) = sreg[set][i]; \
        if (tid < 32) *(LAS f32x4*)(tb_ + DV_OFF + 16 * tid) = dreg[set]; } while (0)
#define O_STORE(cidx, buf) do { const u32x4 ov_ = *(const LAS u32x4*)(base + OB_OFF + (buf) * OB_BYTES + s_r0 * ORS + s_chn * 16); \
        *(u32x4*)(odst + (size_t)(dummy ? c.bid * 32 + s_r0 : tok0 + 32 * (cidx) + s_r0) * 1024 + h * 128 + s_chn * 8) = ov_; } while (0)
    { LAS u32x4* st = (LAS u32x4*)(base + ST_OFF + ST_BYTES); for (int i = tid; i < ST_BYTES / 16; i += NTHR) st[i] = (u32x4){0u, 0u, 0u, 0u}; }
    f32x16 S[4];
#pragma unroll
    for (int kt2 = 0; kt2 < 4; ++kt2) S[kt2] = f32x16{};
    SCAN_LOAD(ch ? NC - 1 : 0, 0); SCAN_LOAD(ch ? NC - 2 : 1, 1); SCAN_WRITE(0);
    __syncthreads();
    auto chunk_body = [&](auto subc, auto rolec, const int ci) {
        constexpr int sub = decltype(subc)::value; constexpr bool og = decltype(rolec)::value == 0;
        const int cidx = ch ? NC - 1 - ci : ci;
        SCAN_LOAD(ci + 2 < NC ? (ch ? cidx - 2 : cidx + 2) : cidx, sub);
        O_STORE(ci > 0 ? (ch ? cidx + 1 : cidx - 1) : cidx, 1 - sub);
        LAS unsigned char* tb = base + sub * TILE_SET;
        if (dummy && (PROBE_ROLE == 3 || PROBE_ROLE == (og ? 1 : 2))) {   } else
        if constexpr (og) {
            const LAS unsigned char* strd = base + ST_OFF + (sub ? 0 : ST_BYTES);
            bf16x8 sb[8], qa[8];
#pragma unroll
            for (int ks = 0; ks < 8; ++ks) sb[ks] = *(const LAS bf16x8*)(strd + vcol * RS + (16 * ks + 8 * hi) * 2);
#pragma unroll
            for (int ks = 0; ks < 8; ++ks) qa[ks] = *(const LAS bf16x8*)(tb + QT_OFF + row_read_addr(lane, ks));
            __builtin_amdgcn_sched_barrier(0);
            f32x16 X = f32x16{};
#pragma unroll
            for (int ks = 0; ks < 8; ++ks) { const bf16x8 kb = *(const LAS bf16x8*)(tb + KT_OFF + row_read_addr(lane, ks));
                X = __builtin_amdgcn_mfma_f32_32x32x16_bf16(kb, qa[ks], X, 0, 0, 0); }
            s16x4 vl[2], vh[2];
            vl[0] = tr_rd<sub * TILE_SET + V_OFF>(trp[0]); vh[0] = tr_rd<sub * TILE_SET + V_OFF>(trp[1]); vl[1] = tr_rd<sub * TILE_SET + V_OFF + 4096>(trp[0]); vh[1] = tr_rd<sub * TILE_SET + V_OFF + 4096>(trp[1]);
            bf16x8 pa[2];
#pragma unroll
            for (int ks = 0; ks < 2; ++ks) { u32x4 pw;
#pragma unroll
                for (int e = 0; e < 4; ++e) { const int r = 8 * ks + 2 * e;
                    const float x0 = (mlane >= sgn * crow(r, 0)) ? X[r] : 0.f, x1 = (mlane >= sgn * crow(r + 1, 0)) ? X[r + 1] : 0.f; pw[e] = cvt_pk_bf16(x0, x1); }
                pa[ks] = __builtin_bit_cast(bf16x8, pw); }
            asm volatile("s_waitcnt lgkmcnt(0)" ::: "memory"); __builtin_amdgcn_sched_barrier(0);
            f32x16 O = f32x16{};
#pragma unroll
            for (int ks = 0; ks < 2; ++ks) O = __builtin_amdgcn_mfma_f32_32x32x16_bf16(TRPK(vl[ks], vh[ks]), pa[ks], O, 0, 0, 0);
#pragma unroll
            for (int ks = 0; ks < 8; ++ks) O = __builtin_amdgcn_mfma_f32_32x32x16_bf16(sb[ks], qa[ks], O, 0, 0, 0);
            { LAS unsigned char* ob = base + OB_OFF + sub * OB_BYTES + r32 * ORS + (32 * w + 4 * hi) * 2;
#pragma unroll
              for (int g = 0; g < 4; ++g) { u32x2 pk; pk.x = cvt_pk_bf16(O[4 * g], O[4 * g + 1]); pk.y = cvt_pk_bf16(O[4 * g + 2], O[4 * g + 3]); *(LAS u32x2*)(ob + 16 * g) = pk; } }
        } else {
            s16x4 vl[2], vh[2];
            vl[0] = tr_rd<sub * TILE_SET + V_OFF>(trv[0]); vh[0] = tr_rd<sub * TILE_SET + V_OFF>(trv[1]); vl[1] = tr_rd<sub * TILE_SET + V_OFF + 4096>(trv[0]); vh[1] = tr_rd<sub * TILE_SET + V_OFF + 4096>(trv[1]);
            s16x4 al[4][2], ah[4][2];
#define SCAN_KTRD(KT2) al[KT2][0] = tr_rd<sub * TILE_SET + KT_OFF>(trk[KT2][0]); ah[KT2][0] = tr_rd<sub * TILE_SET + KT_OFF>(trk[KT2][1]); \
            al[KT2][1] = tr_rd<sub * TILE_SET + KT_OFF + 4096>(trk[KT2][0]); ah[KT2][1] = tr_rd<sub * TILE_SET + KT_OFF + 4096>(trk[KT2][1]);
            SCAN_KTRD(0) SCAN_KTRD(1) SCAN_KTRD(2) SCAN_KTRD(3)
#undef SCAN_KTRD
            asm volatile("s_waitcnt lgkmcnt(0)" ::: "memory"); __builtin_amdgcn_sched_barrier(0);
            bf16x8 vb[2];
#pragma unroll
            for (int ks = 0; ks < 2; ++ks) vb[ks] = TRPK(vl[ks], vh[ks]);
#pragma unroll
            for (int kt2 = 0; kt2 < 4; ++kt2)
#pragma unroll
                for (int ks = 0; ks < 2; ++ks) S[kt2] = __builtin_amdgcn_mfma_f32_32x32x16_bf16(TRPK(al[kt2][ks], ah[kt2][ks]), vb[ks], S[kt2], 0, 0, 0);
            unsigned stw = (unsigned)(vcol * RS + 8 * hi) + (unsigned)(ST_OFF + (sub ? ST_BYTES : 0)), dvo = (unsigned)(16 * hi) + (unsigned)(sub * TILE_SET + DV_OFF); asm volatile("" : "+v"(stw), "+v"(dvo));
            f32x4 dq[2][4];
#define SCAN_DLOAD(KT2) _Pragma("unroll") for (int g = 0; g < 4; ++g) dq[(KT2) & 1][g] = *(const LAS f32x4*)(base + dvo + 128 * (KT2) + 32 * g);
#define SCAN_DECAY(KT2) _Pragma("unroll") for (int g = 0; g < 4; ++g) { const f32x4 d4 = dq[(KT2) & 1][g]; \
                _Pragma("unroll") for (int e = 0; e < 4; ++e) S[KT2][4 * g + e] *= d4[e]; \
                u32x2 pk; pk.x = cvt_pk_bf16(S[KT2][4 * g], S[KT2][4 * g + 1]); pk.y = cvt_pk_bf16(S[KT2][4 * g + 2], S[KT2][4 * g + 3]); \
                *(LAS u32x2*)(base + stw + 64 * (KT2) + 16 * g) = pk; }
            SCAN_DLOAD(0) SCAN_DLOAD(1)
            SCAN_DECAY(0) SCAN_DLOAD(2)
            SCAN_DECAY(1) SCAN_DLOAD(3)
            SCAN_DECAY(2) SCAN_DECAY(3)
#undef SCAN_DLOAD
#undef SCAN_DECAY
        }
        SCAN_WRITE(1 - sub);
        __syncthreads();
    };
    if (wave < 4) { for (int cj = 0; cj < NC; cj += 2) { chunk_body(IC<0>{}, IC<0>{}, cj); chunk_body(IC<1>{}, IC<0>{}, cj + 1); } }
    else          { for (int cj = 0; cj < NC; cj += 2) { chunk_body(IC<0>{}, IC<1>{}, cj); chunk_body(IC<1>{}, IC<1>{}, cj + 1); } }
    O_STORE(ch ? 0 : NC - 1, 1);
    __builtin_amdgcn_s_waitcnt(0x0F70);
#undef SCAN_LOAD
#undef SCAN_WRITE
#undef O_STORE
}
#undef TRPK
__device__ __forceinline__ void hgrn_scan(const Ctx& c, bool dummy) {
    const int NI = 32 + 512;
    const bool split = c.G > 64;
    const int first = split ? (c.bid < 32 ? c.bid : 32 + (c.bid - 32)) : c.bid, step = split ? (c.bid < 32 ? NI : c.G - 32) : c.G;
    for (int it = first; it < NI; it += step) {
        const bool pr = it < 32; const int si = it - 32;
        run_chain(c, pr ? (it >> 4) * SP : TP + (si >> 4) * SS, pr ? SP : SS, pr ? ((it >> 1) & 7) : ((si >> 1) & 7), pr ? (it & 1) : (si & 1), dummy);
    }
}
}
#define CE_(a, i, j) { const unsigned _x = a[i] > a[j] ? a[i] : a[j], _y = a[i] > a[j] ? a[j] : a[i]; a[i] = _x; a[j] = _y; }
__device__ __forceinline__ void sort16_desc(unsigned (&a)[16]) {
    CE_(a, 0, 1) CE_(a, 2, 3) CE_(a, 0, 2) CE_(a, 1, 3) CE_(a, 1, 2) CE_(a, 4, 5) CE_(a, 6, 7) CE_(a, 4, 6) CE_(a, 5, 7) CE_(a, 5, 6) CE_(a, 0, 4) CE_(a, 2, 6) CE_(a, 2, 4) CE_(a, 1, 5) CE_(a, 3, 7) CE_(a, 3, 5) CE_(a, 1, 2) CE_(a, 3, 4) CE_(a, 5, 6) CE_(a, 8, 9) CE_(a, 10, 11) CE_(a, 8, 10) CE_(a, 9, 11) CE_(a, 9, 10) CE_(a, 12, 13) CE_(a, 14, 15) CE_(a, 12, 14) CE_(a, 13, 15) CE_(a, 13, 14) CE_(a, 8, 12) CE_(a, 10, 14) CE_(a, 10, 12) CE_(a, 9, 13) CE_(a, 11, 15) CE_(a, 11, 13) CE_(a, 9, 10) CE_(a, 11, 12) CE_(a, 13, 14) CE_(a, 0, 8) CE_(a, 4, 12) CE_(a, 4, 8) CE_(a, 2, 10) CE_(a, 6, 14) CE_(a, 6, 10) CE_(a, 2, 4) CE_(a, 6, 8) CE_(a, 10, 12) CE_(a, 1, 9) CE_(a, 5, 13) CE_(a, 5, 9) CE_(a, 3, 11) CE_(a, 7, 15) CE_(a, 7, 11) CE_(a, 3, 5) CE_(a, 7, 9) CE_(a, 11, 13) CE_(a, 1, 2) CE_(a, 3, 4) CE_(a, 5, 6) CE_(a, 7, 8) CE_(a, 9, 10) CE_(a, 11, 12) CE_(a, 13, 14)
}
__device__ __forceinline__ void merge16_top(unsigned (&a)[16], const unsigned (&b)[16]) {
    a[0] = a[0] > b[15] ? a[0] : b[15]; a[1] = a[1] > b[14] ? a[1] : b[14]; a[2] = a[2] > b[13] ? a[2] : b[13]; a[3] = a[3] > b[12] ? a[3] : b[12]; a[4] = a[4] > b[11] ? a[4] : b[11]; a[5] = a[5] > b[10] ? a[5] : b[10]; a[6] = a[6] > b[9] ? a[6] : b[9]; a[7] = a[7] > b[8] ? a[7] : b[8]; a[8] = a[8] > b[7] ? a[8] : b[7]; a[9] = a[9] > b[6] ? a[9] : b[6]; a[10] = a[10] > b[5] ? a[10] : b[5]; a[11] = a[11] > b[4] ? a[11] : b[4]; a[12] = a[12] > b[3] ? a[12] : b[3]; a[13] = a[13] > b[2] ? a[13] : b[2]; a[14] = a[14] > b[1] ? a[14] : b[1]; a[15] = a[15] > b[0] ? a[15] : b[0];
    CE_(a, 0, 8) CE_(a, 1, 9) CE_(a, 2, 10) CE_(a, 3, 11) CE_(a, 4, 12) CE_(a, 5, 13) CE_(a, 6, 14) CE_(a, 7, 15) CE_(a, 0, 4) CE_(a, 1, 5) CE_(a, 2, 6) CE_(a, 3, 7) CE_(a, 8, 12) CE_(a, 9, 13) CE_(a, 10, 14) CE_(a, 11, 15) CE_(a, 0, 2) CE_(a, 1, 3) CE_(a, 4, 6) CE_(a, 5, 7) CE_(a, 8, 10) CE_(a, 9, 11) CE_(a, 12, 14) CE_(a, 13, 15) CE_(a, 0, 1) CE_(a, 2, 3) CE_(a, 4, 5) CE_(a, 6, 7) CE_(a, 8, 9) CE_(a, 10, 11) CE_(a, 12, 13) CE_(a, 14, 15)
}
namespace peer {
constexpr int KEY_RS = 272;
constexpr int KEYS_BYTES = 2 * 128 * KEY_RS;
constexpr int SI_OFF = KEYS_BYTES;
__device__ __forceinline__ int crow(int r, int hi) { return (r & 3) + 8 * (r >> 2) + 4 * hi; }
__device__ __forceinline__ unsigned sortable(float f) { const unsigned u = __float_as_uint(f); return u ^ ((u >> 31) ? 0xFFFFFFFFu : 0x80000000u); }
__device__ __forceinline__ float unsortable(unsigned s) { const unsigned u = (s >> 31) ? (s ^ 0x80000000u) : ~s; return __uint_as_float(u); }
__device__ __forceinline__ unsigned pair_max(unsigned m) { auto rr = __builtin_amdgcn_permlane32_swap(m, m, false, false); return rr[0] > rr[1] ? rr[0] : rr[1]; }

__device__ __forceinline__ void top16_half(const Ctx& c, const bf16_t* pq_rows, int half, LAS unsigned char* keys, unsigned (&sel)[16]) {
    const int lane = c.lane, r32 = lane & 31, hi = lane >> 5;
    f32x16 acc[4];
#pragma unroll
    for (int nt = 0; nt < 4; ++nt) acc[nt] = f32x16{};
    const bf16_t* qrow = pq_rows + (size_t)r32 * 256 + half * 128;
    bf16x8 qb[8];
#pragma unroll
    for (int ks = 0; ks < 8; ++ks) qb[ks] = *reinterpret_cast<const bf16x8*>(qrow + 16 * ks + 8 * hi);
#pragma unroll
    for (int ks = 0; ks < 8; ++ks) {
#pragma unroll
        for (int nt = 0; nt < 4; ++nt) { const bf16x8 ka = *(const LAS bf16x8*)(keys + (half * 128 + 32 * nt + r32) * KEY_RS + (16 * ks + 8 * hi) * 2);
            acc[nt] = __builtin_amdgcn_mfma_f32_32x32x16_bf16(ka, qb[ks], acc[nt], 0, 0, 0); }
        if (ks & 1) __builtin_amdgcn_sched_barrier(0); }
    unsigned p[64];
#pragma unroll
    for (int nt = 0; nt < 4; ++nt)
#pragma unroll
        for (int r = 0; r < 16; ++r) { const int n = 32 * nt + crow(r, hi); p[nt * 16 + r] = (sortable(acc[nt][r]) & ~127u) | (unsigned)(127 - n); }
    unsigned g0[16], g1[16], g2[16], g3[16];
#pragma unroll
    for (int i = 0; i < 16; ++i) { g0[i] = p[i]; g1[i] = p[16 + i]; g2[i] = p[32 + i]; g3[i] = p[48 + i]; }
    sort16_desc(g0); sort16_desc(g1); sort16_desc(g2); sort16_desc(g3);
    merge16_top(g0, g1); merge16_top(g2, g3); merge16_top(g0, g2);
    unsigned pb[16];
#pragma unroll
    for (int i = 0; i < 16; ++i) { auto rr = __builtin_amdgcn_permlane32_swap(g0[i], g0[i], false, false); sel[i] = rr[0]; pb[i] = rr[1]; }
    merge16_top(sel, pb);
}
__device__ __forceinline__ void route(const Ctx& c, int layer) {
    const bf16_t* pq = (const bf16_t*)(c.ws + B_PQ); unsigned short* idx_out = (unsigned short*)(c.ws + R2_IDX); float* gate_out = (float*)(c.ws + R2_GATE);
    const bf16_t* keys_g = (const bf16_t*)(c.ws + W_KEYS) + (size_t)layer * 2 * 128 * 128;
    LAS unsigned char* keys = c.lds;
    const int lane = c.lane, r32 = lane & 31, hi = lane >> 5;
    for (int i = c.tid; i < 2 * 128 * 16; i += NTHR) { const int row = i >> 4, ch = i & 15; *(LAS u32x4*)(keys + row * KEY_RS + ch * 16) = *(const u32x4*)(keys_g + (size_t)row * 128 + ch * 8); }
    __syncthreads();
    LAS int* si = (LAS int*)(c.lds + SI_OFF + c.wave * 4096) + r32 * 32;
    for (int grp = c.gw; grp < T / 4; grp += c.NGW) {
        const bf16_t* rows = pq + (size_t)grp * 4 * 2048;
        unsigned s1[16], s2[16];
        top16_half(c, rows, 0, keys, s1);
        top16_half(c, rows, 1, keys, s2);
        float v1[16], v2[16];
#pragma unroll
        for (int i = 0; i < 16; ++i) { v1[i] = unsortable(s1[i] & ~127u); v2[i] = unsortable(s2[i] & ~127u); }
        if (hi == 0) {
#pragma unroll
            for (int i = 0; i < 16; ++i) { si[i] = 127 - (int)(s1[i] & 127u); si[16 + i] = 127 - (int)(s2[i] & 127u); }
        }
        float A[16], B[16];
#pragma unroll
        for (int i = 0; i < 16; ++i) { A[i] = hi ? v2[i] : v1[i]; B[i] = hi ? v1[i] : v2[i]; }
        unsigned cd[27]; int nc = 0;
#pragma unroll
        for (int i = 0; i < 16; ++i)
#pragma unroll
            for (int j = i; j < 16; ++j) if ((i + 1) * (j + 1) <= 16) {
                const unsigned flat = hi ? (unsigned)(j * 16 + i) : (unsigned)(i * 16 + j);
                unsigned pk = (sortable(A[i] + B[j]) & ~255u) | (255u - flat);
                if (i == j) pk = hi ? 0u : pk;
                cd[nc++] = pk; }
        unsigned sel[16], c1[16], pb[16];
#pragma unroll
        for (int i = 0; i < 16; ++i) { sel[i] = cd[i]; c1[i] = (16 + i < 27) ? cd[(16 + i < 27) ? 16 + i : 0] : 0u; }
        sort16_desc(sel); sort16_desc(c1); merge16_top(sel, c1);
#pragma unroll
        for (int i = 0; i < 16; ++i) { auto rr = __builtin_amdgcn_permlane32_swap(sel[i], sel[i], false, false); sel[i] = rr[0]; pb[i] = rr[1]; }
        merge16_top(sel, pb);
        LDS_WAIT(); asm volatile("" ::: "memory");
        const float vmax = unsortable(sel[0] & ~255u);
        float e[16], es = 0.f;
#pragma unroll
        for (int i = 0; i < 16; ++i) { e[i] = fast_exp(unsortable(sel[i] & ~255u) - vmax); es += e[i]; }
        const float inv = 1.0f / es;
        const size_t obase = ((size_t)grp * 4 + (r32 >> 3)) * 128 + (r32 & 7) * 16 + 8 * hi;
        int oi[8]; float og[8];
#pragma unroll
        for (int q = 0; q < 8; ++q) { const unsigned sv = hi ? sel[8 + q] : sel[q]; const float ev = hi ? e[8 + q] : e[q];
            const int flat = 255 - (int)(sv & 255u); oi[q] = si[flat >> 4] * 128 + si[16 + (flat & 15)]; og[q] = ev * inv; }
        *(u32x4*)(idx_out + obase) = (u32x4){(unsigned)oi[0] | ((unsigned)oi[1] << 16), (unsigned)oi[2] | ((unsigned)oi[3] << 16), (unsigned)oi[4] | ((unsigned)oi[5] << 16), (unsigned)oi[6] | ((unsigned)oi[7] << 16)};
        *(f32x4*)(gate_out + obase) = (f32x4){og[0], og[1], og[2], og[3]};
        *(f32x4*)(gate_out + obase + 4) = (f32x4){og[4], og[5], og[6], og[7]};
        LDS_WAIT(); asm volatile("" ::: "memory");
    }
    __syncthreads();
}

__device__ __forceinline__ float gelu_exact(float x) { return 0.5f * x * (1.0f + erff(x * 0.70710678118654752f)); }
template <int IDXMASK> __device__ __forceinline__ void gather_ln(const Ctx& c, int layer, float* xout, bf16_t* xb) {
    const unsigned char* U8 = c.ws + R2_UB; const unsigned char* V8 = c.ws + R2_VB;
    const float* su = (const float*)(c.ws + R2_SU); const float* sv = (const float*)(c.ws + R2_SV);
    const int* idx = (const int*)(c.ws + R2_IDX); const float* gate = (const float*)(c.ws + R2_GATE);
    const float* lg = c.in(20) + layer * D; const float* lbv = c.in(21) + layer * D;
    const int lane = c.lane;
    for (int t = c.gw; t < T; t += c.NGW) {
        const float* xr = c.out + (size_t)t * D + 16 * lane; float* xw = xout + (size_t)t * D + 16 * lane;
        float x[16], acc[16];
#pragma unroll
        for (int j = 0; j < 4; ++j) { const f32x4 a = *(const f32x4*)(xr + 4 * j); x[4 * j] = a[0]; x[4 * j + 1] = a[1]; x[4 * j + 2] = a[2]; x[4 * j + 3] = a[3]; }
#pragma unroll
        for (int e = 0; e < 16; ++e) acc[e] = 0.f;
        const int myidx0 = idx[(size_t)t * 128 + lane] & IDXMASK, myidx1 = idx[(size_t)t * 128 + 64 + lane] & IDXMASK;
        const float myg0 = gate[(size_t)t * 128 + lane], myg1 = gate[(size_t)t * 128 + 64 + lane];
        for (int eb = 0; eb < 128; eb += 8) {
            float part[8]; int ei[8];
#pragma unroll
            for (int q = 0; q < 8; ++q) { const int e = eb + q; ei[q] = __builtin_amdgcn_readlane(e < 64 ? myidx0 : myidx1, e & 63); }
            u32x4 vr[8];
#pragma unroll
            for (int q = 0; q < 8; ++q) vr[q] = *(const u32x4*)(V8 + (size_t)ei[q] * D + 16 * lane);
#pragma unroll
            for (int q = 0; q < 8; ++q) { const u32x4 a = *(const u32x4*)(U8 + (size_t)ei[q] * D + 16 * lane);
                float s = 0.f;
#pragma unroll
                for (int j = 0; j < 4; ++j) { const f32x2 lo = __builtin_amdgcn_cvt_pk_f32_fp8((int)a[j], false), hi = __builtin_amdgcn_cvt_pk_f32_fp8((int)a[j], true);
                    s = fmaf(lo[0], x[4 * j], s); s = fmaf(lo[1], x[4 * j + 1], s); s = fmaf(hi[0], x[4 * j + 2], s); s = fmaf(hi[1], x[4 * j + 3], s); }
                part[q] = s; }
            float r4[4], r2[2], r1;
            { const bool up = (lane & 32) != 0;
#pragma unroll
              for (int i = 0; i < 4; ++i) { const float send = up ? part[i] : part[4 + i]; const float keep = up ? part[4 + i] : part[i]; r4[i] = keep + __shfl_xor(send, 32); } }
            { const bool up = (lane & 16) != 0;
#pragma unroll
              for (int i = 0; i < 2; ++i) { const float send = up ? r4[i] : r4[2 + i]; const float keep = up ? r4[2 + i] : r4[i]; r2[i] = keep + __shfl_xor(send, 16); } }
            { const bool up = (lane & 8) != 0; const float send = up ? r2[0] : r2[1]; const float keep = up ? r2[1] : r2[0]; r1 = keep + __shfl_xor(send, 8); }
            r1 += __shfl_xor(r1, 4); r1 += __shfl_xor(r1, 2); r1 += __shfl_xor(r1, 1);
            const int myq = ((lane >> 5) & 1) * 4 + ((lane >> 4) & 1) * 2 + ((lane >> 3) & 1);
            const int me = eb + myq;
            const float g = __shfl(me < 64 ? myg0 : myg1, me & 63);
            const int mye = __shfl(me < 64 ? myidx0 : myidx1, me & 63);
            const float cf = g * gelu_exact(r1 * su[mye]) * sv[mye];
            float cq[8];
#pragma unroll
            for (int q = 0; q < 8; ++q) cq[q] = __int_as_float(__builtin_amdgcn_readlane(__float_as_int(cf), ((q >> 2) & 1) * 32 + ((q >> 1) & 1) * 16 + (q & 1) * 8));
#pragma unroll
            for (int q = 0; q < 8; ++q) { const float s = cq[q];
#pragma unroll
                for (int j = 0; j < 4; ++j) { const f32x2 lo = __builtin_amdgcn_cvt_pk_f32_fp8((int)vr[q][j], false), hi = __builtin_amdgcn_cvt_pk_f32_fp8((int)vr[q][j], true);
                    acc[4 * j] = fmaf(s, lo[0], acc[4 * j]); acc[4 * j + 1] = fmaf(s, lo[1], acc[4 * j + 1]); acc[4 * j + 2] = fmaf(s, hi[0], acc[4 * j + 2]); acc[4 * j + 3] = fmaf(s, hi[1], acc[4 * j + 3]); } }
        }
        float s = 0.f;
#pragma unroll
        for (int e = 0; e < 16; ++e) { acc[e] = fmaf(DN_ALPHA, x[e], acc[e]); s += acc[e]; }
        const float mean = wave_sum(s) * (1.0f / D); float s2 = 0.f;
#pragma unroll
        for (int e = 0; e < 16; ++e) { acc[e] -= mean; s2 += acc[e] * acc[e]; }
        const float rstd = 1.0f / sqrtf(wave_sum(s2) * (1.0f / D) + LN_EPS);
        float o[16];
#pragma unroll
        for (int j = 0; j < 4; ++j) { const f32x4 g4 = *(const f32x4*)(lg + 16 * lane + 4 * j), b4 = *(const f32x4*)(lbv + 16 * lane + 4 * j);
#pragma unroll
            for (int e = 0; e < 4; ++e) o[4 * j + e] = acc[4 * j + e] * rstd * g4[e] + b4[e];
            *(f32x4*)(xw + 4 * j) = (f32x4){o[4 * j], o[4 * j + 1], o[4 * j + 2], o[4 * j + 3]}; }
        u32x4 w0, w1; w0.x = cvt_pk_bf16(o[0], o[1]); w0.y = cvt_pk_bf16(o[2], o[3]); w0.z = cvt_pk_bf16(o[4], o[5]); w0.w = cvt_pk_bf16(o[6], o[7]);
        w1.x = cvt_pk_bf16(o[8], o[9]); w1.y = cvt_pk_bf16(o[10], o[11]); w1.z = cvt_pk_bf16(o[12], o[13]); w1.w = cvt_pk_bf16(o[14], o[15]);
        *(u32x4*)(xb + (size_t)t * D + 16 * lane) = w0; *(u32x4*)(xb + (size_t)t * D + 16 * lane + 8) = w1;
    }
}
}
namespace peer {
#ifndef PROBE_NOMATH
#define PROBE_NOMATH 0
#endif
constexpr size_t HP_OFF = WS_BIG;
constexpr size_t COEF_OFF = WS_R2 + 36 * MiB;
constexpr int QW_BASE = 4096;
constexpr int ITEM_TOK = 128, NBLK = T / ITEM_TOK;
constexpr int GT = 1;
#define DPP_F(v, ctrl) __int_as_float(__builtin_amdgcn_update_dpp(0, __float_as_int(v), (ctrl), 0xf, 0xf, true))

constexpr int BIG_TOK = 65536, N_BIG = BIG_TOK / 128, N_SMALL = (T - BIG_TOK) / 64;
template <class F> __device__ __forceinline__ void for_items(const Ctx& c, int layer, int phase, F body) {
    unsigned* qw = (unsigned*)(c.ws + WS_CTL) + QW_BASE + (size_t)((layer * 4 + phase) * 8) * 16;
    volatile LAS int* slot = (volatile LAS int*)(c.lds + LDS_MISC_OFF + 128);
    const int home = (int)(xb_xcc_id() & 7u);
    for (int k = 0; k < 8; ++k) {
        const int s = (home + k) & 7;
        for (int stage = 0; stage < 2; ++stage) {
            unsigned* cursor = qw + s * 16 + stage; const int limit = stage ? N_SMALL : N_BIG, tokb = stage ? BIG_TOK : 0, sz = stage ? 64 : 128;
            if (c.tid == 0) slot[0] = (int)__hip_atomic_fetch_add(cursor, 1u, __ATOMIC_RELAXED, __HIP_MEMORY_SCOPE_AGENT);
            __syncthreads();
            int cur = slot[0];
            __syncthreads();
            while (cur < limit) {
                int nxt = 0;
                if (c.tid == 0) nxt = (int)__hip_atomic_fetch_add(cursor, 1u, __ATOMIC_RELAXED, __HIP_MEMORY_SCOPE_AGENT);
                body(s, tokb + cur * sz, sz / NWAVES);
                if (c.tid == 0) slot[0] = nxt;
                __syncthreads();
                cur = slot[0];
                __syncthreads();
            }
        }
    }
}

__device__ __forceinline__ void g1_udot(const Ctx& c, int layer, int dup) {
    const unsigned char* U8 = c.ws + R2_UB; const unsigned short* idx = (const unsigned short*)(c.ws + R2_IDX); bf16_t* hp = (bf16_t*)(c.ws + HP_OFF);
    for_items(c, layer, 0 + 2 * dup, [&](int s, int tok0, int N) {
        int lane = c.lane; asm volatile("" : "+v"(lane));
        const int g = lane >> 3, c8 = lane & 7;
        const int co = 128 * s + 16 * c8;
        const int t0 = tok0 + c.wave * N;
        auto issue_idx = [&](int t, u32x4 (&q)[2]) {
#pragma unroll
            for (int j = 0; j < 2; ++j) q[j] = *(const u32x4*)(idx + (size_t)t * 128 + 16 * g + 8 * j); };
        auto unpack_idx = [&](const u32x4 (&q)[2], int (&id)[16]) {
#pragma unroll
            for (int j = 0; j < 2; ++j)
#pragma unroll
                for (int e = 0; e < 4; ++e) { id[8 * j + 2 * e] = (int)(q[j][e] & 0xffffu); id[8 * j + 2 * e + 1] = (int)(q[j][e] >> 16); } };
        auto load_rows = [&](int t, const int (&id)[16], u32x4 (&row)[16], u32x4 (&xr)[2]) {
#pragma unroll
            for (int j = 0; j < 2; ++j) xr[j] = *(const u32x4*)((const bf16_t*)(c.ws + WS_XB) + (size_t)t * D + co + 8 * j);
#pragma unroll
            for (int j = 0; j < 16; ++j) row[j] = *(const u32x4*)(U8 + ((unsigned)id[j] * 1024u + (unsigned)co)); };
        auto compute = [&](int t, const u32x4 (&row)[16], const u32x4 (&xr)[2]) {
            f32x2 x2[8];
#pragma unroll
            for (int j = 0; j < 2; ++j)
#pragma unroll
                for (int e = 0; e < 4; ++e) x2[4 * j + e] = (f32x2){bflo(xr[j][e]), bfhi(xr[j][e])};
            float V[16];
#pragma unroll
            for (int j = 0; j < 16; ++j) { f32x2 acc2 = (f32x2){0.f, 0.f};
                if (PROBE_NOMATH && dup) { V[j] = __uint_as_float((row[j][0] ^ row[j][1] ^ row[j][2] ^ row[j][3]) & 0x3fffffffu) + x2[j & 7][0]; continue; }
#pragma unroll
                for (int q = 0; q < 4; ++q) { const f32x2 lo = __builtin_amdgcn_cvt_pk_f32_fp8((int)row[j][q], false), hi = __builtin_amdgcn_cvt_pk_f32_fp8((int)row[j][q], true);
                    acc2 = __builtin_elementwise_fma(lo, x2[2 * q], acc2); acc2 = __builtin_elementwise_fma(hi, x2[2 * q + 1], acc2); }
                V[j] = acc2[0] + acc2[1]; }
            float W[8], Y[4], Z[2];
            { const bool hiA = (lane & 4) != 0;
#pragma unroll
              for (int m = 0; m < 8; ++m) { const float send = hiA ? V[m] : V[8 + m], keep = hiA ? V[8 + m] : V[m]; W[m] = keep + DPP_F(send, 0x141); } }
            { const bool hiB = (lane & 2) != 0;
#pragma unroll
              for (int m = 0; m < 4; ++m) { const float send = hiB ? W[m] : W[4 + m], keep = hiB ? W[4 + m] : W[m]; Y[m] = keep + DPP_F(send, 0x1B); } }
            { const bool hiC = (lane & 1) != 0;
#pragma unroll
              for (int m = 0; m < 2; ++m) { const float send = hiC ? Y[m] : Y[2 + m], keep = hiC ? Y[2 + m] : Y[m]; Z[m] = keep + DPP_F(send, 0xB1); } }
            *(unsigned*)((dup ? hp + (size_t)320 * MiB : hp) + ((size_t)(dup ? 0 : s) * T + t) * 128 + 16 * g + 2 * c8) = cvt_pk_bf16(Z[0], Z[1]); };
        int id[16]; u32x4 qA[2], qB[2], rowA[16], rowB[16], xA[2], xB[2];
        issue_idx(t0, qA); issue_idx(t0 + 1, qB);
        unpack_idx(qA, id); load_rows(t0, id, rowA, xA);
#pragma unroll 1
        for (int i = 0; i < N; i += 2) {
            unpack_idx(qB, id); load_rows(t0 + i + 1, id, rowB, xB);
            if (i + 2 < N) issue_idx(t0 + i + 2, qA);
            __builtin_amdgcn_sched_barrier(0);
            compute(t0 + i, rowA, xA);
            __builtin_amdgcn_sched_barrier(0);
            if (i + 2 < N) { unpack_idx(qA, id); load_rows(t0 + i + 2, id, rowA, xA); }
            if (i + 3 < N) issue_idx(t0 + i + 3, qB);
            __builtin_amdgcn_sched_barrier(0);
            compute(t0 + i + 1, rowB, xB);
            __builtin_amdgcn_sched_barrier(0);
        }
    });
}
__device__ __forceinline__ void g2_coef(const Ctx& c, int dup) {
    const unsigned short* idx = (const unsigned short*)(c.ws + R2_IDX); const float* gate = (const float*)(c.ws + R2_GATE); const bf16_t* hp = (const bf16_t*)(c.ws + HP_OFF);
    const float* su = (const float*)(c.ws + R2_SU); const float* sv = (const float*)(c.ws + R2_SV);
    bf16_t* dstb = dup ? (bf16_t*)(c.ws + HP_OFF) + (size_t)340 * MiB : (bf16_t*)(c.ws + COEF_OFF);
    const int lane = c.lane;
    constexpr int NU = 4;
    for (int t0 = c.gw * NU; t0 < T; t0 += c.NGW * NU) {
        float h[NU][2]; unsigned ew[NU]; f32x2 gt[NU];
#pragma unroll
        for (int u = 0; u < NU; ++u) { const size_t o = (size_t)(t0 + u) * 128 + 2 * lane; ew[u] = *(const unsigned*)(idx + o); gt[u] = *(const f32x2*)(gate + o); float a0 = 0.f, a1 = 0.f;
#pragma unroll
            for (int s = 0; s < 8; ++s) { const unsigned w = *(const unsigned*)(hp + (size_t)s * T * 128 + o); a0 += bflo(w); a1 += bfhi(w); }
            h[u][0] = a0; h[u][1] = a1; }
        float s1[NU][2], s2[NU][2];
#pragma unroll
        for (int u = 0; u < NU; ++u) { const int e0 = (int)(ew[u] & 0xffffu), e1 = (int)(ew[u] >> 16); s1[u][0] = su[e0]; s1[u][1] = su[e1]; s2[u][0] = sv[e0]; s2[u][1] = sv[e1]; }
#pragma unroll
        for (int u = 0; u < NU; ++u) *(unsigned*)(dstb + (size_t)(t0 + u) * 128 + 2 * lane) = cvt_pk_bf16(gt[u][0] * gelu_exact(h[u][0] * s1[u][0]) * s2[u][0], gt[u][1] * gelu_exact(h[u][1] * s1[u][1]) * s2[u][1]);
    }
}
__device__ __forceinline__ void g3_vaxpy(const Ctx& c, int layer, int dup) {
    const unsigned char* V8 = c.ws + R2_VB; const unsigned short* idx = (const unsigned short*)(c.ws + R2_IDX); const bf16_t* coef = (const bf16_t*)(c.ws + COEF_OFF);
    for_items(c, layer, 1 + 2 * dup, [&](int s, int tok0, int N) {
        int lane = c.lane; asm volatile("" : "+v"(lane));
        const int g = lane >> 3, c8 = lane & 7;
        const int co = 128 * s + 16 * c8;
        const int t0 = tok0 + c.wave * N;
        auto issue_idx = [&](int t, u32x4 (&q)[2]) {
#pragma unroll
            for (int j = 0; j < 2; ++j) q[j] = *(const u32x4*)(idx + (size_t)t * 128 + 16 * g + 8 * j); };
        auto unpack_idx = [&](const u32x4 (&q)[2], int (&id)[16]) {
#pragma unroll
            for (int j = 0; j < 2; ++j)
#pragma unroll
                for (int e = 0; e < 4; ++e) { id[8 * j + 2 * e] = (int)(q[j][e] & 0xffffu); id[8 * j + 2 * e + 1] = (int)(q[j][e] >> 16); } };
        auto load_rows = [&](int t, const int (&id)[16], u32x4 (&row)[16], f32x4 (&cf)[4], unsigned& xo) {
            xo = *(const unsigned*)((const bf16_t*)(c.ws + WS_XB) + (size_t)t * D + co + 8 * ((lane >> 5) & 1) + 4 * ((lane >> 4) & 1) + 2 * ((lane >> 3) & 1));
#pragma unroll
            for (int j = 0; j < 2; ++j) { const u32x4 q = *(const u32x4*)(coef + (size_t)t * 128 + 16 * g + 8 * j); cf[2 * j] = (f32x4){bflo(q[0]), bfhi(q[0]), bflo(q[1]), bfhi(q[1])}; cf[2 * j + 1] = (f32x4){bflo(q[2]), bfhi(q[2]), bflo(q[3]), bfhi(q[3])}; }
#pragma unroll
            for (int j = 0; j < 16; ++j) row[j] = *(const u32x4*)(V8 + ((unsigned)id[j] * 1024u + (unsigned)co)); };
        auto compute = [&](int t, const u32x4 (&row)[16], const f32x4 (&cf)[4], const unsigned xo) {
            f32x2 A2[8];
#pragma unroll
            for (int e = 0; e < 8; ++e) A2[e] = (f32x2){0.f, 0.f};
#pragma unroll
            for (int j = 0; j < 16; ++j) { const float cj = cf[j >> 2][j & 3]; const f32x2 sc = (f32x2){cj, cj};
#pragma unroll
                for (int q = 0; q < 4; ++q) { const f32x2 lo = __builtin_amdgcn_cvt_pk_f32_fp8((int)row[j][q], false), hi = __builtin_amdgcn_cvt_pk_f32_fp8((int)row[j][q], true);
                    A2[2 * q] = __builtin_elementwise_fma(sc, lo, A2[2 * q]); A2[2 * q + 1] = __builtin_elementwise_fma(sc, hi, A2[2 * q + 1]); } }
            float A[16];
#pragma unroll
            for (int e = 0; e < 8; ++e) { A[2 * e] = A2[e][0]; A[2 * e + 1] = A2[e][1]; }
            float R[8], S2[4], Y[2];
#pragma unroll
            for (int m = 0; m < 8; ++m) { auto rr = __builtin_amdgcn_permlane32_swap(__float_as_uint(A[m]), __float_as_uint(A[8 + m]), false, false); R[m] = __uint_as_float(rr[0]) + __uint_as_float(rr[1]); }
#pragma unroll
            for (int m = 0; m < 4; ++m) { auto rr = __builtin_amdgcn_permlane16_swap(__float_as_uint(R[m]), __float_as_uint(R[4 + m]), false, false); S2[m] = __uint_as_float(rr[0]) + __uint_as_float(rr[1]); }
            { const bool hi8 = (lane & 8) != 0;
#pragma unroll
              for (int m = 0; m < 2; ++m) { const float send = hi8 ? S2[m] : S2[2 + m], keep = hi8 ? S2[2 + m] : S2[m]; Y[m] = keep + DPP_F(send, 0x128); } }
            const size_t yo = (size_t)t * D + co + 8 * ((lane >> 5) & 1) + 4 * ((lane >> 4) & 1) + 2 * ((lane >> 3) & 1);
            *(unsigned*)((bf16_t*)c.out + yo) = cvt_pk_bf16(fmaf(DN_ALPHA, bflo(xo), Y[0]), fmaf(DN_ALPHA, bfhi(xo), Y[1])); };
        int id[16]; u32x4 qA[2], qB[2], rowA[16], rowB[16]; f32x4 cfA[4], cfB[4]; unsigned xoA, xoB;
        issue_idx(t0, qA); issue_idx(t0 + 1, qB);
        unpack_idx(qA, id); load_rows(t0, id, rowA, cfA, xoA);
#pragma unroll 1
        for (int i = 0; i < N; i += 2) {
            unpack_idx(qB, id); load_rows(t0 + i + 1, id, rowB, cfB, xoB);
            if (i + 2 < N) issue_idx(t0 + i + 2, qA);
            __builtin_amdgcn_sched_barrier(0);
            compute(t0 + i, rowA, cfA, xoA);
            __builtin_amdgcn_sched_barrier(0);
            if (i + 2 < N) { unpack_idx(qA, id); load_rows(t0 + i + 2, id, rowA, cfA, xoA); }
            if (i + 3 < N) issue_idx(t0 + i + 3, qB);
            __builtin_amdgcn_sched_barrier(0);
            compute(t0 + i + 1, rowB, cfB, xoB);
            __builtin_amdgcn_sched_barrier(0);
        }
    });
}
__device__ __forceinline__ void ln_pass(const Ctx& c, const float* g, const float* b) {
    const bf16_t* ym = (const bf16_t*)c.out; bf16_t* xa = (bf16_t*)(c.ws + WS_XB); const int lane = c.lane;
    constexpr int NU = 4;
    f32x4 ggv[4], bbv[4];
#pragma unroll
    for (int j = 0; j < 4; ++j) { ggv[j] = *(const f32x4*)(g + 256 * j + 4 * lane); bbv[j] = *(const f32x4*)(b + 256 * j + 4 * lane); }
    auto ld = [&](int t0, u32x2 (&w)[NU][4]) {
#pragma unroll
        for (int u = 0; u < NU; ++u)
#pragma unroll
            for (int j = 0; j < 4; ++j) w[u][j] = *(const u32x2*)(ym + (size_t)(t0 + u) * D + 256 * j + 4 * lane); };
    auto fin = [&](int t0, const u32x2 (&w)[NU][4]) {
        f32x4 v[NU][4]; bf16_t* dst[NU]; unsigned char* dst8[NU]; float* dsc[NU];
#pragma unroll
        for (int u = 0; u < NU; ++u) { dst8[u] = nullptr; dsc[u] = nullptr; dst[u] = xa + (size_t)(t0 + u) * D;
#pragma unroll
            for (int j = 0; j < 4; ++j) v[u][j] = (f32x4){bflo(w[u][j].x), bfhi(w[u][j].x), bflo(w[u][j].y), bfhi(w[u][j].y)}; }
        ln_rows<NU, false>(v, ggv, bbv, lane, dst, dst8, dsc); };
    const int stride = c.NGW * NU; int t0 = c.gw * NU;
    if (t0 >= T) return;
    u32x2 wA[NU][4], wB[NU][4];
    ld(t0, wA);
    for (;;) {
        const int t1 = t0 + stride; ld(min(t1, T - NU), wB);
        fin(t0, wA);
        if (t1 >= T) break;
        const int t2 = t1 + stride; ld(min(t2, T - NU), wA);
        fin(t1, wB);
        if (t2 >= T) break;
        t0 = t2;
    }
}
#undef DPP_F
}
constexpr int N_PHASES = 1 + 2 * (5 + 8) + 2 * (5 + 8);

#ifndef PROBE_SITE
#define PROBE_SITE -1
#endif
#ifndef PROBE_LN
#define PROBE_LN 0
#endif
#ifndef PROBE_VAR
#define PROBE_VAR 9
#endif
#define GEMM_PHASE(EPI, Aptr, Bptr, NN, KK, ...) { pg8::Gemm g{(const bf16_t*)(Aptr), (const bf16_t*)(Bptr), T, (NN), (KK)}; pg8::StaticOrder S; S.init(T, (NN), c.G, c.bid); \
        pg8::EPI E{__VA_ARGS__}; pg8::gemm_phase<pg8::EPI, pg8::StaticOrder>(c.lds, g, S, E, c.tid); }

__global__ void __launch_bounds__(NTHR, 2) fwd_kernel(Args args) {
    extern __shared__ __attribute__((aligned(16))) unsigned char lds_raw[];
    volatile LAS unsigned* misc = (volatile LAS unsigned*)((LAS unsigned char*)lds_raw + LDS_MISC_OFF);
    if (threadIdx.x < 64) misc[threadIdx.x] = 0u;
    __syncthreads();
    const int wave_s = __builtin_amdgcn_readfirstlane((int)threadIdx.x >> 6);
    const int lo = args.ph_lo, hi = args.ph_hi;
    XcdBarrier bar; bar.bar = (unsigned*)(args.ws + WS_CTL); bar.x = 0; bar.st = nullptr;
    if (hi - lo > 1) bar = xcd_barrier_post((unsigned*)(args.ws + WS_CTL), misc + 8);
    int ph = 0;
#define PHASE(site, ...) if (ph >= lo && ph < hi) { const Ctx c = mk_ctx(lds_raw, wave_s); unsigned char* const ws = c.ws; (void)ws; { constexpr int dup = 0; (void)dup; __VA_ARGS__ } \
        if constexpr (PROBE_SITE == (site)) { __syncthreads(); constexpr int dup = 1; (void)dup; __VA_ARGS__ } if (ph + 1 < hi) xcd_barrier(bar); } ++ph;

    PHASE(0, p0_prologue(c);)

    for (int layer = 0; layer < NL; ++layer) {
        const int j = layer >> 1;
        if ((layer & 1) == 0) {
            PHASE(1, GEMM_PHASE(EpiBf16P, c.out, (const bf16_t*)(ws + W_WA) + (size_t)j * 768 * 1024, 768, 1024, (bf16_t*)(ws + B_A32), 768))
            PHASE(2, l0_convert(c, layer); mla_e1(c, j);)
            PHASE(3, GEMM_PHASE(EpiBf16P, ws + B_CQN, (const bf16_t*)(ws + W_WUQ) + (size_t)j * 1536 * 384, 1536, 384, (bf16_t*)(ws + B_Q), 1536) __syncthreads();
                     GEMM_PHASE(EpiBf16P, ws + B_CKVN, (const bf16_t*)(ws + W_WUKV) + (size_t)j * 2048 * 256, 2048, 256, (bf16_t*)(ws + B_KV), 2048))
            PHASE(5, if (dup == 0) mla_attention<0>(c); else mla_attention<(PROBE_VAR > 4 ? 0 : PROBE_VAR)>(c);)
            PHASE(6, GEMM_PHASE(EpiBf16P, ws + B_O, (const bf16_t*)(ws + W_WO) + (size_t)j * 1024 * 1024, 1024, 1024, (bf16_t*)(ws + B_H32_MLA), 1024))
        } else {
            PHASE(7, GEMM_PHASE(EpiHgrn, c.out, (const bf16_t*)(ws + W_HIN) + (size_t)j * 5120 * 1024, 5120, 1024, (bf16_t*)(ws + B_PLANE), (size_t)T * 1024, (const float*)(ws + WS_MISC) + (size_t)j * 2048))
            PHASE(8, scan::hgrn_prep(c, dup);)
            PHASE(9, scan::hgrn_scan(c, dup != 0); if (dup == 0) { if (c.G > 64) { if (c.bid >= 32) l0_convert(c, layer, (c.bid - 32) * NWAVES + c.wave, (c.G - 32) * NWAVES); } else l0_convert(c, layer); })
            PHASE(10, hgrn_post(c, j);)
            PHASE(11, GEMM_PHASE(EpiBf16P, ws + B_PLANE, (const bf16_t*)(ws + W_HO) + (size_t)j * 1024 * 1024, 1024, 1024, (bf16_t*)(ws + B_H32_HGRN), 1024))
        }
        PHASE(12, ln_residual(c, (const bf16_t*)(ws + ((layer & 1) ? B_H32_HGRN : B_H32_MLA)), c.in(18) + layer * D, c.in(19) + layer * D);)
        PHASE(13, GEMM_PHASE(EpiBf16P, ws + WS_XB, (const bf16_t*)(ws + W_PQ) + (size_t)layer * 2048 * 1024, 2048, 1024, (bf16_t*)(ws + B_PQ), 2048))
        PHASE(14, peer::route(c, layer);)
        PHASE(15, peer::g1_udot(c, layer, dup);)
        PHASE(16, peer::g2_coef(c, dup);)
        PHASE(17, peer::g3_vaxpy(c, layer, dup);)
        PHASE(18, if (dup == 0 || PROBE_LN == 0) GEMM_PHASE(EpiBf16P, ws + R2_PB, (const bf16_t*)(ws + W_PP) + (size_t)layer * 1024 * 256, 1024, 256, (bf16_t*)(ws + B_PP), 1024) if (dup == 0 || PROBE_LN == 1) peer::ln_pass(c, c.in(20) + layer * D, c.in(21) + layer * D);)
        PHASE(19, GEMM_PHASE(EpiPle, ws + WS_XB, (const bf16_t*)(ws + W_GW) + (size_t)layer * 1024 * 1024, 1024, 1024, (const bf16_t*)(ws + WS_XB), (const bf16_t*)(ws + B_PP), c.in(23) + layer * D, (bf16_t*)c.out, (layer == NL - 1) ? c.out : (float*)nullptr))
    }
#undef PHASE
}

extern "C" void kernel_launch(void* const* d_in, const int* in_sizes, int n_in, void* d_out, int out_size, void* d_ws, size_t ws_size, hipStream_t stream) {
    static int grid = 0;
    if (grid == 0) {
        if (n_in != 25 || out_size != T * D || ws_size < WS_END) { fprintf(stderr, "kernel_launch: unexpected shapes: n_in %d out %d ws %zu (need %zu)\n", n_in, out_size, ws_size, (size_t)WS_END); grid = -1; return; }
        int dev = 0, cus = 0, per_cu = 0;
        if (hipGetDevice(&dev) != hipSuccess || hipDeviceGetAttribute(&cus, hipDeviceAttributeMultiprocessorCount, dev) != hipSuccess) { grid = -1; return; }
        if (hipFuncSetAttribute((const void*)fwd_kernel, hipFuncAttributeMaxDynamicSharedMemorySize, LDS_BYTES) != hipSuccess) { fprintf(stderr, "kernel_launch: hipFuncSetAttribute failed\n"); grid = -1; return; }
        if (hipOccupancyMaxActiveBlocksPerMultiprocessor(&per_cu, (const void*)fwd_kernel, NTHR, LDS_BYTES) != hipSuccess || per_cu < 1) { fprintf(stderr, "kernel_launch: occupancy query says %d\n", per_cu); }
        (void)hipGetLastError();
        grid = cus;
    }
    if (grid < 0) return;
    (void)hipMemsetAsync((char*)d_ws + WS_CTL, 0, CTL_ZERO_BYTES, stream);
    Args a{};
    for (int i = 0; i < 25; ++i) a.in[i] = (const float*)d_in[i];
    a.out = (float*)d_out; a.ws = (unsigned char*)d_ws;
#if defined(MK_DEBUG_MLA)
    float* res = (float*)((char*)d_ws + WS_CTL + 48 * 1024);
    for (int p = 0; p < 4; ++p) { a.ph_lo = p; a.ph_hi = p + 1; hipLaunchKernelGGL(fwd_kernel, dim3(grid), dim3(NTHR), LDS_BYTES, stream, a); }
    hipLaunchKernelGGL(k_zero_out, dim3(2048), dim3(256), 0, stream, (float*)d_out, (size_t)T * D);
    hipLaunchKernelGGL(k_mla_naive, dim3(2), dim3(256), 0, stream, (const float*)d_in[0], (const float*)d_in[1], (const float*)d_in[4], (const float*)d_in[5], (const float*)d_in[6], (const float*)d_in[7], (const float*)d_in[8], (const unsigned char*)d_ws, res);
    hipLaunchKernelGGL(k_mla_report, dim3(1), dim3(64), 0, stream, (const float*)res, (float*)d_out);
#elif defined(MK_DEBUG_ATTN)
    float* res = (float*)((char*)d_ws + WS_CTL + 48 * 1024);
    for (int p = 0; p < 5; ++p) { a.ph_lo = p; a.ph_hi = p + 1; hipLaunchKernelGGL(fwd_kernel, dim3(grid), dim3(NTHR), LDS_BYTES, stream, a); }
    hipLaunchKernelGGL(k_zero_out, dim3(2048), dim3(256), 0, stream, (float*)d_out, (size_t)T * D);
    hipLaunchKernelGGL(k_attn_naive, dim3(2 * CHK_NR), dim3(256), 0, stream, (const unsigned char*)d_ws, (float*)nullptr, res);
    hipLaunchKernelGGL(k_attn_report, dim3(1), dim3(64), 0, stream, (const float*)res, (float*)d_out);
#elif defined(MK_DEBUG_DET)
    unsigned long long* tab = (unsigned long long*)((char*)d_ws + WS_CTL + 32 * 1024);
    for (int pass = 0; pass < 2; ++pass)
        for (int p = 0; p < N_PHASES; ++p) { a.ph_lo = p; a.ph_hi = p + 1; hipLaunchKernelGGL(fwd_kernel, dim3(grid), dim3(NTHR), LDS_BYTES, stream, a);
            Reg r[4]; const int nr = phase_regions(p, r);
            for (int i = 0; i < nr; ++i) hipLaunchKernelGGL(k_checksum, dim3(2048), dim3(256), 0, stream, (const unsigned*)(r[i].in_out ? (char*)d_out : (char*)d_ws + r[i].off), r[i].bytes / 4, tab + (size_t)pass * N_PHASES * 4 + p * 4 + i); }
    hipLaunchKernelGGL(k_zero_out, dim3(2048), dim3(256), 0, stream, (float*)d_out, (size_t)T * D);
    hipLaunchKernelGGL(k_report, dim3(1), dim3(64), 0, stream, tab, N_PHASES * 4, (float*)d_out);
#elif MK_ONE_LAUNCH
    a.ph_lo = 0; a.ph_hi = N_PHASES;
    hipLaunchKernelGGL(fwd_kernel, dim3(grid), dim3(NTHR), LDS_BYTES, stream, a);
#else
    for (int p = 0; p < N_PHASES; ++p) { a.ph_lo = p; a.ph_hi = p + 1; hipLaunchKernelGGL(fwd_kernel, dim3(grid), dim3(NTHR), LDS_BYTES, stream, a); }
#endif
}
```
